# Optimizing an MI355X kernel written in HIP

```python
import math
import jax, jax.numpy as jnp
from jax import lax
import numpy as np

D_MODEL = 1024
BATCH = 16
SEQ = 256
DEPTH = 4
DEC_BATCH = 8
DEC_SEQ = 1024
PAST_LEN = 512

GRID_W = 64
N_EVEN = (DEPTH + 1) // 2
N_ODD = DEPTH // 2
BRANCH = D_MODEL // 2
CHUNK = 64
EPS = 1e-6

GLA_HEADS = 4
GLA_DV = BRANCH // GLA_HEADS
GLA_DK = GLA_DV // 2
GLA_QK = GLA_HEADS * GLA_DK
GLA_GATE_RANK = 16
GLA_TAU = 16.0

RWKV_HEAD = 64
RWKV_HEADS = BRANCH // RWKV_HEAD
RWKV_DECAY_RANK = 64
RWKV_A_RANK = 64
RWKV_LN_EPS = 64e-5
RWKV_SHIFTED = 3 * BRANCH + 2 * RWKV_DECAY_RANK + 2 * RWKV_A_RANK

GDN_HEADS = 4
GDN_DK = BRANCH // GDN_HEADS
GDN_DV = BRANCH // GDN_HEADS
CONV_K = 3

S5_GROUP = 16
S5_GROUPS = BRANCH // S5_GROUP
S5_STATE = 64
S5_MAX_RE = -1e-4

EVEN_SIZES = (GLA_QK, GLA_QK, BRANCH, 2 * GLA_GATE_RANK, BRANCH, RWKV_SHIFTED, BRANCH)
RWKV_SIZES = (BRANCH, BRANCH, BRANCH, 2 * RWKV_DECAY_RANK, 2 * RWKV_A_RANK)
ODD_SIZES = (3 * BRANCH, 2 * GDN_HEADS, 2 * GDN_HEADS, BRANCH, BRANCH, BRANCH)
EVEN_WIDTH = sum(EVEN_SIZES)
ODD_WIDTH = sum(ODD_SIZES)

kernel_name = 'hybrid_bidir_flow_step'


def _cuts(sizes):
    return [int(v) for v in np.cumsum(sizes)[:-1]]


def _rev(t):
    return jnp.flip(t, axis=1)


def _rmsnorm(x, g):
    xf = x.astype(jnp.float32)
    y = xf * lax.rsqrt(jnp.mean(xf * xf, axis=-1, keepdims=True) + EPS)
    return (y * g.astype(jnp.float32)).astype(x.dtype)


def _l2norm(x):
    return x * lax.rsqrt(jnp.sum(x * x, axis=-1, keepdims=True) + EPS)


def _head_layernorm(x, g, b):
    mu = jnp.mean(x, axis=-1, keepdims=True)
    xc = x - mu
    var = jnp.mean(xc * xc, axis=-1, keepdims=True)
    return xc * lax.rsqrt(var + RWKV_LN_EPS) * g.astype(jnp.float32) + b.astype(jnp.float32)


def _neighbour_mean(f, rows):
    b, l, ch = f.shape
    g = f.reshape(b, 1 if rows is None else rows, -1, ch)
    gp = jnp.pad(g, ((0, 0), (0, 0), (1, 1), (0, 0)))
    return (0.5 * (gp[:, :, :-2] + gp[:, :, 2:])).reshape(b, l, ch)


def _short_conv(f, w, rows):
    b, l, ch = f.shape
    w = w.astype(f.dtype)
    p = CONV_K // 2
    if rows is None:
        fp = jnp.pad(f, ((0, 0), (p, p), (0, 0)))
        out = fp[:, 0:l] * w[p, 0]
        for j in range(1, CONV_K):
            out = out + fp[:, j:j + l] * w[p, j]
        return out
    g = f.reshape(b, rows, GRID_W, ch)
    gp = jnp.pad(g, ((0, 0), (p, p), (p, p), (0, 0)))
    out = gp[:, 0:rows, 0:GRID_W] * w[0, 0]
    for i in range(CONV_K):
        for j in range(CONV_K):
            if i or j:
                out = out + gp[:, i:i + rows, j:j + GRID_W] * w[i, j]
    return out.reshape(b, l, ch)


def _gla_chunked(q, k, v, log_a, s0):
    b, l, h, dk = q.shape
    dv = v.shape[-1]
    n = l // CHUNK
    q, k, v, log_a = (t.reshape(b, n, CHUNK, h, t.shape[-1]) for t in (q, k, v, log_a))
    bcum = jnp.cumsum(log_a, axis=2)
    q_dec = q * jnp.exp(bcum)
    k_inv = k * jnp.exp(-bcum)
    k_end = k * jnp.exp(bcum[:, :, -1:] - bcum)
    a_end = jnp.exp(bcum[:, :, -1])
    mask = jnp.tril(jnp.ones((CHUNK, CHUNK), bool))
    scores = jnp.where(mask, jnp.einsum('bnthd,bnshd->bnhts', q_dec, k_inv), 0.0)
    o_intra = jnp.einsum('bnhts,bnshv->bnthv', scores, v)

    def step(s, inp):
        qd, ke, vv, ae = inp
        o_inter = jnp.einsum('bthd,bhdv->bthv', qd, s)
        s = s * ae[..., None] + jnp.einsum('bthd,bthv->bhdv', ke, vv)
        return s, o_inter

    xs = tuple(jnp.moveaxis(t, 1, 0) for t in (q_dec, k_end, v, a_end))
    s_fin, o_inter = lax.scan(step, s0, xs)
    o = o_intra + jnp.moveaxis(o_inter, 0, 1)
    return o.reshape(b, l, h, dv), s_fin


def _rwkv7_scan(r, w, k, v, kk, a, s0):
    def step(s, inp):
        rt, wt, kt, vt, kkt, at = inp
        sa = jnp.einsum('bhvk,bhk->bhv', s, -kkt)
        s = (s * wt[:, :, None, :] + sa[..., None] * (kkt * at)[:, :, None, :]
             + vt[..., None] * kt[:, :, None, :])
        return s, jnp.einsum('bhvk,bhk->bhv', s, rt)

    xs = tuple(jnp.moveaxis(t, 1, 0) for t in (r, w, k, v, kk, a))
    s_fin, y = lax.scan(step, s0, xs)
    return jnp.moveaxis(y, 0, 1), s_fin


def _gated_delta_chunked(q, k, v, log_g, beta, s0):
    b, l, h, dk = q.shape
    dv = v.shape[-1]
    n = l // CHUNK
    q, k, v = (t.reshape(b, n, CHUNK, h, t.shape[-1]) for t in (q, k, v))
    log_g, beta = (t.reshape(b, n, CHUNK, h) for t in (log_g, beta))
    gcum = jnp.cumsum(log_g, axis=2)
    gh = jnp.swapaxes(gcum, 2, 3)
    causal = jnp.tril(jnp.ones((CHUNK, CHUNK), bool))
    strict = jnp.tril(jnp.ones((CHUNK, CHUNK), bool), -1)
    diff = gh[..., :, None] - gh[..., None, :]
    decay = jnp.where(causal, jnp.exp(jnp.where(causal, diff, 0.0)), 0.0)
    kb = k * beta[..., None]
    a_mat = jnp.where(strict, jnp.einsum('bnthd,bnshd->bnhts', kb, k) * decay, 0.0)
    eye = jnp.eye(CHUNK, dtype=a_mat.dtype)
    rhs = jnp.concatenate([jnp.swapaxes(v * beta[..., None], 2, 3),
                           jnp.swapaxes(kb * jnp.exp(gcum)[..., None], 2, 3)], axis=-1)
    sol = lax.linalg.triangular_solve(eye + a_mat, rhs, left_side=True, lower=True,
                                      unit_diagonal=True)
    u, w = sol[..., :dv], sol[..., dv:]
    qk = jnp.einsum('bnthd,bnshd->bnhts', q, k) * decay
    q_g = jnp.swapaxes(q * jnp.exp(gcum)[..., None], 2, 3)
    k_end = jnp.swapaxes(k * jnp.exp(gcum[:, :, -1:] - gcum)[..., None], 2, 3)
    g_end = jnp.exp(gcum[:, :, -1])

    def step(s, inp):
        u_c, w_c, qk_c, qg_c, ke_c, ge_c = inp
        delta = u_c - jnp.einsum('bhtd,bhdv->bhtv', w_c, s)
        o = jnp.einsum('bhtd,bhdv->bhtv', qg_c, s) + jnp.einsum('bhts,bhsv->bhtv', qk_c, delta)
        s = s * ge_c[..., None, None] + jnp.einsum('bhsd,bhsv->bhdv', ke_c, delta)
        return s, o

    xs = tuple(jnp.moveaxis(t, 1, 0) for t in (u, w, qk, q_g, k_end, g_end))
    s_fin, o = lax.scan(step, s0, xs)
    o = jnp.transpose(o, (1, 0, 3, 2, 4)).reshape(b, l, h, dv)
    return o, s_fin


def _complex_affine_combine(e1, e2):
    a1r, a1i, b1r, b1i = e1
    a2r, a2i, b2r, b2i = e2
    return (a1r * a2r - a1i * a2i, a1r * a2i + a1i * a2r,
            a2r * b1r - a2i * b1i + b2r, a2r * b1i + a2i * b1r + b2i)


def _s5_scan(u, a_re, a_im, log_dt, b_re, b_im, c_re, c_im, h0_re, h0_im):
    f32 = jnp.float32
    a_re = jnp.minimum(a_re.astype(f32), S5_MAX_RE)
    a_im = a_im.astype(f32)
    dt = jnp.exp(log_dt.astype(f32))[:, None]
    mag = jnp.exp(a_re * dt)
    ab_re = mag * jnp.cos(a_im * dt)
    ab_im = mag * jnp.sin(a_im * dt)
    den = a_re * a_re + a_im * a_im
    f_re = ((ab_re - 1.0) * a_re + ab_im * a_im) / den
    f_im = (ab_im * a_re - (ab_re - 1.0) * a_im) / den
    b_re = b_re.astype(f32)
    b_im = b_im.astype(f32)
    bb_re = f_re[..., None] * b_re - f_im[..., None] * b_im
    bb_im = f_re[..., None] * b_im + f_im[..., None] * b_re
    bu_re = jnp.einsum('gpc,blgc->blgp', bb_re, u)
    bu_im = jnp.einsum('gpc,blgc->blgp', bb_im, u)
    ar = jnp.broadcast_to(ab_re, bu_re.shape)
    ai = jnp.broadcast_to(ab_im, bu_im.shape)
    pr, pim, hr, hi = lax.associative_scan(_complex_affine_combine, (ar, ai, bu_re, bu_im), axis=1)
    h0r = h0_re.astype(f32)[:, None]
    h0i = h0_im.astype(f32)[:, None]
    hr = hr + pr * h0r - pim * h0i
    hi = hi + pr * h0i + pim * h0r
    y = (jnp.einsum('gcp,blgp->blgc', c_re.astype(f32), hr)
         - jnp.einsum('gcp,blgp->blgc', c_im.astype(f32), hi))
    return y, hr[:, -1], hi[:, -1]


def _mix_even(h, rows, s_gla, s_rwkv, w_in, w_out, gate_up, gate_bias, gla_g,
              mix, w0, w2, a0, a2, k_k, k_a, r_k, ln_g, ln_b):
    f32 = jnp.float32
    b, l, _ = h.shape
    proj = h @ w_in
    q_a, k_a_in, v_a, gd, z_a, feat_b, z_b = jnp.split(proj, _cuts(EVEN_SIZES), axis=-1)
    q_a = q_a.astype(f32).reshape(b, l, GLA_HEADS, GLA_DK) * GLA_DK ** -0.5
    k_a_in = k_a_in.astype(f32).reshape(b, l, GLA_HEADS, GLA_DK)
    v_a = v_a.astype(f32).reshape(b, l, GLA_HEADS, GLA_DV)
    gd = gd.astype(f32).reshape(b, l, 2, GLA_GATE_RANK)
    log_a = jax.nn.log_sigmoid(jnp.einsum('bldr,drk->bldk', gd, gate_up.astype(f32))
                               + gate_bias.astype(f32)) / GLA_TAU
    log_a = log_a.reshape(b, l, 2, GLA_HEADS, GLA_DK)
    o_f, sg_f = _gla_chunked(q_a, k_a_in, v_a, log_a[:, :, 0], s_gla[:, 0].astype(f32))
    o_b, sg_b = _gla_chunked(_rev(q_a), _rev(k_a_in), _rev(v_a), _rev(log_a[:, :, 1]),
                             s_gla[:, 1].astype(f32))
    o_a = _rmsnorm(o_f + _rev(o_b), gla_g).reshape(b, l, BRANCH)
    y_a = o_a * jax.nn.silu(z_a.astype(f32))
    fb = feat_b.astype(f32)
    fb = fb + mix.astype(f32) * (_neighbour_mean(fb, rows) - fb)
    r, k_b, v_b, wd, ad = jnp.split(fb, _cuts(RWKV_SIZES), axis=-1)
    wd = wd.reshape(b, l, 2, RWKV_DECAY_RANK)
    ad = ad.reshape(b, l, 2, RWKV_A_RANK)
    w_log = -jax.nn.softplus(-(w0.astype(f32)
                               + jnp.einsum('bldr,drc->bldc', jnp.tanh(wd), w2.astype(f32)))) - 0.5
    decay = jnp.exp(-jnp.exp(w_log))
    a = jax.nn.sigmoid(a0.astype(f32) + jnp.einsum('bldr,drc->bldc', ad, a2.astype(f32)))
    hd = lambda t: t.reshape(t.shape[:2] + (RWKV_HEADS, RWKV_HEAD))
    kk = _l2norm(hd(k_b * k_k.astype(f32)))
    k_mod = k_b[:, :, None] * (1.0 + (a - 1.0) * k_a.astype(f32))
    r_h, v_h = hd(r), hd(v_b)
    o_f, sr_f = _rwkv7_scan(r_h, hd(decay[:, :, 0]), hd(k_mod[:, :, 0]), v_h, kk,
                            hd(a[:, :, 0]), s_rwkv[:, 0].astype(f32))
    o_b, sr_b = _rwkv7_scan(_rev(r_h), _rev(hd(decay[:, :, 1])), _rev(hd(k_mod[:, :, 1])),
                            _rev(v_h), _rev(kk), _rev(hd(a[:, :, 1])), s_rwkv[:, 1].astype(f32))
    o = _head_layernorm(o_f + _rev(o_b), ln_g.reshape(RWKV_HEADS, RWKV_HEAD),
                        ln_b.reshape(RWKV_HEADS, RWKV_HEAD))
    bonus = jnp.sum(r_h * hd(jnp.sum(k_mod, axis=2)) * r_k.astype(f32).reshape(RWKV_HEADS, RWKV_HEAD),
                    axis=-1, keepdims=True) * v_h
    y_b = (o + bonus).reshape(b, l, BRANCH) * jax.nn.silu(z_b.astype(f32))
    y = jnp.concatenate([y_a, y_b], axis=-1).astype(h.dtype) @ w_out
    return y, (jnp.stack([sg_f, sg_b], axis=1), jnp.stack([sr_f, sr_b], axis=1))


def _mix_odd(h, rows, s_gdn, s5_re, s5_im, w_in, w_out, conv_w, a_log, dt_bias, gdn_g,
             a_re, a_im, log_dt, b_re, b_im, c_re, c_im, d_skip, glu_w, glu_b):
    f32 = jnp.float32
    b, l, _ = h.shape
    proj = h @ w_in
    qkv, g_in, beta_in, z_c, u, z_d = jnp.split(proj, _cuts(ODD_SIZES), axis=-1)
    qkv = jax.nn.silu(_short_conv(qkv.astype(f32), conv_w, rows))
    q, k, v = (t.reshape(b, l, GDN_HEADS, -1) for t in jnp.split(qkv, 3, axis=-1))
    q = _l2norm(q) * GDN_DK ** -0.5
    k = _l2norm(k)
    log_g = -jnp.exp(a_log.astype(f32)) * jax.nn.softplus(
        g_in.astype(f32).reshape(b, l, 2, GDN_HEADS) + dt_bias.astype(f32))
    beta = jax.nn.sigmoid(beta_in.astype(f32).reshape(b, l, 2, GDN_HEADS))
    o_f, sd_f = _gated_delta_chunked(q, k, v, log_g[:, :, 0], beta[:, :, 0], s_gdn[:, 0].astype(f32))
    o_b, sd_b = _gated_delta_chunked(_rev(q), _rev(k), _rev(v), _rev(log_g[:, :, 1]),
                                     _rev(beta[:, :, 1]), s_gdn[:, 1].astype(f32))
    y_c = _rmsnorm(o_f + _rev(o_b), gdn_g).reshape(b, l, BRANCH) * jax.nn.silu(z_c.astype(f32))
    uf = u.astype(f32).reshape(b, l, S5_GROUPS, S5_GROUP)
    y_f, hr_f, hi_f = _s5_scan(uf, a_re[0], a_im[0], log_dt[0], b_re[0], b_im[0], c_re[0], c_im[0],
                               s5_re[:, 0], s5_im[:, 0])
    y_b, hr_b, hi_b = _s5_scan(_rev(uf), a_re[1], a_im[1], log_dt[1], b_re[1], b_im[1], c_re[1],
                               c_im[1], s5_re[:, 1], s5_im[:, 1])
    y = y_f + _rev(y_b) + d_skip.astype(f32).reshape(S5_GROUPS, S5_GROUP) * uf
    y = jax.nn.gelu(y.reshape(b, l, BRANCH))
    y_d = y * jax.nn.sigmoid(y @ glu_w.astype(f32) + glu_b.astype(f32)) * jax.nn.silu(z_d.astype(f32))
    out = jnp.concatenate([y_c, y_d], axis=-1).astype(h.dtype) @ w_out
    return out, (jnp.stack([sd_f, sd_b], axis=1), jnp.stack([hr_f, hr_b], axis=1),
                 jnp.stack([hi_f, hi_b], axis=1))


def setup_inputs(seed: int = 0) -> dict:
    key = jax.random.key(seed)
    ks = iter(jax.random.split(key, 64))
    f32 = jnp.float32
    nrm = lambda shape, s=1.0: s * jax.random.normal(next(ks), shape, f32)
    unif = lambda shape, lo, hi: jax.random.uniform(next(ks), shape, f32, lo, hi)
    d = D_MODEL
    E, O = N_EVEN, N_ODD
    gdn_dt = jnp.exp(unif((O, 2, GDN_HEADS), math.log(1e-3), math.log(1e-1)))
    n_idx = jnp.arange(S5_STATE, dtype=f32)
    return {
        'x_prompt': nrm((BATCH, SEQ, d)),
        'x_sample': nrm((DEC_BATCH, DEC_SEQ, d)),
        'c': nrm((DEC_BATCH, d)),
        'state_gla': nrm((DEC_BATCH, E, 2, GLA_HEADS, GLA_DK, GLA_DV), 0.5),
        'state_rwkv': nrm((DEC_BATCH, E, 2, RWKV_HEADS, RWKV_HEAD, RWKV_HEAD), 0.5),
        'state_gdn': nrm((DEC_BATCH, O, 2, GDN_HEADS, GDN_DK, GDN_DV), 0.1),
        'state_s5_re': nrm((DEC_BATCH, O, 2, S5_GROUPS, S5_STATE), 0.5),
        'state_s5_im': nrm((DEC_BATCH, O, 2, S5_GROUPS, S5_STATE), 0.5),
        'c_ctx': nrm((d,)),
        'w_mod': nrm((DEPTH, d, 3 * d), d ** -0.5),
        'b_mod': nrm((DEPTH, 3 * d), 0.01),
        'g_pre': 1.0 + nrm((DEPTH, d), 0.01),
        'g_post': 1.0 + nrm((DEPTH, d), 0.01),
        'w_in_e': nrm((E, d, EVEN_WIDTH), d ** -0.5),
        'w_out_e': nrm((E, 2 * BRANCH, d), (2 * BRANCH) ** -0.5),
        'gla_gate_up': nrm((E, 2, GLA_GATE_RANK, GLA_QK), GLA_GATE_RANK ** -0.5),
        'gla_gate_bias': nrm((E, 2, GLA_QK), 0.1),
        'gla_norm': 1.0 + nrm((E, GLA_DV), 0.01),
        'rwkv_mix': unif((E, RWKV_SHIFTED), 0.0, 1.0),
        'rwkv_w0': unif((E, 2, BRANCH), -6.0, -1.0),
        'rwkv_w2': nrm((E, 2, RWKV_DECAY_RANK, BRANCH), 0.5 * RWKV_DECAY_RANK ** -0.5),
        'rwkv_a0': nrm((E, 2, BRANCH), 0.1),
        'rwkv_a2': nrm((E, 2, RWKV_A_RANK, BRANCH), 0.5 * RWKV_A_RANK ** -0.5),
        'rwkv_kk': 0.85 + nrm((E, BRANCH), 0.05),
        'rwkv_ka': 1.0 + nrm((E, BRANCH), 0.05),
        'rwkv_rk': nrm((E, BRANCH), 0.1),
        'rwkv_ln_g': 1.0 + nrm((E, BRANCH), 0.01),
        'rwkv_ln_b': nrm((E, BRANCH), 0.01),
        'w_in_o': nrm((O, d, ODD_WIDTH), d ** -0.5),
        'w_out_o': nrm((O, 2 * BRANCH, d), (2 * BRANCH) ** -0.5),
        'gdn_conv': nrm((O, CONV_K, CONV_K, 3 * BRANCH), 1.0 / CONV_K),
        'gdn_A_log': jnp.log(unif((O, 2, GDN_HEADS), 1.0, 16.0)),
        'gdn_dt_bias': gdn_dt + jnp.log(-jnp.expm1(-gdn_dt)),
        'gdn_norm': 1.0 + nrm((O, GDN_DV), 0.01),
        's5_A_re': -0.5 + nrm((O, 2, S5_GROUPS, S5_STATE), 0.01),
        's5_A_im': jnp.pi * n_idx + nrm((O, 2, S5_GROUPS, S5_STATE), 0.01),
        's5_log_dt': unif((O, 2, S5_GROUPS), math.log(1e-3), math.log(1e-1)),
        's5_B_re': nrm((O, 2, S5_GROUPS, S5_STATE, S5_GROUP), (2 * S5_GROUP) ** -0.5),
        's5_B_im': nrm((O, 2, S5_GROUPS, S5_STATE, S5_GROUP), (2 * S5_GROUP) ** -0.5),
        's5_C_re': nrm((O, 2, S5_GROUPS, S5_GROUP, S5_STATE), 0.5),
        's5_C_im': nrm((O, 2, S5_GROUPS, S5_GROUP, S5_STATE), 0.5),
        's5_D': nrm((O, BRANCH)),
        's5_glu_w': nrm((O, BRANCH, BRANCH), BRANCH ** -0.5),
        's5_glu_b': nrm((O, BRANCH), 0.01),
    }


def reference(x_prompt, x_sample, c, state_gla, state_rwkv, state_gdn, state_s5_re, state_s5_im,
              c_ctx, w_mod, b_mod, g_pre, g_post,
              w_in_e, w_out_e, gla_gate_up, gla_gate_bias, gla_norm,
              rwkv_mix, rwkv_w0, rwkv_w2, rwkv_a0, rwkv_a2, rwkv_kk, rwkv_ka, rwkv_rk,
              rwkv_ln_g, rwkv_ln_b,
              w_in_o, w_out_o, gdn_conv, gdn_A_log, gdn_dt_bias, gdn_norm,
              s5_A_re, s5_A_im, s5_log_dt, s5_B_re, s5_B_im, s5_C_re, s5_C_im,
              s5_D, s5_glu_w, s5_glu_b):

    def trunk(x, cond, s_gla, s_rwkv, s_gdn, s_re, s_im, rows):
        fin_gla, fin_rwkv, fin_gdn, fin_re, fin_im = [], [], [], [], []
        for layer in range(DEPTH):
            mod = (jax.nn.silu(cond) @ w_mod[layer] + b_mod[layer])[:, None, :]
            shift, scale, gate = jnp.split(mod, 3, axis=-1)
            hmod = _rmsnorm(x, g_pre[layer]) * (1.0 + scale) + shift
            i = layer // 2
            if layer % 2 == 0:
                m, (fg, fr) = _mix_even(
                    hmod, rows, s_gla[:, i], s_rwkv[:, i], w_in_e[i], w_out_e[i],
                    gla_gate_up[i], gla_gate_bias[i], gla_norm[i],
                    rwkv_mix[i], rwkv_w0[i], rwkv_w2[i], rwkv_a0[i], rwkv_a2[i],
                    rwkv_kk[i], rwkv_ka[i], rwkv_rk[i], rwkv_ln_g[i], rwkv_ln_b[i])
                fin_gla.append(fg)
                fin_rwkv.append(fr)
            else:
                m, (fd, fre, fim) = _mix_odd(
                    hmod, rows, s_gdn[:, i], s_re[:, i], s_im[:, i], w_in_o[i], w_out_o[i],
                    gdn_conv[i], gdn_A_log[i], gdn_dt_bias[i], gdn_norm[i],
                    s5_A_re[i], s5_A_im[i], s5_log_dt[i], s5_B_re[i], s5_B_im[i],
                    s5_C_re[i], s5_C_im[i], s5_D[i], s5_glu_w[i], s5_glu_b[i])
                fin_gdn.append(fd)
                fin_re.append(fre)
                fin_im.append(fim)
            x = x + gate * _rmsnorm(m, g_post[layer])
        st = lambda lst: jnp.stack(lst, axis=1).astype(x.dtype)
        return x, st(fin_gla), st(fin_rwkv), st(fin_gdn), st(fin_re), st(fin_im)

    bp = x_prompt.shape[0]
    zeros = lambda shape: jnp.zeros((bp,) + shape, x_prompt.dtype)
    y_prompt, new_gla, new_rwkv, new_gdn, new_s5_re, new_s5_im = trunk(
        x_prompt, c_ctx[None, :],
        zeros((N_EVEN, 2, GLA_HEADS, GLA_DK, GLA_DV)),
        zeros((N_EVEN, 2, RWKV_HEADS, RWKV_HEAD, RWKV_HEAD)),
        zeros((N_ODD, 2, GDN_HEADS, GDN_DK, GDN_DV)),
        zeros((N_ODD, 2, S5_GROUPS, S5_STATE)),
        zeros((N_ODD, 2, S5_GROUPS, S5_STATE)),
        None)

    rows = x_sample.shape[1] // GRID_W
    y_sample = trunk(x_sample, c, state_gla, state_rwkv, state_gdn, state_s5_re, state_s5_im, rows)[0]

    return (y_prompt, y_sample, new_gla, new_rwkv, new_gdn, new_s5_re, new_s5_im)
```

```cpp
#ifndef CPU_EMU
#include <hip/hip_runtime.h>
#endif
#include <stdint.h>

#ifndef CFG_BATCH
#define CFG_BATCH 16
#define CFG_SEQ 256
#define CFG_DEC_BATCH 8
#define CFG_DEC_SEQ 1024
#define CFG_DEPTH 4
#endif

typedef unsigned short bf16;
typedef short s8v __attribute__((ext_vector_type(8)));
typedef float f4v __attribute__((ext_vector_type(4)));

constexpr int D = 1024;
constexpr int NB_CTX = CFG_BATCH, L_CTX = CFG_SEQ, NB_LAT = CFG_DEC_BATCH, L_LAT = CFG_DEC_SEQ, DEPTH = CFG_DEPTH;
constexpr int N_EVEN = (DEPTH + 1) / 2, N_ODD = DEPTH / 2;
constexpr int T_CTX = NB_CTX * L_CTX, T_LAT = NB_LAT * L_LAT, T = T_CTX + T_LAT;
constexpr int NSEQ = NB_CTX + NB_LAT, NCOND = 1 + NB_LAT;
constexpr int EW = 3872, OW = 3088, EWP = 3968, OWP = 3200;
constexpr float EPS = 1e-6f;
constexpr int E_Q = 0, E_K = 256, E_V = 512, E_GD = 1024, E_ZA = 1056, E_FB = 1568, E_ZB = 3360;
constexpr int FB_R = 0, FB_K = 512, FB_V = 1024, FB_WD = 1536, FB_AD = 1664;
constexpr int O_QKV = 0, O_G = 1536, O_BETA = 1544, O_ZC = 1552, O_U = 2064, O_ZD = 2576;

constexpr size_t al(size_t x) { return (x + 255) & ~(size_t)255; }
constexpr size_t WS_MOD = 0;
constexpr size_t WS_WTE = WS_MOD + al((size_t)DEPTH * NCOND * 3072 * 4);
constexpr size_t WS_WTO = WS_WTE + al((size_t)N_EVEN * EWP * D * 2);
constexpr size_t WS_WTOUT = WS_WTO + al((size_t)(N_ODD ? N_ODD : 1) * OWP * D * 2);
constexpr size_t WS_WTGLU = WS_WTOUT + al((size_t)DEPTH * D * D * 2);
constexpr size_t WS_HM = WS_WTGLU + al((size_t)(N_ODD ? N_ODD : 1) * 512 * 512 * 2);
constexpr size_t WS_PROJ = WS_HM + al((size_t)T * D * 2);
constexpr size_t WS_PART = WS_PROJ + al((size_t)T * EW * 2);
constexpr size_t PART_SZ = al((size_t)T * 512 * 2);
constexpr size_t WS_BONUS = WS_PART + 4 * PART_SZ;
constexpr size_t WS_QKVN = WS_BONUS + al((size_t)T * 16 * 4);
constexpr size_t WS_GATES = WS_QKVN + al((size_t)T * 1536 * 2);
constexpr size_t WS_END = WS_GATES + al((size_t)T * 16 * 4);

constexpr size_t OUT_X = 0;
constexpr size_t OUT_GLA = (size_t)T * D;
constexpr size_t OUT_RWKV = OUT_GLA + (size_t)NB_CTX * N_EVEN * 2 * 4 * 64 * 128;
constexpr size_t OUT_GDN = OUT_RWKV + (size_t)NB_CTX * N_EVEN * 2 * 8 * 64 * 64;
constexpr size_t OUT_S5R = OUT_GDN + (size_t)NB_CTX * N_ODD * 2 * 4 * 128 * 128;
constexpr size_t OUT_S5I = OUT_S5R + (size_t)NB_CTX * N_ODD * 2 * 32 * 64;

struct P {
    const float* in[44];
    float* out;
    char* ws;
};
enum { I_XP = 0, I_XS, I_C, I_SGLA, I_SRWKV, I_SGDN, I_SS5R, I_SS5I, I_CCTX, I_WMOD, I_BMOD, I_GPRE, I_GPOST,
       I_WINE, I_WOUTE, I_GUP, I_GBIAS, I_GLAN, I_MIX, I_W0, I_W2, I_A0, I_A2, I_KK, I_KA, I_RK, I_LNG, I_LNB,
       I_WINO, I_WOUTO, I_CONV, I_ALOG, I_DTB, I_GDNN, I_S5AR, I_S5AI, I_S5DT, I_S5BR, I_S5BI, I_S5CR, I_S5CI,
       I_S5D, I_GLUW, I_GLUB };

__device__ __forceinline__ float u2f(unsigned u) { return __builtin_bit_cast(float, u); }
__device__ __forceinline__ unsigned f2u(float f) { return __builtin_bit_cast(unsigned, f); }
__device__ __forceinline__ float bf2f(bf16 h) { return u2f((unsigned)h << 16); }
__device__ __forceinline__ bf16 f2bf(float f) { unsigned u = f2u(f); u += 0x7fffu + ((u >> 16) & 1u); return (bf16)(u >> 16); }
__device__ __forceinline__ float sigmoidf_(float x) { return 1.0f / (1.0f + expf(-x)); }
__device__ __forceinline__ float siluf_(float x) { return x / (1.0f + expf(-x)); }
__device__ __forceinline__ float logsigf_(float x) { return fminf(x, 0.f) - log1pf(expf(-fabsf(x))); }
__device__ __forceinline__ float softplusf_(float x) { return fmaxf(x, 0.f) + log1pf(expf(-fabsf(x))); }
__device__ __forceinline__ float gelu_tanh(float x) { return 0.5f * x * (1.0f + tanhf(0.7978845608028654f * (x + 0.044715f * x * x * x))); }

struct Seq { int start, len, cond, lat, b; };
__device__ __forceinline__ Seq get_seq(int s) {
    Seq q;
    if (s < NB_CTX) { q.start = s * L_CTX; q.len = L_CTX; q.cond = 0; q.lat = 0; q.b = s; }
    else { int b = s - NB_CTX; q.start = T_CTX + b * L_LAT; q.len = L_LAT; q.cond = 1 + b; q.lat = 1; q.b = b; }
    return q;
}
__device__ __forceinline__ int tok_cond(int t) { return t < T_CTX ? 0 : 1 + (t - T_CTX) / L_LAT; }
__device__ __forceinline__ void tok_nbr(int t, bool& hl, bool& hr) {
    if (t < T_CTX) { int pos = t % L_CTX; hl = pos != 0; hr = pos != L_CTX - 1; }
    else { int pos = (t - T_CTX) & 63; hl = pos != 0; hr = pos != 63; }
}

__global__ void __launch_bounds__(256) k_mod(P p) {
    __shared__ float sc[NCOND][1024];
    __shared__ float red[4][64][NCOND];
    const int layer = blockIdx.x / 48, ct = blockIdx.x % 48;
    const int tid = threadIdx.x, cl = tid & 63, kg = tid >> 6;
    for (int i = tid; i < NCOND * 1024; i += 256) {
        int ci = i >> 10, k = i & 1023;
        float v = ci == 0 ? p.in[I_CCTX][k] : p.in[I_C][(ci - 1) * 1024 + k];
        sc[ci][k] = siluf_(v);
    }
    __syncthreads();
    float acc[NCOND];
#pragma unroll
    for (int ci = 0; ci < NCOND; ++ci) acc[ci] = 0.f;
    const float* w = p.in[I_WMOD] + (size_t)layer * 1024 * 3072 + ct * 64 + cl;
    for (int kk = 0; kk < 256; ++kk) {
        int k = kg * 256 + kk;
        float wv = w[(size_t)k * 3072];
#pragma unroll
        for (int ci = 0; ci < NCOND; ++ci) acc[ci] += sc[ci][k] * wv;
    }
#pragma unroll
    for (int ci = 0; ci < NCOND; ++ci) red[kg][cl][ci] = acc[ci];
    __syncthreads();
    if (tid < 64) {
        float* mod = (float*)(p.ws + WS_MOD);
        int col = ct * 64 + cl;
#pragma unroll
        for (int ci = 0; ci < NCOND; ++ci)
            mod[(size_t)(layer * NCOND + ci) * 3072 + col] = red[0][cl][ci] + red[1][cl][ci] + red[2][cl][ci] + red[3][cl][ci] + p.in[I_BMOD][layer * 3072 + col];
    }
}

struct WtJob { const float* src; bf16* dst; int K, N, Npad; };
__device__ __forceinline__ WtJob wt_job(const P& p, int j) {
    WtJob q;
    if (j < N_EVEN) { q.src = p.in[I_WINE] + (size_t)j * D * EW; q.dst = (bf16*)(p.ws + WS_WTE) + (size_t)j * EWP * D; q.K = D; q.N = EW; q.Npad = EWP; return q; }
    j -= N_EVEN;
    if (j < N_ODD) { q.src = p.in[I_WINO] + (size_t)j * D * OW; q.dst = (bf16*)(p.ws + WS_WTO) + (size_t)j * OWP * D; q.K = D; q.N = OW; q.Npad = OWP; return q; }
    j -= N_ODD;
    if (j < DEPTH) { int i = j >> 1; q.src = (j & 1) ? p.in[I_WOUTO] + (size_t)i * D * D : p.in[I_WOUTE] + (size_t)i * D * D; q.dst = (bf16*)(p.ws + WS_WTOUT) + (size_t)j * D * D; q.K = D; q.N = D; q.Npad = D; return q; }
    j -= DEPTH;
    q.src = p.in[I_GLUW] + (size_t)j * 512 * 512; q.dst = (bf16*)(p.ws + WS_WTGLU) + (size_t)j * 512 * 512; q.K = 512; q.N = 512; q.Npad = 512; return q;
}
constexpr int WT_NJOBS = N_EVEN + N_ODD + DEPTH + N_ODD;
constexpr int WT_TILES = N_EVEN * (EWP / 64) * 16 + N_ODD * (OWP / 64) * 16 + DEPTH * 256 + N_ODD * 64;
__global__ void __launch_bounds__(256) k_wt(P p) {
    __shared__ float tile[64][65];
    int b = blockIdx.x, j = 0;
    WtJob q;
    for (;; ++j) { q = wt_job(p, j); int nt = (q.Npad / 64) * (q.K / 64); if (b < nt) break; b -= nt; }
    const int nk = q.K / 64, n0 = (b / nk) * 64, k0 = (b % nk) * 64;
    const int tx = threadIdx.x & 63, ty = threadIdx.x >> 6;
#pragma unroll
    for (int i = 0; i < 16; ++i) { int kk = ty + 4 * i, n = n0 + tx; tile[kk][tx] = n < q.N ? q.src[(size_t)(k0 + kk) * q.N + n] : 0.f; }
    __syncthreads();
#pragma unroll
    for (int i = 0; i < 16; ++i) { int nn = ty + 4 * i; q.dst[(size_t)(n0 + nn) * q.K + k0 + tx] = f2bf(tile[tx][nn]); }
}

__device__ __forceinline__ float wave_sum(float v) {
#pragma unroll
    for (int m = 1; m < 64; m <<= 1) v += __shfl_xor(v, m);
    return v;
}
__device__ __forceinline__ void hmod_row(const float* xv  , int lane, const float* gpre, const float* mod, bf16* dst) {
    float ss = 0.f;
#pragma unroll
    for (int i = 0; i < 16; ++i) ss += xv[i] * xv[i];
    ss = wave_sum(ss);
    const float r = rsqrtf(ss * (1.0f / 1024.f) + EPS);
#pragma unroll
    for (int i = 0; i < 4; ++i) {
        int idx = i * 256 + lane * 4;
        bf16 o[4];
#pragma unroll
        for (int j = 0; j < 4; ++j) o[j] = f2bf(xv[i * 4 + j] * r * gpre[idx + j] * (1.0f + mod[1024 + idx + j]) + mod[idx + j]);
        *(uint2*)(dst + idx) = make_uint2((unsigned)o[0] | ((unsigned)o[1] << 16), (unsigned)o[2] | ((unsigned)o[3] << 16));
    }
}
__global__ void __launch_bounds__(256) k_hmod0(P p) {
    const int lane = threadIdx.x & 63, t = blockIdx.x * 4 + (threadIdx.x >> 6);
    if (t >= T) return;
    const float* xr = t < T_CTX ? p.in[I_XP] + (size_t)t * D : p.in[I_XS] + (size_t)(t - T_CTX) * D;
    float xv[16];
#pragma unroll
    for (int i = 0; i < 4; ++i) { float4 v = *(const float4*)(xr + i * 256 + lane * 4); xv[i * 4] = v.x; xv[i * 4 + 1] = v.y; xv[i * 4 + 2] = v.z; xv[i * 4 + 3] = v.w; }
    const float* mod = (const float*)(p.ws + WS_MOD) + (size_t)(0 * NCOND + tok_cond(t)) * 3072;
    hmod_row(xv, lane, p.in[I_GPRE], mod, (bf16*)(p.ws + WS_HM) + (size_t)t * D);
}
__global__ void __launch_bounds__(256) k_post(P p, int layer) {
    const int lane = threadIdx.x & 63, t = blockIdx.x * 4 + (threadIdx.x >> 6);
    if (t >= T) return;
    const float* xr = layer == 0 ? (t < T_CTX ? p.in[I_XP] + (size_t)t * D : p.in[I_XS] + (size_t)(t - T_CTX) * D) : p.out + OUT_X + (size_t)t * D;
    const float* mr = (const float*)(p.ws + WS_PROJ) + (size_t)t * D;
    const float* mod = (const float*)(p.ws + WS_MOD) + (size_t)(layer * NCOND + tok_cond(t)) * 3072;
    const float* gpost = p.in[I_GPOST] + layer * D;
    float xv[16], mv[16];
    float ss = 0.f;
#pragma unroll
    for (int i = 0; i < 4; ++i) {
        float4 v = *(const float4*)(xr + i * 256 + lane * 4); xv[i * 4] = v.x; xv[i * 4 + 1] = v.y; xv[i * 4 + 2] = v.z; xv[i * 4 + 3] = v.w;
        float4 m = *(const float4*)(mr + i * 256 + lane * 4); mv[i * 4] = m.x; mv[i * 4 + 1] = m.y; mv[i * 4 + 2] = m.z; mv[i * 4 + 3] = m.w;
    }
#pragma unroll
    for (int i = 0; i < 16; ++i) ss += mv[i] * mv[i];
    ss = wave_sum(ss);
    const float r = rsqrtf(ss * (1.0f / 1024.f) + EPS);
    float* xo = p.out + OUT_X + (size_t)t * D;
#pragma unroll
    for (int i = 0; i < 4; ++i) {
        int idx = i * 256 + lane * 4;
#pragma unroll
        for (int j = 0; j < 4; ++j) xv[i * 4 + j] += mod[2048 + idx + j] * (mv[i * 4 + j] * r * gpost[idx + j]);
        *(float4*)(xo + idx) = make_float4(xv[i * 4], xv[i * 4 + 1], xv[i * 4 + 2], xv[i * 4 + 3]);
    }
    if (layer + 1 < DEPTH) {
        const float* mod2 = (const float*)(p.ws + WS_MOD) + (size_t)((layer + 1) * NCOND + tok_cond(t)) * 3072;
        hmod_row(xv, lane, p.in[I_GPRE] + (layer + 1) * D, mod2, (bf16*)(p.ws + WS_HM) + (size_t)t * D);
    }
}

template <bool OUT_BF16>
__global__ void __launch_bounds__(256) k_gemm(const bf16* __restrict__ A, int lda, const bf16* __restrict__ Bt, int K, void* __restrict__ Cv, int ldc, int N, int ntn) {
    __shared__ __attribute__((aligned(16))) bf16 As[128][40];
    __shared__ __attribute__((aligned(16))) bf16 Bs[128][40];
    const int tid = threadIdx.x, lane = tid & 63, wid = tid >> 6, wr = wid >> 1, wc = wid & 1;
    const int m0 = (blockIdx.x / ntn) * 128, n0 = (blockIdx.x % ntn) * 128;
    const int lr = tid >> 2, lc = (tid & 3) * 8;
    const bf16* Ag = A + (size_t)(m0 + lr) * lda + lc;
    const bf16* Bg = Bt + (size_t)(n0 + lr) * K + lc;
    f4v acc[4][4];
#pragma unroll
    for (int i = 0; i < 4; ++i)
#pragma unroll
        for (int j = 0; j < 4; ++j) acc[i][j] = (f4v){0.f, 0.f, 0.f, 0.f};
    uint4 ra0 = *(const uint4*)Ag, ra1 = *(const uint4*)(Ag + (size_t)64 * lda);
    uint4 rb0 = *(const uint4*)Bg, rb1 = *(const uint4*)(Bg + (size_t)64 * K);
    const int fr = lane & 15, fq = (lane >> 4) * 8;
    for (int k0 = 0; k0 < K; k0 += 32) {
        __syncthreads();
        *(uint4*)&As[lr][lc] = ra0; *(uint4*)&As[lr + 64][lc] = ra1;
        *(uint4*)&Bs[lr][lc] = rb0; *(uint4*)&Bs[lr + 64][lc] = rb1;
        __syncthreads();
        if (k0 + 32 < K) {
            ra0 = *(const uint4*)(Ag + k0 + 32); ra1 = *(const uint4*)(Ag + (size_t)64 * lda + k0 + 32);
            rb0 = *(const uint4*)(Bg + k0 + 32); rb1 = *(const uint4*)(Bg + (size_t)64 * K + k0 + 32);
        }
        s8v af[4], bfr[4];
#pragma unroll
        for (int i = 0; i < 4; ++i) af[i] = *(const s8v*)&As[wr * 64 + i * 16 + fr][fq];
#pragma unroll
        for (int j = 0; j < 4; ++j) bfr[j] = *(const s8v*)&Bs[wc * 64 + j * 16 + fr][fq];
#pragma unroll
        for (int i = 0; i < 4; ++i)
#pragma unroll
            for (int j = 0; j < 4; ++j) acc[i][j] = __builtin_amdgcn_mfma_f32_16x16x32_bf16(af[i], bfr[j], acc[i][j], 0, 0, 0);
    }
#pragma unroll
    for (int i = 0; i < 4; ++i)
#pragma unroll
        for (int j = 0; j < 4; ++j) {
            const int col = n0 + wc * 64 + j * 16 + (lane & 15);
            if (col < N) {
#pragma unroll
                for (int r = 0; r < 4; ++r) {
                    const int row = m0 + wr * 64 + i * 16 + (lane >> 4) * 4 + r;
                    if (OUT_BF16) ((bf16*)Cv)[(size_t)row * ldc + col] = f2bf(acc[i][j][r]);
                    else ((float*)Cv)[(size_t)row * ldc + col] = acc[i][j][r];
                }
            }
        }
}

constexpr int TC = 32;
__device__ void gla_scan_task(const P& p, int ei, int s, int h, int dir, float* smem) {
    float (*sq)[64] = (float(*)[64])smem;
    float (*sk)[64] = (float(*)[64])(smem + TC * 64);
    float (*sa)[64] = (float(*)[64])(smem + 2 * TC * 64);
    float (*sv)[128] = (float(*)[128])(smem + 3 * TC * 64);
    float (*sgd)[16] = (float(*)[16])(smem + 3 * TC * 64 + TC * 128);
    const Seq sq_ = get_seq(s);
    const int tid = threadIdx.x, v = tid >> 1, dh = tid & 1;
    const bf16* proj = (const bf16*)(p.ws + WS_PROJ);
    bf16* opart = (bf16*)(p.ws + WS_PART + (size_t)dir * PART_SZ);
    const float* gup = p.in[I_GUP] + (size_t)(ei * 2 + dir) * 16 * 256 + h * 64;
    const float* gbias = p.in[I_GBIAS] + (size_t)(ei * 2 + dir) * 256 + h * 64;
    float S[32];
    if (sq_.lat) {
        const float* s0 = p.in[I_SGLA] + ((((size_t)sq_.b * N_EVEN + ei) * 2 + dir) * 4 + h) * 64 * 128;
#pragma unroll
        for (int d = 0; d < 32; ++d) S[d] = s0[(dh * 32 + d) * 128 + v];
    } else {
#pragma unroll
        for (int d = 0; d < 32; ++d) S[d] = 0.f;
    }
    for (int c0 = 0; c0 < sq_.len; c0 += TC) {
        __syncthreads();
        for (int e = tid; e < TC * 64; e += 256) {
            int i = e >> 6, d = e & 63, pos = c0 + i, t = sq_.start + (dir ? sq_.len - 1 - pos : pos);
            const bf16* pr = proj + (size_t)t * EW;
            sq[i][d] = bf2f(pr[E_Q + h * 64 + d]) * 0.125f;
            sk[i][d] = bf2f(pr[E_K + h * 64 + d]);
        }
        for (int e = tid; e < TC * 128; e += 256) {
            int i = e >> 7, d = e & 127, pos = c0 + i, t = sq_.start + (dir ? sq_.len - 1 - pos : pos);
            sv[i][d] = bf2f(proj[(size_t)t * EW + E_V + h * 128 + d]);
        }
        for (int e = tid; e < TC * 16; e += 256) {
            int i = e >> 4, r = e & 15, pos = c0 + i, t = sq_.start + (dir ? sq_.len - 1 - pos : pos);
            sgd[i][r] = bf2f(proj[(size_t)t * EW + E_GD + dir * 16 + r]);
        }
        __syncthreads();
        for (int e = tid; e < TC * 64; e += 256) {
            int i = e >> 6, d = e & 63;
            float x = gbias[d];
#pragma unroll
            for (int r = 0; r < 16; ++r) x += sgd[i][r] * gup[r * 256 + d];
            sa[i][d] = expf(logsigf_(x) * (1.0f / 16.0f));
        }
        __syncthreads();
        for (int i = 0; i < TC; ++i) {
            const float vv = sv[i][v];
            float o = 0.f;
#pragma unroll
            for (int d = 0; d < 32; ++d) {
                S[d] = sa[i][dh * 32 + d] * S[d] + sk[i][dh * 32 + d] * vv;
                o += sq[i][dh * 32 + d] * S[d];
            }
            o += __shfl_xor(o, 1);
            if (dh == 0) { int pos = c0 + i, t = sq_.start + (dir ? sq_.len - 1 - pos : pos); opart[(size_t)t * 512 + h * 128 + v] = f2bf(o); }
        }
    }
    if (!sq_.lat) {
        float* fs = p.out + OUT_GLA + ((((size_t)sq_.b * N_EVEN + ei) * 2 + dir) * 4 + h) * 64 * 128;
#pragma unroll
        for (int d = 0; d < 32; ++d) fs[(dh * 32 + d) * 128 + v] = S[d];
    }
}

__device__ void rwkv_scan_task(const P& p, int ei, int s, int h, int dir, float* smem) {
    float (*sW)[64] = (float(*)[64])smem;
    float (*sKK)[64] = (float(*)[64])(smem + 1 * TC * 64);
    float (*sKA)[64] = (float(*)[64])(smem + 2 * TC * 64);
    float (*sKM)[64] = (float(*)[64])(smem + 3 * TC * 64);
    float (*sR)[64] = (float(*)[64])(smem + 4 * TC * 64);
    float (*sV)[64] = (float(*)[64])(smem + 5 * TC * 64);
    float (*sTW)[64] = (float(*)[64])(smem + 6 * TC * 64);
    float (*sAD)[64] = (float(*)[64])(smem + 7 * TC * 64);
    const Seq sq_ = get_seq(s);
    const int tid = threadIdx.x, row = tid >> 2, kq = tid & 3;
    const bf16* proj = (const bf16*)(p.ws + WS_PROJ);
    bf16* opart = (bf16*)(p.ws + WS_PART + (size_t)(2 + dir) * PART_SZ);
    float* bonus = (float*)(p.ws + WS_BONUS);
    const float* mix = p.in[I_MIX] + (size_t)ei * 1792;
    const int hc0 = h * 64;
    const float* w0 = p.in[I_W0] + (size_t)(ei * 2 + dir) * 512 + hc0;
    const float* w2 = p.in[I_W2] + (size_t)(ei * 2 + dir) * 64 * 512 + hc0;
    const float* a0 = p.in[I_A0] + (size_t)(ei * 2 + dir) * 512 + hc0;
    const float* a2 = p.in[I_A2] + (size_t)(ei * 2 + dir) * 64 * 512 + hc0;
    const float* kkw = p.in[I_KK] + (size_t)ei * 512 + hc0;
    const float* kaw = p.in[I_KA] + (size_t)ei * 512 + hc0;
    const float* rkw = p.in[I_RK] + (size_t)ei * 512 + hc0;
    float S[16];
    if (sq_.lat) {
        const float* s0 = p.in[I_SRWKV] + ((((size_t)sq_.b * N_EVEN + ei) * 2 + dir) * 8 + h) * 64 * 64;
#pragma unroll
        for (int k = 0; k < 16; ++k) S[k] = s0[row * 64 + kq * 16 + k];
    } else {
#pragma unroll
        for (int k = 0; k < 16; ++k) S[k] = 0.f;
    }
    for (int c0 = 0; c0 < sq_.len; c0 += TC) {
        __syncthreads();
        for (int e = tid; e < TC * 64 * 5; e += 256) {
            int which = e / (TC * 64), rem = e % (TC * 64), i = rem >> 6, c = rem & 63;
            int pos = c0 + i, t = sq_.start + (dir ? sq_.len - 1 - pos : pos);
            int col = which == 0 ? FB_R + hc0 + c : which == 1 ? FB_K + hc0 + c : which == 2 ? FB_V + hc0 + c : which == 3 ? FB_WD + dir * 64 + c : FB_AD + dir * 64 + c;
            bool hl, hr; tok_nbr(t, hl, hr);
            const bf16* pr = proj + (size_t)t * EW + E_FB + col;
            float x = bf2f(pr[0]);
            float nl = hl ? bf2f(pr[-EW]) : 0.f, nr = hr ? bf2f(pr[EW]) : 0.f;
            float y = x + mix[col] * (0.5f * (nl + nr) - x);
            if (which == 0) sR[i][c] = y; else if (which == 1) sKM[i][c] = y; else if (which == 2) sV[i][c] = y; else if (which == 3) sTW[i][c] = tanhf(y); else sAD[i][c] = y;
        }
        __syncthreads();
        {
            const int c = tid & 63, ig = tid >> 6;
            float aw[TC / 4], aa[TC / 4];
#pragma unroll
            for (int j = 0; j < TC / 4; ++j) { aw[j] = w0[c]; aa[j] = a0[c]; }
            for (int r = 0; r < 64; ++r) {
                const float w2v = w2[(size_t)r * 512 + c], a2v = a2[(size_t)r * 512 + c];
#pragma unroll
                for (int j = 0; j < TC / 4; ++j) { aw[j] += sTW[ig * (TC / 4) + j][r] * w2v; aa[j] += sAD[ig * (TC / 4) + j][r] * a2v; }
            }
            const float kkc = kkw[c], kac = kaw[c], rkc = rkw[c];
#pragma unroll
            for (int j = 0; j < TC / 4; ++j) {
                const int i = ig * (TC / 4) + j;
                const float dec = expf(-0.6065306597126334f * sigmoidf_(aw[j]));
                const float av = sigmoidf_(aa[j]);
                const float kraw = sKM[i][c];
                const float km = kraw * (1.0f + (av - 1.0f) * kac);
                float kkv = kraw * kkc;
                const float nrm = rsqrtf(wave_sum(kkv * kkv) + EPS);
                kkv *= nrm;
                const float bn = wave_sum(sR[i][c] * km * rkc);
                sW[i][c] = dec; sKM[i][c] = km; sKK[i][c] = kkv; sKA[i][c] = kkv * av;
                if (c == 0) { int pos = c0 + i, t = sq_.start + (dir ? sq_.len - 1 - pos : pos); bonus[((size_t)t * 8 + h) * 2 + dir] = bn; }
            }
        }
        __syncthreads();
        for (int i = 0; i < TC; ++i) {
            float sa = 0.f;
#pragma unroll
            for (int k = 0; k < 16; ++k) sa -= S[k] * sKK[i][kq * 16 + k];
            sa += __shfl_xor(sa, 1); sa += __shfl_xor(sa, 2);
            const float vv = sV[i][row];
            float y = 0.f;
#pragma unroll
            for (int k = 0; k < 16; ++k) {
                S[k] = S[k] * sW[i][kq * 16 + k] + sa * sKA[i][kq * 16 + k] + vv * sKM[i][kq * 16 + k];
                y += S[k] * sR[i][kq * 16 + k];
            }
            y += __shfl_xor(y, 1); y += __shfl_xor(y, 2);
            if (kq == 0) { int pos = c0 + i, t = sq_.start + (dir ? sq_.len - 1 - pos : pos); opart[(size_t)t * 512 + hc0 + row] = f2bf(y); }
        }
    }
    if (!sq_.lat) {
        float* fs = p.out + OUT_RWKV + ((((size_t)sq_.b * N_EVEN + ei) * 2 + dir) * 8 + h) * 64 * 64;
#pragma unroll
        for (int k = 0; k < 16; ++k) fs[row * 64 + kq * 16 + k] = S[k];
    }
}
constexpr int EVEN_SCAN_BLOCKS = NSEQ * 8 * 2 + NSEQ * 4 * 2;
__global__ void __launch_bounds__(256) k_even_scan(P p, int ei) {
    __shared__ __attribute__((aligned(16))) float smem[16384];
    int b = blockIdx.x;
    const int nlr = NB_LAT * 16, nlg = NB_LAT * 8, ncr = NB_CTX * 16;
    if (b < nlr) { rwkv_scan_task(p, ei, NB_CTX + b / 16, (b % 16) >> 1, b & 1, smem); return; }
    b -= nlr;
    if (b < nlg) { gla_scan_task(p, ei, NB_CTX + b / 8, (b % 8) >> 1, b & 1, smem); return; }
    b -= nlg;
    if (b < ncr) { rwkv_scan_task(p, ei, b / 16, (b % 16) >> 1, b & 1, smem); return; }
    b -= ncr;
    gla_scan_task(p, ei, b / 8, (b % 8) >> 1, b & 1, smem);
}

__global__ void __launch_bounds__(256) k_fin_even(P p, int ei) {
    const int lane = threadIdx.x & 63, t = blockIdx.x * 4 + (threadIdx.x >> 6);
    if (t >= T) return;
    const bf16* pr = (const bf16*)(p.ws + WS_PROJ) + (size_t)t * EW;
    const bf16* oaf = (const bf16*)(p.ws + WS_PART) + (size_t)t * 512;
    const bf16* oab = (const bf16*)(p.ws + WS_PART + PART_SZ) + (size_t)t * 512;
    const bf16* obf = (const bf16*)(p.ws + WS_PART + 2 * PART_SZ) + (size_t)t * 512;
    const bf16* obb = (const bf16*)(p.ws + WS_PART + 3 * PART_SZ) + (size_t)t * 512;
    bf16* yc = (bf16*)(p.ws + WS_HM) + (size_t)t * D;
    const int idx = lane * 8;
    {
        float o[8], ss = 0.f;
#pragma unroll
        for (int j = 0; j < 8; ++j) { o[j] = bf2f(oaf[idx + j]) + bf2f(oab[idx + j]); ss += o[j] * o[j]; }
        ss += __shfl_xor(ss, 1); ss += __shfl_xor(ss, 2); ss += __shfl_xor(ss, 4); ss += __shfl_xor(ss, 8);
        const float r = rsqrtf(ss * (1.0f / 128.f) + EPS);
        const float* gn = p.in[I_GLAN] + ei * 128 + (idx & 127);
#pragma unroll
        for (int j = 0; j < 8; ++j) yc[idx + j] = f2bf(o[j] * r * gn[j] * siluf_(bf2f(pr[E_ZA + idx + j])));
    }
    {
        float o[8], mu = 0.f;
#pragma unroll
        for (int j = 0; j < 8; ++j) { o[j] = bf2f(obf[idx + j]) + bf2f(obb[idx + j]); mu += o[j]; }
        mu += __shfl_xor(mu, 1); mu += __shfl_xor(mu, 2); mu += __shfl_xor(mu, 4);
        mu *= (1.0f / 64.f);
        float var = 0.f;
#pragma unroll
        for (int j = 0; j < 8; ++j) { o[j] -= mu; var += o[j] * o[j]; }
        var += __shfl_xor(var, 1); var += __shfl_xor(var, 2); var += __shfl_xor(var, 4);
        const float r = rsqrtf(var * (1.0f / 64.f) + 64e-5f);
        const int h = idx >> 6;
        const float* bn = (const float*)(p.ws + WS_BONUS) + ((size_t)t * 8 + h) * 2;
        const float bsum = bn[0] + bn[1];
        bool hl, hr; tok_nbr(t, hl, hr);
        const float* mix = p.in[I_MIX] + (size_t)ei * 1792 + FB_V + idx;
        const float* lg = p.in[I_LNG] + ei * 512 + idx;
        const float* lb = p.in[I_LNB] + ei * 512 + idx;
#pragma unroll
        for (int j = 0; j < 8; ++j) {
            const bf16* pv = pr + E_FB + FB_V + idx + j;
            const float x = bf2f(pv[0]);
            const float nl = hl ? bf2f(pv[-EW]) : 0.f, nr = hr ? bf2f(pv[EW]) : 0.f;
            const float vsh = x + mix[j] * (0.5f * (nl + nr) - x);
            yc[512 + idx + j] = f2bf((o[j] * r * lg[j] + lb[j] + bsum * vsh) * siluf_(bf2f(pr[E_ZB + idx + j])));
        }
    }
}

__global__ void __launch_bounds__(256) k_odd_prep(P p, int oi) {
    const int lane = threadIdx.x & 63, t = blockIdx.x * 4 + (threadIdx.x >> 6);
    if (t >= T) return;
    const bf16* proj = (const bf16*)(p.ws + WS_PROJ);
    const float* cw = p.in[I_CONV] + (size_t)oi * 9 * 1536;
    bf16* qo = (bf16*)(p.ws + WS_QKVN) + (size_t)t * 1536;
    const bool lat = t >= T_CTX;
    int pos, len;
    if (!lat) { pos = t % L_CTX; len = L_CTX; } else { pos = (t - T_CTX) % L_LAT; len = L_LAT; }
    const int gr = pos >> 6, gc = pos & 63, nrows = len >> 6;
#pragma unroll
    for (int part = 0; part < 3; ++part) {
        const int ch = part * 512 + lane * 8;
        float acc[8];
#pragma unroll
        for (int j = 0; j < 8; ++j) acc[j] = 0.f;
        for (int di = (lat ? -1 : 0); di <= (lat ? 1 : 0); ++di)
            for (int dj = -1; dj <= 1; ++dj) {
                bool ok;
                if (lat) ok = (gr + di >= 0) && (gr + di < nrows) && (gc + dj >= 0) && (gc + dj < 64);
                else ok = (pos + dj >= 0) && (pos + dj < len);
                if (!ok) continue;
                const bf16* src = proj + (size_t)(t + di * 64 + dj) * OW + O_QKV + ch;
                const float* w = cw + ((di + 1) * 3 + (dj + 1)) * 1536 + ch;
#pragma unroll
                for (int j = 0; j < 8; ++j) acc[j] += bf2f(src[j]) * w[j];
            }
        float ss = 0.f;
#pragma unroll
        for (int j = 0; j < 8; ++j) { acc[j] = siluf_(acc[j]); ss += acc[j] * acc[j]; }
        if (part < 2) {
            ss += __shfl_xor(ss, 1); ss += __shfl_xor(ss, 2); ss += __shfl_xor(ss, 4); ss += __shfl_xor(ss, 8);
            float r = rsqrtf(ss + EPS);
            if (part == 0) r *= 0.08838834764831845f;
#pragma unroll
            for (int j = 0; j < 8; ++j) acc[j] *= r;
        }
#pragma unroll
        for (int j = 0; j < 8; ++j) qo[ch + j] = f2bf(acc[j]);
    }
    if (lane < 16) {
        float* g = (float*)(p.ws + WS_GATES) + (size_t)t * 16;
        const float x = bf2f(proj[(size_t)t * OW + O_G + lane]);
        if (lane < 8) {
            const float lgv = -expf(p.in[I_ALOG][oi * 8 + lane]) * softplusf_(x + p.in[I_DTB][oi * 8 + lane]);
            g[lane] = expf(lgv);
        } else g[lane] = sigmoidf_(x);
    }
}
__device__ void gdn_scan_task(const P& p, int oi, int s, int h, int dir, float* smem) {
    float (*sq)[128] = (float(*)[128])smem;
    float (*sk)[128] = (float(*)[128])(smem + TC * 128);
    float (*sv)[128] = (float(*)[128])(smem + 2 * TC * 128);
    float* sg = smem + 3 * TC * 128;
    float* sb = sg + TC;
    const Seq sq_ = get_seq(s);
    const int tid = threadIdx.x, v = tid >> 1, dh = tid & 1;
    const bf16* qkvn = (const bf16*)(p.ws + WS_QKVN);
    const float* gates = (const float*)(p.ws + WS_GATES);
    bf16* opart = (bf16*)(p.ws + WS_PART + (size_t)dir * PART_SZ);
    float S[64];
    if (sq_.lat) {
        const float* s0 = p.in[I_SGDN] + ((((size_t)sq_.b * N_ODD + oi) * 2 + dir) * 4 + h) * 128 * 128;
#pragma unroll
        for (int d = 0; d < 64; ++d) S[d] = s0[(dh * 64 + d) * 128 + v];
    } else {
#pragma unroll
        for (int d = 0; d < 64; ++d) S[d] = 0.f;
    }
    for (int c0 = 0; c0 < sq_.len; c0 += TC) {
        __syncthreads();
        for (int e = tid; e < TC * 128; e += 256) {
            int i = e >> 7, d = e & 127, pos = c0 + i, t = sq_.start + (dir ? sq_.len - 1 - pos : pos);
            const bf16* src = qkvn + (size_t)t * 1536 + h * 128 + d;
            sq[i][d] = bf2f(src[0]); sk[i][d] = bf2f(src[512]); sv[i][d] = bf2f(src[1024]);
        }
        if (tid < TC) {
            int pos = c0 + tid, t = sq_.start + (dir ? sq_.len - 1 - pos : pos);
            sg[tid] = gates[(size_t)t * 16 + dir * 4 + h]; sb[tid] = gates[(size_t)t * 16 + 8 + dir * 4 + h];
        }
        __syncthreads();
        for (int i = 0; i < TC; ++i) {
            float ks = 0.f;
#pragma unroll
            for (int d = 0; d < 64; ++d) ks += sk[i][dh * 64 + d] * S[d];
            ks += __shfl_xor(ks, 1);
            const float g = sg[i];
            const float cc = sb[i] * (sv[i][v] - g * ks);
            float o = 0.f;
#pragma unroll
            for (int d = 0; d < 64; ++d) {
                S[d] = g * S[d] + sk[i][dh * 64 + d] * cc;
                o += sq[i][dh * 64 + d] * S[d];
            }
            o += __shfl_xor(o, 1);
            if (dh == 0) { int pos = c0 + i, t = sq_.start + (dir ? sq_.len - 1 - pos : pos); opart[(size_t)t * 512 + h * 128 + v] = f2bf(o); }
        }
    }
    if (!sq_.lat) {
        float* fs = p.out + OUT_GDN + ((((size_t)sq_.b * N_ODD + oi) * 2 + dir) * 4 + h) * 128 * 128;
#pragma unroll
        for (int d = 0; d < 64; ++d) fs[(dh * 64 + d) * 128 + v] = S[d];
    }
}
constexpr int TS = 8;
__device__ void s5_scan_task(const P& p, int oi, int s, int dir, int g4, float* smem) {
    const int tid = threadIdx.x, w = tid >> 6, lane = tid & 63, g = g4 * 4 + w;
    float* base = smem + w * (2 * TS * 64 + TS * 16 + 2 * 16 * 64);
    float (*hre)[64] = (float(*)[64])base;
    float (*him)[64] = (float(*)[64])(base + TS * 64);
    float (*su)[16] = (float(*)[16])(base + 2 * TS * 64);
    float (*cre)[64] = (float(*)[64])(base + 2 * TS * 64 + TS * 16);
    float (*cim)[64] = (float(*)[64])(base + 2 * TS * 64 + TS * 16 + 16 * 64);
    const Seq sq_ = get_seq(s);
    const bf16* proj = (const bf16*)(p.ws + WS_PROJ);
    bf16* ypart = (bf16*)(p.ws + WS_PART + (size_t)(2 + dir) * PART_SZ);
    const size_t pg = ((size_t)(oi * 2 + dir) * 32 + g);
    float are = fminf(p.in[I_S5AR][pg * 64 + lane], -1e-4f), aim = p.in[I_S5AI][pg * 64 + lane];
    const float dt = expf(p.in[I_S5DT][pg]);
    const float mag = expf(are * dt);
    const float abr = mag * cosf(aim * dt), abi = mag * sinf(aim * dt);
    const float den = are * are + aim * aim;
    const float fre = ((abr - 1.0f) * are + abi * aim) / den, fim = (abi * are - (abr - 1.0f) * aim) / den;
    float bbr[16], bbi[16];
#pragma unroll
    for (int c = 0; c < 16; ++c) {
        const float br = p.in[I_S5BR][(pg * 64 + lane) * 16 + c], bi = p.in[I_S5BI][(pg * 64 + lane) * 16 + c];
        bbr[c] = fre * br - fim * bi; bbi[c] = fre * bi + fim * br;
    }
    for (int e = lane; e < 16 * 64; e += 64) { cre[e >> 6][e & 63] = p.in[I_S5CR][pg * 1024 + e]; cim[e >> 6][e & 63] = p.in[I_S5CI][pg * 1024 + e]; }
    float hr = 0.f, hi = 0.f;
    if (sq_.lat) { const size_t o = (((size_t)sq_.b * N_ODD + oi) * 2 + dir) * 32 * 64 + g * 64 + lane; hr = p.in[I_SS5R][o]; hi = p.in[I_SS5I][o]; }
    for (int c0 = 0; c0 < sq_.len; c0 += TS) {
        __syncthreads();
        for (int e = lane; e < TS * 16; e += 64) {
            int i = e >> 4, c = e & 15, pos = c0 + i, t = sq_.start + (dir ? sq_.len - 1 - pos : pos);
            su[i][c] = bf2f(proj[(size_t)t * OW + O_U + g * 16 + c]);
        }
        __syncthreads();
        for (int i = 0; i < TS; ++i) {
            float br = 0.f, bi = 0.f;
#pragma unroll
            for (int c = 0; c < 16; ++c) { br += bbr[c] * su[i][c]; bi += bbi[c] * su[i][c]; }
            const float nr = abr * hr - abi * hi + br, ni = abr * hi + abi * hr + bi;
            hr = nr; hi = ni;
            hre[i][lane] = hr; him[i][lane] = hi;
        }
        __syncthreads();
        {
            const int c = lane & 15;
#pragma unroll
            for (int j = 0; j < TS / 4; ++j) {
                const int i = (lane >> 4) + 4 * j;
                float y = 0.f;
                for (int q = 0; q < 64; ++q) y += cre[c][q] * hre[i][q] - cim[c][q] * him[i][q];
                int pos = c0 + i, t = sq_.start + (dir ? sq_.len - 1 - pos : pos);
                ypart[(size_t)t * 512 + g * 16 + c] = f2bf(y);
            }
        }
    }
    if (!sq_.lat) {
        const size_t o = (((size_t)sq_.b * N_ODD + oi) * 2 + dir) * 32 * 64 + g * 64 + lane;
        p.out[OUT_S5R + o] = hr; p.out[OUT_S5I + o] = hi;
    }
}
constexpr int ODD_SCAN_BLOCKS = NSEQ * 4 * 2 + NSEQ * 2 * 8;
__global__ void __launch_bounds__(256) k_odd_scan(P p, int oi) {
    __shared__ __attribute__((aligned(16))) float smem[16384];
    int b = blockIdx.x;
    const int nlg = NB_LAT * 8, nls = NB_LAT * 16, ncg = NB_CTX * 8;
    if (b < nlg) { gdn_scan_task(p, oi, NB_CTX + b / 8, (b % 8) >> 1, b & 1, smem); return; }
    b -= nlg;
    if (b < nls) { s5_scan_task(p, oi, NB_CTX + b / 16, (b % 16) >> 3, b & 7, smem); return; }
    b -= nls;
    if (b < ncg) { gdn_scan_task(p, oi, b / 8, (b % 8) >> 1, b & 1, smem); return; }
    b -= ncg;
    s5_scan_task(p, oi, b / 16, (b % 16) >> 3, b & 7, smem);
}
__global__ void __launch_bounds__(256) k_fin_odd_a(P p, int oi) {
    const int lane = threadIdx.x & 63, t = blockIdx.x * 4 + (threadIdx.x >> 6);
    if (t >= T) return;
    const bf16* pr = (const bf16*)(p.ws + WS_PROJ) + (size_t)t * OW;
    const bf16* of = (const bf16*)(p.ws + WS_PART) + (size_t)t * 512;
    const bf16* ob = (const bf16*)(p.ws + WS_PART + PART_SZ) + (size_t)t * 512;
    const bf16* yf = (const bf16*)(p.ws + WS_PART + 2 * PART_SZ) + (size_t)t * 512;
    const bf16* yb = (const bf16*)(p.ws + WS_PART + 3 * PART_SZ) + (size_t)t * 512;
    bf16* yc = (bf16*)(p.ws + WS_HM) + (size_t)t * D;
    const int idx = lane * 8;
    float o[8], ss = 0.f;
#pragma unroll
    for (int j = 0; j < 8; ++j) { o[j] = bf2f(of[idx + j]) + bf2f(ob[idx + j]); ss += o[j] * o[j]; }
    ss += __shfl_xor(ss, 1); ss += __shfl_xor(ss, 2); ss += __shfl_xor(ss, 4); ss += __shfl_xor(ss, 8);
    const float r = rsqrtf(ss * (1.0f / 128.f) + EPS);
    const float* gn = p.in[I_GDNN] + oi * 128 + (idx & 127);
    const float* dsk = p.in[I_S5D] + oi * 512 + idx;
#pragma unroll
    for (int j = 0; j < 8; ++j) {
        yc[idx + j] = f2bf(o[j] * r * gn[j] * siluf_(bf2f(pr[O_ZC + idx + j])));
        const float y = bf2f(yf[idx + j]) + bf2f(yb[idx + j]) + dsk[j] * bf2f(pr[O_U + idx + j]);
        yc[512 + idx + j] = f2bf(gelu_tanh(y));
    }
}
__global__ void __launch_bounds__(256) k_fin_odd_b(P p, int oi) {
    const size_t e = ((size_t)blockIdx.x * 256 + threadIdx.x) * 4;
    if (e >= (size_t)T * 512) return;
    const int t = (int)(e >> 9), idx = (int)(e & 511);
    const bf16* pr = (const bf16*)(p.ws + WS_PROJ) + (size_t)t * OW;
    const bf16* gl = (const bf16*)(p.ws + WS_PART + 2 * PART_SZ) + (size_t)t * 512;
    bf16* yc = (bf16*)(p.ws + WS_HM) + (size_t)t * D + 512;
#pragma unroll
    for (int j = 0; j < 4; ++j) {
        const float ys = bf2f(yc[idx + j]);
        yc[idx + j] = f2bf(ys * sigmoidf_(bf2f(gl[idx + j]) + p.in[I_GLUB][oi * 512 + idx + j]) * siluf_(bf2f(pr[O_ZD + idx + j])));
    }
}

#ifdef CPU_EMU
#define LAUNCH(kern, grid, block, ...) EMU_LAUNCH(kern, grid, block, __VA_ARGS__)
void emu_hook(const char* stage, int layer, const P& p);
#define HOOK(n, l) emu_hook(n, l, p)
#else
#define HOOK(n, l)
#define LAUNCH(kern, grid, block, ...) hipLaunchKernelGGL(kern, dim3(grid), dim3(block), 0, stream, __VA_ARGS__)
#endif

extern "C" void kernel_launch(void* const* d_in, const int* in_sizes, int n_in, void* d_out, int out_size, void* d_ws, size_t ws_size, hipStream_t stream) {
    P p{};
    for (int i = 0; i < 44; ++i) p.in[i] = (const float*)d_in[i];
    p.out = (float*)d_out; p.ws = (char*)d_ws;
    const int tokb = (T + 3) / 4;
    LAUNCH(k_mod, DEPTH * 48, 256, p);
    LAUNCH(k_wt, WT_TILES, 256, p);
    LAUNCH(k_hmod0, tokb, 256, p);
    HOOK("hmod", 0);
    for (int layer = 0; layer < DEPTH; ++layer) {
        const int i = layer >> 1;
        const bf16* hm = (const bf16*)(p.ws + WS_HM);
        if ((layer & 1) == 0) {
            const bf16* wt = (const bf16*)(p.ws + WS_WTE) + (size_t)i * EWP * D;
            LAUNCH(k_gemm<true>, (T / 128) * (EWP / 128), 256, hm, D, wt, D, (void*)(p.ws + WS_PROJ), EW, EW, EWP / 128);
            HOOK("proj", layer);
            LAUNCH(k_even_scan, EVEN_SCAN_BLOCKS, 256, p, i);
            HOOK("even_scan", layer);
            LAUNCH(k_fin_even, tokb, 256, p, i);
            HOOK("ycat", layer);
        } else {
            const bf16* wt = (const bf16*)(p.ws + WS_WTO) + (size_t)i * OWP * D;
            LAUNCH(k_gemm<true>, (T / 128) * (OWP / 128), 256, hm, D, wt, D, (void*)(p.ws + WS_PROJ), OW, OW, OWP / 128);
            HOOK("proj", layer);
            LAUNCH(k_odd_prep, tokb, 256, p, i);
            HOOK("odd_prep", layer);
            LAUNCH(k_odd_scan, ODD_SCAN_BLOCKS, 256, p, i);
            HOOK("odd_scan", layer);
            LAUNCH(k_fin_odd_a, tokb, 256, p, i);
            const bf16* wg = (const bf16*)(p.ws + WS_WTGLU) + (size_t)i * 512 * 512;
            LAUNCH(k_gemm<true>, (T / 128) * 4, 256, hm + 512, D, wg, 512, (void*)(p.ws + WS_PART + 2 * PART_SZ), 512, 512, 4);
            LAUNCH(k_fin_odd_b, (T * 512 / 4 + 255) / 256, 256, p, i);
            HOOK("ycat", layer);
        }
        const bf16* wo = (const bf16*)(p.ws + WS_WTOUT) + (size_t)layer * D * D;
        LAUNCH(k_gemm<false>, (T / 128) * 8, 256, hm, D, wo, D, (void*)(p.ws + WS_PROJ), D, D, 8);
        LAUNCH(k_post, tokb, 256, p, layer);
        HOOK("post", layer);
    }
}
```

```cpp
#ifndef CPU_EMU
#include <hip/hip_runtime.h>
#include <hip/hip_cooperative_groups.h>
#include <cstdio>
namespace cg = cooperative_groups;
#endif
#include <stdint.h>

#ifndef CFG_BATCH
#define CFG_BATCH 16
#define CFG_SEQ 256
#define CFG_DEC_BATCH 8
#define CFG_DEC_SEQ 1024
#define CFG_DEPTH 4
#endif

typedef unsigned short bf16;
typedef short s8v __attribute__((ext_vector_type(8)));
typedef float f4v __attribute__((ext_vector_type(4)));

constexpr int D = 1024;
constexpr int NB_CTX = CFG_BATCH, L_CTX = CFG_SEQ, NB_LAT = CFG_DEC_BATCH, L_LAT = CFG_DEC_SEQ, DEPTH = CFG_DEPTH;
constexpr int N_EVEN = (DEPTH + 1) / 2, N_ODD = DEPTH / 2;
constexpr int T_CTX = NB_CTX * L_CTX, T_LAT = NB_LAT * L_LAT, T = T_CTX + T_LAT;
constexpr int NSEQ = NB_CTX + NB_LAT, NCOND = 1 + NB_LAT;
constexpr int EW = 3872, OW = 3088, EWP = 3968, OWP = 3200;
constexpr float EPS = 1e-6f;
constexpr int E_Q = 0, E_K = 256, E_V = 512, E_GD = 1024, E_ZA = 1056, E_FB = 1568, E_ZB = 3360;
constexpr int FB_R = 0, FB_K = 512, FB_V = 1024, FB_WD = 1536, FB_AD = 1664;
constexpr int O_QKV = 0, O_G = 1536, O_BETA = 1544, O_ZC = 1552, O_U = 2064, O_ZD = 2576;

constexpr size_t al(size_t x) { return (x + 255) & ~(size_t)255; }
constexpr size_t WS_MOD = 0;
constexpr size_t WS_WTE = WS_MOD + al((size_t)DEPTH * NCOND * 3072 * 4);
constexpr size_t WS_WTO = WS_WTE + al((size_t)N_EVEN * EWP * D * 2);
constexpr size_t WS_WTOUT = WS_WTO + al((size_t)(N_ODD ? N_ODD : 1) * OWP * D * 2);
constexpr size_t WS_WTGLU = WS_WTOUT + al((size_t)DEPTH * D * D * 2);
constexpr size_t WS_HM = WS_WTGLU + al((size_t)(N_ODD ? N_ODD : 1) * 512 * 512 * 2);
constexpr size_t WS_PROJ = WS_HM + al((size_t)T * D * 2);
constexpr size_t WS_PART = WS_PROJ + al((size_t)T * EW * 2);
constexpr size_t PART_SZ = al((size_t)T * 512 * 2);
constexpr size_t WS_BONUS = WS_PART + 4 * PART_SZ;
constexpr size_t WS_QKVN = WS_BONUS + al((size_t)T * 16 * 4);
constexpr size_t WS_GATES = WS_QKVN + al((size_t)T * 1536 * 2);
constexpr size_t WS_END = WS_GATES + al((size_t)T * 16 * 4);

constexpr size_t OUT_X = 0;
constexpr size_t OUT_GLA = (size_t)T * D;
constexpr size_t OUT_RWKV = OUT_GLA + (size_t)NB_CTX * N_EVEN * 2 * 4 * 64 * 128;
constexpr size_t OUT_GDN = OUT_RWKV + (size_t)NB_CTX * N_EVEN * 2 * 8 * 64 * 64;
constexpr size_t OUT_S5R = OUT_GDN + (size_t)NB_CTX * N_ODD * 2 * 4 * 128 * 128;
constexpr size_t OUT_S5I = OUT_S5R + (size_t)NB_CTX * N_ODD * 2 * 32 * 64;

struct P {
    const float* in[44];
    float* out;
    char* ws;
};
enum { I_XP = 0, I_XS, I_C, I_SGLA, I_SRWKV, I_SGDN, I_SS5R, I_SS5I, I_CCTX, I_WMOD, I_BMOD, I_GPRE, I_GPOST,
       I_WINE, I_WOUTE, I_GUP, I_GBIAS, I_GLAN, I_MIX, I_W0, I_W2, I_A0, I_A2, I_KK, I_KA, I_RK, I_LNG, I_LNB,
       I_WINO, I_WOUTO, I_CONV, I_ALOG, I_DTB, I_GDNN, I_S5AR, I_S5AI, I_S5DT, I_S5BR, I_S5BI, I_S5CR, I_S5CI,
       I_S5D, I_GLUW, I_GLUB };

__device__ __forceinline__ float u2f(unsigned u) { return __builtin_bit_cast(float, u); }
__device__ __forceinline__ unsigned f2u(float f) { return __builtin_bit_cast(unsigned, f); }
__device__ __forceinline__ float bf2f(bf16 h) { return u2f((unsigned)h << 16); }
__device__ __forceinline__ bf16 f2bf(float f) { unsigned u = f2u(f); u += 0x7fffu + ((u >> 16) & 1u); return (bf16)(u >> 16); }
__device__ __forceinline__ float sigmoidf_(float x) { return 1.0f / (1.0f + expf(-x)); }
__device__ __forceinline__ float siluf_(float x) { return x / (1.0f + expf(-x)); }
__device__ __forceinline__ float logsigf_(float x) { return fminf(x, 0.f) - log1pf(expf(-fabsf(x))); }
__device__ __forceinline__ float softplusf_(float x) { return fmaxf(x, 0.f) + log1pf(expf(-fabsf(x))); }
__device__ __forceinline__ float gelu_tanh(float x) { return 0.5f * x * (1.0f + tanhf(0.7978845608028654f * (x + 0.044715f * x * x * x))); }

struct Seq { int start, len, cond, lat, b; };
__device__ __forceinline__ Seq get_seq(int s) {
    Seq q;
    if (s < NB_CTX) { q.start = s * L_CTX; q.len = L_CTX; q.cond = 0; q.lat = 0; q.b = s; }
    else { int b = s - NB_CTX; q.start = T_CTX + b * L_LAT; q.len = L_LAT; q.cond = 1 + b; q.lat = 1; q.b = b; }
    return q;
}
__device__ __forceinline__ int tok_cond(int t) { return t < T_CTX ? 0 : 1 + (t - T_CTX) / L_LAT; }
__device__ __forceinline__ void tok_nbr(int t, bool& hl, bool& hr) {
    if (t < T_CTX) { int pos = t % L_CTX; hl = pos != 0; hr = pos != L_CTX - 1; }
    else { int pos = (t - T_CTX) & 63; hl = pos != 0; hr = pos != 63; }
}

__device__ void ph_mod(const P& p, int bid, float* smem) {
    float (*sc)[1024] = (float(*)[1024])smem;
    float (*red)[64][NCOND] = (float(*)[64][NCOND])(smem + NCOND * 1024);
    const int layer = bid / 48, ct = bid % 48;
    __syncthreads();
    const int tid = threadIdx.x, cl = tid & 63, kg = tid >> 6;
    for (int i = tid; i < NCOND * 1024; i += 256) {
        int ci = i >> 10, k = i & 1023;
        float v = ci == 0 ? p.in[I_CCTX][k] : p.in[I_C][(ci - 1) * 1024 + k];
        sc[ci][k] = siluf_(v);
    }
    __syncthreads();
    float acc[NCOND];
#pragma unroll
    for (int ci = 0; ci < NCOND; ++ci) acc[ci] = 0.f;
    const float* w = p.in[I_WMOD] + (size_t)layer * 1024 * 3072 + ct * 64 + cl;
    for (int kk = 0; kk < 256; ++kk) {
        int k = kg * 256 + kk;
        float wv = w[(size_t)k * 3072];
#pragma unroll
        for (int ci = 0; ci < NCOND; ++ci) acc[ci] += sc[ci][k] * wv;
    }
#pragma unroll
    for (int ci = 0; ci < NCOND; ++ci) red[kg][cl][ci] = acc[ci];
    __syncthreads();
    if (tid < 64) {
        float* mod = (float*)(p.ws + WS_MOD);
        int col = ct * 64 + cl;
#pragma unroll
        for (int ci = 0; ci < NCOND; ++ci)
            mod[(size_t)(layer * NCOND + ci) * 3072 + col] = red[0][cl][ci] + red[1][cl][ci] + red[2][cl][ci] + red[3][cl][ci] + p.in[I_BMOD][layer * 3072 + col];
    }
}

struct WtJob { const float* src; bf16* dst; int K, N, Npad; };
__device__ __forceinline__ WtJob wt_job(const P& p, int j) {
    WtJob q;
    if (j < N_EVEN) { q.src = p.in[I_WINE] + (size_t)j * D * EW; q.dst = (bf16*)(p.ws + WS_WTE) + (size_t)j * EWP * D; q.K = D; q.N = EW; q.Npad = EWP; return q; }
    j -= N_EVEN;
    if (j < N_ODD) { q.src = p.in[I_WINO] + (size_t)j * D * OW; q.dst = (bf16*)(p.ws + WS_WTO) + (size_t)j * OWP * D; q.K = D; q.N = OW; q.Npad = OWP; return q; }
    j -= N_ODD;
    if (j < DEPTH) { int i = j >> 1; q.src = (j & 1) ? p.in[I_WOUTO] + (size_t)i * D * D : p.in[I_WOUTE] + (size_t)i * D * D; q.dst = (bf16*)(p.ws + WS_WTOUT) + (size_t)j * D * D; q.K = D; q.N = D; q.Npad = D; return q; }
    j -= DEPTH;
    q.src = p.in[I_GLUW] + (size_t)j * 512 * 512; q.dst = (bf16*)(p.ws + WS_WTGLU) + (size_t)j * 512 * 512; q.K = 512; q.N = 512; q.Npad = 512; return q;
}
constexpr int WT_NJOBS = N_EVEN + N_ODD + DEPTH + N_ODD;
constexpr int WT_TILES = N_EVEN * (EWP / 64) * 16 + N_ODD * (OWP / 64) * 16 + DEPTH * 256 + N_ODD * 64;
__device__ void ph_wt(const P& p, int bid, float* smem) {
    float (*tile)[65] = (float(*)[65])smem;
    int b = bid, j = 0;
    __syncthreads();
    WtJob q;
    for (;; ++j) { q = wt_job(p, j); int nt = (q.Npad / 64) * (q.K / 64); if (b < nt) break; b -= nt; }
    const int nk = q.K / 64, n0 = (b / nk) * 64, k0 = (b % nk) * 64;
    const int tx = threadIdx.x & 63, ty = threadIdx.x >> 6;
#pragma unroll
    for (int i = 0; i < 16; ++i) { int kk = ty + 4 * i, n = n0 + tx; tile[kk][tx] = n < q.N ? q.src[(size_t)(k0 + kk) * q.N + n] : 0.f; }
    __syncthreads();
#pragma unroll
    for (int i = 0; i < 16; ++i) { int nn = ty + 4 * i; q.dst[(size_t)(n0 + nn) * q.K + k0 + tx] = f2bf(tile[tx][nn]); }
}

__device__ __forceinline__ float wave_sum(float v) {
#pragma unroll
    for (int m = 1; m < 64; m <<= 1) v += __shfl_xor(v, m);
    return v;
}
__device__ __forceinline__ void hmod_row(const float* xv  , int lane, const float* gpre, const float* mod, bf16* dst) {
    float ss = 0.f;
#pragma unroll
    for (int i = 0; i < 16; ++i) ss += xv[i] * xv[i];
    ss = wave_sum(ss);
    const float r = rsqrtf(ss * (1.0f / 1024.f) + EPS);
#pragma unroll
    for (int i = 0; i < 4; ++i) {
        int idx = i * 256 + lane * 4;
        bf16 o[4];
#pragma unroll
        for (int j = 0; j < 4; ++j) o[j] = f2bf(xv[i * 4 + j] * r * gpre[idx + j] * (1.0f + mod[1024 + idx + j]) + mod[idx + j]);
        *(uint2*)(dst + idx) = make_uint2((unsigned)o[0] | ((unsigned)o[1] << 16), (unsigned)o[2] | ((unsigned)o[3] << 16));
    }
}
__device__ void ph_hmod0(const P& p, int bid) {
    const int lane = threadIdx.x & 63, t = bid * 4 + (threadIdx.x >> 6);
    if (t >= T) return;
    const float* xr = t < T_CTX ? p.in[I_XP] + (size_t)t * D : p.in[I_XS] + (size_t)(t - T_CTX) * D;
    float xv[16];
#pragma unroll
    for (int i = 0; i < 4; ++i) { float4 v = *(const float4*)(xr + i * 256 + lane * 4); xv[i * 4] = v.x; xv[i * 4 + 1] = v.y; xv[i * 4 + 2] = v.z; xv[i * 4 + 3] = v.w; }
    const float* mod = (const float*)(p.ws + WS_MOD) + (size_t)(0 * NCOND + tok_cond(t)) * 3072;
    hmod_row(xv, lane, p.in[I_GPRE], mod, (bf16*)(p.ws + WS_HM) + (size_t)t * D);
}
__device__ void ph_post(const P& p, int bid, int layer) {
    const int lane = threadIdx.x & 63, t = bid * 4 + (threadIdx.x >> 6);
    if (t >= T) return;
    const float* xr = layer == 0 ? (t < T_CTX ? p.in[I_XP] + (size_t)t * D : p.in[I_XS] + (size_t)(t - T_CTX) * D) : p.out + OUT_X + (size_t)t * D;
    const float* mr = (const float*)(p.ws + WS_PROJ) + (size_t)t * D;
    const float* mod = (const float*)(p.ws + WS_MOD) + (size_t)(layer * NCOND + tok_cond(t)) * 3072;
    const float* gpost = p.in[I_GPOST] + layer * D;
    float xv[16], mv[16];
    float ss = 0.f;
#pragma unroll
    for (int i = 0; i < 4; ++i) {
        float4 v = *(const float4*)(xr + i * 256 + lane * 4); xv[i * 4] = v.x; xv[i * 4 + 1] = v.y; xv[i * 4 + 2] = v.z; xv[i * 4 + 3] = v.w;
        float4 m = *(const float4*)(mr + i * 256 + lane * 4); mv[i * 4] = m.x; mv[i * 4 + 1] = m.y; mv[i * 4 + 2] = m.z; mv[i * 4 + 3] = m.w;
    }
#pragma unroll
    for (int i = 0; i < 16; ++i) ss += mv[i] * mv[i];
    ss = wave_sum(ss);
    const float r = rsqrtf(ss * (1.0f / 1024.f) + EPS);
    float* xo = p.out + OUT_X + (size_t)t * D;
#pragma unroll
    for (int i = 0; i < 4; ++i) {
        int idx = i * 256 + lane * 4;
#pragma unroll
        for (int j = 0; j < 4; ++j) xv[i * 4 + j] += mod[2048 + idx + j] * (mv[i * 4 + j] * r * gpost[idx + j]);
        *(float4*)(xo + idx) = make_float4(xv[i * 4], xv[i * 4 + 1], xv[i * 4 + 2], xv[i * 4 + 3]);
    }
    if (layer + 1 < DEPTH) {
        const float* mod2 = (const float*)(p.ws + WS_MOD) + (size_t)((layer + 1) * NCOND + tok_cond(t)) * 3072;
        hmod_row(xv, lane, p.in[I_GPRE] + (layer + 1) * D, mod2, (bf16*)(p.ws + WS_HM) + (size_t)t * D);
    }
}

template <bool OUT_BF16>
__device__ void ph_gemm(int bid, float* smem, const bf16* __restrict__ A, int lda, const bf16* __restrict__ Bt, int K, void* __restrict__ Cv, int ldc, int N, int ntn) {
    bf16 (*As)[40] = (bf16(*)[40])smem;
    bf16 (*Bs)[40] = (bf16(*)[40])(smem + 128 * 40 / 2);
    const int tid = threadIdx.x, lane = tid & 63, wid = tid >> 6, wr = wid >> 1, wc = wid & 1;
    const int m0 = (bid / ntn) * 128, n0 = (bid % ntn) * 128;
    const int lr = tid >> 2, lc = (tid & 3) * 8;
    const bf16* Ag = A + (size_t)(m0 + lr) * lda + lc;
    const bf16* Bg = Bt + (size_t)(n0 + lr) * K + lc;
    f4v acc[4][4];
#pragma unroll
    for (int i = 0; i < 4; ++i)
#pragma unroll
        for (int j = 0; j < 4; ++j) acc[i][j] = (f4v){0.f, 0.f, 0.f, 0.f};
    uint4 ra0 = *(const uint4*)Ag, ra1 = *(const uint4*)(Ag + (size_t)64 * lda);
    uint4 rb0 = *(const uint4*)Bg, rb1 = *(const uint4*)(Bg + (size_t)64 * K);
    const int fr = lane & 15, fq = (lane >> 4) * 8;
    for (int k0 = 0; k0 < K; k0 += 32) {
        __syncthreads();
        *(uint4*)&As[lr][lc] = ra0; *(uint4*)&As[lr + 64][lc] = ra1;
        *(uint4*)&Bs[lr][lc] = rb0; *(uint4*)&Bs[lr + 64][lc] = rb1;
        __syncthreads();
        if (k0 + 32 < K) {
            ra0 = *(const uint4*)(Ag + k0 + 32); ra1 = *(const uint4*)(Ag + (size_t)64 * lda + k0 + 32);
            rb0 = *(const uint4*)(Bg + k0 + 32); rb1 = *(const uint4*)(Bg + (size_t)64 * K + k0 + 32);
        }
        s8v af[4], bfr[4];
#pragma unroll
        for (int i = 0; i < 4; ++i) af[i] = *(const s8v*)&As[wr * 64 + i * 16 + fr][fq];
#pragma unroll
        for (int j = 0; j < 4; ++j) bfr[j] = *(const s8v*)&Bs[wc * 64 + j * 16 + fr][fq];
#pragma unroll
        for (int i = 0; i < 4; ++i)
#pragma unroll
            for (int j = 0; j < 4; ++j) acc[i][j] = __builtin_amdgcn_mfma_f32_16x16x32_bf16(af[i], bfr[j], acc[i][j], 0, 0, 0);
    }
#pragma unroll
    for (int i = 0; i < 4; ++i)
#pragma unroll
        for (int j = 0; j < 4; ++j) {
            const int col = n0 + wc * 64 + j * 16 + (lane & 15);
            if (col < N) {
#pragma unroll
                for (int r = 0; r < 4; ++r) {
                    const int row = m0 + wr * 64 + i * 16 + (lane >> 4) * 4 + r;
                    if (OUT_BF16) ((bf16*)Cv)[(size_t)row * ldc + col] = f2bf(acc[i][j][r]);
                    else ((float*)Cv)[(size_t)row * ldc + col] = acc[i][j][r];
                }
            }
        }
}

constexpr int TC = 32;
__device__ void gla_scan_task(const P& p, int ei, int s, int h, int dir, float* smem) {
    float (*sq)[64] = (float(*)[64])smem;
    float (*sk)[64] = (float(*)[64])(smem + TC * 64);
    float (*sa)[64] = (float(*)[64])(smem + 2 * TC * 64);
    float (*sv)[128] = (float(*)[128])(smem + 3 * TC * 64);
    float (*sgd)[16] = (float(*)[16])(smem + 3 * TC * 64 + TC * 128);
    const Seq sq_ = get_seq(s);
    const int tid = threadIdx.x, v = tid >> 1, dh = tid & 1;
    const bf16* proj = (const bf16*)(p.ws + WS_PROJ);
    bf16* opart = (bf16*)(p.ws + WS_PART + (size_t)dir * PART_SZ);
    const float* gup = p.in[I_GUP] + (size_t)(ei * 2 + dir) * 16 * 256 + h * 64;
    const float* gbias = p.in[I_GBIAS] + (size_t)(ei * 2 + dir) * 256 + h * 64;
    float S[32];
    if (sq_.lat) {
        const float* s0 = p.in[I_SGLA] + ((((size_t)sq_.b * N_EVEN + ei) * 2 + dir) * 4 + h) * 64 * 128;
#pragma unroll
        for (int d = 0; d < 32; ++d) S[d] = s0[(dh * 32 + d) * 128 + v];
    } else {
#pragma unroll
        for (int d = 0; d < 32; ++d) S[d] = 0.f;
    }
    for (int c0 = 0; c0 < sq_.len; c0 += TC) {
        __syncthreads();
        for (int e = tid; e < TC * 64; e += 256) {
            int i = e >> 6, d = e & 63, pos = c0 + i, t = sq_.start + (dir ? sq_.len - 1 - pos : pos);
            const bf16* pr = proj + (size_t)t * EW;
            sq[i][d] = bf2f(pr[E_Q + h * 64 + d]) * 0.125f;
            sk[i][d] = bf2f(pr[E_K + h * 64 + d]);
        }
        for (int e = tid; e < TC * 128; e += 256) {
            int i = e >> 7, d = e & 127, pos = c0 + i, t = sq_.start + (dir ? sq_.len - 1 - pos : pos);
            sv[i][d] = bf2f(proj[(size_t)t * EW + E_V + h * 128 + d]);
        }
        for (int e = tid; e < TC * 16; e += 256) {
            int i = e >> 4, r = e & 15, pos = c0 + i, t = sq_.start + (dir ? sq_.len - 1 - pos : pos);
            sgd[i][r] = bf2f(proj[(size_t)t * EW + E_GD + dir * 16 + r]);
        }
        __syncthreads();
        for (int e = tid; e < TC * 64; e += 256) {
            int i = e >> 6, d = e & 63;
            float x = gbias[d];
#pragma unroll
            for (int r = 0; r < 16; ++r) x += sgd[i][r] * gup[r * 256 + d];
            sa[i][d] = expf(logsigf_(x) * (1.0f / 16.0f));
        }
        __syncthreads();
        for (int i = 0; i < TC; ++i) {
            const float vv = sv[i][v];
            float o = 0.f;
#pragma unroll
            for (int d = 0; d < 32; ++d) {
                S[d] = sa[i][dh * 32 + d] * S[d] + sk[i][dh * 32 + d] * vv;
                o += sq[i][dh * 32 + d] * S[d];
            }
            o += __shfl_xor(o, 1);
            if (dh == 0) { int pos = c0 + i, t = sq_.start + (dir ? sq_.len - 1 - pos : pos); opart[(size_t)t * 512 + h * 128 + v] = f2bf(o); }
        }
    }
    if (!sq_.lat) {
        float* fs = p.out + OUT_GLA + ((((size_t)sq_.b * N_EVEN + ei) * 2 + dir) * 4 + h) * 64 * 128;
#pragma unroll
        for (int d = 0; d < 32; ++d) fs[(dh * 32 + d) * 128 + v] = S[d];
    }
}

__device__ void rwkv_scan_task(const P& p, int ei, int s, int h, int dir, float* smem) {
    float (*sW)[64] = (float(*)[64])smem;
    float (*sKK)[64] = (float(*)[64])(smem + 1 * TC * 64);
    float (*sKA)[64] = (float(*)[64])(smem + 2 * TC * 64);
    float (*sKM)[64] = (float(*)[64])(smem + 3 * TC * 64);
    float (*sR)[64] = (float(*)[64])(smem + 4 * TC * 64);
    float (*sV)[64] = (float(*)[64])(smem + 5 * TC * 64);
    float (*sTW)[64] = (float(*)[64])(smem + 6 * TC * 64);
    float (*sAD)[64] = (float(*)[64])(smem + 7 * TC * 64);
    const Seq sq_ = get_seq(s);
    const int tid = threadIdx.x, row = tid >> 2, kq = tid & 3;
    const bf16* proj = (const bf16*)(p.ws + WS_PROJ);
    bf16* opart = (bf16*)(p.ws + WS_PART + (size_t)(2 + dir) * PART_SZ);
    float* bonus = (float*)(p.ws + WS_BONUS);
    const float* mix = p.in[I_MIX] + (size_t)ei * 1792;
    const int hc0 = h * 64;
    const float* w0 = p.in[I_W0] + (size_t)(ei * 2 + dir) * 512 + hc0;
    const float* w2 = p.in[I_W2] + (size_t)(ei * 2 + dir) * 64 * 512 + hc0;
    const float* a0 = p.in[I_A0] + (size_t)(ei * 2 + dir) * 512 + hc0;
    const float* a2 = p.in[I_A2] + (size_t)(ei * 2 + dir) * 64 * 512 + hc0;
    const float* kkw = p.in[I_KK] + (size_t)ei * 512 + hc0;
    const float* kaw = p.in[I_KA] + (size_t)ei * 512 + hc0;
    const float* rkw = p.in[I_RK] + (size_t)ei * 512 + hc0;
    float S[16];
    if (sq_.lat) {
        const float* s0 = p.in[I_SRWKV] + ((((size_t)sq_.b * N_EVEN + ei) * 2 + dir) * 8 + h) * 64 * 64;
#pragma unroll
        for (int k = 0; k < 16; ++k) S[k] = s0[row * 64 + kq * 16 + k];
    } else {
#pragma unroll
        for (int k = 0; k < 16; ++k) S[k] = 0.f;
    }
    for (int c0 = 0; c0 < sq_.len; c0 += TC) {
        __syncthreads();
        for (int e = tid; e < TC * 64 * 5; e += 256) {
            int which = e / (TC * 64), rem = e % (TC * 64), i = rem >> 6, c = rem & 63;
            int pos = c0 + i, t = sq_.start + (dir ? sq_.len - 1 - pos : pos);
            int col = which == 0 ? FB_R + hc0 + c : which == 1 ? FB_K + hc0 + c : which == 2 ? FB_V + hc0 + c : which == 3 ? FB_WD + dir * 64 + c : FB_AD + dir * 64 + c;
            bool hl, hr; tok_nbr(t, hl, hr);
            const bf16* pr = proj + (size_t)t * EW + E_FB + col;
            float x = bf2f(pr[0]);
            float nl = hl ? bf2f(pr[-EW]) : 0.f, nr = hr ? bf2f(pr[EW]) : 0.f;
            float y = x + mix[col] * (0.5f * (nl + nr) - x);
            if (which == 0) sR[i][c] = y; else if (which == 1) sKM[i][c] = y; else if (which == 2) sV[i][c] = y; else if (which == 3) sTW[i][c] = tanhf(y); else sAD[i][c] = y;
        }
        __syncthreads();
        {
            const int c = tid & 63, ig = tid >> 6;
            float aw[TC / 4], aa[TC / 4];
#pragma unroll
            for (int j = 0; j < TC / 4; ++j) { aw[j] = w0[c]; aa[j] = a0[c]; }
            for (int r = 0; r < 64; ++r) {
                const float w2v = w2[(size_t)r * 512 + c], a2v = a2[(size_t)r * 512 + c];
#pragma unroll
                for (int j = 0; j < TC / 4; ++j) { aw[j] += sTW[ig * (TC / 4) + j][r] * w2v; aa[j] += sAD[ig * (TC / 4) + j][r] * a2v; }
            }
            const float kkc = kkw[c], kac = kaw[c], rkc = rkw[c];
#pragma unroll
            for (int j = 0; j < TC / 4; ++j) {
                const int i = ig * (TC / 4) + j;
                const float dec = expf(-0.6065306597126334f * sigmoidf_(aw[j]));
                const float av = sigmoidf_(aa[j]);
                const float kraw = sKM[i][c];
                const float km = kraw * (1.0f + (av - 1.0f) * kac);
                float kkv = kraw * kkc;
                const float nrm = rsqrtf(wave_sum(kkv * kkv) + EPS);
                kkv *= nrm;
                const float bn = wave_sum(sR[i][c] * km * rkc);
                sW[i][c] = dec; sKM[i][c] = km; sKK[i][c] = kkv; sKA[i][c] = kkv * av;
                if (c == 0) { int pos = c0 + i, t = sq_.start + (dir ? sq_.len - 1 - pos : pos); bonus[((size_t)t * 8 + h) * 2 + dir] = bn; }
            }
        }
        __syncthreads();
        for (int i = 0; i < TC; ++i) {
            float sa = 0.f;
#pragma unroll
            for (int k = 0; k < 16; ++k) sa -= S[k] * sKK[i][kq * 16 + k];
            sa += __shfl_xor(sa, 1); sa += __shfl_xor(sa, 2);
            const float vv = sV[i][row];
            float y = 0.f;
#pragma unroll
            for (int k = 0; k < 16; ++k) {
                S[k] = S[k] * sW[i][kq * 16 + k] + sa * sKA[i][kq * 16 + k] + vv * sKM[i][kq * 16 + k];
                y += S[k] * sR[i][kq * 16 + k];
            }
            y += __shfl_xor(y, 1); y += __shfl_xor(y, 2);
            if (kq == 0) { int pos = c0 + i, t = sq_.start + (dir ? sq_.len - 1 - pos : pos); opart[(size_t)t * 512 + hc0 + row] = f2bf(y); }
        }
    }
    if (!sq_.lat) {
        float* fs = p.out + OUT_RWKV + ((((size_t)sq_.b * N_EVEN + ei) * 2 + dir) * 8 + h) * 64 * 64;
#pragma unroll
        for (int k = 0; k < 16; ++k) fs[row * 64 + kq * 16 + k] = S[k];
    }
}
constexpr int EVEN_SCAN_BLOCKS = NSEQ * 8 * 2 + NSEQ * 4 * 2;
__device__ void ph_even_scan(const P& p, int bid, int ei, float* smem) {
    int b = bid;
    const int nlr = NB_LAT * 16, nlg = NB_LAT * 8, ncr = NB_CTX * 16;
    if (b < nlr) { rwkv_scan_task(p, ei, NB_CTX + b / 16, (b % 16) >> 1, b & 1, smem); return; }
    b -= nlr;
    if (b < nlg) { gla_scan_task(p, ei, NB_CTX + b / 8, (b % 8) >> 1, b & 1, smem); return; }
    b -= nlg;
    if (b < ncr) { rwkv_scan_task(p, ei, b / 16, (b % 16) >> 1, b & 1, smem); return; }
    b -= ncr;
    gla_scan_task(p, ei, b / 8, (b % 8) >> 1, b & 1, smem);
}

__device__ void ph_fin_even(const P& p, int bid, int ei) {
    const int lane = threadIdx.x & 63, t = bid * 4 + (threadIdx.x >> 6);
    if (t >= T) return;
    const bf16* pr = (const bf16*)(p.ws + WS_PROJ) + (size_t)t * EW;
    const bf16* oaf = (const bf16*)(p.ws + WS_PART) + (size_t)t * 512;
    const bf16* oab = (const bf16*)(p.ws + WS_PART + PART_SZ) + (size_t)t * 512;
    const bf16* obf = (const bf16*)(p.ws + WS_PART + 2 * PART_SZ) + (size_t)t * 512;
    const bf16* obb = (const bf16*)(p.ws + WS_PART + 3 * PART_SZ) + (size_t)t * 512;
    bf16* yc = (bf16*)(p.ws + WS_HM) + (size_t)t * D;
    const int idx = lane * 8;
    {
        float o[8], ss = 0.f;
#pragma unroll
        for (int j = 0; j < 8; ++j) { o[j] = bf2f(oaf[idx + j]) + bf2f(oab[idx + j]); ss += o[j] * o[j]; }
        ss += __shfl_xor(ss, 1); ss += __shfl_xor(ss, 2); ss += __shfl_xor(ss, 4); ss += __shfl_xor(ss, 8);
        const float r = rsqrtf(ss * (1.0f / 128.f) + EPS);
        const float* gn = p.in[I_GLAN] + ei * 128 + (idx & 127);
#pragma unroll
        for (int j = 0; j < 8; ++j) yc[idx + j] = f2bf(o[j] * r * gn[j] * siluf_(bf2f(pr[E_ZA + idx + j])));
    }
    {
        float o[8], mu = 0.f;
#pragma unroll
        for (int j = 0; j < 8; ++j) { o[j] = bf2f(obf[idx + j]) + bf2f(obb[idx + j]); mu += o[j]; }
        mu += __shfl_xor(mu, 1); mu += __shfl_xor(mu, 2); mu += __shfl_xor(mu, 4);
        mu *= (1.0f / 64.f);
        float var = 0.f;
#pragma unroll
        for (int j = 0; j < 8; ++j) { o[j] -= mu; var += o[j] * o[j]; }
        var += __shfl_xor(var, 1); var += __shfl_xor(var, 2); var += __shfl_xor(var, 4);
        const float r = rsqrtf(var * (1.0f / 64.f) + 64e-5f);
        const int h = idx >> 6;
        const float* bn = (const float*)(p.ws + WS_BONUS) + ((size_t)t * 8 + h) * 2;
        const float bsum = bn[0] + bn[1];
        bool hl, hr; tok_nbr(t, hl, hr);
        const float* mix = p.in[I_MIX] + (size_t)ei * 1792 + FB_V + idx;
        const float* lg = p.in[I_LNG] + ei * 512 + idx;
        const float* lb = p.in[I_LNB] + ei * 512 + idx;
#pragma unroll
        for (int j = 0; j < 8; ++j) {
            const bf16* pv = pr + E_FB + FB_V + idx + j;
            const float x = bf2f(pv[0]);
            const float nl = hl ? bf2f(pv[-EW]) : 0.f, nr = hr ? bf2f(pv[EW]) : 0.f;
            const float vsh = x + mix[j] * (0.5f * (nl + nr) - x);
            yc[512 + idx + j] = f2bf((o[j] * r * lg[j] + lb[j] + bsum * vsh) * siluf_(bf2f(pr[E_ZB + idx + j])));
        }
    }
}

__device__ void ph_odd_prep(const P& p, int bid, int oi) {
    const int lane = threadIdx.x & 63, t = bid * 4 + (threadIdx.x >> 6);
    if (t >= T) return;
    const bf16* proj = (const bf16*)(p.ws + WS_PROJ);
    const float* cw = p.in[I_CONV] + (size_t)oi * 9 * 1536;
    bf16* qo = (bf16*)(p.ws + WS_QKVN) + (size_t)t * 1536;
    const bool lat = t >= T_CTX;
    int pos, len;
    if (!lat) { pos = t % L_CTX; len = L_CTX; } else { pos = (t - T_CTX) % L_LAT; len = L_LAT; }
    const int gr = pos >> 6, gc = pos & 63, nrows = len >> 6;
#pragma unroll
    for (int part = 0; part < 3; ++part) {
        const int ch = part * 512 + lane * 8;
        float acc[8];
#pragma unroll
        for (int j = 0; j < 8; ++j) acc[j] = 0.f;
        for (int di = (lat ? -1 : 0); di <= (lat ? 1 : 0); ++di)
            for (int dj = -1; dj <= 1; ++dj) {
                bool ok;
                if (lat) ok = (gr + di >= 0) && (gr + di < nrows) && (gc + dj >= 0) && (gc + dj < 64);
                else ok = (pos + dj >= 0) && (pos + dj < len);
                if (!ok) continue;
                const bf16* src = proj + (size_t)(t + di * 64 + dj) * OW + O_QKV + ch;
                const float* w = cw + ((di + 1) * 3 + (dj + 1)) * 1536 + ch;
#pragma unroll
                for (int j = 0; j < 8; ++j) acc[j] += bf2f(src[j]) * w[j];
            }
        float ss = 0.f;
#pragma unroll
        for (int j = 0; j < 8; ++j) { acc[j] = siluf_(acc[j]); ss += acc[j] * acc[j]; }
        if (part < 2) {
            ss += __shfl_xor(ss, 1); ss += __shfl_xor(ss, 2); ss += __shfl_xor(ss, 4); ss += __shfl_xor(ss, 8);
            float r = rsqrtf(ss + EPS);
            if (part == 0) r *= 0.08838834764831845f;
#pragma unroll
            for (int j = 0; j < 8; ++j) acc[j] *= r;
        }
#pragma unroll
        for (int j = 0; j < 8; ++j) qo[ch + j] = f2bf(acc[j]);
    }
    if (lane < 16) {
        float* g = (float*)(p.ws + WS_GATES) + (size_t)t * 16;
        const float x = bf2f(proj[(size_t)t * OW + O_G + lane]);
        if (lane < 8) {
            const float lgv = -expf(p.in[I_ALOG][oi * 8 + lane]) * softplusf_(x + p.in[I_DTB][oi * 8 + lane]);
            g[lane] = expf(lgv);
        } else g[lane] = sigmoidf_(x);
    }
}
__device__ void gdn_scan_task(const P& p, int oi, int s, int h, int dir, float* smem) {
    float (*sq)[128] = (float(*)[128])smem;
    float (*sk)[128] = (float(*)[128])(smem + TC * 128);
    float (*sv)[128] = (float(*)[128])(smem + 2 * TC * 128);
    float* sg = smem + 3 * TC * 128;
    float* sb = sg + TC;
    const Seq sq_ = get_seq(s);
    const int tid = threadIdx.x, v = tid >> 1, dh = tid & 1;
    const bf16* qkvn = (const bf16*)(p.ws + WS_QKVN);
    const float* gates = (const float*)(p.ws + WS_GATES);
    bf16* opart = (bf16*)(p.ws + WS_PART + (size_t)dir * PART_SZ);
    float S[64];
    if (sq_.lat) {
        const float* s0 = p.in[I_SGDN] + ((((size_t)sq_.b * N_ODD + oi) * 2 + dir) * 4 + h) * 128 * 128;
#pragma unroll
        for (int d = 0; d < 64; ++d) S[d] = s0[(dh * 64 + d) * 128 + v];
    } else {
#pragma unroll
        for (int d = 0; d < 64; ++d) S[d] = 0.f;
    }
    for (int c0 = 0; c0 < sq_.len; c0 += TC) {
        __syncthreads();
        for (int e = tid; e < TC * 128; e += 256) {
            int i = e >> 7, d = e & 127, pos = c0 + i, t = sq_.start + (dir ? sq_.len - 1 - pos : pos);
            const bf16* src = qkvn + (size_t)t * 1536 + h * 128 + d;
            sq[i][d] = bf2f(src[0]); sk[i][d] = bf2f(src[512]); sv[i][d] = bf2f(src[1024]);
        }
        if (tid < TC) {
            int pos = c0 + tid, t = sq_.start + (dir ? sq_.len - 1 - pos : pos);
            sg[tid] = gates[(size_t)t * 16 + dir * 4 + h]; sb[tid] = gates[(size_t)t * 16 + 8 + dir * 4 + h];
        }
        __syncthreads();
        for (int i = 0; i < TC; ++i) {
            float ks = 0.f;
#pragma unroll
            for (int d = 0; d < 64; ++d) ks += sk[i][dh * 64 + d] * S[d];
            ks += __shfl_xor(ks, 1);
            const float g = sg[i];
            const float cc = sb[i] * (sv[i][v] - g * ks);
            float o = 0.f;
#pragma unroll
            for (int d = 0; d < 64; ++d) {
                S[d] = g * S[d] + sk[i][dh * 64 + d] * cc;
                o += sq[i][dh * 64 + d] * S[d];
            }
            o += __shfl_xor(o, 1);
            if (dh == 0) { int pos = c0 + i, t = sq_.start + (dir ? sq_.len - 1 - pos : pos); opart[(size_t)t * 512 + h * 128 + v] = f2bf(o); }
        }
    }
    if (!sq_.lat) {
        float* fs = p.out + OUT_GDN + ((((size_t)sq_.b * N_ODD + oi) * 2 + dir) * 4 + h) * 128 * 128;
#pragma unroll
        for (int d = 0; d < 64; ++d) fs[(dh * 64 + d) * 128 + v] = S[d];
    }
}
constexpr int TS = 8;
__device__ void s5_scan_task(const P& p, int oi, int s, int dir, int g4, float* smem) {
    const int tid = threadIdx.x, w = tid >> 6, lane = tid & 63, g = g4 * 4 + w;
    float* base = smem + w * (2 * TS * 64 + TS * 16 + 2 * 16 * 64);
    float (*hre)[64] = (float(*)[64])base;
    float (*him)[64] = (float(*)[64])(base + TS * 64);
    float (*su)[16] = (float(*)[16])(base + 2 * TS * 64);
    float (*cre)[64] = (float(*)[64])(base + 2 * TS * 64 + TS * 16);
    float (*cim)[64] = (float(*)[64])(base + 2 * TS * 64 + TS * 16 + 16 * 64);
    const Seq sq_ = get_seq(s);
    const bf16* proj = (const bf16*)(p.ws + WS_PROJ);
    bf16* ypart = (bf16*)(p.ws + WS_PART + (size_t)(2 + dir) * PART_SZ);
    const size_t pg = ((size_t)(oi * 2 + dir) * 32 + g);
    float are = fminf(p.in[I_S5AR][pg * 64 + lane], -1e-4f), aim = p.in[I_S5AI][pg * 64 + lane];
    const float dt = expf(p.in[I_S5DT][pg]);
    const float mag = expf(are * dt);
    const float abr = mag * cosf(aim * dt), abi = mag * sinf(aim * dt);
    const float den = are * are + aim * aim;
    const float fre = ((abr - 1.0f) * are + abi * aim) / den, fim = (abi * are - (abr - 1.0f) * aim) / den;
    float bbr[16], bbi[16];
#pragma unroll
    for (int c = 0; c < 16; ++c) {
        const float br = p.in[I_S5BR][(pg * 64 + lane) * 16 + c], bi = p.in[I_S5BI][(pg * 64 + lane) * 16 + c];
        bbr[c] = fre * br - fim * bi; bbi[c] = fre * bi + fim * br;
    }
    for (int e = lane; e < 16 * 64; e += 64) { cre[e >> 6][e & 63] = p.in[I_S5CR][pg * 1024 + e]; cim[e >> 6][e & 63] = p.in[I_S5CI][pg * 1024 + e]; }
    float hr = 0.f, hi = 0.f;
    if (sq_.lat) { const size_t o = (((size_t)sq_.b * N_ODD + oi) * 2 + dir) * 32 * 64 + g * 64 + lane; hr = p.in[I_SS5R][o]; hi = p.in[I_SS5I][o]; }
    for (int c0 = 0; c0 < sq_.len; c0 += TS) {
        __syncthreads();
        for (int e = lane; e < TS * 16; e += 64) {
            int i = e >> 4, c = e & 15, pos = c0 + i, t = sq_.start + (dir ? sq_.len - 1 - pos : pos);
            su[i][c] = bf2f(proj[(size_t)t * OW + O_U + g * 16 + c]);
        }
        __syncthreads();
        for (int i = 0; i < TS; ++i) {
            float br = 0.f, bi = 0.f;
#pragma unroll
            for (int c = 0; c < 16; ++c) { br += bbr[c] * su[i][c]; bi += bbi[c] * su[i][c]; }
            const float nr = abr * hr - abi * hi + br, ni = abr * hi + abi * hr + bi;
            hr = nr; hi = ni;
            hre[i][lane] = hr; him[i][lane] = hi;
        }
        __syncthreads();
        {
            const int c = lane & 15;
#pragma unroll
            for (int j = 0; j < TS / 4; ++j) {
                const int i = (lane >> 4) + 4 * j;
                float y = 0.f;
                for (int q = 0; q < 64; ++q) y += cre[c][q] * hre[i][q] - cim[c][q] * him[i][q];
                int pos = c0 + i, t = sq_.start + (dir ? sq_.len - 1 - pos : pos);
                ypart[(size_t)t * 512 + g * 16 + c] = f2bf(y);
            }
        }
    }
    if (!sq_.lat) {
        const size_t o = (((size_t)sq_.b * N_ODD + oi) * 2 + dir) * 32 * 64 + g * 64 + lane;
        p.out[OUT_S5R + o] = hr; p.out[OUT_S5I + o] = hi;
    }
}
constexpr int ODD_SCAN_BLOCKS = NSEQ * 4 * 2 + NSEQ * 2 * 8;
__device__ void ph_odd_scan(const P& p, int bid, int oi, float* smem) {
    int b = bid;
    const int nlg = NB_LAT * 8, nls = NB_LAT * 16, ncg = NB_CTX * 8;
    if (b < nlg) { gdn_scan_task(p, oi, NB_CTX + b / 8, (b % 8) >> 1, b & 1, smem); return; }
    b -= nlg;
    if (b < nls) { s5_scan_task(p, oi, NB_CTX + b / 16, (b % 16) >> 3, b & 7, smem); return; }
    b -= nls;
    if (b < ncg) { gdn_scan_task(p, oi, b / 8, (b % 8) >> 1, b & 1, smem); return; }
    b -= ncg;
    s5_scan_task(p, oi, b / 16, (b % 16) >> 3, b & 7, smem);
}
__device__ void ph_fin_odd_a(const P& p, int bid, int oi) {
    const int lane = threadIdx.x & 63, t = bid * 4 + (threadIdx.x >> 6);
    if (t >= T) return;
    const bf16* pr = (const bf16*)(p.ws + WS_PROJ) + (size_t)t * OW;
    const bf16* of = (const bf16*)(p.ws + WS_PART) + (size_t)t * 512;
    const bf16* ob = (const bf16*)(p.ws + WS_PART + PART_SZ) + (size_t)t * 512;
    const bf16* yf = (const bf16*)(p.ws + WS_PART + 2 * PART_SZ) + (size_t)t * 512;
    const bf16* yb = (const bf16*)(p.ws + WS_PART + 3 * PART_SZ) + (size_t)t * 512;
    bf16* yc = (bf16*)(p.ws + WS_HM) + (size_t)t * D;
    const int idx = lane * 8;
    float o[8], ss = 0.f;
#pragma unroll
    for (int j = 0; j < 8; ++j) { o[j] = bf2f(of[idx + j]) + bf2f(ob[idx + j]); ss += o[j] * o[j]; }
    ss += __shfl_xor(ss, 1); ss += __shfl_xor(ss, 2); ss += __shfl_xor(ss, 4); ss += __shfl_xor(ss, 8);
    const float r = rsqrtf(ss * (1.0f / 128.f) + EPS);
    const float* gn = p.in[I_GDNN] + oi * 128 + (idx & 127);
    const float* dsk = p.in[I_S5D] + oi * 512 + idx;
#pragma unroll
    for (int j = 0; j < 8; ++j) {
        yc[idx + j] = f2bf(o[j] * r * gn[j] * siluf_(bf2f(pr[O_ZC + idx + j])));
        const float y = bf2f(yf[idx + j]) + bf2f(yb[idx + j]) + dsk[j] * bf2f(pr[O_U + idx + j]);
        yc[512 + idx + j] = f2bf(gelu_tanh(y));
    }
}
__device__ void ph_fin_odd_b(const P& p, int bid, int oi) {
    const size_t e = ((size_t)bid * 256 + threadIdx.x) * 4;
    if (e >= (size_t)T * 512) return;
    const int t = (int)(e >> 9), idx = (int)(e & 511);
    const bf16* pr = (const bf16*)(p.ws + WS_PROJ) + (size_t)t * OW;
    const bf16* gl = (const bf16*)(p.ws + WS_PART + 2 * PART_SZ) + (size_t)t * 512;
    bf16* yc = (bf16*)(p.ws + WS_HM) + (size_t)t * D + 512;
#pragma unroll
    for (int j = 0; j < 4; ++j) {
        const float ys = bf2f(yc[idx + j]);
        yc[idx + j] = f2bf(ys * sigmoidf_(bf2f(gl[idx + j]) + p.in[I_GLUB][oi * 512 + idx + j]) * siluf_(bf2f(pr[O_ZD + idx + j])));
    }
}

enum { PK_PREP0, PK_HMOD0, PK_GEMM_IN, PK_EVEN_SCAN, PK_FIN_EVEN, PK_ODD_PREP, PK_ODD_SCAN, PK_FIN_ODD_A, PK_GEMM_GLU, PK_FIN_ODD_B, PK_GEMM_OUT, PK_POST };
constexpr int NPH = 2 + (DEPTH / 2) * 13 + (DEPTH & 1) * 5;
constexpr int TOKB = (T + 3) / 4;
__host__ __device__ inline void phase_desc(int ph, int& kind, int& layer) {
    if (ph == 0) { kind = PK_PREP0; layer = 0; return; }
    if (ph == 1) { kind = PK_HMOD0; layer = 0; return; }
    ph -= 2;
    const int pair = ph / 13, r = ph % 13;
    if (r < 5) { layer = 2 * pair; kind = r == 0 ? PK_GEMM_IN : r == 1 ? PK_EVEN_SCAN : r == 2 ? PK_FIN_EVEN : r == 3 ? PK_GEMM_OUT : PK_POST; }
    else { const int q = r - 5; layer = 2 * pair + 1; kind = q == 0 ? PK_GEMM_IN : q == 1 ? PK_ODD_PREP : q == 2 ? PK_ODD_SCAN : q == 3 ? PK_FIN_ODD_A : q == 4 ? PK_GEMM_GLU : q == 5 ? PK_FIN_ODD_B : q == 6 ? PK_GEMM_OUT : PK_POST; }
}
__host__ __device__ inline int phase_nblk(int kind, int layer) {
    switch (kind) {
        case PK_PREP0: return DEPTH * 48 + WT_TILES;
        case PK_GEMM_IN: return (T / 128) * (((layer & 1) ? OWP : EWP) / 128);
        case PK_EVEN_SCAN: return EVEN_SCAN_BLOCKS;
        case PK_ODD_SCAN: return ODD_SCAN_BLOCKS;
        case PK_GEMM_GLU: return (T / 128) * 4;
        case PK_FIN_ODD_B: return (T * 512 / 4 + 255) / 256;
        case PK_GEMM_OUT: return (T / 128) * 8;
        default: return TOKB;
    }
}
__device__ __forceinline__ void do_phase(const P& p, int kind, int layer, int bid, float* smem) {
    const int i = layer >> 1;
    const bf16* hm = (const bf16*)(p.ws + WS_HM);
    switch (kind) {
        case PK_PREP0: if (bid < DEPTH * 48) ph_mod(p, bid, smem); else ph_wt(p, bid - DEPTH * 48, smem); break;
        case PK_HMOD0: ph_hmod0(p, bid); break;
        case PK_GEMM_IN:
            if ((layer & 1) == 0) ph_gemm<true>(bid, smem, hm, D, (const bf16*)(p.ws + WS_WTE) + (size_t)i * EWP * D, D, (void*)(p.ws + WS_PROJ), EW, EW, EWP / 128);
            else ph_gemm<true>(bid, smem, hm, D, (const bf16*)(p.ws + WS_WTO) + (size_t)i * OWP * D, D, (void*)(p.ws + WS_PROJ), OW, OW, OWP / 128);
            break;
        case PK_EVEN_SCAN: ph_even_scan(p, bid, i, smem); break;
        case PK_FIN_EVEN: ph_fin_even(p, bid, i); break;
        case PK_ODD_PREP: ph_odd_prep(p, bid, i); break;
        case PK_ODD_SCAN: ph_odd_scan(p, bid, i, smem); break;
        case PK_FIN_ODD_A: ph_fin_odd_a(p, bid, i); break;
        case PK_GEMM_GLU: ph_gemm<true>(bid, smem, hm + 512, D, (const bf16*)(p.ws + WS_WTGLU) + (size_t)i * 512 * 512, 512, (void*)(p.ws + WS_PART + 2 * PART_SZ), 512, 512, 4); break;
        case PK_FIN_ODD_B: ph_fin_odd_b(p, bid, i); break;
        case PK_GEMM_OUT: ph_gemm<false>(bid, smem, hm, D, (const bf16*)(p.ws + WS_WTOUT) + (size_t)layer * D * D, D, (void*)(p.ws + WS_PROJ), D, D, 8); break;
        case PK_POST: ph_post(p, bid, layer); break;
    }
}

#ifdef CPU_EMU
__global__ void k_phase(P p, int kind, int layer) {
    __shared__ __attribute__((aligned(16))) float smem[16384];
    do_phase(p, kind, layer, blockIdx.x, smem);
}
void emu_hook(const char* stage, int layer, const P& p);
extern "C" void kernel_launch(void* const* d_in, const int* in_sizes, int n_in, void* d_out, int out_size, void* d_ws, size_t ws_size, hipStream_t stream) {
    P p{};
    for (int i = 0; i < 44; ++i) p.in[i] = (const float*)d_in[i];
    p.out = (float*)d_out; p.ws = (char*)d_ws;
    static const char* names[] = {"prep0", "hmod", "proj", "even_scan", "ycat", "odd_prep", "odd_scan", "fin_odd_a", "glu", "ycat", "outproj", "post"};
    for (int ph = 0; ph < NPH; ++ph) {
        int kind, layer; phase_desc(ph, kind, layer);
        EMU_LAUNCH(k_phase, phase_nblk(kind, layer), 256, p, kind, layer);
        emu_hook(names[kind], layer, p);
    }
}
#else
#define RUN_PHASE(KIND, LAYER) do { const int nb_ = phase_nblk(KIND, LAYER); for (int b_ = blockIdx.x; b_ < nb_; b_ += gridDim.x) do_phase(p, KIND, LAYER, b_, smem); } while (0)
__global__ void __launch_bounds__(256) mega(P p) {
    __shared__ __attribute__((aligned(16))) float smem[16384];
    cg::grid_group grid = cg::this_grid();
    RUN_PHASE(PK_PREP0, 0); grid.sync();
    RUN_PHASE(PK_HMOD0, 0); grid.sync();
#pragma nounroll
    for (int pair = 0; pair < DEPTH / 2; ++pair) {
        const int le = 2 * pair, lo = 2 * pair + 1;
        RUN_PHASE(PK_GEMM_IN, le); grid.sync();
        RUN_PHASE(PK_EVEN_SCAN, le); grid.sync();
        RUN_PHASE(PK_FIN_EVEN, le); grid.sync();
        RUN_PHASE(PK_GEMM_OUT, le); grid.sync();
        RUN_PHASE(PK_POST, le); grid.sync();
        RUN_PHASE(PK_GEMM_IN, lo); grid.sync();
        RUN_PHASE(PK_ODD_PREP, lo); grid.sync();
        RUN_PHASE(PK_ODD_SCAN, lo); grid.sync();
        RUN_PHASE(PK_FIN_ODD_A, lo); grid.sync();
        RUN_PHASE(PK_GEMM_GLU, lo); grid.sync();
        RUN_PHASE(PK_FIN_ODD_B, lo); grid.sync();
        RUN_PHASE(PK_GEMM_OUT, lo); grid.sync();
        RUN_PHASE(PK_POST, lo);
        if (pair + 1 < DEPTH / 2) grid.sync();
    }
}
extern "C" void kernel_launch(void* const* d_in, const int* in_sizes, int n_in, void* d_out, int out_size, void* d_ws, size_t ws_size, hipStream_t stream) {
    static int grid_blocks = 0;
    if (!grid_blocks) {
        int dev = 0, cus = 0, per_cu = 0;
        (void)hipGetDevice(&dev);
        (void)hipDeviceGetAttribute(&cus, hipDeviceAttributeMultiprocessorCount, dev);
        (void)hipOccupancyMaxActiveBlocksPerMultiprocessor(&per_cu, mega, 256, 0);
        if (per_cu > 1) per_cu = 1;
        if (per_cu < 1) per_cu = 1;
        grid_blocks = cus * per_cu;
    }
    P p{};
    for (int i = 0; i < 44; ++i) p.in[i] = (const float*)d_in[i];
    p.out = (float*)d_out; p.ws = (char*)d_ws;
    void* args[] = {&p};
    hipError_t e = hipLaunchCooperativeKernel((void*)mega, dim3(grid_blocks), dim3(256), args, 0, stream);
    if (e != hipSuccess) fprintf(stderr, "cooperative launch failed: %s (grid %d)\n", hipGetErrorString(e), grid_blocks);
}
#endif
```

```cpp
#ifndef CPU_EMU
#include <hip/hip_runtime.h>
#include <hip/hip_cooperative_groups.h>
#include <cstdio>
namespace cg = cooperative_groups;
#endif
#include <stdint.h>

#ifndef CFG_BATCH
#define CFG_BATCH 16
#define CFG_SEQ 256
#define CFG_DEC_BATCH 8
#define CFG_DEC_SEQ 1024
#define CFG_DEPTH 4
#endif

typedef unsigned short bf16;
typedef short s8v __attribute__((ext_vector_type(8)));
typedef float f4v __attribute__((ext_vector_type(4)));

constexpr int D = 1024;
constexpr int NB_CTX = CFG_BATCH, L_CTX = CFG_SEQ, NB_LAT = CFG_DEC_BATCH, L_LAT = CFG_DEC_SEQ, DEPTH = CFG_DEPTH;
constexpr int N_EVEN = (DEPTH + 1) / 2, N_ODD = DEPTH / 2;
constexpr int T_CTX = NB_CTX * L_CTX, T_LAT = NB_LAT * L_LAT, T = T_CTX + T_LAT;
constexpr int NSEQ = NB_CTX + NB_LAT, NCOND = 1 + NB_LAT;
constexpr int EW = 3872, OW = 3088, EWP = 4096, OWP = 3328;
constexpr float EPS = 1e-6f;
constexpr int E_Q = 0, E_K = 256, E_V = 512, E_GD = 1024, E_ZA = 1056, E_FB = 1568, E_ZB = 3360;
constexpr int FB_R = 0, FB_K = 512, FB_V = 1024, FB_WD = 1536, FB_AD = 1664;
constexpr int O_QKV = 0, O_G = 1536, O_BETA = 1544, O_ZC = 1552, O_U = 2064, O_ZD = 2576;

constexpr size_t al(size_t x) { return (x + 255) & ~(size_t)255; }
constexpr size_t WS_MOD = 0;
constexpr size_t WS_WTE = WS_MOD + al((size_t)DEPTH * NCOND * 3072 * 4);
constexpr size_t WS_WTO = WS_WTE + al((size_t)N_EVEN * EWP * D * 2);
constexpr size_t WS_WTOUT = WS_WTO + al((size_t)(N_ODD ? N_ODD : 1) * OWP * D * 2);
constexpr size_t WS_WTGLU = WS_WTOUT + al((size_t)DEPTH * D * D * 2);
constexpr size_t WS_HM = WS_WTGLU + al((size_t)(N_ODD ? N_ODD : 1) * 512 * 512 * 2);
constexpr size_t WS_PROJ = WS_HM + al((size_t)T * D * 2);
constexpr size_t WS_PART = WS_PROJ + al((size_t)T * EW * 2);
constexpr size_t PART_SZ = al((size_t)T * 512 * 2);
constexpr size_t WS_BONUS = WS_PART + 4 * PART_SZ;
constexpr size_t WS_QKVN = WS_BONUS + al((size_t)T * 16 * 4);
constexpr size_t WS_GATES = WS_QKVN + al((size_t)T * 1536 * 2);
constexpr size_t WS_END = WS_GATES + al((size_t)T * 16 * 4);

constexpr size_t OUT_X = 0;
constexpr size_t OUT_GLA = (size_t)T * D;
constexpr size_t OUT_RWKV = OUT_GLA + (size_t)NB_CTX * N_EVEN * 2 * 4 * 64 * 128;
constexpr size_t OUT_GDN = OUT_RWKV + (size_t)NB_CTX * N_EVEN * 2 * 8 * 64 * 64;
constexpr size_t OUT_S5R = OUT_GDN + (size_t)NB_CTX * N_ODD * 2 * 4 * 128 * 128;
constexpr size_t OUT_S5I = OUT_S5R + (size_t)NB_CTX * N_ODD * 2 * 32 * 64;

struct P {
    const float* in[44];
    float* out;
    char* ws;
};
enum { I_XP = 0, I_XS, I_C, I_SGLA, I_SRWKV, I_SGDN, I_SS5R, I_SS5I, I_CCTX, I_WMOD, I_BMOD, I_GPRE, I_GPOST,
       I_WINE, I_WOUTE, I_GUP, I_GBIAS, I_GLAN, I_MIX, I_W0, I_W2, I_A0, I_A2, I_KK, I_KA, I_RK, I_LNG, I_LNB,
       I_WINO, I_WOUTO, I_CONV, I_ALOG, I_DTB, I_GDNN, I_S5AR, I_S5AI, I_S5DT, I_S5BR, I_S5BI, I_S5CR, I_S5CI,
       I_S5D, I_GLUW, I_GLUB };

#ifdef CPU_EMU
__device__ __forceinline__ int opaque_tid() { return (int)threadIdx.x; }
#else
__device__ __forceinline__ int opaque_tid() { int t = (int)threadIdx.x; asm volatile("" : "+v"(t)); return t; }
#endif
#define LT (opaque_tid() & 255)
__device__ __forceinline__ float u2f(unsigned u) { return __builtin_bit_cast(float, u); }
__device__ __forceinline__ unsigned f2u(float f) { return __builtin_bit_cast(unsigned, f); }
__device__ __forceinline__ float bf2f(bf16 h) { return u2f((unsigned)h << 16); }
__device__ __forceinline__ bf16 f2bf(float f) { unsigned u = f2u(f); u += 0x7fffu + ((u >> 16) & 1u); return (bf16)(u >> 16); }
__device__ __forceinline__ float sigmoidf_(float x) { return 1.0f / (1.0f + expf(-x)); }
__device__ __forceinline__ float siluf_(float x) { return x / (1.0f + expf(-x)); }
__device__ __forceinline__ float logsigf_(float x) { return fminf(x, 0.f) - log1pf(expf(-fabsf(x))); }
__device__ __forceinline__ float softplusf_(float x) { return fmaxf(x, 0.f) + log1pf(expf(-fabsf(x))); }
__device__ __forceinline__ float gelu_tanh(float x) { return 0.5f * x * (1.0f + tanhf(0.7978845608028654f * (x + 0.044715f * x * x * x))); }

struct Seq { int start, len, cond, lat, b; };
__device__ __forceinline__ Seq get_seq(int s) {
    Seq q;
    if (s < NB_CTX) { q.start = s * L_CTX; q.len = L_CTX; q.cond = 0; q.lat = 0; q.b = s; }
    else { int b = s - NB_CTX; q.start = T_CTX + b * L_LAT; q.len = L_LAT; q.cond = 1 + b; q.lat = 1; q.b = b; }
    return q;
}
__device__ __forceinline__ int tok_cond(int t) { return t < T_CTX ? 0 : 1 + (t - T_CTX) / L_LAT; }
__device__ __forceinline__ void tok_nbr(int t, bool& hl, bool& hr) {
    if (t < T_CTX) { int pos = t % L_CTX; hl = pos != 0; hr = pos != L_CTX - 1; }
    else { int pos = (t - T_CTX) & 63; hl = pos != 0; hr = pos != 63; }
}

__device__ void ph_mod(const P& p, int bid, float* smem) {
    float (*sc)[1024] = (float(*)[1024])smem;
    float (*red)[64][NCOND] = (float(*)[64][NCOND])(smem + NCOND * 1024);
    const int layer = bid / 48, ct = bid % 48;
    __syncthreads();
    const int tid = LT, cl = tid & 63, kg = tid >> 6;
    for (int i = tid; i < NCOND * 1024; i += 256) {
        int ci = i >> 10, k = i & 1023;
        float v = ci == 0 ? p.in[I_CCTX][k] : p.in[I_C][(ci - 1) * 1024 + k];
        sc[ci][k] = siluf_(v);
    }
    __syncthreads();
    float acc[NCOND];
#pragma unroll
    for (int ci = 0; ci < NCOND; ++ci) acc[ci] = 0.f;
    const float* w = p.in[I_WMOD] + (size_t)layer * 1024 * 3072 + ct * 64 + cl;
    for (int kk = 0; kk < 256; ++kk) {
        int k = kg * 256 + kk;
        float wv = w[(size_t)k * 3072];
#pragma unroll
        for (int ci = 0; ci < NCOND; ++ci) acc[ci] += sc[ci][k] * wv;
    }
#pragma unroll
    for (int ci = 0; ci < NCOND; ++ci) red[kg][cl][ci] = acc[ci];
    __syncthreads();
    if (tid < 64) {
        float* mod = (float*)(p.ws + WS_MOD);
        int col = ct * 64 + cl;
#pragma unroll
        for (int ci = 0; ci < NCOND; ++ci)
            mod[(size_t)(layer * NCOND + ci) * 3072 + col] = red[0][cl][ci] + red[1][cl][ci] + red[2][cl][ci] + red[3][cl][ci] + p.in[I_BMOD][layer * 3072 + col];
    }
}

struct WtJob { const float* src; bf16* dst; int K, N, Npad; };
__device__ __forceinline__ WtJob wt_job(const P& p, int j) {
    WtJob q;
    if (j < N_EVEN) { q.src = p.in[I_WINE] + (size_t)j * D * EW; q.dst = (bf16*)(p.ws + WS_WTE) + (size_t)j * EWP * D; q.K = D; q.N = EW; q.Npad = EWP; return q; }
    j -= N_EVEN;
    if (j < N_ODD) { q.src = p.in[I_WINO] + (size_t)j * D * OW; q.dst = (bf16*)(p.ws + WS_WTO) + (size_t)j * OWP * D; q.K = D; q.N = OW; q.Npad = OWP; return q; }
    j -= N_ODD;
    if (j < DEPTH) { int i = j >> 1; q.src = (j & 1) ? p.in[I_WOUTO] + (size_t)i * D * D : p.in[I_WOUTE] + (size_t)i * D * D; q.dst = (bf16*)(p.ws + WS_WTOUT) + (size_t)j * D * D; q.K = D; q.N = D; q.Npad = D; return q; }
    j -= DEPTH;
    q.src = p.in[I_GLUW] + (size_t)j * 512 * 512; q.dst = (bf16*)(p.ws + WS_WTGLU) + (size_t)j * 512 * 512; q.K = 512; q.N = 512; q.Npad = 512; return q;
}
constexpr int WT_NJOBS = N_EVEN + N_ODD + DEPTH + N_ODD;
constexpr int WT_TILES = N_EVEN * (EWP / 64) * 16 + N_ODD * (OWP / 64) * 16 + DEPTH * 256 + N_ODD * 64;
__device__ void ph_wt(const P& p, int bid, float* smem) {
    float (*tile)[65] = (float(*)[65])smem;
    int b = bid, j = 0;
    __syncthreads();
    WtJob q;
    for (;; ++j) { q = wt_job(p, j); int nt = (q.Npad / 64) * (q.K / 64); if (b < nt) break; b -= nt; }
    const int nk = q.K / 64, n0 = (b / nk) * 64, k0 = (b % nk) * 64;
    const int tx = LT & 63, ty = LT >> 6;
#pragma unroll
    for (int i = 0; i < 16; ++i) { int kk = ty + 4 * i, n = n0 + tx; tile[kk][tx] = n < q.N ? q.src[(size_t)(k0 + kk) * q.N + n] : 0.f; }
    __syncthreads();
#pragma unroll
    for (int i = 0; i < 16; ++i) { int nn = ty + 4 * i; q.dst[(size_t)(n0 + nn) * q.K + k0 + tx] = f2bf(tile[tx][nn]); }
}

__device__ __forceinline__ float wave_sum(float v) {
#pragma unroll
    for (int m = 1; m < 64; m <<= 1) v += __shfl_xor(v, m);
    return v;
}
__device__ __forceinline__ void hmod_row(const float* xv  , int lane, const float* gpre, const float* mod, bf16* dst) {
    float ss = 0.f;
#pragma unroll
    for (int i = 0; i < 16; ++i) ss += xv[i] * xv[i];
    ss = wave_sum(ss);
    const float r = rsqrtf(ss * (1.0f / 1024.f) + EPS);
#pragma unroll
    for (int i = 0; i < 4; ++i) {
        int idx = i * 256 + lane * 4;
        bf16 o[4];
#pragma unroll
        for (int j = 0; j < 4; ++j) o[j] = f2bf(xv[i * 4 + j] * r * gpre[idx + j] * (1.0f + mod[1024 + idx + j]) + mod[idx + j]);
        *(uint2*)(dst + idx) = make_uint2((unsigned)o[0] | ((unsigned)o[1] << 16), (unsigned)o[2] | ((unsigned)o[3] << 16));
    }
}
__device__ void ph_hmod0(const P& p, int bid) {
    const int lane = LT & 63, t = bid * 4 + (LT >> 6);
    if (t >= T) return;
    const float* xr = t < T_CTX ? p.in[I_XP] + (size_t)t * D : p.in[I_XS] + (size_t)(t - T_CTX) * D;
    float xv[16];
#pragma unroll
    for (int i = 0; i < 4; ++i) { float4 v = *(const float4*)(xr + i * 256 + lane * 4); xv[i * 4] = v.x; xv[i * 4 + 1] = v.y; xv[i * 4 + 2] = v.z; xv[i * 4 + 3] = v.w; }
    const float* mod = (const float*)(p.ws + WS_MOD) + (size_t)(0 * NCOND + tok_cond(t)) * 3072;
    hmod_row(xv, lane, p.in[I_GPRE], mod, (bf16*)(p.ws + WS_HM) + (size_t)t * D);
}
__device__ void ph_post(const P& p, int bid, int layer) {
    const int lane = LT & 63, t = bid * 4 + (LT >> 6);
    if (t >= T) return;
    const float* xr = layer == 0 ? (t < T_CTX ? p.in[I_XP] + (size_t)t * D : p.in[I_XS] + (size_t)(t - T_CTX) * D) : p.out + OUT_X + (size_t)t * D;
    const float* mr = (const float*)(p.ws + WS_PROJ) + (size_t)t * D;
    const float* mod = (const float*)(p.ws + WS_MOD) + (size_t)(layer * NCOND + tok_cond(t)) * 3072;
    const float* gpost = p.in[I_GPOST] + layer * D;
    float xv[16], mv[16];
    float ss = 0.f;
#pragma unroll
    for (int i = 0; i < 4; ++i) {
        float4 v = *(const float4*)(xr + i * 256 + lane * 4); xv[i * 4] = v.x; xv[i * 4 + 1] = v.y; xv[i * 4 + 2] = v.z; xv[i * 4 + 3] = v.w;
        float4 m = *(const float4*)(mr + i * 256 + lane * 4); mv[i * 4] = m.x; mv[i * 4 + 1] = m.y; mv[i * 4 + 2] = m.z; mv[i * 4 + 3] = m.w;
    }
#pragma unroll
    for (int i = 0; i < 16; ++i) ss += mv[i] * mv[i];
    ss = wave_sum(ss);
    const float r = rsqrtf(ss * (1.0f / 1024.f) + EPS);
    float* xo = p.out + OUT_X + (size_t)t * D;
#pragma unroll
    for (int i = 0; i < 4; ++i) {
        int idx = i * 256 + lane * 4;
#pragma unroll
        for (int j = 0; j < 4; ++j) xv[i * 4 + j] += mod[2048 + idx + j] * (mv[i * 4 + j] * r * gpost[idx + j]);
        *(float4*)(xo + idx) = make_float4(xv[i * 4], xv[i * 4 + 1], xv[i * 4 + 2], xv[i * 4 + 3]);
    }
    if (layer + 1 < DEPTH) {
        const float* mod2 = (const float*)(p.ws + WS_MOD) + (size_t)((layer + 1) * NCOND + tok_cond(t)) * 3072;
        hmod_row(xv, lane, p.in[I_GPRE] + (layer + 1) * D, mod2, (bf16*)(p.ws + WS_HM) + (size_t)t * D);
    }
}

#ifdef CPU_EMU
#define LDS_AS
#define GLDS16(gptr, lptr) memcpy((char*)(lptr) + (threadIdx.x & 63) * 16, (const void*)(gptr), 16)
#define PG_WAIT_V(n)
#define PG_WAIT_L(n)
#define PG_BAR __syncthreads()
#define PG_SCHED
#define PG_PRIO(x)
#define RFL(x) (x)
__device__ __forceinline__ unsigned cvt_pk_bf16(float lo, float hi) { return (unsigned)f2bf(lo) | ((unsigned)f2bf(hi) << 16); }
#else
#define LDS_AS __attribute__((address_space(3)))
#define GLDS16(gptr, lptr) __builtin_amdgcn_global_load_lds((const unsigned*)(gptr), (LDS_AS unsigned*)(lptr), 16, 0, 0)
#define PG_WAIT_V(n) asm volatile("s_waitcnt vmcnt(" #n ")" ::: "memory")
#define PG_WAIT_L(n) asm volatile("s_waitcnt lgkmcnt(" #n ")" ::: "memory")
#define PG_BAR __builtin_amdgcn_s_barrier()
#define PG_SCHED __builtin_amdgcn_sched_barrier(0)
#define PG_PRIO(x) __builtin_amdgcn_s_setprio(x)
#define RFL(x) __builtin_amdgcn_readfirstlane(x)
__device__ __forceinline__ unsigned cvt_pk_bf16(float lo, float hi) { unsigned r; asm volatile("v_cvt_pk_bf16_f32 %0, %1, %2" : "=v"(r) : "v"(lo), "v"(hi)); return r; }
#endif
namespace pg8 {
constexpr int BM = 256, BK = 64, HALF = 128, HTB = HALF * BK * 2, STAGE_BYTES = 8 * HTB, NXCD = 8, WGM = 8;
__host__ __device__ __forceinline__ int lds_byte(int r, int c) { const int st = (r >> 4) * 2 + (c >> 5), rr = r & 15, cc = c & 31, ob = rr * 64 + cc * 2; return st * 1024 + (ob ^ (((ob >> 9) & 1) << 5)); }
__host__ __device__ __forceinline__ void stage_rc(int b, int& R, int& C) { const int st = b / 1024, sb = b % 1024, swz = sb ^ (((sb >> 9) & 1) << 5); R = (st >> 1) * 16 + swz / 64; C = (st & 1) * 32 + (swz % 64) / 2; }
__host__ __device__ __forceinline__ int perm32(int rho) { const int n = rho >> 4, i = rho & 15; return 8 * (i >> 2) + 4 * n + (i & 3); }
struct Unit { int pm, pn; };
struct Gemm { const bf16* A; const bf16* Bt; int M, N, K, lda; };
struct StaticOrder {
    int nM, nN, nwg, G, c;
    __host__ __device__ void init(int M, int N, int G_, int c_) { nM = M / BM; nN = N / BM; nwg = nM * nN; G = G_; c = c_; }
    __host__ __device__ bool next(int i, Unit& u) const {
        const long L = (long)i * G + c; if (L >= nwg) return false;
        int wgid = (int)L; { const int q = nwg / NXCD, r = nwg % NXCD, xcd = wgid % NXCD, off = wgid / NXCD; wgid = (xcd < r ? xcd * (q + 1) : r * (q + 1) + (xcd - r) * q) + off; }
        const int nig = WGM * nN, gid = wgid / nig, fm = gid * WGM, gsz = (nM - fm) < WGM ? (nM - fm) : WGM;
        u.pm = fm + ((wgid % nig) % gsz); u.pn = (wgid % nig) / gsz; return true;
    }
};
struct EpiF32 {
    static constexpr bool PERM = false;
    float* C; int ldc;
    __device__ __forceinline__ void operator()(const f4v (&acc)[2][2][4][2], const Unit& u, int wr, int wc, int fr, int fq) const {
        const int row0 = u.pm * BM + wr * 64 + fr, col0 = u.pn * BM + wc * 32 + 4 * fq;
#pragma unroll
        for (int ai = 0; ai < 2; ++ai)
#pragma unroll
            for (int m = 0; m < 4; ++m) { float* rowp = C + (size_t)(row0 + ai * HALF + m * 16) * ldc + col0;
#pragma unroll
                for (int bj = 0; bj < 2; ++bj)
#pragma unroll
                    for (int n = 0; n < 2; ++n) *(f4v*)(rowp + bj * HALF + n * 16) = acc[ai][bj][m][n]; }
    }
};
struct EpiBf16 {
    static constexpr bool PERM = true;
    bf16* O; int ldc; int N;
    __device__ __forceinline__ void operator()(const f4v (&acc)[2][2][4][2], const Unit& u, int wr, int wc, int fr, int fq) const {
        const int row0 = u.pm * BM + wr * 64 + fr, col0 = u.pn * BM + wc * 32 + 8 * fq;
#pragma unroll
        for (int ai = 0; ai < 2; ++ai)
#pragma unroll
            for (int m = 0; m < 4; ++m) { bf16* rowp = O + (size_t)(row0 + ai * HALF + m * 16) * ldc + col0;
#pragma unroll
                for (int bj = 0; bj < 2; ++bj) { const f4v v0 = acc[ai][bj][m][0], v1 = acc[ai][bj][m][1];
                    if (col0 + bj * HALF < N) *(uint4*)(rowp + bj * HALF) = make_uint4(cvt_pk_bf16(v0[0], v0[1]), cvt_pk_bf16(v0[2], v0[3]), cvt_pk_bf16(v1[0], v1[1]), cvt_pk_bf16(v1[2], v1[3])); } }
    }
};
template <class Epi>
__device__ __forceinline__ void gemm_phase(LDS_AS unsigned char* lds, const Gemm g, const StaticOrder& S, const Epi& E) {
    const int tid = opaque_tid(), wid = RFL(tid >> 6), lane = tid & 63, wr = wid >> 2, wc = wid & 3, fr = lane & 15, fq = lane >> 4;
    const int K = g.K, nt = K / BK;
    unsigned voffA[2], voffB[2];
#pragma unroll
    for (int i = 0; i < 2; ++i) { int R, C; stage_rc(tid * 16 + i * 8192, R, C); const int Rb = Epi::PERM ? ((R & ~31) + perm32(R & 31)) : R;
        voffA[i] = (unsigned)(R * g.lda + C) * 2u; voffB[i] = (unsigned)(Rb * K + C) * 2u; }
    const size_t kstep = (size_t)(BK * 2);
    const size_t hstepA = (size_t)HALF * g.lda * 2, hstepB = (size_t)HALF * K * 2;
    const size_t tstepA = 2 * hstepA, tstepB = 2 * hstepB;
    const unsigned ldsw = (unsigned)wid * 1024u;
    const int aoff = lds_byte(wr * 64 + fr, fq * 8), boff = lds_byte(wc * 32 + fr, fq * 8);
#define PG8_SA(b, h) (((b) * 2 + (h)) * HTB)
#define PG8_SB(b, h) ((4 + (b) * 2 + (h)) * HTB)
#define PG8_STAGE(bufoff, gbase, voff) do { _Pragma("unroll") for (int _i = 0; _i < 2; ++_i) GLDS16((const char*)(gbase) + (voff)[_i], lds + (bufoff) + ldsw + _i * 8192); } while (0)
#define PG8_LDA(dst, b, h) do { _Pragma("unroll") for (int m = 0; m < 4; ++m) _Pragma("unroll") for (int k = 0; k < 2; ++k) dst[m][k] = *(const LDS_AS s8v*)(lds + PG8_SA(b, h) + aoff + m * 2048 + k * 1024); } while (0)
#define PG8_LDB(dst, b, h) do { _Pragma("unroll") for (int n = 0; n < 2; ++n) _Pragma("unroll") for (int k = 0; k < 2; ++k) dst[n][k] = *(const LDS_AS s8v*)(lds + PG8_SB(b, h) + boff + n * 2048 + k * 1024); } while (0)
#define PG8_MMA(ai, bj, At, Bt) do { PG_PRIO(1); _Pragma("unroll") for (int m = 0; m < 4; ++m) _Pragma("unroll") for (int n = 0; n < 2; ++n) _Pragma("unroll") for (int k = 0; k < 2; ++k) \
        acc[ai][bj][m][n] = __builtin_amdgcn_mfma_f32_16x16x32_bf16(Bt[n][k], At[m][k], acc[ai][bj][m][n], 0, 0, 0); PG_PRIO(0); } while (0)
    Unit cur, nxt; int ui = 0;
    if (!S.next(0, cur)) return;
    f4v acc[2][2][4][2];
#pragma unroll
    for (int a = 0; a < 2; ++a)
#pragma unroll
        for (int b = 0; b < 2; ++b)
#pragma unroll
            for (int m = 0; m < 4; ++m)
#pragma unroll
                for (int n = 0; n < 2; ++n) acc[a][b][m][n] = (f4v){0.f, 0.f, 0.f, 0.f};
    s8v At[4][2], B0[2][2], B1[2][2];
    const char* cA = (const char*)g.A + (size_t)cur.pm * tstepA; const char* cB = (const char*)g.Bt + (size_t)cur.pn * tstepB;
    PG8_STAGE(PG8_SB(0, 0), cB, voffB); PG8_STAGE(PG8_SA(0, 0), cA, voffA); PG8_STAGE(PG8_SB(0, 1), cB + hstepB, voffB); PG8_STAGE(PG8_SA(0, 1), cA + hstepA, voffA);
    if (wr == 1) PG_BAR;
    PG_WAIT_V(4); PG_BAR;
    PG8_STAGE(PG8_SB(1, 0), cB + kstep, voffB); PG8_STAGE(PG8_SA(1, 0), cA + kstep, voffA); PG8_STAGE(PG8_SB(1, 1), cB + hstepB + kstep, voffB);
    PG_WAIT_V(6); PG_BAR;
    for (;;) {
        const bool has_next = S.next(ui + 1, nxt);
        const char* nA = has_next ? (const char*)g.A + (size_t)nxt.pm * tstepA : cA; const char* nB = has_next ? (const char*)g.Bt + (size_t)nxt.pn * tstepB : cB;
        for (int t = 0; t < nt; t += 2) {
            const bool last = (t == nt - 2);
            const char* a1 = cA + (size_t)(t + 1) * kstep;
            const char* a2 = last ? nA : cA + (size_t)(t + 2) * kstep; const char* b2 = last ? nB : cB + (size_t)(t + 2) * kstep;
            const char* a3 = a2 + kstep; const char* b3 = b2 + kstep;
            PG8_LDB(B0, 0, 0); PG_SCHED; PG8_LDA(At, 0, 0); PG8_STAGE(PG8_SA(1, 1), a1 + hstepA, voffA);
            PG_WAIT_L(8); PG_BAR; PG_WAIT_L(0); PG8_MMA(0, 0, At, B0); PG_BAR; PG_SCHED;
            PG8_LDB(B1, 0, 1); PG8_STAGE(PG8_SB(0, 0), b2, voffB);
            PG_BAR; PG_WAIT_L(0); PG8_MMA(0, 1, At, B1); PG_BAR;
            PG8_LDA(At, 0, 1); PG8_STAGE(PG8_SA(0, 0), a2, voffA);
            PG_BAR; PG_WAIT_L(0); PG8_MMA(1, 0, At, B0); PG_BAR; PG_SCHED;
            PG8_STAGE(PG8_SB(0, 1), b2 + hstepB, voffB);
            PG_WAIT_V(6); PG_BAR; PG8_MMA(1, 1, At, B1); PG_BAR;
            PG8_LDB(B0, 1, 0); PG_SCHED; PG8_LDA(At, 1, 0); PG8_STAGE(PG8_SA(0, 1), a2 + hstepA, voffA);
            PG_WAIT_L(8); PG_BAR; PG_WAIT_L(0); PG8_MMA(0, 0, At, B0); PG_BAR; PG_SCHED;
            PG8_LDB(B1, 1, 1); PG8_STAGE(PG8_SB(1, 0), b3, voffB);
            PG_BAR; PG_WAIT_L(0); PG8_MMA(0, 1, At, B1); PG_BAR;
            PG8_LDA(At, 1, 1); PG8_STAGE(PG8_SA(1, 0), a3, voffA);
            PG_BAR; PG_WAIT_L(0); PG8_MMA(1, 0, At, B0); PG_BAR; PG_SCHED;
            PG8_STAGE(PG8_SB(1, 1), b3 + hstepB, voffB);
            PG_WAIT_V(6); PG_BAR; PG8_MMA(1, 1, At, B1); PG_BAR;
        }
        E(acc, cur, wr, wc, fr, fq);
        if (!has_next) break;
#pragma unroll
        for (int a = 0; a < 2; ++a)
#pragma unroll
            for (int b = 0; b < 2; ++b)
#pragma unroll
                for (int m = 0; m < 4; ++m)
#pragma unroll
                    for (int n = 0; n < 2; ++n) acc[a][b][m][n] = (f4v){0.f, 0.f, 0.f, 0.f};
        cur = nxt; cA = nA; cB = nB; ++ui;
    }
    PG_WAIT_V(0);
    if (wr == 0) PG_BAR;
    PG_BAR;
}
}

constexpr int TC = 32;
__device__ void gla_scan_task(const P& p, int ei, int s, int h, int dir, float* smem) {
    float (*sq)[64] = (float(*)[64])smem;
    float (*sk)[64] = (float(*)[64])(smem + TC * 64);
    float (*sa)[64] = (float(*)[64])(smem + 2 * TC * 64);
    float (*sv)[128] = (float(*)[128])(smem + 3 * TC * 64);
    float (*sgd)[16] = (float(*)[16])(smem + 3 * TC * 64 + TC * 128);
    const Seq sq_ = get_seq(s);
    const int tid = LT, v = tid >> 1, dh = tid & 1;
    const bf16* proj = (const bf16*)(p.ws + WS_PROJ);
    bf16* opart = (bf16*)(p.ws + WS_PART + (size_t)dir * PART_SZ);
    const float* gup = p.in[I_GUP] + (size_t)(ei * 2 + dir) * 16 * 256 + h * 64;
    const float* gbias = p.in[I_GBIAS] + (size_t)(ei * 2 + dir) * 256 + h * 64;
    float S[32];
    if (sq_.lat) {
        const float* s0 = p.in[I_SGLA] + ((((size_t)sq_.b * N_EVEN + ei) * 2 + dir) * 4 + h) * 64 * 128;
#pragma unroll
        for (int d = 0; d < 32; ++d) S[d] = s0[(dh * 32 + d) * 128 + v];
    } else {
#pragma unroll
        for (int d = 0; d < 32; ++d) S[d] = 0.f;
    }
    for (int c0 = 0; c0 < sq_.len; c0 += TC) {
        __syncthreads();
        for (int e = tid; e < TC * 64; e += 256) {
            int i = e >> 6, d = e & 63, pos = c0 + i, t = sq_.start + (dir ? sq_.len - 1 - pos : pos);
            const bf16* pr = proj + (size_t)t * EW;
            sq[i][d] = bf2f(pr[E_Q + h * 64 + d]) * 0.125f;
            sk[i][d] = bf2f(pr[E_K + h * 64 + d]);
        }
        for (int e = tid; e < TC * 128; e += 256) {
            int i = e >> 7, d = e & 127, pos = c0 + i, t = sq_.start + (dir ? sq_.len - 1 - pos : pos);
            sv[i][d] = bf2f(proj[(size_t)t * EW + E_V + h * 128 + d]);
        }
        for (int e = tid; e < TC * 16; e += 256) {
            int i = e >> 4, r = e & 15, pos = c0 + i, t = sq_.start + (dir ? sq_.len - 1 - pos : pos);
            sgd[i][r] = bf2f(proj[(size_t)t * EW + E_GD + dir * 16 + r]);
        }
        __syncthreads();
        for (int e = tid; e < TC * 64; e += 256) {
            int i = e >> 6, d = e & 63;
            float x = gbias[d];
#pragma unroll
            for (int r = 0; r < 16; ++r) x += sgd[i][r] * gup[r * 256 + d];
            sa[i][d] = expf(logsigf_(x) * (1.0f / 16.0f));
        }
        __syncthreads();
        for (int i = 0; i < TC; ++i) {
            const float vv = sv[i][v];
            float o = 0.f;
#pragma unroll
            for (int d = 0; d < 32; ++d) {
                S[d] = sa[i][dh * 32 + d] * S[d] + sk[i][dh * 32 + d] * vv;
                o += sq[i][dh * 32 + d] * S[d];
            }
            o += __shfl_xor(o, 1);
            if (dh == 0) { int pos = c0 + i, t = sq_.start + (dir ? sq_.len - 1 - pos : pos); opart[(size_t)t * 512 + h * 128 + v] = f2bf(o); }
        }
    }
    if (!sq_.lat) {
        float* fs = p.out + OUT_GLA + ((((size_t)sq_.b * N_EVEN + ei) * 2 + dir) * 4 + h) * 64 * 128;
#pragma unroll
        for (int d = 0; d < 32; ++d) fs[(dh * 32 + d) * 128 + v] = S[d];
    }
}

__device__ void rwkv_scan_task(const P& p, int ei, int s, int h, int dir, float* smem) {
    float (*sW)[64] = (float(*)[64])smem;
    float (*sKK)[64] = (float(*)[64])(smem + 1 * TC * 64);
    float (*sKA)[64] = (float(*)[64])(smem + 2 * TC * 64);
    float (*sKM)[64] = (float(*)[64])(smem + 3 * TC * 64);
    float (*sR)[64] = (float(*)[64])(smem + 4 * TC * 64);
    float (*sV)[64] = (float(*)[64])(smem + 5 * TC * 64);
    float (*sTW)[64] = (float(*)[64])(smem + 6 * TC * 64);
    float (*sAD)[64] = (float(*)[64])(smem + 7 * TC * 64);
    const Seq sq_ = get_seq(s);
    const int tid = LT, row = tid >> 2, kq = tid & 3;
    const bf16* proj = (const bf16*)(p.ws + WS_PROJ);
    bf16* opart = (bf16*)(p.ws + WS_PART + (size_t)(2 + dir) * PART_SZ);
    float* bonus = (float*)(p.ws + WS_BONUS);
    const float* mix = p.in[I_MIX] + (size_t)ei * 1792;
    const int hc0 = h * 64;
    const float* w0 = p.in[I_W0] + (size_t)(ei * 2 + dir) * 512 + hc0;
    const float* w2 = p.in[I_W2] + (size_t)(ei * 2 + dir) * 64 * 512 + hc0;
    const float* a0 = p.in[I_A0] + (size_t)(ei * 2 + dir) * 512 + hc0;
    const float* a2 = p.in[I_A2] + (size_t)(ei * 2 + dir) * 64 * 512 + hc0;
    const float* kkw = p.in[I_KK] + (size_t)ei * 512 + hc0;
    const float* kaw = p.in[I_KA] + (size_t)ei * 512 + hc0;
    const float* rkw = p.in[I_RK] + (size_t)ei * 512 + hc0;
    float S[16];
    if (sq_.lat) {
        const float* s0 = p.in[I_SRWKV] + ((((size_t)sq_.b * N_EVEN + ei) * 2 + dir) * 8 + h) * 64 * 64;
#pragma unroll
        for (int k = 0; k < 16; ++k) S[k] = s0[row * 64 + kq * 16 + k];
    } else {
#pragma unroll
        for (int k = 0; k < 16; ++k) S[k] = 0.f;
    }
    for (int c0 = 0; c0 < sq_.len; c0 += TC) {
        __syncthreads();
        for (int e = tid; e < TC * 64 * 5; e += 256) {
            int which = e / (TC * 64), rem = e % (TC * 64), i = rem >> 6, c = rem & 63;
            int pos = c0 + i, t = sq_.start + (dir ? sq_.len - 1 - pos : pos);
            int col = which == 0 ? FB_R + hc0 + c : which == 1 ? FB_K + hc0 + c : which == 2 ? FB_V + hc0 + c : which == 3 ? FB_WD + dir * 64 + c : FB_AD + dir * 64 + c;
            bool hl, hr; tok_nbr(t, hl, hr);
            const bf16* pr = proj + (size_t)t * EW + E_FB + col;
            float x = bf2f(pr[0]);
            float nl = hl ? bf2f(pr[-EW]) : 0.f, nr = hr ? bf2f(pr[EW]) : 0.f;
            float y = x + mix[col] * (0.5f * (nl + nr) - x);
            if (which == 0) sR[i][c] = y; else if (which == 1) sKM[i][c] = y; else if (which == 2) sV[i][c] = y; else if (which == 3) sTW[i][c] = tanhf(y); else sAD[i][c] = y;
        }
        __syncthreads();
        {
            const int c = tid & 63, ig = tid >> 6;
            float aw[TC / 4], aa[TC / 4];
#pragma unroll
            for (int j = 0; j < TC / 4; ++j) { aw[j] = w0[c]; aa[j] = a0[c]; }
            for (int r = 0; r < 64; ++r) {
                const float w2v = w2[(size_t)r * 512 + c], a2v = a2[(size_t)r * 512 + c];
#pragma unroll
                for (int j = 0; j < TC / 4; ++j) { aw[j] += sTW[ig * (TC / 4) + j][r] * w2v; aa[j] += sAD[ig * (TC / 4) + j][r] * a2v; }
            }
            const float kkc = kkw[c], kac = kaw[c], rkc = rkw[c];
#pragma unroll
            for (int j = 0; j < TC / 4; ++j) {
                const int i = ig * (TC / 4) + j;
                const float dec = expf(-0.6065306597126334f * sigmoidf_(aw[j]));
                const float av = sigmoidf_(aa[j]);
                const float kraw = sKM[i][c];
                const float km = kraw * (1.0f + (av - 1.0f) * kac);
                float kkv = kraw * kkc;
                const float nrm = rsqrtf(wave_sum(kkv * kkv) + EPS);
                kkv *= nrm;
                const float bn = wave_sum(sR[i][c] * km * rkc);
                sW[i][c] = dec; sKM[i][c] = km; sKK[i][c] = kkv; sKA[i][c] = kkv * av;
                if (c == 0) { int pos = c0 + i, t = sq_.start + (dir ? sq_.len - 1 - pos : pos); bonus[((size_t)t * 8 + h) * 2 + dir] = bn; }
            }
        }
        __syncthreads();
        for (int i = 0; i < TC; ++i) {
            float sa = 0.f;
#pragma unroll
            for (int k = 0; k < 16; ++k) sa -= S[k] * sKK[i][kq * 16 + k];
            sa += __shfl_xor(sa, 1); sa += __shfl_xor(sa, 2);
            const float vv = sV[i][row];
            float y = 0.f;
#pragma unroll
            for (int k = 0; k < 16; ++k) {
                S[k] = S[k] * sW[i][kq * 16 + k] + sa * sKA[i][kq * 16 + k] + vv * sKM[i][kq * 16 + k];
                y += S[k] * sR[i][kq * 16 + k];
            }
            y += __shfl_xor(y, 1); y += __shfl_xor(y, 2);
            if (kq == 0) { int pos = c0 + i, t = sq_.start + (dir ? sq_.len - 1 - pos : pos); opart[(size_t)t * 512 + hc0 + row] = f2bf(y); }
        }
    }
    if (!sq_.lat) {
        float* fs = p.out + OUT_RWKV + ((((size_t)sq_.b * N_EVEN + ei) * 2 + dir) * 8 + h) * 64 * 64;
#pragma unroll
        for (int k = 0; k < 16; ++k) fs[row * 64 + kq * 16 + k] = S[k];
    }
}
constexpr int EVEN_SCAN_BLOCKS = NSEQ * 8 * 2 + NSEQ * 4 * 2;
__device__ void ph_even_scan(const P& p, int bid, int ei, float* smem) {
    int b = bid;
    const int nlr = NB_LAT * 16, nlg = NB_LAT * 8, ncr = NB_CTX * 16;
    if (b < nlr) { rwkv_scan_task(p, ei, NB_CTX + b / 16, (b % 16) >> 1, b & 1, smem); return; }
    b -= nlr;
    if (b < nlg) { gla_scan_task(p, ei, NB_CTX + b / 8, (b % 8) >> 1, b & 1, smem); return; }
    b -= nlg;
    if (b < ncr) { rwkv_scan_task(p, ei, b / 16, (b % 16) >> 1, b & 1, smem); return; }
    b -= ncr;
    gla_scan_task(p, ei, b / 8, (b % 8) >> 1, b & 1, smem);
}

__device__ void ph_fin_even(const P& p, int bid, int ei) {
    const int lane = LT & 63, t = bid * 4 + (LT >> 6);
    if (t >= T) return;
    const bf16* pr = (const bf16*)(p.ws + WS_PROJ) + (size_t)t * EW;
    const bf16* oaf = (const bf16*)(p.ws + WS_PART) + (size_t)t * 512;
    const bf16* oab = (const bf16*)(p.ws + WS_PART + PART_SZ) + (size_t)t * 512;
    const bf16* obf = (const bf16*)(p.ws + WS_PART + 2 * PART_SZ) + (size_t)t * 512;
    const bf16* obb = (const bf16*)(p.ws + WS_PART + 3 * PART_SZ) + (size_t)t * 512;
    bf16* yc = (bf16*)(p.ws + WS_HM) + (size_t)t * D;
    const int idx = lane * 8;
    {
        float o[8], ss = 0.f;
#pragma unroll
        for (int j = 0; j < 8; ++j) { o[j] = bf2f(oaf[idx + j]) + bf2f(oab[idx + j]); ss += o[j] * o[j]; }
        ss += __shfl_xor(ss, 1); ss += __shfl_xor(ss, 2); ss += __shfl_xor(ss, 4); ss += __shfl_xor(ss, 8);
        const float r = rsqrtf(ss * (1.0f / 128.f) + EPS);
        const float* gn = p.in[I_GLAN] + ei * 128 + (idx & 127);
#pragma unroll
        for (int j = 0; j < 8; ++j) yc[idx + j] = f2bf(o[j] * r * gn[j] * siluf_(bf2f(pr[E_ZA + idx + j])));
    }
    {
        float o[8], mu = 0.f;
#pragma unroll
        for (int j = 0; j < 8; ++j) { o[j] = bf2f(obf[idx + j]) + bf2f(obb[idx + j]); mu += o[j]; }
        mu += __shfl_xor(mu, 1); mu += __shfl_xor(mu, 2); mu += __shfl_xor(mu, 4);
        mu *= (1.0f / 64.f);
        float var = 0.f;
#pragma unroll
        for (int j = 0; j < 8; ++j) { o[j] -= mu; var += o[j] * o[j]; }
        var += __shfl_xor(var, 1); var += __shfl_xor(var, 2); var += __shfl_xor(var, 4);
        const float r = rsqrtf(var * (1.0f / 64.f) + 64e-5f);
        const int h = idx >> 6;
        const float* bn = (const float*)(p.ws + WS_BONUS) + ((size_t)t * 8 + h) * 2;
        const float bsum = bn[0] + bn[1];
        bool hl, hr; tok_nbr(t, hl, hr);
        const float* mix = p.in[I_MIX] + (size_t)ei * 1792 + FB_V + idx;
        const float* lg = p.in[I_LNG] + ei * 512 + idx;
        const float* lb = p.in[I_LNB] + ei * 512 + idx;
#pragma unroll
        for (int j = 0; j < 8; ++j) {
            const bf16* pv = pr + E_FB + FB_V + idx + j;
            const float x = bf2f(pv[0]);
            const float nl = hl ? bf2f(pv[-EW]) : 0.f, nr = hr ? bf2f(pv[EW]) : 0.f;
            const float vsh = x + mix[j] * (0.5f * (nl + nr) - x);
            yc[512 + idx + j] = f2bf((o[j] * r * lg[j] + lb[j] + bsum * vsh) * siluf_(bf2f(pr[E_ZB + idx + j])));
        }
    }
}

__device__ void ph_odd_prep(const P& p, int bid, int oi) {
    const int lane = LT & 63, t = bid * 4 + (LT >> 6);
    if (t >= T) return;
    const bf16* proj = (const bf16*)(p.ws + WS_PROJ);
    const float* cw = p.in[I_CONV] + (size_t)oi * 9 * 1536;
    bf16* qo = (bf16*)(p.ws + WS_QKVN) + (size_t)t * 1536;
    const bool lat = t >= T_CTX;
    int pos, len;
    if (!lat) { pos = t % L_CTX; len = L_CTX; } else { pos = (t - T_CTX) % L_LAT; len = L_LAT; }
    const int gr = pos >> 6, gc = pos & 63, nrows = len >> 6;
#pragma unroll
    for (int part = 0; part < 3; ++part) {
        const int ch = part * 512 + lane * 8;
        float acc[8];
#pragma unroll
        for (int j = 0; j < 8; ++j) acc[j] = 0.f;
        for (int di = (lat ? -1 : 0); di <= (lat ? 1 : 0); ++di)
            for (int dj = -1; dj <= 1; ++dj) {
                bool ok;
                if (lat) ok = (gr + di >= 0) && (gr + di < nrows) && (gc + dj >= 0) && (gc + dj < 64);
                else ok = (pos + dj >= 0) && (pos + dj < len);
                if (!ok) continue;
                const bf16* src = proj + (size_t)(t + di * 64 + dj) * OW + O_QKV + ch;
                const float* w = cw + ((di + 1) * 3 + (dj + 1)) * 1536 + ch;
#pragma unroll
                for (int j = 0; j < 8; ++j) acc[j] += bf2f(src[j]) * w[j];
            }
        float ss = 0.f;
#pragma unroll
        for (int j = 0; j < 8; ++j) { acc[j] = siluf_(acc[j]); ss += acc[j] * acc[j]; }
        if (part < 2) {
            ss += __shfl_xor(ss, 1); ss += __shfl_xor(ss, 2); ss += __shfl_xor(ss, 4); ss += __shfl_xor(ss, 8);
            float r = rsqrtf(ss + EPS);
            if (part == 0) r *= 0.08838834764831845f;
#pragma unroll
            for (int j = 0; j < 8; ++j) acc[j] *= r;
        }
#pragma unroll
        for (int j = 0; j < 8; ++j) qo[ch + j] = f2bf(acc[j]);
    }
    if (lane < 16) {
        float* g = (float*)(p.ws + WS_GATES) + (size_t)t * 16;
        const float x = bf2f(proj[(size_t)t * OW + O_G + lane]);
        if (lane < 8) {
            const float lgv = -expf(p.in[I_ALOG][oi * 8 + lane]) * softplusf_(x + p.in[I_DTB][oi * 8 + lane]);
            g[lane] = expf(lgv);
        } else g[lane] = sigmoidf_(x);
    }
}
__device__ void gdn_scan_task(const P& p, int oi, int s, int h, int dir, float* smem) {
    float (*sq)[128] = (float(*)[128])smem;
    float (*sk)[128] = (float(*)[128])(smem + TC * 128);
    float (*sv)[128] = (float(*)[128])(smem + 2 * TC * 128);
    float* sg = smem + 3 * TC * 128;
    float* sb = sg + TC;
    const Seq sq_ = get_seq(s);
    const int tid = opaque_tid(), v = tid >> 2, dq = tid & 3;
    const bf16* qkvn = (const bf16*)(p.ws + WS_QKVN);
    const float* gates = (const float*)(p.ws + WS_GATES);
    bf16* opart = (bf16*)(p.ws + WS_PART + (size_t)dir * PART_SZ);
    float S[32];
    if (sq_.lat) {
        const float* s0 = p.in[I_SGDN] + ((((size_t)sq_.b * N_ODD + oi) * 2 + dir) * 4 + h) * 128 * 128;
#pragma unroll
        for (int d = 0; d < 32; ++d) S[d] = s0[(dq * 32 + d) * 128 + v];
    } else {
#pragma unroll
        for (int d = 0; d < 32; ++d) S[d] = 0.f;
    }
    for (int c0 = 0; c0 < sq_.len; c0 += TC) {
        __syncthreads();
        for (int e = tid; e < TC * 128; e += 512) {
            int i = e >> 7, d = e & 127, pos = c0 + i, t = sq_.start + (dir ? sq_.len - 1 - pos : pos);
            const bf16* src = qkvn + (size_t)t * 1536 + h * 128 + d;
            sq[i][d] = bf2f(src[0]); sk[i][d] = bf2f(src[512]); sv[i][d] = bf2f(src[1024]);
        }
        if (tid < TC) {
            int pos = c0 + tid, t = sq_.start + (dir ? sq_.len - 1 - pos : pos);
            sg[tid] = gates[(size_t)t * 16 + dir * 4 + h]; sb[tid] = gates[(size_t)t * 16 + 8 + dir * 4 + h];
        }
        __syncthreads();
        for (int i = 0; i < TC; ++i) {
            float ks = 0.f;
#pragma unroll
            for (int d = 0; d < 32; ++d) ks += sk[i][dq * 32 + d] * S[d];
            ks += __shfl_xor(ks, 1); ks += __shfl_xor(ks, 2);
            const float g = sg[i];
            const float cc = sb[i] * (sv[i][v] - g * ks);
            float o = 0.f;
#pragma unroll
            for (int d = 0; d < 32; ++d) {
                S[d] = g * S[d] + sk[i][dq * 32 + d] * cc;
                o += sq[i][dq * 32 + d] * S[d];
            }
            o += __shfl_xor(o, 1); o += __shfl_xor(o, 2);
            if (dq == 0) { int pos = c0 + i, t = sq_.start + (dir ? sq_.len - 1 - pos : pos); opart[(size_t)t * 512 + h * 128 + v] = f2bf(o); }
        }
    }
    if (!sq_.lat) {
        float* fs = p.out + OUT_GDN + ((((size_t)sq_.b * N_ODD + oi) * 2 + dir) * 4 + h) * 128 * 128;
#pragma unroll
        for (int d = 0; d < 32; ++d) fs[(dq * 32 + d) * 128 + v] = S[d];
    }
}
constexpr int TS = 8;
__device__ void s5_scan_task(const P& p, int oi, int s, int dir, int g4, float* smem) {
    const int tid = LT, w = tid >> 6, lane = tid & 63, g = g4 * 4 + w;
    float* base = smem + w * (2 * TS * 64 + TS * 16 + 2 * 16 * 64);
    float (*hre)[64] = (float(*)[64])base;
    float (*him)[64] = (float(*)[64])(base + TS * 64);
    float (*su)[16] = (float(*)[16])(base + 2 * TS * 64);
    float (*cre)[64] = (float(*)[64])(base + 2 * TS * 64 + TS * 16);
    float (*cim)[64] = (float(*)[64])(base + 2 * TS * 64 + TS * 16 + 16 * 64);
    const Seq sq_ = get_seq(s);
    const bf16* proj = (const bf16*)(p.ws + WS_PROJ);
    bf16* ypart = (bf16*)(p.ws + WS_PART + (size_t)(2 + dir) * PART_SZ);
    const size_t pg = ((size_t)(oi * 2 + dir) * 32 + g);
    float are = fminf(p.in[I_S5AR][pg * 64 + lane], -1e-4f), aim = p.in[I_S5AI][pg * 64 + lane];
    const float dt = expf(p.in[I_S5DT][pg]);
    const float mag = expf(are * dt);
    const float abr = mag * cosf(aim * dt), abi = mag * sinf(aim * dt);
    const float den = are * are + aim * aim;
    const float fre = ((abr - 1.0f) * are + abi * aim) / den, fim = (abi * are - (abr - 1.0f) * aim) / den;
    float bbr[16], bbi[16];
#pragma unroll
    for (int c = 0; c < 16; ++c) {
        const float br = p.in[I_S5BR][(pg * 64 + lane) * 16 + c], bi = p.in[I_S5BI][(pg * 64 + lane) * 16 + c];
        bbr[c] = fre * br - fim * bi; bbi[c] = fre * bi + fim * br;
    }
    __syncthreads();
    for (int e = lane; e < 16 * 64; e += 64) { cre[e >> 6][e & 63] = p.in[I_S5CR][pg * 1024 + e]; cim[e >> 6][e & 63] = p.in[I_S5CI][pg * 1024 + e]; }
    float hr = 0.f, hi = 0.f;
    if (sq_.lat) { const size_t o = (((size_t)sq_.b * N_ODD + oi) * 2 + dir) * 32 * 64 + g * 64 + lane; hr = p.in[I_SS5R][o]; hi = p.in[I_SS5I][o]; }
    for (int c0 = 0; c0 < sq_.len; c0 += TS) {
        __syncthreads();
        for (int e = lane; e < TS * 16; e += 64) {
            int i = e >> 4, c = e & 15, pos = c0 + i, t = sq_.start + (dir ? sq_.len - 1 - pos : pos);
            su[i][c] = bf2f(proj[(size_t)t * OW + O_U + g * 16 + c]);
        }
        __syncthreads();
        for (int i = 0; i < TS; ++i) {
            float br = 0.f, bi = 0.f;
#pragma unroll
            for (int c = 0; c < 16; ++c) { br += bbr[c] * su[i][c]; bi += bbi[c] * su[i][c]; }
            const float nr = abr * hr - abi * hi + br, ni = abr * hi + abi * hr + bi;
            hr = nr; hi = ni;
            hre[i][lane] = hr; him[i][lane] = hi;
        }
        __syncthreads();
        {
            const int c = lane & 15;
#pragma unroll
            for (int j = 0; j < TS / 4; ++j) {
                const int i = (lane >> 4) + 4 * j;
                float y = 0.f;
                for (int q = 0; q < 64; ++q) y += cre[c][q] * hre[i][q] - cim[c][q] * him[i][q];
                int pos = c0 + i, t = sq_.start + (dir ? sq_.len - 1 - pos : pos);
                ypart[(size_t)t * 512 + g * 16 + c] = f2bf(y);
            }
        }
    }
    if (!sq_.lat) {
        const size_t o = (((size_t)sq_.b * N_ODD + oi) * 2 + dir) * 32 * 64 + g * 64 + lane;
        p.out[OUT_S5R + o] = hr; p.out[OUT_S5I + o] = hi;
    }
}
constexpr int ODD_GDN_ITEMS = NSEQ * 8, ODD_S5_VB = NSEQ * 16;
constexpr int ODD_SCAN_ITEMS = ODD_GDN_ITEMS + ODD_S5_VB / 2;
__device__ void ph_odd_scan_item(const P& p, int w, int oi, float* smem_full) {
    if (w < ODD_GDN_ITEMS) {
        const int nl = NB_LAT * 8;
        if (w < nl) gdn_scan_task(p, oi, NB_CTX + w / 8, (w % 8) >> 1, w & 1, smem_full);
        else { w -= nl; gdn_scan_task(p, oi, w / 8, (w % 8) >> 1, w & 1, smem_full); }
        return;
    }
    const int half = opaque_tid() >> 8;
    int b = 2 * (w - ODD_GDN_ITEMS) + half;
    const int nls = NB_LAT * 16;
    float* smem = smem_full + half * 16384;
    if (b < nls) s5_scan_task(p, oi, NB_CTX + b / 16, (b % 16) >> 3, b & 7, smem);
    else { b -= nls; s5_scan_task(p, oi, b / 16, (b % 16) >> 3, b & 7, smem); }
}
__device__ void ph_fin_odd_a(const P& p, int bid, int oi) {
    const int lane = LT & 63, t = bid * 4 + (LT >> 6);
    if (t >= T) return;
    const bf16* pr = (const bf16*)(p.ws + WS_PROJ) + (size_t)t * OW;
    const bf16* of = (const bf16*)(p.ws + WS_PART) + (size_t)t * 512;
    const bf16* ob = (const bf16*)(p.ws + WS_PART + PART_SZ) + (size_t)t * 512;
    const bf16* yf = (const bf16*)(p.ws + WS_PART + 2 * PART_SZ) + (size_t)t * 512;
    const bf16* yb = (const bf16*)(p.ws + WS_PART + 3 * PART_SZ) + (size_t)t * 512;
    bf16* yc = (bf16*)(p.ws + WS_HM) + (size_t)t * D;
    const int idx = lane * 8;
    float o[8], ss = 0.f;
#pragma unroll
    for (int j = 0; j < 8; ++j) { o[j] = bf2f(of[idx + j]) + bf2f(ob[idx + j]); ss += o[j] * o[j]; }
    ss += __shfl_xor(ss, 1); ss += __shfl_xor(ss, 2); ss += __shfl_xor(ss, 4); ss += __shfl_xor(ss, 8);
    const float r = rsqrtf(ss * (1.0f / 128.f) + EPS);
    const float* gn = p.in[I_GDNN] + oi * 128 + (idx & 127);
    const float* dsk = p.in[I_S5D] + oi * 512 + idx;
#pragma unroll
    for (int j = 0; j < 8; ++j) {
        yc[idx + j] = f2bf(o[j] * r * gn[j] * siluf_(bf2f(pr[O_ZC + idx + j])));
        const float y = bf2f(yf[idx + j]) + bf2f(yb[idx + j]) + dsk[j] * bf2f(pr[O_U + idx + j]);
        yc[512 + idx + j] = f2bf(gelu_tanh(y));
    }
}
__device__ void ph_fin_odd_b(const P& p, int bid, int oi) {
    const size_t e = ((size_t)bid * 256 + LT) * 4;
    if (e >= (size_t)T * 512) return;
    const int t = (int)(e >> 9), idx = (int)(e & 511);
    const bf16* pr = (const bf16*)(p.ws + WS_PROJ) + (size_t)t * OW;
    const bf16* gl = (const bf16*)(p.ws + WS_PART + 2 * PART_SZ) + (size_t)t * 512;
    bf16* yc = (bf16*)(p.ws + WS_HM) + (size_t)t * D + 512;
#pragma unroll
    for (int j = 0; j < 4; ++j) {
        const float ys = bf2f(yc[idx + j]);
        yc[idx + j] = f2bf(ys * sigmoidf_(bf2f(gl[idx + j]) + p.in[I_GLUB][oi * 512 + idx + j]) * siluf_(bf2f(pr[O_ZD + idx + j])));
    }
}

enum { PK_PREP0, PK_HMOD0, PK_GEMM_IN, PK_EVEN_SCAN, PK_FIN_EVEN, PK_ODD_PREP, PK_ODD_SCAN, PK_FIN_ODD_A, PK_GEMM_GLU, PK_FIN_ODD_B, PK_GEMM_OUT, PK_POST };
constexpr int NPH = 2 + (DEPTH / 2) * 13;
constexpr int TOKB = (T + 3) / 4;
static_assert(DEPTH % 2 == 0, "even depth expected");
__host__ __device__ inline void phase_desc(int ph, int& kind, int& layer) {
    if (ph == 0) { kind = PK_PREP0; layer = 0; return; }
    if (ph == 1) { kind = PK_HMOD0; layer = 0; return; }
    ph -= 2;
    const int pair = ph / 13, r = ph % 13;
    if (r < 5) { layer = 2 * pair; kind = r == 0 ? PK_GEMM_IN : r == 1 ? PK_EVEN_SCAN : r == 2 ? PK_FIN_EVEN : r == 3 ? PK_GEMM_OUT : PK_POST; }
    else { const int q = r - 5; layer = 2 * pair + 1; kind = q == 0 ? PK_GEMM_IN : q == 1 ? PK_ODD_PREP : q == 2 ? PK_ODD_SCAN : q == 3 ? PK_FIN_ODD_A : q == 4 ? PK_GEMM_GLU : q == 5 ? PK_FIN_ODD_B : q == 6 ? PK_GEMM_OUT : PK_POST; }
}
__host__ __device__ inline bool phase_is_gemm(int kind) { return kind == PK_GEMM_IN || kind == PK_GEMM_GLU || kind == PK_GEMM_OUT; }
__host__ __device__ inline int phase_nblk(int kind, int layer) {
    switch (kind) {
        case PK_PREP0: return DEPTH * 48 + WT_TILES;
        case PK_EVEN_SCAN: return EVEN_SCAN_BLOCKS;
        case PK_FIN_ODD_B: return (T * 512 / 4 + 255) / 256;
        default: return TOKB;
    }
}
__device__ __forceinline__ void do_phase(const P& p, int kind, int layer, int vb, float* smem) {
    const int i = layer >> 1;
    switch (kind) {
        case PK_PREP0: if (vb < DEPTH * 48) ph_mod(p, vb, smem); else ph_wt(p, vb - DEPTH * 48, smem); break;
        case PK_HMOD0: ph_hmod0(p, vb); break;
        case PK_EVEN_SCAN: ph_even_scan(p, vb, i, smem); break;
        case PK_FIN_EVEN: ph_fin_even(p, vb, i); break;
        case PK_ODD_PREP: ph_odd_prep(p, vb, i); break;
        case PK_FIN_ODD_A: ph_fin_odd_a(p, vb, i); break;
        case PK_FIN_ODD_B: ph_fin_odd_b(p, vb, i); break;
        case PK_POST: ph_post(p, vb, layer); break;
    }
}
__device__ __forceinline__ void do_gemm(const P& p, int kind, int layer, int G, int c, unsigned char* dsm) {
    const int i = layer >> 1;
    const bf16* hm = (const bf16*)(p.ws + WS_HM);
    pg8::StaticOrder S;
    LDS_AS unsigned char* lds = (LDS_AS unsigned char*)dsm;
    if (kind == PK_GEMM_IN) {
        if ((layer & 1) == 0) { pg8::Gemm g{hm, (const bf16*)(p.ws + WS_WTE) + (size_t)i * EWP * D, T, EWP, D, D}; S.init(T, EWP, G, c); pg8::EpiBf16 E{(bf16*)(p.ws + WS_PROJ), EW, EW}; pg8::gemm_phase(lds, g, S, E); }
        else { pg8::Gemm g{hm, (const bf16*)(p.ws + WS_WTO) + (size_t)i * OWP * D, T, OWP, D, D}; S.init(T, OWP, G, c); pg8::EpiBf16 E{(bf16*)(p.ws + WS_PROJ), OW, OW}; pg8::gemm_phase(lds, g, S, E); }
    } else if (kind == PK_GEMM_GLU) {
        pg8::Gemm g{hm + 512, (const bf16*)(p.ws + WS_WTGLU) + (size_t)i * 512 * 512, T, 512, 512, D}; S.init(T, 512, G, c); pg8::EpiBf16 E{(bf16*)(p.ws + WS_PART + 2 * PART_SZ), 512, 512}; pg8::gemm_phase(lds, g, S, E);
    } else {
        pg8::Gemm g{hm, (const bf16*)(p.ws + WS_WTOUT) + (size_t)layer * D * D, T, D, D, D}; S.init(T, D, G, c); pg8::EpiF32 E{(float*)(p.ws + WS_PROJ), D}; pg8::gemm_phase(lds, g, S, E);
    }
}
constexpr int LDS_BYTES = 131072;

#ifdef CPU_EMU
__global__ void k_phase(P p, int kind, int layer, int nb) {
    __shared__ __attribute__((aligned(16))) unsigned char dsm[LDS_BYTES];
    if (phase_is_gemm(kind)) { do_gemm(p, kind, layer, gridDim.x, blockIdx.x, dsm); return; }
    if (kind == PK_ODD_SCAN) { ph_odd_scan_item(p, blockIdx.x, layer >> 1, (float*)dsm); return; }
    const int half = threadIdx.x >> 8, vb = 2 * blockIdx.x + half;
    if (vb < nb) do_phase(p, kind, layer, vb, (float*)dsm + half * 16384);
}
void emu_hook(const char* stage, int layer, const P& p);
extern "C" void kernel_launch(void* const* d_in, const int* in_sizes, int n_in, void* d_out, int out_size, void* d_ws, size_t ws_size, hipStream_t stream) {
    P p{};
    for (int i = 0; i < 44; ++i) p.in[i] = (const float*)d_in[i];
    p.out = (float*)d_out; p.ws = (char*)d_ws;
    static const char* names[] = {"prep0", "hmod", "proj", "even_scan", "ycat", "odd_prep", "odd_scan", "fin_odd_a", "glu", "ycat", "outproj", "post"};
    for (int ph = 0; ph < NPH; ++ph) {
        int kind, layer; phase_desc(ph, kind, layer);
        const int nb = phase_nblk(kind, layer);
        EMU_LAUNCH(k_phase, phase_is_gemm(kind) ? 3 : kind == PK_ODD_SCAN ? ODD_SCAN_ITEMS : (nb + 1) / 2, 512, p, kind, layer, nb);
        emu_hook(names[kind], layer, p);
    }
}
#else
extern __shared__ __attribute__((aligned(16))) unsigned char dsm[];
#define RUN_PHASE(KIND, LAYER) do { const int nb_ = phase_nblk(KIND, LAYER); const int half_ = opaque_tid() >> 8; \
    for (int b_ = blockIdx.x; 2 * b_ < nb_; b_ += gridDim.x) { const int vb_ = 2 * b_ + half_; if (vb_ < nb_) do_phase(p, KIND, LAYER, vb_, (float*)dsm + half_ * 16384); } } while (0)
#define RUN_GEMM(KIND, LAYER) do_gemm(p, KIND, LAYER, gridDim.x, blockIdx.x, dsm)
__global__ void __launch_bounds__(512) mega(P p) {
    cg::grid_group grid = cg::this_grid();
    RUN_PHASE(PK_PREP0, 0); grid.sync();
    RUN_PHASE(PK_HMOD0, 0); grid.sync();
#pragma nounroll
    for (int pair = 0; pair < DEPTH / 2; ++pair) {
        const int le = 2 * pair, lo = 2 * pair + 1;
        RUN_GEMM(PK_GEMM_IN, le); grid.sync();
        RUN_PHASE(PK_EVEN_SCAN, le); grid.sync();
        RUN_PHASE(PK_FIN_EVEN, le); grid.sync();
        RUN_GEMM(PK_GEMM_OUT, le); grid.sync();
        RUN_PHASE(PK_POST, le); grid.sync();
        RUN_GEMM(PK_GEMM_IN, lo); grid.sync();
        RUN_PHASE(PK_ODD_PREP, lo); grid.sync();
        for (int w_ = blockIdx.x; w_ < ODD_SCAN_ITEMS; w_ += gridDim.x) ph_odd_scan_item(p, w_, pair, (float*)dsm);
        grid.sync();
        RUN_PHASE(PK_FIN_ODD_A, lo); grid.sync();
        RUN_GEMM(PK_GEMM_GLU, lo); grid.sync();
        RUN_PHASE(PK_FIN_ODD_B, lo); grid.sync();
        RUN_GEMM(PK_GEMM_OUT, lo); grid.sync();
        RUN_PHASE(PK_POST, lo);
        if (pair + 1 < DEPTH / 2) grid.sync();
    }
}
extern "C" void kernel_launch(void* const* d_in, const int* in_sizes, int n_in, void* d_out, int out_size, void* d_ws, size_t ws_size, hipStream_t stream) {
    static int grid_blocks = 0;
    if (!grid_blocks) {
        int dev = 0, cus = 0, per_cu = 0;
        (void)hipGetDevice(&dev);
        (void)hipDeviceGetAttribute(&cus, hipDeviceAttributeMultiprocessorCount, dev);
        (void)hipFuncSetAttribute((const void*)mega, hipFuncAttributeMaxDynamicSharedMemorySize, LDS_BYTES);
        (void)hipOccupancyMaxActiveBlocksPerMultiprocessor(&per_cu, mega, 512, LDS_BYTES);
        if (per_cu < 1) fprintf(stderr, "occupancy query says %d blocks/CU\n", per_cu);
        grid_blocks = cus;
    }
    P p{};
    for (int i = 0; i < 44; ++i) p.in[i] = (const float*)d_in[i];
    p.out = (float*)d_out; p.ws = (char*)d_ws;
    void* args[] = {&p};
    hipError_t e = hipLaunchCooperativeKernel((void*)mega, dim3(grid_blocks), dim3(512), args, LDS_BYTES, stream);
    if (e != hipSuccess) fprintf(stderr, "cooperative launch failed: %s (grid %d)\n", hipGetErrorString(e), grid_blocks);
}
#endif
```

```cpp
#ifndef CPU_EMU
#include <hip/hip_runtime.h>
#include <hip/hip_cooperative_groups.h>
#include <cstdio>
namespace cg = cooperative_groups;
#endif
#include <stdint.h>

#ifndef CFG_BATCH
#define CFG_BATCH 16
#define CFG_SEQ 256
#define CFG_DEC_BATCH 8
#define CFG_DEC_SEQ 1024
#define CFG_DEPTH 4
#endif

typedef unsigned short bf16;
typedef short s8v __attribute__((ext_vector_type(8)));
typedef float f4v __attribute__((ext_vector_type(4)));

constexpr int D = 1024;
constexpr int NB_CTX = CFG_BATCH, L_CTX = CFG_SEQ, NB_LAT = CFG_DEC_BATCH, L_LAT = CFG_DEC_SEQ, DEPTH = CFG_DEPTH;
constexpr int N_EVEN = (DEPTH + 1) / 2, N_ODD = DEPTH / 2;
constexpr int T_CTX = NB_CTX * L_CTX, T_LAT = NB_LAT * L_LAT, T = T_CTX + T_LAT;
constexpr int NSEQ = NB_CTX + NB_LAT, NCOND = 1 + NB_LAT;
constexpr int EW = 3872, OW = 3088, EWP = 4096, OWP = 3328;
constexpr float EPS = 1e-6f;
constexpr int E_Q = 0, E_K = 256, E_V = 512, E_GD = 1024, E_ZA = 1056, E_FB = 1568, E_ZB = 3360;
constexpr int FB_R = 0, FB_K = 512, FB_V = 1024, FB_WD = 1536, FB_AD = 1664;
constexpr int O_QKV = 0, O_G = 1536, O_BETA = 1544, O_ZC = 1552, O_U = 2064, O_ZD = 2576;

constexpr size_t al(size_t x) { return (x + 255) & ~(size_t)255; }
constexpr size_t WS_MOD = 0;
constexpr size_t WS_WTE = WS_MOD + al((size_t)DEPTH * NCOND * 3072 * 4);
constexpr size_t WS_WTO = WS_WTE + al((size_t)N_EVEN * EWP * D * 2);
constexpr size_t WS_WTOUT = WS_WTO + al((size_t)(N_ODD ? N_ODD : 1) * OWP * D * 2);
constexpr size_t WS_WTGLU = WS_WTOUT + al((size_t)DEPTH * D * D * 2);
constexpr size_t WS_HM = WS_WTGLU + al((size_t)(N_ODD ? N_ODD : 1) * 512 * 512 * 2);
constexpr size_t WS_PROJ = WS_HM + al((size_t)T * D * 2);
constexpr size_t WS_PART = WS_PROJ + al((size_t)T * EW * 2);
constexpr size_t PART_SZ = al((size_t)T * 512 * 2);
constexpr size_t WS_BONUS = WS_PART + 4 * PART_SZ;
constexpr size_t WS_QKVN = WS_BONUS + al((size_t)T * 16 * 4);
constexpr size_t WS_GATES = WS_QKVN + al((size_t)T * 1536 * 2);
constexpr size_t WS_GC = WS_GATES + al((size_t)T * 16 * 4);
constexpr size_t WS_END = WS_GC + al((size_t)(T / 64) * 8 * 64 * 4);
constexpr size_t WS_TINV = WS_PROJ + al((size_t)T * OW * 2);
constexpr size_t WS_QKM = WS_HM;
static_assert(WS_TINV + (size_t)T * 1024 <= WS_PART, "TINV must fit in the PROJ tail");

constexpr size_t OUT_X = 0;
constexpr size_t OUT_GLA = (size_t)T * D;
constexpr size_t OUT_RWKV = OUT_GLA + (size_t)NB_CTX * N_EVEN * 2 * 4 * 64 * 128;
constexpr size_t OUT_GDN = OUT_RWKV + (size_t)NB_CTX * N_EVEN * 2 * 8 * 64 * 64;
constexpr size_t OUT_S5R = OUT_GDN + (size_t)NB_CTX * N_ODD * 2 * 4 * 128 * 128;
constexpr size_t OUT_S5I = OUT_S5R + (size_t)NB_CTX * N_ODD * 2 * 32 * 64;

struct P {
    const float* in[44];
    float* out;
    char* ws;
};
enum { I_XP = 0, I_XS, I_C, I_SGLA, I_SRWKV, I_SGDN, I_SS5R, I_SS5I, I_CCTX, I_WMOD, I_BMOD, I_GPRE, I_GPOST,
       I_WINE, I_WOUTE, I_GUP, I_GBIAS, I_GLAN, I_MIX, I_W0, I_W2, I_A0, I_A2, I_KK, I_KA, I_RK, I_LNG, I_LNB,
       I_WINO, I_WOUTO, I_CONV, I_ALOG, I_DTB, I_GDNN, I_S5AR, I_S5AI, I_S5DT, I_S5BR, I_S5BI, I_S5CR, I_S5CI,
       I_S5D, I_GLUW, I_GLUB };

#ifdef CPU_EMU
__device__ __forceinline__ int opaque_tid() { return (int)threadIdx.x; }
#else
__device__ __forceinline__ int opaque_tid() { int t = (int)threadIdx.x; asm volatile("" : "+v"(t)); return t; }
#endif
#define LT (opaque_tid() & 255)
__device__ __forceinline__ float u2f(unsigned u) { return __builtin_bit_cast(float, u); }
__device__ __forceinline__ unsigned f2u(float f) { return __builtin_bit_cast(unsigned, f); }
__device__ __forceinline__ float bf2f(bf16 h) { return u2f((unsigned)h << 16); }
__device__ __forceinline__ bf16 f2bf(float f) { unsigned u = f2u(f); u += 0x7fffu + ((u >> 16) & 1u); return (bf16)(u >> 16); }
__device__ __forceinline__ float sigmoidf_(float x) { return 1.0f / (1.0f + expf(-x)); }
__device__ __forceinline__ float siluf_(float x) { return x / (1.0f + expf(-x)); }
__device__ __forceinline__ float logsigf_(float x) { return fminf(x, 0.f) - log1pf(expf(-fabsf(x))); }
__device__ __forceinline__ float softplusf_(float x) { return fmaxf(x, 0.f) + log1pf(expf(-fabsf(x))); }
__device__ __forceinline__ float gelu_tanh(float x) { return 0.5f * x * (1.0f + tanhf(0.7978845608028654f * (x + 0.044715f * x * x * x))); }

struct Seq { int start, len, cond, lat, b; };
__device__ __forceinline__ Seq get_seq(int s) {
    Seq q;
    if (s < NB_CTX) { q.start = s * L_CTX; q.len = L_CTX; q.cond = 0; q.lat = 0; q.b = s; }
    else { int b = s - NB_CTX; q.start = T_CTX + b * L_LAT; q.len = L_LAT; q.cond = 1 + b; q.lat = 1; q.b = b; }
    return q;
}
__device__ __forceinline__ int tok_cond(int t) { return t < T_CTX ? 0 : 1 + (t - T_CTX) / L_LAT; }
__device__ __forceinline__ void tok_nbr(int t, bool& hl, bool& hr) {
    if (t < T_CTX) { int pos = t % L_CTX; hl = pos != 0; hr = pos != L_CTX - 1; }
    else { int pos = (t - T_CTX) & 63; hl = pos != 0; hr = pos != 63; }
}

__device__ __forceinline__ void ph_mod(const P& p, int bid, float* smem) {
    float (*sc)[1024] = (float(*)[1024])smem;
    float (*red)[64][NCOND] = (float(*)[64][NCOND])(smem + NCOND * 1024);
    const int layer = bid / 48, ct = bid % 48;
    __syncthreads();
    const int tid = LT, cl = tid & 63, kg = tid >> 6;
    for (int i = tid; i < NCOND * 1024; i += 256) {
        int ci = i >> 10, k = i & 1023;
        float v = ci == 0 ? p.in[I_CCTX][k] : p.in[I_C][(ci - 1) * 1024 + k];
        sc[ci][k] = siluf_(v);
    }
    __syncthreads();
    float acc[NCOND];
#pragma unroll
    for (int ci = 0; ci < NCOND; ++ci) acc[ci] = 0.f;
    const float* w = p.in[I_WMOD] + (size_t)layer * 1024 * 3072 + ct * 64 + cl;
    for (int kk = 0; kk < 256; ++kk) {
        int k = kg * 256 + kk;
        float wv = w[(size_t)k * 3072];
#pragma unroll
        for (int ci = 0; ci < NCOND; ++ci) acc[ci] += sc[ci][k] * wv;
    }
#pragma unroll
    for (int ci = 0; ci < NCOND; ++ci) red[kg][cl][ci] = acc[ci];
    __syncthreads();
    if (tid < 64) {
        float* mod = (float*)(p.ws + WS_MOD);
        int col = ct * 64 + cl;
#pragma unroll
        for (int ci = 0; ci < NCOND; ++ci)
            mod[(size_t)(layer * NCOND + ci) * 3072 + col] = red[0][cl][ci] + red[1][cl][ci] + red[2][cl][ci] + red[3][cl][ci] + p.in[I_BMOD][layer * 3072 + col];
    }
}

struct WtJob { const float* src; bf16* dst; int K, N, Npad; };
__device__ __forceinline__ WtJob wt_job(const P& p, int j) {
    WtJob q;
    if (j < N_EVEN) { q.src = p.in[I_WINE] + (size_t)j * D * EW; q.dst = (bf16*)(p.ws + WS_WTE) + (size_t)j * EWP * D; q.K = D; q.N = EW; q.Npad = EWP; return q; }
    j -= N_EVEN;
    if (j < N_ODD) { q.src = p.in[I_WINO] + (size_t)j * D * OW; q.dst = (bf16*)(p.ws + WS_WTO) + (size_t)j * OWP * D; q.K = D; q.N = OW; q.Npad = OWP; return q; }
    j -= N_ODD;
    if (j < DEPTH) { int i = j >> 1; q.src = (j & 1) ? p.in[I_WOUTO] + (size_t)i * D * D : p.in[I_WOUTE] + (size_t)i * D * D; q.dst = (bf16*)(p.ws + WS_WTOUT) + (size_t)j * D * D; q.K = D; q.N = D; q.Npad = D; return q; }
    j -= DEPTH;
    q.src = p.in[I_GLUW] + (size_t)j * 512 * 512; q.dst = (bf16*)(p.ws + WS_WTGLU) + (size_t)j * 512 * 512; q.K = 512; q.N = 512; q.Npad = 512; return q;
}
constexpr int WT_NJOBS = N_EVEN + N_ODD + DEPTH + N_ODD;
constexpr int WT_TILES = N_EVEN * (EWP / 64) * 16 + N_ODD * (OWP / 64) * 16 + DEPTH * 256 + N_ODD * 64;
__device__ __forceinline__ void ph_wt(const P& p, int bid, float* smem) {
    float (*tile)[65] = (float(*)[65])smem;
    int b = bid, j = 0;
    __syncthreads();
    WtJob q;
    for (;; ++j) { q = wt_job(p, j); int nt = (q.Npad / 64) * (q.K / 64); if (b < nt) break; b -= nt; }
    const int nk = q.K / 64, n0 = (b / nk) * 64, k0 = (b % nk) * 64;
    const int tx = LT & 63, ty = LT >> 6;
#pragma unroll
    for (int i = 0; i < 16; ++i) { int kk = ty + 4 * i, n = n0 + tx; tile[kk][tx] = n < q.N ? q.src[(size_t)(k0 + kk) * q.N + n] : 0.f; }
    __syncthreads();
#pragma unroll
    for (int i = 0; i < 16; ++i) { int nn = ty + 4 * i; q.dst[(size_t)(n0 + nn) * q.K + k0 + tx] = f2bf(tile[tx][nn]); }
}

__device__ __forceinline__ float wave_sum(float v) {
#pragma unroll
    for (int m = 1; m < 64; m <<= 1) v += __shfl_xor(v, m);
    return v;
}
__device__ __forceinline__ void hmod_row(const float* xv  , int lane, const float* gpre, const float* mod, bf16* dst) {
    float ss = 0.f;
#pragma unroll
    for (int i = 0; i < 16; ++i) ss += xv[i] * xv[i];
    ss = wave_sum(ss);
    const float r = rsqrtf(ss * (1.0f / 1024.f) + EPS);
#pragma unroll
    for (int i = 0; i < 4; ++i) {
        int idx = i * 256 + lane * 4;
        bf16 o[4];
#pragma unroll
        for (int j = 0; j < 4; ++j) o[j] = f2bf(xv[i * 4 + j] * r * gpre[idx + j] * (1.0f + mod[1024 + idx + j]) + mod[idx + j]);
        *(uint2*)(dst + idx) = make_uint2((unsigned)o[0] | ((unsigned)o[1] << 16), (unsigned)o[2] | ((unsigned)o[3] << 16));
    }
}
__device__ __forceinline__ void ph_hmod0(const P& p, int bid) {
    const int lane = LT & 63, t = bid * 4 + (LT >> 6);
    if (t >= T) return;
    const float* xr = t < T_CTX ? p.in[I_XP] + (size_t)t * D : p.in[I_XS] + (size_t)(t - T_CTX) * D;
    float xv[16];
#pragma unroll
    for (int i = 0; i < 4; ++i) { float4 v = *(const float4*)(xr + i * 256 + lane * 4); xv[i * 4] = v.x; xv[i * 4 + 1] = v.y; xv[i * 4 + 2] = v.z; xv[i * 4 + 3] = v.w; }
    const float* mod = (const float*)(p.ws + WS_MOD) + (size_t)(0 * NCOND + tok_cond(t)) * 3072;
    hmod_row(xv, lane, p.in[I_GPRE], mod, (bf16*)(p.ws + WS_HM) + (size_t)t * D);
}
__device__ __forceinline__ void ph_post(const P& p, int bid, int layer) {
    const int lane = LT & 63, t = bid * 4 + (LT >> 6);
    if (t >= T) return;
    const float* xr = layer == 0 ? (t < T_CTX ? p.in[I_XP] + (size_t)t * D : p.in[I_XS] + (size_t)(t - T_CTX) * D) : p.out + OUT_X + (size_t)t * D;
    const float* mr = (const float*)(p.ws + WS_PROJ) + (size_t)t * D;
    const float* mod = (const float*)(p.ws + WS_MOD) + (size_t)(layer * NCOND + tok_cond(t)) * 3072;
    const float* gpost = p.in[I_GPOST] + layer * D;
    float xv[16], mv[16];
    float ss = 0.f;
#pragma unroll
    for (int i = 0; i < 4; ++i) {
        float4 v = *(const float4*)(xr + i * 256 + lane * 4); xv[i * 4] = v.x; xv[i * 4 + 1] = v.y; xv[i * 4 + 2] = v.z; xv[i * 4 + 3] = v.w;
        float4 m = *(const float4*)(mr + i * 256 + lane * 4); mv[i * 4] = m.x; mv[i * 4 + 1] = m.y; mv[i * 4 + 2] = m.z; mv[i * 4 + 3] = m.w;
    }
#pragma unroll
    for (int i = 0; i < 16; ++i) ss += mv[i] * mv[i];
    ss = wave_sum(ss);
    const float r = rsqrtf(ss * (1.0f / 1024.f) + EPS);
    float* xo = p.out + OUT_X + (size_t)t * D;
#pragma unroll
    for (int i = 0; i < 4; ++i) {
        int idx = i * 256 + lane * 4;
#pragma unroll
        for (int j = 0; j < 4; ++j) xv[i * 4 + j] += mod[2048 + idx + j] * (mv[i * 4 + j] * r * gpost[idx + j]);
        *(float4*)(xo + idx) = make_float4(xv[i * 4], xv[i * 4 + 1], xv[i * 4 + 2], xv[i * 4 + 3]);
    }
    if (layer + 1 < DEPTH) {
        const float* mod2 = (const float*)(p.ws + WS_MOD) + (size_t)((layer + 1) * NCOND + tok_cond(t)) * 3072;
        hmod_row(xv, lane, p.in[I_GPRE] + (layer + 1) * D, mod2, (bf16*)(p.ws + WS_HM) + (size_t)t * D);
    }
}

#ifdef CPU_EMU
#define LDS_AS
#define GLDS16(gptr, lptr) memcpy((char*)(lptr) + (threadIdx.x & 63) * 16, (const void*)(gptr), 16)
#define PG_WAIT_V(n)
#define PG_WAIT_L(n)
#define PG_BAR __syncthreads()
#define PG_SCHED
#define PG_PRIO(x)
#define RFL(x) (x)
__device__ __forceinline__ unsigned cvt_pk_bf16(float lo, float hi) { return (unsigned)f2bf(lo) | ((unsigned)f2bf(hi) << 16); }
#else
#define LDS_AS __attribute__((address_space(3)))
#define GLDS16(gptr, lptr) __builtin_amdgcn_global_load_lds((const unsigned*)(gptr), (LDS_AS unsigned*)(lptr), 16, 0, 0)
#define PG_WAIT_V(n) asm volatile("s_waitcnt vmcnt(" #n ")" ::: "memory")
#define PG_WAIT_L(n) asm volatile("s_waitcnt lgkmcnt(" #n ")" ::: "memory")
#define PG_BAR __builtin_amdgcn_s_barrier()
#define PG_SCHED __builtin_amdgcn_sched_barrier(0)
#define PG_PRIO(x) __builtin_amdgcn_s_setprio(x)
#define RFL(x) __builtin_amdgcn_readfirstlane(x)
__device__ __forceinline__ unsigned cvt_pk_bf16(float lo, float hi) { unsigned r; asm volatile("v_cvt_pk_bf16_f32 %0, %1, %2" : "=v"(r) : "v"(lo), "v"(hi)); return r; }
#endif
namespace pg8 {
constexpr int BM = 256, BK = 64, HALF = 128, HTB = HALF * BK * 2, STAGE_BYTES = 8 * HTB, NXCD = 8, WGM = 8;
__host__ __device__ __forceinline__ int lds_byte(int r, int c) { const int st = (r >> 4) * 2 + (c >> 5), rr = r & 15, cc = c & 31, ob = rr * 64 + cc * 2; return st * 1024 + (ob ^ (((ob >> 9) & 1) << 5)); }
__host__ __device__ __forceinline__ void stage_rc(int b, int& R, int& C) { const int st = b / 1024, sb = b % 1024, swz = sb ^ (((sb >> 9) & 1) << 5); R = (st >> 1) * 16 + swz / 64; C = (st & 1) * 32 + (swz % 64) / 2; }
__host__ __device__ __forceinline__ int perm32(int rho) { const int n = rho >> 4, i = rho & 15; return 8 * (i >> 2) + 4 * n + (i & 3); }
struct Unit { int pm, pn; };
struct Gemm { const bf16* A; const bf16* Bt; int M, N, K, lda; };
struct StaticOrder {
    int nM, nN, nwg, G, c;
    __host__ __device__ void init(int M, int N, int G_, int c_) { nM = M / BM; nN = N / BM; nwg = nM * nN; G = G_; c = c_; }
    __host__ __device__ bool next(int i, Unit& u) const {
        const long L = (long)i * G + c; if (L >= nwg) return false;
        int wgid = (int)L; { const int q = nwg / NXCD, r = nwg % NXCD, xcd = wgid % NXCD, off = wgid / NXCD; wgid = (xcd < r ? xcd * (q + 1) : r * (q + 1) + (xcd - r) * q) + off; }
        const int nig = WGM * nN, gid = wgid / nig, fm = gid * WGM, gsz = (nM - fm) < WGM ? (nM - fm) : WGM;
        u.pm = fm + ((wgid % nig) % gsz); u.pn = (wgid % nig) / gsz; return true;
    }
};
struct EpiF32 {
    static constexpr bool PERM = false;
    float* C; int ldc;
    __device__ __forceinline__ void operator()(const f4v (&acc)[2][2][4][2], const Unit& u, int wr, int wc, int fr, int fq) const {
        const int row0 = u.pm * BM + wr * 64 + fr, col0 = u.pn * BM + wc * 32 + 4 * fq;
#pragma unroll
        for (int ai = 0; ai < 2; ++ai)
#pragma unroll
            for (int m = 0; m < 4; ++m) { float* rowp = C + (size_t)(row0 + ai * HALF + m * 16) * ldc + col0;
#pragma unroll
                for (int bj = 0; bj < 2; ++bj)
#pragma unroll
                    for (int n = 0; n < 2; ++n) *(f4v*)(rowp + bj * HALF + n * 16) = acc[ai][bj][m][n]; }
    }
};
struct EpiBf16 {
    static constexpr bool PERM = true;
    bf16* O; int ldc; int N;
    __device__ __forceinline__ void operator()(const f4v (&acc)[2][2][4][2], const Unit& u, int wr, int wc, int fr, int fq) const {
        const int row0 = u.pm * BM + wr * 64 + fr, col0 = u.pn * BM + wc * 32 + 8 * fq;
#pragma unroll
        for (int ai = 0; ai < 2; ++ai)
#pragma unroll
            for (int m = 0; m < 4; ++m) { bf16* rowp = O + (size_t)(row0 + ai * HALF + m * 16) * ldc + col0;
#pragma unroll
                for (int bj = 0; bj < 2; ++bj) { const f4v v0 = acc[ai][bj][m][0], v1 = acc[ai][bj][m][1];
                    if (col0 + bj * HALF < N) *(uint4*)(rowp + bj * HALF) = make_uint4(cvt_pk_bf16(v0[0], v0[1]), cvt_pk_bf16(v0[2], v0[3]), cvt_pk_bf16(v1[0], v1[1]), cvt_pk_bf16(v1[2], v1[3])); } }
    }
};
template <class Epi>
__device__ __forceinline__ void gemm_phase(LDS_AS unsigned char* lds, const Gemm g, const StaticOrder& S, const Epi& E) {
    const int tid = opaque_tid(), wid = RFL(tid >> 6), lane = tid & 63, wr = wid >> 2, wc = wid & 3, fr = lane & 15, fq = lane >> 4;
    const int K = g.K, nt = K / BK;
    unsigned voffA[2], voffB[2];
#pragma unroll
    for (int i = 0; i < 2; ++i) { int R, C; stage_rc(tid * 16 + i * 8192, R, C); const int Rb = Epi::PERM ? ((R & ~31) + perm32(R & 31)) : R;
        voffA[i] = (unsigned)(R * g.lda + C) * 2u; voffB[i] = (unsigned)(Rb * K + C) * 2u; }
    const size_t kstep = (size_t)(BK * 2);
    const size_t hstepA = (size_t)HALF * g.lda * 2, hstepB = (size_t)HALF * K * 2;
    const size_t tstepA = 2 * hstepA, tstepB = 2 * hstepB;
    const unsigned ldsw = (unsigned)wid * 1024u;
    const int aoff = lds_byte(wr * 64 + fr, fq * 8), boff = lds_byte(wc * 32 + fr, fq * 8);
#define PG8_SA(b, h) (((b) * 2 + (h)) * HTB)
#define PG8_SB(b, h) ((4 + (b) * 2 + (h)) * HTB)
#define PG8_STAGE(bufoff, gbase, voff) do { _Pragma("unroll") for (int _i = 0; _i < 2; ++_i) GLDS16((const char*)(gbase) + (voff)[_i], lds + (bufoff) + ldsw + _i * 8192); } while (0)
#define PG8_LDA(dst, b, h) do { _Pragma("unroll") for (int m = 0; m < 4; ++m) _Pragma("unroll") for (int k = 0; k < 2; ++k) dst[m][k] = *(const LDS_AS s8v*)(lds + PG8_SA(b, h) + aoff + m * 2048 + k * 1024); } while (0)
#define PG8_LDB(dst, b, h) do { _Pragma("unroll") for (int n = 0; n < 2; ++n) _Pragma("unroll") for (int k = 0; k < 2; ++k) dst[n][k] = *(const LDS_AS s8v*)(lds + PG8_SB(b, h) + boff + n * 2048 + k * 1024); } while (0)
#define PG8_MMA(ai, bj, At, Bt) do { PG_PRIO(1); _Pragma("unroll") for (int m = 0; m < 4; ++m) _Pragma("unroll") for (int n = 0; n < 2; ++n) _Pragma("unroll") for (int k = 0; k < 2; ++k) \
        acc[ai][bj][m][n] = __builtin_amdgcn_mfma_f32_16x16x32_bf16(Bt[n][k], At[m][k], acc[ai][bj][m][n], 0, 0, 0); PG_PRIO(0); } while (0)
    Unit cur, nxt; int ui = 0;
    if (!S.next(0, cur)) return;
    f4v acc[2][2][4][2];
#pragma unroll
    for (int a = 0; a < 2; ++a)
#pragma unroll
        for (int b = 0; b < 2; ++b)
#pragma unroll
            for (int m = 0; m < 4; ++m)
#pragma unroll
                for (int n = 0; n < 2; ++n) acc[a][b][m][n] = (f4v){0.f, 0.f, 0.f, 0.f};
    s8v At[4][2], B0[2][2], B1[2][2];
    const char* cA = (const char*)g.A + (size_t)cur.pm * tstepA; const char* cB = (const char*)g.Bt + (size_t)cur.pn * tstepB;
    PG8_STAGE(PG8_SB(0, 0), cB, voffB); PG8_STAGE(PG8_SA(0, 0), cA, voffA); PG8_STAGE(PG8_SB(0, 1), cB + hstepB, voffB); PG8_STAGE(PG8_SA(0, 1), cA + hstepA, voffA);
    if (wr == 1) PG_BAR;
    PG_WAIT_V(4); PG_BAR;
    PG8_STAGE(PG8_SB(1, 0), cB + kstep, voffB); PG8_STAGE(PG8_SA(1, 0), cA + kstep, voffA); PG8_STAGE(PG8_SB(1, 1), cB + hstepB + kstep, voffB);
    PG_WAIT_V(6); PG_BAR;
    for (;;) {
        const bool has_next = S.next(ui + 1, nxt);
        const char* nA = has_next ? (const char*)g.A + (size_t)nxt.pm * tstepA : cA; const char* nB = has_next ? (const char*)g.Bt + (size_t)nxt.pn * tstepB : cB;
        for (int t = 0; t < nt; t += 2) {
            const bool last = (t == nt - 2);
            const char* a1 = cA + (size_t)(t + 1) * kstep;
            const char* a2 = last ? nA : cA + (size_t)(t + 2) * kstep; const char* b2 = last ? nB : cB + (size_t)(t + 2) * kstep;
            const char* a3 = a2 + kstep; const char* b3 = b2 + kstep;
            PG8_LDB(B0, 0, 0); PG_SCHED; PG8_LDA(At, 0, 0); PG8_STAGE(PG8_SA(1, 1), a1 + hstepA, voffA);
            PG_WAIT_L(8); PG_BAR; PG_WAIT_L(0); PG8_MMA(0, 0, At, B0); PG_BAR; PG_SCHED;
            PG8_LDB(B1, 0, 1); PG8_STAGE(PG8_SB(0, 0), b2, voffB);
            PG_BAR; PG_WAIT_L(0); PG8_MMA(0, 1, At, B1); PG_BAR;
            PG8_LDA(At, 0, 1); PG8_STAGE(PG8_SA(0, 0), a2, voffA);
            PG_BAR; PG_WAIT_L(0); PG8_MMA(1, 0, At, B0); PG_BAR; PG_SCHED;
            PG8_STAGE(PG8_SB(0, 1), b2 + hstepB, voffB);
            PG_WAIT_V(6); PG_BAR; PG8_MMA(1, 1, At, B1); PG_BAR;
            PG8_LDB(B0, 1, 0); PG_SCHED; PG8_LDA(At, 1, 0); PG8_STAGE(PG8_SA(0, 1), a2 + hstepA, voffA);
            PG_WAIT_L(8); PG_BAR; PG_WAIT_L(0); PG8_MMA(0, 0, At, B0); PG_BAR; PG_SCHED;
            PG8_LDB(B1, 1, 1); PG8_STAGE(PG8_SB(1, 0), b3, voffB);
            PG_BAR; PG_WAIT_L(0); PG8_MMA(0, 1, At, B1); PG_BAR;
            PG8_LDA(At, 1, 1); PG8_STAGE(PG8_SA(1, 0), a3, voffA);
            PG_BAR; PG_WAIT_L(0); PG8_MMA(1, 0, At, B0); PG_BAR; PG_SCHED;
            PG8_STAGE(PG8_SB(1, 1), b3 + hstepB, voffB);
            PG_WAIT_V(6); PG_BAR; PG8_MMA(1, 1, At, B1); PG_BAR;
        }
        E(acc, cur, wr, wc, fr, fq);
        if (!has_next) break;
#pragma unroll
        for (int a = 0; a < 2; ++a)
#pragma unroll
            for (int b = 0; b < 2; ++b)
#pragma unroll
                for (int m = 0; m < 4; ++m)
#pragma unroll
                    for (int n = 0; n < 2; ++n) acc[a][b][m][n] = (f4v){0.f, 0.f, 0.f, 0.f};
        cur = nxt; cA = nA; cB = nB; ++ui;
    }
    PG_WAIT_V(0);
    if (wr == 0) PG_BAR;
    PG_BAR;
}
}

#ifdef CPU_EMU
#define WAVE_SYNC() emu::wsync()
#else
#define WAVE_SYNC() __builtin_amdgcn_wave_barrier()
#endif
__device__ __forceinline__ void unpack8(const uint4& u, float* f) {
    f[0] = u2f(u.x << 16); f[1] = u2f(u.x & 0xffff0000u); f[2] = u2f(u.y << 16); f[3] = u2f(u.y & 0xffff0000u);
    f[4] = u2f(u.z << 16); f[5] = u2f(u.z & 0xffff0000u); f[6] = u2f(u.w << 16); f[7] = u2f(u.w & 0xffff0000u);
}
typedef float f8v __attribute__((ext_vector_type(8)));
__device__ __forceinline__ f8v unpack8v(const uint4& u) {
    f8v f; f[0] = u2f(u.x << 16); f[1] = u2f(u.x & 0xffff0000u); f[2] = u2f(u.y << 16); f[3] = u2f(u.y & 0xffff0000u);
    f[4] = u2f(u.z << 16); f[5] = u2f(u.z & 0xffff0000u); f[6] = u2f(u.w << 16); f[7] = u2f(u.w & 0xffff0000u); return f;
}
__device__ __forceinline__ unsigned pack2(float lo, float hi) { return (unsigned)f2bf(lo) | ((unsigned)f2bf(hi) << 16); }
__device__ __forceinline__ uint4 pack8(const float* f) { return make_uint4(pack2(f[0], f[1]), pack2(f[2], f[3]), pack2(f[4], f[5]), pack2(f[6], f[7])); }
__device__ __forceinline__ uint4 pack8v(const f8v& f) { return make_uint4(pack2(f[0], f[1]), pack2(f[2], f[3]), pack2(f[4], f[5]), pack2(f[6], f[7])); }
__device__ __forceinline__ f4v mfma16(const s8v& a, const s8v& b, const f4v& c) { return __builtin_amdgcn_mfma_f32_16x16x32_bf16(a, b, c, 0, 0, 0); }

__device__ __forceinline__ float red8(float x) {
#ifdef CPU_EMU
    x += __shfl_xor(x, 1); x += __shfl_xor(x, 2); x += __shfl_xor(x, 4);
#else
    x += __builtin_bit_cast(float, __builtin_amdgcn_mov_dpp(__builtin_bit_cast(int, x), 0xB1, 0xF, 0xF, true));
    x += __builtin_bit_cast(float, __builtin_amdgcn_mov_dpp(__builtin_bit_cast(int, x), 0x4E, 0xF, 0xF, true));
    x += __builtin_bit_cast(float, __builtin_amdgcn_mov_dpp(__builtin_bit_cast(int, x), 0x141, 0xF, 0xF, true));
#endif
    return x;
}
constexpr int GL_LD = 72;
__device__ __forceinline__ void gla_scan_task(const P& p, int ei, int s, int h, int dir, unsigned char* dsm) {
    bf16* LAt = (bf16*)dsm;
    bf16* Qd = LAt + 64 * GL_LD;
    bf16* Ki = Qd + 64 * GL_LD;
    bf16* KiT = Ki + 64 * GL_LD;
    bf16* Sc = KiT + 64 * GL_LD;
    bf16* VT = Sc + 64 * GL_LD;
    bf16* St = VT + 128 * GL_LD;
    float* sAE = (float*)(St + 128 * GL_LD);
    const Seq sq_ = get_seq(s);
    const int tid = opaque_tid(), lane = tid & 63, wid = tid >> 6, fr = lane & 15, fq = lane >> 4;
    const int rt = wid & 3, chf = wid >> 2;
    const bf16* proj = (const bf16*)(p.ws + WS_PROJ);
    bf16* opart = (bf16*)(p.ws + WS_PART + (size_t)dir * PART_SZ);
    s8v gfrag[2]; float gb[2];
    {
        const float* gup = p.in[I_GUP] + (size_t)(ei * 2 + dir) * 16 * 256 + h * 64;
        const float* gbias = p.in[I_GBIAS] + (size_t)(ei * 2 + dir) * 256 + h * 64;
#pragma unroll
        for (int c2 = 0; c2 < 2; ++c2) {
            const int d = 16 * (2 * chf + c2) + fr;
            gb[c2] = gbias[d];
#pragma unroll
            for (int j = 0; j < 8; ++j) gfrag[c2][j] = (short)f2bf(fq < 2 ? gup[(8 * fq + j) * 256 + d] : 0.f);
        }
    }
    f4v Sacc[4];
    __syncthreads();
    if (sq_.lat) {
        const float* s0 = p.in[I_SGLA] + ((((size_t)sq_.b * N_EVEN + ei) * 2 + dir) * 4 + h) * 64 * 128;
#pragma unroll
        for (int ct = 0; ct < 4; ++ct)
#pragma unroll
            for (int r = 0; r < 4; ++r) Sacc[ct][r] = s0[(16 * rt + fq * 4 + r) * 128 + 64 * chf + 16 * ct + fr];
    } else {
#pragma unroll
        for (int ct = 0; ct < 4; ++ct) Sacc[ct] = (f4v){0.f, 0.f, 0.f, 0.f};
    }
#pragma unroll
    for (int ct = 0; ct < 4; ++ct) *(uint2*)(St + (64 * chf + 16 * ct + fr) * GL_LD + 16 * rt + fq * 4) = make_uint2(pack2(Sacc[ct][0], Sacc[ct][1]), pack2(Sacc[ct][2], Sacc[ct][3]));
    const int nch = sq_.len >> 6;
    for (int cc = 0; cc < nch; ++cc) {
        const int tb = sq_.start + (dir ? sq_.len - 64 - cc * 64 : cc * 64);
        {
#pragma unroll
            for (int rep = 0; rep < 2; ++rep) {
                const int e = tid + rep * 512, i = e >> 4, c8 = (e & 15) * 8, t = tb + (dir ? 63 - i : i);
                const f8v vv = unpack8v(*(const uint4*)(proj + (size_t)t * EW + E_V + h * 128 + c8));
#pragma unroll
                for (int j = 0; j < 8; ++j) VT[(c8 + j) * GL_LD + i] = f2bf(vv[j]);
            }
            s8v ga = (s8v){0, 0, 0, 0, 0, 0, 0, 0};
            { const int i = 16 * rt + fr, t = tb + (dir ? 63 - i : i); if (fq < 2) ga = *(const s8v*)(proj + (size_t)t * EW + E_GD + dir * 16 + fq * 8); }
#pragma unroll
            for (int c2 = 0; c2 < 2; ++c2) {
                const f4v x = mfma16(ga, gfrag[c2], (f4v){0.f, 0.f, 0.f, 0.f});
                float la[4];
#pragma unroll
                for (int r = 0; r < 4; ++r) la[r] = logsigf_(x[r] + gb[c2]) * (1.0f / 16.0f);
                *(uint2*)(LAt + (16 * (2 * chf + c2) + fr) * GL_LD + 16 * rt + fq * 4) = make_uint2(pack2(la[0], la[1]), pack2(la[2], la[3]));
            }
        }
        __syncthreads();
        {
            f4v bc[2];
            bc[0] = (f4v){0.f, 0.f, 0.f, 0.f}; bc[1] = bc[0];
#pragma unroll
            for (int ks = 0; ks < 2; ++ks) {
                s8v lf;
#pragma unroll
                for (int j = 0; j < 8; ++j) lf[j] = (32 * ks + 8 * fq + j <= 16 * rt + fr) ? (short)0x3F80 : (short)0;
#pragma unroll
                for (int c2 = 0; c2 < 2; ++c2) bc[c2] = mfma16(lf, *(const s8v*)(LAt + (16 * (2 * chf + c2) + fr) * GL_LD + 32 * ks + 8 * fq), bc[c2]);
            }
#pragma unroll
            for (int c2 = 0; c2 < 2; ++c2) {
                const int d = 16 * (2 * chf + c2) + fr;
                float kiv[4];
#pragma unroll
                for (int r = 0; r < 4; ++r) {
                    const int i = 16 * rt + fq * 4 + r, t = tb + (dir ? 63 - i : i);
                    const float eb = expf(bc[c2][r]);
                    const float qv = bf2f(proj[(size_t)t * EW + E_Q + h * 64 + d]) * 0.125f * eb;
                    kiv[r] = bf2f(proj[(size_t)t * EW + E_K + h * 64 + d]) / eb;
                    Qd[i * GL_LD + d] = f2bf(qv); Ki[i * GL_LD + d] = f2bf(kiv[r]);
                    if (i == 63) sAE[d] = eb;
                }
                *(uint2*)(KiT + d * GL_LD + 16 * rt + fq * 4) = make_uint2(pack2(kiv[0], kiv[1]), pack2(kiv[2], kiv[3]));
            }
        }
        __syncthreads();
        f4v oacc[4];
        {
            f4v sc[2];
            sc[0] = (f4v){0.f, 0.f, 0.f, 0.f}; sc[1] = sc[0];
#pragma unroll
            for (int ct = 0; ct < 4; ++ct) oacc[ct] = (f4v){0.f, 0.f, 0.f, 0.f};
#pragma unroll
            for (int ks = 0; ks < 2; ++ks) {
                const s8v a = *(const s8v*)(Qd + (16 * rt + fr) * GL_LD + 32 * ks + 8 * fq);
#pragma unroll
                for (int c2 = 0; c2 < 2; ++c2) sc[c2] = mfma16(a, *(const s8v*)(Ki + (16 * (2 * chf + c2) + fr) * GL_LD + 32 * ks + 8 * fq), sc[c2]);
#pragma unroll
                for (int ct = 0; ct < 4; ++ct) oacc[ct] = mfma16(a, *(const s8v*)(St + (64 * chf + 16 * ct + fr) * GL_LD + 32 * ks + 8 * fq), oacc[ct]);
            }
#pragma unroll
            for (int c2 = 0; c2 < 2; ++c2)
#pragma unroll
                for (int r = 0; r < 4; ++r) { const int i = 16 * rt + fq * 4 + r, j = 16 * (2 * chf + c2) + fr; Sc[i * GL_LD + j] = f2bf(j <= i ? sc[c2][r] : 0.f); }
        }
        __syncthreads();
        {
#pragma unroll
            for (int ks = 0; ks < 2; ++ks) {
                const s8v a = *(const s8v*)(Sc + (16 * rt + fr) * GL_LD + 32 * ks + 8 * fq);
                const s8v kt = *(const s8v*)(KiT + (16 * rt + fr) * GL_LD + 32 * ks + 8 * fq);
#pragma unroll
                for (int ct = 0; ct < 4; ++ct) {
                    const s8v bv = *(const s8v*)(VT + (64 * chf + 16 * ct + fr) * GL_LD + 32 * ks + 8 * fq);
                    oacc[ct] = mfma16(a, bv, oacc[ct]); Sacc[ct] = mfma16(kt, bv, Sacc[ct]);
                }
            }
#pragma unroll
            for (int ct = 0; ct < 4; ++ct)
#pragma unroll
                for (int r = 0; r < 4; ++r) { const int i = 16 * rt + fq * 4 + r, t = tb + (dir ? 63 - i : i);
                    opart[(size_t)t * 512 + h * 128 + 64 * chf + 16 * ct + fr] = f2bf(oacc[ct][r]); }
            float ae[4];
#pragma unroll
            for (int r = 0; r < 4; ++r) ae[r] = sAE[16 * rt + fq * 4 + r];
#pragma unroll
            for (int ct = 0; ct < 4; ++ct) {
#pragma unroll
                for (int r = 0; r < 4; ++r) Sacc[ct][r] *= ae[r];
                *(uint2*)(St + (64 * chf + 16 * ct + fr) * GL_LD + 16 * rt + fq * 4) = make_uint2(pack2(Sacc[ct][0], Sacc[ct][1]), pack2(Sacc[ct][2], Sacc[ct][3]));
            }
        }
        __syncthreads();
    }
    if (!sq_.lat) {
        float* fs = p.out + OUT_GLA + ((((size_t)sq_.b * N_EVEN + ei) * 2 + dir) * 4 + h) * 64 * 128;
#pragma unroll
        for (int ct = 0; ct < 4; ++ct)
#pragma unroll
            for (int r = 0; r < 4; ++r) fs[(16 * rt + fq * 4 + r) * 128 + 64 * chf + 16 * ct + fr] = Sacc[ct][r];
    }
}

constexpr int RW_LD = 72;
__device__ __forceinline__ void rwkv_scan_task(const P& p, int ei, int s, int h, int dir, unsigned char* dsm) {
    float* sW = (float*)dsm;
    float* sKK = sW + 4096;
    float* sKA = sKK + 4096;
    float* sKM = sKA + 4096;
    float* sR = sKM + 4096;
    float* sV = sR + 4096;
    bf16* sTW = (bf16*)(sV + 4096);
    bf16* sAD = sTW + 64 * RW_LD;
    bf16* sW2T = sAD + 64 * RW_LD;
    bf16* sA2T = sW2T + 64 * RW_LD;
    const Seq sq_ = get_seq(s);
    const int tid = opaque_tid(), lane = tid & 63, wid = tid >> 6, fr = lane & 15, fq = lane >> 4;
    const int vi = 8 * wid + (lane >> 3), kg = lane & 7;
    const bf16* proj = (const bf16*)(p.ws + WS_PROJ);
    bf16* opart = (bf16*)(p.ws + WS_PART + (size_t)(2 + dir) * PART_SZ);
    float* bonus = (float*)(p.ws + WS_BONUS);
    const float* mix = p.in[I_MIX] + (size_t)ei * 1792;
    const int hc0 = h * 64;
    const float* w0 = p.in[I_W0] + (size_t)(ei * 2 + dir) * 512 + hc0;
    const float* w2 = p.in[I_W2] + (size_t)(ei * 2 + dir) * 64 * 512 + hc0;
    const float* a0 = p.in[I_A0] + (size_t)(ei * 2 + dir) * 512 + hc0;
    const float* a2 = p.in[I_A2] + (size_t)(ei * 2 + dir) * 64 * 512 + hc0;
    const float* kkw = p.in[I_KK] + (size_t)ei * 512 + hc0;
    const float* kaw = p.in[I_KA] + (size_t)ei * 512 + hc0;
    const float* rkw = p.in[I_RK] + (size_t)ei * 512 + hc0;
    __syncthreads();
    for (int e = tid; e < 4096; e += 512) { const int r = e >> 6, c = e & 63; sW2T[c * RW_LD + r] = f2bf(w2[(size_t)r * 512 + c]); sA2T[c * RW_LD + r] = f2bf(a2[(size_t)r * 512 + c]); }
    f4v S0, S1;
    if (sq_.lat) {
        const float* s0 = p.in[I_SRWKV] + ((((size_t)sq_.b * N_EVEN + ei) * 2 + dir) * 8 + h) * 64 * 64 + vi * 64 + 8 * kg;
        S0 = *(const f4v*)s0; S1 = *(const f4v*)(s0 + 4);
    } else { S0 = (f4v){0.f, 0.f, 0.f, 0.f}; S1 = S0; }
    for (int c0 = 0; c0 < sq_.len; c0 += 64) {
        __syncthreads();
        {
            const int i = tid >> 3, c8 = (tid & 7) * 8, pos = c0 + i, t = sq_.start + (dir ? sq_.len - 1 - pos : pos);
            bool hl, hr; tok_nbr(t, hl, hr);
#pragma unroll
            for (int grp = 0; grp < 5; ++grp) {
                const int col = (grp == 0 ? FB_R + hc0 : grp == 1 ? FB_K + hc0 : grp == 2 ? FB_V + hc0 : grp == 3 ? FB_WD + dir * 64 : FB_AD + dir * 64) + c8;
                const bf16* pr = proj + (size_t)t * EW + E_FB + col;
                const f8v x = unpack8v(*(const uint4*)pr);
                f8v nb = (f8v)(0.f);
                if (hl) nb += unpack8v(*(const uint4*)(pr - EW));
                if (hr) nb += unpack8v(*(const uint4*)(pr + EW));
                const f8v mv = *(const f8v*)(mix + col);
                f8v y = x + mv * (nb * 0.5f - x);
                if (grp < 3) { float* dst = (grp == 0 ? sR : grp == 1 ? sKM : sV) + i * 64 + c8; *(f8v*)dst = y; }
                else {
                    if (grp == 3) {
#pragma unroll
                        for (int j = 0; j < 8; ++j) y[j] = tanhf(y[j]);
                    }
                    *(uint4*)((grp == 3 ? sTW : sAD) + i * RW_LD + c8) = pack8v(y);
                }
            }
        }
        __syncthreads();
        {
            const int which = wid >> 2, rt = wid & 3;
            const bf16* Am = which ? sAD : sTW; const bf16* Bm = which ? sA2T : sW2T;
            f4v acc[4];
#pragma unroll
            for (int ct = 0; ct < 4; ++ct) acc[ct] = (f4v){0.f, 0.f, 0.f, 0.f};
#pragma unroll
            for (int ks = 0; ks < 2; ++ks) {
                const s8v a = *(const s8v*)(Am + (16 * rt + fr) * RW_LD + ks * 32 + fq * 8);
#pragma unroll
                for (int ct = 0; ct < 4; ++ct) acc[ct] = mfma16(a, *(const s8v*)(Bm + (16 * ct + fr) * RW_LD + ks * 32 + fq * 8), acc[ct]);
            }
#pragma unroll
            for (int ct = 0; ct < 4; ++ct) {
                const int c = 16 * ct + fr;
                const float bias = which ? a0[c] : w0[c];
#pragma unroll
                for (int r = 0; r < 4; ++r) {
                    const int tok = 16 * rt + fq * 4 + r;
                    const float sg = sigmoidf_(bias + acc[ct][r]);
                    if (which) sKA[tok * 64 + c] = sg; else sW[tok * 64 + c] = expf(-0.6065306597126334f * sg);
                }
            }
        }
        __syncthreads();
        {
            const int i = tid >> 3, c8 = (tid & 7) * 8;
            const f8v av = *(const f8v*)(sKA + i * 64 + c8), kr = *(const f8v*)(sKM + i * 64 + c8), rv = *(const f8v*)(sR + i * 64 + c8);
            const f8v kav = *(const f8v*)(kaw + c8), kkv = *(const f8v*)(kkw + c8), rkv = *(const f8v*)(rkw + c8);
            const f8v km = kr * (1.0f + (av - 1.0f) * kav);
            f8v kk = kr * kkv;
            float ss = 0.f, bn = 0.f;
#pragma unroll
            for (int j = 0; j < 8; ++j) { ss += kk[j] * kk[j]; bn += rv[j] * km[j] * rkv[j]; }
            ss = red8(ss); bn = red8(bn);
            kk *= rsqrtf(ss + EPS);
            *(f8v*)(sKK + i * 64 + c8) = kk; *(f8v*)(sKA + i * 64 + c8) = kk * av; *(f8v*)(sKM + i * 64 + c8) = km;
            if ((tid & 7) == 0) { const int pos = c0 + i, t = sq_.start + (dir ? sq_.len - 1 - pos : pos); bonus[((size_t)t * 8 + h) * 2 + dir] = bn; }
        }
        __syncthreads();
#pragma unroll 2
        for (int i = 0; i < 64; ++i) {
            const int o = i * 64 + 8 * kg;
            const f4v kk0 = *(const f4v*)(sKK + o), kk1 = *(const f4v*)(sKK + o + 4);
            const f4v wv0 = *(const f4v*)(sW + o), wv1 = *(const f4v*)(sW + o + 4);
            const f4v ka0 = *(const f4v*)(sKA + o), ka1 = *(const f4v*)(sKA + o + 4);
            const f4v km0 = *(const f4v*)(sKM + o), km1 = *(const f4v*)(sKM + o + 4);
            const f4v r0 = *(const f4v*)(sR + o), r1 = *(const f4v*)(sR + o + 4);
            const float vv = sV[i * 64 + vi];
            const f4v d = S0 * kk0 + S1 * kk1;
            const float sa = -red8((d[0] + d[1]) + (d[2] + d[3]));
            S0 = S0 * wv0 + (sa * ka0 + vv * km0);
            S1 = S1 * wv1 + (sa * ka1 + vv * km1);
            const f4v e = S0 * r0 + S1 * r1;
            const float y = red8((e[0] + e[1]) + (e[2] + e[3]));
            if (kg == 0) sV[i * 64 + vi] = y;
        }
        __syncthreads();
        {
            const int i = tid >> 3, c8 = (tid & 7) * 8, pos = c0 + i, t = sq_.start + (dir ? sq_.len - 1 - pos : pos);
            *(uint4*)(opart + (size_t)t * 512 + hc0 + c8) = pack8v(*(const f8v*)(sV + i * 64 + c8));
        }
    }
    if (!sq_.lat) {
        float* fs = p.out + OUT_RWKV + ((((size_t)sq_.b * N_EVEN + ei) * 2 + dir) * 8 + h) * 64 * 64 + vi * 64 + 8 * kg;
        *(f4v*)fs = S0; *(f4v*)(fs + 4) = S1;
    }
}
constexpr int EVEN_RWKV_LAT = NB_LAT * 16, EVEN_RWKV_CTX = NB_CTX * 16, EVEN_GLA_LAT = NB_LAT * 8, EVEN_GLA_CTX = NB_CTX * 8;
constexpr int EVEN_SCAN_ITEMS = EVEN_RWKV_LAT + EVEN_RWKV_CTX + EVEN_GLA_LAT + EVEN_GLA_CTX;
__device__ __forceinline__ int sched_item(int G, int b, int k, int nheavy, int total) {
    if (G >= 2 * nheavy) { if (b < nheavy) return k == 0 ? b : -1; const int idx = nheavy + (b - nheavy) + k * (G - nheavy); return idx < total ? idx : -1; }
    const int idx = b + k * G; return idx < total ? idx : -1;
}
__device__ __forceinline__ void ph_even_scan_item(const P& p, int w, int ei, unsigned char* dsm) {
    int kind, sbase, x;
    if (w < EVEN_RWKV_LAT) { kind = 0; sbase = NB_CTX; x = w; }
    else if (w < EVEN_RWKV_LAT + EVEN_RWKV_CTX) { kind = 0; sbase = 0; x = w - EVEN_RWKV_LAT; }
    else if (w < EVEN_RWKV_LAT + EVEN_RWKV_CTX + EVEN_GLA_LAT) { kind = 1; sbase = NB_CTX; x = w - EVEN_RWKV_LAT - EVEN_RWKV_CTX; }
    else { kind = 1; sbase = 0; x = w - EVEN_RWKV_LAT - EVEN_RWKV_CTX - EVEN_GLA_LAT; }
    if (kind == 0) rwkv_scan_task(p, ei, sbase + x / 16, (x % 16) >> 1, x & 1, dsm);
    else gla_scan_task(p, ei, sbase + x / 8, (x % 8) >> 1, x & 1, dsm);
}

__device__ __forceinline__ void ph_fin_even(const P& p, int bid, int ei) {
    const int lane = LT & 63, t = bid * 4 + (LT >> 6);
    if (t >= T) return;
    const bf16* pr = (const bf16*)(p.ws + WS_PROJ) + (size_t)t * EW;
    const bf16* oaf = (const bf16*)(p.ws + WS_PART) + (size_t)t * 512;
    const bf16* oab = (const bf16*)(p.ws + WS_PART + PART_SZ) + (size_t)t * 512;
    const bf16* obf = (const bf16*)(p.ws + WS_PART + 2 * PART_SZ) + (size_t)t * 512;
    const bf16* obb = (const bf16*)(p.ws + WS_PART + 3 * PART_SZ) + (size_t)t * 512;
    bf16* yc = (bf16*)(p.ws + WS_HM) + (size_t)t * D;
    const int idx = lane * 8;
    {
        float o[8], ss = 0.f;
#pragma unroll
        for (int j = 0; j < 8; ++j) { o[j] = bf2f(oaf[idx + j]) + bf2f(oab[idx + j]); ss += o[j] * o[j]; }
        ss += __shfl_xor(ss, 1); ss += __shfl_xor(ss, 2); ss += __shfl_xor(ss, 4); ss += __shfl_xor(ss, 8);
        const float r = rsqrtf(ss * (1.0f / 128.f) + EPS);
        const float* gn = p.in[I_GLAN] + ei * 128 + (idx & 127);
#pragma unroll
        for (int j = 0; j < 8; ++j) yc[idx + j] = f2bf(o[j] * r * gn[j] * siluf_(bf2f(pr[E_ZA + idx + j])));
    }
    {
        float o[8], mu = 0.f;
#pragma unroll
        for (int j = 0; j < 8; ++j) { o[j] = bf2f(obf[idx + j]) + bf2f(obb[idx + j]); mu += o[j]; }
        mu += __shfl_xor(mu, 1); mu += __shfl_xor(mu, 2); mu += __shfl_xor(mu, 4);
        mu *= (1.0f / 64.f);
        float var = 0.f;
#pragma unroll
        for (int j = 0; j < 8; ++j) { o[j] -= mu; var += o[j] * o[j]; }
        var += __shfl_xor(var, 1); var += __shfl_xor(var, 2); var += __shfl_xor(var, 4);
        const float r = rsqrtf(var * (1.0f / 64.f) + 64e-5f);
        const int h = idx >> 6;
        const float* bn = (const float*)(p.ws + WS_BONUS) + ((size_t)t * 8 + h) * 2;
        const float bsum = bn[0] + bn[1];
        bool hl, hr; tok_nbr(t, hl, hr);
        const float* mix = p.in[I_MIX] + (size_t)ei * 1792 + FB_V + idx;
        const float* lg = p.in[I_LNG] + ei * 512 + idx;
        const float* lb = p.in[I_LNB] + ei * 512 + idx;
#pragma unroll
        for (int j = 0; j < 8; ++j) {
            const bf16* pv = pr + E_FB + FB_V + idx + j;
            const float x = bf2f(pv[0]);
            const float nl = hl ? bf2f(pv[-EW]) : 0.f, nr = hr ? bf2f(pv[EW]) : 0.f;
            const float vsh = x + mix[j] * (0.5f * (nl + nr) - x);
            yc[512 + idx + j] = f2bf((o[j] * r * lg[j] + lb[j] + bsum * vsh) * siluf_(bf2f(pr[E_ZB + idx + j])));
        }
    }
}

constexpr int ODD_PREP_ITEMS = (T / 64) * 4;
constexpr int PQ_LD = 136;
__device__ __forceinline__ void ph_odd_prep(const P& p, int item, int oi, unsigned char* dsm) {
    bf16* sq = (bf16*)dsm;
    bf16* sk = sq + 64 * PQ_LD;
    float* sA = (float*)(dsm + 2 * 64 * PQ_LD * 2);
    float* sX = sA + 2 * 4096;
    float* slg = sX + 2 * 4096;
    float* sbt = slg + 128;
    float* sgc = sbt + 128;
    float* sbp = sgc + 128;
    const int tid = opaque_tid(), lane = tid & 63, wid = tid >> 6;
    const int cg = item >> 2, h = item & 3;
    const bf16* proj = (const bf16*)(p.ws + WS_PROJ);
    const float* cw = p.in[I_CONV] + (size_t)oi * 9 * 1536;
    __syncthreads();
    {
        const int i = tid >> 3, sub = tid & 7, t = cg * 64 + i;
        const bool lat = t >= T_CTX;
        int pos, len;
        if (!lat) { pos = t % L_CTX; len = L_CTX; } else { pos = (t - T_CTX) % L_LAT; len = L_LAT; }
        const int gr = pos >> 6, gcl = pos & 63, nrows = len >> 6;
        bf16* qo = (bf16*)(p.ws + WS_QKVN) + (size_t)t * 1536;
#pragma unroll
        for (int part = 0; part < 3; ++part) {
            const int ch = part * 512 + h * 128 + sub * 16;
            f8v a0 = (f8v)(0.f), a1 = (f8v)(0.f);
            for (int di = (lat ? -1 : 0); di <= (lat ? 1 : 0); ++di)
                for (int dj = -1; dj <= 1; ++dj) {
                    bool ok;
                    if (lat) ok = (gr + di >= 0) && (gr + di < nrows) && (gcl + dj >= 0) && (gcl + dj < 64);
                    else ok = (pos + dj >= 0) && (pos + dj < len);
                    if (!ok) continue;
                    const bf16* src = proj + (size_t)(t + di * 64 + dj) * OW + O_QKV + ch;
                    const float* w = cw + ((di + 1) * 3 + (dj + 1)) * 1536 + ch;
                    const f8v x0 = unpack8v(*(const uint4*)src), x1 = unpack8v(*(const uint4*)(src + 8));
                    const f8v w0 = *(const f8v*)w, w1 = *(const f8v*)(w + 8);
                    a0 += x0 * w0; a1 += x1 * w1;
                }
            float ss = 0.f;
#pragma unroll
            for (int j = 0; j < 8; ++j) { a0[j] = siluf_(a0[j]); a1[j] = siluf_(a1[j]); ss += a0[j] * a0[j] + a1[j] * a1[j]; }
            if (part < 2) {
                ss += __shfl_xor(ss, 1); ss += __shfl_xor(ss, 2); ss += __shfl_xor(ss, 4);
                float r = rsqrtf(ss + EPS);
                if (part == 0) r *= 0.08838834764831845f;
                a0 *= r; a1 *= r;
            }
            const uint4 p0 = pack8v(a0), p1 = pack8v(a1);
            *(uint4*)(qo + ch) = p0; *(uint4*)(qo + ch + 8) = p1;
            if (part == 0) { *(uint4*)(sq + i * PQ_LD + sub * 16) = p0; *(uint4*)(sq + i * PQ_LD + sub * 16 + 8) = p1; }
            if (part == 1) { *(uint4*)(sk + i * PQ_LD + sub * 16) = p0; *(uint4*)(sk + i * PQ_LD + sub * 16 + 8) = p1; }
        }
        if (sub < 2) {
            const int dir = sub;
            float* g = (float*)(p.ws + WS_GATES) + (size_t)t * 16;
            const float x = bf2f(proj[(size_t)t * OW + O_G + dir * 4 + h]);
            const float lgv = -expf(p.in[I_ALOG][oi * 8 + dir * 4 + h]) * softplusf_(x + p.in[I_DTB][oi * 8 + dir * 4 + h]);
            const float bv = sigmoidf_(bf2f(proj[(size_t)t * OW + O_BETA + dir * 4 + h]));
            g[dir * 4 + h] = lgv; g[8 + dir * 4 + h] = bv;
            slg[dir * 64 + i] = lgv; sbt[dir * 64 + i] = bv;
        }
    }
    __syncthreads();
    if (tid < 2) {
        const int dir = tid; float c = 0.f;
        for (int i = 0; i < 64; ++i) { const int n = dir ? 63 - i : i; c += slg[dir * 64 + n]; sgc[dir * 64 + i] = c; sbp[dir * 64 + i] = sbt[dir * 64 + n]; }
    }
    __syncthreads();
    {
        const int rt = wid & 3, fr = lane & 15, fq = lane >> 4;
        const bf16* arow = (wid < 4 ? sk : sq) + (16 * rt + fr) * PQ_LD + fq * 8;
        f4v acc[4];
#pragma unroll
        for (int ct = 0; ct < 4; ++ct) acc[ct] = (f4v){0.f, 0.f, 0.f, 0.f};
#pragma unroll
        for (int ks = 0; ks < 4; ++ks) {
            const s8v a = *(const s8v*)(arow + ks * 32);
#pragma unroll
            for (int ct = 0; ct < 4; ++ct) { const s8v bb = *(const s8v*)(sk + (16 * ct + fr) * PQ_LD + fq * 8 + ks * 32); acc[ct] = mfma16(a, bb, acc[ct]); }
        }
        const size_t task0 = ((size_t)cg * 4 + h) * 2;
        bf16* qk0 = (bf16*)(p.ws + WS_QKM) + task0 * 4096; bf16* qk1 = qk0 + 4096;
#pragma unroll
        for (int ct = 0; ct < 4; ++ct)
#pragma unroll
            for (int r = 0; r < 4; ++r) {
                const int a = 16 * rt + fq * 4 + r, b = 16 * ct + fr, i1 = 63 - a, j1 = 63 - b;
                const float v = acc[ct][r];
                if (wid < 4) {
                    if (b < a) sA[b * 64 + a] = sbp[a] * v * expf(sgc[a] - sgc[b]);
                    if (b > a) sA[4096 + j1 * 64 + i1] = sbp[64 + i1] * v * expf(sgc[64 + i1] - sgc[64 + j1]);
                } else {
                    qk0[a * 64 + b] = f2bf(b <= a ? v * expf(sgc[a] - sgc[b]) : 0.f);
                    qk1[i1 * 64 + j1] = f2bf(b >= a ? v * expf(sgc[64 + i1] - sgc[64 + j1]) : 0.f);
                }
            }
    }
    __syncthreads();
    if (wid < 2) {
        const int dir = wid, c = lane;
        const float* AT = sA + dir * 4096;
        float* X = sX + dir * 4096;
        bf16* ti = (bf16*)(p.ws + WS_TINV) + (((size_t)cg * 4 + h) * 2 + dir) * 4096;
#pragma unroll 1
        for (int B = 0; B < 4; ++B) {
            float acc[16];
#pragma unroll
            for (int r = 0; r < 16; ++r) acc[r] = (16 * B + r == c) ? 1.f : 0.f;
#pragma unroll 2
            for (int j = 0; j < 16 * B; ++j) {
                const float xj = X[j * 64 + c];
                const float* ar = AT + j * 64 + 16 * B;
#pragma unroll
                for (int r = 0; r < 16; ++r) acc[r] -= ar[r] * xj;
            }
#pragma unroll
            for (int r2 = 0; r2 < 16; ++r2) {
                const float* ar = AT + (16 * B + r2) * 64 + 16 * B;
#pragma unroll
                for (int r = r2 + 1; r < 16; ++r) acc[r] -= ar[r] * acc[r2];
            }
#pragma unroll
            for (int r = 0; r < 16; ++r) { X[(16 * B + r) * 64 + c] = acc[r]; ti[(16 * B + r) * 64 + c] = f2bf(acc[r]); }
            WAVE_SYNC();
        }
    } else if (wid == 2) {
        float* gco = (float*)(p.ws + WS_GC) + ((size_t)cg * 4 + h) * 128;
        gco[lane] = sgc[lane]; gco[64 + lane] = sgc[64 + lane];
    }
}

constexpr int G_LDS = 136, G_LDT = 72;
__device__ __forceinline__ void gdn_scan_task(const P& p, int oi, int s, int h, int dir, unsigned char* dsm) {
    bf16* St = (bf16*)dsm;
    bf16* Kc = St + 128 * G_LDS;
    bf16* Qc = Kc + 64 * G_LDS;
    bf16* KeT = Qc + 64 * G_LDS;
    bf16* rT = KeT + 128 * G_LDT;
    bf16* dT = rT + 128 * G_LDT;
    bf16* Vc = dT;
    bf16* Ti = dT + 128 * G_LDT;
    bf16* Qk = Ti + 64 * G_LDT;
    float* sgc = (float*)(Qk + 64 * G_LDT);
    float* sbt = sgc + 64;
    const Seq sq_ = get_seq(s);
    const int tid = opaque_tid(), lane = tid & 63, wid = tid >> 6, fr = lane & 15, fq = lane >> 4;
    const int rt = wid & 3, chf = wid >> 2;
    const bf16* qkvn = (const bf16*)(p.ws + WS_QKVN);
    const float* gates = (const float*)(p.ws + WS_GATES);
    bf16* opart = (bf16*)(p.ws + WS_PART + (size_t)dir * PART_SZ);
    f4v Sacc[8];
    __syncthreads();
    if (sq_.lat) {
        const float* s0 = p.in[I_SGDN] + ((((size_t)sq_.b * N_ODD + oi) * 2 + dir) * 4 + h) * 128 * 128;
#pragma unroll
        for (int ct = 0; ct < 8; ++ct)
#pragma unroll
            for (int r = 0; r < 4; ++r) Sacc[ct][r] = s0[(16 * wid + fq * 4 + r) * 128 + 16 * ct + fr];
    } else {
#pragma unroll
        for (int ct = 0; ct < 8; ++ct) Sacc[ct] = (f4v){0.f, 0.f, 0.f, 0.f};
    }
#pragma unroll
    for (int ct = 0; ct < 8; ++ct) *(uint2*)(St + (16 * ct + fr) * G_LDS + 16 * wid + fq * 4) = make_uint2(pack2(Sacc[ct][0], Sacc[ct][1]), pack2(Sacc[ct][2], Sacc[ct][3]));
    const int nch = sq_.len >> 6;
    for (int cc = 0; cc < nch; ++cc) {
        const int cl = dir ? nch - 1 - cc : cc;
        const int cg = (sq_.start >> 6) + cl;
        const size_t task = ((size_t)cg * 4 + h) * 2 + dir;
        const float* gcp = (const float*)(p.ws + WS_GC) + task * 64;
        {
            const float gc63 = gcp[63];
#pragma unroll
            for (int rep = 0; rep < 2; ++rep) {
                const int e = tid + rep * 512, i = e >> 4, c8 = (e & 15) * 8;
                const int t = cg * 64 + (dir ? 63 - i : i);
                const bf16* src = qkvn + (size_t)t * 1536 + h * 128 + c8;
                const uint4 qv = *(const uint4*)src, kv = *(const uint4*)(src + 512), vv = *(const uint4*)(src + 1024);
                *(uint4*)(Qc + i * G_LDS + c8) = qv; *(uint4*)(Kc + i * G_LDS + c8) = kv; *(uint4*)(Vc + i * 128 + c8) = vv;
                float kf[8]; unpack8(kv, kf);
                const float sc = expf(gc63 - gcp[i]);
#pragma unroll
                for (int j = 0; j < 8; ++j) KeT[(c8 + j) * G_LDT + i] = f2bf(kf[j] * sc);
            }
            {
                const int i = tid >> 3, c8 = (tid & 7) * 8;
                *(uint4*)(Ti + i * G_LDT + c8) = *(const uint4*)((const bf16*)(p.ws + WS_TINV) + task * 4096 + i * 64 + c8);
                *(uint4*)(Qk + i * G_LDT + c8) = *(const uint4*)((const bf16*)(p.ws + WS_QKM) + task * 4096 + i * 64 + c8);
            }
            if (tid < 64) { const int t = cg * 64 + (dir ? 63 - tid : tid); sgc[tid] = gcp[tid]; sbt[tid] = gates[(size_t)t * 16 + 8 + dir * 4 + h]; }
        }
        __syncthreads();
        f4v oacc[4];
        {
            f4v kS[4], qS[4];
#pragma unroll
            for (int ct = 0; ct < 4; ++ct) { kS[ct] = (f4v){0.f, 0.f, 0.f, 0.f}; qS[ct] = (f4v){0.f, 0.f, 0.f, 0.f}; }
#pragma unroll
            for (int ks = 0; ks < 4; ++ks) {
                const s8v ak = *(const s8v*)(Kc + (16 * rt + fr) * G_LDS + ks * 32 + fq * 8);
                const s8v aq = *(const s8v*)(Qc + (16 * rt + fr) * G_LDS + ks * 32 + fq * 8);
#pragma unroll
                for (int ct = 0; ct < 4; ++ct) {
                    const s8v bb = *(const s8v*)(St + (64 * chf + 16 * ct + fr) * G_LDS + ks * 32 + fq * 8);
                    kS[ct] = mfma16(ak, bb, kS[ct]); qS[ct] = mfma16(aq, bb, qS[ct]);
                }
            }
            float eg[4], bt[4];
#pragma unroll
            for (int r = 0; r < 4; ++r) { const int i = 16 * rt + fq * 4 + r; eg[r] = expf(sgc[i]); bt[r] = sbt[i]; }
#pragma unroll
            for (int ct = 0; ct < 4; ++ct) {
                const int dv = 64 * chf + 16 * ct + fr;
                float rv[4];
#pragma unroll
                for (int r = 0; r < 4; ++r) { const int i = 16 * rt + fq * 4 + r; rv[r] = bt[r] * (bf2f(Vc[i * 128 + dv]) - eg[r] * kS[ct][r]); oacc[ct][r] = eg[r] * qS[ct][r]; }
                *(uint2*)(rT + dv * G_LDT + 16 * rt + fq * 4) = make_uint2(pack2(rv[0], rv[1]), pack2(rv[2], rv[3]));
            }
        }
        __syncthreads();
        {
            f4v dl[4];
#pragma unroll
            for (int ct = 0; ct < 4; ++ct) dl[ct] = (f4v){0.f, 0.f, 0.f, 0.f};
#pragma unroll
            for (int ks = 0; ks < 2; ++ks) {
                const s8v a = *(const s8v*)(Ti + (16 * rt + fr) * G_LDT + ks * 32 + fq * 8);
#pragma unroll
                for (int ct = 0; ct < 4; ++ct) { const s8v bb = *(const s8v*)(rT + (64 * chf + 16 * ct + fr) * G_LDT + ks * 32 + fq * 8); dl[ct] = mfma16(a, bb, dl[ct]); }
            }
#pragma unroll
            for (int ct = 0; ct < 4; ++ct) { const int dv = 64 * chf + 16 * ct + fr;
                *(uint2*)(dT + dv * G_LDT + 16 * rt + fq * 4) = make_uint2(pack2(dl[ct][0], dl[ct][1]), pack2(dl[ct][2], dl[ct][3])); }
        }
        __syncthreads();
        {
#pragma unroll
            for (int ks = 0; ks < 2; ++ks) {
                const s8v a = *(const s8v*)(Qk + (16 * rt + fr) * G_LDT + ks * 32 + fq * 8);
#pragma unroll
                for (int ct = 0; ct < 4; ++ct) { const s8v bb = *(const s8v*)(dT + (64 * chf + 16 * ct + fr) * G_LDT + ks * 32 + fq * 8); oacc[ct] = mfma16(a, bb, oacc[ct]); }
            }
#pragma unroll
            for (int ct = 0; ct < 4; ++ct)
#pragma unroll
                for (int r = 0; r < 4; ++r) { const int i = 16 * rt + fq * 4 + r, t = cg * 64 + (dir ? 63 - i : i);
                    opart[(size_t)t * 512 + h * 128 + 64 * chf + 16 * ct + fr] = f2bf(oacc[ct][r]); }
            const float ge = expf(sgc[63]);
#pragma unroll
            for (int ct = 0; ct < 8; ++ct) Sacc[ct] *= ge;
#pragma unroll
            for (int ks = 0; ks < 2; ++ks) {
                const s8v a = *(const s8v*)(KeT + (16 * wid + fr) * G_LDT + ks * 32 + fq * 8);
#pragma unroll
                for (int ct = 0; ct < 8; ++ct) { const s8v bb = *(const s8v*)(dT + (16 * ct + fr) * G_LDT + ks * 32 + fq * 8); Sacc[ct] = mfma16(a, bb, Sacc[ct]); }
            }
#pragma unroll
            for (int ct = 0; ct < 8; ++ct) *(uint2*)(St + (16 * ct + fr) * G_LDS + 16 * wid + fq * 4) = make_uint2(pack2(Sacc[ct][0], Sacc[ct][1]), pack2(Sacc[ct][2], Sacc[ct][3]));
        }
        __syncthreads();
    }
    if (!sq_.lat) {
        float* fs = p.out + OUT_GDN + ((((size_t)sq_.b * N_ODD + oi) * 2 + dir) * 4 + h) * 128 * 128;
#pragma unroll
        for (int ct = 0; ct < 8; ++ct)
#pragma unroll
            for (int r = 0; r < 4; ++r) fs[(16 * wid + fq * 4 + r) * 128 + 16 * ct + fr] = Sacc[ct][r];
    }
}
constexpr int S5_HLD = 136;
__device__ __forceinline__ void s5_scan_task(const P& p, int oi, int s, int dir, int g8, unsigned char* dsm) {
    const int tid = opaque_tid(), w = tid >> 6, lane = tid & 63, g = g8 * 8 + w, fr = lane & 15, fq = lane >> 4;
    float* BuL = (float*)(dsm + w * (16 * 128 * 4 + 16 * S5_HLD * 2));
    bf16* Hs = (bf16*)(BuL + 16 * 128);
    const Seq sq_ = get_seq(s);
    const bf16* proj = (const bf16*)(p.ws + WS_PROJ);
    bf16* ypart = (bf16*)(p.ws + WS_PART + (size_t)(2 + dir) * PART_SZ);
    const size_t pg = ((size_t)(oi * 2 + dir) * 32 + g);
    float abr, abi;
    {
        const float are = fminf(p.in[I_S5AR][pg * 64 + lane], -1e-4f), aim = p.in[I_S5AI][pg * 64 + lane];
        const float dt = expf(p.in[I_S5DT][pg]);
        const float mag = expf(are * dt);
        abr = mag * cosf(aim * dt); abi = mag * sinf(aim * dt);
    }
    s8v bfrag[8];
    {
        const float dt = expf(p.in[I_S5DT][pg]);
#pragma unroll
        for (int ct = 0; ct < 8; ++ct) {
            const int st = (16 * ct + fr) & 63;
            const float are = fminf(p.in[I_S5AR][pg * 64 + st], -1e-4f), aim = p.in[I_S5AI][pg * 64 + st];
            const float mag = expf(are * dt), br_ = mag * cosf(aim * dt), bi_ = mag * sinf(aim * dt);
            const float den = are * are + aim * aim;
            const float fre = ((br_ - 1.0f) * are + bi_ * aim) / den, fim = (bi_ * are - (br_ - 1.0f) * aim) / den;
#pragma unroll
            for (int j = 0; j < 8; ++j) {
                float v = 0.f;
                if (fq < 2) {
                    const float br = p.in[I_S5BR][(pg * 64 + st) * 16 + fq * 8 + j], bi = p.in[I_S5BI][(pg * 64 + st) * 16 + fq * 8 + j];
                    v = ct < 4 ? fre * br - fim * bi : fre * bi + fim * br;
                }
                bfrag[ct][j] = (short)f2bf(v);
            }
        }
    }
    s8v cfrag[4];
#pragma unroll
    for (int ks = 0; ks < 4; ++ks)
#pragma unroll
        for (int j = 0; j < 8; ++j) {
            const int pp = 32 * ks + 8 * fq + j;
            const float v = pp < 64 ? p.in[I_S5CR][pg * 1024 + fr * 64 + pp] : -p.in[I_S5CI][pg * 1024 + fr * 64 + pp - 64];
            cfrag[ks][j] = (short)f2bf(v);
        }
    float hr = 0.f, hi = 0.f;
    if (sq_.lat) { const size_t o = (((size_t)sq_.b * N_ODD + oi) * 2 + dir) * 32 * 64 + g * 64 + lane; hr = p.in[I_SS5R][o]; hi = p.in[I_SS5I][o]; }
    for (int c0 = 0; c0 < sq_.len; c0 += 16) {
        s8v ua = (s8v){0, 0, 0, 0, 0, 0, 0, 0};
        {
            const int pos = c0 + fr, t = sq_.start + (dir ? sq_.len - 1 - pos : pos);
            if (fq < 2) ua = *(const s8v*)(proj + (size_t)t * OW + O_U + g * 16 + fq * 8);
        }
        WAVE_SYNC();
#pragma unroll
        for (int ct = 0; ct < 8; ++ct) {
            const f4v bu = mfma16(ua, bfrag[ct], (f4v){0.f, 0.f, 0.f, 0.f});
#pragma unroll
            for (int r = 0; r < 4; ++r) BuL[(fq * 4 + r) * 128 + 16 * ct + fr] = bu[r];
        }
        WAVE_SYNC();
#pragma unroll
        for (int i = 0; i < 16; ++i) {
            const float br = BuL[i * 128 + lane], bi = BuL[i * 128 + 64 + lane];
            const float nr = abr * hr - abi * hi + br, ni = abr * hi + abi * hr + bi;
            hr = nr; hi = ni;
            Hs[i * S5_HLD + lane] = f2bf(hr); Hs[i * S5_HLD + 64 + lane] = f2bf(hi);
        }
        WAVE_SYNC();
        f4v y = (f4v){0.f, 0.f, 0.f, 0.f};
#pragma unroll
        for (int ks = 0; ks < 4; ++ks) y = mfma16(*(const s8v*)(Hs + fr * S5_HLD + 32 * ks + 8 * fq), cfrag[ks], y);
#pragma unroll
        for (int r = 0; r < 4; ++r) { const int pos = c0 + fq * 4 + r, t = sq_.start + (dir ? sq_.len - 1 - pos : pos); ypart[(size_t)t * 512 + g * 16 + fr] = f2bf(y[r]); }
    }
    if (!sq_.lat) {
        const size_t o = (((size_t)sq_.b * N_ODD + oi) * 2 + dir) * 32 * 64 + g * 64 + lane;
        p.out[OUT_S5R + o] = hr; p.out[OUT_S5I + o] = hi;
    }
}
constexpr int ODD_GDN_ITEMS = NSEQ * 8, ODD_S5_ITEMS = NSEQ * 8;
constexpr int ODD_SCAN_ITEMS = ODD_GDN_ITEMS + ODD_S5_ITEMS;
__device__ __forceinline__ void ph_odd_scan_item(const P& p, int w, int oi, float* smem_full) {
    unsigned char* dsm = (unsigned char*)smem_full;
    const int nlg = NB_LAT * 8, nls = NB_LAT * 8, ncg = NB_CTX * 8;
    int kind, sbase, x;
    if (w < nlg) { kind = 0; sbase = NB_CTX; x = w; }
    else if (w < nlg + nls) { kind = 1; sbase = NB_CTX; x = w - nlg; }
    else if (w < nlg + nls + ncg) { kind = 0; sbase = 0; x = w - nlg - nls; }
    else { kind = 1; sbase = 0; x = w - nlg - nls - ncg; }
    if (kind == 0) gdn_scan_task(p, oi, sbase + x / 8, (x % 8) >> 1, x & 1, dsm);
    else { __syncthreads(); s5_scan_task(p, oi, sbase + x / 8, (x % 8) >> 2, x & 3, dsm); }
}
__device__ __forceinline__ void ph_fin_odd_a(const P& p, int bid, int oi) {
    const int lane = LT & 63, t = bid * 4 + (LT >> 6);
    if (t >= T) return;
    const bf16* pr = (const bf16*)(p.ws + WS_PROJ) + (size_t)t * OW;
    const bf16* of = (const bf16*)(p.ws + WS_PART) + (size_t)t * 512;
    const bf16* ob = (const bf16*)(p.ws + WS_PART + PART_SZ) + (size_t)t * 512;
    const bf16* yf = (const bf16*)(p.ws + WS_PART + 2 * PART_SZ) + (size_t)t * 512;
    const bf16* yb = (const bf16*)(p.ws + WS_PART + 3 * PART_SZ) + (size_t)t * 512;
    bf16* yc = (bf16*)(p.ws + WS_HM) + (size_t)t * D;
    const int idx = lane * 8;
    float o[8], ss = 0.f;
#pragma unroll
    for (int j = 0; j < 8; ++j) { o[j] = bf2f(of[idx + j]) + bf2f(ob[idx + j]); ss += o[j] * o[j]; }
    ss += __shfl_xor(ss, 1); ss += __shfl_xor(ss, 2); ss += __shfl_xor(ss, 4); ss += __shfl_xor(ss, 8);
    const float r = rsqrtf(ss * (1.0f / 128.f) + EPS);
    const float* gn = p.in[I_GDNN] + oi * 128 + (idx & 127);
    const float* dsk = p.in[I_S5D] + oi * 512 + idx;
#pragma unroll
    for (int j = 0; j < 8; ++j) {
        yc[idx + j] = f2bf(o[j] * r * gn[j] * siluf_(bf2f(pr[O_ZC + idx + j])));
        const float y = bf2f(yf[idx + j]) + bf2f(yb[idx + j]) + dsk[j] * bf2f(pr[O_U + idx + j]);
        yc[512 + idx + j] = f2bf(gelu_tanh(y));
    }
}
__device__ __forceinline__ void ph_fin_odd_b(const P& p, int bid, int oi) {
    const size_t e = ((size_t)bid * 256 + LT) * 4;
    if (e >= (size_t)T * 512) return;
    const int t = (int)(e >> 9), idx = (int)(e & 511);
    const bf16* pr = (const bf16*)(p.ws + WS_PROJ) + (size_t)t * OW;
    const bf16* gl = (const bf16*)(p.ws + WS_PART + 2 * PART_SZ) + (size_t)t * 512;
    bf16* yc = (bf16*)(p.ws + WS_HM) + (size_t)t * D + 512;
#pragma unroll
    for (int j = 0; j < 4; ++j) {
        const float ys = bf2f(yc[idx + j]);
        yc[idx + j] = f2bf(ys * sigmoidf_(bf2f(gl[idx + j]) + p.in[I_GLUB][oi * 512 + idx + j]) * siluf_(bf2f(pr[O_ZD + idx + j])));
    }
}

enum { PK_PREP0, PK_HMOD0, PK_GEMM_IN, PK_EVEN_SCAN, PK_FIN_EVEN, PK_ODD_PREP, PK_ODD_SCAN, PK_FIN_ODD_A, PK_GEMM_GLU, PK_FIN_ODD_B, PK_GEMM_OUT, PK_POST };
constexpr int NPH = 2 + (DEPTH / 2) * 13;
constexpr int TOKB = (T + 3) / 4;
static_assert(DEPTH % 2 == 0, "even depth expected");
__host__ __device__ inline void phase_desc(int ph, int& kind, int& layer) {
    if (ph == 0) { kind = PK_PREP0; layer = 0; return; }
    if (ph == 1) { kind = PK_HMOD0; layer = 0; return; }
    ph -= 2;
    const int pair = ph / 13, r = ph % 13;
    if (r < 5) { layer = 2 * pair; kind = r == 0 ? PK_GEMM_IN : r == 1 ? PK_EVEN_SCAN : r == 2 ? PK_FIN_EVEN : r == 3 ? PK_GEMM_OUT : PK_POST; }
    else { const int q = r - 5; layer = 2 * pair + 1; kind = q == 0 ? PK_GEMM_IN : q == 1 ? PK_ODD_PREP : q == 2 ? PK_ODD_SCAN : q == 3 ? PK_FIN_ODD_A : q == 4 ? PK_GEMM_GLU : q == 5 ? PK_FIN_ODD_B : q == 6 ? PK_GEMM_OUT : PK_POST; }
}
__host__ __device__ inline bool phase_is_gemm(int kind) { return kind == PK_GEMM_IN || kind == PK_GEMM_GLU || kind == PK_GEMM_OUT; }
__host__ __device__ inline int phase_nblk(int kind, int layer) {
    switch (kind) {
        case PK_PREP0: return DEPTH * 48 + WT_TILES;
        case PK_FIN_ODD_B: return (T * 512 / 4 + 255) / 256;
        default: return TOKB;
    }
}
__device__ __forceinline__ void do_phase(const P& p, int kind, int layer, int vb, float* smem) {
    const int i = layer >> 1;
    switch (kind) {
        case PK_PREP0: if (vb < DEPTH * 48) ph_mod(p, vb, smem); else ph_wt(p, vb - DEPTH * 48, smem); break;
        case PK_HMOD0: ph_hmod0(p, vb); break;
        case PK_FIN_EVEN: ph_fin_even(p, vb, i); break;
        case PK_FIN_ODD_A: ph_fin_odd_a(p, vb, i); break;
        case PK_FIN_ODD_B: ph_fin_odd_b(p, vb, i); break;
        case PK_POST: ph_post(p, vb, layer); break;
    }
}
__device__ __forceinline__ void do_gemm(const P& p, int kind, int layer, int G, int c, unsigned char* dsm) {
    const int i = layer >> 1;
    const bf16* hm = (const bf16*)(p.ws + WS_HM);
    pg8::StaticOrder S;
    LDS_AS unsigned char* lds = (LDS_AS unsigned char*)dsm;
    if (kind == PK_GEMM_IN) {
        if ((layer & 1) == 0) { pg8::Gemm g{hm, (const bf16*)(p.ws + WS_WTE) + (size_t)i * EWP * D, T, EWP, D, D}; S.init(T, EWP, G, c); pg8::EpiBf16 E{(bf16*)(p.ws + WS_PROJ), EW, EW}; pg8::gemm_phase(lds, g, S, E); }
        else { pg8::Gemm g{hm, (const bf16*)(p.ws + WS_WTO) + (size_t)i * OWP * D, T, OWP, D, D}; S.init(T, OWP, G, c); pg8::EpiBf16 E{(bf16*)(p.ws + WS_PROJ), OW, OW}; pg8::gemm_phase(lds, g, S, E); }
    } else if (kind == PK_GEMM_GLU) {
        pg8::Gemm g{hm + 512, (const bf16*)(p.ws + WS_WTGLU) + (size_t)i * 512 * 512, T, 512, 512, D}; S.init(T, 512, G, c); pg8::EpiBf16 E{(bf16*)(p.ws + WS_PART + 2 * PART_SZ), 512, 512}; pg8::gemm_phase(lds, g, S, E);
    } else {
        pg8::Gemm g{hm, (const bf16*)(p.ws + WS_WTOUT) + (size_t)layer * D * D, T, D, D, D}; S.init(T, D, G, c); pg8::EpiF32 E{(float*)(p.ws + WS_PROJ), D}; pg8::gemm_phase(lds, g, S, E);
    }
}
constexpr int LDS_BYTES = 163840;
#ifndef REP_SCAN
#define REP_SCAN 1
#endif
#ifndef REP_GEMM
#define REP_GEMM 1
#endif

#ifdef CPU_EMU
__global__ void k_phase(P p, int kind, int layer, int nb) {
    __shared__ __attribute__((aligned(16))) unsigned char dsm[LDS_BYTES];
    if (phase_is_gemm(kind)) { do_gemm(p, kind, layer, gridDim.x, blockIdx.x, dsm); return; }
    if (kind == PK_ODD_SCAN) { ph_odd_scan_item(p, blockIdx.x, layer >> 1, (float*)dsm); return; }
    if (kind == PK_ODD_PREP) { ph_odd_prep(p, blockIdx.x, layer >> 1, dsm); return; }
    if (kind == PK_EVEN_SCAN) { ph_even_scan_item(p, blockIdx.x, layer >> 1, dsm); return; }
    const int half = threadIdx.x >> 8, vb = 2 * blockIdx.x + half;
    if (vb < nb) do_phase(p, kind, layer, vb, (float*)dsm + half * 16384);
}
void emu_hook(const char* stage, int layer, const P& p);
extern "C" void kernel_launch(void* const* d_in, const int* in_sizes, int n_in, void* d_out, int out_size, void* d_ws, size_t ws_size, hipStream_t stream) {
    P p{};
    for (int i = 0; i < 44; ++i) p.in[i] = (const float*)d_in[i];
    p.out = (float*)d_out; p.ws = (char*)d_ws;
    static const char* names[] = {"prep0", "hmod", "proj", "even_scan", "ycat", "odd_prep", "odd_scan", "fin_odd_a", "glu", "ycat", "outproj", "post"};
    for (int ph = 0; ph < NPH; ++ph) {
        int kind, layer; phase_desc(ph, kind, layer);
        const int nb = phase_nblk(kind, layer);
        EMU_LAUNCH(k_phase, phase_is_gemm(kind) ? 3 : kind == PK_ODD_SCAN ? ODD_SCAN_ITEMS : kind == PK_EVEN_SCAN ? EVEN_SCAN_ITEMS : kind == PK_ODD_PREP ? ODD_PREP_ITEMS : (nb + 1) / 2, 512, p, kind, layer, nb);
        emu_hook(names[kind], layer, p);
    }
}
#else
extern __shared__ __attribute__((aligned(16))) unsigned char dsm[];
#define RUN_PHASE(KIND, LAYER) do { const int nb_ = phase_nblk(KIND, LAYER); const int half_ = opaque_tid() >> 8; \
    for (int b_ = blockIdx.x; 2 * b_ < nb_; b_ += gridDim.x) { const int vb_ = 2 * b_ + half_; if (vb_ < nb_) do_phase(p, KIND, LAYER, vb_, (float*)dsm + half_ * 16384); } } while (0)
#define RUN_GEMM(KIND, LAYER) do_gemm(p, KIND, LAYER, gridDim.x, blockIdx.x, dsm)
__global__ void __launch_bounds__(512) mega(P p) {
    cg::grid_group grid = cg::this_grid();
    RUN_PHASE(PK_PREP0, 0); grid.sync();
    RUN_PHASE(PK_HMOD0, 0); grid.sync();
#pragma nounroll
    for (int pair = 0; pair < DEPTH / 2; ++pair) {
        const int le = 2 * pair, lo = 2 * pair + 1;
        for (int r_ = 0; r_ < REP_GEMM; ++r_) { RUN_GEMM(PK_GEMM_IN, le); grid.sync(); }
        for (int k_ = 0;; ++k_) { const int w_ = sched_item(gridDim.x, blockIdx.x, k_, EVEN_RWKV_LAT, EVEN_SCAN_ITEMS); if (w_ < 0) break; ph_even_scan_item(p, w_, pair, dsm); }
        grid.sync();
        RUN_PHASE(PK_FIN_EVEN, le); grid.sync();
        RUN_GEMM(PK_GEMM_OUT, le); grid.sync();
        RUN_PHASE(PK_POST, le); grid.sync();
        for (int r_ = 0; r_ < REP_GEMM; ++r_) { RUN_GEMM(PK_GEMM_IN, lo); grid.sync(); }
        for (int w_ = blockIdx.x; w_ < ODD_PREP_ITEMS; w_ += gridDim.x) ph_odd_prep(p, w_, pair, dsm);
        grid.sync();
        for (int r_ = 0; r_ < REP_SCAN; ++r_) { for (int w_ = blockIdx.x; w_ < ODD_SCAN_ITEMS; w_ += gridDim.x) ph_odd_scan_item(p, w_, pair, (float*)dsm);
        grid.sync(); }
        RUN_PHASE(PK_FIN_ODD_A, lo); grid.sync();
        RUN_GEMM(PK_GEMM_GLU, lo); grid.sync();
        RUN_PHASE(PK_FIN_ODD_B, lo); grid.sync();
        RUN_GEMM(PK_GEMM_OUT, lo); grid.sync();
        RUN_PHASE(PK_POST, lo);
        if (pair + 1 < DEPTH / 2) grid.sync();
    }
}
extern "C" void kernel_launch(void* const* d_in, const int* in_sizes, int n_in, void* d_out, int out_size, void* d_ws, size_t ws_size, hipStream_t stream) {
    static int grid_blocks = 0;
    if (!grid_blocks) {
        int dev = 0, cus = 0, per_cu = 0;
        (void)hipGetDevice(&dev);
        (void)hipDeviceGetAttribute(&cus, hipDeviceAttributeMultiprocessorCount, dev);
        (void)hipFuncSetAttribute((const void*)mega, hipFuncAttributeMaxDynamicSharedMemorySize, LDS_BYTES);
        (void)hipOccupancyMaxActiveBlocksPerMultiprocessor(&per_cu, mega, 512, LDS_BYTES);
        if (per_cu < 1) fprintf(stderr, "occupancy query says %d blocks/CU\n", per_cu);
        grid_blocks = cus;
    }
    P p{};
    for (int i = 0; i < 44; ++i) p.in[i] = (const float*)d_in[i];
    p.out = (float*)d_out; p.ws = (char*)d_ws;
    void* args[] = {&p};
    hipError_t e = hipLaunchCooperativeKernel((void*)mega, dim3(grid_blocks), dim3(512), args, LDS_BYTES, stream);
    if (e != hipSuccess) fprintf(stderr, "cooperative launch failed: %s (grid %d)\n", hipGetErrorString(e), grid_blocks);
}
#endif
```

```cpp
#ifndef CPU_EMU
#include <hip/hip_runtime.h>
#include <hip/hip_cooperative_groups.h>
#include <cstdio>
namespace cg = cooperative_groups;
#endif
#include <stdint.h>

#ifndef CFG_BATCH
#define CFG_BATCH 16
#define CFG_SEQ 256
#define CFG_DEC_BATCH 8
#define CFG_DEC_SEQ 1024
#define CFG_DEPTH 4
#endif

typedef unsigned short bf16;
typedef short s8v __attribute__((ext_vector_type(8)));
typedef float f4v __attribute__((ext_vector_type(4)));

constexpr int D = 1024;
constexpr int NB_CTX = CFG_BATCH, L_CTX = CFG_SEQ, NB_LAT = CFG_DEC_BATCH, L_LAT = CFG_DEC_SEQ, DEPTH = CFG_DEPTH;
constexpr int N_EVEN = (DEPTH + 1) / 2, N_ODD = DEPTH / 2;
constexpr int T_CTX = NB_CTX * L_CTX, T_LAT = NB_LAT * L_LAT, T = T_CTX + T_LAT;
constexpr int NSEQ = NB_CTX + NB_LAT, NCOND = 1 + NB_LAT;
constexpr int EW = 3872, OW = 3088, EWP = 4096, OWP = 3328;
constexpr float EPS = 1e-6f;
constexpr int E_Q = 0, E_K = 256, E_V = 512, E_GD = 1024, E_ZA = 1056, E_FB = 1568, E_ZB = 3360;
constexpr int FB_R = 0, FB_K = 512, FB_V = 1024, FB_WD = 1536, FB_AD = 1664;
constexpr int O_QKV = 0, O_G = 1536, O_BETA = 1544, O_ZC = 1552, O_U = 2064, O_ZD = 2576;

constexpr size_t al(size_t x) { return (x + 255) & ~(size_t)255; }
constexpr size_t WS_MOD = 0;
constexpr size_t WS_WTE = WS_MOD + al((size_t)DEPTH * NCOND * 3072 * 4);
constexpr size_t WS_WTO = WS_WTE + al((size_t)N_EVEN * EWP * D * 2);
constexpr size_t WS_WTOUT = WS_WTO + al((size_t)(N_ODD ? N_ODD : 1) * OWP * D * 2);
constexpr size_t WS_WTGLU = WS_WTOUT + al((size_t)DEPTH * D * D * 2);
constexpr size_t WS_HM = WS_WTGLU + al((size_t)(N_ODD ? N_ODD : 1) * 512 * 512 * 2);
constexpr size_t WS_PROJ = WS_HM + al((size_t)T * D * 2);
constexpr size_t WS_PART = WS_PROJ + al((size_t)T * EW * 2);
constexpr size_t PART_SZ = al((size_t)T * 512 * 2);
constexpr size_t WS_BONUS = WS_PART + 4 * PART_SZ;
constexpr size_t WS_QKVN = WS_BONUS + al((size_t)T * 16 * 4);
constexpr size_t WS_GATES = WS_QKVN + al((size_t)T * 1536 * 2);
constexpr size_t WS_GC = WS_GATES + al((size_t)T * 16 * 4);
constexpr size_t WS_BAR = WS_GC + al((size_t)(T / 64) * 8 * 64 * 4);
constexpr size_t WS_END = WS_BAR + 16384;
constexpr size_t WS_TINV = WS_PROJ + al((size_t)T * OW * 2);
constexpr size_t WS_QKM = WS_HM;
static_assert(WS_TINV + (size_t)T * 1024 <= WS_PART, "TINV must fit in the PROJ tail");
constexpr size_t WS_RM12 = WS_HM;
constexpr size_t WS_RM34 = WS_QKVN;
constexpr size_t WS_VSH = WS_QKVN + (size_t)(T / 64) * 8 * 16384;
static_assert((size_t)(T / 64) * 8 * 16384 <= (size_t)T * D * 2, "M1/M2 must fit in HM");
static_assert((size_t)(T / 64) * 8 * 16384 + (size_t)T * 512 * 2 <= (size_t)T * 1536 * 2, "M3/M4 + shifted v must fit in QKVN");

constexpr size_t OUT_X = 0;
constexpr size_t OUT_GLA = (size_t)T * D;
constexpr size_t OUT_RWKV = OUT_GLA + (size_t)NB_CTX * N_EVEN * 2 * 4 * 64 * 128;
constexpr size_t OUT_GDN = OUT_RWKV + (size_t)NB_CTX * N_EVEN * 2 * 8 * 64 * 64;
constexpr size_t OUT_S5R = OUT_GDN + (size_t)NB_CTX * N_ODD * 2 * 4 * 128 * 128;
constexpr size_t OUT_S5I = OUT_S5R + (size_t)NB_CTX * N_ODD * 2 * 32 * 64;

struct P {
    const float* in[44];
    float* out;
    char* ws;
};
enum { I_XP = 0, I_XS, I_C, I_SGLA, I_SRWKV, I_SGDN, I_SS5R, I_SS5I, I_CCTX, I_WMOD, I_BMOD, I_GPRE, I_GPOST,
       I_WINE, I_WOUTE, I_GUP, I_GBIAS, I_GLAN, I_MIX, I_W0, I_W2, I_A0, I_A2, I_KK, I_KA, I_RK, I_LNG, I_LNB,
       I_WINO, I_WOUTO, I_CONV, I_ALOG, I_DTB, I_GDNN, I_S5AR, I_S5AI, I_S5DT, I_S5BR, I_S5BI, I_S5CR, I_S5CI,
       I_S5D, I_GLUW, I_GLUB };

#ifdef CPU_EMU
__device__ __forceinline__ int opaque_tid() { return (int)threadIdx.x; }
#else
__device__ __forceinline__ int opaque_tid() { int t = (int)threadIdx.x; asm volatile("" : "+v"(t)); return t; }
#endif
#define LT (opaque_tid() & 255)
__device__ __forceinline__ float u2f(unsigned u) { return __builtin_bit_cast(float, u); }
__device__ __forceinline__ unsigned f2u(float f) { return __builtin_bit_cast(unsigned, f); }
__device__ __forceinline__ float bf2f(bf16 h) { return u2f((unsigned)h << 16); }
#ifdef CPU_EMU
__device__ __forceinline__ bf16 f2bf(float f) { unsigned u = f2u(f); u += 0x7fffu + ((u >> 16) & 1u); return (bf16)(u >> 16); }
__device__ __forceinline__ unsigned pack2(float lo, float hi) { return (unsigned)f2bf(lo) | ((unsigned)f2bf(hi) << 16); }
__device__ __forceinline__ float fexp(float x) { return expf(x); }
__device__ __forceinline__ float flog(float x) { return logf(x); }
__device__ __forceinline__ float frcp(float x) { return 1.0f / x; }
__device__ __forceinline__ float frsq(float x) { return 1.0f / sqrtf(x); }
#else
typedef __bf16 hwbf2 __attribute__((ext_vector_type(2)));
typedef float hwf2 __attribute__((ext_vector_type(2)));
__device__ __forceinline__ unsigned pack2(float lo, float hi) { hwf2 v = {lo, hi}; return __builtin_bit_cast(unsigned, __builtin_convertvector(v, hwbf2)); }
__device__ __forceinline__ bf16 f2bf(float f) { return (bf16)(pack2(f, 0.f) & 0xffffu); }
__device__ __forceinline__ float fexp(float x) { return __builtin_amdgcn_exp2f(x * 1.4426950408889634f); }
__device__ __forceinline__ float flog(float x) { return __builtin_amdgcn_logf(x) * 0.6931471805599453f; }
__device__ __forceinline__ float frcp(float x) { return __builtin_amdgcn_rcpf(x); }
__device__ __forceinline__ float frsq(float x) { return __builtin_amdgcn_rsqf(x); }
#endif
__device__ __forceinline__ float sigmoidf_(float x) { return frcp(1.0f + fexp(-x)); }
__device__ __forceinline__ float siluf_(float x) { return x * frcp(1.0f + fexp(-x)); }
__device__ __forceinline__ float logsigf_(float x) { return fminf(x, 0.f) - flog(1.0f + fexp(-fabsf(x))); }
__device__ __forceinline__ float softplusf_(float x) { return fmaxf(x, 0.f) + flog(1.0f + fexp(-fabsf(x))); }
__device__ __forceinline__ float ftanh(float x) { const float e = fexp(-2.0f * fabsf(x)); const float t = (1.0f - e) * frcp(1.0f + e); return x < 0.f ? -t : t; }
__device__ __forceinline__ float gelu_tanh(float x) { return 0.5f * x * (1.0f + ftanh(0.7978845608028654f * (x + 0.044715f * x * x * x))); }

struct Seq { int start, len, cond, lat, b; };
__device__ __forceinline__ Seq get_seq(int s) {
    Seq q;
    if (s < NB_CTX) { q.start = s * L_CTX; q.len = L_CTX; q.cond = 0; q.lat = 0; q.b = s; }
    else { int b = s - NB_CTX; q.start = T_CTX + b * L_LAT; q.len = L_LAT; q.cond = 1 + b; q.lat = 1; q.b = b; }
    return q;
}
__device__ __forceinline__ int tok_cond(int t) { return t < T_CTX ? 0 : 1 + (t - T_CTX) / L_LAT; }
__device__ __forceinline__ void tok_nbr(int t, bool& hl, bool& hr) {
    if (t < T_CTX) { int pos = t % L_CTX; hl = pos != 0; hr = pos != L_CTX - 1; }
    else { int pos = (t - T_CTX) & 63; hl = pos != 0; hr = pos != 63; }
}

__device__ __forceinline__ void ph_mod(const P& p, int bid, float* smem) {
    float (*sc)[1024] = (float(*)[1024])smem;
    float (*red)[64][NCOND] = (float(*)[64][NCOND])(smem + NCOND * 1024);
    const int layer = bid / 48, ct = bid % 48;
    __syncthreads();
    const int tid = LT, cl = tid & 63, kg = tid >> 6;
    for (int i = tid; i < NCOND * 1024; i += 256) {
        int ci = i >> 10, k = i & 1023;
        float v = ci == 0 ? p.in[I_CCTX][k] : p.in[I_C][(ci - 1) * 1024 + k];
        sc[ci][k] = siluf_(v);
    }
    __syncthreads();
    float acc[NCOND];
#pragma unroll
    for (int ci = 0; ci < NCOND; ++ci) acc[ci] = 0.f;
    const float* w = p.in[I_WMOD] + (size_t)layer * 1024 * 3072 + ct * 64 + cl;
    for (int kk = 0; kk < 256; ++kk) {
        int k = kg * 256 + kk;
        float wv = w[(size_t)k * 3072];
#pragma unroll
        for (int ci = 0; ci < NCOND; ++ci) acc[ci] += sc[ci][k] * wv;
    }
#pragma unroll
    for (int ci = 0; ci < NCOND; ++ci) red[kg][cl][ci] = acc[ci];
    __syncthreads();
    if (tid < 64) {
        float* mod = (float*)(p.ws + WS_MOD);
        int col = ct * 64 + cl;
#pragma unroll
        for (int ci = 0; ci < NCOND; ++ci)
            mod[(size_t)(layer * NCOND + ci) * 3072 + col] = red[0][cl][ci] + red[1][cl][ci] + red[2][cl][ci] + red[3][cl][ci] + p.in[I_BMOD][layer * 3072 + col];
    }
}

struct WtJob { const float* src; bf16* dst; int K, N, Npad; };
__device__ __forceinline__ WtJob wt_job(const P& p, int j) {
    WtJob q;
    if (j < N_EVEN) { q.src = p.in[I_WINE] + (size_t)j * D * EW; q.dst = (bf16*)(p.ws + WS_WTE) + (size_t)j * EWP * D; q.K = D; q.N = EW; q.Npad = EWP; return q; }
    j -= N_EVEN;
    if (j < N_ODD) { q.src = p.in[I_WINO] + (size_t)j * D * OW; q.dst = (bf16*)(p.ws + WS_WTO) + (size_t)j * OWP * D; q.K = D; q.N = OW; q.Npad = OWP; return q; }
    j -= N_ODD;
    if (j < DEPTH) { int i = j >> 1; q.src = (j & 1) ? p.in[I_WOUTO] + (size_t)i * D * D : p.in[I_WOUTE] + (size_t)i * D * D; q.dst = (bf16*)(p.ws + WS_WTOUT) + (size_t)j * D * D; q.K = D; q.N = D; q.Npad = D; return q; }
    j -= DEPTH;
    q.src = p.in[I_GLUW] + (size_t)j * 512 * 512; q.dst = (bf16*)(p.ws + WS_WTGLU) + (size_t)j * 512 * 512; q.K = 512; q.N = 512; q.Npad = 512; return q;
}
constexpr int WT_NJOBS = N_EVEN + N_ODD + DEPTH + N_ODD;
constexpr int WT_TILES = N_EVEN * (EWP / 64) * 16 + N_ODD * (OWP / 64) * 16 + DEPTH * 256 + N_ODD * 64;
__device__ __forceinline__ void ph_wt(const P& p, int bid, float* smem) {
    float (*tile)[65] = (float(*)[65])smem;
    int b = bid, j = 0;
    __syncthreads();
    WtJob q;
    for (;; ++j) { q = wt_job(p, j); int nt = (q.Npad / 64) * (q.K / 64); if (b < nt) break; b -= nt; }
    const int nk = q.K / 64, n0 = (b / nk) * 64, k0 = (b % nk) * 64;
    const int tx = LT & 63, ty = LT >> 6;
#pragma unroll
    for (int i = 0; i < 16; ++i) { int kk = ty + 4 * i, n = n0 + tx; tile[kk][tx] = n < q.N ? q.src[(size_t)(k0 + kk) * q.N + n] : 0.f; }
    __syncthreads();
#pragma unroll
    for (int i = 0; i < 16; ++i) { int nn = ty + 4 * i; q.dst[(size_t)(n0 + nn) * q.K + k0 + tx] = f2bf(tile[tx][nn]); }
}

__device__ __forceinline__ float wave_sum(float v) {
#pragma unroll
    for (int m = 1; m < 64; m <<= 1) v += __shfl_xor(v, m);
    return v;
}
__device__ __forceinline__ void hmod_row(const float* xv  , int lane, const float* gpre, const float* mod, bf16* dst) {
    float ss = 0.f;
#pragma unroll
    for (int i = 0; i < 16; ++i) ss += xv[i] * xv[i];
    ss = wave_sum(ss);
    const float r = frsq(ss * (1.0f / 1024.f) + EPS);
#pragma unroll
    for (int i = 0; i < 4; ++i) {
        int idx = i * 256 + lane * 4;
        bf16 o[4];
#pragma unroll
        for (int j = 0; j < 4; ++j) o[j] = f2bf(xv[i * 4 + j] * r * gpre[idx + j] * (1.0f + mod[1024 + idx + j]) + mod[idx + j]);
        *(uint2*)(dst + idx) = make_uint2((unsigned)o[0] | ((unsigned)o[1] << 16), (unsigned)o[2] | ((unsigned)o[3] << 16));
    }
}
__device__ __forceinline__ void ph_hmod0(const P& p, int bid) {
    const int lane = LT & 63, t = bid * 4 + (LT >> 6);
    if (t >= T) return;
    const float* xr = t < T_CTX ? p.in[I_XP] + (size_t)t * D : p.in[I_XS] + (size_t)(t - T_CTX) * D;
    float xv[16];
#pragma unroll
    for (int i = 0; i < 4; ++i) { float4 v = *(const float4*)(xr + i * 256 + lane * 4); xv[i * 4] = v.x; xv[i * 4 + 1] = v.y; xv[i * 4 + 2] = v.z; xv[i * 4 + 3] = v.w; }
    const float* mod = (const float*)(p.ws + WS_MOD) + (size_t)(0 * NCOND + tok_cond(t)) * 3072;
    hmod_row(xv, lane, p.in[I_GPRE], mod, (bf16*)(p.ws + WS_HM) + (size_t)t * D);
}
__device__ __forceinline__ void ph_post(const P& p, int bid, int layer) {
    const int lane = LT & 63, t = bid * 4 + (LT >> 6);
    if (t >= T) return;
    const float* xr = layer == 0 ? (t < T_CTX ? p.in[I_XP] + (size_t)t * D : p.in[I_XS] + (size_t)(t - T_CTX) * D) : p.out + OUT_X + (size_t)t * D;
    const float* mr = (const float*)(p.ws + WS_PROJ) + (size_t)t * D;
    const float* mod = (const float*)(p.ws + WS_MOD) + (size_t)(layer * NCOND + tok_cond(t)) * 3072;
    const float* gpost = p.in[I_GPOST] + layer * D;
    float xv[16], mv[16];
    float ss = 0.f;
#pragma unroll
    for (int i = 0; i < 4; ++i) {
        float4 v = *(const float4*)(xr + i * 256 + lane * 4); xv[i * 4] = v.x; xv[i * 4 + 1] = v.y; xv[i * 4 + 2] = v.z; xv[i * 4 + 3] = v.w;
        float4 m = *(const float4*)(mr + i * 256 + lane * 4); mv[i * 4] = m.x; mv[i * 4 + 1] = m.y; mv[i * 4 + 2] = m.z; mv[i * 4 + 3] = m.w;
    }
#pragma unroll
    for (int i = 0; i < 16; ++i) ss += mv[i] * mv[i];
    ss = wave_sum(ss);
    const float r = frsq(ss * (1.0f / 1024.f) + EPS);
    float* xo = p.out + OUT_X + (size_t)t * D;
#pragma unroll
    for (int i = 0; i < 4; ++i) {
        int idx = i * 256 + lane * 4;
#pragma unroll
        for (int j = 0; j < 4; ++j) xv[i * 4 + j] += mod[2048 + idx + j] * (mv[i * 4 + j] * r * gpost[idx + j]);
        *(float4*)(xo + idx) = make_float4(xv[i * 4], xv[i * 4 + 1], xv[i * 4 + 2], xv[i * 4 + 3]);
    }
    if (layer + 1 < DEPTH) {
        const float* mod2 = (const float*)(p.ws + WS_MOD) + (size_t)((layer + 1) * NCOND + tok_cond(t)) * 3072;
        hmod_row(xv, lane, p.in[I_GPRE] + (layer + 1) * D, mod2, (bf16*)(p.ws + WS_HM) + (size_t)t * D);
    }
}

#ifdef CPU_EMU
#define LDS_AS
#define GLDS16(gptr, lptr) memcpy((char*)(lptr) + (threadIdx.x & 63) * 16, (const void*)(gptr), 16)
#define PG_WAIT_V(n)
#define PG_WAIT_L(n)
#define PG_BAR __syncthreads()
#define PG_SCHED
#define PG_PRIO(x)
#define RFL(x) (x)
__device__ __forceinline__ unsigned cvt_pk_bf16(float lo, float hi) { return (unsigned)f2bf(lo) | ((unsigned)f2bf(hi) << 16); }
#else
#define LDS_AS __attribute__((address_space(3)))
#define GLDS16(gptr, lptr) __builtin_amdgcn_global_load_lds((const unsigned*)(gptr), (LDS_AS unsigned*)(lptr), 16, 0, 0)
#define PG_WAIT_V(n) asm volatile("s_waitcnt vmcnt(" #n ")" ::: "memory")
#define PG_WAIT_L(n) asm volatile("s_waitcnt lgkmcnt(" #n ")" ::: "memory")
#define PG_BAR __builtin_amdgcn_s_barrier()
#define PG_SCHED __builtin_amdgcn_sched_barrier(0)
#define PG_PRIO(x) __builtin_amdgcn_s_setprio(x)
#define RFL(x) __builtin_amdgcn_readfirstlane(x)
__device__ __forceinline__ unsigned cvt_pk_bf16(float lo, float hi) { return pack2(lo, hi); }
#endif
namespace pg8 {
constexpr int BM = 256, BK = 64, HALF = 128, HTB = HALF * BK * 2, STAGE_BYTES = 8 * HTB, NXCD = 8, WGM = 8;
__host__ __device__ __forceinline__ int lds_byte(int r, int c) { const int st = (r >> 4) * 2 + (c >> 5), rr = r & 15, cc = c & 31, ob = rr * 64 + cc * 2; return st * 1024 + (ob ^ (((ob >> 9) & 1) << 5)); }
__host__ __device__ __forceinline__ void stage_rc(int b, int& R, int& C) { const int st = b / 1024, sb = b % 1024, swz = sb ^ (((sb >> 9) & 1) << 5); R = (st >> 1) * 16 + swz / 64; C = (st & 1) * 32 + (swz % 64) / 2; }
__host__ __device__ __forceinline__ int perm32(int rho) { const int n = rho >> 4, i = rho & 15; return 8 * (i >> 2) + 4 * n + (i & 3); }
struct Unit { int pm, pn; };
struct Gemm { const bf16* A; const bf16* Bt; int M, N, K, lda; };
struct StaticOrder {
    int nM, nN, nwg, G, c;
    __host__ __device__ void init(int M, int N, int G_, int c_) { nM = M / BM; nN = N / BM; nwg = nM * nN; G = G_; c = c_; }
    __host__ __device__ bool next(int i, Unit& u) const {
        const long L = (long)i * G + c; if (L >= nwg) return false;
        int wgid = (int)L; { const int q = nwg / NXCD, r = nwg % NXCD, xcd = wgid % NXCD, off = wgid / NXCD; wgid = (xcd < r ? xcd * (q + 1) : r * (q + 1) + (xcd - r) * q) + off; }
        const int nig = WGM * nN, gid = wgid / nig, fm = gid * WGM, gsz = (nM - fm) < WGM ? (nM - fm) : WGM;
        u.pm = fm + ((wgid % nig) % gsz); u.pn = (wgid % nig) / gsz; return true;
    }
};
struct EpiF32 {
    static constexpr bool PERM = false;
    float* C; int ldc;
    __device__ __forceinline__ void operator()(const f4v (&acc)[2][2][4][2], const Unit& u, int wr, int wc, int fr, int fq) const {
        const int row0 = u.pm * BM + wr * 64 + fr, col0 = u.pn * BM + wc * 32 + 4 * fq;
#pragma unroll
        for (int ai = 0; ai < 2; ++ai)
#pragma unroll
            for (int m = 0; m < 4; ++m) { float* rowp = C + (size_t)(row0 + ai * HALF + m * 16) * ldc + col0;
#pragma unroll
                for (int bj = 0; bj < 2; ++bj)
#pragma unroll
                    for (int n = 0; n < 2; ++n) *(f4v*)(rowp + bj * HALF + n * 16) = acc[ai][bj][m][n]; }
    }
};
struct EpiBf16 {
    static constexpr bool PERM = true;
    bf16* O; int ldc; int N;
    __device__ __forceinline__ void operator()(const f4v (&acc)[2][2][4][2], const Unit& u, int wr, int wc, int fr, int fq) const {
        const int row0 = u.pm * BM + wr * 64 + fr, col0 = u.pn * BM + wc * 32 + 8 * fq;
#pragma unroll
        for (int ai = 0; ai < 2; ++ai)
#pragma unroll
            for (int m = 0; m < 4; ++m) { bf16* rowp = O + (size_t)(row0 + ai * HALF + m * 16) * ldc + col0;
#pragma unroll
                for (int bj = 0; bj < 2; ++bj) { const f4v v0 = acc[ai][bj][m][0], v1 = acc[ai][bj][m][1];
                    if (col0 + bj * HALF < N) *(uint4*)(rowp + bj * HALF) = make_uint4(cvt_pk_bf16(v0[0], v0[1]), cvt_pk_bf16(v0[2], v0[3]), cvt_pk_bf16(v1[0], v1[1]), cvt_pk_bf16(v1[2], v1[3])); } }
    }
};
template <class Epi>
__device__ __forceinline__ void gemm_phase(LDS_AS unsigned char* lds, const Gemm g, const StaticOrder& S, const Epi& E) {
    const int tid = opaque_tid(), wid = RFL(tid >> 6), lane = tid & 63, wr = wid >> 2, wc = wid & 3, fr = lane & 15, fq = lane >> 4;
    const int K = g.K, nt = K / BK;
    unsigned voffA[2], voffB[2];
#pragma unroll
    for (int i = 0; i < 2; ++i) { int R, C; stage_rc(tid * 16 + i * 8192, R, C); const int Rb = Epi::PERM ? ((R & ~31) + perm32(R & 31)) : R;
        voffA[i] = (unsigned)(R * g.lda + C) * 2u; voffB[i] = (unsigned)(Rb * K + C) * 2u; }
    const size_t kstep = (size_t)(BK * 2);
    const size_t hstepA = (size_t)HALF * g.lda * 2, hstepB = (size_t)HALF * K * 2;
    const size_t tstepA = 2 * hstepA, tstepB = 2 * hstepB;
    const unsigned ldsw = (unsigned)wid * 1024u;
    const int aoff = lds_byte(wr * 64 + fr, fq * 8), boff = lds_byte(wc * 32 + fr, fq * 8);
#define PG8_SA(b, h) (((b) * 2 + (h)) * HTB)
#define PG8_SB(b, h) ((4 + (b) * 2 + (h)) * HTB)
#define PG8_STAGE(bufoff, gbase, voff) do { _Pragma("unroll") for (int _i = 0; _i < 2; ++_i) GLDS16((const char*)(gbase) + (voff)[_i], lds + (bufoff) + ldsw + _i * 8192); } while (0)
#define PG8_LDA(dst, b, h) do { _Pragma("unroll") for (int m = 0; m < 4; ++m) _Pragma("unroll") for (int k = 0; k < 2; ++k) dst[m][k] = *(const LDS_AS s8v*)(lds + PG8_SA(b, h) + aoff + m * 2048 + k * 1024); } while (0)
#define PG8_LDB(dst, b, h) do { _Pragma("unroll") for (int n = 0; n < 2; ++n) _Pragma("unroll") for (int k = 0; k < 2; ++k) dst[n][k] = *(const LDS_AS s8v*)(lds + PG8_SB(b, h) + boff + n * 2048 + k * 1024); } while (0)
#define PG8_MMA(ai, bj, At, Bt) do { PG_PRIO(1); _Pragma("unroll") for (int m = 0; m < 4; ++m) _Pragma("unroll") for (int n = 0; n < 2; ++n) _Pragma("unroll") for (int k = 0; k < 2; ++k) \
        acc[ai][bj][m][n] = __builtin_amdgcn_mfma_f32_16x16x32_bf16(Bt[n][k], At[m][k], acc[ai][bj][m][n], 0, 0, 0); PG_PRIO(0); } while (0)
    Unit cur, nxt; int ui = 0;
    if (!S.next(0, cur)) return;
    f4v acc[2][2][4][2];
#pragma unroll
    for (int a = 0; a < 2; ++a)
#pragma unroll
        for (int b = 0; b < 2; ++b)
#pragma unroll
            for (int m = 0; m < 4; ++m)
#pragma unroll
                for (int n = 0; n < 2; ++n) acc[a][b][m][n] = (f4v){0.f, 0.f, 0.f, 0.f};
    s8v At[4][2], B0[2][2], B1[2][2];
    const char* cA = (const char*)g.A + (size_t)cur.pm * tstepA; const char* cB = (const char*)g.Bt + (size_t)cur.pn * tstepB;
    PG8_STAGE(PG8_SB(0, 0), cB, voffB); PG8_STAGE(PG8_SA(0, 0), cA, voffA); PG8_STAGE(PG8_SB(0, 1), cB + hstepB, voffB); PG8_STAGE(PG8_SA(0, 1), cA + hstepA, voffA);
    if (wr == 1) PG_BAR;
    PG_WAIT_V(4); PG_BAR;
    PG8_STAGE(PG8_SB(1, 0), cB + kstep, voffB); PG8_STAGE(PG8_SA(1, 0), cA + kstep, voffA); PG8_STAGE(PG8_SB(1, 1), cB + hstepB + kstep, voffB);
    PG_WAIT_V(6); PG_BAR;
    for (;;) {
        const bool has_next = S.next(ui + 1, nxt);
        const char* nA = has_next ? (const char*)g.A + (size_t)nxt.pm * tstepA : cA; const char* nB = has_next ? (const char*)g.Bt + (size_t)nxt.pn * tstepB : cB;
        for (int t = 0; t < nt; t += 2) {
            const bool last = (t == nt - 2);
            const char* a1 = cA + (size_t)(t + 1) * kstep;
            const char* a2 = last ? nA : cA + (size_t)(t + 2) * kstep; const char* b2 = last ? nB : cB + (size_t)(t + 2) * kstep;
            const char* a3 = a2 + kstep; const char* b3 = b2 + kstep;
            PG8_LDB(B0, 0, 0); PG_SCHED; PG8_LDA(At, 0, 0); PG8_STAGE(PG8_SA(1, 1), a1 + hstepA, voffA);
            PG_WAIT_L(8); PG_BAR; PG_WAIT_L(0); PG8_MMA(0, 0, At, B0); PG_BAR; PG_SCHED;
            PG8_LDB(B1, 0, 1); PG8_STAGE(PG8_SB(0, 0), b2, voffB);
            PG_BAR; PG_WAIT_L(0); PG8_MMA(0, 1, At, B1); PG_BAR;
            PG8_LDA(At, 0, 1); PG8_STAGE(PG8_SA(0, 0), a2, voffA);
            PG_BAR; PG_WAIT_L(0); PG8_MMA(1, 0, At, B0); PG_BAR; PG_SCHED;
            PG8_STAGE(PG8_SB(0, 1), b2 + hstepB, voffB);
            PG_WAIT_V(6); PG_BAR; PG8_MMA(1, 1, At, B1); PG_BAR;
            PG8_LDB(B0, 1, 0); PG_SCHED; PG8_LDA(At, 1, 0); PG8_STAGE(PG8_SA(0, 1), a2 + hstepA, voffA);
            PG_WAIT_L(8); PG_BAR; PG_WAIT_L(0); PG8_MMA(0, 0, At, B0); PG_BAR; PG_SCHED;
            PG8_LDB(B1, 1, 1); PG8_STAGE(PG8_SB(1, 0), b3, voffB);
            PG_BAR; PG_WAIT_L(0); PG8_MMA(0, 1, At, B1); PG_BAR;
            PG8_LDA(At, 1, 1); PG8_STAGE(PG8_SA(1, 0), a3, voffA);
            PG_BAR; PG_WAIT_L(0); PG8_MMA(1, 0, At, B0); PG_BAR; PG_SCHED;
            PG8_STAGE(PG8_SB(1, 1), b3 + hstepB, voffB);
            PG_WAIT_V(6); PG_BAR; PG8_MMA(1, 1, At, B1); PG_BAR;
        }
        E(acc, cur, wr, wc, fr, fq);
        if (!has_next) break;
#pragma unroll
        for (int a = 0; a < 2; ++a)
#pragma unroll
            for (int b = 0; b < 2; ++b)
#pragma unroll
                for (int m = 0; m < 4; ++m)
#pragma unroll
                    for (int n = 0; n < 2; ++n) acc[a][b][m][n] = (f4v){0.f, 0.f, 0.f, 0.f};
        cur = nxt; cA = nA; cB = nB; ++ui;
    }
    PG_WAIT_V(0);
    if (wr == 0) PG_BAR;
    PG_BAR;
}
}

#ifdef CPU_EMU
#define WAVE_SYNC() emu::wsync()
#else
#define WAVE_SYNC() __builtin_amdgcn_wave_barrier()
#endif
__device__ __forceinline__ void unpack8(const uint4& u, float* f) {
    f[0] = u2f(u.x << 16); f[1] = u2f(u.x & 0xffff0000u); f[2] = u2f(u.y << 16); f[3] = u2f(u.y & 0xffff0000u);
    f[4] = u2f(u.z << 16); f[5] = u2f(u.z & 0xffff0000u); f[6] = u2f(u.w << 16); f[7] = u2f(u.w & 0xffff0000u);
}
typedef float f8v __attribute__((ext_vector_type(8)));
__device__ __forceinline__ f8v unpack8v(const uint4& u) {
    f8v f; f[0] = u2f(u.x << 16); f[1] = u2f(u.x & 0xffff0000u); f[2] = u2f(u.y << 16); f[3] = u2f(u.y & 0xffff0000u);
    f[4] = u2f(u.z << 16); f[5] = u2f(u.z & 0xffff0000u); f[6] = u2f(u.w << 16); f[7] = u2f(u.w & 0xffff0000u); return f;
}
__device__ __forceinline__ uint4 pack8(const float* f) { return make_uint4(pack2(f[0], f[1]), pack2(f[2], f[3]), pack2(f[4], f[5]), pack2(f[6], f[7])); }
__device__ __forceinline__ uint4 pack8v(const f8v& f) { return make_uint4(pack2(f[0], f[1]), pack2(f[2], f[3]), pack2(f[4], f[5]), pack2(f[6], f[7])); }
__device__ __forceinline__ f4v mfma16(const s8v& a, const s8v& b, const f4v& c) { return __builtin_amdgcn_mfma_f32_16x16x32_bf16(a, b, c, 0, 0, 0); }

__device__ __forceinline__ float red8(float x) {
#ifdef CPU_EMU
    x += __shfl_xor(x, 1); x += __shfl_xor(x, 2); x += __shfl_xor(x, 4);
#else
    x += __builtin_bit_cast(float, __builtin_amdgcn_mov_dpp(__builtin_bit_cast(int, x), 0xB1, 0xF, 0xF, true));
    x += __builtin_bit_cast(float, __builtin_amdgcn_mov_dpp(__builtin_bit_cast(int, x), 0x4E, 0xF, 0xF, true));
    x += __builtin_bit_cast(float, __builtin_amdgcn_mov_dpp(__builtin_bit_cast(int, x), 0x141, 0xF, 0xF, true));
#endif
    return x;
}
constexpr int GL_LD = 72;
__device__ __forceinline__ void gla_scan_task(const P& p, int ei, int s, int h, int dir, unsigned char* dsm) {
    bf16* LAt = (bf16*)dsm;
    bf16* Qd = LAt + 64 * GL_LD;
    bf16* Ki = Qd + 64 * GL_LD;
    bf16* KiT = Ki + 64 * GL_LD;
    bf16* Sc = KiT + 64 * GL_LD;
    bf16* VT = Sc + 64 * GL_LD;
    bf16* St = VT + 128 * GL_LD;
    float* sAE = (float*)(St + 128 * GL_LD);
    const Seq sq_ = get_seq(s);
    const int tid = opaque_tid(), lane = tid & 63, wid = tid >> 6, fr = lane & 15, fq = lane >> 4;
    const int rt = wid & 3, chf = wid >> 2;
    const bf16* proj = (const bf16*)(p.ws + WS_PROJ);
    bf16* opart = (bf16*)(p.ws + WS_PART + (size_t)dir * PART_SZ);
    s8v gfrag[2]; float gb[2];
    {
        const float* gup = p.in[I_GUP] + (size_t)(ei * 2 + dir) * 16 * 256 + h * 64;
        const float* gbias = p.in[I_GBIAS] + (size_t)(ei * 2 + dir) * 256 + h * 64;
#pragma unroll
        for (int c2 = 0; c2 < 2; ++c2) {
            const int d = 16 * (2 * chf + c2) + fr;
            gb[c2] = gbias[d];
#pragma unroll
            for (int j = 0; j < 8; ++j) gfrag[c2][j] = (short)f2bf(fq < 2 ? gup[(8 * fq + j) * 256 + d] : 0.f);
        }
    }
    f4v Sacc[4];
    __syncthreads();
    if (sq_.lat) {
        const float* s0 = p.in[I_SGLA] + ((((size_t)sq_.b * N_EVEN + ei) * 2 + dir) * 4 + h) * 64 * 128;
#pragma unroll
        for (int ct = 0; ct < 4; ++ct)
#pragma unroll
            for (int r = 0; r < 4; ++r) Sacc[ct][r] = s0[(16 * rt + fq * 4 + r) * 128 + 64 * chf + 16 * ct + fr];
    } else {
#pragma unroll
        for (int ct = 0; ct < 4; ++ct) Sacc[ct] = (f4v){0.f, 0.f, 0.f, 0.f};
    }
#pragma unroll
    for (int ct = 0; ct < 4; ++ct) *(uint2*)(St + (64 * chf + 16 * ct + fr) * GL_LD + 16 * rt + fq * 4) = make_uint2(pack2(Sacc[ct][0], Sacc[ct][1]), pack2(Sacc[ct][2], Sacc[ct][3]));
    const int nch = sq_.len >> 6;
    uint4 pv0, pv1, pq, pkk, pga;
#define GLA_FETCH(TB) do { \
        { const int i_ = lane, c8_ = wid * 8; const bf16* pr_ = proj + (size_t)((TB) + (dir ? 63 - i_ : i_)) * EW + E_V + h * 128 + c8_; \
          pv0 = *(const uint4*)pr_; pv1 = *(const uint4*)(pr_ + 64); } \
        { const int i_ = tid >> 3, c8_ = (tid & 7) * 8; const bf16* pr_ = proj + (size_t)((TB) + (dir ? 63 - i_ : i_)) * EW + h * 64 + c8_; \
          pq = *(const uint4*)(pr_ + E_Q); pkk = *(const uint4*)(pr_ + E_K); } \
        { const int i_ = 16 * rt + fr; pga = make_uint4(0u, 0u, 0u, 0u); if (fq < 2) pga = *(const uint4*)(proj + (size_t)((TB) + (dir ? 63 - i_ : i_)) * EW + E_GD + dir * 16 + fq * 8); } \
    } while (0)
    GLA_FETCH(sq_.start + (dir ? sq_.len - 64 : 0));
    for (int cc = 0; cc < nch; ++cc) {
        const int tb = sq_.start + (dir ? sq_.len - 64 - cc * 64 : cc * 64);
        {
            {
                const int i = lane, c8 = wid * 8;
                const f8v va = unpack8v(pv0), vb = unpack8v(pv1);
#pragma unroll
                for (int j = 0; j < 8; ++j) { VT[(c8 + j) * GL_LD + i] = f2bf(va[j]); VT[(64 + c8 + j) * GL_LD + i] = f2bf(vb[j]); }
            }
            { const int i = tid >> 3, c8 = (tid & 7) * 8; *(uint4*)(Qd + i * GL_LD + c8) = pq; *(uint4*)(Ki + i * GL_LD + c8) = pkk; }
            const s8v ga = __builtin_bit_cast(s8v, pga);
            if (cc + 1 < nch) GLA_FETCH(sq_.start + (dir ? sq_.len - 128 - cc * 64 : (cc + 1) * 64));
#pragma unroll
            for (int c2 = 0; c2 < 2; ++c2) {
                const f4v x = mfma16(ga, gfrag[c2], (f4v){0.f, 0.f, 0.f, 0.f});
                float la[4];
#pragma unroll
                for (int r = 0; r < 4; ++r) la[r] = logsigf_(x[r] + gb[c2]) * (1.0f / 16.0f);
                *(uint2*)(LAt + (16 * (2 * chf + c2) + fr) * GL_LD + 16 * rt + fq * 4) = make_uint2(pack2(la[0], la[1]), pack2(la[2], la[3]));
            }
        }
        __syncthreads();
        {
            f4v bc[2];
            bc[0] = (f4v){0.f, 0.f, 0.f, 0.f}; bc[1] = bc[0];
#pragma unroll
            for (int ks = 0; ks < 2; ++ks) {
                s8v lf;
#pragma unroll
                for (int j = 0; j < 8; ++j) lf[j] = (32 * ks + 8 * fq + j <= 16 * rt + fr) ? (short)0x3F80 : (short)0;
#pragma unroll
                for (int c2 = 0; c2 < 2; ++c2) bc[c2] = mfma16(lf, *(const s8v*)(LAt + (16 * (2 * chf + c2) + fr) * GL_LD + 32 * ks + 8 * fq), bc[c2]);
            }
#pragma unroll
            for (int c2 = 0; c2 < 2; ++c2) {
                const int d = 16 * (2 * chf + c2) + fr;
                float kiv[4];
#pragma unroll
                for (int r = 0; r < 4; ++r) {
                    const int i = 16 * rt + fq * 4 + r;
                    const float eb = fexp(bc[c2][r]);
                    const float qv = bf2f(Qd[i * GL_LD + d]) * 0.125f * eb;
                    kiv[r] = bf2f(Ki[i * GL_LD + d]) * frcp(eb);
                    Qd[i * GL_LD + d] = f2bf(qv); Ki[i * GL_LD + d] = f2bf(kiv[r]);
                    if (i == 63) sAE[d] = eb;
                }
                *(uint2*)(KiT + d * GL_LD + 16 * rt + fq * 4) = make_uint2(pack2(kiv[0], kiv[1]), pack2(kiv[2], kiv[3]));
            }
        }
        __syncthreads();
        f4v oacc[4];
        {
            f4v sc[2];
            sc[0] = (f4v){0.f, 0.f, 0.f, 0.f}; sc[1] = sc[0];
#pragma unroll
            for (int ct = 0; ct < 4; ++ct) oacc[ct] = (f4v){0.f, 0.f, 0.f, 0.f};
#pragma unroll
            for (int ks = 0; ks < 2; ++ks) {
                const s8v a = *(const s8v*)(Qd + (16 * rt + fr) * GL_LD + 32 * ks + 8 * fq);
#pragma unroll
                for (int c2 = 0; c2 < 2; ++c2) sc[c2] = mfma16(a, *(const s8v*)(Ki + (16 * (2 * chf + c2) + fr) * GL_LD + 32 * ks + 8 * fq), sc[c2]);
#pragma unroll
                for (int ct = 0; ct < 4; ++ct) oacc[ct] = mfma16(a, *(const s8v*)(St + (64 * chf + 16 * ct + fr) * GL_LD + 32 * ks + 8 * fq), oacc[ct]);
            }
#pragma unroll
            for (int c2 = 0; c2 < 2; ++c2)
#pragma unroll
                for (int r = 0; r < 4; ++r) { const int i = 16 * rt + fq * 4 + r, j = 16 * (2 * chf + c2) + fr; Sc[i * GL_LD + j] = f2bf(j <= i ? sc[c2][r] : 0.f); }
        }
        __syncthreads();
        {
#pragma unroll
            for (int ks = 0; ks < 2; ++ks) {
                const s8v a = *(const s8v*)(Sc + (16 * rt + fr) * GL_LD + 32 * ks + 8 * fq);
                const s8v kt = *(const s8v*)(KiT + (16 * rt + fr) * GL_LD + 32 * ks + 8 * fq);
#pragma unroll
                for (int ct = 0; ct < 4; ++ct) {
                    const s8v bv = *(const s8v*)(VT + (64 * chf + 16 * ct + fr) * GL_LD + 32 * ks + 8 * fq);
                    oacc[ct] = mfma16(a, bv, oacc[ct]); Sacc[ct] = mfma16(kt, bv, Sacc[ct]);
                }
            }
#pragma unroll
            for (int ct = 0; ct < 4; ++ct)
#pragma unroll
                for (int r = 0; r < 4; ++r) { const int i = 16 * rt + fq * 4 + r, t = tb + (dir ? 63 - i : i);
                    opart[(size_t)t * 512 + h * 128 + 64 * chf + 16 * ct + fr] = f2bf(oacc[ct][r]); }
            float ae[4];
#pragma unroll
            for (int r = 0; r < 4; ++r) ae[r] = sAE[16 * rt + fq * 4 + r];
#pragma unroll
            for (int ct = 0; ct < 4; ++ct) {
#pragma unroll
                for (int r = 0; r < 4; ++r) Sacc[ct][r] *= ae[r];
                *(uint2*)(St + (64 * chf + 16 * ct + fr) * GL_LD + 16 * rt + fq * 4) = make_uint2(pack2(Sacc[ct][0], Sacc[ct][1]), pack2(Sacc[ct][2], Sacc[ct][3]));
            }
        }
        __syncthreads();
    }
    if (!sq_.lat) {
        float* fs = p.out + OUT_GLA + ((((size_t)sq_.b * N_EVEN + ei) * 2 + dir) * 4 + h) * 64 * 128;
#pragma unroll
        for (int ct = 0; ct < 4; ++ct)
#pragma unroll
            for (int r = 0; r < 4; ++r) fs[(16 * rt + fq * 4 + r) * 128 + 64 * chf + 16 * ct + fr] = Sacc[ct][r];
    }
}

#ifndef RW_PREFETCH
#define RW_PREFETCH 1
#endif
constexpr int RW_LD = 72;
constexpr int RWKV_PREP_ITEMS = (T / 64) * 8;
struct RwPre { uint4 x[5], l[5], r[5]; };
__device__ __forceinline__ void rwkv_prefetch(const P& p, int w, int dir, int tid, RwPre& q) {
    const int cg = w >> 3, h = w & 7, hc0 = h * 64;
    const int i = tid >> 3, c8 = (tid & 7) * 8, t = cg * 64 + (dir ? 63 - i : i);
    bool hl, hr; tok_nbr(t, hl, hr);
    const bf16* proj = (const bf16*)(p.ws + WS_PROJ);
#pragma unroll
    for (int grp = 0; grp < 5; ++grp) {
        const int col = (grp == 0 ? FB_R + hc0 : grp == 1 ? FB_K + hc0 : grp == 2 ? FB_V + hc0 : grp == 3 ? FB_WD + dir * 64 : FB_AD + dir * 64) + c8;
        const bf16* pr = proj + (size_t)t * EW + E_FB + col;
        q.x[grp] = *(const uint4*)pr;
        q.l[grp] = hl ? *(const uint4*)(pr - EW) : make_uint4(0u, 0u, 0u, 0u);
        q.r[grp] = hr ? *(const uint4*)(pr + EW) : make_uint4(0u, 0u, 0u, 0u);
    }
}
__device__ __forceinline__ f4v unpack4(const uint2& u) { f4v f; f[0] = u2f(u.x << 16); f[1] = u2f(u.x & 0xffff0000u); f[2] = u2f(u.y << 16); f[3] = u2f(u.y & 0xffff0000u); return f; }
__device__ __forceinline__ uint2 pack4(const f4v& f) { return make_uint2(pack2(f[0], f[1]), pack2(f[2], f[3])); }
__device__ __forceinline__ void rwkv_prep_phase(const P& p, int ei, int dir, int w_first, int w_stride, unsigned char* dsm) {
    float* sCS = (float*)dsm;
    float* sKK = sCS + 4096;
    float* sB = sKK + 4096;
    float* sKM = sB + 4096;
    float* sR = sKM + 4096;
    float* sAf = (float*)dsm;
    bf16* AakT = (bf16*)(dsm + 16384);
    bf16* Brb = AakT + 64 * RW_LD;
    bf16* Tm = Brb + 64 * RW_LD;
    bf16* PT = Tm + 64 * RW_LD;
    bf16* W1T = PT + 64 * RW_LD;
    bf16* At = (bf16*)(dsm + 81920);
    bf16* Bt = At + 64 * RW_LD;
    bf16* Kt = Bt + 64 * RW_LD;
    bf16* Rt = Kt + 64 * RW_LD;
    bf16* BhT = Rt + 64 * RW_LD;
    bf16* KhT = BhT + 64 * RW_LD;
    bf16* AtT = KhT + 64 * RW_LD;
    bf16* sTW = At;
    bf16* sAD = Bt;
    float* sSeg = (float*)(AtT + 64 * RW_LD);
    const int tid0 = opaque_tid();
    float* bonus = (float*)(p.ws + WS_BONUS);
    const float* mix = p.in[I_MIX] + (size_t)ei * 1792;
    int hcur = -1;
    s8v lrf[4][2];
    float lrb[4];
    RwPre pre;
#if RW_PREFETCH
    if (w_first < RWKV_PREP_ITEMS) rwkv_prefetch(p, w_first, dir, tid0, pre);
#endif
    for (int w = w_first; w < RWKV_PREP_ITEMS; w += w_stride) {
        const int tid = opaque_tid(), lane = tid & 63, wid = tid >> 6, fr = lane & 15, fq = lane >> 4;
        const int rt = wid & 3, cb = 2 * (wid >> 2), which = wid >> 2;
        const int cg = w >> 3, h = w & 7, hc0 = h * 64;
        const size_t tk = (size_t)cg * 8 + h;
        if (h != hcur) {
            hcur = h;
            __syncthreads();
            const float* w2 = p.in[I_W2] + (size_t)(ei * 2 + dir) * 64 * 512 + hc0; const float* a2 = p.in[I_A2] + (size_t)(ei * 2 + dir) * 64 * 512 + hc0;
            for (int e = tid; e < 4096; e += 512) { const int r = e >> 6, c = e & 63; Kt[c * RW_LD + r] = f2bf(w2[(size_t)r * 512 + c]); Rt[c * RW_LD + r] = f2bf(a2[(size_t)r * 512 + c]); }
            __syncthreads();
            const bf16* src = which ? Rt : Kt;
            const float* lb = (which ? p.in[I_A0] : p.in[I_W0]) + (size_t)(ei * 2 + dir) * 512 + hc0;
#pragma unroll
            for (int ct = 0; ct < 4; ++ct) {
                lrb[ct] = lb[16 * ct + fr];
#pragma unroll
                for (int ks = 0; ks < 2; ++ks) lrf[ct][ks] = *(const s8v*)(src + (16 * ct + fr) * RW_LD + ks * 32 + fq * 8);
            }
        }
        __syncthreads();
#if !RW_PREFETCH
        rwkv_prefetch(p, w, dir, tid, pre);
#endif
        {
            const int i = tid >> 3, c8 = (tid & 7) * 8, t = cg * 64 + (dir ? 63 - i : i);
#pragma unroll
            for (int grp = 0; grp < 5; ++grp) {
                const int col = (grp == 0 ? FB_R + hc0 : grp == 1 ? FB_K + hc0 : grp == 2 ? FB_V + hc0 : grp == 3 ? FB_WD + dir * 64 : FB_AD + dir * 64) + c8;
                const f8v x = unpack8v(pre.x[grp]);
                const f8v nb = unpack8v(pre.l[grp]) + unpack8v(pre.r[grp]);
                const f8v mv = *(const f8v*)(mix + col);
                f8v y = x + mv * (nb * 0.5f - x);
                if (grp == 0) *(f8v*)(sR + i * 64 + c8) = y;
                else if (grp == 1) *(f8v*)(sKM + i * 64 + c8) = y;
                else if (grp == 2) { if (dir == 0) *(uint4*)((bf16*)(p.ws + WS_VSH) + (size_t)t * 512 + hc0 + c8) = pack8v(y); }
                else {
                    if (grp == 3) {
#pragma unroll
                        for (int j = 0; j < 8; ++j) y[j] = ftanh(y[j]);
                    }
                    *(uint4*)((grp == 3 ? sTW : sAD) + i * RW_LD + c8) = pack8v(y);
                }
            }
        }
#if RW_PREFETCH
        if (w + w_stride < RWKV_PREP_ITEMS) rwkv_prefetch(p, w + w_stride, dir, tid, pre);
#endif
        __syncthreads();
        {
            const bf16* Am = which ? sAD : sTW;
            f4v acc[4];
#pragma unroll
            for (int ct = 0; ct < 4; ++ct) acc[ct] = (f4v){0.f, 0.f, 0.f, 0.f};
#pragma unroll
            for (int ks = 0; ks < 2; ++ks) {
                const s8v a = *(const s8v*)(Am + (16 * rt + fr) * RW_LD + ks * 32 + fq * 8);
#pragma unroll
                for (int ct = 0; ct < 4; ++ct) acc[ct] = mfma16(a, lrf[ct][ks], acc[ct]);
            }
#pragma unroll
            for (int ct = 0; ct < 4; ++ct) {
                const int c = 16 * ct + fr;
#pragma unroll
                for (int r = 0; r < 4; ++r) {
                    const int tok = 16 * rt + fq * 4 + r;
                    const float sg = sigmoidf_(lrb[ct] + acc[ct][r]);
                    if (which) sB[tok * 64 + c] = sg; else sCS[tok * 64 + c] = -0.6065306597126334f * sg;
                }
            }
        }
        __syncthreads();
        {
            const int i = tid >> 3, c8 = (tid & 7) * 8;
            const float* kkw = p.in[I_KK] + (size_t)ei * 512 + hc0; const float* kaw = p.in[I_KA] + (size_t)ei * 512 + hc0; const float* rkw = p.in[I_RK] + (size_t)ei * 512 + hc0;
            const f8v av = *(const f8v*)(sB + i * 64 + c8), kr = *(const f8v*)(sKM + i * 64 + c8), rv = *(const f8v*)(sR + i * 64 + c8);
            const f8v kav = *(const f8v*)(kaw + c8), kkv = *(const f8v*)(kkw + c8), rkv = *(const f8v*)(rkw + c8);
            const f8v km = kr * (1.0f + (av - 1.0f) * kav);
            f8v kk = kr * kkv;
            float ss = 0.f, bn = 0.f;
#pragma unroll
            for (int j = 0; j < 8; ++j) { ss += kk[j] * kk[j]; bn += rv[j] * km[j] * rkv[j]; }
            ss = red8(ss); bn = red8(bn);
            kk *= frsq(ss + EPS);
            *(f8v*)(sKK + i * 64 + c8) = kk; *(f8v*)(sB + i * 64 + c8) = kk * av; *(f8v*)(sKM + i * 64 + c8) = km;
            if ((tid & 7) == 0) { const int t = cg * 64 + (dir ? 63 - i : i); bonus[((size_t)t * 8 + h) * 2 + dir] = bn; }
        }
        {
            const int c = tid & 63, sg = tid >> 6;
            float run = 0.f;
#pragma unroll
            for (int j = 0; j < 8; ++j) { run += sCS[(8 * sg + j) * 64 + c]; sCS[(8 * sg + j) * 64 + c] = run; }
            sSeg[sg * 64 + c] = run;
        }
        __syncthreads();
        {
            const int c = tid & 63, sg = tid >> 6;
            float off = 0.f;
            for (int q = 0; q < sg; ++q) off += sSeg[q * 64 + c];
#pragma unroll
            for (int j = 0; j < 8; ++j) sCS[(8 * sg + j) * 64 + c] += off;
        }
        __syncthreads();
        {
            const int i = tid >> 3, c8 = (tid & 7) * 8;
            const f8v cs = *(const f8v*)(sCS + i * 64 + c8), cl = *(const f8v*)(sCS + 63 * 64 + c8);
            f8v cp = (f8v)(0.f);
            if (i > 0) cp = *(const f8v*)(sCS + (i - 1) * 64 + c8);
            const f8v kk = *(const f8v*)(sKK + i * 64 + c8), bb = *(const f8v*)(sB + i * 64 + c8), km = *(const f8v*)(sKM + i * 64 + c8), rv = *(const f8v*)(sR + i * 64 + c8);
            f8v at, bt, kt, rtv;
#pragma unroll
            for (int j = 0; j < 8; ++j) {
                const float g = fexp(cs[j]), gi = frcp(g), gp = fexp(cp[j]), gc = fexp(cl[j]) * gi;
                at[j] = -kk[j] * gp; bt[j] = bb[j] * gi; kt[j] = km[j] * gi; rtv[j] = rv[j] * g;
                BhT[(c8 + j) * RW_LD + i] = f2bf(bb[j] * gc); KhT[(c8 + j) * RW_LD + i] = f2bf(km[j] * gc); AtT[(c8 + j) * RW_LD + i] = f2bf(at[j]);
            }
            *(uint4*)(At + i * RW_LD + c8) = pack8v(at); *(uint4*)(Bt + i * RW_LD + c8) = pack8v(bt);
            *(uint4*)(Kt + i * RW_LD + c8) = pack8v(kt); *(uint4*)(Rt + i * RW_LD + c8) = pack8v(rtv);
            if (i == 63) {
                float* gco = (float*)(p.ws + WS_GC) + tk * 64 + c8;
#pragma unroll
                for (int j = 0; j < 8; ++j) gco[j] = fexp(cl[j]);
            }
        }
        __syncthreads();
        f4v brkT[2];
        {
            f4v aab[2], aak[2], brb[2];
#pragma unroll
            for (int c2 = 0; c2 < 2; ++c2) { aab[c2] = (f4v){0.f, 0.f, 0.f, 0.f}; aak[c2] = aab[c2]; brb[c2] = aab[c2]; brkT[c2] = aab[c2]; }
#pragma unroll
            for (int ks = 0; ks < 2; ++ks) {
                const int ko = ks * 32 + fq * 8, ra = (16 * rt + fr) * RW_LD + ko;
                const s8v fa = *(const s8v*)(At + ra), frr = *(const s8v*)(Rt + ra), fk = *(const s8v*)(Kt + ra);
#pragma unroll
                for (int c2 = 0; c2 < 2; ++c2) {
                    const int ro = (16 * (cb + c2) + fr) * RW_LD + ko;
                    const s8v gb = *(const s8v*)(Bt + ro), gk = *(const s8v*)(Kt + ro), gr = *(const s8v*)(Rt + ro);
                    aab[c2] = mfma16(fa, gb, aab[c2]); aak[c2] = mfma16(fa, gk, aak[c2]); brb[c2] = mfma16(frr, gb, brb[c2]);
                    brkT[c2] = mfma16(fk, gr, brkT[c2]);
                }
            }
#pragma unroll
            for (int c2 = 0; c2 < 2; ++c2) {
                const int col = 16 * (cb + c2) + fr, r0 = 16 * rt + fq * 4;
                f4v ak;
#pragma unroll
                for (int r = 0; r < 4; ++r) {
                    const int row = r0 + r;
                    sAf[row * 64 + col] = col < row ? -aab[c2][r] : 0.f;
                    ak[r] = col < row ? aak[c2][r] : 0.f;
                    Brb[row * RW_LD + col] = f2bf(col <= row ? brb[c2][r] : 0.f);
                    if (!(row <= col)) brkT[c2][r] = 0.f;
                }
                *(uint2*)(AakT + col * RW_LD + r0) = pack4(ak);
            }
        }
        __syncthreads();
        {
            const int c = 8 * wid + (lane >> 3), js = lane & 7;
            float xr[8];
#pragma unroll
            for (int m = 0; m < 8; ++m) xr[m] = 0.f;
#pragma unroll
            for (int i = 0; i < 64; ++i) {
                float part0 = 0.f, part1 = 0.f;
#pragma unroll
                for (int m = 0; m <= (i - 1) / 8 && i > 0; ++m) {
                    const float av = sAf[i * 64 + 8 * m + js];
                    if (m & 1) part1 += av * xr[m]; else part0 += av * xr[m];
                }
                const float tot = red8(part0 + part1);
                const float xi = (i == c ? 1.f : 0.f) - tot;
                xr[i >> 3] = ((i & 7) == js) ? xi : xr[i >> 3];
            }
#pragma unroll
            for (int m = 0; m < 8; ++m) Tm[(8 * m + js) * RW_LD + c] = f2bf(xr[m]);
        }
        __syncthreads();
        {
            f4v pp[2], ww[2];
#pragma unroll
            for (int c2 = 0; c2 < 2; ++c2) { pp[c2] = (f4v){0.f, 0.f, 0.f, 0.f}; ww[c2] = pp[c2]; }
#pragma unroll
            for (int ks = 0; ks < 2; ++ks) {
                const int ko = ks * 32 + fq * 8;
                const s8v ft = *(const s8v*)(Tm + (16 * rt + fr) * RW_LD + ko);
#pragma unroll
                for (int c2 = 0; c2 < 2; ++c2) {
                    const int ro = (16 * (cb + c2) + fr) * RW_LD + ko;
                    pp[c2] = mfma16(ft, *(const s8v*)(AtT + ro), pp[c2]); ww[c2] = mfma16(ft, *(const s8v*)(AakT + ro), ww[c2]);
                }
            }
#pragma unroll
            for (int c2 = 0; c2 < 2; ++c2) {
                const int col = 16 * (cb + c2) + fr;
                *(uint2*)(PT + col * RW_LD + 16 * rt + fq * 4) = pack4(pp[c2]);
                *(uint2*)(W1T + col * RW_LD + 16 * rt + fq * 4) = pack4(ww[c2]);
            }
        }
        __syncthreads();
        {
            bf16* m12 = (bf16*)(p.ws + WS_RM12) + tk * 8192; bf16* m34 = (bf16*)(p.ws + WS_RM34) + tk * 8192;
#pragma unroll
            for (int c2 = 0; c2 < 2; ++c2) {
                const int col = 16 * (cb + c2) + fr, r0 = 16 * rt + fq * 4;
                f4v m1 = unpack4(*(const uint2*)(Rt + col * RW_LD + r0));
                f4v m2 = brkT[c2], m3 = (f4v){0.f, 0.f, 0.f, 0.f};
                f4v m4 = unpack4(*(const uint2*)(KhT + col * RW_LD + r0));
#pragma unroll
                for (int ks = 0; ks < 2; ++ks) {
                    const int ko = ks * 32 + fq * 8;
                    const s8v fp = *(const s8v*)(PT + (16 * rt + fr) * RW_LD + ko), fw = *(const s8v*)(W1T + (16 * rt + fr) * RW_LD + ko);
                    const s8v gb = *(const s8v*)(Brb + col * RW_LD + ko), gh = *(const s8v*)(BhT + col * RW_LD + ko);
                    m1 = mfma16(fp, gb, m1);
                    m2 = mfma16(fw, gb, m2);
                    m3 = mfma16(fp, gh, m3);
                    m4 = mfma16(fw, gh, m4);
                }
                *(uint2*)(m12 + col * 64 + r0) = pack4(m1);
                *(uint2*)(m12 + 4096 + col * 64 + r0) = pack4(m2);
                *(uint2*)(m34 + col * 64 + r0) = pack4(m3);
                *(uint2*)(m34 + 4096 + col * 64 + r0) = pack4(m4);
            }
        }
    }
}
__device__ __forceinline__ void rwkv_apply_task(const P& p, int ei, int s, int h, int dir, unsigned char* dsm) {
    bf16* St = (bf16*)dsm;
    bf16* VT = St + 64 * RW_LD;
    bf16* M1 = VT + 64 * RW_LD;
    bf16* M2 = M1 + 64 * RW_LD;
    bf16* M3 = M2 + 64 * RW_LD;
    bf16* M4 = M3 + 64 * RW_LD;
    float* sGC = (float*)(M4 + 64 * RW_LD);
    const Seq sq_ = get_seq(s);
    const int tid = opaque_tid(), lane = tid & 63, wid = tid >> 6, fr = lane & 15, fq = lane >> 4;
    const int rt = wid & 3, cb = 2 * (wid >> 2), hc0 = h * 64;
    bf16* opart = (bf16*)(p.ws + WS_PART + (size_t)(2 + dir) * PART_SZ);
    f4v Sacc[2];
    __syncthreads();
#pragma unroll
    for (int c2 = 0; c2 < 2; ++c2) {
        const int v = 16 * (cb + c2) + fr, k0 = 16 * rt + fq * 4;
        if (sq_.lat) Sacc[c2] = *(const f4v*)(p.in[I_SRWKV] + ((((size_t)sq_.b * N_EVEN + ei) * 2 + dir) * 8 + h) * 4096 + v * 64 + k0);
        else Sacc[c2] = (f4v){0.f, 0.f, 0.f, 0.f};
        *(uint2*)(St + v * RW_LD + k0) = make_uint2(pack2(Sacc[c2][0], Sacc[c2][1]), pack2(Sacc[c2][2], Sacc[c2][3]));
    }
    const int nch = sq_.len >> 6;
    uint4 pm0, pm1, pm2, pm3, pvv; float pgc = 0.f;
    {
        const int cg0 = (sq_.start >> 6) + (dir ? nch - 1 : 0); const size_t tk0 = (size_t)cg0 * 8 + h;
        const int i = tid >> 3, c8 = (tid & 7) * 8;
        const bf16* m12 = (const bf16*)(p.ws + WS_RM12) + tk0 * 8192; const bf16* m34 = (const bf16*)(p.ws + WS_RM34) + tk0 * 8192;
        pm0 = *(const uint4*)(m12 + i * 64 + c8); pm1 = *(const uint4*)(m12 + 4096 + i * 64 + c8); pm2 = *(const uint4*)(m34 + i * 64 + c8); pm3 = *(const uint4*)(m34 + 4096 + i * 64 + c8);
        pvv = *(const uint4*)((const bf16*)(p.ws + WS_VSH) + (size_t)(cg0 * 64 + (dir ? 63 - lane : lane)) * 512 + hc0 + wid * 8);
        if (tid < 64) pgc = ((const float*)(p.ws + WS_GC))[tk0 * 64 + tid];
    }
    for (int cc = 0; cc < nch; ++cc) {
        const int cg = (sq_.start >> 6) + (dir ? nch - 1 - cc : cc);
        {
            const int i = tid >> 3, c8 = (tid & 7) * 8;
            *(uint4*)(M1 + i * RW_LD + c8) = pm0; *(uint4*)(M2 + i * RW_LD + c8) = pm1; *(uint4*)(M3 + i * RW_LD + c8) = pm2; *(uint4*)(M4 + i * RW_LD + c8) = pm3;
            const f8v vv = unpack8v(pvv);
#pragma unroll
            for (int j = 0; j < 8; ++j) VT[(wid * 8 + j) * RW_LD + lane] = f2bf(vv[j]);
            if (tid < 64) sGC[tid] = pgc;
            if (cc + 1 < nch) {
                const int cgn = (sq_.start >> 6) + (dir ? nch - 2 - cc : cc + 1); const size_t tkn = (size_t)cgn * 8 + h;
                const bf16* m12 = (const bf16*)(p.ws + WS_RM12) + tkn * 8192; const bf16* m34 = (const bf16*)(p.ws + WS_RM34) + tkn * 8192;
                pm0 = *(const uint4*)(m12 + i * 64 + c8); pm1 = *(const uint4*)(m12 + 4096 + i * 64 + c8); pm2 = *(const uint4*)(m34 + i * 64 + c8); pm3 = *(const uint4*)(m34 + 4096 + i * 64 + c8);
                pvv = *(const uint4*)((const bf16*)(p.ws + WS_VSH) + (size_t)(cgn * 64 + (dir ? 63 - lane : lane)) * 512 + hc0 + wid * 8);
                if (tid < 64) pgc = ((const float*)(p.ws + WS_GC))[tkn * 64 + tid];
            }
        }
        __syncthreads();
        {
            f4v yT[2], sn[2];
#pragma unroll
            for (int c2 = 0; c2 < 2; ++c2) { yT[c2] = (f4v){0.f, 0.f, 0.f, 0.f}; sn[c2] = yT[c2]; }
#pragma unroll
            for (int ks = 0; ks < 2; ++ks) {
                const int ko = ks * 32 + fq * 8;
                const s8v fs = *(const s8v*)(St + (16 * rt + fr) * RW_LD + ko), fv = *(const s8v*)(VT + (16 * rt + fr) * RW_LD + ko);
                const s8v f3 = *(const s8v*)(M3 + (16 * rt + fr) * RW_LD + ko), f4 = *(const s8v*)(M4 + (16 * rt + fr) * RW_LD + ko);
#pragma unroll
                for (int c2 = 0; c2 < 2; ++c2) {
                    const int ro = (16 * (cb + c2) + fr) * RW_LD + ko;
                    yT[c2] = mfma16(fs, *(const s8v*)(M1 + ro), yT[c2]); yT[c2] = mfma16(fv, *(const s8v*)(M2 + ro), yT[c2]);
                    sn[c2] = mfma16(f3, *(const s8v*)(St + ro), sn[c2]); sn[c2] = mfma16(f4, *(const s8v*)(VT + ro), sn[c2]);
                }
            }
            float gc[4];
#pragma unroll
            for (int r = 0; r < 4; ++r) gc[r] = sGC[16 * rt + fq * 4 + r];
#pragma unroll
            for (int c2 = 0; c2 < 2; ++c2) {
                const int tt = 16 * (cb + c2) + fr, t = cg * 64 + (dir ? 63 - tt : tt);
                *(uint2*)(opart + (size_t)t * 512 + hc0 + 16 * rt + fq * 4) = make_uint2(pack2(yT[c2][0], yT[c2][1]), pack2(yT[c2][2], yT[c2][3]));
#pragma unroll
                for (int r = 0; r < 4; ++r) Sacc[c2][r] = Sacc[c2][r] * gc[r] + sn[c2][r];
            }
        }
        __syncthreads();
#pragma unroll
        for (int c2 = 0; c2 < 2; ++c2) *(uint2*)(St + (16 * (cb + c2) + fr) * RW_LD + 16 * rt + fq * 4) = make_uint2(pack2(Sacc[c2][0], Sacc[c2][1]), pack2(Sacc[c2][2], Sacc[c2][3]));
    }
    if (!sq_.lat) {
#pragma unroll
        for (int c2 = 0; c2 < 2; ++c2)
            *(f4v*)(p.out + OUT_RWKV + ((((size_t)sq_.b * N_EVEN + ei) * 2 + dir) * 8 + h) * 4096 + (16 * (cb + c2) + fr) * 64 + 16 * rt + fq * 4) = Sacc[c2];
    }
}
constexpr int EV_AP_LAT = NB_LAT * 8, EV_AP_CTX = NB_CTX * 8, EV_GLA_LAT = NB_LAT * 4, EV_GLA_CTX = NB_CTX * 4;
constexpr int EVEN_SCAN_ITEMS = EV_AP_LAT + EV_GLA_LAT + EV_AP_CTX + EV_GLA_CTX;
__device__ __forceinline__ void ph_even_scan_item(const P& p, int w, int ei, int dir, unsigned char* dsm) {
    int kind, sbase, x;
    if (w < EV_AP_LAT) { kind = 0; sbase = NB_CTX; x = w; }
    else if (w < EV_AP_LAT + EV_GLA_LAT) { kind = 1; sbase = NB_CTX; x = w - EV_AP_LAT; }
    else if (w < EV_AP_LAT + EV_GLA_LAT + EV_AP_CTX) { kind = 0; sbase = 0; x = w - EV_AP_LAT - EV_GLA_LAT; }
    else { kind = 1; sbase = 0; x = w - EV_AP_LAT - EV_GLA_LAT - EV_AP_CTX; }
    if (kind == 0) rwkv_apply_task(p, ei, sbase + x / 8, x & 7, dir, dsm);
    else gla_scan_task(p, ei, sbase + x / 4, x & 3, dir, dsm);
}

__device__ __forceinline__ void ph_fin_even(const P& p, int bid, int ei) {
    const int lane = LT & 63, t = bid * 4 + (LT >> 6);
    if (t >= T) return;
    const bf16* pr = (const bf16*)(p.ws + WS_PROJ) + (size_t)t * EW;
    const bf16* oaf = (const bf16*)(p.ws + WS_PART) + (size_t)t * 512;
    const bf16* oab = (const bf16*)(p.ws + WS_PART + PART_SZ) + (size_t)t * 512;
    const bf16* obf = (const bf16*)(p.ws + WS_PART + 2 * PART_SZ) + (size_t)t * 512;
    const bf16* obb = (const bf16*)(p.ws + WS_PART + 3 * PART_SZ) + (size_t)t * 512;
    bf16* yc = (bf16*)(p.ws + WS_HM) + (size_t)t * D;
    const int idx = lane * 8;
    {
        float o[8], ss = 0.f;
#pragma unroll
        for (int j = 0; j < 8; ++j) { o[j] = bf2f(oaf[idx + j]) + bf2f(oab[idx + j]); ss += o[j] * o[j]; }
        ss += __shfl_xor(ss, 1); ss += __shfl_xor(ss, 2); ss += __shfl_xor(ss, 4); ss += __shfl_xor(ss, 8);
        const float r = frsq(ss * (1.0f / 128.f) + EPS);
        const float* gn = p.in[I_GLAN] + ei * 128 + (idx & 127);
#pragma unroll
        for (int j = 0; j < 8; ++j) yc[idx + j] = f2bf(o[j] * r * gn[j] * siluf_(bf2f(pr[E_ZA + idx + j])));
    }
    {
        float o[8], mu = 0.f;
#pragma unroll
        for (int j = 0; j < 8; ++j) { o[j] = bf2f(obf[idx + j]) + bf2f(obb[idx + j]); mu += o[j]; }
        mu += __shfl_xor(mu, 1); mu += __shfl_xor(mu, 2); mu += __shfl_xor(mu, 4);
        mu *= (1.0f / 64.f);
        float var = 0.f;
#pragma unroll
        for (int j = 0; j < 8; ++j) { o[j] -= mu; var += o[j] * o[j]; }
        var += __shfl_xor(var, 1); var += __shfl_xor(var, 2); var += __shfl_xor(var, 4);
        const float r = frsq(var * (1.0f / 64.f) + 64e-5f);
        const int h = idx >> 6;
        const float* bn = (const float*)(p.ws + WS_BONUS) + ((size_t)t * 8 + h) * 2;
        const float bsum = bn[0] + bn[1];
        bool hl, hr; tok_nbr(t, hl, hr);
        const float* mix = p.in[I_MIX] + (size_t)ei * 1792 + FB_V + idx;
        const float* lg = p.in[I_LNG] + ei * 512 + idx;
        const float* lb = p.in[I_LNB] + ei * 512 + idx;
#pragma unroll
        for (int j = 0; j < 8; ++j) {
            const bf16* pv = pr + E_FB + FB_V + idx + j;
            const float x = bf2f(pv[0]);
            const float nl = hl ? bf2f(pv[-EW]) : 0.f, nr = hr ? bf2f(pv[EW]) : 0.f;
            const float vsh = x + mix[j] * (0.5f * (nl + nr) - x);
            yc[512 + idx + j] = f2bf((o[j] * r * lg[j] + lb[j] + bsum * vsh) * siluf_(bf2f(pr[E_ZB + idx + j])));
        }
    }
}

constexpr int ODD_PREP_ITEMS = (T / 64) * 4;
constexpr int PQ_LD = 136;
__device__ __forceinline__ void ph_odd_prep(const P& p, int item, int oi, unsigned char* dsm) {
    bf16* sq = (bf16*)dsm;
    bf16* sk = sq + 64 * PQ_LD;
    float* sA = (float*)(dsm + 2 * 64 * PQ_LD * 2);
    float* sX = sA + 2 * 4096;
    float* slg = sX + 2 * 4096;
    float* sbt = slg + 128;
    float* sgc = sbt + 128;
    float* sbp = sgc + 128;
    const int tid = opaque_tid(), lane = tid & 63, wid = tid >> 6;
    const int cg = item >> 2, h = item & 3;
    const bf16* proj = (const bf16*)(p.ws + WS_PROJ);
    const float* cw = p.in[I_CONV] + (size_t)oi * 9 * 1536;
    __syncthreads();
    {
        const int i = tid >> 3, sub = tid & 7, t = cg * 64 + i;
        const bool lat = t >= T_CTX;
        int pos, len;
        if (!lat) { pos = t % L_CTX; len = L_CTX; } else { pos = (t - T_CTX) % L_LAT; len = L_LAT; }
        const int gr = pos >> 6, gcl = pos & 63, nrows = len >> 6;
        bf16* qo = (bf16*)(p.ws + WS_QKVN) + (size_t)t * 1536;
#pragma unroll
        for (int part = 0; part < 3; ++part) {
            const int ch = part * 512 + h * 128 + sub * 16;
            f8v a0 = (f8v)(0.f), a1 = (f8v)(0.f);
            for (int di = (lat ? -1 : 0); di <= (lat ? 1 : 0); ++di)
                for (int dj = -1; dj <= 1; ++dj) {
                    bool ok;
                    if (lat) ok = (gr + di >= 0) && (gr + di < nrows) && (gcl + dj >= 0) && (gcl + dj < 64);
                    else ok = (pos + dj >= 0) && (pos + dj < len);
                    if (!ok) continue;
                    const bf16* src = proj + (size_t)(t + di * 64 + dj) * OW + O_QKV + ch;
                    const float* w = cw + ((di + 1) * 3 + (dj + 1)) * 1536 + ch;
                    const f8v x0 = unpack8v(*(const uint4*)src), x1 = unpack8v(*(const uint4*)(src + 8));
                    const f8v w0 = *(const f8v*)w, w1 = *(const f8v*)(w + 8);
                    a0 += x0 * w0; a1 += x1 * w1;
                }
            float ss = 0.f;
#pragma unroll
            for (int j = 0; j < 8; ++j) { a0[j] = siluf_(a0[j]); a1[j] = siluf_(a1[j]); ss += a0[j] * a0[j] + a1[j] * a1[j]; }
            if (part < 2) {
                ss += __shfl_xor(ss, 1); ss += __shfl_xor(ss, 2); ss += __shfl_xor(ss, 4);
                float r = frsq(ss + EPS);
                if (part == 0) r *= 0.08838834764831845f;
                a0 *= r; a1 *= r;
            }
            const uint4 p0 = pack8v(a0), p1 = pack8v(a1);
            *(uint4*)(qo + ch) = p0; *(uint4*)(qo + ch + 8) = p1;
            if (part == 0) { *(uint4*)(sq + i * PQ_LD + sub * 16) = p0; *(uint4*)(sq + i * PQ_LD + sub * 16 + 8) = p1; }
            if (part == 1) { *(uint4*)(sk + i * PQ_LD + sub * 16) = p0; *(uint4*)(sk + i * PQ_LD + sub * 16 + 8) = p1; }
        }
        if (sub < 2) {
            const int dir = sub;
            float* g = (float*)(p.ws + WS_GATES) + (size_t)t * 16;
            const float x = bf2f(proj[(size_t)t * OW + O_G + dir * 4 + h]);
            const float lgv = -fexp(p.in[I_ALOG][oi * 8 + dir * 4 + h]) * softplusf_(x + p.in[I_DTB][oi * 8 + dir * 4 + h]);
            const float bv = sigmoidf_(bf2f(proj[(size_t)t * OW + O_BETA + dir * 4 + h]));
            g[dir * 4 + h] = lgv; g[8 + dir * 4 + h] = bv;
            slg[dir * 64 + i] = lgv; sbt[dir * 64 + i] = bv;
        }
    }
    __syncthreads();
    if (tid < 2) {
        const int dir = tid; float c = 0.f;
        for (int i = 0; i < 64; ++i) { const int n = dir ? 63 - i : i; c += slg[dir * 64 + n]; sgc[dir * 64 + i] = c; sbp[dir * 64 + i] = sbt[dir * 64 + n]; }
    }
    __syncthreads();
    {
        const int rt = wid & 3, fr = lane & 15, fq = lane >> 4;
        const bf16* arow = (wid < 4 ? sk : sq) + (16 * rt + fr) * PQ_LD + fq * 8;
        f4v acc[4];
#pragma unroll
        for (int ct = 0; ct < 4; ++ct) acc[ct] = (f4v){0.f, 0.f, 0.f, 0.f};
#pragma unroll
        for (int ks = 0; ks < 4; ++ks) {
            const s8v a = *(const s8v*)(arow + ks * 32);
#pragma unroll
            for (int ct = 0; ct < 4; ++ct) { const s8v bb = *(const s8v*)(sk + (16 * ct + fr) * PQ_LD + fq * 8 + ks * 32); acc[ct] = mfma16(a, bb, acc[ct]); }
        }
        const size_t task0 = ((size_t)cg * 4 + h) * 2;
        bf16* qk0 = (bf16*)(p.ws + WS_QKM) + task0 * 4096; bf16* qk1 = qk0 + 4096;
#pragma unroll
        for (int ct = 0; ct < 4; ++ct)
#pragma unroll
            for (int r = 0; r < 4; ++r) {
                const int a = 16 * rt + fq * 4 + r, b = 16 * ct + fr, i1 = 63 - a, j1 = 63 - b;
                const float v = acc[ct][r];
                if (wid < 4) {
                    if (b < a) sA[b * 64 + a] = sbp[a] * v * fexp(sgc[a] - sgc[b]);
                    if (b > a) sA[4096 + j1 * 64 + i1] = sbp[64 + i1] * v * fexp(sgc[64 + i1] - sgc[64 + j1]);
                } else {
                    qk0[a * 64 + b] = f2bf(b <= a ? v * fexp(sgc[a] - sgc[b]) : 0.f);
                    qk1[i1 * 64 + j1] = f2bf(b >= a ? v * fexp(sgc[64 + i1] - sgc[64 + j1]) : 0.f);
                }
            }
    }
    __syncthreads();
    if (wid < 2) {
        const int dir = wid, c = lane;
        const float* AT = sA + dir * 4096;
        float* X = sX + dir * 4096;
        bf16* ti = (bf16*)(p.ws + WS_TINV) + (((size_t)cg * 4 + h) * 2 + dir) * 4096;
#pragma unroll 1
        for (int B = 0; B < 4; ++B) {
            float acc[16];
#pragma unroll
            for (int r = 0; r < 16; ++r) acc[r] = (16 * B + r == c) ? 1.f : 0.f;
#pragma unroll 2
            for (int j = 0; j < 16 * B; ++j) {
                const float xj = X[j * 64 + c];
                const float* ar = AT + j * 64 + 16 * B;
#pragma unroll
                for (int r = 0; r < 16; ++r) acc[r] -= ar[r] * xj;
            }
#pragma unroll
            for (int r2 = 0; r2 < 16; ++r2) {
                const float* ar = AT + (16 * B + r2) * 64 + 16 * B;
#pragma unroll
                for (int r = r2 + 1; r < 16; ++r) acc[r] -= ar[r] * acc[r2];
            }
#pragma unroll
            for (int r = 0; r < 16; ++r) { X[(16 * B + r) * 64 + c] = acc[r]; ti[(16 * B + r) * 64 + c] = f2bf(acc[r]); }
            WAVE_SYNC();
        }
    } else if (wid == 2) {
        float* gco = (float*)(p.ws + WS_GC) + ((size_t)cg * 4 + h) * 128;
        gco[lane] = sgc[lane]; gco[64 + lane] = sgc[64 + lane];
    }
}

constexpr int G_LDS = 136, G_LDT = 72;
__device__ __forceinline__ void gdn_scan_task(const P& p, int oi, int s, int h, int dir, unsigned char* dsm) {
    bf16* St = (bf16*)dsm;
    bf16* Kc = St + 128 * G_LDS;
    bf16* Qc = Kc + 64 * G_LDS;
    bf16* KeT = Qc + 64 * G_LDS;
    bf16* rT = KeT + 128 * G_LDT;
    bf16* dT = rT + 128 * G_LDT;
    bf16* Vc = dT;
    bf16* Ti = dT + 128 * G_LDT;
    bf16* Qk = Ti + 64 * G_LDT;
    float* sgc = (float*)(Qk + 64 * G_LDT);
    float* sbt = sgc + 64;
    const Seq sq_ = get_seq(s);
    const int tid = opaque_tid(), lane = tid & 63, wid = tid >> 6, fr = lane & 15, fq = lane >> 4;
    const int rt = wid & 3, chf = wid >> 2;
    const bf16* qkvn = (const bf16*)(p.ws + WS_QKVN);
    const float* gates = (const float*)(p.ws + WS_GATES);
    bf16* opart = (bf16*)(p.ws + WS_PART + (size_t)dir * PART_SZ);
    f4v Sacc[8];
    __syncthreads();
    if (sq_.lat) {
        const float* s0 = p.in[I_SGDN] + ((((size_t)sq_.b * N_ODD + oi) * 2 + dir) * 4 + h) * 128 * 128;
#pragma unroll
        for (int ct = 0; ct < 8; ++ct)
#pragma unroll
            for (int r = 0; r < 4; ++r) Sacc[ct][r] = s0[(16 * wid + fq * 4 + r) * 128 + 16 * ct + fr];
    } else {
#pragma unroll
        for (int ct = 0; ct < 8; ++ct) Sacc[ct] = (f4v){0.f, 0.f, 0.f, 0.f};
    }
#pragma unroll
    for (int ct = 0; ct < 8; ++ct) *(uint2*)(St + (16 * ct + fr) * G_LDS + 16 * wid + fq * 4) = make_uint2(pack2(Sacc[ct][0], Sacc[ct][1]), pack2(Sacc[ct][2], Sacc[ct][3]));
    const int nch = sq_.len >> 6;
    uint4 pq0, pq1, pk0, pk1, pw0, pw1, pti, pqk; float pgi, pgl, pbt = 0.f;
#define GDN_FETCH(CG) do { const size_t task_ = ((size_t)(CG) * 4 + h) * 2 + dir; const int t_ = (CG) * 64 + (dir ? 63 - lane : lane); \
        const bf16* src_ = qkvn + (size_t)t_ * 1536 + h * 128 + wid * 8; \
        pq0 = *(const uint4*)src_; pq1 = *(const uint4*)(src_ + 64); pk0 = *(const uint4*)(src_ + 512); pk1 = *(const uint4*)(src_ + 576); pw0 = *(const uint4*)(src_ + 1024); pw1 = *(const uint4*)(src_ + 1088); \
        { const int i2_ = tid >> 3, c8_ = (tid & 7) * 8; pti = *(const uint4*)((const bf16*)(p.ws + WS_TINV) + task_ * 4096 + i2_ * 64 + c8_); pqk = *(const uint4*)((const bf16*)(p.ws + WS_QKM) + task_ * 4096 + i2_ * 64 + c8_); } \
        const float* gcp_ = (const float*)(p.ws + WS_GC) + task_ * 64; pgi = gcp_[lane]; pgl = gcp_[63]; \
        if (tid < 64) pbt = gates[(size_t)((CG) * 64 + (dir ? 63 - tid : tid)) * 16 + 8 + dir * 4 + h]; } while (0)
    GDN_FETCH((sq_.start >> 6) + (dir ? nch - 1 : 0));
    for (int cc = 0; cc < nch; ++cc) {
        const int cl = dir ? nch - 1 - cc : cc;
        const int cg = (sq_.start >> 6) + cl;
        {
            const int i = lane;
            const float sc = fexp(pgl - pgi);
#pragma unroll
            for (int rep = 0; rep < 2; ++rep) {
                const int c8 = (wid + 8 * rep) * 8;
                const uint4 qv = rep ? pq1 : pq0, kv = rep ? pk1 : pk0, vv = rep ? pw1 : pw0;
                *(uint4*)(Qc + i * G_LDS + c8) = qv; *(uint4*)(Kc + i * G_LDS + c8) = kv; *(uint4*)(Vc + i * 128 + c8) = vv;
                const f8v kf = unpack8v(kv);
#pragma unroll
                for (int j = 0; j < 8; ++j) KeT[(c8 + j) * G_LDT + i] = f2bf(kf[j] * sc);
            }
            { const int i2 = tid >> 3, c8 = (tid & 7) * 8; *(uint4*)(Ti + i2 * G_LDT + c8) = pti; *(uint4*)(Qk + i2 * G_LDT + c8) = pqk; }
            if (tid < 64) { sgc[tid] = pgi; sbt[tid] = pbt; }
            if (cc + 1 < nch) { const int cln = dir ? nch - 2 - cc : cc + 1; GDN_FETCH((sq_.start >> 6) + cln); }
        }
        __syncthreads();
        f4v oacc[4];
        {
            f4v kS[4], qS[4];
#pragma unroll
            for (int ct = 0; ct < 4; ++ct) { kS[ct] = (f4v){0.f, 0.f, 0.f, 0.f}; qS[ct] = (f4v){0.f, 0.f, 0.f, 0.f}; }
#pragma unroll
            for (int ks = 0; ks < 4; ++ks) {
                const s8v ak = *(const s8v*)(Kc + (16 * rt + fr) * G_LDS + ks * 32 + fq * 8);
                const s8v aq = *(const s8v*)(Qc + (16 * rt + fr) * G_LDS + ks * 32 + fq * 8);
#pragma unroll
                for (int ct = 0; ct < 4; ++ct) {
                    const s8v bb = *(const s8v*)(St + (64 * chf + 16 * ct + fr) * G_LDS + ks * 32 + fq * 8);
                    kS[ct] = mfma16(ak, bb, kS[ct]); qS[ct] = mfma16(aq, bb, qS[ct]);
                }
            }
            float eg[4], bt[4];
#pragma unroll
            for (int r = 0; r < 4; ++r) { const int i = 16 * rt + fq * 4 + r; eg[r] = fexp(sgc[i]); bt[r] = sbt[i]; }
#pragma unroll
            for (int ct = 0; ct < 4; ++ct) {
                const int dv = 64 * chf + 16 * ct + fr;
                float rv[4];
#pragma unroll
                for (int r = 0; r < 4; ++r) { const int i = 16 * rt + fq * 4 + r; rv[r] = bt[r] * (bf2f(Vc[i * 128 + dv]) - eg[r] * kS[ct][r]); oacc[ct][r] = eg[r] * qS[ct][r]; }
                *(uint2*)(rT + dv * G_LDT + 16 * rt + fq * 4) = make_uint2(pack2(rv[0], rv[1]), pack2(rv[2], rv[3]));
            }
        }
        __syncthreads();
        {
            f4v dl[4];
#pragma unroll
            for (int ct = 0; ct < 4; ++ct) dl[ct] = (f4v){0.f, 0.f, 0.f, 0.f};
#pragma unroll
            for (int ks = 0; ks < 2; ++ks) {
                const s8v a = *(const s8v*)(Ti + (16 * rt + fr) * G_LDT + ks * 32 + fq * 8);
#pragma unroll
                for (int ct = 0; ct < 4; ++ct) { const s8v bb = *(const s8v*)(rT + (64 * chf + 16 * ct + fr) * G_LDT + ks * 32 + fq * 8); dl[ct] = mfma16(a, bb, dl[ct]); }
            }
#pragma unroll
            for (int ct = 0; ct < 4; ++ct) { const int dv = 64 * chf + 16 * ct + fr;
                *(uint2*)(dT + dv * G_LDT + 16 * rt + fq * 4) = make_uint2(pack2(dl[ct][0], dl[ct][1]), pack2(dl[ct][2], dl[ct][3])); }
        }
        __syncthreads();
        {
#pragma unroll
            for (int ks = 0; ks < 2; ++ks) {
                const s8v a = *(const s8v*)(Qk + (16 * rt + fr) * G_LDT + ks * 32 + fq * 8);
#pragma unroll
                for (int ct = 0; ct < 4; ++ct) { const s8v bb = *(const s8v*)(dT + (64 * chf + 16 * ct + fr) * G_LDT + ks * 32 + fq * 8); oacc[ct] = mfma16(a, bb, oacc[ct]); }
            }
#pragma unroll
            for (int ct = 0; ct < 4; ++ct)
#pragma unroll
                for (int r = 0; r < 4; ++r) { const int i = 16 * rt + fq * 4 + r, t = cg * 64 + (dir ? 63 - i : i);
                    opart[(size_t)t * 512 + h * 128 + 64 * chf + 16 * ct + fr] = f2bf(oacc[ct][r]); }
            const float ge = fexp(sgc[63]);
#pragma unroll
            for (int ct = 0; ct < 8; ++ct) Sacc[ct] *= ge;
#pragma unroll
            for (int ks = 0; ks < 2; ++ks) {
                const s8v a = *(const s8v*)(KeT + (16 * wid + fr) * G_LDT + ks * 32 + fq * 8);
#pragma unroll
                for (int ct = 0; ct < 8; ++ct) { const s8v bb = *(const s8v*)(dT + (16 * ct + fr) * G_LDT + ks * 32 + fq * 8); Sacc[ct] = mfma16(a, bb, Sacc[ct]); }
            }
#pragma unroll
            for (int ct = 0; ct < 8; ++ct) *(uint2*)(St + (16 * ct + fr) * G_LDS + 16 * wid + fq * 4) = make_uint2(pack2(Sacc[ct][0], Sacc[ct][1]), pack2(Sacc[ct][2], Sacc[ct][3]));
        }
        __syncthreads();
    }
    if (!sq_.lat) {
        float* fs = p.out + OUT_GDN + ((((size_t)sq_.b * N_ODD + oi) * 2 + dir) * 4 + h) * 128 * 128;
#pragma unroll
        for (int ct = 0; ct < 8; ++ct)
#pragma unroll
            for (int r = 0; r < 4; ++r) fs[(16 * wid + fq * 4 + r) * 128 + 16 * ct + fr] = Sacc[ct][r];
    }
}
constexpr int S5_HLD = 136;
__device__ __forceinline__ void s5_scan_task(const P& p, int oi, int s, int dir, int g8, unsigned char* dsm) {
    const int tid = opaque_tid(), w = tid >> 6, lane = tid & 63, g = g8 * 8 + w, fr = lane & 15, fq = lane >> 4;
    float* BuL = (float*)(dsm + w * (16 * 128 * 4 + 16 * S5_HLD * 2));
    bf16* Hs = (bf16*)(BuL + 16 * 128);
    const Seq sq_ = get_seq(s);
    const bf16* proj = (const bf16*)(p.ws + WS_PROJ);
    bf16* ypart = (bf16*)(p.ws + WS_PART + (size_t)(2 + dir) * PART_SZ);
    const size_t pg = ((size_t)(oi * 2 + dir) * 32 + g);
    float abr, abi;
    {
        const float are = fminf(p.in[I_S5AR][pg * 64 + lane], -1e-4f), aim = p.in[I_S5AI][pg * 64 + lane];
        const float dt = fexp(p.in[I_S5DT][pg]);
        const float mag = fexp(are * dt);
        abr = mag * cosf(aim * dt); abi = mag * sinf(aim * dt);
    }
    s8v bfrag[8];
    {
        const float dt = fexp(p.in[I_S5DT][pg]);
#pragma unroll
        for (int ct = 0; ct < 8; ++ct) {
            const int st = (16 * ct + fr) & 63;
            const float are = fminf(p.in[I_S5AR][pg * 64 + st], -1e-4f), aim = p.in[I_S5AI][pg * 64 + st];
            const float mag = fexp(are * dt), br_ = mag * cosf(aim * dt), bi_ = mag * sinf(aim * dt);
            const float den = are * are + aim * aim;
            const float fre = ((br_ - 1.0f) * are + bi_ * aim) / den, fim = (bi_ * are - (br_ - 1.0f) * aim) / den;
#pragma unroll
            for (int j = 0; j < 8; ++j) {
                float v = 0.f;
                if (fq < 2) {
                    const float br = p.in[I_S5BR][(pg * 64 + st) * 16 + fq * 8 + j], bi = p.in[I_S5BI][(pg * 64 + st) * 16 + fq * 8 + j];
                    v = ct < 4 ? fre * br - fim * bi : fre * bi + fim * br;
                }
                bfrag[ct][j] = (short)f2bf(v);
            }
        }
    }
    s8v cfrag[4];
#pragma unroll
    for (int ks = 0; ks < 4; ++ks)
#pragma unroll
        for (int j = 0; j < 8; ++j) {
            const int pp = 32 * ks + 8 * fq + j;
            const float v = pp < 64 ? p.in[I_S5CR][pg * 1024 + fr * 64 + pp] : -p.in[I_S5CI][pg * 1024 + fr * 64 + pp - 64];
            cfrag[ks][j] = (short)f2bf(v);
        }
    float hr = 0.f, hi = 0.f;
    if (sq_.lat) { const size_t o = (((size_t)sq_.b * N_ODD + oi) * 2 + dir) * 32 * 64 + g * 64 + lane; hr = p.in[I_SS5R][o]; hi = p.in[I_SS5I][o]; }
    for (int c0 = 0; c0 < sq_.len; c0 += 16) {
        s8v ua = (s8v){0, 0, 0, 0, 0, 0, 0, 0};
        {
            const int pos = c0 + fr, t = sq_.start + (dir ? sq_.len - 1 - pos : pos);
            if (fq < 2) ua = *(const s8v*)(proj + (size_t)t * OW + O_U + g * 16 + fq * 8);
        }
        WAVE_SYNC();
#pragma unroll
        for (int ct = 0; ct < 8; ++ct) {
            const f4v bu = mfma16(ua, bfrag[ct], (f4v){0.f, 0.f, 0.f, 0.f});
#pragma unroll
            for (int r = 0; r < 4; ++r) BuL[(fq * 4 + r) * 128 + 16 * ct + fr] = bu[r];
        }
        WAVE_SYNC();
#pragma unroll
        for (int i = 0; i < 16; ++i) {
            const float br = BuL[i * 128 + lane], bi = BuL[i * 128 + 64 + lane];
            const float nr = abr * hr - abi * hi + br, ni = abr * hi + abi * hr + bi;
            hr = nr; hi = ni;
            Hs[i * S5_HLD + lane] = f2bf(hr); Hs[i * S5_HLD + 64 + lane] = f2bf(hi);
        }
        WAVE_SYNC();
        f4v y = (f4v){0.f, 0.f, 0.f, 0.f};
#pragma unroll
        for (int ks = 0; ks < 4; ++ks) y = mfma16(*(const s8v*)(Hs + fr * S5_HLD + 32 * ks + 8 * fq), cfrag[ks], y);
#pragma unroll
        for (int r = 0; r < 4; ++r) { const int pos = c0 + fq * 4 + r, t = sq_.start + (dir ? sq_.len - 1 - pos : pos); ypart[(size_t)t * 512 + g * 16 + fr] = f2bf(y[r]); }
    }
    if (!sq_.lat) {
        const size_t o = (((size_t)sq_.b * N_ODD + oi) * 2 + dir) * 32 * 64 + g * 64 + lane;
        p.out[OUT_S5R + o] = hr; p.out[OUT_S5I + o] = hi;
    }
}
constexpr int ODD_GDN_ITEMS = NSEQ * 8, ODD_S5_ITEMS = NSEQ * 8;
constexpr int ODD_SCAN_ITEMS = ODD_GDN_ITEMS + ODD_S5_ITEMS;
__device__ __forceinline__ void ph_odd_scan_item(const P& p, int w, int oi, float* smem_full) {
    unsigned char* dsm = (unsigned char*)smem_full;
    const int nlg = NB_LAT * 8, nls = NB_LAT * 8, ncg = NB_CTX * 8;
    int kind, sbase, x;
    if (w < nlg) { kind = 0; sbase = NB_CTX; x = w; }
    else if (w < nlg + nls) { kind = 1; sbase = NB_CTX; x = w - nlg; }
    else if (w < nlg + nls + ncg) { kind = 0; sbase = 0; x = w - nlg - nls; }
    else { kind = 1; sbase = 0; x = w - nlg - nls - ncg; }
    if (kind == 0) gdn_scan_task(p, oi, sbase + x / 8, (x % 8) >> 1, x & 1, dsm);
    else { __syncthreads(); s5_scan_task(p, oi, sbase + x / 8, (x % 8) >> 2, x & 3, dsm); }
}
__device__ __forceinline__ void ph_fin_odd_a(const P& p, int bid, int oi) {
    const int lane = LT & 63, t = bid * 4 + (LT >> 6);
    if (t >= T) return;
    const bf16* pr = (const bf16*)(p.ws + WS_PROJ) + (size_t)t * OW;
    const bf16* of = (const bf16*)(p.ws + WS_PART) + (size_t)t * 512;
    const bf16* ob = (const bf16*)(p.ws + WS_PART + PART_SZ) + (size_t)t * 512;
    const bf16* yf = (const bf16*)(p.ws + WS_PART + 2 * PART_SZ) + (size_t)t * 512;
    const bf16* yb = (const bf16*)(p.ws + WS_PART + 3 * PART_SZ) + (size_t)t * 512;
    bf16* yc = (bf16*)(p.ws + WS_HM) + (size_t)t * D;
    const int idx = lane * 8;
    float o[8], ss = 0.f;
#pragma unroll
    for (int j = 0; j < 8; ++j) { o[j] = bf2f(of[idx + j]) + bf2f(ob[idx + j]); ss += o[j] * o[j]; }
    ss += __shfl_xor(ss, 1); ss += __shfl_xor(ss, 2); ss += __shfl_xor(ss, 4); ss += __shfl_xor(ss, 8);
    const float r = frsq(ss * (1.0f / 128.f) + EPS);
    const float* gn = p.in[I_GDNN] + oi * 128 + (idx & 127);
    const float* dsk = p.in[I_S5D] + oi * 512 + idx;
#pragma unroll
    for (int j = 0; j < 8; ++j) {
        yc[idx + j] = f2bf(o[j] * r * gn[j] * siluf_(bf2f(pr[O_ZC + idx + j])));
        const float y = bf2f(yf[idx + j]) + bf2f(yb[idx + j]) + dsk[j] * bf2f(pr[O_U + idx + j]);
        yc[512 + idx + j] = f2bf(gelu_tanh(y));
    }
}
__device__ __forceinline__ void ph_fin_odd_b(const P& p, int bid, int oi) {
    const size_t e = ((size_t)bid * 256 + LT) * 4;
    if (e >= (size_t)T * 512) return;
    const int t = (int)(e >> 9), idx = (int)(e & 511);
    const bf16* pr = (const bf16*)(p.ws + WS_PROJ) + (size_t)t * OW;
    const bf16* gl = (const bf16*)(p.ws + WS_PART + 2 * PART_SZ) + (size_t)t * 512;
    bf16* yc = (bf16*)(p.ws + WS_HM) + (size_t)t * D + 512;
#pragma unroll
    for (int j = 0; j < 4; ++j) {
        const float ys = bf2f(yc[idx + j]);
        yc[idx + j] = f2bf(ys * sigmoidf_(bf2f(gl[idx + j]) + p.in[I_GLUB][oi * 512 + idx + j]) * siluf_(bf2f(pr[O_ZD + idx + j])));
    }
}

enum { PK_PREP0, PK_HMOD0, PK_GEMM_IN, PK_EVEN_SCAN, PK_FIN_EVEN, PK_ODD_PREP, PK_ODD_SCAN, PK_FIN_ODD_A, PK_GEMM_GLU, PK_FIN_ODD_B, PK_GEMM_OUT, PK_POST, PK_RWKV_PREP0, PK_RWKV_PREP1, PK_EVEN_SCAN1 };
constexpr int NPH = 2 + (DEPTH / 2) * 16;
constexpr int TOKB = (T + 3) / 4;
static_assert(DEPTH % 2 == 0, "even depth expected");
__host__ __device__ inline void phase_desc(int ph, int& kind, int& layer) {
    if (ph == 0) { kind = PK_PREP0; layer = 0; return; }
    if (ph == 1) { kind = PK_HMOD0; layer = 0; return; }
    ph -= 2;
    const int pair = ph / 16, r = ph % 16;
    if (r < 8) { layer = 2 * pair; kind = r == 0 ? PK_GEMM_IN : r == 1 ? PK_RWKV_PREP0 : r == 2 ? PK_EVEN_SCAN : r == 3 ? PK_RWKV_PREP1 : r == 4 ? PK_EVEN_SCAN1 : r == 5 ? PK_FIN_EVEN : r == 6 ? PK_GEMM_OUT : PK_POST; }
    else { const int q = r - 8; layer = 2 * pair + 1; kind = q == 0 ? PK_GEMM_IN : q == 1 ? PK_ODD_PREP : q == 2 ? PK_ODD_SCAN : q == 3 ? PK_FIN_ODD_A : q == 4 ? PK_GEMM_GLU : q == 5 ? PK_FIN_ODD_B : q == 6 ? PK_GEMM_OUT : PK_POST; }
}
__host__ __device__ inline bool phase_is_gemm(int kind) { return kind == PK_GEMM_IN || kind == PK_GEMM_GLU || kind == PK_GEMM_OUT; }
__host__ __device__ inline int phase_nblk(int kind, int layer) {
    switch (kind) {
        case PK_PREP0: return DEPTH * 48 + WT_TILES;
        case PK_FIN_ODD_B: return (T * 512 / 4 + 255) / 256;
        default: return TOKB;
    }
}
__device__ __forceinline__ void do_phase(const P& p, int kind, int layer, int vb, float* smem) {
    const int i = layer >> 1;
    switch (kind) {
        case PK_PREP0: if (vb < DEPTH * 48) ph_mod(p, vb, smem); else ph_wt(p, vb - DEPTH * 48, smem); break;
        case PK_HMOD0: ph_hmod0(p, vb); break;
        case PK_FIN_EVEN: ph_fin_even(p, vb, i); break;
        case PK_FIN_ODD_A: ph_fin_odd_a(p, vb, i); break;
        case PK_FIN_ODD_B: ph_fin_odd_b(p, vb, i); break;
        case PK_POST: ph_post(p, vb, layer); break;
    }
}
__device__ __forceinline__ void do_gemm(const P& p, int kind, int layer, int G, int c, unsigned char* dsm) {
    const int i = layer >> 1;
    const bf16* hm = (const bf16*)(p.ws + WS_HM);
    pg8::StaticOrder S;
    LDS_AS unsigned char* lds = (LDS_AS unsigned char*)dsm;
    if (kind == PK_GEMM_IN) {
        if ((layer & 1) == 0) { pg8::Gemm g{hm, (const bf16*)(p.ws + WS_WTE) + (size_t)i * EWP * D, T, EWP, D, D}; S.init(T, EWP, G, c); pg8::EpiBf16 E{(bf16*)(p.ws + WS_PROJ), EW, EW}; pg8::gemm_phase(lds, g, S, E); }
        else { pg8::Gemm g{hm, (const bf16*)(p.ws + WS_WTO) + (size_t)i * OWP * D, T, OWP, D, D}; S.init(T, OWP, G, c); pg8::EpiBf16 E{(bf16*)(p.ws + WS_PROJ), OW, OW}; pg8::gemm_phase(lds, g, S, E); }
    } else if (kind == PK_GEMM_GLU) {
        pg8::Gemm g{hm + 512, (const bf16*)(p.ws + WS_WTGLU) + (size_t)i * 512 * 512, T, 512, 512, D}; S.init(T, 512, G, c); pg8::EpiBf16 E{(bf16*)(p.ws + WS_PART + 2 * PART_SZ), 512, 512}; pg8::gemm_phase(lds, g, S, E);
    } else {
        pg8::Gemm g{hm, (const bf16*)(p.ws + WS_WTOUT) + (size_t)layer * D * D, T, D, D, D}; S.init(T, D, G, c); pg8::EpiF32 E{(float*)(p.ws + WS_PROJ), D}; pg8::gemm_phase(lds, g, S, E);
    }
}
constexpr int LDS_BYTES = 163840;
#ifndef REP_SCAN
#define REP_SCAN 1
#endif
#ifndef REP_GEMM
#define REP_GEMM 1
#endif

#ifdef CPU_EMU
__global__ void k_phase(P p, int kind, int layer, int nb) {
    __shared__ __attribute__((aligned(16))) unsigned char dsm[LDS_BYTES];
    if (phase_is_gemm(kind)) { do_gemm(p, kind, layer, gridDim.x, blockIdx.x, dsm); return; }
    if (kind == PK_ODD_SCAN) { ph_odd_scan_item(p, blockIdx.x, layer >> 1, (float*)dsm); return; }
    if (kind == PK_ODD_PREP) { ph_odd_prep(p, blockIdx.x, layer >> 1, dsm); return; }
    if (kind == PK_EVEN_SCAN || kind == PK_EVEN_SCAN1) { ph_even_scan_item(p, blockIdx.x, layer >> 1, kind == PK_EVEN_SCAN1, dsm); return; }
    if (kind == PK_RWKV_PREP0 || kind == PK_RWKV_PREP1) { rwkv_prep_phase(p, layer >> 1, kind == PK_RWKV_PREP1, blockIdx.x, gridDim.x, dsm); return; }
    const int half = threadIdx.x >> 8, vb = 2 * blockIdx.x + half;
    if (vb < nb) do_phase(p, kind, layer, vb, (float*)dsm + half * 16384);
}
void emu_hook(const char* stage, int layer, const P& p);
extern "C" void kernel_launch(void* const* d_in, const int* in_sizes, int n_in, void* d_out, int out_size, void* d_ws, size_t ws_size, hipStream_t stream) {
    P p{};
    for (int i = 0; i < 44; ++i) p.in[i] = (const float*)d_in[i];
    p.out = (float*)d_out; p.ws = (char*)d_ws;
    static const char* names[] = {"prep0", "hmod", "proj", "even_scan0", "ycat", "odd_prep", "odd_scan", "fin_odd_a", "glu", "ycat", "outproj", "post", "rwkv_prep0", "rwkv_prep1", "even_scan"};
    for (int ph = 0; ph < NPH; ++ph) {
        int kind, layer; phase_desc(ph, kind, layer);
        const int nb = phase_nblk(kind, layer);
        EMU_LAUNCH(k_phase, phase_is_gemm(kind) ? 3 : kind == PK_ODD_SCAN ? ODD_SCAN_ITEMS : (kind == PK_EVEN_SCAN || kind == PK_EVEN_SCAN1) ? EVEN_SCAN_ITEMS : (kind == PK_RWKV_PREP0 || kind == PK_RWKV_PREP1) ? RWKV_PREP_ITEMS : kind == PK_ODD_PREP ? ODD_PREP_ITEMS : (nb + 1) / 2, 512, p, kind, layer, nb);
        emu_hook(names[kind], layer, p);
    }
}
#else

#define XB_TMO      128
#define XB_XCNT(j)  (256  + 64 * (j))
#define XB_XSUB(j)  (1280 + 64 * (j))
#define XB_XGEN(j)  (2304 + 64 * (j))
#define XB_TOP      3328
#define XB_TOPGEN   3392
#define XCD_BAR_WORDS 3456
#define XB_SPIN_CAP (1u << 18)
__device__ __forceinline__ unsigned xb_ld(unsigned* p)              { return __hip_atomic_load(p, __ATOMIC_RELAXED, __HIP_MEMORY_SCOPE_AGENT); }
__device__ __forceinline__ unsigned xb_add(unsigned* p, unsigned v) { return __hip_atomic_fetch_add(p, v, __ATOMIC_RELAXED, __HIP_MEMORY_SCOPE_AGENT); }
__device__ __forceinline__ unsigned xb_xcc_id() { return (unsigned)__builtin_amdgcn_s_getreg((3 << 11) | 20) & 0xFu; }
#define XB_SPIN(cond, bar) do { unsigned _sp = 0; while (cond) { __builtin_amdgcn_s_sleep(1); \
    if ((++_sp & 255u) == 0u) { if (xb_ld(&(bar)[XB_TMO])) break; if (_sp > XB_SPIN_CAP) { atomicAdd(&(bar)[XB_TMO], 1u); break; } } } } while (0)
struct XcdBarrier { unsigned* bar; unsigned x; volatile LDS_AS unsigned* st; };
__device__ __forceinline__ XcdBarrier xcd_barrier_post(unsigned* bar, volatile LDS_AS unsigned* st) {
    XcdBarrier b; b.bar = bar; b.x = xb_xcc_id(); b.st = st;
    if (threadIdx.x == 0) (void)xb_add(&bar[XB_XCNT(b.x)], 1u);
    return b;
}
__device__ __forceinline__ void xcd_barrier_complete(unsigned* bar, unsigned x, unsigned& nloc, unsigned& nx) {
    const unsigned G = gridDim.x * gridDim.y * gridDim.z;
    unsigned sum, cnt, mine, sp = 0u;
    for (;;) {
        sum = 0u; cnt = 0u; mine = 0u;
#pragma unroll
        for (unsigned j = 0; j < 16; ++j) { const unsigned c = xb_ld(&bar[XB_XCNT(j)]); sum += c; cnt += (c > 0u) ? 1u : 0u; mine = (j == x) ? c : mine; }
        if (sum == G) break;
        __builtin_amdgcn_s_sleep(1);
        if ((++sp & 255u) == 0u) { if (xb_ld(&bar[XB_TMO])) break; if (sp > XB_SPIN_CAP) { atomicAdd(&bar[XB_TMO], 1u); break; } }
    }
    nloc = mine > 0u ? mine : 1u; nx = cnt > 0u ? cnt : 1u;
}
__device__ __forceinline__ void xcd_barrier(const XcdBarrier& b) {
    asm volatile("s_waitcnt vmcnt(0)" ::: "memory");
    __syncthreads();
    if (threadIdx.x == 0) {
        unsigned* bar = b.bar;
        __builtin_amdgcn_s_waitcnt(0);
        unsigned nloc = b.st[0], nx = b.st[1];
        if (nloc == 0u) { xcd_barrier_complete(bar, b.x, nloc, nx); b.st[0] = nloc; b.st[1] = nx; }
        const unsigned old = xb_add(&bar[XB_XSUB(b.x)], 1u);
        const unsigned gen = old / nloc;
        if (old + 1u == (gen + 1u) * nloc) {
            __builtin_amdgcn_fence(__ATOMIC_RELEASE, "agent");
            asm volatile("s_waitcnt vmcnt(0)" ::: "memory");
            const unsigned og = xb_add(&bar[XB_TOP], 1u);
            const unsigned tg = og / nx;
            if (og + 1u == (tg + 1u) * nx) xb_add(&bar[XB_TOPGEN], 1u);
            else XB_SPIN(xb_ld(&bar[XB_TOPGEN]) == tg, bar);
            __builtin_amdgcn_fence(__ATOMIC_ACQUIRE, "agent");
            xb_add(&bar[XB_XGEN(b.x)], 1u);
            asm volatile("s_waitcnt vmcnt(0)" ::: "memory");
        } else {
            XB_SPIN(xb_ld(&bar[XB_XGEN(b.x)]) == gen, bar);
            __builtin_amdgcn_fence(__ATOMIC_ACQUIRE, "agent");
            asm volatile("s_waitcnt vmcnt(0)" ::: "memory");
        }
    }
    __syncthreads();
}
extern __shared__ __attribute__((aligned(16))) unsigned char dsm[];
#define RUN_PHASE(KIND, LAYER) do { const int nb_ = phase_nblk(KIND, LAYER); const int half_ = opaque_tid() >> 8; \
    for (int b_ = blockIdx.x; 2 * b_ < nb_; b_ += gridDim.x) { const int vb_ = 2 * b_ + half_; if (vb_ < nb_) do_phase(p, KIND, LAYER, vb_, (float*)dsm + half_ * 16384); } } while (0)
#define RUN_GEMM(KIND, LAYER) do_gemm(p, KIND, LAYER, gridDim.x, blockIdx.x, dsm)
typedef const __attribute__((address_space(4))) P* KP;
__device__ __forceinline__ const P& phase_args(KP pk) { asm volatile("" : "+s"(pk)); return *(const P*)pk; }
__global__ void __launch_bounds__(512) mega(P p_unused) {
    const KP pk = (KP)__builtin_amdgcn_kernarg_segment_ptr();
    cg::grid_group grid = cg::this_grid();
    volatile LDS_AS unsigned* xst = (volatile LDS_AS unsigned*)(dsm + LDS_BYTES - 16);
    if (threadIdx.x == 0) { xst[0] = 0u; xst[1] = 0u; }
    __syncthreads();
    XcdBarrier xb;
    { const P& p = phase_args(pk); xb = xcd_barrier_post((unsigned*)(p.ws + WS_BAR), xst); }
#define GSYNC() do { const P& pb_ = phase_args(pk); XcdBarrier b_ = xb; b_.bar = (unsigned*)(pb_.ws + WS_BAR); xcd_barrier(b_); } while (0)
    { const P& p = phase_args(pk); RUN_PHASE(PK_PREP0, 0); } grid.sync();
    { const P& p = phase_args(pk); RUN_PHASE(PK_HMOD0, 0); } GSYNC();
#pragma nounroll
    for (int pair = 0; pair < DEPTH / 2; ++pair) {
        const int le = 2 * pair, lo = 2 * pair + 1;
        { const P& p = phase_args(pk); RUN_GEMM(PK_GEMM_IN, le); } GSYNC();
#pragma nounroll
        for (int dir_ = 0; dir_ < 2; ++dir_) {
            { const P& p = phase_args(pk); rwkv_prep_phase(p, pair, dir_, blockIdx.x, gridDim.x, dsm); } GSYNC();
            { const P& p = phase_args(pk); for (int w_ = blockIdx.x; w_ < EVEN_SCAN_ITEMS; w_ += gridDim.x) ph_even_scan_item(p, w_, pair, dir_, dsm); } GSYNC();
        }
        { const P& p = phase_args(pk); RUN_PHASE(PK_FIN_EVEN, le); } GSYNC();
        { const P& p = phase_args(pk); RUN_GEMM(PK_GEMM_OUT, le); } GSYNC();
        { const P& p = phase_args(pk); RUN_PHASE(PK_POST, le); } GSYNC();
        { const P& p = phase_args(pk); RUN_GEMM(PK_GEMM_IN, lo); } GSYNC();
        { const P& p = phase_args(pk); for (int w_ = blockIdx.x; w_ < ODD_PREP_ITEMS; w_ += gridDim.x) ph_odd_prep(p, w_, pair, dsm); } GSYNC();
        { const P& p = phase_args(pk); for (int w_ = blockIdx.x; w_ < ODD_SCAN_ITEMS; w_ += gridDim.x) ph_odd_scan_item(p, w_, pair, (float*)dsm); } GSYNC();
        { const P& p = phase_args(pk); RUN_PHASE(PK_FIN_ODD_A, lo); } GSYNC();
        { const P& p = phase_args(pk); RUN_GEMM(PK_GEMM_GLU, lo); } GSYNC();
        { const P& p = phase_args(pk); RUN_PHASE(PK_FIN_ODD_B, lo); } GSYNC();
        { const P& p = phase_args(pk); RUN_GEMM(PK_GEMM_OUT, lo); } GSYNC();
        { const P& p = phase_args(pk); RUN_PHASE(PK_POST, lo); }
        if (pair + 1 < DEPTH / 2) GSYNC();
    }
}
extern "C" void kernel_launch(void* const* d_in, const int* in_sizes, int n_in, void* d_out, int out_size, void* d_ws, size_t ws_size, hipStream_t stream) {
    static int grid_blocks = 0;
    if (!grid_blocks) {
        int dev = 0, cus = 0, per_cu = 0;
        (void)hipGetDevice(&dev);
        (void)hipDeviceGetAttribute(&cus, hipDeviceAttributeMultiprocessorCount, dev);
        (void)hipFuncSetAttribute((const void*)mega, hipFuncAttributeMaxDynamicSharedMemorySize, LDS_BYTES);
        (void)hipOccupancyMaxActiveBlocksPerMultiprocessor(&per_cu, mega, 512, LDS_BYTES);
        if (per_cu < 1) fprintf(stderr, "occupancy query says %d blocks/CU\n", per_cu);
        grid_blocks = cus;
    }
    P p{};
    for (int i = 0; i < 44; ++i) p.in[i] = (const float*)d_in[i];
    p.out = (float*)d_out; p.ws = (char*)d_ws;
    (void)hipMemsetAsync((char*)d_ws + WS_BAR, 0, XCD_BAR_WORDS * 4, stream);
    void* args[] = {&p};
    hipError_t e = hipLaunchCooperativeKernel((void*)mega, dim3(grid_blocks), dim3(512), args, LDS_BYTES, stream);
    if (e != hipSuccess) fprintf(stderr, "cooperative launch failed: %s (grid %d)\n", hipGetErrorString(e), grid_blocks);
}
#endif
```

```cpp
#ifndef CPU_EMU
#include <hip/hip_runtime.h>
#include <hip/hip_cooperative_groups.h>
#include <cstdio>
namespace cg = cooperative_groups;
#endif
#include <stdint.h>

#ifndef CFG_BATCH
#define CFG_BATCH 16
#define CFG_SEQ 256
#define CFG_DEC_BATCH 8
#define CFG_DEC_SEQ 1024
#define CFG_DEPTH 4
#endif

typedef unsigned short bf16;
typedef short s8v __attribute__((ext_vector_type(8)));
typedef float f4v __attribute__((ext_vector_type(4)));

constexpr int D = 1024;
constexpr int NB_CTX = CFG_BATCH, L_CTX = CFG_SEQ, NB_LAT = CFG_DEC_BATCH, L_LAT = CFG_DEC_SEQ, DEPTH = CFG_DEPTH;
constexpr int N_EVEN = (DEPTH + 1) / 2, N_ODD = DEPTH / 2;
constexpr int T_CTX = NB_CTX * L_CTX, T_LAT = NB_LAT * L_LAT, T = T_CTX + T_LAT;
constexpr int NSEQ = NB_CTX + NB_LAT, NCOND = 1 + NB_LAT;
constexpr int EW = 3872, OW = 3088, EWP = 4096, OWP = 3328;
constexpr float EPS = 1e-6f;
constexpr int E_Q = 0, E_K = 256, E_V = 512, E_GD = 1024, E_ZA = 1056, E_FB = 1568, E_ZB = 3360;
constexpr int FB_R = 0, FB_K = 512, FB_V = 1024, FB_WD = 1536, FB_AD = 1664;
constexpr int O_QKV = 0, O_G = 1536, O_BETA = 1544, O_ZC = 1552, O_U = 2064, O_ZD = 2576;

constexpr size_t al(size_t x) { return (x + 255) & ~(size_t)255; }
constexpr size_t WS_MOD = 0;
constexpr size_t WS_WTE = WS_MOD + al((size_t)DEPTH * NCOND * 3072 * 4);
constexpr size_t WS_WTO = WS_WTE + al((size_t)N_EVEN * EWP * D * 2);
constexpr size_t WS_WTOUT = WS_WTO + al((size_t)(N_ODD ? N_ODD : 1) * OWP * D * 2);
constexpr size_t WS_WTGLU = WS_WTOUT + al((size_t)DEPTH * D * D * 2);
constexpr size_t WS_HM = WS_WTGLU + al((size_t)(N_ODD ? N_ODD : 1) * 512 * 512 * 2);
constexpr size_t WS_PROJ = WS_HM + al((size_t)T * D * 2);
constexpr size_t WS_PART = WS_PROJ + al((size_t)T * EW * 2);
constexpr size_t PART_SZ = al((size_t)T * 512 * 2);
constexpr size_t WS_BONUS = WS_PART + 4 * PART_SZ;
constexpr size_t WS_QKVN = WS_BONUS + al((size_t)T * 16 * 4);
constexpr size_t WS_GATES = WS_QKVN + al((size_t)T * 1536 * 2);
constexpr size_t WS_GC = WS_GATES + al((size_t)T * 16 * 4);
constexpr size_t WS_BAR = WS_GC + al((size_t)(T / 64) * 8 * 64 * 4);
constexpr size_t WS_END = WS_BAR + 16384;
constexpr size_t WS_TINV = WS_PROJ + al((size_t)T * OW * 2);
constexpr size_t WS_QKM = WS_HM;
static_assert(WS_TINV + (size_t)T * 1024 <= WS_PART, "TINV must fit in the PROJ tail");
constexpr size_t WS_RM12 = WS_HM;
constexpr size_t WS_RM34 = WS_QKVN;
constexpr size_t WS_VSH = WS_QKVN + (size_t)(T / 64) * 8 * 16384;
static_assert((size_t)(T / 64) * 8 * 16384 <= (size_t)T * D * 2, "M1/M2 must fit in HM");
static_assert((size_t)(T / 64) * 8 * 16384 + (size_t)T * 512 * 2 <= (size_t)T * 1536 * 2, "M3/M4 + shifted v must fit in QKVN");

constexpr size_t OUT_X = 0;
constexpr size_t OUT_GLA = (size_t)T * D;
constexpr size_t OUT_RWKV = OUT_GLA + (size_t)NB_CTX * N_EVEN * 2 * 4 * 64 * 128;
constexpr size_t OUT_GDN = OUT_RWKV + (size_t)NB_CTX * N_EVEN * 2 * 8 * 64 * 64;
constexpr size_t OUT_S5R = OUT_GDN + (size_t)NB_CTX * N_ODD * 2 * 4 * 128 * 128;
constexpr size_t OUT_S5I = OUT_S5R + (size_t)NB_CTX * N_ODD * 2 * 32 * 64;

struct P {
    const float* in[44];
    float* out;
    char* ws;
};
enum { I_XP = 0, I_XS, I_C, I_SGLA, I_SRWKV, I_SGDN, I_SS5R, I_SS5I, I_CCTX, I_WMOD, I_BMOD, I_GPRE, I_GPOST,
       I_WINE, I_WOUTE, I_GUP, I_GBIAS, I_GLAN, I_MIX, I_W0, I_W2, I_A0, I_A2, I_KK, I_KA, I_RK, I_LNG, I_LNB,
       I_WINO, I_WOUTO, I_CONV, I_ALOG, I_DTB, I_GDNN, I_S5AR, I_S5AI, I_S5DT, I_S5BR, I_S5BI, I_S5CR, I_S5CI,
       I_S5D, I_GLUW, I_GLUB };

#ifdef CPU_EMU
__device__ __forceinline__ int opaque_tid() { return (int)threadIdx.x; }
#else
__device__ __forceinline__ int opaque_tid() { int t = (int)threadIdx.x; asm volatile("" : "+v"(t)); return t; }
#endif
#define LT (opaque_tid() & 255)
__device__ __forceinline__ float u2f(unsigned u) { return __builtin_bit_cast(float, u); }
__device__ __forceinline__ unsigned f2u(float f) { return __builtin_bit_cast(unsigned, f); }
__device__ __forceinline__ float bf2f(bf16 h) { return u2f((unsigned)h << 16); }
#ifdef CPU_EMU
__device__ __forceinline__ bf16 f2bf(float f) { unsigned u = f2u(f); u += 0x7fffu + ((u >> 16) & 1u); return (bf16)(u >> 16); }
__device__ __forceinline__ unsigned pack2(float lo, float hi) { return (unsigned)f2bf(lo) | ((unsigned)f2bf(hi) << 16); }
__device__ __forceinline__ float fexp(float x) { return expf(x); }
__device__ __forceinline__ float flog(float x) { return logf(x); }
__device__ __forceinline__ float frcp(float x) { return 1.0f / x; }
__device__ __forceinline__ float frsq(float x) { return 1.0f / sqrtf(x); }
#else
typedef __bf16 hwbf2 __attribute__((ext_vector_type(2)));
typedef float hwf2 __attribute__((ext_vector_type(2)));
__device__ __forceinline__ unsigned pack2(float lo, float hi) { hwf2 v = {lo, hi}; return __builtin_bit_cast(unsigned, __builtin_convertvector(v, hwbf2)); }
__device__ __forceinline__ bf16 f2bf(float f) { return (bf16)(pack2(f, 0.f) & 0xffffu); }
__device__ __forceinline__ float fexp(float x) { return __builtin_amdgcn_exp2f(x * 1.4426950408889634f); }
__device__ __forceinline__ float flog(float x) { return __builtin_amdgcn_logf(x) * 0.6931471805599453f; }
__device__ __forceinline__ float frcp(float x) { return __builtin_amdgcn_rcpf(x); }
__device__ __forceinline__ float frsq(float x) { return __builtin_amdgcn_rsqf(x); }
#endif
__device__ __forceinline__ float sigmoidf_(float x) { return frcp(1.0f + fexp(-x)); }
__device__ __forceinline__ float siluf_(float x) { return x * frcp(1.0f + fexp(-x)); }
__device__ __forceinline__ float logsigf_(float x) { return fminf(x, 0.f) - flog(1.0f + fexp(-fabsf(x))); }
__device__ __forceinline__ float softplusf_(float x) { return fmaxf(x, 0.f) + flog(1.0f + fexp(-fabsf(x))); }
__device__ __forceinline__ float ftanh(float x) { const float e = fexp(-2.0f * fabsf(x)); const float t = (1.0f - e) * frcp(1.0f + e); return x < 0.f ? -t : t; }
__device__ __forceinline__ float gelu_tanh(float x) { return 0.5f * x * (1.0f + ftanh(0.7978845608028654f * (x + 0.044715f * x * x * x))); }

typedef float f8v __attribute__((ext_vector_type(8)));
__device__ __forceinline__ f8v unpack8v(const uint4& u) {
    f8v f; f[0] = u2f(u.x << 16); f[1] = u2f(u.x & 0xffff0000u); f[2] = u2f(u.y << 16); f[3] = u2f(u.y & 0xffff0000u);
    f[4] = u2f(u.z << 16); f[5] = u2f(u.z & 0xffff0000u); f[6] = u2f(u.w << 16); f[7] = u2f(u.w & 0xffff0000u); return f;
}
__device__ __forceinline__ uint4 pack8v(const f8v& f) { return make_uint4(pack2(f[0], f[1]), pack2(f[2], f[3]), pack2(f[4], f[5]), pack2(f[6], f[7])); }
struct Seq { int start, len, cond, lat, b; };
__device__ __forceinline__ Seq get_seq(int s) {
    Seq q;
    if (s < NB_CTX) { q.start = s * L_CTX; q.len = L_CTX; q.cond = 0; q.lat = 0; q.b = s; }
    else { int b = s - NB_CTX; q.start = T_CTX + b * L_LAT; q.len = L_LAT; q.cond = 1 + b; q.lat = 1; q.b = b; }
    return q;
}
__device__ __forceinline__ int tok_cond(int t) { return t < T_CTX ? 0 : 1 + (t - T_CTX) / L_LAT; }
__device__ __forceinline__ void tok_nbr(int t, bool& hl, bool& hr) {
    if (t < T_CTX) { int pos = t % L_CTX; hl = pos != 0; hr = pos != L_CTX - 1; }
    else { int pos = (t - T_CTX) & 63; hl = pos != 0; hr = pos != 63; }
}

__device__ __forceinline__ void ph_mod(const P& p, int bid, float* smem) {
    float (*sc)[1024] = (float(*)[1024])smem;
    float (*red)[64][NCOND] = (float(*)[64][NCOND])(smem + NCOND * 1024);
    const int layer = bid / 48, ct = bid % 48;
    __syncthreads();
    const int tid = LT, cl = tid & 63, kg = tid >> 6;
    for (int i = tid; i < NCOND * 1024; i += 256) {
        int ci = i >> 10, k = i & 1023;
        float v = ci == 0 ? p.in[I_CCTX][k] : p.in[I_C][(ci - 1) * 1024 + k];
        sc[ci][k] = siluf_(v);
    }
    __syncthreads();
    float acc[NCOND];
#pragma unroll
    for (int ci = 0; ci < NCOND; ++ci) acc[ci] = 0.f;
    const float* w = p.in[I_WMOD] + (size_t)layer * 1024 * 3072 + ct * 64 + cl;
    for (int kk = 0; kk < 256; ++kk) {
        int k = kg * 256 + kk;
        float wv = w[(size_t)k * 3072];
#pragma unroll
        for (int ci = 0; ci < NCOND; ++ci) acc[ci] += sc[ci][k] * wv;
    }
#pragma unroll
    for (int ci = 0; ci < NCOND; ++ci) red[kg][cl][ci] = acc[ci];
    __syncthreads();
    if (tid < 64) {
        float* mod = (float*)(p.ws + WS_MOD);
        int col = ct * 64 + cl;
#pragma unroll
        for (int ci = 0; ci < NCOND; ++ci)
            mod[(size_t)(layer * NCOND + ci) * 3072 + col] = red[0][cl][ci] + red[1][cl][ci] + red[2][cl][ci] + red[3][cl][ci] + p.in[I_BMOD][layer * 3072 + col];
    }
}

struct WtJob { const float* src; bf16* dst; int K, N, Npad; };
__device__ __forceinline__ WtJob wt_job(const P& p, int j) {
    WtJob q;
    if (j < N_EVEN) { q.src = p.in[I_WINE] + (size_t)j * D * EW; q.dst = (bf16*)(p.ws + WS_WTE) + (size_t)j * EWP * D; q.K = D; q.N = EW; q.Npad = EWP; return q; }
    j -= N_EVEN;
    if (j < N_ODD) { q.src = p.in[I_WINO] + (size_t)j * D * OW; q.dst = (bf16*)(p.ws + WS_WTO) + (size_t)j * OWP * D; q.K = D; q.N = OW; q.Npad = OWP; return q; }
    j -= N_ODD;
    if (j < DEPTH) { int i = j >> 1; q.src = (j & 1) ? p.in[I_WOUTO] + (size_t)i * D * D : p.in[I_WOUTE] + (size_t)i * D * D; q.dst = (bf16*)(p.ws + WS_WTOUT) + (size_t)j * D * D; q.K = D; q.N = D; q.Npad = D; return q; }
    j -= DEPTH;
    q.src = p.in[I_GLUW] + (size_t)j * 512 * 512; q.dst = (bf16*)(p.ws + WS_WTGLU) + (size_t)j * 512 * 512; q.K = 512; q.N = 512; q.Npad = 512; return q;
}
constexpr int WT_NJOBS = N_EVEN + N_ODD + DEPTH + N_ODD;
constexpr int WT_TILES = N_EVEN * (EWP / 64) * 16 + N_ODD * (OWP / 64) * 16 + DEPTH * 256 + N_ODD * 64;
__device__ __forceinline__ void ph_wt(const P& p, int bid, float* smem) {
    float (*tile)[65] = (float(*)[65])smem;
    int b = bid, j = 0;
    __syncthreads();
    WtJob q;
    for (;; ++j) { q = wt_job(p, j); int nt = (q.Npad / 64) * (q.K / 64); if (b < nt) break; b -= nt; }
    const int nk = q.K / 64, n0 = (b / nk) * 64, k0 = (b % nk) * 64;
    const int tx = LT & 63, ty = LT >> 6;
#pragma unroll
    for (int i = 0; i < 16; ++i) { int kk = ty + 4 * i, n = n0 + tx; tile[kk][tx] = n < q.N ? q.src[(size_t)(k0 + kk) * q.N + n] : 0.f; }
    __syncthreads();
#pragma unroll
    for (int i = 0; i < 16; ++i) { int nn = ty + 4 * i; q.dst[(size_t)(n0 + nn) * q.K + k0 + tx] = f2bf(tile[tx][nn]); }
}

__device__ __forceinline__ float wave_sum(float v) {
#pragma unroll
    for (int m = 1; m < 64; m <<= 1) v += __shfl_xor(v, m);
    return v;
}
__device__ __forceinline__ void hmod_row(const float* xv  , int lane, const float* gpre, const float* mod, bf16* dst) {
    float ss = 0.f;
#pragma unroll
    for (int i = 0; i < 16; ++i) ss += xv[i] * xv[i];
    ss = wave_sum(ss);
    const float r = frsq(ss * (1.0f / 1024.f) + EPS);
#pragma unroll
    for (int i = 0; i < 4; ++i) {
        int idx = i * 256 + lane * 4;
        bf16 o[4];
#pragma unroll
        for (int j = 0; j < 4; ++j) o[j] = f2bf(xv[i * 4 + j] * r * gpre[idx + j] * (1.0f + mod[1024 + idx + j]) + mod[idx + j]);
        *(uint2*)(dst + idx) = make_uint2((unsigned)o[0] | ((unsigned)o[1] << 16), (unsigned)o[2] | ((unsigned)o[3] << 16));
    }
}
__device__ __forceinline__ void ph_hmod0(const P& p, int bid) {
    const int lane = LT & 63, t = bid * 4 + (LT >> 6);
    if (t >= T) return;
    const float* xr = t < T_CTX ? p.in[I_XP] + (size_t)t * D : p.in[I_XS] + (size_t)(t - T_CTX) * D;
    float xv[16];
#pragma unroll
    for (int i = 0; i < 4; ++i) { float4 v = *(const float4*)(xr + i * 256 + lane * 4); xv[i * 4] = v.x; xv[i * 4 + 1] = v.y; xv[i * 4 + 2] = v.z; xv[i * 4 + 3] = v.w; }
    const float* mod = (const float*)(p.ws + WS_MOD) + (size_t)(0 * NCOND + tok_cond(t)) * 3072;
    hmod_row(xv, lane, p.in[I_GPRE], mod, (bf16*)(p.ws + WS_HM) + (size_t)t * D);
}
__device__ __forceinline__ void ph_post(const P& p, int bid, int layer) {
    const int lane = LT & 63, t = bid * 4 + (LT >> 6);
    if (t >= T) return;
    const float* xr = layer == 0 ? (t < T_CTX ? p.in[I_XP] + (size_t)t * D : p.in[I_XS] + (size_t)(t - T_CTX) * D) : p.out + OUT_X + (size_t)t * D;
    const float* mr = (const float*)(p.ws + WS_PROJ) + (size_t)t * D;
    const float* mod = (const float*)(p.ws + WS_MOD) + (size_t)(layer * NCOND + tok_cond(t)) * 3072;
    const float* gpost = p.in[I_GPOST] + layer * D;
    float xv[16], mv[16];
    float ss = 0.f;
#pragma unroll
    for (int i = 0; i < 4; ++i) {
        float4 v = *(const float4*)(xr + i * 256 + lane * 4); xv[i * 4] = v.x; xv[i * 4 + 1] = v.y; xv[i * 4 + 2] = v.z; xv[i * 4 + 3] = v.w;
        float4 m = *(const float4*)(mr + i * 256 + lane * 4); mv[i * 4] = m.x; mv[i * 4 + 1] = m.y; mv[i * 4 + 2] = m.z; mv[i * 4 + 3] = m.w;
    }
#pragma unroll
    for (int i = 0; i < 16; ++i) ss += mv[i] * mv[i];
    ss = wave_sum(ss);
    const float r = frsq(ss * (1.0f / 1024.f) + EPS);
    float* xo = p.out + OUT_X + (size_t)t * D;
#pragma unroll
    for (int i = 0; i < 4; ++i) {
        int idx = i * 256 + lane * 4;
#pragma unroll
        for (int j = 0; j < 4; ++j) xv[i * 4 + j] += mod[2048 + idx + j] * (mv[i * 4 + j] * r * gpost[idx + j]);
        *(float4*)(xo + idx) = make_float4(xv[i * 4], xv[i * 4 + 1], xv[i * 4 + 2], xv[i * 4 + 3]);
    }
    if (layer + 1 < DEPTH) {
        const float* mod2 = (const float*)(p.ws + WS_MOD) + (size_t)((layer + 1) * NCOND + tok_cond(t)) * 3072;
        hmod_row(xv, lane, p.in[I_GPRE] + (layer + 1) * D, mod2, (bf16*)(p.ws + WS_HM) + (size_t)t * D);
    }
}

#ifdef CPU_EMU
#define LDS_AS
#define GLDS16(gptr, lptr) memcpy((char*)(lptr) + (threadIdx.x & 63) * 16, (const void*)(gptr), 16)
#define PG_WAIT_V(n)
#define PG_WAIT_L(n)
#define PG_BAR __syncthreads()
#define PG_SCHED
#define PG_PRIO(x)
#define RFL(x) (x)
__device__ __forceinline__ unsigned cvt_pk_bf16(float lo, float hi) { return (unsigned)f2bf(lo) | ((unsigned)f2bf(hi) << 16); }
#else
#define LDS_AS __attribute__((address_space(3)))
#define GLDS16(gptr, lptr) __builtin_amdgcn_global_load_lds((const unsigned*)(gptr), (LDS_AS unsigned*)(lptr), 16, 0, 0)
#define PG_WAIT_V(n) asm volatile("s_waitcnt vmcnt(" #n ")" ::: "memory")
#define PG_WAIT_L(n) asm volatile("s_waitcnt lgkmcnt(" #n ")" ::: "memory")
#define PG_BAR __builtin_amdgcn_s_barrier()
#define PG_SCHED __builtin_amdgcn_sched_barrier(0)
#define PG_PRIO(x) __builtin_amdgcn_s_setprio(x)
#define RFL(x) __builtin_amdgcn_readfirstlane(x)
__device__ __forceinline__ unsigned cvt_pk_bf16(float lo, float hi) { return pack2(lo, hi); }
#endif
namespace pg8 {
constexpr int BM = 256, BK = 64, HALF = 128, HTB = HALF * BK * 2, STAGE_BYTES = 8 * HTB, NXCD = 8, WGM = 8;
__host__ __device__ __forceinline__ int lds_byte(int r, int c) { const int st = (r >> 4) * 2 + (c >> 5), rr = r & 15, cc = c & 31, ob = rr * 64 + cc * 2; return st * 1024 + (ob ^ (((ob >> 9) & 1) << 5)); }
__host__ __device__ __forceinline__ void stage_rc(int b, int& R, int& C) { const int st = b / 1024, sb = b % 1024, swz = sb ^ (((sb >> 9) & 1) << 5); R = (st >> 1) * 16 + swz / 64; C = (st & 1) * 32 + (swz % 64) / 2; }
__host__ __device__ __forceinline__ int perm32(int rho) { const int n = rho >> 4, i = rho & 15; return 8 * (i >> 2) + 4 * n + (i & 3); }
struct Unit { int pm, pn; };
struct Gemm { const bf16* A; const bf16* Bt; int M, N, K, lda; };
struct StaticOrder {
    int nM, nN, nwg, G, c;
    __host__ __device__ void init(int M, int N, int G_, int c_) { nM = M / BM; nN = N / BM; nwg = nM * nN; G = G_; c = c_; }
    __host__ __device__ bool next(int i, Unit& u) const {
        const long L = (long)i * G + c; if (L >= nwg) return false;
        int wgid = (int)L; { const int q = nwg / NXCD, r = nwg % NXCD, xcd = wgid % NXCD, off = wgid / NXCD; wgid = (xcd < r ? xcd * (q + 1) : r * (q + 1) + (xcd - r) * q) + off; }
        const int nig = WGM * nN, gid = wgid / nig, fm = gid * WGM, gsz = (nM - fm) < WGM ? (nM - fm) : WGM;
        u.pm = fm + ((wgid % nig) % gsz); u.pn = (wgid % nig) / gsz; return true;
    }
};
struct EpiF32 {
    static constexpr bool PERM = false;
    float* C; int ldc;
    __device__ __forceinline__ void operator()(const f4v (&acc)[2][2][4][2], const Unit& u, int wr, int wc, int fr, int fq) const {
        const int row0 = u.pm * BM + wr * 64 + fr, col0 = u.pn * BM + wc * 32 + 4 * fq;
#pragma unroll
        for (int ai = 0; ai < 2; ++ai)
#pragma unroll
            for (int m = 0; m < 4; ++m) { float* rowp = C + (size_t)(row0 + ai * HALF + m * 16) * ldc + col0;
#pragma unroll
                for (int bj = 0; bj < 2; ++bj)
#pragma unroll
                    for (int n = 0; n < 2; ++n) *(f4v*)(rowp + bj * HALF + n * 16) = acc[ai][bj][m][n]; }
    }
};
struct EpiBf16 {
    static constexpr bool PERM = true;
    bf16* O; int ldc; int N;
    __device__ __forceinline__ void operator()(const f4v (&acc)[2][2][4][2], const Unit& u, int wr, int wc, int fr, int fq) const {
        const int row0 = u.pm * BM + wr * 64 + fr, col0 = u.pn * BM + wc * 32 + 8 * fq;
#pragma unroll
        for (int ai = 0; ai < 2; ++ai)
#pragma unroll
            for (int m = 0; m < 4; ++m) { bf16* rowp = O + (size_t)(row0 + ai * HALF + m * 16) * ldc + col0;
#pragma unroll
                for (int bj = 0; bj < 2; ++bj) { const f4v v0 = acc[ai][bj][m][0], v1 = acc[ai][bj][m][1];
                    if (col0 + bj * HALF < N) *(uint4*)(rowp + bj * HALF) = make_uint4(cvt_pk_bf16(v0[0], v0[1]), cvt_pk_bf16(v0[2], v0[3]), cvt_pk_bf16(v1[0], v1[1]), cvt_pk_bf16(v1[2], v1[3])); } }
    }
};
struct EpiGlu {
    static constexpr bool PERM = true;
    bf16* O; const bf16* YS; const bf16* ZD; const float* GB;
    __device__ __forceinline__ void operator()(const f4v (&acc)[2][2][4][2], const Unit& u, int wr, int wc, int fr, int fq) const {
        const int row0 = u.pm * BM + wr * 64 + fr, col0 = u.pn * BM + wc * 32 + 8 * fq;
#pragma unroll
        for (int ai = 0; ai < 2; ++ai)
#pragma unroll
            for (int m = 0; m < 4; ++m) { const size_t row = (size_t)(row0 + ai * HALF + m * 16);
#pragma unroll
                for (int bj = 0; bj < 2; ++bj) { const int col = col0 + bj * HALF;
                    const f8v ys = unpack8v(*(const uint4*)(YS + row * 512 + col)), zd = unpack8v(*(const uint4*)(ZD + row * OW + col));
                    const f8v gb = *(const f8v*)(GB + col);
                    f8v o;
#pragma unroll
                    for (int j = 0; j < 8; ++j) { const float g = (j < 4 ? acc[ai][bj][m][0][j] : acc[ai][bj][m][1][j - 4]) + gb[j]; o[j] = ys[j] * sigmoidf_(g) * siluf_(zd[j]); }
                    *(uint4*)(O + row * D + col) = pack8v(o); } }
    }
};
template <class Epi>
__device__ __forceinline__ void gemm_phase(LDS_AS unsigned char* lds, const Gemm g, const StaticOrder& S, const Epi& E) {
    const int tid = opaque_tid(), wid = RFL(tid >> 6), lane = tid & 63, wr = wid >> 2, wc = wid & 3, fr = lane & 15, fq = lane >> 4;
    const int K = g.K, nt = K / BK;
    unsigned voffA[2], voffB[2];
#pragma unroll
    for (int i = 0; i < 2; ++i) { int R, C; stage_rc(tid * 16 + i * 8192, R, C); const int Rb = Epi::PERM ? ((R & ~31) + perm32(R & 31)) : R;
        voffA[i] = (unsigned)(R * g.lda + C) * 2u; voffB[i] = (unsigned)(Rb * K + C) * 2u; }
    const size_t kstep = (size_t)(BK * 2);
    const size_t hstepA = (size_t)HALF * g.lda * 2, hstepB = (size_t)HALF * K * 2;
    const size_t tstepA = 2 * hstepA, tstepB = 2 * hstepB;
    const unsigned ldsw = (unsigned)wid * 1024u;
    const int aoff = lds_byte(wr * 64 + fr, fq * 8), boff = lds_byte(wc * 32 + fr, fq * 8);
#define PG8_SA(b, h) (((b) * 2 + (h)) * HTB)
#define PG8_SB(b, h) ((4 + (b) * 2 + (h)) * HTB)
#define PG8_STAGE(bufoff, gbase, voff) do { _Pragma("unroll") for (int _i = 0; _i < 2; ++_i) GLDS16((const char*)(gbase) + (voff)[_i], lds + (bufoff) + ldsw + _i * 8192); } while (0)
#define PG8_LDA(dst, b, h) do { _Pragma("unroll") for (int m = 0; m < 4; ++m) _Pragma("unroll") for (int k = 0; k < 2; ++k) dst[m][k] = *(const LDS_AS s8v*)(lds + PG8_SA(b, h) + aoff + m * 2048 + k * 1024); } while (0)
#define PG8_LDB(dst, b, h) do { _Pragma("unroll") for (int n = 0; n < 2; ++n) _Pragma("unroll") for (int k = 0; k < 2; ++k) dst[n][k] = *(const LDS_AS s8v*)(lds + PG8_SB(b, h) + boff + n * 2048 + k * 1024); } while (0)
#define PG8_MMA(ai, bj, At, Bt) do { PG_PRIO(1); _Pragma("unroll") for (int m = 0; m < 4; ++m) _Pragma("unroll") for (int n = 0; n < 2; ++n) _Pragma("unroll") for (int k = 0; k < 2; ++k) \
        acc[ai][bj][m][n] = __builtin_amdgcn_mfma_f32_16x16x32_bf16(Bt[n][k], At[m][k], acc[ai][bj][m][n], 0, 0, 0); PG_PRIO(0); } while (0)
    Unit cur, nxt; int ui = 0;
    if (!S.next(0, cur)) return;
    f4v acc[2][2][4][2];
#pragma unroll
    for (int a = 0; a < 2; ++a)
#pragma unroll
        for (int b = 0; b < 2; ++b)
#pragma unroll
            for (int m = 0; m < 4; ++m)
#pragma unroll
                for (int n = 0; n < 2; ++n) acc[a][b][m][n] = (f4v){0.f, 0.f, 0.f, 0.f};
    s8v At[4][2], B0[2][2], B1[2][2];
    const char* cA = (const char*)g.A + (size_t)cur.pm * tstepA; const char* cB = (const char*)g.Bt + (size_t)cur.pn * tstepB;
    PG8_STAGE(PG8_SB(0, 0), cB, voffB); PG8_STAGE(PG8_SA(0, 0), cA, voffA); PG8_STAGE(PG8_SB(0, 1), cB + hstepB, voffB); PG8_STAGE(PG8_SA(0, 1), cA + hstepA, voffA);
    if (wr == 1) PG_BAR;
    PG_WAIT_V(4); PG_BAR;
    PG8_STAGE(PG8_SB(1, 0), cB + kstep, voffB); PG8_STAGE(PG8_SA(1, 0), cA + kstep, voffA); PG8_STAGE(PG8_SB(1, 1), cB + hstepB + kstep, voffB);
    PG_WAIT_V(6); PG_BAR;
    for (;;) {
        const bool has_next = S.next(ui + 1, nxt);
        const char* nA = has_next ? (const char*)g.A + (size_t)nxt.pm * tstepA : cA; const char* nB = has_next ? (const char*)g.Bt + (size_t)nxt.pn * tstepB : cB;
        for (int t = 0; t < nt; t += 2) {
            const bool last = (t == nt - 2);
            const char* a1 = cA + (size_t)(t + 1) * kstep;
            const char* a2 = last ? nA : cA + (size_t)(t + 2) * kstep; const char* b2 = last ? nB : cB + (size_t)(t + 2) * kstep;
            const char* a3 = a2 + kstep; const char* b3 = b2 + kstep;
            PG8_LDB(B0, 0, 0); PG_SCHED; PG8_LDA(At, 0, 0); PG8_STAGE(PG8_SA(1, 1), a1 + hstepA, voffA);
            PG_WAIT_L(8); PG_BAR; PG_WAIT_L(0); PG8_MMA(0, 0, At, B0); PG_BAR; PG_SCHED;
            PG8_LDB(B1, 0, 1); PG8_STAGE(PG8_SB(0, 0), b2, voffB);
            PG_BAR; PG_WAIT_L(0); PG8_MMA(0, 1, At, B1); PG_BAR;
            PG8_LDA(At, 0, 1); PG8_STAGE(PG8_SA(0, 0), a2, voffA);
            PG_BAR; PG_WAIT_L(0); PG8_MMA(1, 0, At, B0); PG_BAR; PG_SCHED;
            PG8_STAGE(PG8_SB(0, 1), b2 + hstepB, voffB);
            PG_WAIT_V(6); PG_BAR; PG8_MMA(1, 1, At, B1); PG_BAR;
            PG8_LDB(B0, 1, 0); PG_SCHED; PG8_LDA(At, 1, 0); PG8_STAGE(PG8_SA(0, 1), a2 + hstepA, voffA);
            PG_WAIT_L(8); PG_BAR; PG_WAIT_L(0); PG8_MMA(0, 0, At, B0); PG_BAR; PG_SCHED;
            PG8_LDB(B1, 1, 1); PG8_STAGE(PG8_SB(1, 0), b3, voffB);
            PG_BAR; PG_WAIT_L(0); PG8_MMA(0, 1, At, B1); PG_BAR;
            PG8_LDA(At, 1, 1); PG8_STAGE(PG8_SA(1, 0), a3, voffA);
            PG_BAR; PG_WAIT_L(0); PG8_MMA(1, 0, At, B0); PG_BAR; PG_SCHED;
            PG8_STAGE(PG8_SB(1, 1), b3 + hstepB, voffB);
            PG_WAIT_V(6); PG_BAR; PG8_MMA(1, 1, At, B1); PG_BAR;
        }
        E(acc, cur, wr, wc, fr, fq);
        if (!has_next) break;
#pragma unroll
        for (int a = 0; a < 2; ++a)
#pragma unroll
            for (int b = 0; b < 2; ++b)
#pragma unroll
                for (int m = 0; m < 4; ++m)
#pragma unroll
                    for (int n = 0; n < 2; ++n) acc[a][b][m][n] = (f4v){0.f, 0.f, 0.f, 0.f};
        cur = nxt; cA = nA; cB = nB; ++ui;
    }
    PG_WAIT_V(0);
    if (wr == 0) PG_BAR;
    PG_BAR;
}
}

#ifdef CPU_EMU
#define WAVE_SYNC() emu::wsync()
#define LBAR() __syncthreads()
#else
#define WAVE_SYNC() __builtin_amdgcn_wave_barrier()
#define LBAR() do { asm volatile("s_waitcnt lgkmcnt(0)" ::: "memory"); __builtin_amdgcn_s_barrier(); asm volatile("" ::: "memory"); } while (0)
#endif
__device__ __forceinline__ void unpack8(const uint4& u, float* f) {
    f[0] = u2f(u.x << 16); f[1] = u2f(u.x & 0xffff0000u); f[2] = u2f(u.y << 16); f[3] = u2f(u.y & 0xffff0000u);
    f[4] = u2f(u.z << 16); f[5] = u2f(u.z & 0xffff0000u); f[6] = u2f(u.w << 16); f[7] = u2f(u.w & 0xffff0000u);
}
__device__ __forceinline__ uint4 pack8(const float* f) { return make_uint4(pack2(f[0], f[1]), pack2(f[2], f[3]), pack2(f[4], f[5]), pack2(f[6], f[7])); }
__device__ __forceinline__ f4v unpack4(const uint2& u) { f4v f; f[0] = u2f(u.x << 16); f[1] = u2f(u.x & 0xffff0000u); f[2] = u2f(u.y << 16); f[3] = u2f(u.y & 0xffff0000u); return f; }
__device__ __forceinline__ uint2 pack4(const f4v& f) { return make_uint2(pack2(f[0], f[1]), pack2(f[2], f[3])); }
__device__ __forceinline__ f4v mfma16(const s8v& a, const s8v& b, const f4v& c) { return __builtin_amdgcn_mfma_f32_16x16x32_bf16(a, b, c, 0, 0, 0); }

__device__ __forceinline__ float red8(float x) {
#ifdef CPU_EMU
    x += __shfl_xor(x, 1); x += __shfl_xor(x, 2); x += __shfl_xor(x, 4);
#else
    x += __builtin_bit_cast(float, __builtin_amdgcn_mov_dpp(__builtin_bit_cast(int, x), 0xB1, 0xF, 0xF, true));
    x += __builtin_bit_cast(float, __builtin_amdgcn_mov_dpp(__builtin_bit_cast(int, x), 0x4E, 0xF, 0xF, true));
    x += __builtin_bit_cast(float, __builtin_amdgcn_mov_dpp(__builtin_bit_cast(int, x), 0x141, 0xF, 0xF, true));
#endif
    return x;
}
constexpr int GL_LD = 72;
__device__ __forceinline__ void gla_scan_task(const P& p, int ei, int s, int h, int dir, unsigned char* dsm) {
    bf16* LAt = (bf16*)dsm;
    bf16* Qd = LAt + 64 * GL_LD;
    bf16* Ki = Qd + 64 * GL_LD;
    bf16* KiT = Ki + 64 * GL_LD;
    bf16* Sc = KiT + 64 * GL_LD;
    bf16* VT = Sc + 64 * GL_LD;
    bf16* St = VT + 128 * GL_LD;
    float* sAE = (float*)(St + 128 * GL_LD);
    const Seq sq_ = get_seq(s);
    const int tid = opaque_tid(), lane = tid & 63, wid = tid >> 6, fr = lane & 15, fq = lane >> 4;
    const int rt = wid & 3, chf = wid >> 2;
    const bf16* proj = (const bf16*)(p.ws + WS_PROJ);
    bf16* opart = (bf16*)(p.ws + WS_PART + (size_t)dir * PART_SZ);
    s8v gfrag[2]; float gb[2];
    {
        const float* gup = p.in[I_GUP] + (size_t)(ei * 2 + dir) * 16 * 256 + h * 64;
        const float* gbias = p.in[I_GBIAS] + (size_t)(ei * 2 + dir) * 256 + h * 64;
#pragma unroll
        for (int c2 = 0; c2 < 2; ++c2) {
            const int d = 16 * (2 * chf + c2) + fr;
            gb[c2] = gbias[d];
#pragma unroll
            for (int j = 0; j < 8; ++j) gfrag[c2][j] = (short)f2bf(fq < 2 ? gup[(8 * fq + j) * 256 + d] : 0.f);
        }
    }
    f4v Sacc[4];
    LBAR();
    if (sq_.lat) {
        const float* s0 = p.in[I_SGLA] + ((((size_t)sq_.b * N_EVEN + ei) * 2 + dir) * 4 + h) * 64 * 128;
#pragma unroll
        for (int ct = 0; ct < 4; ++ct)
#pragma unroll
            for (int r = 0; r < 4; ++r) Sacc[ct][r] = s0[(16 * rt + fq * 4 + r) * 128 + 64 * chf + 16 * ct + fr];
    } else {
#pragma unroll
        for (int ct = 0; ct < 4; ++ct) Sacc[ct] = (f4v){0.f, 0.f, 0.f, 0.f};
    }
#pragma unroll
    for (int ct = 0; ct < 4; ++ct) *(uint2*)(St + (64 * chf + 16 * ct + fr) * GL_LD + 16 * rt + fq * 4) = make_uint2(pack2(Sacc[ct][0], Sacc[ct][1]), pack2(Sacc[ct][2], Sacc[ct][3]));
    const int nch = sq_.len >> 6;
    uint4 pv0, pv1, pq, pkk, pga;
#define GLA_FETCH(TB) do { \
        { const int i_ = lane, c8_ = wid * 8; const bf16* pr_ = proj + (size_t)((TB) + (dir ? 63 - i_ : i_)) * EW + E_V + h * 128 + c8_; \
          pv0 = *(const uint4*)pr_; pv1 = *(const uint4*)(pr_ + 64); } \
        { const int i_ = tid >> 3, c8_ = (tid & 7) * 8; const bf16* pr_ = proj + (size_t)((TB) + (dir ? 63 - i_ : i_)) * EW + h * 64 + c8_; \
          pq = *(const uint4*)(pr_ + E_Q); pkk = *(const uint4*)(pr_ + E_K); } \
        { const int i_ = 16 * rt + fr; pga = make_uint4(0u, 0u, 0u, 0u); if (fq < 2) pga = *(const uint4*)(proj + (size_t)((TB) + (dir ? 63 - i_ : i_)) * EW + E_GD + dir * 16 + fq * 8); } \
    } while (0)
    GLA_FETCH(sq_.start + (dir ? sq_.len - 64 : 0));
    for (int cc = 0; cc < nch; ++cc) {
        const int tb = sq_.start + (dir ? sq_.len - 64 - cc * 64 : cc * 64);
        {
            {
                const int i = lane, c8 = wid * 8;
                const f8v va = unpack8v(pv0), vb = unpack8v(pv1);
#pragma unroll
                for (int j = 0; j < 8; ++j) { VT[(c8 + j) * GL_LD + i] = f2bf(va[j]); VT[(64 + c8 + j) * GL_LD + i] = f2bf(vb[j]); }
            }
            { const int i = tid >> 3, c8 = (tid & 7) * 8; *(uint4*)(Qd + i * GL_LD + c8) = pq; *(uint4*)(Ki + i * GL_LD + c8) = pkk; }
            const s8v ga = __builtin_bit_cast(s8v, pga);
            if (cc + 1 < nch) GLA_FETCH(sq_.start + (dir ? sq_.len - 128 - cc * 64 : (cc + 1) * 64));
#pragma unroll
            for (int c2 = 0; c2 < 2; ++c2) {
                const f4v x = mfma16(ga, gfrag[c2], (f4v){0.f, 0.f, 0.f, 0.f});
                float la[4];
#pragma unroll
                for (int r = 0; r < 4; ++r) la[r] = logsigf_(x[r] + gb[c2]) * (1.0f / 16.0f);
                *(uint2*)(LAt + (16 * (2 * chf + c2) + fr) * GL_LD + 16 * rt + fq * 4) = make_uint2(pack2(la[0], la[1]), pack2(la[2], la[3]));
            }
        }
        LBAR();
        {
            f4v bc[2];
            bc[0] = (f4v){0.f, 0.f, 0.f, 0.f}; bc[1] = bc[0];
#pragma unroll
            for (int ks = 0; ks < 2; ++ks) {
                s8v lf;
#pragma unroll
                for (int j = 0; j < 8; ++j) lf[j] = (32 * ks + 8 * fq + j <= 16 * rt + fr) ? (short)0x3F80 : (short)0;
#pragma unroll
                for (int c2 = 0; c2 < 2; ++c2) bc[c2] = mfma16(lf, *(const s8v*)(LAt + (16 * (2 * chf + c2) + fr) * GL_LD + 32 * ks + 8 * fq), bc[c2]);
            }
#pragma unroll
            for (int c2 = 0; c2 < 2; ++c2) {
                const int d = 16 * (2 * chf + c2) + fr;
                float kiv[4];
#pragma unroll
                for (int r = 0; r < 4; ++r) {
                    const int i = 16 * rt + fq * 4 + r;
                    const float eb = fexp(bc[c2][r]);
                    const float qv = bf2f(Qd[i * GL_LD + d]) * 0.125f * eb;
                    kiv[r] = bf2f(Ki[i * GL_LD + d]) * frcp(eb);
                    Qd[i * GL_LD + d] = f2bf(qv); Ki[i * GL_LD + d] = f2bf(kiv[r]);
                    if (i == 63) sAE[d] = eb;
                }
                *(uint2*)(KiT + d * GL_LD + 16 * rt + fq * 4) = make_uint2(pack2(kiv[0], kiv[1]), pack2(kiv[2], kiv[3]));
            }
        }
        LBAR();
        f4v oacc[4];
        {
            f4v sc[2];
            sc[0] = (f4v){0.f, 0.f, 0.f, 0.f}; sc[1] = sc[0];
#pragma unroll
            for (int ct = 0; ct < 4; ++ct) oacc[ct] = (f4v){0.f, 0.f, 0.f, 0.f};
#pragma unroll
            for (int ks = 0; ks < 2; ++ks) {
                const s8v a = *(const s8v*)(Qd + (16 * rt + fr) * GL_LD + 32 * ks + 8 * fq);
#pragma unroll
                for (int c2 = 0; c2 < 2; ++c2) sc[c2] = mfma16(a, *(const s8v*)(Ki + (16 * (2 * chf + c2) + fr) * GL_LD + 32 * ks + 8 * fq), sc[c2]);
#pragma unroll
                for (int ct = 0; ct < 4; ++ct) oacc[ct] = mfma16(*(const s8v*)(St + (64 * chf + 16 * ct + fr) * GL_LD + 32 * ks + 8 * fq), a, oacc[ct]);
            }
#pragma unroll
            for (int c2 = 0; c2 < 2; ++c2)
#pragma unroll
                for (int r = 0; r < 4; ++r) { const int i = 16 * rt + fq * 4 + r, j = 16 * (2 * chf + c2) + fr; Sc[i * GL_LD + j] = f2bf(j <= i ? sc[c2][r] : 0.f); }
        }
        LBAR();
        {
#pragma unroll
            for (int ks = 0; ks < 2; ++ks) {
                const s8v a = *(const s8v*)(Sc + (16 * rt + fr) * GL_LD + 32 * ks + 8 * fq);
                const s8v kt = *(const s8v*)(KiT + (16 * rt + fr) * GL_LD + 32 * ks + 8 * fq);
#pragma unroll
                for (int ct = 0; ct < 4; ++ct) {
                    const s8v bv = *(const s8v*)(VT + (64 * chf + 16 * ct + fr) * GL_LD + 32 * ks + 8 * fq);
                    oacc[ct] = mfma16(bv, a, oacc[ct]); Sacc[ct] = mfma16(kt, bv, Sacc[ct]);
                }
            }
            {
                const int i = 16 * rt + fr, t = tb + (dir ? 63 - i : i);
#pragma unroll
                for (int ct = 0; ct < 4; ++ct) *(uint2*)(opart + (size_t)t * 512 + h * 128 + 64 * chf + 16 * ct + fq * 4) = pack4(oacc[ct]);
            }
            float ae[4];
#pragma unroll
            for (int r = 0; r < 4; ++r) ae[r] = sAE[16 * rt + fq * 4 + r];
#pragma unroll
            for (int ct = 0; ct < 4; ++ct) {
#pragma unroll
                for (int r = 0; r < 4; ++r) Sacc[ct][r] *= ae[r];
                *(uint2*)(St + (64 * chf + 16 * ct + fr) * GL_LD + 16 * rt + fq * 4) = make_uint2(pack2(Sacc[ct][0], Sacc[ct][1]), pack2(Sacc[ct][2], Sacc[ct][3]));
            }
        }
        LBAR();
    }
    if (!sq_.lat) {
        float* fs = p.out + OUT_GLA + ((((size_t)sq_.b * N_EVEN + ei) * 2 + dir) * 4 + h) * 64 * 128;
#pragma unroll
        for (int ct = 0; ct < 4; ++ct)
#pragma unroll
            for (int r = 0; r < 4; ++r) fs[(16 * rt + fq * 4 + r) * 128 + 64 * chf + 16 * ct + fr] = Sacc[ct][r];
    }
}

#ifndef RW_PREFETCH
#define RW_PREFETCH 1
#endif
constexpr int RW_LD = 72;
constexpr int RWKV_PREP_ITEMS = (T / 64) * 8;
struct RwPre { uint4 x[5], l[5], r[5]; };
__device__ __forceinline__ void rwkv_prefetch(const P& p, int w, int dir, int tid, RwPre& q) {
    const int cg = w >> 3, h = w & 7, hc0 = h * 64;
    const int i = tid >> 3, c8 = (tid & 7) * 8, t = cg * 64 + (dir ? 63 - i : i);
    bool hl, hr; tok_nbr(t, hl, hr);
    const bf16* proj = (const bf16*)(p.ws + WS_PROJ);
#pragma unroll
    for (int grp = 0; grp < 5; ++grp) {
        const int col = (grp == 0 ? FB_R + hc0 : grp == 1 ? FB_K + hc0 : grp == 2 ? FB_V + hc0 : grp == 3 ? FB_WD + dir * 64 : FB_AD + dir * 64) + c8;
        const bf16* pr = proj + (size_t)t * EW + E_FB + col;
        q.x[grp] = *(const uint4*)pr;
        q.l[grp] = hl ? *(const uint4*)(pr - EW) : make_uint4(0u, 0u, 0u, 0u);
        q.r[grp] = hr ? *(const uint4*)(pr + EW) : make_uint4(0u, 0u, 0u, 0u);
    }
}
__device__ __forceinline__ void rwkv_prep_phase(const P& p, int ei, int dir, int w_first, int w_stride, unsigned char* dsm) {
    float* sCS = (float*)dsm;
    float* sKK = sCS + 4096;
    float* sB = sKK + 4096;
    float* sKM = sB + 4096;
    float* sR = sKM + 4096;
    float* sAf = (float*)dsm;
    bf16* AakT = (bf16*)(dsm + 16384);
    bf16* Brb = AakT + 64 * RW_LD;
    bf16* Tm = Brb + 64 * RW_LD;
    bf16* PT = Tm + 64 * RW_LD;
    bf16* W1T = PT + 64 * RW_LD;
    bf16* At = (bf16*)(dsm + 81920);
    bf16* Bt = At + 64 * RW_LD;
    bf16* Kt = Bt + 64 * RW_LD;
    bf16* Rt = Kt + 64 * RW_LD;
    bf16* BhT = Rt + 64 * RW_LD;
    bf16* KhT = BhT + 64 * RW_LD;
    bf16* AtT = KhT + 64 * RW_LD;
    bf16* sTW = At;
    bf16* sAD = Bt;
    float* sSeg = (float*)(AtT + 64 * RW_LD);
    const int tid0 = opaque_tid();
    float* bonus = (float*)(p.ws + WS_BONUS);
    const float* mix = p.in[I_MIX] + (size_t)ei * 1792;
    int hcur = -1;
    s8v lrf[4][2];
    float lrb[4];
    RwPre pre;
#if RW_PREFETCH
    if (w_first < RWKV_PREP_ITEMS) rwkv_prefetch(p, w_first, dir, tid0, pre);
#endif
    for (int w = w_first; w < RWKV_PREP_ITEMS; w += w_stride) {
        const int tid = opaque_tid(), lane = tid & 63, wid = tid >> 6, fr = lane & 15, fq = lane >> 4;
        const int rt = wid & 3, cb = 2 * (wid >> 2), which = wid >> 2;
        const int cg = w >> 3, h = w & 7, hc0 = h * 64;
        const size_t tk = (size_t)cg * 8 + h;
        if (h != hcur) {
            hcur = h;
            LBAR();
            const float* w2 = p.in[I_W2] + (size_t)(ei * 2 + dir) * 64 * 512 + hc0; const float* a2 = p.in[I_A2] + (size_t)(ei * 2 + dir) * 64 * 512 + hc0;
            for (int e = tid; e < 4096; e += 512) { const int r = e >> 6, c = e & 63; Kt[c * RW_LD + r] = f2bf(w2[(size_t)r * 512 + c]); Rt[c * RW_LD + r] = f2bf(a2[(size_t)r * 512 + c]); }
            LBAR();
            const bf16* src = which ? Rt : Kt;
            const float* lb = (which ? p.in[I_A0] : p.in[I_W0]) + (size_t)(ei * 2 + dir) * 512 + hc0;
#pragma unroll
            for (int ct = 0; ct < 4; ++ct) {
                lrb[ct] = lb[16 * ct + fr];
#pragma unroll
                for (int ks = 0; ks < 2; ++ks) lrf[ct][ks] = *(const s8v*)(src + (16 * ct + fr) * RW_LD + ks * 32 + fq * 8);
            }
        }
        LBAR();
#if !RW_PREFETCH
        rwkv_prefetch(p, w, dir, tid, pre);
#endif
        {
            const int i = tid >> 3, c8 = (tid & 7) * 8, t = cg * 64 + (dir ? 63 - i : i);
#pragma unroll
            for (int grp = 0; grp < 5; ++grp) {
                const int col = (grp == 0 ? FB_R + hc0 : grp == 1 ? FB_K + hc0 : grp == 2 ? FB_V + hc0 : grp == 3 ? FB_WD + dir * 64 : FB_AD + dir * 64) + c8;
                const f8v x = unpack8v(pre.x[grp]);
                const f8v nb = unpack8v(pre.l[grp]) + unpack8v(pre.r[grp]);
                const f8v mv = *(const f8v*)(mix + col);
                f8v y = x + mv * (nb * 0.5f - x);
                if (grp == 0) *(f8v*)(sR + i * 64 + c8) = y;
                else if (grp == 1) *(f8v*)(sKM + i * 64 + c8) = y;
                else if (grp == 2) { if (dir == 0) *(uint4*)((bf16*)(p.ws + WS_VSH) + (size_t)t * 512 + hc0 + c8) = pack8v(y); }
                else {
                    if (grp == 3) {
#pragma unroll
                        for (int j = 0; j < 8; ++j) y[j] = ftanh(y[j]);
                    }
                    *(uint4*)((grp == 3 ? sTW : sAD) + i * RW_LD + c8) = pack8v(y);
                }
            }
        }
#if RW_PREFETCH
        if (w + w_stride < RWKV_PREP_ITEMS) rwkv_prefetch(p, w + w_stride, dir, tid, pre);
#endif
        LBAR();
        {
            const bf16* Am = which ? sAD : sTW;
            f4v acc[4];
#pragma unroll
            for (int ct = 0; ct < 4; ++ct) acc[ct] = (f4v){0.f, 0.f, 0.f, 0.f};
#pragma unroll
            for (int ks = 0; ks < 2; ++ks) {
                const s8v a = *(const s8v*)(Am + (16 * rt + fr) * RW_LD + ks * 32 + fq * 8);
#pragma unroll
                for (int ct = 0; ct < 4; ++ct) acc[ct] = mfma16(a, lrf[ct][ks], acc[ct]);
            }
#pragma unroll
            for (int ct = 0; ct < 4; ++ct) {
                const int c = 16 * ct + fr;
#pragma unroll
                for (int r = 0; r < 4; ++r) {
                    const int tok = 16 * rt + fq * 4 + r;
                    const float sg = sigmoidf_(lrb[ct] + acc[ct][r]);
                    if (which) sB[tok * 64 + c] = sg; else sCS[tok * 64 + c] = -0.6065306597126334f * sg;
                }
            }
        }
        LBAR();
        {
            const int i = tid >> 3, c8 = (tid & 7) * 8;
            const float* kkw = p.in[I_KK] + (size_t)ei * 512 + hc0; const float* kaw = p.in[I_KA] + (size_t)ei * 512 + hc0; const float* rkw = p.in[I_RK] + (size_t)ei * 512 + hc0;
            const f8v av = *(const f8v*)(sB + i * 64 + c8), kr = *(const f8v*)(sKM + i * 64 + c8), rv = *(const f8v*)(sR + i * 64 + c8);
            const f8v kav = *(const f8v*)(kaw + c8), kkv = *(const f8v*)(kkw + c8), rkv = *(const f8v*)(rkw + c8);
            const f8v km = kr * (1.0f + (av - 1.0f) * kav);
            f8v kk = kr * kkv;
            float ss = 0.f, bn = 0.f;
#pragma unroll
            for (int j = 0; j < 8; ++j) { ss += kk[j] * kk[j]; bn += rv[j] * km[j] * rkv[j]; }
            ss = red8(ss); bn = red8(bn);
            kk *= frsq(ss + EPS);
            *(f8v*)(sKK + i * 64 + c8) = kk; *(f8v*)(sB + i * 64 + c8) = kk * av; *(f8v*)(sKM + i * 64 + c8) = km;
            if ((tid & 7) == 0) { const int t = cg * 64 + (dir ? 63 - i : i); bonus[((size_t)t * 8 + h) * 2 + dir] = bn; }
        }
        {
            const int c = tid & 63, sg = tid >> 6;
            float run = 0.f;
#pragma unroll
            for (int j = 0; j < 8; ++j) { run += sCS[(8 * sg + j) * 64 + c]; sCS[(8 * sg + j) * 64 + c] = run; }
            sSeg[sg * 64 + c] = run;
        }
        LBAR();
        {
            const int c = tid & 63, sg = tid >> 6;
            float off = 0.f;
            for (int q = 0; q < sg; ++q) off += sSeg[q * 64 + c];
#pragma unroll
            for (int j = 0; j < 8; ++j) sCS[(8 * sg + j) * 64 + c] += off;
        }
        LBAR();
        {
            const int i = tid >> 3, c8 = (tid & 7) * 8;
            const f8v cs = *(const f8v*)(sCS + i * 64 + c8), cl = *(const f8v*)(sCS + 63 * 64 + c8);
            f8v cp = (f8v)(0.f);
            if (i > 0) cp = *(const f8v*)(sCS + (i - 1) * 64 + c8);
            const f8v kk = *(const f8v*)(sKK + i * 64 + c8), bb = *(const f8v*)(sB + i * 64 + c8), km = *(const f8v*)(sKM + i * 64 + c8), rv = *(const f8v*)(sR + i * 64 + c8);
            f8v at, bt, kt, rtv;
#pragma unroll
            for (int j = 0; j < 8; ++j) {
                const float g = fexp(cs[j]), gi = frcp(g), gp = fexp(cp[j]), gc = fexp(cl[j]) * gi;
                at[j] = -kk[j] * gp; bt[j] = bb[j] * gi; kt[j] = km[j] * gi; rtv[j] = rv[j] * g;
                BhT[(c8 + j) * RW_LD + i] = f2bf(bb[j] * gc); KhT[(c8 + j) * RW_LD + i] = f2bf(km[j] * gc); AtT[(c8 + j) * RW_LD + i] = f2bf(at[j]);
            }
            *(uint4*)(At + i * RW_LD + c8) = pack8v(at); *(uint4*)(Bt + i * RW_LD + c8) = pack8v(bt);
            *(uint4*)(Kt + i * RW_LD + c8) = pack8v(kt); *(uint4*)(Rt + i * RW_LD + c8) = pack8v(rtv);
            if (i == 63) {
                float* gco = (float*)(p.ws + WS_GC) + tk * 64 + c8;
#pragma unroll
                for (int j = 0; j < 8; ++j) gco[j] = fexp(cl[j]);
            }
        }
        LBAR();
        f4v brkT[2];
        {
            f4v aab[2], aak[2], brb[2];
#pragma unroll
            for (int c2 = 0; c2 < 2; ++c2) { aab[c2] = (f4v){0.f, 0.f, 0.f, 0.f}; aak[c2] = aab[c2]; brb[c2] = aab[c2]; brkT[c2] = aab[c2]; }
#pragma unroll
            for (int ks = 0; ks < 2; ++ks) {
                const int ko = ks * 32 + fq * 8, ra = (16 * rt + fr) * RW_LD + ko;
                const s8v fa = *(const s8v*)(At + ra), frr = *(const s8v*)(Rt + ra), fk = *(const s8v*)(Kt + ra);
#pragma unroll
                for (int c2 = 0; c2 < 2; ++c2) {
                    const int ro = (16 * (cb + c2) + fr) * RW_LD + ko;
                    const s8v gb = *(const s8v*)(Bt + ro), gk = *(const s8v*)(Kt + ro), gr = *(const s8v*)(Rt + ro);
                    aab[c2] = mfma16(fa, gb, aab[c2]); aak[c2] = mfma16(fa, gk, aak[c2]); brb[c2] = mfma16(frr, gb, brb[c2]);
                    brkT[c2] = mfma16(fk, gr, brkT[c2]);
                }
            }
#pragma unroll
            for (int c2 = 0; c2 < 2; ++c2) {
                const int col = 16 * (cb + c2) + fr, r0 = 16 * rt + fq * 4;
                f4v ak;
#pragma unroll
                for (int r = 0; r < 4; ++r) {
                    const int row = r0 + r;
                    sAf[row * 64 + col] = col < row ? -aab[c2][r] : 0.f;
                    ak[r] = col < row ? aak[c2][r] : 0.f;
                    Brb[row * RW_LD + col] = f2bf(col <= row ? brb[c2][r] : 0.f);
                    if (!(row <= col)) brkT[c2][r] = 0.f;
                }
                *(uint2*)(AakT + col * RW_LD + r0) = pack4(ak);
            }
        }
        LBAR();
        {
            const int c = 8 * wid + (lane >> 3), js = lane & 7;
            float xr[8];
#pragma unroll
            for (int m = 0; m < 8; ++m) xr[m] = 0.f;
#pragma unroll
            for (int i = 0; i < 64; ++i) {
                float part0 = 0.f, part1 = 0.f;
#pragma unroll
                for (int m = 0; m <= (i - 1) / 8 && i > 0; ++m) {
                    const float av = sAf[i * 64 + 8 * m + js];
                    if (m & 1) part1 += av * xr[m]; else part0 += av * xr[m];
                }
                const float tot = red8(part0 + part1);
                const float xi = (i == c ? 1.f : 0.f) - tot;
                xr[i >> 3] = ((i & 7) == js) ? xi : xr[i >> 3];
            }
#pragma unroll
            for (int m = 0; m < 8; ++m) Tm[(8 * m + js) * RW_LD + c] = f2bf(xr[m]);
        }
        LBAR();
        {
            f4v pp[2], ww[2];
#pragma unroll
            for (int c2 = 0; c2 < 2; ++c2) { pp[c2] = (f4v){0.f, 0.f, 0.f, 0.f}; ww[c2] = pp[c2]; }
#pragma unroll
            for (int ks = 0; ks < 2; ++ks) {
                const int ko = ks * 32 + fq * 8;
                const s8v ft = *(const s8v*)(Tm + (16 * rt + fr) * RW_LD + ko);
#pragma unroll
                for (int c2 = 0; c2 < 2; ++c2) {
                    const int ro = (16 * (cb + c2) + fr) * RW_LD + ko;
                    pp[c2] = mfma16(ft, *(const s8v*)(AtT + ro), pp[c2]); ww[c2] = mfma16(ft, *(const s8v*)(AakT + ro), ww[c2]);
                }
            }
#pragma unroll
            for (int c2 = 0; c2 < 2; ++c2) {
                const int col = 16 * (cb + c2) + fr;
                *(uint2*)(PT + col * RW_LD + 16 * rt + fq * 4) = pack4(pp[c2]);
                *(uint2*)(W1T + col * RW_LD + 16 * rt + fq * 4) = pack4(ww[c2]);
            }
        }
        LBAR();
        {
            bf16* m12 = (bf16*)(p.ws + WS_RM12) + tk * 8192; bf16* m34 = (bf16*)(p.ws + WS_RM34) + tk * 8192;
#pragma unroll
            for (int c2 = 0; c2 < 2; ++c2) {
                const int col = 16 * (cb + c2) + fr, r0 = 16 * rt + fq * 4;
                f4v m1 = unpack4(*(const uint2*)(Rt + col * RW_LD + r0));
                f4v m2 = brkT[c2], m3 = (f4v){0.f, 0.f, 0.f, 0.f};
                f4v m4 = unpack4(*(const uint2*)(KhT + col * RW_LD + r0));
#pragma unroll
                for (int ks = 0; ks < 2; ++ks) {
                    const int ko = ks * 32 + fq * 8;
                    const s8v fp = *(const s8v*)(PT + (16 * rt + fr) * RW_LD + ko), fw = *(const s8v*)(W1T + (16 * rt + fr) * RW_LD + ko);
                    const s8v gb = *(const s8v*)(Brb + col * RW_LD + ko), gh = *(const s8v*)(BhT + col * RW_LD + ko);
                    m1 = mfma16(fp, gb, m1);
                    m2 = mfma16(fw, gb, m2);
                    m3 = mfma16(fp, gh, m3);
                    m4 = mfma16(fw, gh, m4);
                }
                *(uint2*)(m12 + col * 64 + r0) = pack4(m1);
                *(uint2*)(m12 + 4096 + col * 64 + r0) = pack4(m2);
                *(uint2*)(m34 + col * 64 + r0) = pack4(m3);
                *(uint2*)(m34 + 4096 + col * 64 + r0) = pack4(m4);
            }
        }
    }
}
__device__ __forceinline__ void rwkv_apply_task(const P& p, int ei, int s, int h, int dir, unsigned char* dsm) {
    bf16* St = (bf16*)dsm;
    bf16* VT = St + 64 * RW_LD;
    bf16* M1 = VT + 64 * RW_LD;
    bf16* M2 = M1 + 64 * RW_LD;
    bf16* M3 = M2 + 64 * RW_LD;
    bf16* M4 = M3 + 64 * RW_LD;
    float* sGC = (float*)(M4 + 64 * RW_LD);
    const Seq sq_ = get_seq(s);
    const int tid = opaque_tid(), lane = tid & 63, wid = tid >> 6, fr = lane & 15, fq = lane >> 4;
    const int rt = wid & 3, cb = 2 * (wid >> 2), hc0 = h * 64;
    bf16* opart = (bf16*)(p.ws + WS_PART + (size_t)(2 + dir) * PART_SZ);
    f4v Sacc[2];
    LBAR();
#pragma unroll
    for (int c2 = 0; c2 < 2; ++c2) {
        const int v = 16 * (cb + c2) + fr, k0 = 16 * rt + fq * 4;
        if (sq_.lat) Sacc[c2] = *(const f4v*)(p.in[I_SRWKV] + ((((size_t)sq_.b * N_EVEN + ei) * 2 + dir) * 8 + h) * 4096 + v * 64 + k0);
        else Sacc[c2] = (f4v){0.f, 0.f, 0.f, 0.f};
        *(uint2*)(St + v * RW_LD + k0) = make_uint2(pack2(Sacc[c2][0], Sacc[c2][1]), pack2(Sacc[c2][2], Sacc[c2][3]));
    }
    const int nch = sq_.len >> 6;
    uint4 pm0, pm1, pm2, pm3, pvv; float pgc = 0.f;
    {
        const int cg0 = (sq_.start >> 6) + (dir ? nch - 1 : 0); const size_t tk0 = (size_t)cg0 * 8 + h;
        const int i = tid >> 3, c8 = (tid & 7) * 8;
        const bf16* m12 = (const bf16*)(p.ws + WS_RM12) + tk0 * 8192; const bf16* m34 = (const bf16*)(p.ws + WS_RM34) + tk0 * 8192;
        pm0 = *(const uint4*)(m12 + i * 64 + c8); pm1 = *(const uint4*)(m12 + 4096 + i * 64 + c8); pm2 = *(const uint4*)(m34 + i * 64 + c8); pm3 = *(const uint4*)(m34 + 4096 + i * 64 + c8);
        pvv = *(const uint4*)((const bf16*)(p.ws + WS_VSH) + (size_t)(cg0 * 64 + (dir ? 63 - lane : lane)) * 512 + hc0 + wid * 8);
        if (tid < 64) pgc = ((const float*)(p.ws + WS_GC))[tk0 * 64 + tid];
    }
    for (int cc = 0; cc < nch; ++cc) {
        const int cg = (sq_.start >> 6) + (dir ? nch - 1 - cc : cc);
        {
            const int i = tid >> 3, c8 = (tid & 7) * 8;
            *(uint4*)(M1 + i * RW_LD + c8) = pm0; *(uint4*)(M2 + i * RW_LD + c8) = pm1; *(uint4*)(M3 + i * RW_LD + c8) = pm2; *(uint4*)(M4 + i * RW_LD + c8) = pm3;
            const f8v vv = unpack8v(pvv);
#pragma unroll
            for (int j = 0; j < 8; ++j) VT[(wid * 8 + j) * RW_LD + lane] = f2bf(vv[j]);
            if (tid < 64) sGC[tid] = pgc;
            if (cc + 1 < nch) {
                const int cgn = (sq_.start >> 6) + (dir ? nch - 2 - cc : cc + 1); const size_t tkn = (size_t)cgn * 8 + h;
                const bf16* m12 = (const bf16*)(p.ws + WS_RM12) + tkn * 8192; const bf16* m34 = (const bf16*)(p.ws + WS_RM34) + tkn * 8192;
                pm0 = *(const uint4*)(m12 + i * 64 + c8); pm1 = *(const uint4*)(m12 + 4096 + i * 64 + c8); pm2 = *(const uint4*)(m34 + i * 64 + c8); pm3 = *(const uint4*)(m34 + 4096 + i * 64 + c8);
                pvv = *(const uint4*)((const bf16*)(p.ws + WS_VSH) + (size_t)(cgn * 64 + (dir ? 63 - lane : lane)) * 512 + hc0 + wid * 8);
                if (tid < 64) pgc = ((const float*)(p.ws + WS_GC))[tkn * 64 + tid];
            }
        }
        LBAR();
        {
            f4v yT[2], sn[2];
#pragma unroll
            for (int c2 = 0; c2 < 2; ++c2) { yT[c2] = (f4v){0.f, 0.f, 0.f, 0.f}; sn[c2] = yT[c2]; }
#pragma unroll
            for (int ks = 0; ks < 2; ++ks) {
                const int ko = ks * 32 + fq * 8;
                const s8v fs = *(const s8v*)(St + (16 * rt + fr) * RW_LD + ko), fv = *(const s8v*)(VT + (16 * rt + fr) * RW_LD + ko);
                const s8v f3 = *(const s8v*)(M3 + (16 * rt + fr) * RW_LD + ko), f4 = *(const s8v*)(M4 + (16 * rt + fr) * RW_LD + ko);
#pragma unroll
                for (int c2 = 0; c2 < 2; ++c2) {
                    const int ro = (16 * (cb + c2) + fr) * RW_LD + ko;
                    yT[c2] = mfma16(fs, *(const s8v*)(M1 + ro), yT[c2]); yT[c2] = mfma16(fv, *(const s8v*)(M2 + ro), yT[c2]);
                    sn[c2] = mfma16(f3, *(const s8v*)(St + ro), sn[c2]); sn[c2] = mfma16(f4, *(const s8v*)(VT + ro), sn[c2]);
                }
            }
            float gc[4];
#pragma unroll
            for (int r = 0; r < 4; ++r) gc[r] = sGC[16 * rt + fq * 4 + r];
#pragma unroll
            for (int c2 = 0; c2 < 2; ++c2) {
                const int tt = 16 * (cb + c2) + fr, t = cg * 64 + (dir ? 63 - tt : tt);
                *(uint2*)(opart + (size_t)t * 512 + hc0 + 16 * rt + fq * 4) = make_uint2(pack2(yT[c2][0], yT[c2][1]), pack2(yT[c2][2], yT[c2][3]));
#pragma unroll
                for (int r = 0; r < 4; ++r) Sacc[c2][r] = Sacc[c2][r] * gc[r] + sn[c2][r];
            }
        }
        LBAR();
#pragma unroll
        for (int c2 = 0; c2 < 2; ++c2) *(uint2*)(St + (16 * (cb + c2) + fr) * RW_LD + 16 * rt + fq * 4) = make_uint2(pack2(Sacc[c2][0], Sacc[c2][1]), pack2(Sacc[c2][2], Sacc[c2][3]));
    }
    if (!sq_.lat) {
#pragma unroll
        for (int c2 = 0; c2 < 2; ++c2)
            *(f4v*)(p.out + OUT_RWKV + ((((size_t)sq_.b * N_EVEN + ei) * 2 + dir) * 8 + h) * 4096 + (16 * (cb + c2) + fr) * 64 + 16 * rt + fq * 4) = Sacc[c2];
    }
}
constexpr int EV_AP_LAT = NB_LAT * 8, EV_AP_CTX = NB_CTX * 8, EV_GLA_LAT = NB_LAT * 4, EV_GLA_CTX = NB_CTX * 4;
constexpr int EVEN_SCAN_ITEMS = EV_AP_LAT + EV_GLA_LAT + EV_AP_CTX + EV_GLA_CTX;
__device__ __forceinline__ void ph_even_scan_item(const P& p, int w, int ei, int dir, unsigned char* dsm) {
    int kind, sbase, x;
    if (w < EV_AP_LAT) { kind = 0; sbase = NB_CTX; x = w; }
    else if (w < EV_AP_LAT + EV_GLA_LAT) { kind = 1; sbase = NB_CTX; x = w - EV_AP_LAT; }
    else if (w < EV_AP_LAT + EV_GLA_LAT + EV_AP_CTX) { kind = 0; sbase = 0; x = w - EV_AP_LAT - EV_GLA_LAT; }
    else { kind = 1; sbase = 0; x = w - EV_AP_LAT - EV_GLA_LAT - EV_AP_CTX; }
    if (kind == 0) rwkv_apply_task(p, ei, sbase + x / 8, x & 7, dir, dsm);
    else gla_scan_task(p, ei, sbase + x / 4, x & 3, dir, dsm);
}

__device__ __forceinline__ void ph_fin_even(const P& p, int bid, int ei) {
    const int lane = LT & 63, t = bid * 4 + (LT >> 6);
    if (t >= T) return;
    const bf16* pr = (const bf16*)(p.ws + WS_PROJ) + (size_t)t * EW;
    const bf16* oaf = (const bf16*)(p.ws + WS_PART) + (size_t)t * 512;
    const bf16* oab = (const bf16*)(p.ws + WS_PART + PART_SZ) + (size_t)t * 512;
    const bf16* obf = (const bf16*)(p.ws + WS_PART + 2 * PART_SZ) + (size_t)t * 512;
    const bf16* obb = (const bf16*)(p.ws + WS_PART + 3 * PART_SZ) + (size_t)t * 512;
    bf16* yc = (bf16*)(p.ws + WS_HM) + (size_t)t * D;
    const int idx = lane * 8;
    {
        float o[8], ss = 0.f;
#pragma unroll
        for (int j = 0; j < 8; ++j) { o[j] = bf2f(oaf[idx + j]) + bf2f(oab[idx + j]); ss += o[j] * o[j]; }
        ss += __shfl_xor(ss, 1); ss += __shfl_xor(ss, 2); ss += __shfl_xor(ss, 4); ss += __shfl_xor(ss, 8);
        const float r = frsq(ss * (1.0f / 128.f) + EPS);
        const float* gn = p.in[I_GLAN] + ei * 128 + (idx & 127);
#pragma unroll
        for (int j = 0; j < 8; ++j) yc[idx + j] = f2bf(o[j] * r * gn[j] * siluf_(bf2f(pr[E_ZA + idx + j])));
    }
    {
        float o[8], mu = 0.f;
#pragma unroll
        for (int j = 0; j < 8; ++j) { o[j] = bf2f(obf[idx + j]) + bf2f(obb[idx + j]); mu += o[j]; }
        mu += __shfl_xor(mu, 1); mu += __shfl_xor(mu, 2); mu += __shfl_xor(mu, 4);
        mu *= (1.0f / 64.f);
        float var = 0.f;
#pragma unroll
        for (int j = 0; j < 8; ++j) { o[j] -= mu; var += o[j] * o[j]; }
        var += __shfl_xor(var, 1); var += __shfl_xor(var, 2); var += __shfl_xor(var, 4);
        const float r = frsq(var * (1.0f / 64.f) + 64e-5f);
        const int h = idx >> 6;
        const float* bn = (const float*)(p.ws + WS_BONUS) + ((size_t)t * 8 + h) * 2;
        const float bsum = bn[0] + bn[1];
        bool hl, hr; tok_nbr(t, hl, hr);
        const float* mix = p.in[I_MIX] + (size_t)ei * 1792 + FB_V + idx;
        const float* lg = p.in[I_LNG] + ei * 512 + idx;
        const float* lb = p.in[I_LNB] + ei * 512 + idx;
#pragma unroll
        for (int j = 0; j < 8; ++j) {
            const bf16* pv = pr + E_FB + FB_V + idx + j;
            const float x = bf2f(pv[0]);
            const float nl = hl ? bf2f(pv[-EW]) : 0.f, nr = hr ? bf2f(pv[EW]) : 0.f;
            const float vsh = x + mix[j] * (0.5f * (nl + nr) - x);
            yc[512 + idx + j] = f2bf((o[j] * r * lg[j] + lb[j] + bsum * vsh) * siluf_(bf2f(pr[E_ZB + idx + j])));
        }
    }
}

constexpr int ODD_PREP_ITEMS = (T / 64) * 4;
constexpr int PQ_LD = 136;
__device__ __forceinline__ void ph_odd_prep(const P& p, int item, int oi, unsigned char* dsm) {
    bf16* sq = (bf16*)dsm;
    bf16* sk = sq + 64 * PQ_LD;
    float* sA = (float*)(dsm + 2 * 64 * PQ_LD * 2);
    float* sX = sA + 2 * 4096;
    float* slg = sX + 2 * 4096;
    float* sbt = slg + 128;
    float* sgc = sbt + 128;
    float* sbp = sgc + 128;
    const int tid = opaque_tid(), lane = tid & 63, wid = tid >> 6;
    const int cg = item >> 2, h = item & 3;
    const bf16* proj = (const bf16*)(p.ws + WS_PROJ);
    const float* cw = p.in[I_CONV] + (size_t)oi * 9 * 1536;
    LBAR();
    {
        const int i = tid >> 3, sub = tid & 7, t = cg * 64 + i;
        const bool lat = t >= T_CTX;
        int pos, len;
        if (!lat) { pos = t % L_CTX; len = L_CTX; } else { pos = (t - T_CTX) % L_LAT; len = L_LAT; }
        const int gr = pos >> 6, gcl = pos & 63, nrows = len >> 6;
        bf16* qo = (bf16*)(p.ws + WS_QKVN) + (size_t)t * 1536;
#pragma unroll
        for (int part = 0; part < 3; ++part) {
            const int ch = part * 512 + h * 128 + sub * 16;
            f8v a0 = (f8v)(0.f), a1 = (f8v)(0.f);
            for (int di = (lat ? -1 : 0); di <= (lat ? 1 : 0); ++di)
                for (int dj = -1; dj <= 1; ++dj) {
                    bool ok;
                    if (lat) ok = (gr + di >= 0) && (gr + di < nrows) && (gcl + dj >= 0) && (gcl + dj < 64);
                    else ok = (pos + dj >= 0) && (pos + dj < len);
                    if (!ok) continue;
                    const bf16* src = proj + (size_t)(t + di * 64 + dj) * OW + O_QKV + ch;
                    const float* w = cw + ((di + 1) * 3 + (dj + 1)) * 1536 + ch;
                    const f8v x0 = unpack8v(*(const uint4*)src), x1 = unpack8v(*(const uint4*)(src + 8));
                    const f8v w0 = *(const f8v*)w, w1 = *(const f8v*)(w + 8);
                    a0 += x0 * w0; a1 += x1 * w1;
                }
            float ss = 0.f;
#pragma unroll
            for (int j = 0; j < 8; ++j) { a0[j] = siluf_(a0[j]); a1[j] = siluf_(a1[j]); ss += a0[j] * a0[j] + a1[j] * a1[j]; }
            if (part < 2) {
                ss += __shfl_xor(ss, 1); ss += __shfl_xor(ss, 2); ss += __shfl_xor(ss, 4);
                float r = frsq(ss + EPS);
                if (part == 0) r *= 0.08838834764831845f;
                a0 *= r; a1 *= r;
            }
            const uint4 p0 = pack8v(a0), p1 = pack8v(a1);
            *(uint4*)(qo + ch) = p0; *(uint4*)(qo + ch + 8) = p1;
            if (part == 0) { *(uint4*)(sq + i * PQ_LD + sub * 16) = p0; *(uint4*)(sq + i * PQ_LD + sub * 16 + 8) = p1; }
            if (part == 1) { *(uint4*)(sk + i * PQ_LD + sub * 16) = p0; *(uint4*)(sk + i * PQ_LD + sub * 16 + 8) = p1; }
        }
        if (sub < 2) {
            const int dir = sub;
            float* g = (float*)(p.ws + WS_GATES) + (size_t)t * 16;
            const float x = bf2f(proj[(size_t)t * OW + O_G + dir * 4 + h]);
            const float lgv = -fexp(p.in[I_ALOG][oi * 8 + dir * 4 + h]) * softplusf_(x + p.in[I_DTB][oi * 8 + dir * 4 + h]);
            const float bv = sigmoidf_(bf2f(proj[(size_t)t * OW + O_BETA + dir * 4 + h]));
            g[dir * 4 + h] = lgv; g[8 + dir * 4 + h] = bv;
            slg[dir * 64 + i] = lgv; sbt[dir * 64 + i] = bv;
        }
    }
    LBAR();
    if (tid < 2) {
        const int dir = tid; float c = 0.f;
        for (int i = 0; i < 64; ++i) { const int n = dir ? 63 - i : i; c += slg[dir * 64 + n]; sgc[dir * 64 + i] = c; sbp[dir * 64 + i] = sbt[dir * 64 + n]; }
    }
    LBAR();
    {
        const int rt = wid & 3, fr = lane & 15, fq = lane >> 4;
        f4v acc[4];
#pragma unroll
        for (int ct = 0; ct < 4; ++ct) acc[ct] = (f4v){0.f, 0.f, 0.f, 0.f};
#pragma unroll
        for (int ks = 0; ks < 4; ++ks) {
            const s8v a = *(const s8v*)((wid < 4 ? sk : sq) + (16 * rt + fr) * PQ_LD + fq * 8 + ks * 32);
#pragma unroll
            for (int ct = 0; ct < 4; ++ct) {
                const s8v bb = *(const s8v*)(sk + (16 * ct + fr) * PQ_LD + fq * 8 + ks * 32);
                acc[ct] = (wid < 4) ? mfma16(a, bb, acc[ct]) : mfma16(bb, a, acc[ct]);
            }
        }
        const size_t task0 = ((size_t)cg * 4 + h) * 2;
        bf16* qk0 = (bf16*)(p.ws + WS_QKM) + task0 * 4096; bf16* qk1 = qk0 + 4096;
        if (wid < 4) {
#pragma unroll
            for (int ct = 0; ct < 4; ++ct)
#pragma unroll
                for (int r = 0; r < 4; ++r) {
                    const int a = 16 * rt + fq * 4 + r, b = 16 * ct + fr, i1 = 63 - a, j1 = 63 - b;
                    const float v = acc[ct][r];
                    if (b < a) sA[b * 64 + a] = sbp[a] * v * fexp(sgc[a] - sgc[b]);
                    if (b > a) sA[4096 + j1 * 64 + i1] = sbp[64 + i1] * v * fexp(sgc[64 + i1] - sgc[64 + j1]);
                }
        } else {
            const int a = 16 * rt + fr, i1 = 63 - a;
            const float ga0 = sgc[a], ga1 = sgc[64 + i1];
#pragma unroll
            for (int ct = 0; ct < 4; ++ct) {
                const int b0 = 16 * ct + fq * 4;
                f4v v0, v1;
#pragma unroll
                for (int r = 0; r < 4; ++r) {
                    const int b = b0 + r, j1 = 63 - b;
                    const float v = acc[ct][r];
                    v0[r] = b <= a ? v * fexp(ga0 - sgc[b]) : 0.f;
                    v1[3 - r] = b >= a ? v * fexp(ga1 - sgc[64 + j1]) : 0.f;
                }
                *(uint2*)(qk0 + a * 64 + b0) = pack4(v0);
                *(uint2*)(qk1 + i1 * 64 + 60 - b0) = pack4(v1);
            }
        }
    }
    LBAR();
    if (wid < 2) {
        const int dir = wid, c = lane;
        const float* AT = sA + dir * 4096;
        float* X = sX + dir * 4096;
#pragma unroll 1
        for (int B = 0; B < 4; ++B) {
            float acc[16];
#pragma unroll
            for (int r = 0; r < 16; ++r) acc[r] = (16 * B + r == c) ? 1.f : 0.f;
#pragma unroll 2
            for (int j = 0; j < 16 * B; ++j) {
                const float xj = X[j * 64 + c];
                const float* ar = AT + j * 64 + 16 * B;
#pragma unroll
                for (int r = 0; r < 16; ++r) acc[r] -= ar[r] * xj;
            }
#pragma unroll
            for (int r2 = 0; r2 < 16; ++r2) {
                const float* ar = AT + (16 * B + r2) * 64 + 16 * B;
#pragma unroll
                for (int r = r2 + 1; r < 16; ++r) acc[r] -= ar[r] * acc[r2];
            }
#pragma unroll
            for (int r = 0; r < 16; ++r) X[(16 * B + r) * 64 + c] = acc[r];
            WAVE_SYNC();
        }
    } else if (wid == 2) {
        float* gco = (float*)(p.ws + WS_GC) + ((size_t)cg * 4 + h) * 128;
        gco[lane] = sgc[lane]; gco[64 + lane] = sgc[64 + lane];
    }
    LBAR();
    {
        const int dir = tid >> 8, i = (tid >> 2) & 63, c16 = (tid & 3) * 16;
        const float* xs = sX + dir * 4096 + i * 64 + c16;
        bf16* ti = (bf16*)(p.ws + WS_TINV) + (((size_t)cg * 4 + h) * 2 + dir) * 4096 + i * 64 + c16;
        *(uint4*)ti = pack8v(*(const f8v*)xs); *(uint4*)(ti + 8) = pack8v(*(const f8v*)(xs + 8));
    }
}

constexpr int G_LDS = 136, G_LDT = 72;
__device__ __forceinline__ void gdn_scan_task(const P& p, int oi, int s, int h, int dir, unsigned char* dsm) {
    bf16* St = (bf16*)dsm;
    bf16* Kc = St + 128 * G_LDS;
    bf16* Qc = Kc + 64 * G_LDS;
    bf16* KeT = Qc + 64 * G_LDS;
    bf16* rT = KeT + 128 * G_LDT;
    bf16* dT = rT + 128 * G_LDT;
    bf16* Vc = dT;
    bf16* Ti = dT + 128 * G_LDT;
    bf16* Qk = Ti + 64 * G_LDT;
    float* sgc = (float*)(Qk + 64 * G_LDT);
    float* sbt = sgc + 64;
    const Seq sq_ = get_seq(s);
    const int tid = opaque_tid(), lane = tid & 63, wid = tid >> 6, fr = lane & 15, fq = lane >> 4;
    const int rt = wid & 3, chf = wid >> 2;
    const bf16* qkvn = (const bf16*)(p.ws + WS_QKVN);
    const float* gates = (const float*)(p.ws + WS_GATES);
    bf16* opart = (bf16*)(p.ws + WS_PART + (size_t)dir * PART_SZ);
    f4v Sacc[8];
    LBAR();
    if (sq_.lat) {
        const float* s0 = p.in[I_SGDN] + ((((size_t)sq_.b * N_ODD + oi) * 2 + dir) * 4 + h) * 128 * 128;
#pragma unroll
        for (int ct = 0; ct < 8; ++ct)
#pragma unroll
            for (int r = 0; r < 4; ++r) Sacc[ct][r] = s0[(16 * wid + fq * 4 + r) * 128 + 16 * ct + fr];
    } else {
#pragma unroll
        for (int ct = 0; ct < 8; ++ct) Sacc[ct] = (f4v){0.f, 0.f, 0.f, 0.f};
    }
#pragma unroll
    for (int ct = 0; ct < 8; ++ct) *(uint2*)(St + (16 * ct + fr) * G_LDS + 16 * wid + fq * 4) = make_uint2(pack2(Sacc[ct][0], Sacc[ct][1]), pack2(Sacc[ct][2], Sacc[ct][3]));
    const int nch = sq_.len >> 6;
    uint4 pq0, pq1, pk0, pk1, pw0, pw1, pti, pqk; float pgi, pgl, pbt = 0.f;
#define GDN_FETCH(CG) do { const size_t task_ = ((size_t)(CG) * 4 + h) * 2 + dir; const int t_ = (CG) * 64 + (dir ? 63 - lane : lane); \
        const bf16* src_ = qkvn + (size_t)t_ * 1536 + h * 128 + wid * 8; \
        pq0 = *(const uint4*)src_; pq1 = *(const uint4*)(src_ + 64); pk0 = *(const uint4*)(src_ + 512); pk1 = *(const uint4*)(src_ + 576); pw0 = *(const uint4*)(src_ + 1024); pw1 = *(const uint4*)(src_ + 1088); \
        { const int i2_ = tid >> 3, c8_ = (tid & 7) * 8; pti = *(const uint4*)((const bf16*)(p.ws + WS_TINV) + task_ * 4096 + i2_ * 64 + c8_); pqk = *(const uint4*)((const bf16*)(p.ws + WS_QKM) + task_ * 4096 + i2_ * 64 + c8_); } \
        const float* gcp_ = (const float*)(p.ws + WS_GC) + task_ * 64; pgi = gcp_[lane]; pgl = gcp_[63]; \
        if (tid < 64) pbt = gates[(size_t)((CG) * 64 + (dir ? 63 - tid : tid)) * 16 + 8 + dir * 4 + h]; } while (0)
    GDN_FETCH((sq_.start >> 6) + (dir ? nch - 1 : 0));
    for (int cc = 0; cc < nch; ++cc) {
        const int cl = dir ? nch - 1 - cc : cc;
        const int cg = (sq_.start >> 6) + cl;
        {
            const int i = lane;
            const float sc = fexp(pgl - pgi);
#pragma unroll
            for (int rep = 0; rep < 2; ++rep) {
                const int c8 = (wid + 8 * rep) * 8;
                const uint4 qv = rep ? pq1 : pq0, kv = rep ? pk1 : pk0, vv = rep ? pw1 : pw0;
                *(uint4*)(Qc + i * G_LDS + c8) = qv; *(uint4*)(Kc + i * G_LDS + c8) = kv; *(uint4*)(Vc + i * G_LDS + c8) = vv;
                const f8v kf = unpack8v(kv);
#pragma unroll
                for (int j = 0; j < 8; ++j) KeT[(c8 + j) * G_LDT + i] = f2bf(kf[j] * sc);
            }
            { const int i2 = tid >> 3, c8 = (tid & 7) * 8; *(uint4*)(Ti + i2 * G_LDT + c8) = pti; *(uint4*)(Qk + i2 * G_LDT + c8) = pqk; }
            if (tid < 64) { sgc[tid] = pgi; sbt[tid] = pbt; }
            if (cc + 1 < nch) { const int cln = dir ? nch - 2 - cc : cc + 1; GDN_FETCH((sq_.start >> 6) + cln); }
        }
        LBAR();
        f4v oacc[4];
        {
            f4v kS[4], qS[4];
#pragma unroll
            for (int ct = 0; ct < 4; ++ct) { kS[ct] = (f4v){0.f, 0.f, 0.f, 0.f}; qS[ct] = (f4v){0.f, 0.f, 0.f, 0.f}; }
#pragma unroll
            for (int ks = 0; ks < 4; ++ks) {
                const s8v ak = *(const s8v*)(Kc + (16 * rt + fr) * G_LDS + ks * 32 + fq * 8);
                const s8v aq = *(const s8v*)(Qc + (16 * rt + fr) * G_LDS + ks * 32 + fq * 8);
#pragma unroll
                for (int ct = 0; ct < 4; ++ct) {
                    const s8v bb = *(const s8v*)(St + (64 * chf + 16 * ct + fr) * G_LDS + ks * 32 + fq * 8);
                    kS[ct] = mfma16(ak, bb, kS[ct]);
                    qS[ct] = mfma16(bb, aq, qS[ct]);
                }
            }
            float eg[4], bt[4];
#pragma unroll
            for (int r = 0; r < 4; ++r) { const int i = 16 * rt + fq * 4 + r; eg[r] = fexp(sgc[i]); bt[r] = sbt[i]; }
            const float egc = fexp(sgc[16 * rt + fr]);
#pragma unroll
            for (int ct = 0; ct < 4; ++ct) {
                const int dv = 64 * chf + 16 * ct + fr;
                float rv[4];
#pragma unroll
                for (int r = 0; r < 4; ++r) { const int i = 16 * rt + fq * 4 + r; rv[r] = bt[r] * (bf2f(Vc[i * G_LDS + dv]) - eg[r] * kS[ct][r]); oacc[ct][r] = egc * qS[ct][r]; }
                *(uint2*)(rT + dv * G_LDT + 16 * rt + fq * 4) = make_uint2(pack2(rv[0], rv[1]), pack2(rv[2], rv[3]));
            }
        }
        LBAR();
        {
            f4v dl[4];
#pragma unroll
            for (int ct = 0; ct < 4; ++ct) dl[ct] = (f4v){0.f, 0.f, 0.f, 0.f};
#pragma unroll
            for (int ks = 0; ks < 2; ++ks) {
                const s8v a = *(const s8v*)(Ti + (16 * rt + fr) * G_LDT + ks * 32 + fq * 8);
#pragma unroll
                for (int ct = 0; ct < 4; ++ct) { const s8v bb = *(const s8v*)(rT + (64 * chf + 16 * ct + fr) * G_LDT + ks * 32 + fq * 8); dl[ct] = mfma16(a, bb, dl[ct]); }
            }
#pragma unroll
            for (int ct = 0; ct < 4; ++ct) { const int dv = 64 * chf + 16 * ct + fr;
                *(uint2*)(dT + dv * G_LDT + 16 * rt + fq * 4) = make_uint2(pack2(dl[ct][0], dl[ct][1]), pack2(dl[ct][2], dl[ct][3])); }
        }
        LBAR();
        {
#pragma unroll
            for (int ks = 0; ks < 2; ++ks) {
                const s8v a = *(const s8v*)(Qk + (16 * rt + fr) * G_LDT + ks * 32 + fq * 8);
#pragma unroll
                for (int ct = 0; ct < 4; ++ct) { const s8v bb = *(const s8v*)(dT + (64 * chf + 16 * ct + fr) * G_LDT + ks * 32 + fq * 8); oacc[ct] = mfma16(bb, a, oacc[ct]); }
            }
            {
                const int i = 16 * rt + fr, t = cg * 64 + (dir ? 63 - i : i);
#pragma unroll
                for (int ct = 0; ct < 4; ++ct) *(uint2*)(opart + (size_t)t * 512 + h * 128 + 64 * chf + 16 * ct + fq * 4) = pack4(oacc[ct]);
            }
            const float ge = fexp(sgc[63]);
#pragma unroll
            for (int ct = 0; ct < 8; ++ct) Sacc[ct] *= ge;
#pragma unroll
            for (int ks = 0; ks < 2; ++ks) {
                const s8v a = *(const s8v*)(KeT + (16 * wid + fr) * G_LDT + ks * 32 + fq * 8);
#pragma unroll
                for (int ct = 0; ct < 8; ++ct) { const s8v bb = *(const s8v*)(dT + (16 * ct + fr) * G_LDT + ks * 32 + fq * 8); Sacc[ct] = mfma16(a, bb, Sacc[ct]); }
            }
#pragma unroll
            for (int ct = 0; ct < 8; ++ct) *(uint2*)(St + (16 * ct + fr) * G_LDS + 16 * wid + fq * 4) = make_uint2(pack2(Sacc[ct][0], Sacc[ct][1]), pack2(Sacc[ct][2], Sacc[ct][3]));
        }
        LBAR();
    }
    if (!sq_.lat) {
        float* fs = p.out + OUT_GDN + ((((size_t)sq_.b * N_ODD + oi) * 2 + dir) * 4 + h) * 128 * 128;
#pragma unroll
        for (int ct = 0; ct < 8; ++ct)
#pragma unroll
            for (int r = 0; r < 4; ++r) fs[(16 * wid + fq * 4 + r) * 128 + 16 * ct + fr] = Sacc[ct][r];
    }
}
constexpr int S5_HLD = 136;
constexpr int S5_ITEMS = 2 * 32 * 2;
__device__ __forceinline__ void s5_task(const P& p, int oi, int dir, int g, int set, unsigned char* dsm) {
    float* sPr = (float*)dsm;
    float* sPi = sPr + 17 * 64;
    float* sBr = sPi + 17 * 64;
    float* sBi = sBr + 1024;
    float* sCr = sBi + 1024;
    float* sCi = sCr + 16 * 65;
    bf16* sK = (bf16*)(sCi + 16 * 65 + 16);
    bf16* HT = sK + 4096;
    bf16* sG = HT + 2 * 16 * S5_HLD;
    bf16* UT = sG + 256 * S5_HLD;
    const int tid = opaque_tid(), lane = tid & 63, wid = tid >> 6, fr = lane & 15, fq = lane >> 4;
    const int nseq = set ? NB_CTX : NB_LAT, sbase = set ? 0 : NB_CTX, len = set ? L_CTX : L_LAT;
    const bf16* proj = (const bf16*)(p.ws + WS_PROJ);
    bf16* ypart = (bf16*)(p.ws + WS_PART + (size_t)(2 + dir) * PART_SZ);
    const size_t pg = ((size_t)(oi * 2 + dir) * 32 + g);
    LBAR();
    if (tid < 64) {
        const float are = fminf(p.in[I_S5AR][pg * 64 + tid], -1e-4f), aim = p.in[I_S5AI][pg * 64 + tid];
        const float dt = expf(p.in[I_S5DT][pg]);
        const float mag = expf(are * dt), ar = mag * cosf(aim * dt), ai = mag * sinf(aim * dt);
        float pr = 1.f, pi = 0.f;
        for (int j = 0; j <= 16; ++j) { sPr[j * 64 + tid] = pr; sPi[j * 64 + tid] = pi; const float nr = pr * ar - pi * ai, ni = pr * ai + pi * ar; pr = nr; pi = ni; }
    }
    {
        const int st = tid >> 3, c0 = (tid & 7) * 2;
        const float are = fminf(p.in[I_S5AR][pg * 64 + st], -1e-4f), aim = p.in[I_S5AI][pg * 64 + st];
        const float dt = expf(p.in[I_S5DT][pg]);
        const float mag = expf(are * dt), ar = mag * cosf(aim * dt), ai = mag * sinf(aim * dt);
        const float den = are * are + aim * aim;
        const float fre = ((ar - 1.0f) * are + ai * aim) / den, fim = (ai * are - (ar - 1.0f) * aim) / den;
#pragma unroll
        for (int c = 0; c < 2; ++c) {
            const float br = p.in[I_S5BR][(pg * 64 + st) * 16 + c0 + c], bi = p.in[I_S5BI][(pg * 64 + st) * 16 + c0 + c];
            sBr[st * 16 + c0 + c] = fre * br - fim * bi; sBi[st * 16 + c0 + c] = fre * bi + fim * br;
        }
        for (int e = tid; e < 1024; e += 512) { sCr[(e >> 6) * 65 + (e & 63)] = p.in[I_S5CR][pg * 1024 + e]; sCi[(e >> 6) * 65 + (e & 63)] = p.in[I_S5CI][pg * 1024 + e]; }
    }
    LBAR();
    {
        const int lag = tid >> 5, co = (tid >> 1) & 15, c8 = (tid & 1) * 8;
        f8v acc = (f8v)(0.f);
        for (int q = 0; q < 64; ++q) {
            const float cr = sCr[co * 65 + q], ci = sCi[co * 65 + q], pr = sPr[lag * 64 + q], pi = sPi[lag * 64 + q];
            const float mr = cr * pr - ci * pi, mi = cr * pi + ci * pr;
            const f8v br = *(const f8v*)(sBr + q * 16 + c8), bi = *(const f8v*)(sBi + q * 16 + c8);
            acc += mr * br - mi * bi;
        }
        *(uint4*)(sK + (lag * 16 + co) * 16 + c8) = pack8v(acc);
    }
    {
        const int row = tid >> 1, tt = row >> 4, co = row & 15, half = tid & 1;
        for (int q0 = 0; q0 < 64; q0 += 8) {
            f8v v;
#pragma unroll
            for (int j = 0; j < 8; ++j) { const int q = q0 + j; const float cr = sCr[co * 65 + q], ci = sCi[co * 65 + q], pr = sPr[(tt + 1) * 64 + q], pi = sPi[(tt + 1) * 64 + q]; v[j] = half ? -(cr * pi + ci * pr) : cr * pr - ci * pi; }
            *(uint4*)(sG + row * S5_HLD + half * 64 + q0) = pack8v(v);
        }
    }
    LBAR();
    const int sp = fq >> 1, cih = (fq & 1) * 8;
    const int nsteps = len >> 4;
    constexpr int S5_ULD = 264;
    const int un = (tid & 255) >> 4, us = tid & 15;
    const bf16* ubase = proj + (size_t)get_seq(sbase + (un < nseq ? un : 0)).start * OW + O_U + g * 16;
#define S5_UADDR(K) (ubase + (size_t)(dir ? len - 1 - (16 * (K) + us) : 16 * (K) + us) * OW)
#define S5_UPUT(K, QA, QB) do { bf16* d_ = UT + ((K) & 1) * 16 * S5_ULD + un * S5_ULD + us * 16; *(uint4*)d_ = QA; *(uint4*)(d_ + 8) = QB; } while (0)
#define S5_ULOAD(K) const bf16* up_ = UT + ((K) & 1) * 16 * S5_ULD + fr * S5_ULD + 8 * fq; \
        const s8v u0 = *(const s8v*)up_, u1 = *(const s8v*)(up_ + 32), u2 = *(const s8v*)(up_ + 64), u3 = *(const s8v*)(up_ + 96), \
                  u4 = *(const s8v*)(up_ + 128), u5 = *(const s8v*)(up_ + 160), u6 = *(const s8v*)(up_ + 192), u7 = *(const s8v*)(up_ + 224)
    if (wid < 4) {
        s8v wre[8], wim[8];
        {
            const int pp = 16 * wid + fr;
#pragma unroll
            for (int m = 0; m < 8; ++m) {
                const int sidx = 15 - (2 * m + sp);
                const float pr = sPr[sidx * 64 + pp], pi = sPi[sidx * 64 + pp];
#pragma unroll
                for (int j = 0; j < 8; ++j) {
                    const float br = sBr[pp * 16 + cih + j], bi = sBi[pp * 16 + cih + j];
                    wre[m][j] = (short)f2bf(pr * br - pi * bi); wim[m][j] = (short)f2bf(pr * bi + pi * br);
                }
            }
        }
        float a16r[4], a16i[4], hr[4], hi[4];
#pragma unroll
        for (int r = 0; r < 4; ++r) {
            const int pp = 16 * wid + fq * 4 + r;
            a16r[r] = sPr[16 * 64 + pp]; a16i[r] = sPi[16 * 64 + pp];
            hr[r] = 0.f; hi[r] = 0.f;
            if (set == 0 && fr < nseq) { const size_t o = (((size_t)fr * N_ODD + oi) * 2 + dir) * 32 * 64 + g * 64 + pp; hr[r] = p.in[I_SS5R][o]; hi[r] = p.in[I_SS5I][o]; }
        }
        *(uint2*)(HT + fr * S5_HLD + 16 * wid + fq * 4) = make_uint2(pack2(hr[0], hr[1]), pack2(hr[2], hr[3]));
        *(uint2*)(HT + fr * S5_HLD + 64 + 16 * wid + fq * 4) = make_uint2(pack2(hi[0], hi[1]), pack2(hi[2], hi[3]));
        uint4 qa0, qb0, qa1, qb1, qa2, qb2, qa3, qb3;
        { const bf16* a_ = S5_UADDR(0); qa0 = *(const uint4*)a_; qb0 = *(const uint4*)(a_ + 8); S5_UPUT(0, qa0, qb0); }
#define S5_QLOAD(K, QA, QB) do { if ((K) < nsteps) { const bf16* a_ = S5_UADDR(K); QA = *(const uint4*)a_; QB = *(const uint4*)(a_ + 8); } } while (0)
        S5_QLOAD(1, qa1, qb1); S5_QLOAD(2, qa2, qb2); S5_QLOAD(3, qa3, qb3); S5_QLOAD(4, qa0, qb0);
        LBAR();
#define S5_STATE_STEP(K, QA, QB) do { \
            const int k = (K); \
            S5_ULOAD(k); \
            if (k + 1 < nsteps) { S5_UPUT(k + 1, QA, QB); S5_QLOAD(k + 5, QA, QB); } \
            f4v zr = (f4v){0.f, 0.f, 0.f, 0.f}, zi = zr; \
            zr = mfma16(wre[0], u0, zr); zi = mfma16(wim[0], u0, zi); zr = mfma16(wre[1], u1, zr); zi = mfma16(wim[1], u1, zi); \
            zr = mfma16(wre[2], u2, zr); zi = mfma16(wim[2], u2, zi); zr = mfma16(wre[3], u3, zr); zi = mfma16(wim[3], u3, zi); \
            zr = mfma16(wre[4], u4, zr); zi = mfma16(wim[4], u4, zi); zr = mfma16(wre[5], u5, zr); zi = mfma16(wim[5], u5, zi); \
            zr = mfma16(wre[6], u6, zr); zi = mfma16(wim[6], u6, zi); zr = mfma16(wre[7], u7, zr); zi = mfma16(wim[7], u7, zi); \
            _Pragma("unroll") for (int r = 0; r < 4; ++r) { const float nr = a16r[r] * hr[r] - a16i[r] * hi[r] + zr[r], ni = a16r[r] * hi[r] + a16i[r] * hr[r] + zi[r]; hr[r] = nr; hi[r] = ni; } \
            bf16* hb = HT + ((k + 1) & 1) * 16 * S5_HLD; \
            *(uint2*)(hb + fr * S5_HLD + 16 * wid + fq * 4) = make_uint2(pack2(hr[0], hr[1]), pack2(hr[2], hr[3])); \
            *(uint2*)(hb + fr * S5_HLD + 64 + 16 * wid + fq * 4) = make_uint2(pack2(hi[0], hi[1]), pack2(hi[2], hi[3])); \
            LBAR(); } while (0)
        for (int k4 = 0; k4 < nsteps; k4 += 4) {
            S5_STATE_STEP(k4, qa1, qb1); S5_STATE_STEP(k4 + 1, qa2, qb2); S5_STATE_STEP(k4 + 2, qa3, qb3); S5_STATE_STEP(k4 + 3, qa0, qb0);
        }
        if (set == 1 && fr < nseq) {
#pragma unroll
            for (int r = 0; r < 4; ++r) { const size_t o = (((size_t)fr * N_ODD + oi) * 2 + dir) * 32 * 64 + g * 64 + 16 * wid + fq * 4 + r; p.out[OUT_S5R + o] = hr[r]; p.out[OUT_S5I + o] = hi[r]; }
        }
    } else {
        const int t0 = 4 * (RFL(wid) - 4);
        s8v klr[18];
#pragma unroll
        for (int e = 0; e < 18; ++e) { const int lg = t0 + 3 - e - sp; klr[e] = (lg >= 0) ? *(const s8v*)(sK + (lg * 16 + fr) * 16 + cih) : (s8v){0, 0, 0, 0, 0, 0, 0, 0}; }
        LBAR();
        for (int k = 0; k < nsteps; ++k) {
            S5_ULOAD(k);
            const bf16* hb = HT + (k & 1) * 16 * S5_HLD + fr * S5_HLD + 8 * fq;
            const s8v h0 = *(const s8v*)hb, h1 = *(const s8v*)(hb + 32), h2 = *(const s8v*)(hb + 64), h3 = *(const s8v*)(hb + 96);
#pragma unroll
            for (int tt = 0; tt < 4; ++tt) {
                const int t = t0 + tt;
                f4v y = (f4v){0.f, 0.f, 0.f, 0.f};
                { const bf16* gp = sG + ((t0 + tt) * 16 + fr) * S5_HLD + 8 * fq;
                  y = mfma16(*(const s8v*)gp, h0, y); y = mfma16(*(const s8v*)(gp + 32), h1, y); y = mfma16(*(const s8v*)(gp + 64), h2, y); y = mfma16(*(const s8v*)(gp + 96), h3, y); }
                if (0 <= t) y = mfma16(klr[3 - tt], u0, y);
                if (2 <= t) y = mfma16(klr[5 - tt], u1, y);
                if (4 <= t) y = mfma16(klr[7 - tt], u2, y);
                if (6 <= t) y = mfma16(klr[9 - tt], u3, y);
                if (8 <= t) y = mfma16(klr[11 - tt], u4, y);
                if (10 <= t) y = mfma16(klr[13 - tt], u5, y);
                if (12 <= t) y = mfma16(klr[15 - tt], u6, y);
                if (14 <= t) y = mfma16(klr[17 - tt], u7, y);
                if (fr < nseq) {
                    const int pos = 16 * k + t, tok = get_seq(sbase + fr).start + (dir ? len - 1 - pos : pos);
                    *(uint2*)(ypart + (size_t)tok * 512 + g * 16 + fq * 4) = pack4(y);
                }
            }
            LBAR();
        }
    }
}
constexpr int ODD_GDN_ITEMS = NSEQ * 8;
constexpr int ODD_SCAN_ITEMS = ODD_GDN_ITEMS + S5_ITEMS;
__device__ __forceinline__ void ph_odd_scan_item(const P& p, int w, int oi, float* smem_full) {
    unsigned char* dsm = (unsigned char*)smem_full;
    const int nlg = NB_LAT * 8, ncg = NB_CTX * 8;
    if (w < 64) { __syncthreads(); s5_task(p, oi, w >> 5, w & 31, 0, dsm); return; }
    w -= 64;
    if (w < nlg + ncg) {
        const int sbase = w < nlg ? NB_CTX : 0, x = w < nlg ? w : w - nlg;
        gdn_scan_task(p, oi, sbase + x / 8, (x % 8) >> 1, x & 1, dsm);
        return;
    }
    w -= nlg + ncg;
    __syncthreads(); s5_task(p, oi, w >> 5, w & 31, 1, dsm);
}
__device__ __forceinline__ void ph_fin_odd_a(const P& p, int bid, int oi) {
    const int lane = LT & 63, t = bid * 4 + (LT >> 6);
    if (t >= T) return;
    const bf16* pr = (const bf16*)(p.ws + WS_PROJ) + (size_t)t * OW;
    const bf16* of = (const bf16*)(p.ws + WS_PART) + (size_t)t * 512;
    const bf16* ob = (const bf16*)(p.ws + WS_PART + PART_SZ) + (size_t)t * 512;
    const bf16* yf = (const bf16*)(p.ws + WS_PART + 2 * PART_SZ) + (size_t)t * 512;
    const bf16* yb = (const bf16*)(p.ws + WS_PART + 3 * PART_SZ) + (size_t)t * 512;
    bf16* ysw = (bf16*)(p.ws + WS_PART + 2 * PART_SZ) + (size_t)t * 512;
    bf16* yc = (bf16*)(p.ws + WS_HM) + (size_t)t * D;
    const int idx = lane * 8;
    float o[8], ss = 0.f;
#pragma unroll
    for (int j = 0; j < 8; ++j) { o[j] = bf2f(of[idx + j]) + bf2f(ob[idx + j]); ss += o[j] * o[j]; }
    ss += __shfl_xor(ss, 1); ss += __shfl_xor(ss, 2); ss += __shfl_xor(ss, 4); ss += __shfl_xor(ss, 8);
    const float r = frsq(ss * (1.0f / 128.f) + EPS);
    const float* gn = p.in[I_GDNN] + oi * 128 + (idx & 127);
    const float* dsk = p.in[I_S5D] + oi * 512 + idx;
#pragma unroll
    for (int j = 0; j < 8; ++j) {
        yc[idx + j] = f2bf(o[j] * r * gn[j] * siluf_(bf2f(pr[O_ZC + idx + j])));
        const float y = bf2f(yf[idx + j]) + bf2f(yb[idx + j]) + dsk[j] * bf2f(pr[O_U + idx + j]);
        ysw[idx + j] = f2bf(gelu_tanh(y));
    }
}
__device__ __forceinline__ void ph_fin_odd_b(const P& p, int bid, int oi) {
    const size_t e = ((size_t)bid * 256 + LT) * 4;
    if (e >= (size_t)T * 512) return;
    const int t = (int)(e >> 9), idx = (int)(e & 511);
    const bf16* pr = (const bf16*)(p.ws + WS_PROJ) + (size_t)t * OW;
    const bf16* gl = (const bf16*)(p.ws + WS_PART + 2 * PART_SZ) + (size_t)t * 512;
    bf16* yc = (bf16*)(p.ws + WS_HM) + (size_t)t * D + 512;
#pragma unroll
    for (int j = 0; j < 4; ++j) {
        const float ys = bf2f(yc[idx + j]);
        yc[idx + j] = f2bf(ys * sigmoidf_(bf2f(gl[idx + j]) + p.in[I_GLUB][oi * 512 + idx + j]) * siluf_(bf2f(pr[O_ZD + idx + j])));
    }
}

enum { PK_PREP0, PK_HMOD0, PK_GEMM_IN, PK_EVEN_SCAN, PK_FIN_EVEN, PK_ODD_PREP, PK_ODD_SCAN, PK_FIN_ODD_A, PK_GEMM_GLU, PK_FIN_ODD_B, PK_GEMM_OUT, PK_POST, PK_RWKV_PREP0, PK_RWKV_PREP1, PK_EVEN_SCAN1 };
constexpr int NPH = 2 + (DEPTH / 2) * 15;
constexpr int TOKB = (T + 3) / 4;
static_assert(DEPTH % 2 == 0, "even depth expected");
__host__ __device__ inline void phase_desc(int ph, int& kind, int& layer) {
    if (ph == 0) { kind = PK_PREP0; layer = 0; return; }
    if (ph == 1) { kind = PK_HMOD0; layer = 0; return; }
    ph -= 2;
    const int pair = ph / 15, r = ph % 15;
    if (r < 8) { layer = 2 * pair; kind = r == 0 ? PK_GEMM_IN : r == 1 ? PK_RWKV_PREP0 : r == 2 ? PK_EVEN_SCAN : r == 3 ? PK_RWKV_PREP1 : r == 4 ? PK_EVEN_SCAN1 : r == 5 ? PK_FIN_EVEN : r == 6 ? PK_GEMM_OUT : PK_POST; }
    else { const int q = r - 8; layer = 2 * pair + 1; kind = q == 0 ? PK_GEMM_IN : q == 1 ? PK_ODD_PREP : q == 2 ? PK_ODD_SCAN : q == 3 ? PK_FIN_ODD_A : q == 4 ? PK_GEMM_GLU : q == 5 ? PK_GEMM_OUT : PK_POST; }
}
__host__ __device__ inline bool phase_is_gemm(int kind) { return kind == PK_GEMM_IN || kind == PK_GEMM_GLU || kind == PK_GEMM_OUT; }
__host__ __device__ inline int phase_nblk(int kind, int layer) {
    switch (kind) {
        case PK_PREP0: return DEPTH * 48 + WT_TILES;
        case PK_FIN_ODD_B: return (T * 512 / 4 + 255) / 256;
        default: return TOKB;
    }
}
__device__ __forceinline__ void do_phase(const P& p, int kind, int layer, int vb, float* smem) {
    const int i = layer >> 1;
    switch (kind) {
        case PK_PREP0: if (vb < DEPTH * 48) ph_mod(p, vb, smem); else ph_wt(p, vb - DEPTH * 48, smem); break;
        case PK_HMOD0: ph_hmod0(p, vb); break;
        case PK_FIN_EVEN: ph_fin_even(p, vb, i); break;
        case PK_FIN_ODD_A: ph_fin_odd_a(p, vb, i); break;
        case PK_FIN_ODD_B: ph_fin_odd_b(p, vb, i); break;
        case PK_POST: ph_post(p, vb, layer); break;
    }
}
__device__ __forceinline__ void do_gemm(const P& p, int kind, int layer, int G, int c, unsigned char* dsm) {
    const int i = layer >> 1;
    const bf16* hm = (const bf16*)(p.ws + WS_HM);
    pg8::StaticOrder S;
    LDS_AS unsigned char* lds = (LDS_AS unsigned char*)dsm;
    if (kind == PK_GEMM_IN) {
        if ((layer & 1) == 0) { pg8::Gemm g{hm, (const bf16*)(p.ws + WS_WTE) + (size_t)i * EWP * D, T, EWP, D, D}; S.init(T, EWP, G, c); pg8::EpiBf16 E{(bf16*)(p.ws + WS_PROJ), EW, EW}; pg8::gemm_phase(lds, g, S, E); }
        else { pg8::Gemm g{hm, (const bf16*)(p.ws + WS_WTO) + (size_t)i * OWP * D, T, OWP, D, D}; S.init(T, OWP, G, c); pg8::EpiBf16 E{(bf16*)(p.ws + WS_PROJ), OW, OW}; pg8::gemm_phase(lds, g, S, E); }
    } else if (kind == PK_GEMM_GLU) {
        const bf16* ysb = (const bf16*)(p.ws + WS_PART + 2 * PART_SZ);
        pg8::Gemm g{ysb, (const bf16*)(p.ws + WS_WTGLU) + (size_t)i * 512 * 512, T, 512, 512, 512}; S.init(T, 512, G, c);
        pg8::EpiGlu E{(bf16*)(p.ws + WS_HM) + 512, ysb, (const bf16*)(p.ws + WS_PROJ) + O_ZD, p.in[I_GLUB] + i * 512}; pg8::gemm_phase(lds, g, S, E);
    } else {
        pg8::Gemm g{hm, (const bf16*)(p.ws + WS_WTOUT) + (size_t)layer * D * D, T, D, D, D}; S.init(T, D, G, c); pg8::EpiF32 E{(float*)(p.ws + WS_PROJ), D}; pg8::gemm_phase(lds, g, S, E);
    }
}
constexpr int LDS_BYTES = 163840;
#ifndef REP_SCAN
#define REP_SCAN 1
#endif
#ifndef REP_GEMM
#define REP_GEMM 1
#endif

#ifdef CPU_EMU
__global__ void k_phase(P p, int kind, int layer, int nb) {
    __shared__ __attribute__((aligned(16))) unsigned char dsm[LDS_BYTES];
    if (phase_is_gemm(kind)) { do_gemm(p, kind, layer, gridDim.x, blockIdx.x, dsm); return; }
    if (kind == PK_ODD_SCAN) { ph_odd_scan_item(p, blockIdx.x, layer >> 1, (float*)dsm); return; }
    if (kind == PK_ODD_PREP) { ph_odd_prep(p, blockIdx.x, layer >> 1, dsm); return; }
    if (kind == PK_EVEN_SCAN || kind == PK_EVEN_SCAN1) { ph_even_scan_item(p, blockIdx.x, layer >> 1, kind == PK_EVEN_SCAN1, dsm); return; }
    if (kind == PK_RWKV_PREP0 || kind == PK_RWKV_PREP1) { rwkv_prep_phase(p, layer >> 1, kind == PK_RWKV_PREP1, blockIdx.x, gridDim.x, dsm); return; }
    const int half = threadIdx.x >> 8, vb = 2 * blockIdx.x + half;
    if (vb < nb) do_phase(p, kind, layer, vb, (float*)dsm + half * 16384);
}
void emu_hook(const char* stage, int layer, const P& p);
extern "C" void kernel_launch(void* const* d_in, const int* in_sizes, int n_in, void* d_out, int out_size, void* d_ws, size_t ws_size, hipStream_t stream) {
    P p{};
    for (int i = 0; i < 44; ++i) p.in[i] = (const float*)d_in[i];
    p.out = (float*)d_out; p.ws = (char*)d_ws;
    static const char* names[] = {"prep0", "hmod", "proj", "even_scan0", "ycat", "odd_prep", "odd_scan", "fin_odd_a", "ycat", "ycat", "outproj", "post", "rwkv_prep0", "rwkv_prep1", "even_scan"};
    for (int ph = 0; ph < NPH; ++ph) {
        int kind, layer; phase_desc(ph, kind, layer);
        const int nb = phase_nblk(kind, layer);
        EMU_LAUNCH(k_phase, phase_is_gemm(kind) ? 3 : kind == PK_ODD_SCAN ? ODD_SCAN_ITEMS : (kind == PK_EVEN_SCAN || kind == PK_EVEN_SCAN1) ? EVEN_SCAN_ITEMS : (kind == PK_RWKV_PREP0 || kind == PK_RWKV_PREP1) ? RWKV_PREP_ITEMS : kind == PK_ODD_PREP ? ODD_PREP_ITEMS : (nb + 1) / 2, 512, p, kind, layer, nb);
        emu_hook(names[kind], layer, p);
    }
}
#else

#define XB_TMO      128
#define XB_XCNT(j)  (256  + 64 * (j))
#define XB_XSUB(j)  (1280 + 64 * (j))
#define XB_XGEN(j)  (2304 + 64 * (j))
#define XB_TOP      3328
#define XB_TOPGEN   3392
#define XCD_BAR_WORDS 3456
#define XB_SPIN_CAP (1u << 18)
__device__ __forceinline__ unsigned xb_ld(unsigned* p)              { return __hip_atomic_load(p, __ATOMIC_RELAXED, __HIP_MEMORY_SCOPE_AGENT); }
__device__ __forceinline__ unsigned xb_add(unsigned* p, unsigned v) { return __hip_atomic_fetch_add(p, v, __ATOMIC_RELAXED, __HIP_MEMORY_SCOPE_AGENT); }
__device__ __forceinline__ unsigned xb_xcc_id() { return (unsigned)__builtin_amdgcn_s_getreg((3 << 11) | 20) & 0xFu; }
#define XB_SPIN(cond, bar) do { unsigned _sp = 0; while (cond) { __builtin_amdgcn_s_sleep(1); \
    if ((++_sp & 255u) == 0u) { if (xb_ld(&(bar)[XB_TMO])) break; if (_sp > XB_SPIN_CAP) { atomicAdd(&(bar)[XB_TMO], 1u); break; } } } } while (0)
struct XcdBarrier { unsigned* bar; unsigned x; volatile LDS_AS unsigned* st; };
__device__ __forceinline__ XcdBarrier xcd_barrier_post(unsigned* bar, volatile LDS_AS unsigned* st) {
    XcdBarrier b; b.bar = bar; b.x = xb_xcc_id(); b.st = st;
    if (threadIdx.x == 0) (void)xb_add(&bar[XB_XCNT(b.x)], 1u);
    return b;
}
__device__ __forceinline__ void xcd_barrier_complete(unsigned* bar, unsigned x, unsigned& nloc, unsigned& nx) {
    const unsigned G = gridDim.x * gridDim.y * gridDim.z;
    unsigned sum, cnt, mine, sp = 0u;
    for (;;) {
        sum = 0u; cnt = 0u; mine = 0u;
#pragma unroll
        for (unsigned j = 0; j < 16; ++j) { const unsigned c = xb_ld(&bar[XB_XCNT(j)]); sum += c; cnt += (c > 0u) ? 1u : 0u; mine = (j == x) ? c : mine; }
        if (sum == G) break;
        __builtin_amdgcn_s_sleep(1);
        if ((++sp & 255u) == 0u) { if (xb_ld(&bar[XB_TMO])) break; if (sp > XB_SPIN_CAP) { atomicAdd(&bar[XB_TMO], 1u); break; } }
    }
    nloc = mine > 0u ? mine : 1u; nx = cnt > 0u ? cnt : 1u;
}
__device__ __forceinline__ void xcd_barrier(const XcdBarrier& b) {
    asm volatile("s_waitcnt vmcnt(0)" ::: "memory");
    __syncthreads();
    if (threadIdx.x == 0) {
        unsigned* bar = b.bar;
        __builtin_amdgcn_s_waitcnt(0);
        unsigned nloc = b.st[0], nx = b.st[1];
        if (nloc == 0u) { xcd_barrier_complete(bar, b.x, nloc, nx); b.st[0] = nloc; b.st[1] = nx; }
        const unsigned old = xb_add(&bar[XB_XSUB(b.x)], 1u);
        const unsigned gen = old / nloc;
        if (old + 1u == (gen + 1u) * nloc) {
            __builtin_amdgcn_fence(__ATOMIC_RELEASE, "agent");
            asm volatile("s_waitcnt vmcnt(0)" ::: "memory");
            const unsigned og = xb_add(&bar[XB_TOP], 1u);
            const unsigned tg = og / nx;
            if (og + 1u == (tg + 1u) * nx) xb_add(&bar[XB_TOPGEN], 1u);
            else XB_SPIN(xb_ld(&bar[XB_TOPGEN]) == tg, bar);
            __builtin_amdgcn_fence(__ATOMIC_ACQUIRE, "agent");
            xb_add(&bar[XB_XGEN(b.x)], 1u);
            asm volatile("s_waitcnt vmcnt(0)" ::: "memory");
        } else {
            XB_SPIN(xb_ld(&bar[XB_XGEN(b.x)]) == gen, bar);
            __builtin_amdgcn_fence(__ATOMIC_ACQUIRE, "agent");
            asm volatile("s_waitcnt vmcnt(0)" ::: "memory");
        }
    }
    __syncthreads();
}
extern __shared__ __attribute__((aligned(16))) unsigned char dsm[];
#define RUN_PHASE(KIND, LAYER) do { const int nb_ = phase_nblk(KIND, LAYER); const int half_ = opaque_tid() >> 8; \
    for (int b_ = blockIdx.x; 2 * b_ < nb_; b_ += gridDim.x) { const int vb_ = 2 * b_ + half_; if (vb_ < nb_) do_phase(p, KIND, LAYER, vb_, (float*)dsm + half_ * 16384); } } while (0)
#define RUN_GEMM(KIND, LAYER) do_gemm(p, KIND, LAYER, gridDim.x, blockIdx.x, dsm)
typedef const __attribute__((address_space(4))) P* KP;
__device__ __forceinline__ const P& phase_args(KP pk) { asm volatile("" : "+s"(pk)); return *(const P*)pk; }
__global__ void __launch_bounds__(512) mega(P p_unused) {
    const KP pk = (KP)__builtin_amdgcn_kernarg_segment_ptr();
    volatile LDS_AS unsigned* xst = (volatile LDS_AS unsigned*)(dsm + LDS_BYTES - 16);
    if (threadIdx.x == 0) { xst[0] = 0u; xst[1] = 0u; }
    __syncthreads();
    XcdBarrier xb;
    { const P& p = phase_args(pk); xb = xcd_barrier_post((unsigned*)(p.ws + WS_BAR), xst); }
#define GSYNC() do { const P& pb_ = phase_args(pk); XcdBarrier b_ = xb; b_.bar = (unsigned*)(pb_.ws + WS_BAR); xcd_barrier(b_); } while (0)
    { const P& p = phase_args(pk); RUN_PHASE(PK_PREP0, 0); } GSYNC();
    { const P& p = phase_args(pk); RUN_PHASE(PK_HMOD0, 0); } GSYNC();
#pragma nounroll
    for (int pair = 0; pair < DEPTH / 2; ++pair) {
        const int le = 2 * pair, lo = 2 * pair + 1;
        { const P& p = phase_args(pk); RUN_GEMM(PK_GEMM_IN, le); } GSYNC();
#pragma nounroll
        for (int dir_ = 0; dir_ < 2; ++dir_) {
            { const P& p = phase_args(pk); rwkv_prep_phase(p, pair, dir_, blockIdx.x, gridDim.x, dsm); } GSYNC();
            { const P& p = phase_args(pk); for (int w_ = blockIdx.x; w_ < EVEN_SCAN_ITEMS; w_ += gridDim.x) ph_even_scan_item(p, w_, pair, dir_, dsm); } GSYNC();
        }
        { const P& p = phase_args(pk); RUN_PHASE(PK_FIN_EVEN, le); } GSYNC();
        { const P& p = phase_args(pk); RUN_GEMM(PK_GEMM_OUT, le); } GSYNC();
        { const P& p = phase_args(pk); RUN_PHASE(PK_POST, le); } GSYNC();
        { const P& p = phase_args(pk); RUN_GEMM(PK_GEMM_IN, lo); } GSYNC();
        { const P& p = phase_args(pk); for (int w_ = blockIdx.x; w_ < ODD_PREP_ITEMS; w_ += gridDim.x) ph_odd_prep(p, w_, pair, dsm); } GSYNC();
        { const P& p = phase_args(pk); for (int w_ = blockIdx.x; w_ < ODD_SCAN_ITEMS; w_ += gridDim.x) ph_odd_scan_item(p, w_, pair, (float*)dsm); } GSYNC();
        { const P& p = phase_args(pk); RUN_PHASE(PK_FIN_ODD_A, lo); } GSYNC();
        { const P& p = phase_args(pk); RUN_GEMM(PK_GEMM_GLU, lo); } GSYNC();
        { const P& p = phase_args(pk); RUN_GEMM(PK_GEMM_OUT, lo); } GSYNC();
        { const P& p = phase_args(pk); RUN_PHASE(PK_POST, lo); }
        if (pair + 1 < DEPTH / 2) GSYNC();
    }
}
extern "C" void kernel_launch(void* const* d_in, const int* in_sizes, int n_in, void* d_out, int out_size, void* d_ws, size_t ws_size, hipStream_t stream) {
    static int grid_blocks = 0;
    if (!grid_blocks) {
        int dev = 0, cus = 0, per_cu = 0;
        (void)hipGetDevice(&dev);
        (void)hipDeviceGetAttribute(&cus, hipDeviceAttributeMultiprocessorCount, dev);
        (void)hipFuncSetAttribute((const void*)mega, hipFuncAttributeMaxDynamicSharedMemorySize, LDS_BYTES);
        (void)hipOccupancyMaxActiveBlocksPerMultiprocessor(&per_cu, mega, 512, LDS_BYTES);
        if (per_cu < 1) fprintf(stderr, "occupancy query says %d blocks/CU\n", per_cu);
        grid_blocks = cus;
    }
    P p{};
    for (int i = 0; i < 44; ++i) p.in[i] = (const float*)d_in[i];
    p.out = (float*)d_out; p.ws = (char*)d_ws;
    (void)hipMemsetAsync((char*)d_ws + WS_BAR, 0, XCD_BAR_WORDS * 4, stream);
    hipLaunchKernelGGL(mega, dim3(grid_blocks), dim3(512), LDS_BYTES, stream, p);
    hipError_t e = hipPeekAtLastError();
    if (e != hipSuccess) fprintf(stderr, "launch failed: %s (grid %d)\n", hipGetErrorString(e), grid_blocks);
}
#endif
```

```cpp
#ifndef CPU_EMU
#include <hip/hip_runtime.h>
#include <hip/hip_cooperative_groups.h>
#include <cstdio>
namespace cg = cooperative_groups;
#endif
#include <stdint.h>

#ifndef CFG_BATCH
#define CFG_BATCH 16
#define CFG_SEQ 256
#define CFG_DEC_BATCH 8
#define CFG_DEC_SEQ 1024
#define CFG_DEPTH 4
#endif

typedef unsigned short bf16;
typedef short s8v __attribute__((ext_vector_type(8)));
typedef float f4v __attribute__((ext_vector_type(4)));

constexpr int D = 1024;
constexpr int NB_CTX = CFG_BATCH, L_CTX = CFG_SEQ, NB_LAT = CFG_DEC_BATCH, L_LAT = CFG_DEC_SEQ, DEPTH = CFG_DEPTH;
constexpr int N_EVEN = (DEPTH + 1) / 2, N_ODD = DEPTH / 2;
constexpr int T_CTX = NB_CTX * L_CTX, T_LAT = NB_LAT * L_LAT, T = T_CTX + T_LAT;
constexpr int NSEQ = NB_CTX + NB_LAT, NCOND = 1 + NB_LAT;
constexpr int EW = 3872, OW = 3088, EWP = 4096, OWP = 3328;
constexpr float EPS = 1e-6f;
constexpr int E_Q = 0, E_K = 256, E_V = 512, E_GD = 1024, E_ZA = 1056, E_FB = 1568, E_ZB = 3360;
constexpr int FB_R = 0, FB_K = 512, FB_V = 1024, FB_WD = 1536, FB_AD = 1664;
constexpr int O_QKV = 0, O_G = 1536, O_BETA = 1544, O_ZC = 1552, O_U = 2064, O_ZD = 2576;

constexpr size_t al(size_t x) { return (x + 255) & ~(size_t)255; }
constexpr size_t WS_MOD = 0;
constexpr size_t WS_WTE = WS_MOD + al((size_t)DEPTH * NCOND * 3072 * 4);
constexpr size_t WS_WTO = WS_WTE + al((size_t)N_EVEN * EWP * D * 2);
constexpr size_t WS_WTOUT = WS_WTO + al((size_t)(N_ODD ? N_ODD : 1) * OWP * D * 2);
constexpr size_t WS_WTGLU = WS_WTOUT + al((size_t)DEPTH * D * D * 2);
constexpr size_t WS_HM = WS_WTGLU + al((size_t)(N_ODD ? N_ODD : 1) * 512 * 512 * 2);
constexpr size_t WS_PROJ = WS_HM + al((size_t)T * D * 2);
constexpr size_t WS_PART = WS_PROJ + al((size_t)T * EW * 2);
constexpr size_t PART_SZ = al((size_t)T * 512 * 2);
constexpr size_t WS_BONUS = WS_PART + 4 * PART_SZ;
constexpr size_t WS_QKVN = WS_BONUS + al((size_t)T * 16 * 4);
constexpr size_t WS_GATES = WS_QKVN + al((size_t)T * 1536 * 2);
constexpr size_t WS_GC = WS_GATES + al((size_t)T * 16 * 4);
constexpr size_t WS_BAR = WS_GC + al((size_t)(T / 64) * 8 * 64 * 4);
constexpr size_t WS_END = WS_BAR + 16384;
constexpr size_t WS_TINV = WS_PROJ + al((size_t)T * OW * 2);
constexpr size_t WS_QKM = WS_HM;
static_assert(WS_TINV + (size_t)T * 1024 <= WS_PART, "TINV must fit in the PROJ tail");
constexpr size_t WS_RM12 = WS_HM;
constexpr size_t WS_RM34 = WS_QKVN;
constexpr size_t WS_VSH = WS_QKVN + (size_t)(T / 64) * 8 * 16384;
static_assert((size_t)(T / 64) * 8 * 16384 <= (size_t)T * D * 2, "M1/M2 must fit in HM");
static_assert((size_t)(T / 64) * 8 * 16384 + (size_t)T * 512 * 2 <= (size_t)T * 1536 * 2, "M3/M4 + shifted v must fit in QKVN");

constexpr size_t OUT_X = 0;
constexpr size_t OUT_GLA = (size_t)T * D;
constexpr size_t OUT_RWKV = OUT_GLA + (size_t)NB_CTX * N_EVEN * 2 * 4 * 64 * 128;
constexpr size_t OUT_GDN = OUT_RWKV + (size_t)NB_CTX * N_EVEN * 2 * 8 * 64 * 64;
constexpr size_t OUT_S5R = OUT_GDN + (size_t)NB_CTX * N_ODD * 2 * 4 * 128 * 128;
constexpr size_t OUT_S5I = OUT_S5R + (size_t)NB_CTX * N_ODD * 2 * 32 * 64;

struct P {
    const float* in[44];
    float* out;
    char* ws;
};
enum { I_XP = 0, I_XS, I_C, I_SGLA, I_SRWKV, I_SGDN, I_SS5R, I_SS5I, I_CCTX, I_WMOD, I_BMOD, I_GPRE, I_GPOST,
       I_WINE, I_WOUTE, I_GUP, I_GBIAS, I_GLAN, I_MIX, I_W0, I_W2, I_A0, I_A2, I_KK, I_KA, I_RK, I_LNG, I_LNB,
       I_WINO, I_WOUTO, I_CONV, I_ALOG, I_DTB, I_GDNN, I_S5AR, I_S5AI, I_S5DT, I_S5BR, I_S5BI, I_S5CR, I_S5CI,
       I_S5D, I_GLUW, I_GLUB };

#ifdef CPU_EMU
__device__ __forceinline__ int opaque_tid() { return (int)threadIdx.x; }
#else
__device__ __forceinline__ int opaque_tid() { int t = (int)threadIdx.x; asm volatile("" : "+v"(t)); return t; }
#endif
#define LT (opaque_tid() & 255)
__device__ __forceinline__ float u2f(unsigned u) { return __builtin_bit_cast(float, u); }
__device__ __forceinline__ unsigned f2u(float f) { return __builtin_bit_cast(unsigned, f); }
__device__ __forceinline__ float bf2f(bf16 h) { return u2f((unsigned)h << 16); }
#ifdef CPU_EMU
__device__ __forceinline__ bf16 f2bf(float f) { unsigned u = f2u(f); u += 0x7fffu + ((u >> 16) & 1u); return (bf16)(u >> 16); }
__device__ __forceinline__ unsigned pack2(float lo, float hi) { return (unsigned)f2bf(lo) | ((unsigned)f2bf(hi) << 16); }
__device__ __forceinline__ float fexp(float x) { return expf(x); }
__device__ __forceinline__ float flog(float x) { return logf(x); }
__device__ __forceinline__ float frcp(float x) { return 1.0f / x; }
__device__ __forceinline__ float frsq(float x) { return 1.0f / sqrtf(x); }
#else
typedef __bf16 hwbf2 __attribute__((ext_vector_type(2)));
typedef float hwf2 __attribute__((ext_vector_type(2)));
__device__ __forceinline__ unsigned pack2(float lo, float hi) { hwf2 v = {lo, hi}; return __builtin_bit_cast(unsigned, __builtin_convertvector(v, hwbf2)); }
__device__ __forceinline__ bf16 f2bf(float f) { return (bf16)(pack2(f, 0.f) & 0xffffu); }
__device__ __forceinline__ float fexp(float x) { return __builtin_amdgcn_exp2f(x * 1.4426950408889634f); }
__device__ __forceinline__ float flog(float x) { return __builtin_amdgcn_logf(x) * 0.6931471805599453f; }
__device__ __forceinline__ float frcp(float x) { return __builtin_amdgcn_rcpf(x); }
__device__ __forceinline__ float frsq(float x) { return __builtin_amdgcn_rsqf(x); }
#endif
__device__ __forceinline__ float sigmoidf_(float x) { return frcp(1.0f + fexp(-x)); }
__device__ __forceinline__ float siluf_(float x) { return x * frcp(1.0f + fexp(-x)); }
__device__ __forceinline__ float logsigf_(float x) { return fminf(x, 0.f) - flog(1.0f + fexp(-fabsf(x))); }
__device__ __forceinline__ float softplusf_(float x) { return fmaxf(x, 0.f) + flog(1.0f + fexp(-fabsf(x))); }
__device__ __forceinline__ float ftanh(float x) { const float e = fexp(-2.0f * fabsf(x)); const float t = (1.0f - e) * frcp(1.0f + e); return x < 0.f ? -t : t; }
__device__ __forceinline__ float gelu_tanh(float x) { return 0.5f * x * (1.0f + ftanh(0.7978845608028654f * (x + 0.044715f * x * x * x))); }

typedef float f8v __attribute__((ext_vector_type(8)));
__device__ __forceinline__ f8v unpack8v(const uint4& u) {
    f8v f; f[0] = u2f(u.x << 16); f[1] = u2f(u.x & 0xffff0000u); f[2] = u2f(u.y << 16); f[3] = u2f(u.y & 0xffff0000u);
    f[4] = u2f(u.z << 16); f[5] = u2f(u.z & 0xffff0000u); f[6] = u2f(u.w << 16); f[7] = u2f(u.w & 0xffff0000u); return f;
}
__device__ __forceinline__ uint4 pack8v(const f8v& f) { return make_uint4(pack2(f[0], f[1]), pack2(f[2], f[3]), pack2(f[4], f[5]), pack2(f[6], f[7])); }
struct Seq { int start, len, cond, lat, b; };
__device__ __forceinline__ Seq get_seq(int s) {
    Seq q;
    if (s < NB_CTX) { q.start = s * L_CTX; q.len = L_CTX; q.cond = 0; q.lat = 0; q.b = s; }
    else { int b = s - NB_CTX; q.start = T_CTX + b * L_LAT; q.len = L_LAT; q.cond = 1 + b; q.lat = 1; q.b = b; }
    return q;
}
__device__ __forceinline__ int tok_cond(int t) { return t < T_CTX ? 0 : 1 + (t - T_CTX) / L_LAT; }
__device__ __forceinline__ void tok_nbr(int t, bool& hl, bool& hr) {
    if (t < T_CTX) { int pos = t % L_CTX; hl = pos != 0; hr = pos != L_CTX - 1; }
    else { int pos = (t - T_CTX) & 63; hl = pos != 0; hr = pos != 63; }
}

constexpr int MOD_VB = DEPTH * 192;
__device__ __forceinline__ void ph_mod(const P& p, int bid, float* smem) {
    float (*sc)[1024] = (float(*)[1024])smem;
    float (*red)[16][NCOND] = (float(*)[16][NCOND])(smem + NCOND * 1024);
    const int layer = bid / 192, ct = bid % 192;
    __syncthreads();
    const int tid = LT, cl = tid & 15, kg = tid >> 4;
    for (int i = tid; i < NCOND * 1024; i += 256) {
        int ci = i >> 10, k = i & 1023;
        float v = ci == 0 ? p.in[I_CCTX][k] : p.in[I_C][(ci - 1) * 1024 + k];
        sc[ci][k] = siluf_(v);
    }
    __syncthreads();
    float acc[NCOND];
#pragma unroll
    for (int ci = 0; ci < NCOND; ++ci) acc[ci] = 0.f;
    const float* w = p.in[I_WMOD] + (size_t)layer * 1024 * 3072 + ct * 16 + cl;
#pragma unroll 4
    for (int kk = 0; kk < 64; ++kk) {
        const int k = kg * 64 + kk;
        const float wv = w[(size_t)k * 3072];
#pragma unroll
        for (int ci = 0; ci < NCOND; ++ci) acc[ci] += sc[ci][k] * wv;
    }
#pragma unroll
    for (int ci = 0; ci < NCOND; ++ci) red[kg][cl][ci] = acc[ci];
    __syncthreads();
    if (tid < 16 * NCOND) {
        const int c = tid / NCOND, ci = tid % NCOND;
        float sum = p.in[I_BMOD][layer * 3072 + ct * 16 + c];
#pragma unroll
        for (int g = 0; g < 16; ++g) sum += red[g][c][ci];
        ((float*)(p.ws + WS_MOD))[(size_t)(layer * NCOND + ci) * 3072 + ct * 16 + c] = sum;
    }
}

struct WtJob { const float* src; bf16* dst; int K, N, Npad; };
__device__ __forceinline__ WtJob wt_job(const P& p, int j) {
    WtJob q;
    if (j < N_EVEN) { q.src = p.in[I_WINE] + (size_t)j * D * EW; q.dst = (bf16*)(p.ws + WS_WTE) + (size_t)j * EWP * D; q.K = D; q.N = EW; q.Npad = EWP; return q; }
    j -= N_EVEN;
    if (j < N_ODD) { q.src = p.in[I_WINO] + (size_t)j * D * OW; q.dst = (bf16*)(p.ws + WS_WTO) + (size_t)j * OWP * D; q.K = D; q.N = OW; q.Npad = OWP; return q; }
    j -= N_ODD;
    if (j < DEPTH) { int i = j >> 1; q.src = (j & 1) ? p.in[I_WOUTO] + (size_t)i * D * D : p.in[I_WOUTE] + (size_t)i * D * D; q.dst = (bf16*)(p.ws + WS_WTOUT) + (size_t)j * D * D; q.K = D; q.N = D; q.Npad = D; return q; }
    j -= DEPTH;
    q.src = p.in[I_GLUW] + (size_t)j * 512 * 512; q.dst = (bf16*)(p.ws + WS_WTGLU) + (size_t)j * 512 * 512; q.K = 512; q.N = 512; q.Npad = 512; return q;
}
constexpr int WT_NJOBS = N_EVEN + N_ODD + DEPTH + N_ODD;
constexpr int WT_TILES = N_EVEN * (EWP / 64) * 16 + N_ODD * (OWP / 64) * 16 + DEPTH * 256 + N_ODD * 64;
__device__ __forceinline__ void ph_wt(const P& p, int bid, float* smem) {
    float (*tile)[65] = (float(*)[65])smem;
    int b = bid, j = 0;
    __syncthreads();
    WtJob q;
    for (;; ++j) { q = wt_job(p, j); int nt = (q.Npad / 64) * (q.K / 64); if (b < nt) break; b -= nt; }
    const int nk = q.K / 64, n0 = (b / nk) * 64, k0 = (b % nk) * 64;
    {
        const int kk = LT >> 4, n4 = (LT & 15) * 4, n = n0 + n4;
#pragma unroll
        for (int i = 0; i < 4; ++i) {
            float4 v = make_float4(0.f, 0.f, 0.f, 0.f);
            if (n < q.N) v = *(const float4*)(q.src + (size_t)(k0 + kk + 16 * i) * q.N + n);
            float* tr = &tile[kk + 16 * i][n4];
            tr[0] = v.x; tr[1] = v.y; tr[2] = v.z; tr[3] = v.w;
        }
    }
    __syncthreads();
    {
        const int nn = LT >> 2, k16 = (LT & 3) * 16;
        f8v a, c;
#pragma unroll
        for (int j = 0; j < 8; ++j) { a[j] = tile[k16 + j][nn]; c[j] = tile[k16 + 8 + j][nn]; }
        bf16* d = q.dst + (size_t)(n0 + nn) * q.K + k0 + k16;
        *(uint4*)d = pack8v(a); *(uint4*)(d + 8) = pack8v(c);
    }
}

__device__ __forceinline__ float wave_sum(float v) {
#pragma unroll
    for (int m = 1; m < 64; m <<= 1) v += __shfl_xor(v, m);
    return v;
}
__device__ __forceinline__ void hmod_row(const float* xv  , int lane, const float* gpre, const float* mod, bf16* dst) {
    float ss = 0.f;
#pragma unroll
    for (int i = 0; i < 16; ++i) ss += xv[i] * xv[i];
    ss = wave_sum(ss);
    const float r = frsq(ss * (1.0f / 1024.f) + EPS);
#pragma unroll
    for (int i = 0; i < 4; ++i) {
        int idx = i * 256 + lane * 4;
        bf16 o[4];
#pragma unroll
        for (int j = 0; j < 4; ++j) o[j] = f2bf(xv[i * 4 + j] * r * gpre[idx + j] * (1.0f + mod[1024 + idx + j]) + mod[idx + j]);
        *(uint2*)(dst + idx) = make_uint2((unsigned)o[0] | ((unsigned)o[1] << 16), (unsigned)o[2] | ((unsigned)o[3] << 16));
    }
}
__device__ __forceinline__ void ph_hmod0(const P& p, int bid) {
    const int lane = LT & 63, t = bid * 4 + (LT >> 6);
    if (t >= T) return;
    const float* xr = t < T_CTX ? p.in[I_XP] + (size_t)t * D : p.in[I_XS] + (size_t)(t - T_CTX) * D;
    float xv[16];
#pragma unroll
    for (int i = 0; i < 4; ++i) { float4 v = *(const float4*)(xr + i * 256 + lane * 4); xv[i * 4] = v.x; xv[i * 4 + 1] = v.y; xv[i * 4 + 2] = v.z; xv[i * 4 + 3] = v.w; }
    const float* mod = (const float*)(p.ws + WS_MOD) + (size_t)(0 * NCOND + tok_cond(t)) * 3072;
    hmod_row(xv, lane, p.in[I_GPRE], mod, (bf16*)(p.ws + WS_HM) + (size_t)t * D);
}
__device__ __forceinline__ void ph_post(const P& p, int bid, int layer) {
    const int lane = LT & 63, t = bid * 4 + (LT >> 6);
    if (t >= T) return;
    const float* xr = layer == 0 ? (t < T_CTX ? p.in[I_XP] + (size_t)t * D : p.in[I_XS] + (size_t)(t - T_CTX) * D) : p.out + OUT_X + (size_t)t * D;
    const float* mr = (const float*)(p.ws + WS_PROJ) + (size_t)t * D;
    const float* mod = (const float*)(p.ws + WS_MOD) + (size_t)(layer * NCOND + tok_cond(t)) * 3072;
    const float* gpost = p.in[I_GPOST] + layer * D;
    float xv[16], mv[16];
    float ss = 0.f;
#pragma unroll
    for (int i = 0; i < 4; ++i) {
        float4 v = *(const float4*)(xr + i * 256 + lane * 4); xv[i * 4] = v.x; xv[i * 4 + 1] = v.y; xv[i * 4 + 2] = v.z; xv[i * 4 + 3] = v.w;
        float4 m = *(const float4*)(mr + i * 256 + lane * 4); mv[i * 4] = m.x; mv[i * 4 + 1] = m.y; mv[i * 4 + 2] = m.z; mv[i * 4 + 3] = m.w;
    }
#pragma unroll
    for (int i = 0; i < 16; ++i) ss += mv[i] * mv[i];
    ss = wave_sum(ss);
    const float r = frsq(ss * (1.0f / 1024.f) + EPS);
    float* xo = p.out + OUT_X + (size_t)t * D;
#pragma unroll
    for (int i = 0; i < 4; ++i) {
        int idx = i * 256 + lane * 4;
#pragma unroll
        for (int j = 0; j < 4; ++j) xv[i * 4 + j] += mod[2048 + idx + j] * (mv[i * 4 + j] * r * gpost[idx + j]);
        *(float4*)(xo + idx) = make_float4(xv[i * 4], xv[i * 4 + 1], xv[i * 4 + 2], xv[i * 4 + 3]);
    }
    if (layer + 1 < DEPTH) {
        const float* mod2 = (const float*)(p.ws + WS_MOD) + (size_t)((layer + 1) * NCOND + tok_cond(t)) * 3072;
        hmod_row(xv, lane, p.in[I_GPRE] + (layer + 1) * D, mod2, (bf16*)(p.ws + WS_HM) + (size_t)t * D);
    }
}

#ifdef CPU_EMU
#define LDS_AS
#define GLDS16(gptr, lptr) memcpy((char*)(lptr) + (threadIdx.x & 63) * 16, (const void*)(gptr), 16)
#define PG_WAIT_V(n)
#define PG_WAIT_L(n)
#define PG_BAR __syncthreads()
#define PG_SCHED
#define PG_PRIO(x)
#define RFL(x) (x)
__device__ __forceinline__ unsigned cvt_pk_bf16(float lo, float hi) { return (unsigned)f2bf(lo) | ((unsigned)f2bf(hi) << 16); }
#else
#define LDS_AS __attribute__((address_space(3)))
#define GLDS16(gptr, lptr) __builtin_amdgcn_global_load_lds((const unsigned*)(gptr), (LDS_AS unsigned*)(lptr), 16, 0, 0)
#define PG_WAIT_V(n) asm volatile("s_waitcnt vmcnt(" #n ")" ::: "memory")
#define PG_WAIT_L(n) asm volatile("s_waitcnt lgkmcnt(" #n ")" ::: "memory")
#define PG_BAR __builtin_amdgcn_s_barrier()
#define PG_SCHED __builtin_amdgcn_sched_barrier(0)
#define PG_PRIO(x) __builtin_amdgcn_s_setprio(x)
#define RFL(x) __builtin_amdgcn_readfirstlane(x)
__device__ __forceinline__ unsigned cvt_pk_bf16(float lo, float hi) { return pack2(lo, hi); }
#endif
namespace pg8 {
constexpr int BM = 256, BK = 64, HALF = 128, HTB = HALF * BK * 2, STAGE_BYTES = 8 * HTB, NXCD = 8, WGM = 8;
__host__ __device__ __forceinline__ int lds_byte(int r, int c) { const int st = (r >> 4) * 2 + (c >> 5), rr = r & 15, cc = c & 31, ob = rr * 64 + cc * 2; return st * 1024 + (ob ^ (((ob >> 9) & 1) << 5)); }
__host__ __device__ __forceinline__ void stage_rc(int b, int& R, int& C) { const int st = b / 1024, sb = b % 1024, swz = sb ^ (((sb >> 9) & 1) << 5); R = (st >> 1) * 16 + swz / 64; C = (st & 1) * 32 + (swz % 64) / 2; }
__host__ __device__ __forceinline__ int perm32(int rho) { const int n = rho >> 4, i = rho & 15; return 8 * (i >> 2) + 4 * n + (i & 3); }
struct Unit { int pm, pn; };
struct Gemm { const bf16* A; const bf16* Bt; int M, N, K, lda; };
struct StaticOrder {
    int nM, nN, nwg, G, c;
    __host__ __device__ void init(int M, int N, int G_, int c_) { nM = M / BM; nN = N / BM; nwg = nM * nN; G = G_; c = c_; }
    __host__ __device__ bool next(int i, Unit& u) const {
        const long L = (long)i * G + c; if (L >= nwg) return false;
        int wgid = (int)L; { const int q = nwg / NXCD, r = nwg % NXCD, xcd = wgid % NXCD, off = wgid / NXCD; wgid = (xcd < r ? xcd * (q + 1) : r * (q + 1) + (xcd - r) * q) + off; }
        const int nig = WGM * nN, gid = wgid / nig, fm = gid * WGM, gsz = (nM - fm) < WGM ? (nM - fm) : WGM;
        u.pm = fm + ((wgid % nig) % gsz); u.pn = (wgid % nig) / gsz; return true;
    }
};
struct EpiF32 {
    static constexpr bool PERM = false;
    float* C; int ldc;
    __device__ __forceinline__ void operator()(const f4v (&acc)[2][2][4][2], const Unit& u, int wr, int wc, int fr, int fq) const {
        const int row0 = u.pm * BM + wr * 64 + fr, col0 = u.pn * BM + wc * 32 + 4 * fq;
#pragma unroll
        for (int ai = 0; ai < 2; ++ai)
#pragma unroll
            for (int m = 0; m < 4; ++m) { float* rowp = C + (size_t)(row0 + ai * HALF + m * 16) * ldc + col0;
#pragma unroll
                for (int bj = 0; bj < 2; ++bj)
#pragma unroll
                    for (int n = 0; n < 2; ++n) *(f4v*)(rowp + bj * HALF + n * 16) = acc[ai][bj][m][n]; }
    }
};
struct EpiBf16 {
    static constexpr bool PERM = true;
    bf16* O; int ldc; int N;
    __device__ __forceinline__ void operator()(const f4v (&acc)[2][2][4][2], const Unit& u, int wr, int wc, int fr, int fq) const {
        const int row0 = u.pm * BM + wr * 64 + fr, col0 = u.pn * BM + wc * 32 + 8 * fq;
#pragma unroll
        for (int ai = 0; ai < 2; ++ai)
#pragma unroll
            for (int m = 0; m < 4; ++m) { bf16* rowp = O + (size_t)(row0 + ai * HALF + m * 16) * ldc + col0;
#pragma unroll
                for (int bj = 0; bj < 2; ++bj) { const f4v v0 = acc[ai][bj][m][0], v1 = acc[ai][bj][m][1];
                    if (col0 + bj * HALF < N) *(uint4*)(rowp + bj * HALF) = make_uint4(cvt_pk_bf16(v0[0], v0[1]), cvt_pk_bf16(v0[2], v0[3]), cvt_pk_bf16(v1[0], v1[1]), cvt_pk_bf16(v1[2], v1[3])); } }
    }
};
struct EpiGlu {
    static constexpr bool PERM = true;
    bf16* O; const bf16* YS; const bf16* ZD; const float* GB;
    __device__ __forceinline__ void operator()(const f4v (&acc)[2][2][4][2], const Unit& u, int wr, int wc, int fr, int fq) const {
        const int row0 = u.pm * BM + wr * 64 + fr, col0 = u.pn * BM + wc * 32 + 8 * fq;
#pragma unroll
        for (int ai = 0; ai < 2; ++ai)
#pragma unroll
            for (int m = 0; m < 4; ++m) { const size_t row = (size_t)(row0 + ai * HALF + m * 16);
#pragma unroll
                for (int bj = 0; bj < 2; ++bj) { const int col = col0 + bj * HALF;
                    const f8v ys = unpack8v(*(const uint4*)(YS + row * 512 + col)), zd = unpack8v(*(const uint4*)(ZD + row * OW + col));
                    const f8v gb = *(const f8v*)(GB + col);
                    f8v o;
#pragma unroll
                    for (int j = 0; j < 8; ++j) { const float g = (j < 4 ? acc[ai][bj][m][0][j] : acc[ai][bj][m][1][j - 4]) + gb[j]; o[j] = ys[j] * sigmoidf_(g) * siluf_(zd[j]); }
                    *(uint4*)(O + row * D + col) = pack8v(o); } }
    }
};
template <class Epi>
__device__ __forceinline__ void gemm_phase(LDS_AS unsigned char* lds, const Gemm g, const StaticOrder& S, const Epi& E) {
    const int tid = opaque_tid(), wid = RFL(tid >> 6), lane = tid & 63, wr = wid >> 2, wc = wid & 3, fr = lane & 15, fq = lane >> 4;
    const int K = g.K, nt = K / BK;
    unsigned voffA[2], voffB[2];
#pragma unroll
    for (int i = 0; i < 2; ++i) { int R, C; stage_rc(tid * 16 + i * 8192, R, C); const int Rb = Epi::PERM ? ((R & ~31) + perm32(R & 31)) : R;
        voffA[i] = (unsigned)(R * g.lda + C) * 2u; voffB[i] = (unsigned)(Rb * K + C) * 2u; }
    const size_t kstep = (size_t)(BK * 2);
    const size_t hstepA = (size_t)HALF * g.lda * 2, hstepB = (size_t)HALF * K * 2;
    const size_t tstepA = 2 * hstepA, tstepB = 2 * hstepB;
    const unsigned ldsw = (unsigned)wid * 1024u;
    const int aoff = lds_byte(wr * 64 + fr, fq * 8), boff = lds_byte(wc * 32 + fr, fq * 8);
#define PG8_SA(b, h) (((b) * 2 + (h)) * HTB)
#define PG8_SB(b, h) ((4 + (b) * 2 + (h)) * HTB)
#define PG8_STAGE(bufoff, gbase, voff) do { _Pragma("unroll") for (int _i = 0; _i < 2; ++_i) GLDS16((const char*)(gbase) + (voff)[_i], lds + (bufoff) + ldsw + _i * 8192); } while (0)
#define PG8_LDA(dst, b, h) do { _Pragma("unroll") for (int m = 0; m < 4; ++m) _Pragma("unroll") for (int k = 0; k < 2; ++k) dst[m][k] = *(const LDS_AS s8v*)(lds + PG8_SA(b, h) + aoff + m * 2048 + k * 1024); } while (0)
#define PG8_LDB(dst, b, h) do { _Pragma("unroll") for (int n = 0; n < 2; ++n) _Pragma("unroll") for (int k = 0; k < 2; ++k) dst[n][k] = *(const LDS_AS s8v*)(lds + PG8_SB(b, h) + boff + n * 2048 + k * 1024); } while (0)
#define PG8_MMA(ai, bj, At, Bt) do { PG_PRIO(1); _Pragma("unroll") for (int m = 0; m < 4; ++m) _Pragma("unroll") for (int n = 0; n < 2; ++n) _Pragma("unroll") for (int k = 0; k < 2; ++k) \
        acc[ai][bj][m][n] = __builtin_amdgcn_mfma_f32_16x16x32_bf16(Bt[n][k], At[m][k], acc[ai][bj][m][n], 0, 0, 0); PG_PRIO(0); } while (0)
    Unit cur, nxt; int ui = 0;
    if (!S.next(0, cur)) return;
    f4v acc[2][2][4][2];
#pragma unroll
    for (int a = 0; a < 2; ++a)
#pragma unroll
        for (int b = 0; b < 2; ++b)
#pragma unroll
            for (int m = 0; m < 4; ++m)
#pragma unroll
                for (int n = 0; n < 2; ++n) acc[a][b][m][n] = (f4v){0.f, 0.f, 0.f, 0.f};
    s8v At[4][2], B0[2][2], B1[2][2];
    const char* cA = (const char*)g.A + (size_t)cur.pm * tstepA; const char* cB = (const char*)g.Bt + (size_t)cur.pn * tstepB;
    PG8_STAGE(PG8_SB(0, 0), cB, voffB); PG8_STAGE(PG8_SA(0, 0), cA, voffA); PG8_STAGE(PG8_SB(0, 1), cB + hstepB, voffB); PG8_STAGE(PG8_SA(0, 1), cA + hstepA, voffA);
    if (wr == 1) PG_BAR;
    PG_WAIT_V(4); PG_BAR;
    PG8_STAGE(PG8_SB(1, 0), cB + kstep, voffB); PG8_STAGE(PG8_SA(1, 0), cA + kstep, voffA); PG8_STAGE(PG8_SB(1, 1), cB + hstepB + kstep, voffB);
    PG_WAIT_V(6); PG_BAR;
    for (;;) {
        const bool has_next = S.next(ui + 1, nxt);
        const char* nA = has_next ? (const char*)g.A + (size_t)nxt.pm * tstepA : cA; const char* nB = has_next ? (const char*)g.Bt + (size_t)nxt.pn * tstepB : cB;
        for (int t = 0; t < nt; t += 2) {
            const bool last = (t == nt - 2);
            const char* a1 = cA + (size_t)(t + 1) * kstep;
            const char* a2 = last ? nA : cA + (size_t)(t + 2) * kstep; const char* b2 = last ? nB : cB + (size_t)(t + 2) * kstep;
            const char* a3 = a2 + kstep; const char* b3 = b2 + kstep;
            PG8_LDB(B0, 0, 0); PG_SCHED; PG8_LDA(At, 0, 0); PG8_STAGE(PG8_SA(1, 1), a1 + hstepA, voffA);
            PG_WAIT_L(8); PG_BAR; PG_WAIT_L(0); PG8_MMA(0, 0, At, B0); PG_BAR; PG_SCHED;
            PG8_LDB(B1, 0, 1); PG8_STAGE(PG8_SB(0, 0), b2, voffB);
            PG_BAR; PG_WAIT_L(0); PG8_MMA(0, 1, At, B1); PG_BAR;
            PG8_LDA(At, 0, 1); PG8_STAGE(PG8_SA(0, 0), a2, voffA);
            PG_BAR; PG_WAIT_L(0); PG8_MMA(1, 0, At, B0); PG_BAR; PG_SCHED;
            PG8_STAGE(PG8_SB(0, 1), b2 + hstepB, voffB);
            PG_WAIT_V(6); PG_BAR; PG8_MMA(1, 1, At, B1); PG_BAR;
            PG8_LDB(B0, 1, 0); PG_SCHED; PG8_LDA(At, 1, 0); PG8_STAGE(PG8_SA(0, 1), a2 + hstepA, voffA);
            PG_WAIT_L(8); PG_BAR; PG_WAIT_L(0); PG8_MMA(0, 0, At, B0); PG_BAR; PG_SCHED;
            PG8_LDB(B1, 1, 1); PG8_STAGE(PG8_SB(1, 0), b3, voffB);
            PG_BAR; PG_WAIT_L(0); PG8_MMA(0, 1, At, B1); PG_BAR;
            PG8_LDA(At, 1, 1); PG8_STAGE(PG8_SA(1, 0), a3, voffA);
            PG_BAR; PG_WAIT_L(0); PG8_MMA(1, 0, At, B0); PG_BAR; PG_SCHED;
            PG8_STAGE(PG8_SB(1, 1), b3 + hstepB, voffB);
            PG_WAIT_V(6); PG_BAR; PG8_MMA(1, 1, At, B1); PG_BAR;
        }
        E(acc, cur, wr, wc, fr, fq);
        if (!has_next) break;
#pragma unroll
        for (int a = 0; a < 2; ++a)
#pragma unroll
            for (int b = 0; b < 2; ++b)
#pragma unroll
                for (int m = 0; m < 4; ++m)
#pragma unroll
                    for (int n = 0; n < 2; ++n) acc[a][b][m][n] = (f4v){0.f, 0.f, 0.f, 0.f};
        cur = nxt; cA = nA; cB = nB; ++ui;
    }
    PG_WAIT_V(0);
    if (wr == 0) PG_BAR;
    PG_BAR;
}
}

#ifdef CPU_EMU
#define WAVE_SYNC() emu::wsync()
#define LBAR() __syncthreads()
#else
#define WAVE_SYNC() __builtin_amdgcn_wave_barrier()
#define LBAR() do { asm volatile("s_waitcnt lgkmcnt(0)" ::: "memory"); __builtin_amdgcn_s_barrier(); asm volatile("" ::: "memory"); } while (0)
#endif
__device__ __forceinline__ void unpack8(const uint4& u, float* f) {
    f[0] = u2f(u.x << 16); f[1] = u2f(u.x & 0xffff0000u); f[2] = u2f(u.y << 16); f[3] = u2f(u.y & 0xffff0000u);
    f[4] = u2f(u.z << 16); f[5] = u2f(u.z & 0xffff0000u); f[6] = u2f(u.w << 16); f[7] = u2f(u.w & 0xffff0000u);
}
__device__ __forceinline__ uint4 pack8(const float* f) { return make_uint4(pack2(f[0], f[1]), pack2(f[2], f[3]), pack2(f[4], f[5]), pack2(f[6], f[7])); }
__device__ __forceinline__ f4v unpack4(const uint2& u) { f4v f; f[0] = u2f(u.x << 16); f[1] = u2f(u.x & 0xffff0000u); f[2] = u2f(u.y << 16); f[3] = u2f(u.y & 0xffff0000u); return f; }
__device__ __forceinline__ uint2 pack4(const f4v& f) { return make_uint2(pack2(f[0], f[1]), pack2(f[2], f[3])); }
__device__ __forceinline__ f4v mfma16(const s8v& a, const s8v& b, const f4v& c) { return __builtin_amdgcn_mfma_f32_16x16x32_bf16(a, b, c, 0, 0, 0); }

__device__ __forceinline__ float red8(float x) {
#ifdef CPU_EMU
    x += __shfl_xor(x, 1); x += __shfl_xor(x, 2); x += __shfl_xor(x, 4);
#else
    x += __builtin_bit_cast(float, __builtin_amdgcn_mov_dpp(__builtin_bit_cast(int, x), 0xB1, 0xF, 0xF, true));
    x += __builtin_bit_cast(float, __builtin_amdgcn_mov_dpp(__builtin_bit_cast(int, x), 0x4E, 0xF, 0xF, true));
    x += __builtin_bit_cast(float, __builtin_amdgcn_mov_dpp(__builtin_bit_cast(int, x), 0x141, 0xF, 0xF, true));
#endif
    return x;
}
constexpr int TI_LD = 68, TI_TLD = 20;
__device__ __forceinline__ void ti_mm16(float* dst, int ldd, const float* L, int ldl, const float* R, int ldr, float sgn, const float* add, int lda, int lane) {
    const int r = lane >> 2, c4 = (lane & 3) * 4;
    f4v acc = (f4v){0.f, 0.f, 0.f, 0.f};
#pragma unroll
    for (int k = 0; k < 16; ++k) { const float l = L[r * ldl + k]; const f4v rv = *(const f4v*)(R + k * ldr + c4); acc += l * rv; }
    acc *= sgn;
    if (add) acc += *(const f4v*)(add + r * lda + c4);
    *(f4v*)(dst + r * ldd + c4) = acc;
}
__device__ __forceinline__ float red4(float x) {
#ifdef CPU_EMU
    x += __shfl_xor(x, 1); x += __shfl_xor(x, 2);
#else
    x += __builtin_bit_cast(float, __builtin_amdgcn_mov_dpp(__builtin_bit_cast(int, x), 0xB1, 0xF, 0xF, true));
    x += __builtin_bit_cast(float, __builtin_amdgcn_mov_dpp(__builtin_bit_cast(int, x), 0x4E, 0xF, 0xF, true));
#endif
    return x;
}
__device__ __forceinline__ void tri_inv64(const float* A, float* X, float* TMP, int wl, int lane, bool active) {
#define TI_A(a, b) (A + (16 * (a)) * TI_LD + 16 * (b))
#define TI_X(a, b) (X + (16 * (a)) * TI_LD + 16 * (b))
#define TI_T(n) (TMP + (n) * 16 * TI_TLD)
    if (active) {
        const int c = lane >> 2, js = lane & 3;
        float xr[4] = {0.f, 0.f, 0.f, 0.f};
        const float* Ab = TI_A(wl, wl);
#pragma unroll
        for (int i = 0; i < 16; ++i) {
            float part = 0.f;
#pragma unroll
            for (int m = 0; m <= (i - 1) / 4 && i > 0; ++m) { const int j = 4 * m + js; part += (j < i ? Ab[i * TI_LD + j] : 0.f) * xr[m]; }
            const float tot = red4(part);
            const float xi = (i == c ? 1.f : 0.f) - tot;
            xr[i >> 2] = ((i & 3) == js) ? xi : xr[i >> 2];
        }
        float* Xb = TI_X(wl, wl);
#pragma unroll
        for (int m = 0; m < 4; ++m) Xb[(4 * m + js) * TI_LD + c] = xr[m];
        for (int b = wl + 1; b < 4; ++b) { float* Z = TI_X(wl, b); const int r = lane >> 2, c4 = (lane & 3) * 4; *(f4v*)(Z + r * TI_LD + c4) = (f4v){0.f, 0.f, 0.f, 0.f}; }
    }
    LBAR();
    if (!active) {} else if (wl == 0) ti_mm16(TI_T(0), TI_TLD, TI_A(1, 0), TI_LD, TI_X(0, 0), TI_LD, 1.f, nullptr, 0, lane);
    else if (wl == 1) ti_mm16(TI_T(1), TI_TLD, TI_A(3, 2), TI_LD, TI_X(2, 2), TI_LD, 1.f, nullptr, 0, lane);
    else if (wl == 2) ti_mm16(TI_T(2), TI_TLD, TI_A(2, 1), TI_LD, TI_X(1, 1), TI_LD, 1.f, nullptr, 0, lane);
    else ti_mm16(TI_T(3), TI_TLD, TI_A(3, 1), TI_LD, TI_X(1, 1), TI_LD, 1.f, nullptr, 0, lane);
    LBAR();
    if (!active) {} else if (wl == 0) ti_mm16(TI_X(1, 0), TI_LD, TI_X(1, 1), TI_LD, TI_T(0), TI_TLD, -1.f, nullptr, 0, lane);
    else if (wl == 1) ti_mm16(TI_X(3, 2), TI_LD, TI_X(3, 3), TI_LD, TI_T(1), TI_TLD, -1.f, nullptr, 0, lane);
    else if (wl == 2) ti_mm16(TI_T(4), TI_TLD, TI_A(2, 0), TI_LD, TI_X(0, 0), TI_LD, 1.f, nullptr, 0, lane);
    else ti_mm16(TI_T(5), TI_TLD, TI_A(3, 0), TI_LD, TI_X(0, 0), TI_LD, 1.f, nullptr, 0, lane);
    LBAR();
    if (!active) {} else if (wl == 0) ti_mm16(TI_T(6), TI_TLD, TI_A(2, 1), TI_LD, TI_X(1, 0), TI_LD, 1.f, TI_T(4), TI_TLD, lane);
    else if (wl == 1) ti_mm16(TI_T(7), TI_TLD, TI_A(3, 1), TI_LD, TI_X(1, 0), TI_LD, 1.f, TI_T(5), TI_TLD, lane);
    LBAR();
    if (!active) {} else if (wl == 0) ti_mm16(TI_X(2, 0), TI_LD, TI_X(2, 2), TI_LD, TI_T(6), TI_TLD, -1.f, nullptr, 0, lane);
    else if (wl == 1) ti_mm16(TI_X(2, 1), TI_LD, TI_X(2, 2), TI_LD, TI_T(2), TI_TLD, -1.f, nullptr, 0, lane);
    else if (wl == 2) ti_mm16(TI_T(0), TI_TLD, TI_X(3, 3), TI_LD, TI_T(7), TI_TLD, 1.f, nullptr, 0, lane);
    else ti_mm16(TI_T(1), TI_TLD, TI_X(3, 3), TI_LD, TI_T(3), TI_TLD, 1.f, nullptr, 0, lane);
    LBAR();
    if (!active) {} else if (wl == 2) { ti_mm16(TI_X(3, 0), TI_LD, TI_X(3, 2), TI_LD, TI_T(6), TI_TLD, -1.f, nullptr, 0, lane); }
    else if (wl == 3) { ti_mm16(TI_X(3, 1), TI_LD, TI_X(3, 2), TI_LD, TI_T(2), TI_TLD, -1.f, nullptr, 0, lane); }
    if (active && wl >= 2) {
        const int r = lane >> 2, c4 = (lane & 3) * 4;
        float* d = TI_X(3, wl - 2) + r * TI_LD + c4; const float* t = TI_T(wl - 2) + r * TI_TLD + c4;
        *(f4v*)d = *(const f4v*)d - *(const f4v*)t;
    }
    LBAR();
#undef TI_A
#undef TI_X
#undef TI_T
}

constexpr int GL_LD = 72;
__device__ __forceinline__ void gla_scan_task(const P& p, int ei, int s, int h, int dir, unsigned char* dsm) {
    bf16* LAt = (bf16*)dsm;
    bf16* Qd = LAt + 64 * GL_LD;
    bf16* Ki = Qd + 64 * GL_LD;
    bf16* KiT = Ki + 64 * GL_LD;
    bf16* Sc = KiT + 64 * GL_LD;
    bf16* VT = Sc + 64 * GL_LD;
    bf16* St = VT + 128 * GL_LD;
    float* sAE = (float*)(St + 128 * GL_LD);
    const Seq sq_ = get_seq(s);
    const int tid = opaque_tid(), lane = tid & 63, wid = tid >> 6, fr = lane & 15, fq = lane >> 4;
    const int rt = wid & 3, chf = wid >> 2;
    const bf16* proj = (const bf16*)(p.ws + WS_PROJ);
    bf16* opart = (bf16*)(p.ws + WS_PART + (size_t)dir * PART_SZ);
    s8v gfrag[2]; float gb[2];
    {
        const float* gup = p.in[I_GUP] + (size_t)(ei * 2 + dir) * 16 * 256 + h * 64;
        const float* gbias = p.in[I_GBIAS] + (size_t)(ei * 2 + dir) * 256 + h * 64;
#pragma unroll
        for (int c2 = 0; c2 < 2; ++c2) {
            const int d = 16 * (2 * chf + c2) + fr;
            gb[c2] = gbias[d];
#pragma unroll
            for (int j = 0; j < 8; ++j) gfrag[c2][j] = (short)f2bf(fq < 2 ? gup[(8 * fq + j) * 256 + d] : 0.f);
        }
    }
    f4v Sacc[4];
    LBAR();
    if (sq_.lat) {
        const float* s0 = p.in[I_SGLA] + ((((size_t)sq_.b * N_EVEN + ei) * 2 + dir) * 4 + h) * 64 * 128;
#pragma unroll
        for (int ct = 0; ct < 4; ++ct)
#pragma unroll
            for (int r = 0; r < 4; ++r) Sacc[ct][r] = s0[(16 * rt + fq * 4 + r) * 128 + 64 * chf + 16 * ct + fr];
    } else {
#pragma unroll
        for (int ct = 0; ct < 4; ++ct) Sacc[ct] = (f4v){0.f, 0.f, 0.f, 0.f};
    }
#pragma unroll
    for (int ct = 0; ct < 4; ++ct) *(uint2*)(St + (64 * chf + 16 * ct + fr) * GL_LD + 16 * rt + fq * 4) = make_uint2(pack2(Sacc[ct][0], Sacc[ct][1]), pack2(Sacc[ct][2], Sacc[ct][3]));
    const int nch = sq_.len >> 6;
    uint4 pv0, pv1, pq, pkk, pga;
#define GLA_FETCH(TB) do { \
        { const int i_ = lane, c8_ = wid * 8; const bf16* pr_ = proj + (size_t)((TB) + (dir ? 63 - i_ : i_)) * EW + E_V + h * 128 + c8_; \
          pv0 = *(const uint4*)pr_; pv1 = *(const uint4*)(pr_ + 64); } \
        { const int i_ = tid >> 3, c8_ = (tid & 7) * 8; const bf16* pr_ = proj + (size_t)((TB) + (dir ? 63 - i_ : i_)) * EW + h * 64 + c8_; \
          pq = *(const uint4*)(pr_ + E_Q); pkk = *(const uint4*)(pr_ + E_K); } \
        { const int i_ = 16 * rt + fr; pga = make_uint4(0u, 0u, 0u, 0u); if (fq < 2) pga = *(const uint4*)(proj + (size_t)((TB) + (dir ? 63 - i_ : i_)) * EW + E_GD + dir * 16 + fq * 8); } \
    } while (0)
    GLA_FETCH(sq_.start + (dir ? sq_.len - 64 : 0));
    for (int cc = 0; cc < nch; ++cc) {
        const int tb = sq_.start + (dir ? sq_.len - 64 - cc * 64 : cc * 64);
        {
            {
                const int i = lane, c8 = wid * 8;
                const f8v va = unpack8v(pv0), vb = unpack8v(pv1);
#pragma unroll
                for (int j = 0; j < 8; ++j) { VT[(c8 + j) * GL_LD + i] = f2bf(va[j]); VT[(64 + c8 + j) * GL_LD + i] = f2bf(vb[j]); }
            }
            { const int i = tid >> 3, c8 = (tid & 7) * 8; *(uint4*)(Qd + i * GL_LD + c8) = pq; *(uint4*)(Ki + i * GL_LD + c8) = pkk; }
            const s8v ga = __builtin_bit_cast(s8v, pga);
            if (cc + 1 < nch) GLA_FETCH(sq_.start + (dir ? sq_.len - 128 - cc * 64 : (cc + 1) * 64));
#pragma unroll
            for (int c2 = 0; c2 < 2; ++c2) {
                const f4v x = mfma16(ga, gfrag[c2], (f4v){0.f, 0.f, 0.f, 0.f});
                float la[4];
#pragma unroll
                for (int r = 0; r < 4; ++r) la[r] = logsigf_(x[r] + gb[c2]) * (1.0f / 16.0f);
                *(uint2*)(LAt + (16 * (2 * chf + c2) + fr) * GL_LD + 16 * rt + fq * 4) = make_uint2(pack2(la[0], la[1]), pack2(la[2], la[3]));
            }
        }
        LBAR();
        {
            f4v bc[2];
            bc[0] = (f4v){0.f, 0.f, 0.f, 0.f}; bc[1] = bc[0];
#pragma unroll
            for (int ks = 0; ks < 2; ++ks) {
                s8v lf;
#pragma unroll
                for (int j = 0; j < 8; ++j) lf[j] = (32 * ks + 8 * fq + j <= 16 * rt + fr) ? (short)0x3F80 : (short)0;
#pragma unroll
                for (int c2 = 0; c2 < 2; ++c2) bc[c2] = mfma16(lf, *(const s8v*)(LAt + (16 * (2 * chf + c2) + fr) * GL_LD + 32 * ks + 8 * fq), bc[c2]);
            }
#pragma unroll
            for (int c2 = 0; c2 < 2; ++c2) {
                const int d = 16 * (2 * chf + c2) + fr;
                float kiv[4];
#pragma unroll
                for (int r = 0; r < 4; ++r) {
                    const int i = 16 * rt + fq * 4 + r;
                    const float eb = fexp(bc[c2][r]);
                    const float qv = bf2f(Qd[i * GL_LD + d]) * 0.125f * eb;
                    kiv[r] = bf2f(Ki[i * GL_LD + d]) * frcp(eb);
                    Qd[i * GL_LD + d] = f2bf(qv); Ki[i * GL_LD + d] = f2bf(kiv[r]);
                    if (i == 63) sAE[d] = eb;
                }
                *(uint2*)(KiT + d * GL_LD + 16 * rt + fq * 4) = make_uint2(pack2(kiv[0], kiv[1]), pack2(kiv[2], kiv[3]));
            }
        }
        LBAR();
        f4v oacc[4];
        {
            f4v sc[2];
            sc[0] = (f4v){0.f, 0.f, 0.f, 0.f}; sc[1] = sc[0];
#pragma unroll
            for (int ct = 0; ct < 4; ++ct) oacc[ct] = (f4v){0.f, 0.f, 0.f, 0.f};
#pragma unroll
            for (int ks = 0; ks < 2; ++ks) {
                const s8v a = *(const s8v*)(Qd + (16 * rt + fr) * GL_LD + 32 * ks + 8 * fq);
#pragma unroll
                for (int c2 = 0; c2 < 2; ++c2) sc[c2] = mfma16(a, *(const s8v*)(Ki + (16 * (2 * chf + c2) + fr) * GL_LD + 32 * ks + 8 * fq), sc[c2]);
#pragma unroll
                for (int ct = 0; ct < 4; ++ct) oacc[ct] = mfma16(*(const s8v*)(St + (64 * chf + 16 * ct + fr) * GL_LD + 32 * ks + 8 * fq), a, oacc[ct]);
            }
#pragma unroll
            for (int c2 = 0; c2 < 2; ++c2)
#pragma unroll
                for (int r = 0; r < 4; ++r) { const int i = 16 * rt + fq * 4 + r, j = 16 * (2 * chf + c2) + fr; Sc[i * GL_LD + j] = f2bf(j <= i ? sc[c2][r] : 0.f); }
        }
        LBAR();
        {
#pragma unroll
            for (int ks = 0; ks < 2; ++ks) {
                const s8v a = *(const s8v*)(Sc + (16 * rt + fr) * GL_LD + 32 * ks + 8 * fq);
                const s8v kt = *(const s8v*)(KiT + (16 * rt + fr) * GL_LD + 32 * ks + 8 * fq);
#pragma unroll
                for (int ct = 0; ct < 4; ++ct) {
                    const s8v bv = *(const s8v*)(VT + (64 * chf + 16 * ct + fr) * GL_LD + 32 * ks + 8 * fq);
                    oacc[ct] = mfma16(bv, a, oacc[ct]); Sacc[ct] = mfma16(kt, bv, Sacc[ct]);
                }
            }
            {
                const int i = 16 * rt + fr, t = tb + (dir ? 63 - i : i);
#pragma unroll
                for (int ct = 0; ct < 4; ++ct) *(uint2*)(opart + (size_t)t * 512 + h * 128 + 64 * chf + 16 * ct + fq * 4) = pack4(oacc[ct]);
            }
            float ae[4];
#pragma unroll
            for (int r = 0; r < 4; ++r) ae[r] = sAE[16 * rt + fq * 4 + r];
#pragma unroll
            for (int ct = 0; ct < 4; ++ct) {
#pragma unroll
                for (int r = 0; r < 4; ++r) Sacc[ct][r] *= ae[r];
                *(uint2*)(St + (64 * chf + 16 * ct + fr) * GL_LD + 16 * rt + fq * 4) = make_uint2(pack2(Sacc[ct][0], Sacc[ct][1]), pack2(Sacc[ct][2], Sacc[ct][3]));
            }
        }
        LBAR();
    }
    if (!sq_.lat) {
        float* fs = p.out + OUT_GLA + ((((size_t)sq_.b * N_EVEN + ei) * 2 + dir) * 4 + h) * 64 * 128;
#pragma unroll
        for (int ct = 0; ct < 4; ++ct)
#pragma unroll
            for (int r = 0; r < 4; ++r) fs[(16 * rt + fq * 4 + r) * 128 + 64 * chf + 16 * ct + fr] = Sacc[ct][r];
    }
}

#ifndef RW_PREFETCH
#define RW_PREFETCH 1
#endif
constexpr int RW_LD = 72;
constexpr int RWKV_PREP_ITEMS = (T / 64) * 8;
struct RwPre { uint4 x[5], l[5], r[5]; };
__device__ __forceinline__ void rwkv_prefetch(const P& p, int w, int dir, int tid, RwPre& q) {
    const int cg = w >> 3, h = w & 7, hc0 = h * 64;
    const int i = tid >> 3, c8 = (tid & 7) * 8, t = cg * 64 + (dir ? 63 - i : i);
    bool hl, hr; tok_nbr(t, hl, hr);
    const bf16* proj = (const bf16*)(p.ws + WS_PROJ);
#pragma unroll
    for (int grp = 0; grp < 5; ++grp) {
        const int col = (grp == 0 ? FB_R + hc0 : grp == 1 ? FB_K + hc0 : grp == 2 ? FB_V + hc0 : grp == 3 ? FB_WD + dir * 64 : FB_AD + dir * 64) + c8;
        const bf16* pr = proj + (size_t)t * EW + E_FB + col;
        q.x[grp] = *(const uint4*)pr;
        q.l[grp] = hl ? *(const uint4*)(pr - EW) : make_uint4(0u, 0u, 0u, 0u);
        q.r[grp] = hr ? *(const uint4*)(pr + EW) : make_uint4(0u, 0u, 0u, 0u);
    }
}
__device__ __forceinline__ void rwkv_prep_phase(const P& p, int ei, int dir, int w_first, int w_stride, int w_end, unsigned char* dsm) {
    float* sCS = (float*)dsm;
    float* sKK = sCS + 4096;
    float* sB = sKK + 4096;
    float* sKM = sB + 4096;
    float* sR = sKM + 4096;
    float* sAf = (float*)dsm;
    float* sXf = sAf + 64 * TI_LD;
    float* sTmp = sXf + 64 * TI_LD;
    bf16* AakT = (bf16*)(sTmp + 8 * 16 * TI_TLD);
    bf16* Brb = AakT + 64 * RW_LD;
    bf16* Tm = Brb + 64 * RW_LD;
    bf16* PT = (bf16*)dsm;
    bf16* W1T = PT + 64 * RW_LD;
    static_assert(2 * 64 * TI_LD * 4 + 8 * 16 * TI_TLD * 4 + 3 * 64 * RW_LD * 2 <= 81920, "RWKV prep overlays exceed region A");
    bf16* At = (bf16*)(dsm + 81920);
    bf16* Bt = At + 64 * RW_LD;
    bf16* Kt = Bt + 64 * RW_LD;
    bf16* Rt = Kt + 64 * RW_LD;
    bf16* BhT = Rt + 64 * RW_LD;
    bf16* KhT = BhT + 64 * RW_LD;
    bf16* AtT = KhT + 64 * RW_LD;
    bf16* sTW = At;
    bf16* sAD = Bt;
    float* sSeg = (float*)(AtT + 64 * RW_LD);
    const int tid0 = opaque_tid();
    float* bonus = (float*)(p.ws + WS_BONUS);
    const float* mix = p.in[I_MIX] + (size_t)ei * 1792;
    int hcur = -1;
    s8v lrf[4][2];
    float lrb[4];
    RwPre pre;
#if RW_PREFETCH
    if (w_first < w_end) rwkv_prefetch(p, w_first, dir, tid0, pre);
#endif
    for (int w = w_first; w < w_end; w += w_stride) {
        const int tid = opaque_tid(), lane = tid & 63, wid = tid >> 6, fr = lane & 15, fq = lane >> 4;
        const int rt = wid & 3, cb = 2 * (wid >> 2), which = wid >> 2;
        const int cg = w >> 3, h = w & 7, hc0 = h * 64;
        const size_t tk = (size_t)cg * 8 + h;
        if (h != hcur) {
            hcur = h;
            LBAR();
            const float* w2 = p.in[I_W2] + (size_t)(ei * 2 + dir) * 64 * 512 + hc0; const float* a2 = p.in[I_A2] + (size_t)(ei * 2 + dir) * 64 * 512 + hc0;
            for (int e = tid; e < 4096; e += 512) { const int r = e >> 6, c = e & 63; Kt[c * RW_LD + r] = f2bf(w2[(size_t)r * 512 + c]); Rt[c * RW_LD + r] = f2bf(a2[(size_t)r * 512 + c]); }
            LBAR();
            const bf16* src = which ? Rt : Kt;
            const float* lb = (which ? p.in[I_A0] : p.in[I_W0]) + (size_t)(ei * 2 + dir) * 512 + hc0;
#pragma unroll
            for (int ct = 0; ct < 4; ++ct) {
                lrb[ct] = lb[16 * ct + fr];
#pragma unroll
                for (int ks = 0; ks < 2; ++ks) lrf[ct][ks] = *(const s8v*)(src + (16 * ct + fr) * RW_LD + ks * 32 + fq * 8);
            }
        }
        LBAR();
#if !RW_PREFETCH
        rwkv_prefetch(p, w, dir, tid, pre);
#endif
        {
            const int i = tid >> 3, c8 = (tid & 7) * 8, t = cg * 64 + (dir ? 63 - i : i);
#pragma unroll
            for (int grp = 0; grp < 5; ++grp) {
                const int col = (grp == 0 ? FB_R + hc0 : grp == 1 ? FB_K + hc0 : grp == 2 ? FB_V + hc0 : grp == 3 ? FB_WD + dir * 64 : FB_AD + dir * 64) + c8;
                const f8v x = unpack8v(pre.x[grp]);
                const f8v nb = unpack8v(pre.l[grp]) + unpack8v(pre.r[grp]);
                const f8v mv = *(const f8v*)(mix + col);
                f8v y = x + mv * (nb * 0.5f - x);
                if (grp == 0) *(f8v*)(sR + i * 64 + c8) = y;
                else if (grp == 1) *(f8v*)(sKM + i * 64 + c8) = y;
                else if (grp == 2) { if (dir == 0) *(uint4*)((bf16*)(p.ws + WS_VSH) + (size_t)t * 512 + hc0 + c8) = pack8v(y); }
                else {
                    if (grp == 3) {
#pragma unroll
                        for (int j = 0; j < 8; ++j) y[j] = ftanh(y[j]);
                    }
                    *(uint4*)((grp == 3 ? sTW : sAD) + i * RW_LD + c8) = pack8v(y);
                }
            }
        }
#if RW_PREFETCH
        if (w + w_stride < w_end) rwkv_prefetch(p, w + w_stride, dir, tid, pre);
#endif
        LBAR();
        {
            const bf16* Am = which ? sAD : sTW;
            f4v acc[4];
#pragma unroll
            for (int ct = 0; ct < 4; ++ct) acc[ct] = (f4v){0.f, 0.f, 0.f, 0.f};
#pragma unroll
            for (int ks = 0; ks < 2; ++ks) {
                const s8v a = *(const s8v*)(Am + (16 * rt + fr) * RW_LD + ks * 32 + fq * 8);
#pragma unroll
                for (int ct = 0; ct < 4; ++ct) acc[ct] = mfma16(a, lrf[ct][ks], acc[ct]);
            }
#pragma unroll
            for (int ct = 0; ct < 4; ++ct) {
                const int c = 16 * ct + fr;
#pragma unroll
                for (int r = 0; r < 4; ++r) {
                    const int tok = 16 * rt + fq * 4 + r;
                    const float sg = sigmoidf_(lrb[ct] + acc[ct][r]);
                    if (which) sB[tok * 64 + c] = sg; else sCS[tok * 64 + c] = -0.6065306597126334f * sg;
                }
            }
        }
        LBAR();
        {
            const int i = tid >> 3, c8 = (tid & 7) * 8;
            const float* kkw = p.in[I_KK] + (size_t)ei * 512 + hc0; const float* kaw = p.in[I_KA] + (size_t)ei * 512 + hc0; const float* rkw = p.in[I_RK] + (size_t)ei * 512 + hc0;
            const f8v av = *(const f8v*)(sB + i * 64 + c8), kr = *(const f8v*)(sKM + i * 64 + c8), rv = *(const f8v*)(sR + i * 64 + c8);
            const f8v kav = *(const f8v*)(kaw + c8), kkv = *(const f8v*)(kkw + c8), rkv = *(const f8v*)(rkw + c8);
            const f8v km = kr * (1.0f + (av - 1.0f) * kav);
            f8v kk = kr * kkv;
            float ss = 0.f, bn = 0.f;
#pragma unroll
            for (int j = 0; j < 8; ++j) { ss += kk[j] * kk[j]; bn += rv[j] * km[j] * rkv[j]; }
            ss = red8(ss); bn = red8(bn);
            kk *= frsq(ss + EPS);
            *(f8v*)(sKK + i * 64 + c8) = kk; *(f8v*)(sB + i * 64 + c8) = kk * av; *(f8v*)(sKM + i * 64 + c8) = km;
            if ((tid & 7) == 0) { const int t = cg * 64 + (dir ? 63 - i : i); bonus[((size_t)t * 8 + h) * 2 + dir] = bn; }
        }
        {
            const int c = tid & 63, sg = tid >> 6;
            float run = 0.f;
#pragma unroll
            for (int j = 0; j < 8; ++j) { run += sCS[(8 * sg + j) * 64 + c]; sCS[(8 * sg + j) * 64 + c] = run; }
            sSeg[sg * 64 + c] = run;
        }
        LBAR();
        {
            const int c = tid & 63, sg = tid >> 6;
            float off = 0.f;
            for (int q = 0; q < sg; ++q) off += sSeg[q * 64 + c];
#pragma unroll
            for (int j = 0; j < 8; ++j) sCS[(8 * sg + j) * 64 + c] += off;
        }
        LBAR();
        {
            const int i = tid >> 3, c8 = (tid & 7) * 8;
            const f8v cs = *(const f8v*)(sCS + i * 64 + c8), cl = *(const f8v*)(sCS + 63 * 64 + c8);
            f8v cp = (f8v)(0.f);
            if (i > 0) cp = *(const f8v*)(sCS + (i - 1) * 64 + c8);
            const f8v kk = *(const f8v*)(sKK + i * 64 + c8), bb = *(const f8v*)(sB + i * 64 + c8), km = *(const f8v*)(sKM + i * 64 + c8), rv = *(const f8v*)(sR + i * 64 + c8);
            f8v at, bt, kt, rtv;
#pragma unroll
            for (int j = 0; j < 8; ++j) {
                const float g = fexp(cs[j]), gi = frcp(g), gp = fexp(cp[j]), gc = fexp(cl[j]) * gi;
                at[j] = -kk[j] * gp; bt[j] = bb[j] * gi; kt[j] = km[j] * gi; rtv[j] = rv[j] * g;
                BhT[(c8 + j) * RW_LD + i] = f2bf(bb[j] * gc); KhT[(c8 + j) * RW_LD + i] = f2bf(km[j] * gc); AtT[(c8 + j) * RW_LD + i] = f2bf(at[j]);
            }
            *(uint4*)(At + i * RW_LD + c8) = pack8v(at); *(uint4*)(Bt + i * RW_LD + c8) = pack8v(bt);
            *(uint4*)(Kt + i * RW_LD + c8) = pack8v(kt); *(uint4*)(Rt + i * RW_LD + c8) = pack8v(rtv);
            if (i == 63) {
                float* gco = (float*)(p.ws + WS_GC) + tk * 64 + c8;
#pragma unroll
                for (int j = 0; j < 8; ++j) gco[j] = fexp(cl[j]);
            }
        }
        LBAR();
        f4v brkT[2];
        {
            f4v aab[2], aak[2], brb[2];
#pragma unroll
            for (int c2 = 0; c2 < 2; ++c2) { aab[c2] = (f4v){0.f, 0.f, 0.f, 0.f}; aak[c2] = aab[c2]; brb[c2] = aab[c2]; brkT[c2] = aab[c2]; }
#pragma unroll
            for (int ks = 0; ks < 2; ++ks) {
                const int ko = ks * 32 + fq * 8, ra = (16 * rt + fr) * RW_LD + ko;
                const s8v fa = *(const s8v*)(At + ra), frr = *(const s8v*)(Rt + ra), fk = *(const s8v*)(Kt + ra);
#pragma unroll
                for (int c2 = 0; c2 < 2; ++c2) {
                    const int ro = (16 * (cb + c2) + fr) * RW_LD + ko;
                    const s8v gb = *(const s8v*)(Bt + ro), gk = *(const s8v*)(Kt + ro), gr = *(const s8v*)(Rt + ro);
                    aab[c2] = mfma16(fa, gb, aab[c2]); aak[c2] = mfma16(fa, gk, aak[c2]); brb[c2] = mfma16(frr, gb, brb[c2]);
                    brkT[c2] = mfma16(fk, gr, brkT[c2]);
                }
            }
#pragma unroll
            for (int c2 = 0; c2 < 2; ++c2) {
                const int col = 16 * (cb + c2) + fr, r0 = 16 * rt + fq * 4;
                f4v ak;
#pragma unroll
                for (int r = 0; r < 4; ++r) {
                    const int row = r0 + r;
                    sAf[row * TI_LD + col] = col < row ? -aab[c2][r] : 0.f;
                    ak[r] = col < row ? aak[c2][r] : 0.f;
                    Brb[row * RW_LD + col] = f2bf(col <= row ? brb[c2][r] : 0.f);
                    if (!(row <= col)) brkT[c2][r] = 0.f;
                }
                *(uint2*)(AakT + col * RW_LD + r0) = pack4(ak);
            }
        }
        LBAR();
        tri_inv64(sAf, sXf, sTmp, wid & 3, lane, wid < 4);
        { const int i = tid >> 3, c8 = (tid & 7) * 8; *(uint4*)(Tm + i * RW_LD + c8) = pack8v(*(const f8v*)(sXf + i * TI_LD + c8)); }
        LBAR();
        {
            f4v pp[2], ww[2];
#pragma unroll
            for (int c2 = 0; c2 < 2; ++c2) { pp[c2] = (f4v){0.f, 0.f, 0.f, 0.f}; ww[c2] = pp[c2]; }
#pragma unroll
            for (int ks = 0; ks < 2; ++ks) {
                const int ko = ks * 32 + fq * 8;
                const s8v ft = *(const s8v*)(Tm + (16 * rt + fr) * RW_LD + ko);
#pragma unroll
                for (int c2 = 0; c2 < 2; ++c2) {
                    const int ro = (16 * (cb + c2) + fr) * RW_LD + ko;
                    pp[c2] = mfma16(ft, *(const s8v*)(AtT + ro), pp[c2]); ww[c2] = mfma16(ft, *(const s8v*)(AakT + ro), ww[c2]);
                }
            }
#pragma unroll
            for (int c2 = 0; c2 < 2; ++c2) {
                const int col = 16 * (cb + c2) + fr;
                *(uint2*)(PT + col * RW_LD + 16 * rt + fq * 4) = pack4(pp[c2]);
                *(uint2*)(W1T + col * RW_LD + 16 * rt + fq * 4) = pack4(ww[c2]);
            }
        }
        LBAR();
        {
            bf16* m12 = (bf16*)(p.ws + WS_RM12) + tk * 8192; bf16* m34 = (bf16*)(p.ws + WS_RM34) + tk * 8192;
#pragma unroll
            for (int c2 = 0; c2 < 2; ++c2) {
                const int col = 16 * (cb + c2) + fr, r0 = 16 * rt + fq * 4;
                f4v m1 = unpack4(*(const uint2*)(Rt + col * RW_LD + r0));
                f4v m2 = brkT[c2], m3 = (f4v){0.f, 0.f, 0.f, 0.f};
                f4v m4 = unpack4(*(const uint2*)(KhT + col * RW_LD + r0));
#pragma unroll
                for (int ks = 0; ks < 2; ++ks) {
                    const int ko = ks * 32 + fq * 8;
                    const s8v fp = *(const s8v*)(PT + (16 * rt + fr) * RW_LD + ko), fw = *(const s8v*)(W1T + (16 * rt + fr) * RW_LD + ko);
                    const s8v gb = *(const s8v*)(Brb + col * RW_LD + ko), gh = *(const s8v*)(BhT + col * RW_LD + ko);
                    m1 = mfma16(fp, gb, m1);
                    m2 = mfma16(fw, gb, m2);
                    m3 = mfma16(fp, gh, m3);
                    m4 = mfma16(fw, gh, m4);
                }
                *(uint2*)(m12 + col * 64 + r0) = pack4(m1);
                *(uint2*)(m12 + 4096 + col * 64 + r0) = pack4(m2);
                *(uint2*)(m34 + col * 64 + r0) = pack4(m3);
                *(uint2*)(m34 + 4096 + col * 64 + r0) = pack4(m4);
            }
        }
    }
}
__device__ __forceinline__ void rwkv_apply_task(const P& p, int ei, int s, int h, int dir, unsigned char* dsm) {
    bf16* St = (bf16*)dsm;
    bf16* VT = St + 64 * RW_LD;
    bf16* M1 = VT + 64 * RW_LD;
    bf16* M2 = M1 + 64 * RW_LD;
    bf16* M3 = M2 + 64 * RW_LD;
    bf16* M4 = M3 + 64 * RW_LD;
    float* sGC = (float*)(M4 + 64 * RW_LD);
    const Seq sq_ = get_seq(s);
    const int tid = opaque_tid(), lane = tid & 63, wid = tid >> 6, fr = lane & 15, fq = lane >> 4;
    const int rt = wid & 3, cb = 2 * (wid >> 2), hc0 = h * 64;
    bf16* opart = (bf16*)(p.ws + WS_PART + (size_t)(2 + dir) * PART_SZ);
    f4v Sacc[2];
    LBAR();
#pragma unroll
    for (int c2 = 0; c2 < 2; ++c2) {
        const int v = 16 * (cb + c2) + fr, k0 = 16 * rt + fq * 4;
        if (sq_.lat) Sacc[c2] = *(const f4v*)(p.in[I_SRWKV] + ((((size_t)sq_.b * N_EVEN + ei) * 2 + dir) * 8 + h) * 4096 + v * 64 + k0);
        else Sacc[c2] = (f4v){0.f, 0.f, 0.f, 0.f};
        *(uint2*)(St + v * RW_LD + k0) = make_uint2(pack2(Sacc[c2][0], Sacc[c2][1]), pack2(Sacc[c2][2], Sacc[c2][3]));
    }
    const int nch = sq_.len >> 6;
    uint4 pm0, pm1, pm2, pm3, pvv; float pgc = 0.f;
    {
        const int cg0 = (sq_.start >> 6) + (dir ? nch - 1 : 0); const size_t tk0 = (size_t)cg0 * 8 + h;
        const int i = tid >> 3, c8 = (tid & 7) * 8;
        const bf16* m12 = (const bf16*)(p.ws + WS_RM12) + tk0 * 8192; const bf16* m34 = (const bf16*)(p.ws + WS_RM34) + tk0 * 8192;
        pm0 = *(const uint4*)(m12 + i * 64 + c8); pm1 = *(const uint4*)(m12 + 4096 + i * 64 + c8); pm2 = *(const uint4*)(m34 + i * 64 + c8); pm3 = *(const uint4*)(m34 + 4096 + i * 64 + c8);
        pvv = *(const uint4*)((const bf16*)(p.ws + WS_VSH) + (size_t)(cg0 * 64 + (dir ? 63 - lane : lane)) * 512 + hc0 + wid * 8);
        if (tid < 64) pgc = ((const float*)(p.ws + WS_GC))[tk0 * 64 + tid];
    }
    for (int cc = 0; cc < nch; ++cc) {
        const int cg = (sq_.start >> 6) + (dir ? nch - 1 - cc : cc);
        {
            const int i = tid >> 3, c8 = (tid & 7) * 8;
            *(uint4*)(M1 + i * RW_LD + c8) = pm0; *(uint4*)(M2 + i * RW_LD + c8) = pm1; *(uint4*)(M3 + i * RW_LD + c8) = pm2; *(uint4*)(M4 + i * RW_LD + c8) = pm3;
            const f8v vv = unpack8v(pvv);
#pragma unroll
            for (int j = 0; j < 8; ++j) VT[(wid * 8 + j) * RW_LD + lane] = f2bf(vv[j]);
            if (tid < 64) sGC[tid] = pgc;
            if (cc + 1 < nch) {
                const int cgn = (sq_.start >> 6) + (dir ? nch - 2 - cc : cc + 1); const size_t tkn = (size_t)cgn * 8 + h;
                const bf16* m12 = (const bf16*)(p.ws + WS_RM12) + tkn * 8192; const bf16* m34 = (const bf16*)(p.ws + WS_RM34) + tkn * 8192;
                pm0 = *(const uint4*)(m12 + i * 64 + c8); pm1 = *(const uint4*)(m12 + 4096 + i * 64 + c8); pm2 = *(const uint4*)(m34 + i * 64 + c8); pm3 = *(const uint4*)(m34 + 4096 + i * 64 + c8);
                pvv = *(const uint4*)((const bf16*)(p.ws + WS_VSH) + (size_t)(cgn * 64 + (dir ? 63 - lane : lane)) * 512 + hc0 + wid * 8);
                if (tid < 64) pgc = ((const float*)(p.ws + WS_GC))[tkn * 64 + tid];
            }
        }
        LBAR();
        {
            f4v yT[2], sn[2];
#pragma unroll
            for (int c2 = 0; c2 < 2; ++c2) { yT[c2] = (f4v){0.f, 0.f, 0.f, 0.f}; sn[c2] = yT[c2]; }
#pragma unroll
            for (int ks = 0; ks < 2; ++ks) {
                const int ko = ks * 32 + fq * 8;
                const s8v fs = *(const s8v*)(St + (16 * rt + fr) * RW_LD + ko), fv = *(const s8v*)(VT + (16 * rt + fr) * RW_LD + ko);
                const s8v f3 = *(const s8v*)(M3 + (16 * rt + fr) * RW_LD + ko), f4 = *(const s8v*)(M4 + (16 * rt + fr) * RW_LD + ko);
#pragma unroll
                for (int c2 = 0; c2 < 2; ++c2) {
                    const int ro = (16 * (cb + c2) + fr) * RW_LD + ko;
                    yT[c2] = mfma16(fs, *(const s8v*)(M1 + ro), yT[c2]); yT[c2] = mfma16(fv, *(const s8v*)(M2 + ro), yT[c2]);
                    sn[c2] = mfma16(f3, *(const s8v*)(St + ro), sn[c2]); sn[c2] = mfma16(f4, *(const s8v*)(VT + ro), sn[c2]);
                }
            }
            float gc[4];
#pragma unroll
            for (int r = 0; r < 4; ++r) gc[r] = sGC[16 * rt + fq * 4 + r];
#pragma unroll
            for (int c2 = 0; c2 < 2; ++c2) {
                const int tt = 16 * (cb + c2) + fr, t = cg * 64 + (dir ? 63 - tt : tt);
                *(uint2*)(opart + (size_t)t * 512 + hc0 + 16 * rt + fq * 4) = make_uint2(pack2(yT[c2][0], yT[c2][1]), pack2(yT[c2][2], yT[c2][3]));
#pragma unroll
                for (int r = 0; r < 4; ++r) Sacc[c2][r] = Sacc[c2][r] * gc[r] + sn[c2][r];
            }
        }
        LBAR();
#pragma unroll
        for (int c2 = 0; c2 < 2; ++c2) *(uint2*)(St + (16 * (cb + c2) + fr) * RW_LD + 16 * rt + fq * 4) = make_uint2(pack2(Sacc[c2][0], Sacc[c2][1]), pack2(Sacc[c2][2], Sacc[c2][3]));
    }
    if (!sq_.lat) {
#pragma unroll
        for (int c2 = 0; c2 < 2; ++c2)
            *(f4v*)(p.out + OUT_RWKV + ((((size_t)sq_.b * N_EVEN + ei) * 2 + dir) * 8 + h) * 4096 + (16 * (cb + c2) + fr) * 64 + 16 * rt + fq * 4) = Sacc[c2];
    }
}
constexpr int EV_AP_LAT = NB_LAT * 8, EV_AP_CTX = NB_CTX * 8, EV_GLA_LAT = NB_LAT * 4, EV_GLA_CTX = NB_CTX * 4;
constexpr int EVEN_SCAN_ITEMS = EV_AP_LAT + EV_GLA_LAT + EV_AP_CTX + EV_GLA_CTX;
__device__ __forceinline__ void ph_even_scan_item(const P& p, int w, int ei, int dir, unsigned char* dsm) {
    int kind, sbase, x;
    if (w < EV_AP_LAT) { kind = 0; sbase = NB_CTX; x = w; }
    else if (w < EV_AP_LAT + EV_GLA_LAT) { kind = 1; sbase = NB_CTX; x = w - EV_AP_LAT; }
    else if (w < EV_AP_LAT + EV_GLA_LAT + EV_AP_CTX) { kind = 0; sbase = 0; x = w - EV_AP_LAT - EV_GLA_LAT; }
    else { kind = 1; sbase = 0; x = w - EV_AP_LAT - EV_GLA_LAT - EV_AP_CTX; }
    if (kind == 0) rwkv_apply_task(p, ei, sbase + x / 8, x & 7, dir, dsm);
    else gla_scan_task(p, ei, sbase + x / 4, x & 3, dir, dsm);
}

__device__ __forceinline__ void ph_fin_even(const P& p, int bid, int ei) {
    const int lane = LT & 63, t = bid * 4 + (LT >> 6);
    if (t >= T) return;
    const bf16* pr = (const bf16*)(p.ws + WS_PROJ) + (size_t)t * EW;
    const bf16* oaf = (const bf16*)(p.ws + WS_PART) + (size_t)t * 512;
    const bf16* oab = (const bf16*)(p.ws + WS_PART + PART_SZ) + (size_t)t * 512;
    const bf16* obf = (const bf16*)(p.ws + WS_PART + 2 * PART_SZ) + (size_t)t * 512;
    const bf16* obb = (const bf16*)(p.ws + WS_PART + 3 * PART_SZ) + (size_t)t * 512;
    bf16* yc = (bf16*)(p.ws + WS_HM) + (size_t)t * D;
    const int idx = lane * 8;
    {
        float o[8], ss = 0.f;
#pragma unroll
        for (int j = 0; j < 8; ++j) { o[j] = bf2f(oaf[idx + j]) + bf2f(oab[idx + j]); ss += o[j] * o[j]; }
        ss += __shfl_xor(ss, 1); ss += __shfl_xor(ss, 2); ss += __shfl_xor(ss, 4); ss += __shfl_xor(ss, 8);
        const float r = frsq(ss * (1.0f / 128.f) + EPS);
        const float* gn = p.in[I_GLAN] + ei * 128 + (idx & 127);
#pragma unroll
        for (int j = 0; j < 8; ++j) yc[idx + j] = f2bf(o[j] * r * gn[j] * siluf_(bf2f(pr[E_ZA + idx + j])));
    }
    {
        float o[8], mu = 0.f;
#pragma unroll
        for (int j = 0; j < 8; ++j) { o[j] = bf2f(obf[idx + j]) + bf2f(obb[idx + j]); mu += o[j]; }
        mu += __shfl_xor(mu, 1); mu += __shfl_xor(mu, 2); mu += __shfl_xor(mu, 4);
        mu *= (1.0f / 64.f);
        float var = 0.f;
#pragma unroll
        for (int j = 0; j < 8; ++j) { o[j] -= mu; var += o[j] * o[j]; }
        var += __shfl_xor(var, 1); var += __shfl_xor(var, 2); var += __shfl_xor(var, 4);
        const float r = frsq(var * (1.0f / 64.f) + 64e-5f);
        const int h = idx >> 6;
        const float* bn = (const float*)(p.ws + WS_BONUS) + ((size_t)t * 8 + h) * 2;
        const float bsum = bn[0] + bn[1];
        bool hl, hr; tok_nbr(t, hl, hr);
        const float* mix = p.in[I_MIX] + (size_t)ei * 1792 + FB_V + idx;
        const float* lg = p.in[I_LNG] + ei * 512 + idx;
        const float* lb = p.in[I_LNB] + ei * 512 + idx;
#pragma unroll
        for (int j = 0; j < 8; ++j) {
            const bf16* pv = pr + E_FB + FB_V + idx + j;
            const float x = bf2f(pv[0]);
            const float nl = hl ? bf2f(pv[-EW]) : 0.f, nr = hr ? bf2f(pv[EW]) : 0.f;
            const float vsh = x + mix[j] * (0.5f * (nl + nr) - x);
            yc[512 + idx + j] = f2bf((o[j] * r * lg[j] + lb[j] + bsum * vsh) * siluf_(bf2f(pr[E_ZB + idx + j])));
        }
    }
}

constexpr int ODD_PREP_ITEMS = (T / 64) * 4;
constexpr int PQ_LD = 136;
__device__ __forceinline__ void ph_odd_prep(const P& p, int item, int oi, unsigned char* dsm) {
    bf16* sq = (bf16*)dsm;
    bf16* sk = sq + 64 * PQ_LD;
    float* sA = (float*)(dsm + 2 * 64 * PQ_LD * 2);
    float* sX = sA + 2 * 64 * TI_LD;
    float* sTm = sX + 2 * 64 * TI_LD;
    float* slg = sTm + 2 * 8 * 16 * TI_TLD;
    float* sbt = slg + 128;
    float* sgc = sbt + 128;
    float* sbp = sgc + 128;
    const int tid = opaque_tid(), lane = tid & 63, wid = tid >> 6;
    const int cg = item >> 2, h = item & 3;
    const bf16* proj = (const bf16*)(p.ws + WS_PROJ);
    const float* cw = p.in[I_CONV] + (size_t)oi * 9 * 1536;
    LBAR();
    {
        const int i = tid >> 3, sub = tid & 7, t = cg * 64 + i;
        const bool lat = t >= T_CTX;
        int pos, len;
        if (!lat) { pos = t % L_CTX; len = L_CTX; } else { pos = (t - T_CTX) % L_LAT; len = L_LAT; }
        const int gr = pos >> 6, gcl = pos & 63, nrows = len >> 6;
        bf16* qo = (bf16*)(p.ws + WS_QKVN) + (size_t)t * 1536;
#pragma unroll
        for (int part = 0; part < 3; ++part) {
            const int ch = part * 512 + h * 128 + sub * 16;
            f8v a0 = (f8v)(0.f), a1 = (f8v)(0.f);
            for (int di = (lat ? -1 : 0); di <= (lat ? 1 : 0); ++di)
                for (int dj = -1; dj <= 1; ++dj) {
                    bool ok;
                    if (lat) ok = (gr + di >= 0) && (gr + di < nrows) && (gcl + dj >= 0) && (gcl + dj < 64);
                    else ok = (pos + dj >= 0) && (pos + dj < len);
                    if (!ok) continue;
                    const bf16* src = proj + (size_t)(t + di * 64 + dj) * OW + O_QKV + ch;
                    const float* w = cw + ((di + 1) * 3 + (dj + 1)) * 1536 + ch;
                    const f8v x0 = unpack8v(*(const uint4*)src), x1 = unpack8v(*(const uint4*)(src + 8));
                    const f8v w0 = *(const f8v*)w, w1 = *(const f8v*)(w + 8);
                    a0 += x0 * w0; a1 += x1 * w1;
                }
            float ss = 0.f;
#pragma unroll
            for (int j = 0; j < 8; ++j) { a0[j] = siluf_(a0[j]); a1[j] = siluf_(a1[j]); ss += a0[j] * a0[j] + a1[j] * a1[j]; }
            if (part < 2) {
                ss += __shfl_xor(ss, 1); ss += __shfl_xor(ss, 2); ss += __shfl_xor(ss, 4);
                float r = frsq(ss + EPS);
                if (part == 0) r *= 0.08838834764831845f;
                a0 *= r; a1 *= r;
            }
            const uint4 p0 = pack8v(a0), p1 = pack8v(a1);
            *(uint4*)(qo + ch) = p0; *(uint4*)(qo + ch + 8) = p1;
            if (part == 0) { *(uint4*)(sq + i * PQ_LD + sub * 16) = p0; *(uint4*)(sq + i * PQ_LD + sub * 16 + 8) = p1; }
            if (part == 1) { *(uint4*)(sk + i * PQ_LD + sub * 16) = p0; *(uint4*)(sk + i * PQ_LD + sub * 16 + 8) = p1; }
        }
        if (sub < 2) {
            const int dir = sub;
            float* g = (float*)(p.ws + WS_GATES) + (size_t)t * 16;
            const float x = bf2f(proj[(size_t)t * OW + O_G + dir * 4 + h]);
            const float lgv = -fexp(p.in[I_ALOG][oi * 8 + dir * 4 + h]) * softplusf_(x + p.in[I_DTB][oi * 8 + dir * 4 + h]);
            const float bv = sigmoidf_(bf2f(proj[(size_t)t * OW + O_BETA + dir * 4 + h]));
            g[dir * 4 + h] = lgv; g[8 + dir * 4 + h] = bv;
            slg[dir * 64 + i] = lgv; sbt[dir * 64 + i] = bv;
        }
    }
    LBAR();
    if (tid < 2) {
        const int dir = tid; float c = 0.f;
        for (int i = 0; i < 64; ++i) { const int n = dir ? 63 - i : i; c += slg[dir * 64 + n]; sgc[dir * 64 + i] = c; sbp[dir * 64 + i] = sbt[dir * 64 + n]; }
    }
    LBAR();
    {
        const int rt = wid & 3, fr = lane & 15, fq = lane >> 4;
        f4v acc[4];
#pragma unroll
        for (int ct = 0; ct < 4; ++ct) acc[ct] = (f4v){0.f, 0.f, 0.f, 0.f};
#pragma unroll
        for (int ks = 0; ks < 4; ++ks) {
            const s8v a = *(const s8v*)((wid < 4 ? sk : sq) + (16 * rt + fr) * PQ_LD + fq * 8 + ks * 32);
#pragma unroll
            for (int ct = 0; ct < 4; ++ct) {
                const s8v bb = *(const s8v*)(sk + (16 * ct + fr) * PQ_LD + fq * 8 + ks * 32);
                acc[ct] = (wid < 4) ? mfma16(a, bb, acc[ct]) : mfma16(bb, a, acc[ct]);
            }
        }
        const size_t task0 = ((size_t)cg * 4 + h) * 2;
        bf16* qk0 = (bf16*)(p.ws + WS_QKM) + task0 * 4096; bf16* qk1 = qk0 + 4096;
        if (wid < 4) {
#pragma unroll
            for (int ct = 0; ct < 4; ++ct)
#pragma unroll
                for (int r = 0; r < 4; ++r) {
                    const int a = 16 * rt + fq * 4 + r, b = 16 * ct + fr, i1 = 63 - a, j1 = 63 - b;
                    const float v = acc[ct][r];
                    if (b < a) sA[a * TI_LD + b] = sbp[a] * v * fexp(sgc[a] - sgc[b]);
                    if (b > a) sA[64 * TI_LD + i1 * TI_LD + j1] = sbp[64 + i1] * v * fexp(sgc[64 + i1] - sgc[64 + j1]);
                }
        } else {
            const int a = 16 * rt + fr, i1 = 63 - a;
            const float ga0 = sgc[a], ga1 = sgc[64 + i1];
#pragma unroll
            for (int ct = 0; ct < 4; ++ct) {
                const int b0 = 16 * ct + fq * 4;
                f4v v0, v1;
#pragma unroll
                for (int r = 0; r < 4; ++r) {
                    const int b = b0 + r, j1 = 63 - b;
                    const float v = acc[ct][r];
                    v0[r] = b <= a ? v * fexp(ga0 - sgc[b]) : 0.f;
                    v1[3 - r] = b >= a ? v * fexp(ga1 - sgc[64 + j1]) : 0.f;
                }
                *(uint2*)(qk0 + a * 64 + b0) = pack4(v0);
                *(uint2*)(qk1 + i1 * 64 + 60 - b0) = pack4(v1);
            }
        }
    }
    LBAR();
    if (wid == 2) {
        float* gco = (float*)(p.ws + WS_GC) + ((size_t)cg * 4 + h) * 128;
        gco[lane] = sgc[lane]; gco[64 + lane] = sgc[64 + lane];
    }
    tri_inv64(sA + (wid >> 2) * 64 * TI_LD, sX + (wid >> 2) * 64 * TI_LD, sTm + (wid >> 2) * 8 * 16 * TI_TLD, wid & 3, lane, true);
    {
        const int dir = tid >> 8, i = (tid >> 2) & 63, c16 = (tid & 3) * 16;
        const float* xs = sX + dir * 64 * TI_LD + i * TI_LD + c16;
        bf16* ti = (bf16*)(p.ws + WS_TINV) + (((size_t)cg * 4 + h) * 2 + dir) * 4096 + i * 64 + c16;
        *(uint4*)ti = pack8v(*(const f8v*)xs); *(uint4*)(ti + 8) = pack8v(*(const f8v*)(xs + 8));
    }
}

constexpr int G_LDS = 136, G_LDT = 72;
__device__ __forceinline__ void gdn_scan_task(const P& p, int oi, int s, int h, int dir, unsigned char* dsm) {
    bf16* St = (bf16*)dsm;
    bf16* Kc = St + 128 * G_LDS;
    bf16* Qc = Kc + 64 * G_LDS;
    bf16* KeT = Qc + 64 * G_LDS;
    bf16* rT = KeT + 128 * G_LDT;
    bf16* dT = rT + 128 * G_LDT;
    bf16* Vc = dT;
    bf16* Ti = dT + 128 * G_LDT;
    bf16* Qk = Ti + 64 * G_LDT;
    float* sgc = (float*)(Qk + 64 * G_LDT);
    float* sbt = sgc + 64;
    const Seq sq_ = get_seq(s);
    const int tid = opaque_tid(), lane = tid & 63, wid = tid >> 6, fr = lane & 15, fq = lane >> 4;
    const int rt = wid & 3, chf = wid >> 2;
    const bf16* qkvn = (const bf16*)(p.ws + WS_QKVN);
    const float* gates = (const float*)(p.ws + WS_GATES);
    bf16* opart = (bf16*)(p.ws + WS_PART + (size_t)dir * PART_SZ);
    f4v Sacc[8];
    LBAR();
    if (sq_.lat) {
        const float* s0 = p.in[I_SGDN] + ((((size_t)sq_.b * N_ODD + oi) * 2 + dir) * 4 + h) * 128 * 128;
#pragma unroll
        for (int ct = 0; ct < 8; ++ct)
#pragma unroll
            for (int r = 0; r < 4; ++r) Sacc[ct][r] = s0[(16 * wid + fq * 4 + r) * 128 + 16 * ct + fr];
    } else {
#pragma unroll
        for (int ct = 0; ct < 8; ++ct) Sacc[ct] = (f4v){0.f, 0.f, 0.f, 0.f};
    }
#pragma unroll
    for (int ct = 0; ct < 8; ++ct) *(uint2*)(St + (16 * ct + fr) * G_LDS + 16 * wid + fq * 4) = make_uint2(pack2(Sacc[ct][0], Sacc[ct][1]), pack2(Sacc[ct][2], Sacc[ct][3]));
    const int nch = sq_.len >> 6;
    uint4 pq0, pq1, pk0, pk1, pw0, pw1, pti, pqk; float pgi, pgl, pbt = 0.f;
#define GDN_FETCH(CG) do { const size_t task_ = ((size_t)(CG) * 4 + h) * 2 + dir; const int t_ = (CG) * 64 + (dir ? 63 - lane : lane); \
        const bf16* src_ = qkvn + (size_t)t_ * 1536 + h * 128 + wid * 8; \
        pq0 = *(const uint4*)src_; pq1 = *(const uint4*)(src_ + 64); pk0 = *(const uint4*)(src_ + 512); pk1 = *(const uint4*)(src_ + 576); pw0 = *(const uint4*)(src_ + 1024); pw1 = *(const uint4*)(src_ + 1088); \
        { const int i2_ = tid >> 3, c8_ = (tid & 7) * 8; pti = *(const uint4*)((const bf16*)(p.ws + WS_TINV) + task_ * 4096 + i2_ * 64 + c8_); pqk = *(const uint4*)((const bf16*)(p.ws + WS_QKM) + task_ * 4096 + i2_ * 64 + c8_); } \
        const float* gcp_ = (const float*)(p.ws + WS_GC) + task_ * 64; pgi = gcp_[lane]; pgl = gcp_[63]; \
        if (tid < 64) pbt = gates[(size_t)((CG) * 64 + (dir ? 63 - tid : tid)) * 16 + 8 + dir * 4 + h]; } while (0)
    GDN_FETCH((sq_.start >> 6) + (dir ? nch - 1 : 0));
    for (int cc = 0; cc < nch; ++cc) {
        const int cl = dir ? nch - 1 - cc : cc;
        const int cg = (sq_.start >> 6) + cl;
        {
            const int i = lane;
            const float sc = fexp(pgl - pgi);
#pragma unroll
            for (int rep = 0; rep < 2; ++rep) {
                const int c8 = (wid + 8 * rep) * 8;
                const uint4 qv = rep ? pq1 : pq0, kv = rep ? pk1 : pk0, vv = rep ? pw1 : pw0;
                *(uint4*)(Qc + i * G_LDS + c8) = qv; *(uint4*)(Kc + i * G_LDS + c8) = kv; *(uint4*)(Vc + i * G_LDS + c8) = vv;
                const f8v kf = unpack8v(kv);
#pragma unroll
                for (int j = 0; j < 8; ++j) KeT[(c8 + j) * G_LDT + i] = f2bf(kf[j] * sc);
            }
            { const int i2 = tid >> 3, c8 = (tid & 7) * 8; *(uint4*)(Ti + i2 * G_LDT + c8) = pti; *(uint4*)(Qk + i2 * G_LDT + c8) = pqk; }
            if (tid < 64) { sgc[tid] = pgi; sbt[tid] = pbt; }
            if (cc + 1 < nch) { const int cln = dir ? nch - 2 - cc : cc + 1; GDN_FETCH((sq_.start >> 6) + cln); }
        }
        LBAR();
        f4v oacc[4];
        {
            f4v kS[4], qS[4];
#pragma unroll
            for (int ct = 0; ct < 4; ++ct) { kS[ct] = (f4v){0.f, 0.f, 0.f, 0.f}; qS[ct] = (f4v){0.f, 0.f, 0.f, 0.f}; }
#pragma unroll
            for (int ks = 0; ks < 4; ++ks) {
                const s8v ak = *(const s8v*)(Kc + (16 * rt + fr) * G_LDS + ks * 32 + fq * 8);
                const s8v aq = *(const s8v*)(Qc + (16 * rt + fr) * G_LDS + ks * 32 + fq * 8);
#pragma unroll
                for (int ct = 0; ct < 4; ++ct) {
                    const s8v bb = *(const s8v*)(St + (64 * chf + 16 * ct + fr) * G_LDS + ks * 32 + fq * 8);
                    kS[ct] = mfma16(ak, bb, kS[ct]);
                    qS[ct] = mfma16(bb, aq, qS[ct]);
                }
            }
            float eg[4], bt[4];
#pragma unroll
            for (int r = 0; r < 4; ++r) { const int i = 16 * rt + fq * 4 + r; eg[r] = fexp(sgc[i]); bt[r] = sbt[i]; }
            const float egc = fexp(sgc[16 * rt + fr]);
#pragma unroll
            for (int ct = 0; ct < 4; ++ct) {
                const int dv = 64 * chf + 16 * ct + fr;
                float rv[4];
#pragma unroll
                for (int r = 0; r < 4; ++r) { const int i = 16 * rt + fq * 4 + r; rv[r] = bt[r] * (bf2f(Vc[i * G_LDS + dv]) - eg[r] * kS[ct][r]); oacc[ct][r] = egc * qS[ct][r]; }
                *(uint2*)(rT + dv * G_LDT + 16 * rt + fq * 4) = make_uint2(pack2(rv[0], rv[1]), pack2(rv[2], rv[3]));
            }
        }
        LBAR();
        {
            f4v dl[4];
#pragma unroll
            for (int ct = 0; ct < 4; ++ct) dl[ct] = (f4v){0.f, 0.f, 0.f, 0.f};
#pragma unroll
            for (int ks = 0; ks < 2; ++ks) {
                const s8v a = *(const s8v*)(Ti + (16 * rt + fr) * G_LDT + ks * 32 + fq * 8);
#pragma unroll
                for (int ct = 0; ct < 4; ++ct) { const s8v bb = *(const s8v*)(rT + (64 * chf + 16 * ct + fr) * G_LDT + ks * 32 + fq * 8); dl[ct] = mfma16(a, bb, dl[ct]); }
            }
#pragma unroll
            for (int ct = 0; ct < 4; ++ct) { const int dv = 64 * chf + 16 * ct + fr;
                *(uint2*)(dT + dv * G_LDT + 16 * rt + fq * 4) = make_uint2(pack2(dl[ct][0], dl[ct][1]), pack2(dl[ct][2], dl[ct][3])); }
        }
        LBAR();
        {
#pragma unroll
            for (int ks = 0; ks < 2; ++ks) {
                const s8v a = *(const s8v*)(Qk + (16 * rt + fr) * G_LDT + ks * 32 + fq * 8);
#pragma unroll
                for (int ct = 0; ct < 4; ++ct) { const s8v bb = *(const s8v*)(dT + (64 * chf + 16 * ct + fr) * G_LDT + ks * 32 + fq * 8); oacc[ct] = mfma16(bb, a, oacc[ct]); }
            }
            {
                const int i = 16 * rt + fr, t = cg * 64 + (dir ? 63 - i : i);
#pragma unroll
                for (int ct = 0; ct < 4; ++ct) *(uint2*)(opart + (size_t)t * 512 + h * 128 + 64 * chf + 16 * ct + fq * 4) = pack4(oacc[ct]);
            }
            const float ge = fexp(sgc[63]);
#pragma unroll
            for (int ct = 0; ct < 8; ++ct) Sacc[ct] *= ge;
#pragma unroll
            for (int ks = 0; ks < 2; ++ks) {
                const s8v a = *(const s8v*)(KeT + (16 * wid + fr) * G_LDT + ks * 32 + fq * 8);
#pragma unroll
                for (int ct = 0; ct < 8; ++ct) { const s8v bb = *(const s8v*)(dT + (16 * ct + fr) * G_LDT + ks * 32 + fq * 8); Sacc[ct] = mfma16(a, bb, Sacc[ct]); }
            }
#pragma unroll
            for (int ct = 0; ct < 8; ++ct) *(uint2*)(St + (16 * ct + fr) * G_LDS + 16 * wid + fq * 4) = make_uint2(pack2(Sacc[ct][0], Sacc[ct][1]), pack2(Sacc[ct][2], Sacc[ct][3]));
        }
        LBAR();
    }
    if (!sq_.lat) {
        float* fs = p.out + OUT_GDN + ((((size_t)sq_.b * N_ODD + oi) * 2 + dir) * 4 + h) * 128 * 128;
#pragma unroll
        for (int ct = 0; ct < 8; ++ct)
#pragma unroll
            for (int r = 0; r < 4; ++r) fs[(16 * wid + fq * 4 + r) * 128 + 16 * ct + fr] = Sacc[ct][r];
    }
}
constexpr int S5_HLD = 136;
constexpr int S5_ITEMS = 2 * 32 * 2;
__device__ __forceinline__ void s5_task(const P& p, int oi, int dir, int g, int set, unsigned char* dsm) {
    float* sPr = (float*)dsm;
    float* sPi = sPr + 17 * 64;
    float* sBr = sPi + 17 * 64;
    float* sBi = sBr + 1024;
    float* sCr = sBi + 1024;
    float* sCi = sCr + 16 * 65;
    bf16* sK = (bf16*)(sCi + 16 * 65 + 16);
    bf16* HT = sK + 4096;
    bf16* sG = HT + 2 * 16 * S5_HLD;
    bf16* UT = sG + 256 * S5_HLD;
    const int tid = opaque_tid(), lane = tid & 63, wid = tid >> 6, fr = lane & 15, fq = lane >> 4;
    const int nseq = set ? NB_CTX : NB_LAT, sbase = set ? 0 : NB_CTX, len = set ? L_CTX : L_LAT;
    const bf16* proj = (const bf16*)(p.ws + WS_PROJ);
    bf16* ypart = (bf16*)(p.ws + WS_PART + (size_t)(2 + dir) * PART_SZ);
    const size_t pg = ((size_t)(oi * 2 + dir) * 32 + g);
    LBAR();
    if (tid < 64) {
        const float are = fminf(p.in[I_S5AR][pg * 64 + tid], -1e-4f), aim = p.in[I_S5AI][pg * 64 + tid];
        const float dt = expf(p.in[I_S5DT][pg]);
        const float mag = expf(are * dt), ar = mag * cosf(aim * dt), ai = mag * sinf(aim * dt);
        float pr = 1.f, pi = 0.f;
        for (int j = 0; j <= 16; ++j) { sPr[j * 64 + tid] = pr; sPi[j * 64 + tid] = pi; const float nr = pr * ar - pi * ai, ni = pr * ai + pi * ar; pr = nr; pi = ni; }
    }
    {
        const int st = tid >> 3, c0 = (tid & 7) * 2;
        const float are = fminf(p.in[I_S5AR][pg * 64 + st], -1e-4f), aim = p.in[I_S5AI][pg * 64 + st];
        const float dt = expf(p.in[I_S5DT][pg]);
        const float mag = expf(are * dt), ar = mag * cosf(aim * dt), ai = mag * sinf(aim * dt);
        const float den = are * are + aim * aim;
        const float fre = ((ar - 1.0f) * are + ai * aim) / den, fim = (ai * are - (ar - 1.0f) * aim) / den;
#pragma unroll
        for (int c = 0; c < 2; ++c) {
            const float br = p.in[I_S5BR][(pg * 64 + st) * 16 + c0 + c], bi = p.in[I_S5BI][(pg * 64 + st) * 16 + c0 + c];
            sBr[st * 16 + c0 + c] = fre * br - fim * bi; sBi[st * 16 + c0 + c] = fre * bi + fim * br;
        }
        for (int e = tid; e < 1024; e += 512) { sCr[(e >> 6) * 65 + (e & 63)] = p.in[I_S5CR][pg * 1024 + e]; sCi[(e >> 6) * 65 + (e & 63)] = p.in[I_S5CI][pg * 1024 + e]; }
    }
    LBAR();
    {
        const int lag = tid >> 5, co = (tid >> 1) & 15, c8 = (tid & 1) * 8;
        f8v acc = (f8v)(0.f);
        for (int q = 0; q < 64; ++q) {
            const float cr = sCr[co * 65 + q], ci = sCi[co * 65 + q], pr = sPr[lag * 64 + q], pi = sPi[lag * 64 + q];
            const float mr = cr * pr - ci * pi, mi = cr * pi + ci * pr;
            const f8v br = *(const f8v*)(sBr + q * 16 + c8), bi = *(const f8v*)(sBi + q * 16 + c8);
            acc += mr * br - mi * bi;
        }
        *(uint4*)(sK + (lag * 16 + co) * 16 + c8) = pack8v(acc);
    }
    {
        const int row = tid >> 1, tt = row >> 4, co = row & 15, half = tid & 1;
        for (int q0 = 0; q0 < 64; q0 += 8) {
            f8v v;
#pragma unroll
            for (int j = 0; j < 8; ++j) { const int q = q0 + j; const float cr = sCr[co * 65 + q], ci = sCi[co * 65 + q], pr = sPr[(tt + 1) * 64 + q], pi = sPi[(tt + 1) * 64 + q]; v[j] = half ? -(cr * pi + ci * pr) : cr * pr - ci * pi; }
            *(uint4*)(sG + row * S5_HLD + half * 64 + q0) = pack8v(v);
        }
    }
    LBAR();
    const int sp = fq >> 1, cih = (fq & 1) * 8;
    const int nsteps = len >> 4;
    constexpr int S5_ULD = 264;
    const int un = (tid & 255) >> 4, us = tid & 15;
    const bf16* ubase = proj + (size_t)get_seq(sbase + (un < nseq ? un : 0)).start * OW + O_U + g * 16;
#define S5_UADDR(K) (ubase + (size_t)(dir ? len - 1 - (16 * (K) + us) : 16 * (K) + us) * OW)
#define S5_UPUT(K, QA, QB) do { bf16* d_ = UT + ((K) & 1) * 16 * S5_ULD + un * S5_ULD + us * 16; *(uint4*)d_ = QA; *(uint4*)(d_ + 8) = QB; } while (0)
#define S5_ULOAD(K) const bf16* up_ = UT + ((K) & 1) * 16 * S5_ULD + fr * S5_ULD + 8 * fq; \
        const s8v u0 = *(const s8v*)up_, u1 = *(const s8v*)(up_ + 32), u2 = *(const s8v*)(up_ + 64), u3 = *(const s8v*)(up_ + 96), \
                  u4 = *(const s8v*)(up_ + 128), u5 = *(const s8v*)(up_ + 160), u6 = *(const s8v*)(up_ + 192), u7 = *(const s8v*)(up_ + 224)
    if (wid < 4) {
        s8v wre[8], wim[8];
        {
            const int pp = 16 * wid + fr;
#pragma unroll
            for (int m = 0; m < 8; ++m) {
                const int sidx = 15 - (2 * m + sp);
                const float pr = sPr[sidx * 64 + pp], pi = sPi[sidx * 64 + pp];
#pragma unroll
                for (int j = 0; j < 8; ++j) {
                    const float br = sBr[pp * 16 + cih + j], bi = sBi[pp * 16 + cih + j];
                    wre[m][j] = (short)f2bf(pr * br - pi * bi); wim[m][j] = (short)f2bf(pr * bi + pi * br);
                }
            }
        }
        float a16r[4], a16i[4], hr[4], hi[4];
#pragma unroll
        for (int r = 0; r < 4; ++r) {
            const int pp = 16 * wid + fq * 4 + r;
            a16r[r] = sPr[16 * 64 + pp]; a16i[r] = sPi[16 * 64 + pp];
            hr[r] = 0.f; hi[r] = 0.f;
            if (set == 0 && fr < nseq) { const size_t o = (((size_t)fr * N_ODD + oi) * 2 + dir) * 32 * 64 + g * 64 + pp; hr[r] = p.in[I_SS5R][o]; hi[r] = p.in[I_SS5I][o]; }
        }
        *(uint2*)(HT + fr * S5_HLD + 16 * wid + fq * 4) = make_uint2(pack2(hr[0], hr[1]), pack2(hr[2], hr[3]));
        *(uint2*)(HT + fr * S5_HLD + 64 + 16 * wid + fq * 4) = make_uint2(pack2(hi[0], hi[1]), pack2(hi[2], hi[3]));
        uint4 qa0, qb0, qa1, qb1, qa2, qb2, qa3, qb3;
        { const bf16* a_ = S5_UADDR(0); qa0 = *(const uint4*)a_; qb0 = *(const uint4*)(a_ + 8); S5_UPUT(0, qa0, qb0); }
#define S5_QLOAD(K, QA, QB) do { if ((K) < nsteps) { const bf16* a_ = S5_UADDR(K); QA = *(const uint4*)a_; QB = *(const uint4*)(a_ + 8); } } while (0)
        S5_QLOAD(1, qa1, qb1); S5_QLOAD(2, qa2, qb2); S5_QLOAD(3, qa3, qb3); S5_QLOAD(4, qa0, qb0);
        LBAR();
#define S5_STATE_STEP(K, QA, QB) do { \
            const int k = (K); \
            S5_ULOAD(k); \
            if (k + 1 < nsteps) { S5_UPUT(k + 1, QA, QB); S5_QLOAD(k + 5, QA, QB); } \
            f4v zr = (f4v){0.f, 0.f, 0.f, 0.f}, zi = zr; \
            zr = mfma16(wre[0], u0, zr); zi = mfma16(wim[0], u0, zi); zr = mfma16(wre[1], u1, zr); zi = mfma16(wim[1], u1, zi); \
            zr = mfma16(wre[2], u2, zr); zi = mfma16(wim[2], u2, zi); zr = mfma16(wre[3], u3, zr); zi = mfma16(wim[3], u3, zi); \
            zr = mfma16(wre[4], u4, zr); zi = mfma16(wim[4], u4, zi); zr = mfma16(wre[5], u5, zr); zi = mfma16(wim[5], u5, zi); \
            zr = mfma16(wre[6], u6, zr); zi = mfma16(wim[6], u6, zi); zr = mfma16(wre[7], u7, zr); zi = mfma16(wim[7], u7, zi); \
            _Pragma("unroll") for (int r = 0; r < 4; ++r) { const float nr = a16r[r] * hr[r] - a16i[r] * hi[r] + zr[r], ni = a16r[r] * hi[r] + a16i[r] * hr[r] + zi[r]; hr[r] = nr; hi[r] = ni; } \
            bf16* hb = HT + ((k + 1) & 1) * 16 * S5_HLD; \
            *(uint2*)(hb + fr * S5_HLD + 16 * wid + fq * 4) = make_uint2(pack2(hr[0], hr[1]), pack2(hr[2], hr[3])); \
            *(uint2*)(hb + fr * S5_HLD + 64 + 16 * wid + fq * 4) = make_uint2(pack2(hi[0], hi[1]), pack2(hi[2], hi[3])); \
            LBAR(); } while (0)
        for (int k4 = 0; k4 < nsteps; k4 += 4) {
            S5_STATE_STEP(k4, qa1, qb1); S5_STATE_STEP(k4 + 1, qa2, qb2); S5_STATE_STEP(k4 + 2, qa3, qb3); S5_STATE_STEP(k4 + 3, qa0, qb0);
        }
        if (set == 1 && fr < nseq) {
#pragma unroll
            for (int r = 0; r < 4; ++r) { const size_t o = (((size_t)fr * N_ODD + oi) * 2 + dir) * 32 * 64 + g * 64 + 16 * wid + fq * 4 + r; p.out[OUT_S5R + o] = hr[r]; p.out[OUT_S5I + o] = hi[r]; }
        }
    } else {
        const int t0 = 4 * (RFL(wid) - 4);
        s8v klr[18];
#pragma unroll
        for (int e = 0; e < 18; ++e) { const int lg = t0 + 3 - e - sp; klr[e] = (lg >= 0) ? *(const s8v*)(sK + (lg * 16 + fr) * 16 + cih) : (s8v){0, 0, 0, 0, 0, 0, 0, 0}; }
        LBAR();
        for (int k = 0; k < nsteps; ++k) {
            S5_ULOAD(k);
            const bf16* hb = HT + (k & 1) * 16 * S5_HLD + fr * S5_HLD + 8 * fq;
            const s8v h0 = *(const s8v*)hb, h1 = *(const s8v*)(hb + 32), h2 = *(const s8v*)(hb + 64), h3 = *(const s8v*)(hb + 96);
#pragma unroll
            for (int tt = 0; tt < 4; ++tt) {
                const int t = t0 + tt;
                f4v y = (f4v){0.f, 0.f, 0.f, 0.f};
                { const bf16* gp = sG + ((t0 + tt) * 16 + fr) * S5_HLD + 8 * fq;
                  y = mfma16(*(const s8v*)gp, h0, y); y = mfma16(*(const s8v*)(gp + 32), h1, y); y = mfma16(*(const s8v*)(gp + 64), h2, y); y = mfma16(*(const s8v*)(gp + 96), h3, y); }
                if (0 <= t) y = mfma16(klr[3 - tt], u0, y);
                if (2 <= t) y = mfma16(klr[5 - tt], u1, y);
                if (4 <= t) y = mfma16(klr[7 - tt], u2, y);
                if (6 <= t) y = mfma16(klr[9 - tt], u3, y);
                if (8 <= t) y = mfma16(klr[11 - tt], u4, y);
                if (10 <= t) y = mfma16(klr[13 - tt], u5, y);
                if (12 <= t) y = mfma16(klr[15 - tt], u6, y);
                if (14 <= t) y = mfma16(klr[17 - tt], u7, y);
                if (fr < nseq) {
                    const int pos = 16 * k + t, tok = get_seq(sbase + fr).start + (dir ? len - 1 - pos : pos);
                    *(uint2*)(ypart + (size_t)tok * 512 + g * 16 + fq * 4) = pack4(y);
                }
            }
            LBAR();
        }
    }
}
constexpr int ODD_GDN_ITEMS = NSEQ * 8;
constexpr int ODD_SCAN_ITEMS = ODD_GDN_ITEMS + S5_ITEMS;
__device__ __forceinline__ void ph_odd_scan_item(const P& p, int w, int oi, float* smem_full) {
    unsigned char* dsm = (unsigned char*)smem_full;
    const int nlg = NB_LAT * 8, ncg = NB_CTX * 8;
    if (w < ncg) { gdn_scan_task(p, oi, w / 8, (w % 8) >> 1, w & 1, dsm); return; }
    w -= ncg;
    if (w < 64) { __syncthreads(); s5_task(p, oi, w >> 5, w & 31, 0, dsm); return; }
    w -= 64;
    if (w < nlg) { gdn_scan_task(p, oi, NB_CTX + w / 8, (w % 8) >> 1, w & 1, dsm); return; }
    w -= nlg;
    __syncthreads(); s5_task(p, oi, w >> 5, w & 31, 1, dsm);
}
__device__ __forceinline__ void ph_fin_odd_a(const P& p, int bid, int oi) {
    const int lane = LT & 63, t = bid * 4 + (LT >> 6);
    if (t >= T) return;
    const bf16* pr = (const bf16*)(p.ws + WS_PROJ) + (size_t)t * OW;
    const bf16* of = (const bf16*)(p.ws + WS_PART) + (size_t)t * 512;
    const bf16* ob = (const bf16*)(p.ws + WS_PART + PART_SZ) + (size_t)t * 512;
    const bf16* yf = (const bf16*)(p.ws + WS_PART + 2 * PART_SZ) + (size_t)t * 512;
    const bf16* yb = (const bf16*)(p.ws + WS_PART + 3 * PART_SZ) + (size_t)t * 512;
    bf16* ysw = (bf16*)(p.ws + WS_PART + 2 * PART_SZ) + (size_t)t * 512;
    bf16* yc = (bf16*)(p.ws + WS_HM) + (size_t)t * D;
    const int idx = lane * 8;
    float o[8], ss = 0.f;
#pragma unroll
    for (int j = 0; j < 8; ++j) { o[j] = bf2f(of[idx + j]) + bf2f(ob[idx + j]); ss += o[j] * o[j]; }
    ss += __shfl_xor(ss, 1); ss += __shfl_xor(ss, 2); ss += __shfl_xor(ss, 4); ss += __shfl_xor(ss, 8);
    const float r = frsq(ss * (1.0f / 128.f) + EPS);
    const float* gn = p.in[I_GDNN] + oi * 128 + (idx & 127);
    const float* dsk = p.in[I_S5D] + oi * 512 + idx;
#pragma unroll
    for (int j = 0; j < 8; ++j) {
        yc[idx + j] = f2bf(o[j] * r * gn[j] * siluf_(bf2f(pr[O_ZC + idx + j])));
        const float y = bf2f(yf[idx + j]) + bf2f(yb[idx + j]) + dsk[j] * bf2f(pr[O_U + idx + j]);
        ysw[idx + j] = f2bf(gelu_tanh(y));
    }
}
__device__ __forceinline__ void ph_fin_odd_b(const P& p, int bid, int oi) {
    const size_t e = ((size_t)bid * 256 + LT) * 4;
    if (e >= (size_t)T * 512) return;
    const int t = (int)(e >> 9), idx = (int)(e & 511);
    const bf16* pr = (const bf16*)(p.ws + WS_PROJ) + (size_t)t * OW;
    const bf16* gl = (const bf16*)(p.ws + WS_PART + 2 * PART_SZ) + (size_t)t * 512;
    bf16* yc = (bf16*)(p.ws + WS_HM) + (size_t)t * D + 512;
#pragma unroll
    for (int j = 0; j < 4; ++j) {
        const float ys = bf2f(yc[idx + j]);
        yc[idx + j] = f2bf(ys * sigmoidf_(bf2f(gl[idx + j]) + p.in[I_GLUB][oi * 512 + idx + j]) * siluf_(bf2f(pr[O_ZD + idx + j])));
    }
}

enum { PK_PREP0, PK_HMOD0, PK_GEMM_IN, PK_EVEN_SCAN, PK_FIN_EVEN, PK_ODD_PREP, PK_ODD_SCAN, PK_FIN_ODD_A, PK_GEMM_GLU, PK_FIN_ODD_B, PK_GEMM_OUT, PK_POST, PK_RWKV_PREP0, PK_RWKV_PREP1, PK_EVEN_SCAN1 };
constexpr int NPH = 2 + (DEPTH / 2) * 15;
constexpr int TOKB = (T + 3) / 4;
static_assert(DEPTH % 2 == 0, "even depth expected");
__host__ __device__ inline void phase_desc(int ph, int& kind, int& layer) {
    if (ph == 0) { kind = PK_PREP0; layer = 0; return; }
    if (ph == 1) { kind = PK_HMOD0; layer = 0; return; }
    ph -= 2;
    const int pair = ph / 15, r = ph % 15;
    if (r < 8) { layer = 2 * pair; kind = r == 0 ? PK_GEMM_IN : r == 1 ? PK_RWKV_PREP0 : r == 2 ? PK_EVEN_SCAN : r == 3 ? PK_RWKV_PREP1 : r == 4 ? PK_EVEN_SCAN1 : r == 5 ? PK_FIN_EVEN : r == 6 ? PK_GEMM_OUT : PK_POST; }
    else { const int q = r - 8; layer = 2 * pair + 1; kind = q == 0 ? PK_GEMM_IN : q == 1 ? PK_ODD_PREP : q == 2 ? PK_ODD_SCAN : q == 3 ? PK_FIN_ODD_A : q == 4 ? PK_GEMM_GLU : q == 5 ? PK_GEMM_OUT : PK_POST; }
}
__host__ __device__ inline bool phase_is_gemm(int kind) { return kind == PK_GEMM_IN || kind == PK_GEMM_GLU || kind == PK_GEMM_OUT; }
__host__ __device__ inline int phase_nblk(int kind, int layer) {
    switch (kind) {
        case PK_PREP0: return MOD_VB + WT_TILES;
        case PK_FIN_ODD_B: return (T * 512 / 4 + 255) / 256;
        default: return TOKB;
    }
}
__device__ __forceinline__ void do_phase(const P& p, int kind, int layer, int vb, float* smem) {
    const int i = layer >> 1;
    switch (kind) {
        case PK_PREP0: if (vb < MOD_VB) ph_mod(p, vb, smem); else ph_wt(p, vb - MOD_VB, smem); break;
        case PK_HMOD0: ph_hmod0(p, vb); break;
        case PK_FIN_EVEN: ph_fin_even(p, vb, i); break;
        case PK_FIN_ODD_A: ph_fin_odd_a(p, vb, i); break;
        case PK_FIN_ODD_B: ph_fin_odd_b(p, vb, i); break;
        case PK_POST: ph_post(p, vb, layer); break;
    }
}
__device__ __forceinline__ void do_gemm(const P& p, int kind, int layer, int G, int c, unsigned char* dsm) {
    const int i = layer >> 1;
    const bf16* hm = (const bf16*)(p.ws + WS_HM);
    pg8::StaticOrder S;
    LDS_AS unsigned char* lds = (LDS_AS unsigned char*)dsm;
    if (kind == PK_GEMM_IN) {
        if ((layer & 1) == 0) { pg8::Gemm g{hm, (const bf16*)(p.ws + WS_WTE) + (size_t)i * EWP * D, T, EWP, D, D}; S.init(T, EWP, G, c); pg8::EpiBf16 E{(bf16*)(p.ws + WS_PROJ), EW, EW}; pg8::gemm_phase(lds, g, S, E); }
        else { pg8::Gemm g{hm, (const bf16*)(p.ws + WS_WTO) + (size_t)i * OWP * D, T, OWP, D, D}; S.init(T, OWP, G, c); pg8::EpiBf16 E{(bf16*)(p.ws + WS_PROJ), OW, OW}; pg8::gemm_phase(lds, g, S, E); }
    } else if (kind == PK_GEMM_GLU) {
        const bf16* ysb = (const bf16*)(p.ws + WS_PART + 2 * PART_SZ);
        pg8::Gemm g{ysb, (const bf16*)(p.ws + WS_WTGLU) + (size_t)i * 512 * 512, T, 512, 512, 512}; S.init(T, 512, G, c);
        pg8::EpiGlu E{(bf16*)(p.ws + WS_HM) + 512, ysb, (const bf16*)(p.ws + WS_PROJ) + O_ZD, p.in[I_GLUB] + i * 512}; pg8::gemm_phase(lds, g, S, E);
    } else {
        pg8::Gemm g{hm, (const bf16*)(p.ws + WS_WTOUT) + (size_t)layer * D * D, T, D, D, D}; S.init(T, D, G, c); pg8::EpiF32 E{(float*)(p.ws + WS_PROJ), D}; pg8::gemm_phase(lds, g, S, E);
    }
}
constexpr int LDS_BYTES = 163840;
constexpr bool EVEN_FUSED_SCHED = (NB_LAT == 8 && NB_CTX == 16 && L_CTX == 256 && L_LAT == 1024);
#ifndef REP_SCAN
#define REP_SCAN 1
#endif
#ifndef REP_GEMM
#define REP_GEMM 1
#endif

#ifdef CPU_EMU
__global__ void k_phase(P p, int kind, int layer, int nb) {
    __shared__ __attribute__((aligned(16))) unsigned char dsm[LDS_BYTES];
    if (phase_is_gemm(kind)) { do_gemm(p, kind, layer, gridDim.x, blockIdx.x, dsm); return; }
    if (kind == PK_ODD_SCAN) { ph_odd_scan_item(p, blockIdx.x, layer >> 1, (float*)dsm); return; }
    if (kind == PK_ODD_PREP) { ph_odd_prep(p, blockIdx.x, layer >> 1, dsm); return; }
    if (kind == PK_EVEN_SCAN || kind == PK_EVEN_SCAN1) { ph_even_scan_item(p, blockIdx.x, layer >> 1, kind == PK_EVEN_SCAN1, dsm); return; }
    if (kind == PK_RWKV_PREP0 || kind == PK_RWKV_PREP1) { rwkv_prep_phase(p, layer >> 1, kind == PK_RWKV_PREP1, blockIdx.x, gridDim.x, RWKV_PREP_ITEMS, dsm); return; }
    const int half = threadIdx.x >> 8, vb = 2 * blockIdx.x + half;
    if (vb < nb) do_phase(p, kind, layer, vb, (float*)dsm + half * 16384);
}
void emu_hook(const char* stage, int layer, const P& p);
extern "C" void kernel_launch(void* const* d_in, const int* in_sizes, int n_in, void* d_out, int out_size, void* d_ws, size_t ws_size, hipStream_t stream) {
    P p{};
    for (int i = 0; i < 44; ++i) p.in[i] = (const float*)d_in[i];
    p.out = (float*)d_out; p.ws = (char*)d_ws;
    static const char* names[] = {"prep0", "hmod", "proj", "even_scan0", "ycat", "odd_prep", "odd_scan", "fin_odd_a", "ycat", "ycat", "outproj", "post", "rwkv_prep0", "rwkv_prep1", "even_scan"};
    for (int ph = 0; ph < NPH; ++ph) {
        int kind, layer; phase_desc(ph, kind, layer);
        const int nb = phase_nblk(kind, layer);
        EMU_LAUNCH(k_phase, phase_is_gemm(kind) ? 3 : kind == PK_ODD_SCAN ? ODD_SCAN_ITEMS : (kind == PK_EVEN_SCAN || kind == PK_EVEN_SCAN1) ? EVEN_SCAN_ITEMS : (kind == PK_RWKV_PREP0 || kind == PK_RWKV_PREP1) ? RWKV_PREP_ITEMS : kind == PK_ODD_PREP ? ODD_PREP_ITEMS : (nb + 1) / 2, 512, p, kind, layer, nb);
        emu_hook(names[kind], layer, p);
    }
}
#else

#define XB_TMO      128
#define XB_XCNT(j)  (256  + 64 * (j))
#define XB_XSUB(j)  (1280 + 64 * (j))
#define XB_XGEN(j)  (2304 + 64 * (j))
#define XB_TOP      3328
#define XB_TOPGEN   3392
#define XCD_BAR_WORDS 3456
#define XB_SPIN_CAP (1u << 18)
__device__ __forceinline__ unsigned xb_ld(unsigned* p)              { return __hip_atomic_load(p, __ATOMIC_RELAXED, __HIP_MEMORY_SCOPE_AGENT); }
__device__ __forceinline__ unsigned xb_add(unsigned* p, unsigned v) { return __hip_atomic_fetch_add(p, v, __ATOMIC_RELAXED, __HIP_MEMORY_SCOPE_AGENT); }
__device__ __forceinline__ unsigned xb_xcc_id() { return (unsigned)__builtin_amdgcn_s_getreg((3 << 11) | 20) & 0xFu; }
#define XB_SPIN(cond, bar) do { unsigned _sp = 0; while (cond) { __builtin_amdgcn_s_sleep(1); \
    if ((++_sp & 255u) == 0u) { if (xb_ld(&(bar)[XB_TMO])) break; if (_sp > XB_SPIN_CAP) { atomicAdd(&(bar)[XB_TMO], 1u); break; } } } } while (0)
struct XcdBarrier { unsigned* bar; unsigned x; volatile LDS_AS unsigned* st; };
__device__ __forceinline__ XcdBarrier xcd_barrier_post(unsigned* bar, volatile LDS_AS unsigned* st) {
    XcdBarrier b; b.bar = bar; b.x = xb_xcc_id(); b.st = st;
    if (threadIdx.x == 0) (void)xb_add(&bar[XB_XCNT(b.x)], 1u);
    return b;
}
__device__ __forceinline__ void xcd_barrier_complete(unsigned* bar, unsigned x, unsigned& nloc, unsigned& nx) {
    const unsigned G = gridDim.x * gridDim.y * gridDim.z;
    unsigned sum, cnt, mine, sp = 0u;
    for (;;) {
        sum = 0u; cnt = 0u; mine = 0u;
#pragma unroll
        for (unsigned j = 0; j < 16; ++j) { const unsigned c = xb_ld(&bar[XB_XCNT(j)]); sum += c; cnt += (c > 0u) ? 1u : 0u; mine = (j == x) ? c : mine; }
        if (sum == G) break;
        __builtin_amdgcn_s_sleep(1);
        if ((++sp & 255u) == 0u) { if (xb_ld(&bar[XB_TMO])) break; if (sp > XB_SPIN_CAP) { atomicAdd(&bar[XB_TMO], 1u); break; } }
    }
    nloc = mine > 0u ? mine : 1u; nx = cnt > 0u ? cnt : 1u;
}
__device__ __forceinline__ void xcd_barrier(const XcdBarrier& b) {
    asm volatile("s_waitcnt vmcnt(0)" ::: "memory");
    __syncthreads();
    if (threadIdx.x == 0) {
        unsigned* bar = b.bar;
        __builtin_amdgcn_s_waitcnt(0);
        unsigned nloc = b.st[0], nx = b.st[1];
        if (nloc == 0u) { xcd_barrier_complete(bar, b.x, nloc, nx); b.st[0] = nloc; b.st[1] = nx; }
        const unsigned old = xb_add(&bar[XB_XSUB(b.x)], 1u);
        const unsigned gen = old / nloc;
        if (old + 1u == (gen + 1u) * nloc) {
            __builtin_amdgcn_fence(__ATOMIC_RELEASE, "agent");
            asm volatile("s_waitcnt vmcnt(0)" ::: "memory");
            const unsigned og = xb_add(&bar[XB_TOP], 1u);
            const unsigned tg = og / nx;
            if (og + 1u == (tg + 1u) * nx) xb_add(&bar[XB_TOPGEN], 1u);
            else XB_SPIN(xb_ld(&bar[XB_TOPGEN]) == tg, bar);
            __builtin_amdgcn_fence(__ATOMIC_ACQUIRE, "agent");
            xb_add(&bar[XB_XGEN(b.x)], 1u);
            asm volatile("s_waitcnt vmcnt(0)" ::: "memory");
        } else {
            XB_SPIN(xb_ld(&bar[XB_XGEN(b.x)]) == gen, bar);
            __builtin_amdgcn_fence(__ATOMIC_ACQUIRE, "agent");
            asm volatile("s_waitcnt vmcnt(0)" ::: "memory");
        }
    }
    __syncthreads();
}
extern __shared__ __attribute__((aligned(16))) unsigned char dsm[];
#define RUN_PHASE(KIND, LAYER) do { const int nb_ = phase_nblk(KIND, LAYER); const int half_ = opaque_tid() >> 8; \
    for (int b_ = blockIdx.x; 2 * b_ < nb_; b_ += gridDim.x) { const int vb_ = 2 * b_ + half_; if (vb_ < nb_) do_phase(p, KIND, LAYER, vb_, (float*)dsm + half_ * 16384); } } while (0)
#define RUN_GEMM(KIND, LAYER) do_gemm(p, KIND, LAYER, gridDim.x, blockIdx.x, dsm)
typedef const __attribute__((address_space(4))) P* KP;
__device__ __forceinline__ const P& phase_args(KP pk) { asm volatile("" : "+s"(pk)); return *(const P*)pk; }
__global__ void __launch_bounds__(512) mega(P p_unused) {
    const KP pk = (KP)__builtin_amdgcn_kernarg_segment_ptr();
    volatile LDS_AS unsigned* xst = (volatile LDS_AS unsigned*)(dsm + LDS_BYTES - 16);
    if (threadIdx.x == 0) { xst[0] = 0u; xst[1] = 0u; }
    __syncthreads();
    XcdBarrier xb;
    { const P& p = phase_args(pk); xb = xcd_barrier_post((unsigned*)(p.ws + WS_BAR), xst); }
#define GSYNC() do { const P& pb_ = phase_args(pk); XcdBarrier b_ = xb; b_.bar = (unsigned*)(pb_.ws + WS_BAR); xcd_barrier(b_); } while (0)
    { const P& p = phase_args(pk); RUN_PHASE(PK_PREP0, 0); } GSYNC();
    { const P& p = phase_args(pk); RUN_PHASE(PK_HMOD0, 0); } GSYNC();
#pragma nounroll
    for (int pair = 0; pair < DEPTH / 2; ++pair) {
        const int le = 2 * pair, lo = 2 * pair + 1;
        { const P& p = phase_args(pk); RUN_GEMM(PK_GEMM_IN, le); } GSYNC();
#pragma nounroll
        for (int dir_ = 0; dir_ < 2; ++dir_) {
            if (EVEN_FUSED_SCHED && gridDim.x == 256) {
                { const P& p = phase_args(pk); const int hg = blockIdx.x & 7, q = blockIdx.x >> 3;
                  int cg0, ncg;
                  if (q < 4) { const int x = hg * 4 + q; gla_scan_task(p, pair, NB_CTX + x / 4, x & 3, dir_, dsm); cg0 = q * 3; ncg = 3; }
                  else if (q < 12) { const int x = hg * 8 + (q - 4); gla_scan_task(p, pair, x / 4, x & 3, dir_, dsm); cg0 = 12 + (q - 4) * 5; ncg = 5; }
                  else { cg0 = 52 + (q - 12) * 7; ncg = 7; }
                  rwkv_prep_phase(p, pair, dir_, cg0 * 8 + hg, 8, (cg0 + ncg) * 8, dsm); } GSYNC();
                { const P& p = phase_args(pk); for (int w_ = blockIdx.x; w_ < EV_AP_LAT + EV_AP_CTX; w_ += gridDim.x) rwkv_apply_task(p, pair, w_ < EV_AP_LAT ? NB_CTX + w_ / 8 : (w_ - EV_AP_LAT) / 8, w_ & 7, dir_, dsm); } GSYNC();
            } else {
                { const P& p = phase_args(pk); rwkv_prep_phase(p, pair, dir_, blockIdx.x, gridDim.x, RWKV_PREP_ITEMS, dsm); } GSYNC();
                { const P& p = phase_args(pk); for (int w_ = blockIdx.x; w_ < EVEN_SCAN_ITEMS; w_ += gridDim.x) ph_even_scan_item(p, w_, pair, dir_, dsm); } GSYNC();
            }
        }
        { const P& p = phase_args(pk); RUN_PHASE(PK_FIN_EVEN, le); } GSYNC();
        { const P& p = phase_args(pk); RUN_GEMM(PK_GEMM_OUT, le); } GSYNC();
        { const P& p = phase_args(pk); RUN_PHASE(PK_POST, le); } GSYNC();
        { const P& p = phase_args(pk); RUN_GEMM(PK_GEMM_IN, lo); } GSYNC();
        { const P& p = phase_args(pk); for (int w_ = blockIdx.x; w_ < ODD_PREP_ITEMS; w_ += gridDim.x) ph_odd_prep(p, w_, pair, dsm); } GSYNC();
        { const P& p = phase_args(pk); for (int w_ = blockIdx.x; w_ < ODD_SCAN_ITEMS; w_ += gridDim.x) ph_odd_scan_item(p, w_, pair, (float*)dsm); } GSYNC();
        { const P& p = phase_args(pk); RUN_PHASE(PK_FIN_ODD_A, lo); } GSYNC();
        { const P& p = phase_args(pk); RUN_GEMM(PK_GEMM_GLU, lo); } GSYNC();
        { const P& p = phase_args(pk); RUN_GEMM(PK_GEMM_OUT, lo); } GSYNC();
        { const P& p = phase_args(pk); RUN_PHASE(PK_POST, lo); }
        if (pair + 1 < DEPTH / 2) GSYNC();
    }
}
extern "C" void kernel_launch(void* const* d_in, const int* in_sizes, int n_in, void* d_out, int out_size, void* d_ws, size_t ws_size, hipStream_t stream) {
    static int grid_blocks = 0;
    if (!grid_blocks) {
        int dev = 0, cus = 0, per_cu = 0;
        (void)hipGetDevice(&dev);
        (void)hipDeviceGetAttribute(&cus, hipDeviceAttributeMultiprocessorCount, dev);
        (void)hipFuncSetAttribute((const void*)mega, hipFuncAttributeMaxDynamicSharedMemorySize, LDS_BYTES);
        (void)hipOccupancyMaxActiveBlocksPerMultiprocessor(&per_cu, mega, 512, LDS_BYTES);
        if (per_cu < 1) fprintf(stderr, "occupancy query says %d blocks/CU\n", per_cu);
        grid_blocks = cus;
    }
    P p{};
    for (int i = 0; i < 44; ++i) p.in[i] = (const float*)d_in[i];
    p.out = (float*)d_out; p.ws = (char*)d_ws;
    (void)hipMemsetAsync((char*)d_ws + WS_BAR, 0, XCD_BAR_WORDS * 4, stream);
    hipLaunchKernelGGL(mega, dim3(grid_blocks), dim3(512), LDS_BYTES, stream, p);
    hipError_t e = hipPeekAtLastError();
    if (e != hipSuccess) fprintf(stderr, "launch failed: %s (grid %d)\n", hipGetErrorString(e), grid_blocks);
}
#endif
```

```cpp
#ifndef CPU_EMU
#include <hip/hip_runtime.h>
#include <hip/hip_cooperative_groups.h>
#include <cstdio>
namespace cg = cooperative_groups;
#endif
#include <stdint.h>

#ifndef CFG_BATCH
#define CFG_BATCH 16
#define CFG_SEQ 256
#define CFG_DEC_BATCH 8
#define CFG_DEC_SEQ 1024
#define CFG_DEPTH 4
#endif

typedef unsigned short bf16;
typedef short s8v __attribute__((ext_vector_type(8)));
typedef float f4v __attribute__((ext_vector_type(4)));

constexpr int D = 1024;
constexpr int NB_CTX = CFG_BATCH, L_CTX = CFG_SEQ, NB_LAT = CFG_DEC_BATCH, L_LAT = CFG_DEC_SEQ, DEPTH = CFG_DEPTH;
constexpr int N_EVEN = (DEPTH + 1) / 2, N_ODD = DEPTH / 2;
constexpr int T_CTX = NB_CTX * L_CTX, T_LAT = NB_LAT * L_LAT, T = T_CTX + T_LAT;
constexpr int NSEQ = NB_CTX + NB_LAT, NCOND = 1 + NB_LAT;
constexpr int EW = 3872, OW = 3088, EWP = 4096, OWP = 3328;
constexpr float EPS = 1e-6f;
constexpr int E_Q = 0, E_K = 256, E_V = 512, E_GD = 1024, E_ZA = 1056, E_FB = 1568, E_ZB = 3360;
constexpr int FB_R = 0, FB_K = 512, FB_V = 1024, FB_WD = 1536, FB_AD = 1664;
constexpr int O_QKV = 0, O_G = 1536, O_BETA = 1544, O_ZC = 1552, O_U = 2064, O_ZD = 2576;

constexpr size_t al(size_t x) { return (x + 255) & ~(size_t)255; }
constexpr size_t WS_MOD = 0;
constexpr size_t WS_WTE = WS_MOD + al((size_t)DEPTH * NCOND * 3072 * 4);
constexpr size_t WS_WTO = WS_WTE + al((size_t)N_EVEN * EWP * D * 2);
constexpr size_t WS_WTOUT = WS_WTO + al((size_t)(N_ODD ? N_ODD : 1) * OWP * D * 2);
constexpr size_t WS_WTGLU = WS_WTOUT + al((size_t)DEPTH * D * D * 2);
constexpr size_t WS_HM = WS_WTGLU + al((size_t)(N_ODD ? N_ODD : 1) * 512 * 512 * 2);
constexpr size_t WS_PROJ = WS_HM + al((size_t)T * D * 2);
constexpr size_t WS_PART = WS_PROJ + al((size_t)T * EW * 2);
constexpr size_t PART_SZ = al((size_t)T * 512 * 2);
constexpr size_t WS_YCE = WS_PART + 2 * PART_SZ;
constexpr size_t WS_BONUS = WS_PART + 4 * PART_SZ;
constexpr size_t WS_QKVN = WS_BONUS + al((size_t)T * 16 * 4);
constexpr size_t WS_GATES = WS_QKVN + al((size_t)T * 1536 * 2);
constexpr size_t WS_GC = WS_GATES + al((size_t)T * 16 * 4);
constexpr size_t WS_BAR = WS_GC + al((size_t)(T / 64) * 8 * 64 * 4);
constexpr size_t WS_END = WS_BAR + 16384;
constexpr size_t WS_TINV = WS_PROJ + al((size_t)T * OW * 2);
constexpr size_t WS_QKM = WS_HM;
static_assert(WS_TINV + (size_t)T * 1024 <= WS_PART, "TINV must fit in the PROJ tail");
constexpr size_t WS_RM12 = WS_HM;
constexpr size_t WS_RM34 = WS_QKVN;
constexpr size_t WS_VSH = WS_QKVN + (size_t)(T / 64) * 8 * 16384;
static_assert((size_t)(T / 64) * 8 * 16384 <= (size_t)T * D * 2, "M1/M2 must fit in HM");
static_assert((size_t)(T / 64) * 8 * 16384 + (size_t)T * 512 * 2 <= (size_t)T * 1536 * 2, "M3/M4 + shifted v must fit in QKVN");

constexpr size_t OUT_X = 0;
constexpr size_t OUT_GLA = (size_t)T * D;
constexpr size_t OUT_RWKV = OUT_GLA + (size_t)NB_CTX * N_EVEN * 2 * 4 * 64 * 128;
constexpr size_t OUT_GDN = OUT_RWKV + (size_t)NB_CTX * N_EVEN * 2 * 8 * 64 * 64;
constexpr size_t OUT_S5R = OUT_GDN + (size_t)NB_CTX * N_ODD * 2 * 4 * 128 * 128;
constexpr size_t OUT_S5I = OUT_S5R + (size_t)NB_CTX * N_ODD * 2 * 32 * 64;

struct P {
    const float* in[44];
    float* out;
    char* ws;
};
enum { I_XP = 0, I_XS, I_C, I_SGLA, I_SRWKV, I_SGDN, I_SS5R, I_SS5I, I_CCTX, I_WMOD, I_BMOD, I_GPRE, I_GPOST,
       I_WINE, I_WOUTE, I_GUP, I_GBIAS, I_GLAN, I_MIX, I_W0, I_W2, I_A0, I_A2, I_KK, I_KA, I_RK, I_LNG, I_LNB,
       I_WINO, I_WOUTO, I_CONV, I_ALOG, I_DTB, I_GDNN, I_S5AR, I_S5AI, I_S5DT, I_S5BR, I_S5BI, I_S5CR, I_S5CI,
       I_S5D, I_GLUW, I_GLUB };

#ifdef CPU_EMU
__device__ __forceinline__ int opaque_tid() { return (int)threadIdx.x; }
#else
__device__ __forceinline__ int opaque_tid() { int t = (int)threadIdx.x; asm volatile("" : "+v"(t)); return t; }
#endif
#define LT (opaque_tid() & 255)
__device__ __forceinline__ float u2f(unsigned u) { return __builtin_bit_cast(float, u); }
__device__ __forceinline__ unsigned f2u(float f) { return __builtin_bit_cast(unsigned, f); }
__device__ __forceinline__ float bf2f(bf16 h) { return u2f((unsigned)h << 16); }
#ifdef CPU_EMU
__device__ __forceinline__ bf16 f2bf(float f) { unsigned u = f2u(f); u += 0x7fffu + ((u >> 16) & 1u); return (bf16)(u >> 16); }
__device__ __forceinline__ unsigned pack2(float lo, float hi) { return (unsigned)f2bf(lo) | ((unsigned)f2bf(hi) << 16); }
__device__ __forceinline__ float fexp(float x) { return expf(x); }
__device__ __forceinline__ float flog(float x) { return logf(x); }
__device__ __forceinline__ float frcp(float x) { return 1.0f / x; }
__device__ __forceinline__ float frsq(float x) { return 1.0f / sqrtf(x); }
#else
typedef __bf16 hwbf2 __attribute__((ext_vector_type(2)));
typedef float hwf2 __attribute__((ext_vector_type(2)));
__device__ __forceinline__ unsigned pack2(float lo, float hi) { hwf2 v = {lo, hi}; return __builtin_bit_cast(unsigned, __builtin_convertvector(v, hwbf2)); }
__device__ __forceinline__ bf16 f2bf(float f) { return (bf16)(pack2(f, 0.f) & 0xffffu); }
__device__ __forceinline__ float fexp(float x) { return __builtin_amdgcn_exp2f(x * 1.4426950408889634f); }
__device__ __forceinline__ float flog(float x) { return __builtin_amdgcn_logf(x) * 0.6931471805599453f; }
__device__ __forceinline__ float frcp(float x) { return __builtin_amdgcn_rcpf(x); }
__device__ __forceinline__ float frsq(float x) { return __builtin_amdgcn_rsqf(x); }
#endif
__device__ __forceinline__ float sigmoidf_(float x) { return frcp(1.0f + fexp(-x)); }
__device__ __forceinline__ float siluf_(float x) { return x * frcp(1.0f + fexp(-x)); }
__device__ __forceinline__ float logsigf_(float x) { return fminf(x, 0.f) - flog(1.0f + fexp(-fabsf(x))); }
__device__ __forceinline__ float softplusf_(float x) { return fmaxf(x, 0.f) + flog(1.0f + fexp(-fabsf(x))); }
__device__ __forceinline__ float ftanh(float x) { const float e = fexp(-2.0f * fabsf(x)); const float t = (1.0f - e) * frcp(1.0f + e); return x < 0.f ? -t : t; }
__device__ __forceinline__ float gelu_tanh(float x) { return 0.5f * x * (1.0f + ftanh(0.7978845608028654f * (x + 0.044715f * x * x * x))); }

typedef float f8v __attribute__((ext_vector_type(8)));
__device__ __forceinline__ f8v unpack8v(const uint4& u) {
    f8v f; f[0] = u2f(u.x << 16); f[1] = u2f(u.x & 0xffff0000u); f[2] = u2f(u.y << 16); f[3] = u2f(u.y & 0xffff0000u);
    f[4] = u2f(u.z << 16); f[5] = u2f(u.z & 0xffff0000u); f[6] = u2f(u.w << 16); f[7] = u2f(u.w & 0xffff0000u); return f;
}
__device__ __forceinline__ uint4 pack8v(const f8v& f) { return make_uint4(pack2(f[0], f[1]), pack2(f[2], f[3]), pack2(f[4], f[5]), pack2(f[6], f[7])); }
struct Seq { int start, len, cond, lat, b; };
__device__ __forceinline__ Seq get_seq(int s) {
    Seq q;
    if (s < NB_CTX) { q.start = s * L_CTX; q.len = L_CTX; q.cond = 0; q.lat = 0; q.b = s; }
    else { int b = s - NB_CTX; q.start = T_CTX + b * L_LAT; q.len = L_LAT; q.cond = 1 + b; q.lat = 1; q.b = b; }
    return q;
}
__device__ __forceinline__ int tok_cond(int t) { return t < T_CTX ? 0 : 1 + (t - T_CTX) / L_LAT; }
__device__ __forceinline__ void tok_nbr(int t, bool& hl, bool& hr) {
    if (t < T_CTX) { int pos = t % L_CTX; hl = pos != 0; hr = pos != L_CTX - 1; }
    else { int pos = (t - T_CTX) & 63; hl = pos != 0; hr = pos != 63; }
}

constexpr int MOD_VB = DEPTH * 192;
__device__ __forceinline__ void ph_mod(const P& p, int bid, float* smem) {
    float (*sc)[1024] = (float(*)[1024])smem;
    float (*red)[16][NCOND] = (float(*)[16][NCOND])(smem + NCOND * 1024);
    const int layer = bid / 192, ct = bid % 192;
    __syncthreads();
    const int tid = LT, cl = tid & 15, kg = tid >> 4;
    for (int i = tid; i < NCOND * 1024; i += 256) {
        int ci = i >> 10, k = i & 1023;
        float v = ci == 0 ? p.in[I_CCTX][k] : p.in[I_C][(ci - 1) * 1024 + k];
        sc[ci][k] = siluf_(v);
    }
    __syncthreads();
    float acc[NCOND];
#pragma unroll
    for (int ci = 0; ci < NCOND; ++ci) acc[ci] = 0.f;
    const float* w = p.in[I_WMOD] + (size_t)layer * 1024 * 3072 + ct * 16 + cl;
#pragma unroll 4
    for (int kk = 0; kk < 64; ++kk) {
        const int k = kg * 64 + kk;
        const float wv = w[(size_t)k * 3072];
#pragma unroll
        for (int ci = 0; ci < NCOND; ++ci) acc[ci] += sc[ci][k] * wv;
    }
#pragma unroll
    for (int ci = 0; ci < NCOND; ++ci) red[kg][cl][ci] = acc[ci];
    __syncthreads();
    if (tid < 16 * NCOND) {
        const int c = tid / NCOND, ci = tid % NCOND;
        float sum = p.in[I_BMOD][layer * 3072 + ct * 16 + c];
#pragma unroll
        for (int g = 0; g < 16; ++g) sum += red[g][c][ci];
        ((float*)(p.ws + WS_MOD))[(size_t)(layer * NCOND + ci) * 3072 + ct * 16 + c] = sum;
    }
}

struct WtJob { const float* src; bf16* dst; int K, N, Npad; };
__device__ __forceinline__ WtJob wt_job(const P& p, int j) {
    WtJob q;
    if (j < N_EVEN) { q.src = p.in[I_WINE] + (size_t)j * D * EW; q.dst = (bf16*)(p.ws + WS_WTE) + (size_t)j * EWP * D; q.K = D; q.N = EW; q.Npad = EWP; return q; }
    j -= N_EVEN;
    if (j < N_ODD) { q.src = p.in[I_WINO] + (size_t)j * D * OW; q.dst = (bf16*)(p.ws + WS_WTO) + (size_t)j * OWP * D; q.K = D; q.N = OW; q.Npad = OWP; return q; }
    j -= N_ODD;
    if (j < DEPTH) { int i = j >> 1; q.src = (j & 1) ? p.in[I_WOUTO] + (size_t)i * D * D : p.in[I_WOUTE] + (size_t)i * D * D; q.dst = (bf16*)(p.ws + WS_WTOUT) + (size_t)j * D * D; q.K = D; q.N = D; q.Npad = D; return q; }
    j -= DEPTH;
    q.src = p.in[I_GLUW] + (size_t)j * 512 * 512; q.dst = (bf16*)(p.ws + WS_WTGLU) + (size_t)j * 512 * 512; q.K = 512; q.N = 512; q.Npad = 512; return q;
}
constexpr int WT_NJOBS = N_EVEN + N_ODD + DEPTH + N_ODD;
constexpr int WT_TILES = N_EVEN * (EWP / 64) * 16 + N_ODD * (OWP / 64) * 16 + DEPTH * 256 + N_ODD * 64;
__device__ __forceinline__ void ph_wt(const P& p, int bid, float* smem) {
    float (*tile)[65] = (float(*)[65])smem;
    int b = bid, j = 0;
    __syncthreads();
    WtJob q;
    for (;; ++j) { q = wt_job(p, j); int nt = (q.Npad / 64) * (q.K / 64); if (b < nt) break; b -= nt; }
    const int nk = q.K / 64, n0 = (b / nk) * 64, k0 = (b % nk) * 64;
    {
        const int kk = LT >> 4, n4 = (LT & 15) * 4, n = n0 + n4;
#pragma unroll
        for (int i = 0; i < 4; ++i) {
            float4 v = make_float4(0.f, 0.f, 0.f, 0.f);
            if (n < q.N) v = *(const float4*)(q.src + (size_t)(k0 + kk + 16 * i) * q.N + n);
            float* tr = &tile[kk + 16 * i][n4];
            tr[0] = v.x; tr[1] = v.y; tr[2] = v.z; tr[3] = v.w;
        }
    }
    __syncthreads();
    {
        const int nn = LT >> 2, k16 = (LT & 3) * 16;
        f8v a, c;
#pragma unroll
        for (int j = 0; j < 8; ++j) { a[j] = tile[k16 + j][nn]; c[j] = tile[k16 + 8 + j][nn]; }
        bf16* d = q.dst + (size_t)(n0 + nn) * q.K + k0 + k16;
        *(uint4*)d = pack8v(a); *(uint4*)(d + 8) = pack8v(c);
    }
}

__device__ __forceinline__ float wave_sum(float v) {
#pragma unroll
    for (int m = 1; m < 64; m <<= 1) v += __shfl_xor(v, m);
    return v;
}
__device__ __forceinline__ void hmod_row(const float* xv  , int lane, const float* gpre, const float* mod, bf16* dst) {
    float ss = 0.f;
#pragma unroll
    for (int i = 0; i < 16; ++i) ss += xv[i] * xv[i];
    ss = wave_sum(ss);
    const float r = frsq(ss * (1.0f / 1024.f) + EPS);
#pragma unroll
    for (int i = 0; i < 4; ++i) {
        int idx = i * 256 + lane * 4;
        bf16 o[4];
#pragma unroll
        for (int j = 0; j < 4; ++j) o[j] = f2bf(xv[i * 4 + j] * r * gpre[idx + j] * (1.0f + mod[1024 + idx + j]) + mod[idx + j]);
        *(uint2*)(dst + idx) = make_uint2((unsigned)o[0] | ((unsigned)o[1] << 16), (unsigned)o[2] | ((unsigned)o[3] << 16));
    }
}
__device__ __forceinline__ void ph_hmod0(const P& p, int bid) {
    const int lane = LT & 63, t = bid * 4 + (LT >> 6);
    if (t >= T) return;
    const float* xr = t < T_CTX ? p.in[I_XP] + (size_t)t * D : p.in[I_XS] + (size_t)(t - T_CTX) * D;
    float xv[16];
#pragma unroll
    for (int i = 0; i < 4; ++i) { float4 v = *(const float4*)(xr + i * 256 + lane * 4); xv[i * 4] = v.x; xv[i * 4 + 1] = v.y; xv[i * 4 + 2] = v.z; xv[i * 4 + 3] = v.w; }
    const float* mod = (const float*)(p.ws + WS_MOD) + (size_t)(0 * NCOND + tok_cond(t)) * 3072;
    hmod_row(xv, lane, p.in[I_GPRE], mod, (bf16*)(p.ws + WS_HM) + (size_t)t * D);
}
__device__ __forceinline__ void ph_post(const P& p, int bid, int layer) {
    const int lane = LT & 63, t = bid * 4 + (LT >> 6);
    if (t >= T) return;
    const float* xr = layer == 0 ? (t < T_CTX ? p.in[I_XP] + (size_t)t * D : p.in[I_XS] + (size_t)(t - T_CTX) * D) : p.out + OUT_X + (size_t)t * D;
    const float* mr = (const float*)(p.ws + WS_PROJ) + (size_t)t * D;
    const float* mod = (const float*)(p.ws + WS_MOD) + (size_t)(layer * NCOND + tok_cond(t)) * 3072;
    const float* gpost = p.in[I_GPOST] + layer * D;
    float xv[16], mv[16];
    float ss = 0.f;
#pragma unroll
    for (int i = 0; i < 4; ++i) {
        float4 v = *(const float4*)(xr + i * 256 + lane * 4); xv[i * 4] = v.x; xv[i * 4 + 1] = v.y; xv[i * 4 + 2] = v.z; xv[i * 4 + 3] = v.w;
        float4 m = *(const float4*)(mr + i * 256 + lane * 4); mv[i * 4] = m.x; mv[i * 4 + 1] = m.y; mv[i * 4 + 2] = m.z; mv[i * 4 + 3] = m.w;
    }
#pragma unroll
    for (int i = 0; i < 16; ++i) ss += mv[i] * mv[i];
    ss = wave_sum(ss);
    const float r = frsq(ss * (1.0f / 1024.f) + EPS);
    float* xo = p.out + OUT_X + (size_t)t * D;
#pragma unroll
    for (int i = 0; i < 4; ++i) {
        int idx = i * 256 + lane * 4;
#pragma unroll
        for (int j = 0; j < 4; ++j) xv[i * 4 + j] += mod[2048 + idx + j] * (mv[i * 4 + j] * r * gpost[idx + j]);
        *(float4*)(xo + idx) = make_float4(xv[i * 4], xv[i * 4 + 1], xv[i * 4 + 2], xv[i * 4 + 3]);
    }
    if (layer + 1 < DEPTH) {
        const float* mod2 = (const float*)(p.ws + WS_MOD) + (size_t)((layer + 1) * NCOND + tok_cond(t)) * 3072;
        hmod_row(xv, lane, p.in[I_GPRE] + (layer + 1) * D, mod2, (bf16*)(p.ws + WS_HM) + (size_t)t * D);
    }
}

#ifdef CPU_EMU
#define LDS_AS
#define GLDS16(gptr, lptr) memcpy((char*)(lptr) + (threadIdx.x & 63) * 16, (const void*)(gptr), 16)
#define PG_WAIT_V(n)
#define PG_WAIT_L(n)
#define PG_BAR __syncthreads()
#define PG_SCHED
#define PG_PRIO(x)
#define RFL(x) (x)
__device__ __forceinline__ unsigned cvt_pk_bf16(float lo, float hi) { return (unsigned)f2bf(lo) | ((unsigned)f2bf(hi) << 16); }
#else
#define LDS_AS __attribute__((address_space(3)))
#define GLDS16(gptr, lptr) __builtin_amdgcn_global_load_lds((const unsigned*)(gptr), (LDS_AS unsigned*)(lptr), 16, 0, 0)
#define PG_WAIT_V(n) asm volatile("s_waitcnt vmcnt(" #n ")" ::: "memory")
#define PG_WAIT_L(n) asm volatile("s_waitcnt lgkmcnt(" #n ")" ::: "memory")
#define PG_BAR __builtin_amdgcn_s_barrier()
#define PG_SCHED __builtin_amdgcn_sched_barrier(0)
#define PG_PRIO(x) __builtin_amdgcn_s_setprio(x)
#define RFL(x) __builtin_amdgcn_readfirstlane(x)
__device__ __forceinline__ unsigned cvt_pk_bf16(float lo, float hi) { return pack2(lo, hi); }
#endif
namespace pg8 {
constexpr int BM = 256, BK = 64, HALF = 128, HTB = HALF * BK * 2, STAGE_BYTES = 8 * HTB, NXCD = 8, WGM = 8;
__host__ __device__ __forceinline__ int lds_byte(int r, int c) { const int st = (r >> 4) * 2 + (c >> 5), rr = r & 15, cc = c & 31, ob = rr * 64 + cc * 2; return st * 1024 + (ob ^ (((ob >> 9) & 1) << 5)); }
__host__ __device__ __forceinline__ void stage_rc(int b, int& R, int& C) { const int st = b / 1024, sb = b % 1024, swz = sb ^ (((sb >> 9) & 1) << 5); R = (st >> 1) * 16 + swz / 64; C = (st & 1) * 32 + (swz % 64) / 2; }
__host__ __device__ __forceinline__ int perm32(int rho) { const int n = rho >> 4, i = rho & 15; return 8 * (i >> 2) + 4 * n + (i & 3); }
struct Unit { int pm, pn; };
struct Gemm { const bf16* A; const bf16* Bt; int M, N, K, lda; };
struct StaticOrder {
    int nM, nN, nwg, G, c;
    __host__ __device__ void init(int M, int N, int G_, int c_) { nM = M / BM; nN = N / BM; nwg = nM * nN; G = G_; c = c_; }
    __host__ __device__ bool next(int i, Unit& u) const {
        const long L = (long)i * G + c; if (L >= nwg) return false;
        int wgid = (int)L; { const int q = nwg / NXCD, r = nwg % NXCD, xcd = wgid % NXCD, off = wgid / NXCD; wgid = (xcd < r ? xcd * (q + 1) : r * (q + 1) + (xcd - r) * q) + off; }
        const int nig = WGM * nN, gid = wgid / nig, fm = gid * WGM, gsz = (nM - fm) < WGM ? (nM - fm) : WGM;
        u.pm = fm + ((wgid % nig) % gsz); u.pn = (wgid % nig) / gsz; return true;
    }
};
struct EpiF32 {
    static constexpr bool PERM = false;
    float* C; int ldc;
    __device__ __forceinline__ void operator()(const f4v (&acc)[2][2][4][2], const Unit& u, int wr, int wc, int fr, int fq) const {
        const int row0 = u.pm * BM + wr * 64 + fr, col0 = u.pn * BM + wc * 32 + 4 * fq;
#pragma unroll
        for (int ai = 0; ai < 2; ++ai)
#pragma unroll
            for (int m = 0; m < 4; ++m) { float* rowp = C + (size_t)(row0 + ai * HALF + m * 16) * ldc + col0;
#pragma unroll
                for (int bj = 0; bj < 2; ++bj)
#pragma unroll
                    for (int n = 0; n < 2; ++n) *(f4v*)(rowp + bj * HALF + n * 16) = acc[ai][bj][m][n]; }
    }
};
struct EpiBf16 {
    static constexpr bool PERM = true;
    bf16* O; int ldc; int N;
    __device__ __forceinline__ void operator()(const f4v (&acc)[2][2][4][2], const Unit& u, int wr, int wc, int fr, int fq) const {
        const int row0 = u.pm * BM + wr * 64 + fr, col0 = u.pn * BM + wc * 32 + 8 * fq;
#pragma unroll
        for (int ai = 0; ai < 2; ++ai)
#pragma unroll
            for (int m = 0; m < 4; ++m) { bf16* rowp = O + (size_t)(row0 + ai * HALF + m * 16) * ldc + col0;
#pragma unroll
                for (int bj = 0; bj < 2; ++bj) { const f4v v0 = acc[ai][bj][m][0], v1 = acc[ai][bj][m][1];
                    if (col0 + bj * HALF < N) *(uint4*)(rowp + bj * HALF) = make_uint4(cvt_pk_bf16(v0[0], v0[1]), cvt_pk_bf16(v0[2], v0[3]), cvt_pk_bf16(v1[0], v1[1]), cvt_pk_bf16(v1[2], v1[3])); } }
    }
};
struct EpiGlu {
    static constexpr bool PERM = true;
    bf16* O; const bf16* YS; const bf16* ZD; const float* GB;
    __device__ __forceinline__ void operator()(const f4v (&acc)[2][2][4][2], const Unit& u, int wr, int wc, int fr, int fq) const {
        const int row0 = u.pm * BM + wr * 64 + fr, col0 = u.pn * BM + wc * 32 + 8 * fq;
#pragma unroll
        for (int ai = 0; ai < 2; ++ai)
#pragma unroll
            for (int m = 0; m < 4; ++m) { const size_t row = (size_t)(row0 + ai * HALF + m * 16);
#pragma unroll
                for (int bj = 0; bj < 2; ++bj) { const int col = col0 + bj * HALF;
                    const f8v ys = unpack8v(*(const uint4*)(YS + row * 512 + col)), zd = unpack8v(*(const uint4*)(ZD + row * OW + col));
                    const f8v gb = *(const f8v*)(GB + col);
                    f8v o;
#pragma unroll
                    for (int j = 0; j < 8; ++j) { const float g = (j < 4 ? acc[ai][bj][m][0][j] : acc[ai][bj][m][1][j - 4]) + gb[j]; o[j] = ys[j] * sigmoidf_(g) * siluf_(zd[j]); }
                    *(uint4*)(O + row * D + col) = pack8v(o); } }
    }
};
template <class Epi>
__device__ __forceinline__ void gemm_phase(LDS_AS unsigned char* lds, const Gemm g, const StaticOrder& S, const Epi& E) {
    const int tid = opaque_tid(), wid = RFL(tid >> 6), lane = tid & 63, wr = wid >> 2, wc = wid & 3, fr = lane & 15, fq = lane >> 4;
    const int K = g.K, nt = K / BK;
    unsigned voffA[2], voffB[2];
#pragma unroll
    for (int i = 0; i < 2; ++i) { int R, C; stage_rc(tid * 16 + i * 8192, R, C); const int Rb = Epi::PERM ? ((R & ~31) + perm32(R & 31)) : R;
        voffA[i] = (unsigned)(R * g.lda + C) * 2u; voffB[i] = (unsigned)(Rb * K + C) * 2u; }
    const size_t kstep = (size_t)(BK * 2);
    const size_t hstepA = (size_t)HALF * g.lda * 2, hstepB = (size_t)HALF * K * 2;
    const size_t tstepA = 2 * hstepA, tstepB = 2 * hstepB;
    const unsigned ldsw = (unsigned)wid * 1024u;
    const int aoff = lds_byte(wr * 64 + fr, fq * 8), boff = lds_byte(wc * 32 + fr, fq * 8);
#define PG8_SA(b, h) (((b) * 2 + (h)) * HTB)
#define PG8_SB(b, h) ((4 + (b) * 2 + (h)) * HTB)
#define PG8_STAGE(bufoff, gbase, voff) do { _Pragma("unroll") for (int _i = 0; _i < 2; ++_i) GLDS16((const char*)(gbase) + (voff)[_i], lds + (bufoff) + ldsw + _i * 8192); } while (0)
#define PG8_LDA(dst, b, h) do { _Pragma("unroll") for (int m = 0; m < 4; ++m) _Pragma("unroll") for (int k = 0; k < 2; ++k) dst[m][k] = *(const LDS_AS s8v*)(lds + PG8_SA(b, h) + aoff + m * 2048 + k * 1024); } while (0)
#define PG8_LDB(dst, b, h) do { _Pragma("unroll") for (int n = 0; n < 2; ++n) _Pragma("unroll") for (int k = 0; k < 2; ++k) dst[n][k] = *(const LDS_AS s8v*)(lds + PG8_SB(b, h) + boff + n * 2048 + k * 1024); } while (0)
#define PG8_MMA(ai, bj, At, Bt) do { PG_PRIO(1); _Pragma("unroll") for (int m = 0; m < 4; ++m) _Pragma("unroll") for (int n = 0; n < 2; ++n) _Pragma("unroll") for (int k = 0; k < 2; ++k) \
        acc[ai][bj][m][n] = __builtin_amdgcn_mfma_f32_16x16x32_bf16(Bt[n][k], At[m][k], acc[ai][bj][m][n], 0, 0, 0); PG_PRIO(0); } while (0)
    Unit cur, nxt; int ui = 0;
    if (!S.next(0, cur)) return;
    f4v acc[2][2][4][2];
#pragma unroll
    for (int a = 0; a < 2; ++a)
#pragma unroll
        for (int b = 0; b < 2; ++b)
#pragma unroll
            for (int m = 0; m < 4; ++m)
#pragma unroll
                for (int n = 0; n < 2; ++n) acc[a][b][m][n] = (f4v){0.f, 0.f, 0.f, 0.f};
    s8v At[4][2], B0[2][2], B1[2][2];
    const char* cA = (const char*)g.A + (size_t)cur.pm * tstepA; const char* cB = (const char*)g.Bt + (size_t)cur.pn * tstepB;
    PG8_STAGE(PG8_SB(0, 0), cB, voffB); PG8_STAGE(PG8_SA(0, 0), cA, voffA); PG8_STAGE(PG8_SB(0, 1), cB + hstepB, voffB); PG8_STAGE(PG8_SA(0, 1), cA + hstepA, voffA);
    if (wr == 1) PG_BAR;
    PG_WAIT_V(4); PG_BAR;
    PG8_STAGE(PG8_SB(1, 0), cB + kstep, voffB); PG8_STAGE(PG8_SA(1, 0), cA + kstep, voffA); PG8_STAGE(PG8_SB(1, 1), cB + hstepB + kstep, voffB);
    PG_WAIT_V(6); PG_BAR;
    for (;;) {
        const bool has_next = S.next(ui + 1, nxt);
        const char* nA = has_next ? (const char*)g.A + (size_t)nxt.pm * tstepA : cA; const char* nB = has_next ? (const char*)g.Bt + (size_t)nxt.pn * tstepB : cB;
        for (int t = 0; t < nt; t += 2) {
            const bool last = (t == nt - 2);
            const char* a1 = cA + (size_t)(t + 1) * kstep;
            const char* a2 = last ? nA : cA + (size_t)(t + 2) * kstep; const char* b2 = last ? nB : cB + (size_t)(t + 2) * kstep;
            const char* a3 = a2 + kstep; const char* b3 = b2 + kstep;
            PG8_LDB(B0, 0, 0); PG_SCHED; PG8_LDA(At, 0, 0); PG8_STAGE(PG8_SA(1, 1), a1 + hstepA, voffA);
            PG_WAIT_L(8); PG_BAR; PG_WAIT_L(0); PG8_MMA(0, 0, At, B0); PG_BAR; PG_SCHED;
            PG8_LDB(B1, 0, 1); PG8_STAGE(PG8_SB(0, 0), b2, voffB);
            PG_BAR; PG_WAIT_L(0); PG8_MMA(0, 1, At, B1); PG_BAR;
            PG8_LDA(At, 0, 1); PG8_STAGE(PG8_SA(0, 0), a2, voffA);
            PG_BAR; PG_WAIT_L(0); PG8_MMA(1, 0, At, B0); PG_BAR; PG_SCHED;
            PG8_STAGE(PG8_SB(0, 1), b2 + hstepB, voffB);
            PG_WAIT_V(6); PG_BAR; PG8_MMA(1, 1, At, B1); PG_BAR;
            PG8_LDB(B0, 1, 0); PG_SCHED; PG8_LDA(At, 1, 0); PG8_STAGE(PG8_SA(0, 1), a2 + hstepA, voffA);
            PG_WAIT_L(8); PG_BAR; PG_WAIT_L(0); PG8_MMA(0, 0, At, B0); PG_BAR; PG_SCHED;
            PG8_LDB(B1, 1, 1); PG8_STAGE(PG8_SB(1, 0), b3, voffB);
            PG_BAR; PG_WAIT_L(0); PG8_MMA(0, 1, At, B1); PG_BAR;
            PG8_LDA(At, 1, 1); PG8_STAGE(PG8_SA(1, 0), a3, voffA);
            PG_BAR; PG_WAIT_L(0); PG8_MMA(1, 0, At, B0); PG_BAR; PG_SCHED;
            PG8_STAGE(PG8_SB(1, 1), b3 + hstepB, voffB);
            PG_WAIT_V(6); PG_BAR; PG8_MMA(1, 1, At, B1); PG_BAR;
        }
        E(acc, cur, wr, wc, fr, fq);
        if (!has_next) break;
#pragma unroll
        for (int a = 0; a < 2; ++a)
#pragma unroll
            for (int b = 0; b < 2; ++b)
#pragma unroll
                for (int m = 0; m < 4; ++m)
#pragma unroll
                    for (int n = 0; n < 2; ++n) acc[a][b][m][n] = (f4v){0.f, 0.f, 0.f, 0.f};
        cur = nxt; cA = nA; cB = nB; ++ui;
    }
    PG_WAIT_V(0);
    if (wr == 0) PG_BAR;
    PG_BAR;
}
}

#ifdef CPU_EMU
#define WAVE_SYNC() emu::wsync()
#define LBAR() __syncthreads()
#else
#define WAVE_SYNC() __builtin_amdgcn_wave_barrier()
#define LBAR() do { asm volatile("s_waitcnt lgkmcnt(0)" ::: "memory"); __builtin_amdgcn_s_barrier(); asm volatile("" ::: "memory"); } while (0)
#endif
__device__ __forceinline__ void unpack8(const uint4& u, float* f) {
    f[0] = u2f(u.x << 16); f[1] = u2f(u.x & 0xffff0000u); f[2] = u2f(u.y << 16); f[3] = u2f(u.y & 0xffff0000u);
    f[4] = u2f(u.z << 16); f[5] = u2f(u.z & 0xffff0000u); f[6] = u2f(u.w << 16); f[7] = u2f(u.w & 0xffff0000u);
}
__device__ __forceinline__ uint4 pack8(const float* f) { return make_uint4(pack2(f[0], f[1]), pack2(f[2], f[3]), pack2(f[4], f[5]), pack2(f[6], f[7])); }
__device__ __forceinline__ f4v unpack4(const uint2& u) { f4v f; f[0] = u2f(u.x << 16); f[1] = u2f(u.x & 0xffff0000u); f[2] = u2f(u.y << 16); f[3] = u2f(u.y & 0xffff0000u); return f; }
__device__ __forceinline__ uint2 pack4(const f4v& f) { return make_uint2(pack2(f[0], f[1]), pack2(f[2], f[3])); }
__device__ __forceinline__ f4v mfma16(const s8v& a, const s8v& b, const f4v& c) { return __builtin_amdgcn_mfma_f32_16x16x32_bf16(a, b, c, 0, 0, 0); }

__device__ __forceinline__ float red8(float x) {
#ifdef CPU_EMU
    x += __shfl_xor(x, 1); x += __shfl_xor(x, 2); x += __shfl_xor(x, 4);
#else
    x += __builtin_bit_cast(float, __builtin_amdgcn_mov_dpp(__builtin_bit_cast(int, x), 0xB1, 0xF, 0xF, true));
    x += __builtin_bit_cast(float, __builtin_amdgcn_mov_dpp(__builtin_bit_cast(int, x), 0x4E, 0xF, 0xF, true));
    x += __builtin_bit_cast(float, __builtin_amdgcn_mov_dpp(__builtin_bit_cast(int, x), 0x141, 0xF, 0xF, true));
#endif
    return x;
}
__device__ __forceinline__ float red16(float x) {
    x = red8(x);
#ifdef CPU_EMU
    x += __shfl_xor(x, 8);
#else
    x += __builtin_bit_cast(float, __builtin_amdgcn_mov_dpp(__builtin_bit_cast(int, x), 0x140, 0xF, 0xF, true));
#endif
    return x;
}
constexpr int TI_LD = 68, TI_TLD = 20;
__device__ __forceinline__ void ti_mm16(float* dst, int ldd, const float* L, int ldl, const float* R, int ldr, float sgn, const float* add, int lda, int lane) {
    const int r = lane >> 2, c4 = (lane & 3) * 4;
    f4v acc = (f4v){0.f, 0.f, 0.f, 0.f};
#pragma unroll
    for (int k = 0; k < 16; ++k) { const float l = L[r * ldl + k]; const f4v rv = *(const f4v*)(R + k * ldr + c4); acc += l * rv; }
    acc *= sgn;
    if (add) acc += *(const f4v*)(add + r * lda + c4);
    *(f4v*)(dst + r * ldd + c4) = acc;
}
__device__ __forceinline__ float red4(float x) {
#ifdef CPU_EMU
    x += __shfl_xor(x, 1); x += __shfl_xor(x, 2);
#else
    x += __builtin_bit_cast(float, __builtin_amdgcn_mov_dpp(__builtin_bit_cast(int, x), 0xB1, 0xF, 0xF, true));
    x += __builtin_bit_cast(float, __builtin_amdgcn_mov_dpp(__builtin_bit_cast(int, x), 0x4E, 0xF, 0xF, true));
#endif
    return x;
}
__device__ __forceinline__ void tri_inv64(const float* A, float* X, float* TMP, int wl, int lane, bool active) {
#define TI_A(a, b) (A + (16 * (a)) * TI_LD + 16 * (b))
#define TI_X(a, b) (X + (16 * (a)) * TI_LD + 16 * (b))
#define TI_T(n) (TMP + (n) * 16 * TI_TLD)
    if (active) {
        const int c = lane >> 2, js = lane & 3;
        float xr[4] = {0.f, 0.f, 0.f, 0.f};
        const float* Ab = TI_A(wl, wl);
#pragma unroll
        for (int i = 0; i < 16; ++i) {
            float part = 0.f;
#pragma unroll
            for (int m = 0; m <= (i - 1) / 4 && i > 0; ++m) { const int j = 4 * m + js; part += (j < i ? Ab[i * TI_LD + j] : 0.f) * xr[m]; }
            const float tot = red4(part);
            const float xi = (i == c ? 1.f : 0.f) - tot;
            xr[i >> 2] = ((i & 3) == js) ? xi : xr[i >> 2];
        }
        float* Xb = TI_X(wl, wl);
#pragma unroll
        for (int m = 0; m < 4; ++m) Xb[(4 * m + js) * TI_LD + c] = xr[m];
        for (int b = wl + 1; b < 4; ++b) { float* Z = TI_X(wl, b); const int r = lane >> 2, c4 = (lane & 3) * 4; *(f4v*)(Z + r * TI_LD + c4) = (f4v){0.f, 0.f, 0.f, 0.f}; }
    }
    LBAR();
    if (!active) {} else if (wl == 0) ti_mm16(TI_T(0), TI_TLD, TI_A(1, 0), TI_LD, TI_X(0, 0), TI_LD, 1.f, nullptr, 0, lane);
    else if (wl == 1) ti_mm16(TI_T(1), TI_TLD, TI_A(3, 2), TI_LD, TI_X(2, 2), TI_LD, 1.f, nullptr, 0, lane);
    else if (wl == 2) ti_mm16(TI_T(2), TI_TLD, TI_A(2, 1), TI_LD, TI_X(1, 1), TI_LD, 1.f, nullptr, 0, lane);
    else ti_mm16(TI_T(3), TI_TLD, TI_A(3, 1), TI_LD, TI_X(1, 1), TI_LD, 1.f, nullptr, 0, lane);
    LBAR();
    if (!active) {} else if (wl == 0) ti_mm16(TI_X(1, 0), TI_LD, TI_X(1, 1), TI_LD, TI_T(0), TI_TLD, -1.f, nullptr, 0, lane);
    else if (wl == 1) ti_mm16(TI_X(3, 2), TI_LD, TI_X(3, 3), TI_LD, TI_T(1), TI_TLD, -1.f, nullptr, 0, lane);
    else if (wl == 2) ti_mm16(TI_T(4), TI_TLD, TI_A(2, 0), TI_LD, TI_X(0, 0), TI_LD, 1.f, nullptr, 0, lane);
    else ti_mm16(TI_T(5), TI_TLD, TI_A(3, 0), TI_LD, TI_X(0, 0), TI_LD, 1.f, nullptr, 0, lane);
    LBAR();
    if (!active) {} else if (wl == 0) ti_mm16(TI_T(6), TI_TLD, TI_A(2, 1), TI_LD, TI_X(1, 0), TI_LD, 1.f, TI_T(4), TI_TLD, lane);
    else if (wl == 1) ti_mm16(TI_T(7), TI_TLD, TI_A(3, 1), TI_LD, TI_X(1, 0), TI_LD, 1.f, TI_T(5), TI_TLD, lane);
    LBAR();
    if (!active) {} else if (wl == 0) ti_mm16(TI_X(2, 0), TI_LD, TI_X(2, 2), TI_LD, TI_T(6), TI_TLD, -1.f, nullptr, 0, lane);
    else if (wl == 1) ti_mm16(TI_X(2, 1), TI_LD, TI_X(2, 2), TI_LD, TI_T(2), TI_TLD, -1.f, nullptr, 0, lane);
    else if (wl == 2) ti_mm16(TI_T(0), TI_TLD, TI_X(3, 3), TI_LD, TI_T(7), TI_TLD, 1.f, nullptr, 0, lane);
    else ti_mm16(TI_T(1), TI_TLD, TI_X(3, 3), TI_LD, TI_T(3), TI_TLD, 1.f, nullptr, 0, lane);
    LBAR();
    if (!active) {} else if (wl == 2) { ti_mm16(TI_X(3, 0), TI_LD, TI_X(3, 2), TI_LD, TI_T(6), TI_TLD, -1.f, nullptr, 0, lane); }
    else if (wl == 3) { ti_mm16(TI_X(3, 1), TI_LD, TI_X(3, 2), TI_LD, TI_T(2), TI_TLD, -1.f, nullptr, 0, lane); }
    if (active && wl >= 2) {
        const int r = lane >> 2, c4 = (lane & 3) * 4;
        float* d = TI_X(3, wl - 2) + r * TI_LD + c4; const float* t = TI_T(wl - 2) + r * TI_TLD + c4;
        *(f4v*)d = *(const f4v*)d - *(const f4v*)t;
    }
    LBAR();
#undef TI_A
#undef TI_X
#undef TI_T
}

constexpr int GL_LD = 72;
__device__ __forceinline__ void gla_scan_task(const P& p, int ei, int s, int h, int dir, unsigned char* dsm) {
    bf16* LAt = (bf16*)dsm;
    bf16* Qd = LAt + 64 * GL_LD;
    bf16* Ki = Qd + 64 * GL_LD;
    bf16* KiT = Ki + 64 * GL_LD;
    bf16* Sc = KiT + 64 * GL_LD;
    bf16* VT = Sc + 64 * GL_LD;
    bf16* St = VT + 128 * GL_LD;
    float* sAE = (float*)(St + 128 * GL_LD);
    float* Of = sAE + 64;
    const Seq sq_ = get_seq(s);
    const int tid = opaque_tid(), lane = tid & 63, wid = tid >> 6, fr = lane & 15, fq = lane >> 4;
    const int rt = wid & 3, chf = wid >> 2;
    const bf16* proj = (const bf16*)(p.ws + WS_PROJ);
    bf16* opart = (bf16*)(p.ws + WS_PART);
    s8v gfrag[2]; float gb[2];
    {
        const float* gup = p.in[I_GUP] + (size_t)(ei * 2 + dir) * 16 * 256 + h * 64;
        const float* gbias = p.in[I_GBIAS] + (size_t)(ei * 2 + dir) * 256 + h * 64;
#pragma unroll
        for (int c2 = 0; c2 < 2; ++c2) {
            const int d = 16 * (2 * chf + c2) + fr;
            gb[c2] = gbias[d];
#pragma unroll
            for (int j = 0; j < 8; ++j) gfrag[c2][j] = (short)f2bf(fq < 2 ? gup[(8 * fq + j) * 256 + d] : 0.f);
        }
    }
    f4v Sacc[4];
    LBAR();
    if (sq_.lat) {
        const float* s0 = p.in[I_SGLA] + ((((size_t)sq_.b * N_EVEN + ei) * 2 + dir) * 4 + h) * 64 * 128;
#pragma unroll
        for (int ct = 0; ct < 4; ++ct)
#pragma unroll
            for (int r = 0; r < 4; ++r) Sacc[ct][r] = s0[(16 * rt + fq * 4 + r) * 128 + 64 * chf + 16 * ct + fr];
    } else {
#pragma unroll
        for (int ct = 0; ct < 4; ++ct) Sacc[ct] = (f4v){0.f, 0.f, 0.f, 0.f};
    }
#pragma unroll
    for (int ct = 0; ct < 4; ++ct) *(uint2*)(St + (64 * chf + 16 * ct + fr) * GL_LD + 16 * rt + fq * 4) = make_uint2(pack2(Sacc[ct][0], Sacc[ct][1]), pack2(Sacc[ct][2], Sacc[ct][3]));
    const int nch = sq_.len >> 6;
    uint4 pv0, pv1, pq, pkk, pga;
#define GLA_FETCH(TB) do { \
        { const int i_ = lane, c8_ = wid * 8; const bf16* pr_ = proj + (size_t)((TB) + (dir ? 63 - i_ : i_)) * EW + E_V + h * 128 + c8_; \
          pv0 = *(const uint4*)pr_; pv1 = *(const uint4*)(pr_ + 64); } \
        { const int i_ = tid >> 3, c8_ = (tid & 7) * 8; const bf16* pr_ = proj + (size_t)((TB) + (dir ? 63 - i_ : i_)) * EW + h * 64 + c8_; \
          pq = *(const uint4*)(pr_ + E_Q); pkk = *(const uint4*)(pr_ + E_K); } \
        { const int i_ = 16 * rt + fr; pga = make_uint4(0u, 0u, 0u, 0u); if (fq < 2) pga = *(const uint4*)(proj + (size_t)((TB) + (dir ? 63 - i_ : i_)) * EW + E_GD + dir * 16 + fq * 8); } \
    } while (0)
    GLA_FETCH(sq_.start + (dir ? sq_.len - 64 : 0));
    for (int cc = 0; cc < nch; ++cc) {
        const int tb = sq_.start + (dir ? sq_.len - 64 - cc * 64 : cc * 64);
        {
            {
                const int i = lane, c8 = wid * 8;
                const f8v va = unpack8v(pv0), vb = unpack8v(pv1);
#pragma unroll
                for (int j = 0; j < 8; ++j) { VT[(c8 + j) * GL_LD + i] = f2bf(va[j]); VT[(64 + c8 + j) * GL_LD + i] = f2bf(vb[j]); }
            }
            { const int i = tid >> 3, c8 = (tid & 7) * 8; *(uint4*)(Qd + i * GL_LD + c8) = pq; *(uint4*)(Ki + i * GL_LD + c8) = pkk; }
            const s8v ga = __builtin_bit_cast(s8v, pga);
            if (cc + 1 < nch) GLA_FETCH(sq_.start + (dir ? sq_.len - 128 - cc * 64 : (cc + 1) * 64));
#pragma unroll
            for (int c2 = 0; c2 < 2; ++c2) {
                const f4v x = mfma16(ga, gfrag[c2], (f4v){0.f, 0.f, 0.f, 0.f});
                float la[4];
#pragma unroll
                for (int r = 0; r < 4; ++r) la[r] = logsigf_(x[r] + gb[c2]) * (1.0f / 16.0f);
                *(uint2*)(LAt + (16 * (2 * chf + c2) + fr) * GL_LD + 16 * rt + fq * 4) = make_uint2(pack2(la[0], la[1]), pack2(la[2], la[3]));
            }
        }
        LBAR();
        {
            f4v bc[2];
            bc[0] = (f4v){0.f, 0.f, 0.f, 0.f}; bc[1] = bc[0];
#pragma unroll
            for (int ks = 0; ks < 2; ++ks) {
                s8v lf;
#pragma unroll
                for (int j = 0; j < 8; ++j) lf[j] = (32 * ks + 8 * fq + j <= 16 * rt + fr) ? (short)0x3F80 : (short)0;
#pragma unroll
                for (int c2 = 0; c2 < 2; ++c2) bc[c2] = mfma16(lf, *(const s8v*)(LAt + (16 * (2 * chf + c2) + fr) * GL_LD + 32 * ks + 8 * fq), bc[c2]);
            }
#pragma unroll
            for (int c2 = 0; c2 < 2; ++c2) {
                const int d = 16 * (2 * chf + c2) + fr;
                float kiv[4];
#pragma unroll
                for (int r = 0; r < 4; ++r) {
                    const int i = 16 * rt + fq * 4 + r;
                    const float eb = fexp(bc[c2][r]);
                    const float qv = bf2f(Qd[i * GL_LD + d]) * 0.125f * eb;
                    kiv[r] = bf2f(Ki[i * GL_LD + d]) * frcp(eb);
                    Qd[i * GL_LD + d] = f2bf(qv); Ki[i * GL_LD + d] = f2bf(kiv[r]);
                    if (i == 63) sAE[d] = eb;
                }
                *(uint2*)(KiT + d * GL_LD + 16 * rt + fq * 4) = make_uint2(pack2(kiv[0], kiv[1]), pack2(kiv[2], kiv[3]));
            }
        }
        LBAR();
        f4v oacc[4];
        {
            f4v sc[2];
            sc[0] = (f4v){0.f, 0.f, 0.f, 0.f}; sc[1] = sc[0];
#pragma unroll
            for (int ct = 0; ct < 4; ++ct) oacc[ct] = (f4v){0.f, 0.f, 0.f, 0.f};
#pragma unroll
            for (int ks = 0; ks < 2; ++ks) {
                const s8v a = *(const s8v*)(Qd + (16 * rt + fr) * GL_LD + 32 * ks + 8 * fq);
#pragma unroll
                for (int c2 = 0; c2 < 2; ++c2) sc[c2] = mfma16(a, *(const s8v*)(Ki + (16 * (2 * chf + c2) + fr) * GL_LD + 32 * ks + 8 * fq), sc[c2]);
#pragma unroll
                for (int ct = 0; ct < 4; ++ct) oacc[ct] = mfma16(*(const s8v*)(St + (64 * chf + 16 * ct + fr) * GL_LD + 32 * ks + 8 * fq), a, oacc[ct]);
            }
#pragma unroll
            for (int c2 = 0; c2 < 2; ++c2)
#pragma unroll
                for (int r = 0; r < 4; ++r) { const int i = 16 * rt + fq * 4 + r, j = 16 * (2 * chf + c2) + fr; Sc[i * GL_LD + j] = f2bf(j <= i ? sc[c2][r] : 0.f); }
        }
        LBAR();
        {
#pragma unroll
            for (int ks = 0; ks < 2; ++ks) {
                const s8v a = *(const s8v*)(Sc + (16 * rt + fr) * GL_LD + 32 * ks + 8 * fq);
                const s8v kt = *(const s8v*)(KiT + (16 * rt + fr) * GL_LD + 32 * ks + 8 * fq);
#pragma unroll
                for (int ct = 0; ct < 4; ++ct) {
                    const s8v bv = *(const s8v*)(VT + (64 * chf + 16 * ct + fr) * GL_LD + 32 * ks + 8 * fq);
                    oacc[ct] = mfma16(bv, a, oacc[ct]); Sacc[ct] = mfma16(kt, bv, Sacc[ct]);
                }
            }
            {
                const int i = 16 * rt + fr, t = tb + (dir ? 63 - i : i);
                if (dir == 0) {
#pragma unroll
                    for (int ct = 0; ct < 4; ++ct) *(uint2*)(opart + (size_t)t * 512 + h * 128 + 64 * chf + 16 * ct + fq * 4) = pack4(oacc[ct]);
                } else {
#pragma unroll
                    for (int ct = 0; ct < 4; ++ct) *(f4v*)(Of + i * 132 + 64 * chf + 16 * ct + fq * 4) = oacc[ct];
                }
            }
            float ae[4];
#pragma unroll
            for (int r = 0; r < 4; ++r) ae[r] = sAE[16 * rt + fq * 4 + r];
#pragma unroll
            for (int ct = 0; ct < 4; ++ct) {
#pragma unroll
                for (int r = 0; r < 4; ++r) Sacc[ct][r] *= ae[r];
                *(uint2*)(St + (64 * chf + 16 * ct + fr) * GL_LD + 16 * rt + fq * 4) = make_uint2(pack2(Sacc[ct][0], Sacc[ct][1]), pack2(Sacc[ct][2], Sacc[ct][3]));
            }
        }
        LBAR();
        if (dir == 1) {
            const int i = tid >> 3, d0 = (tid & 7) * 16, t = tb + 63 - i;
            const bf16* ofp = opart + (size_t)t * 512 + h * 128 + d0;
            const bf16* zap = proj + (size_t)t * EW + E_ZA + h * 128 + d0;
            const f8v o0 = *(const f8v*)(Of + i * 132 + d0) + unpack8v(*(const uint4*)ofp), o1 = *(const f8v*)(Of + i * 132 + d0 + 8) + unpack8v(*(const uint4*)(ofp + 8));
            float ss = 0.f;
#pragma unroll
            for (int j = 0; j < 8; ++j) ss += o0[j] * o0[j] + o1[j] * o1[j];
            const float r = frsq(red8(ss) * (1.0f / 128.f) + EPS);
            const float* gn = p.in[I_GLAN] + ei * 128 + d0;
            const f8v z0 = unpack8v(*(const uint4*)zap), z1 = unpack8v(*(const uint4*)(zap + 8));
            f8v y0, y1;
#pragma unroll
            for (int j = 0; j < 8; ++j) { y0[j] = o0[j] * r * gn[j] * siluf_(z0[j]); y1[j] = o1[j] * r * gn[8 + j] * siluf_(z1[j]); }
            bf16* yc = (bf16*)(p.ws + WS_YCE) + (size_t)t * D + h * 128 + d0;
            *(uint4*)yc = pack8v(y0); *(uint4*)(yc + 8) = pack8v(y1);
        }
    }
    if (!sq_.lat) {
        float* fs = p.out + OUT_GLA + ((((size_t)sq_.b * N_EVEN + ei) * 2 + dir) * 4 + h) * 64 * 128;
#pragma unroll
        for (int ct = 0; ct < 4; ++ct)
#pragma unroll
            for (int r = 0; r < 4; ++r) fs[(16 * rt + fq * 4 + r) * 128 + 64 * chf + 16 * ct + fr] = Sacc[ct][r];
    }
}

#ifndef RW_PREFETCH
#define RW_PREFETCH 1
#endif
constexpr int RW_LD = 72;
constexpr int RWKV_PREP_ITEMS = (T / 64) * 8;
struct RwPre { uint4 x[5], l[5], r[5]; };
__device__ __forceinline__ void rwkv_prefetch(const P& p, int w, int dir, int tid, RwPre& q) {
    const int cg = w >> 3, h = w & 7, hc0 = h * 64;
    const int i = tid >> 3, c8 = (tid & 7) * 8, t = cg * 64 + (dir ? 63 - i : i);
    bool hl, hr; tok_nbr(t, hl, hr);
    const bf16* proj = (const bf16*)(p.ws + WS_PROJ);
#pragma unroll
    for (int grp = 0; grp < 5; ++grp) {
        const int col = (grp == 0 ? FB_R + hc0 : grp == 1 ? FB_K + hc0 : grp == 2 ? FB_V + hc0 : grp == 3 ? FB_WD + dir * 64 : FB_AD + dir * 64) + c8;
        const bf16* pr = proj + (size_t)t * EW + E_FB + col;
        q.x[grp] = *(const uint4*)pr;
        q.l[grp] = hl ? *(const uint4*)(pr - EW) : make_uint4(0u, 0u, 0u, 0u);
        q.r[grp] = hr ? *(const uint4*)(pr + EW) : make_uint4(0u, 0u, 0u, 0u);
    }
}
__device__ __forceinline__ void rwkv_prep_phase(const P& p, int ei, int dir, int w_first, int w_stride, int w_end, unsigned char* dsm) {
    float* sCS = (float*)dsm;
    float* sKK = sCS + 4096;
    float* sB = sKK + 4096;
    float* sKM = sB + 4096;
    float* sR = sKM + 4096;
    float* sAf = (float*)dsm;
    float* sXf = sAf + 64 * TI_LD;
    float* sTmp = sXf + 64 * TI_LD;
    bf16* AakT = (bf16*)(sTmp + 8 * 16 * TI_TLD);
    bf16* Brb = AakT + 64 * RW_LD;
    bf16* Tm = Brb + 64 * RW_LD;
    bf16* PT = (bf16*)dsm;
    bf16* W1T = PT + 64 * RW_LD;
    static_assert(2 * 64 * TI_LD * 4 + 8 * 16 * TI_TLD * 4 + 3 * 64 * RW_LD * 2 <= 81920, "RWKV prep overlays exceed region A");
    bf16* At = (bf16*)(dsm + 81920);
    bf16* Bt = At + 64 * RW_LD;
    bf16* Kt = Bt + 64 * RW_LD;
    bf16* Rt = Kt + 64 * RW_LD;
    bf16* BhT = Rt + 64 * RW_LD;
    bf16* KhT = BhT + 64 * RW_LD;
    bf16* AtT = KhT + 64 * RW_LD;
    bf16* sTW = At;
    bf16* sAD = Bt;
    float* sSeg = (float*)(AtT + 64 * RW_LD);
    const int tid0 = opaque_tid();
    float* bonus = (float*)(p.ws + WS_BONUS);
    const float* mix = p.in[I_MIX] + (size_t)ei * 1792;
    int hcur = -1;
    s8v lrf[4][2];
    float lrb[4];
    RwPre pre;
#if RW_PREFETCH
    if (w_first < w_end) rwkv_prefetch(p, w_first, dir, tid0, pre);
#endif
    for (int w = w_first; w < w_end; w += w_stride) {
        const int tid = opaque_tid(), lane = tid & 63, wid = tid >> 6, fr = lane & 15, fq = lane >> 4;
        const int rt = wid & 3, cb = 2 * (wid >> 2), which = wid >> 2;
        const int cg = w >> 3, h = w & 7, hc0 = h * 64;
        const size_t tk = (size_t)cg * 8 + h;
        if (h != hcur) {
            hcur = h;
            LBAR();
            const float* w2 = p.in[I_W2] + (size_t)(ei * 2 + dir) * 64 * 512 + hc0; const float* a2 = p.in[I_A2] + (size_t)(ei * 2 + dir) * 64 * 512 + hc0;
            for (int e = tid; e < 4096; e += 512) { const int r = e >> 6, c = e & 63; Kt[c * RW_LD + r] = f2bf(w2[(size_t)r * 512 + c]); Rt[c * RW_LD + r] = f2bf(a2[(size_t)r * 512 + c]); }
            LBAR();
            const bf16* src = which ? Rt : Kt;
            const float* lb = (which ? p.in[I_A0] : p.in[I_W0]) + (size_t)(ei * 2 + dir) * 512 + hc0;
#pragma unroll
            for (int ct = 0; ct < 4; ++ct) {
                lrb[ct] = lb[16 * ct + fr];
#pragma unroll
                for (int ks = 0; ks < 2; ++ks) lrf[ct][ks] = *(const s8v*)(src + (16 * ct + fr) * RW_LD + ks * 32 + fq * 8);
            }
        }
        LBAR();
#if !RW_PREFETCH
        rwkv_prefetch(p, w, dir, tid, pre);
#endif
        {
            const int i = tid >> 3, c8 = (tid & 7) * 8, t = cg * 64 + (dir ? 63 - i : i);
#pragma unroll
            for (int grp = 0; grp < 5; ++grp) {
                const int col = (grp == 0 ? FB_R + hc0 : grp == 1 ? FB_K + hc0 : grp == 2 ? FB_V + hc0 : grp == 3 ? FB_WD + dir * 64 : FB_AD + dir * 64) + c8;
                const f8v x = unpack8v(pre.x[grp]);
                const f8v nb = unpack8v(pre.l[grp]) + unpack8v(pre.r[grp]);
                const f8v mv = *(const f8v*)(mix + col);
                f8v y = x + mv * (nb * 0.5f - x);
                if (grp == 0) *(f8v*)(sR + i * 64 + c8) = y;
                else if (grp == 1) *(f8v*)(sKM + i * 64 + c8) = y;
                else if (grp == 2) { if (dir == 0) *(uint4*)((bf16*)(p.ws + WS_VSH) + (size_t)t * 512 + hc0 + c8) = pack8v(y); }
                else {
                    if (grp == 3) {
#pragma unroll
                        for (int j = 0; j < 8; ++j) y[j] = ftanh(y[j]);
                    }
                    *(uint4*)((grp == 3 ? sTW : sAD) + i * RW_LD + c8) = pack8v(y);
                }
            }
        }
#if RW_PREFETCH
        if (w + w_stride < w_end) rwkv_prefetch(p, w + w_stride, dir, tid, pre);
#endif
        LBAR();
        {
            const bf16* Am = which ? sAD : sTW;
            f4v acc[4];
#pragma unroll
            for (int ct = 0; ct < 4; ++ct) acc[ct] = (f4v){0.f, 0.f, 0.f, 0.f};
#pragma unroll
            for (int ks = 0; ks < 2; ++ks) {
                const s8v a = *(const s8v*)(Am + (16 * rt + fr) * RW_LD + ks * 32 + fq * 8);
#pragma unroll
                for (int ct = 0; ct < 4; ++ct) acc[ct] = mfma16(a, lrf[ct][ks], acc[ct]);
            }
#pragma unroll
            for (int ct = 0; ct < 4; ++ct) {
                const int c = 16 * ct + fr;
#pragma unroll
                for (int r = 0; r < 4; ++r) {
                    const int tok = 16 * rt + fq * 4 + r;
                    const float sg = sigmoidf_(lrb[ct] + acc[ct][r]);
                    if (which) sB[tok * 64 + c] = sg; else sCS[tok * 64 + c] = -0.6065306597126334f * sg;
                }
            }
        }
        LBAR();
        {
            const int i = tid >> 3, c8 = (tid & 7) * 8;
            const float* kkw = p.in[I_KK] + (size_t)ei * 512 + hc0; const float* kaw = p.in[I_KA] + (size_t)ei * 512 + hc0; const float* rkw = p.in[I_RK] + (size_t)ei * 512 + hc0;
            const f8v av = *(const f8v*)(sB + i * 64 + c8), kr = *(const f8v*)(sKM + i * 64 + c8), rv = *(const f8v*)(sR + i * 64 + c8);
            const f8v kav = *(const f8v*)(kaw + c8), kkv = *(const f8v*)(kkw + c8), rkv = *(const f8v*)(rkw + c8);
            const f8v km = kr * (1.0f + (av - 1.0f) * kav);
            f8v kk = kr * kkv;
            float ss = 0.f, bn = 0.f;
#pragma unroll
            for (int j = 0; j < 8; ++j) { ss += kk[j] * kk[j]; bn += rv[j] * km[j] * rkv[j]; }
            ss = red8(ss); bn = red8(bn);
            kk *= frsq(ss + EPS);
            *(f8v*)(sKK + i * 64 + c8) = kk; *(f8v*)(sB + i * 64 + c8) = kk * av; *(f8v*)(sKM + i * 64 + c8) = km;
            if ((tid & 7) == 0) { const int t = cg * 64 + (dir ? 63 - i : i); bonus[((size_t)t * 8 + h) * 2 + dir] = bn; }
        }
        {
            const int c = tid & 63, sg = tid >> 6;
            float run = 0.f;
#pragma unroll
            for (int j = 0; j < 8; ++j) { run += sCS[(8 * sg + j) * 64 + c]; sCS[(8 * sg + j) * 64 + c] = run; }
            sSeg[sg * 64 + c] = run;
        }
        LBAR();
        {
            const int c = tid & 63, sg = tid >> 6;
            float off = 0.f;
            for (int q = 0; q < sg; ++q) off += sSeg[q * 64 + c];
#pragma unroll
            for (int j = 0; j < 8; ++j) sCS[(8 * sg + j) * 64 + c] += off;
        }
        LBAR();
        {
            const int i = tid >> 3, c8 = (tid & 7) * 8;
            const f8v cs = *(const f8v*)(sCS + i * 64 + c8), cl = *(const f8v*)(sCS + 63 * 64 + c8);
            f8v cp = (f8v)(0.f);
            if (i > 0) cp = *(const f8v*)(sCS + (i - 1) * 64 + c8);
            const f8v kk = *(const f8v*)(sKK + i * 64 + c8), bb = *(const f8v*)(sB + i * 64 + c8), km = *(const f8v*)(sKM + i * 64 + c8), rv = *(const f8v*)(sR + i * 64 + c8);
            f8v at, bt, kt, rtv;
#pragma unroll
            for (int j = 0; j < 8; ++j) {
                const float g = fexp(cs[j]), gi = frcp(g), gp = fexp(cp[j]), gc = fexp(cl[j]) * gi;
                at[j] = -kk[j] * gp; bt[j] = bb[j] * gi; kt[j] = km[j] * gi; rtv[j] = rv[j] * g;
                BhT[(c8 + j) * RW_LD + i] = f2bf(bb[j] * gc); KhT[(c8 + j) * RW_LD + i] = f2bf(km[j] * gc); AtT[(c8 + j) * RW_LD + i] = f2bf(at[j]);
            }
            *(uint4*)(At + i * RW_LD + c8) = pack8v(at); *(uint4*)(Bt + i * RW_LD + c8) = pack8v(bt);
            *(uint4*)(Kt + i * RW_LD + c8) = pack8v(kt); *(uint4*)(Rt + i * RW_LD + c8) = pack8v(rtv);
            if (i == 63) {
                float* gco = (float*)(p.ws + WS_GC) + tk * 64 + c8;
#pragma unroll
                for (int j = 0; j < 8; ++j) gco[j] = fexp(cl[j]);
            }
        }
        LBAR();
        f4v brkT[2];
        {
            f4v aab[2], aak[2], brb[2];
#pragma unroll
            for (int c2 = 0; c2 < 2; ++c2) { aab[c2] = (f4v){0.f, 0.f, 0.f, 0.f}; aak[c2] = aab[c2]; brb[c2] = aab[c2]; brkT[c2] = aab[c2]; }
#pragma unroll
            for (int ks = 0; ks < 2; ++ks) {
                const int ko = ks * 32 + fq * 8, ra = (16 * rt + fr) * RW_LD + ko;
                const s8v fa = *(const s8v*)(At + ra), frr = *(const s8v*)(Rt + ra), fk = *(const s8v*)(Kt + ra);
#pragma unroll
                for (int c2 = 0; c2 < 2; ++c2) {
                    const int ro = (16 * (cb + c2) + fr) * RW_LD + ko;
                    const s8v gb = *(const s8v*)(Bt + ro), gk = *(const s8v*)(Kt + ro), gr = *(const s8v*)(Rt + ro);
                    aab[c2] = mfma16(fa, gb, aab[c2]); aak[c2] = mfma16(fa, gk, aak[c2]); brb[c2] = mfma16(frr, gb, brb[c2]);
                    brkT[c2] = mfma16(fk, gr, brkT[c2]);
                }
            }
#pragma unroll
            for (int c2 = 0; c2 < 2; ++c2) {
                const int col = 16 * (cb + c2) + fr, r0 = 16 * rt + fq * 4;
                f4v ak;
#pragma unroll
                for (int r = 0; r < 4; ++r) {
                    const int row = r0 + r;
                    sAf[row * TI_LD + col] = col < row ? -aab[c2][r] : 0.f;
                    ak[r] = col < row ? aak[c2][r] : 0.f;
                    Brb[row * RW_LD + col] = f2bf(col <= row ? brb[c2][r] : 0.f);
                    if (!(row <= col)) brkT[c2][r] = 0.f;
                }
                *(uint2*)(AakT + col * RW_LD + r0) = pack4(ak);
            }
        }
        LBAR();
        tri_inv64(sAf, sXf, sTmp, wid & 3, lane, wid < 4);
        { const int i = tid >> 3, c8 = (tid & 7) * 8; *(uint4*)(Tm + i * RW_LD + c8) = pack8v(*(const f8v*)(sXf + i * TI_LD + c8)); }
        LBAR();
        {
            f4v pp[2], ww[2];
#pragma unroll
            for (int c2 = 0; c2 < 2; ++c2) { pp[c2] = (f4v){0.f, 0.f, 0.f, 0.f}; ww[c2] = pp[c2]; }
#pragma unroll
            for (int ks = 0; ks < 2; ++ks) {
                const int ko = ks * 32 + fq * 8;
                const s8v ft = *(const s8v*)(Tm + (16 * rt + fr) * RW_LD + ko);
#pragma unroll
                for (int c2 = 0; c2 < 2; ++c2) {
                    const int ro = (16 * (cb + c2) + fr) * RW_LD + ko;
                    pp[c2] = mfma16(ft, *(const s8v*)(AtT + ro), pp[c2]); ww[c2] = mfma16(ft, *(const s8v*)(AakT + ro), ww[c2]);
                }
            }
#pragma unroll
            for (int c2 = 0; c2 < 2; ++c2) {
                const int col = 16 * (cb + c2) + fr;
                *(uint2*)(PT + col * RW_LD + 16 * rt + fq * 4) = pack4(pp[c2]);
                *(uint2*)(W1T + col * RW_LD + 16 * rt + fq * 4) = pack4(ww[c2]);
            }
        }
        LBAR();
        {
            bf16* m12 = (bf16*)(p.ws + WS_RM12) + tk * 8192; bf16* m34 = (bf16*)(p.ws + WS_RM34) + tk * 8192;
#pragma unroll
            for (int c2 = 0; c2 < 2; ++c2) {
                const int col = 16 * (cb + c2) + fr, r0 = 16 * rt + fq * 4;
                f4v m1 = unpack4(*(const uint2*)(Rt + col * RW_LD + r0));
                f4v m2 = brkT[c2], m3 = (f4v){0.f, 0.f, 0.f, 0.f};
                f4v m4 = unpack4(*(const uint2*)(KhT + col * RW_LD + r0));
#pragma unroll
                for (int ks = 0; ks < 2; ++ks) {
                    const int ko = ks * 32 + fq * 8;
                    const s8v fp = *(const s8v*)(PT + (16 * rt + fr) * RW_LD + ko), fw = *(const s8v*)(W1T + (16 * rt + fr) * RW_LD + ko);
                    const s8v gb = *(const s8v*)(Brb + col * RW_LD + ko), gh = *(const s8v*)(BhT + col * RW_LD + ko);
                    m1 = mfma16(fp, gb, m1);
                    m2 = mfma16(fw, gb, m2);
                    m3 = mfma16(fp, gh, m3);
                    m4 = mfma16(fw, gh, m4);
                }
                *(uint2*)(m12 + col * 64 + r0) = pack4(m1);
                *(uint2*)(m12 + 4096 + col * 64 + r0) = pack4(m2);
                *(uint2*)(m34 + col * 64 + r0) = pack4(m3);
                *(uint2*)(m34 + 4096 + col * 64 + r0) = pack4(m4);
            }
        }
    }
}
__device__ __forceinline__ void rwkv_apply_task(const P& p, int ei, int s, int h, int dir, unsigned char* dsm) {
    bf16* St = (bf16*)dsm;
    bf16* VT = St + 64 * RW_LD;
    bf16* M1 = VT + 64 * RW_LD;
    bf16* M2 = M1 + 64 * RW_LD;
    bf16* M3 = M2 + 64 * RW_LD;
    bf16* M4 = M3 + 64 * RW_LD;
    float* sGC = (float*)(M4 + 64 * RW_LD);
    float* Yf = sGC + 64;
    const Seq sq_ = get_seq(s);
    const int tid = opaque_tid(), lane = tid & 63, wid = tid >> 6, fr = lane & 15, fq = lane >> 4;
    const int rt = wid & 3, cb = 2 * (wid >> 2), hc0 = h * 64;
    bf16* opart = (bf16*)(p.ws + WS_PART + PART_SZ);
    f4v Sacc[2];
    LBAR();
#pragma unroll
    for (int c2 = 0; c2 < 2; ++c2) {
        const int v = 16 * (cb + c2) + fr, k0 = 16 * rt + fq * 4;
        if (sq_.lat) Sacc[c2] = *(const f4v*)(p.in[I_SRWKV] + ((((size_t)sq_.b * N_EVEN + ei) * 2 + dir) * 8 + h) * 4096 + v * 64 + k0);
        else Sacc[c2] = (f4v){0.f, 0.f, 0.f, 0.f};
        *(uint2*)(St + v * RW_LD + k0) = make_uint2(pack2(Sacc[c2][0], Sacc[c2][1]), pack2(Sacc[c2][2], Sacc[c2][3]));
    }
    const int nch = sq_.len >> 6;
    uint4 pm0, pm1, pm2, pm3, pvv; float pgc = 0.f;
    {
        const int cg0 = (sq_.start >> 6) + (dir ? nch - 1 : 0); const size_t tk0 = (size_t)cg0 * 8 + h;
        const int i = tid >> 3, c8 = (tid & 7) * 8;
        const bf16* m12 = (const bf16*)(p.ws + WS_RM12) + tk0 * 8192; const bf16* m34 = (const bf16*)(p.ws + WS_RM34) + tk0 * 8192;
        pm0 = *(const uint4*)(m12 + i * 64 + c8); pm1 = *(const uint4*)(m12 + 4096 + i * 64 + c8); pm2 = *(const uint4*)(m34 + i * 64 + c8); pm3 = *(const uint4*)(m34 + 4096 + i * 64 + c8);
        pvv = *(const uint4*)((const bf16*)(p.ws + WS_VSH) + (size_t)(cg0 * 64 + (dir ? 63 - lane : lane)) * 512 + hc0 + wid * 8);
        if (tid < 64) pgc = ((const float*)(p.ws + WS_GC))[tk0 * 64 + tid];
    }
    for (int cc = 0; cc < nch; ++cc) {
        const int cg = (sq_.start >> 6) + (dir ? nch - 1 - cc : cc);
        {
            const int i = tid >> 3, c8 = (tid & 7) * 8;
            *(uint4*)(M1 + i * RW_LD + c8) = pm0; *(uint4*)(M2 + i * RW_LD + c8) = pm1; *(uint4*)(M3 + i * RW_LD + c8) = pm2; *(uint4*)(M4 + i * RW_LD + c8) = pm3;
            const f8v vv = unpack8v(pvv);
#pragma unroll
            for (int j = 0; j < 8; ++j) VT[(wid * 8 + j) * RW_LD + lane] = f2bf(vv[j]);
            if (tid < 64) sGC[tid] = pgc;
            if (cc + 1 < nch) {
                const int cgn = (sq_.start >> 6) + (dir ? nch - 2 - cc : cc + 1); const size_t tkn = (size_t)cgn * 8 + h;
                const bf16* m12 = (const bf16*)(p.ws + WS_RM12) + tkn * 8192; const bf16* m34 = (const bf16*)(p.ws + WS_RM34) + tkn * 8192;
                pm0 = *(const uint4*)(m12 + i * 64 + c8); pm1 = *(const uint4*)(m12 + 4096 + i * 64 + c8); pm2 = *(const uint4*)(m34 + i * 64 + c8); pm3 = *(const uint4*)(m34 + 4096 + i * 64 + c8);
                pvv = *(const uint4*)((const bf16*)(p.ws + WS_VSH) + (size_t)(cgn * 64 + (dir ? 63 - lane : lane)) * 512 + hc0 + wid * 8);
                if (tid < 64) pgc = ((const float*)(p.ws + WS_GC))[tkn * 64 + tid];
            }
        }
        LBAR();
        {
            f4v yT[2], sn[2];
#pragma unroll
            for (int c2 = 0; c2 < 2; ++c2) { yT[c2] = (f4v){0.f, 0.f, 0.f, 0.f}; sn[c2] = yT[c2]; }
#pragma unroll
            for (int ks = 0; ks < 2; ++ks) {
                const int ko = ks * 32 + fq * 8;
                const s8v fs = *(const s8v*)(St + (16 * rt + fr) * RW_LD + ko), fv = *(const s8v*)(VT + (16 * rt + fr) * RW_LD + ko);
                const s8v f3 = *(const s8v*)(M3 + (16 * rt + fr) * RW_LD + ko), f4 = *(const s8v*)(M4 + (16 * rt + fr) * RW_LD + ko);
#pragma unroll
                for (int c2 = 0; c2 < 2; ++c2) {
                    const int ro = (16 * (cb + c2) + fr) * RW_LD + ko;
                    yT[c2] = mfma16(fs, *(const s8v*)(M1 + ro), yT[c2]); yT[c2] = mfma16(fv, *(const s8v*)(M2 + ro), yT[c2]);
                    sn[c2] = mfma16(f3, *(const s8v*)(St + ro), sn[c2]); sn[c2] = mfma16(f4, *(const s8v*)(VT + ro), sn[c2]);
                }
            }
            float gc[4];
#pragma unroll
            for (int r = 0; r < 4; ++r) gc[r] = sGC[16 * rt + fq * 4 + r];
#pragma unroll
            for (int c2 = 0; c2 < 2; ++c2) {
                const int tt = 16 * (cb + c2) + fr, t = cg * 64 + (dir ? 63 - tt : tt);
                if (dir == 0) *(uint2*)(opart + (size_t)t * 512 + hc0 + 16 * rt + fq * 4) = make_uint2(pack2(yT[c2][0], yT[c2][1]), pack2(yT[c2][2], yT[c2][3]));
                else *(f4v*)(Yf + tt * 68 + 16 * rt + fq * 4) = yT[c2];
#pragma unroll
                for (int r = 0; r < 4; ++r) Sacc[c2][r] = Sacc[c2][r] * gc[r] + sn[c2][r];
            }
        }
        LBAR();
#pragma unroll
        for (int c2 = 0; c2 < 2; ++c2) *(uint2*)(St + (16 * (cb + c2) + fr) * RW_LD + 16 * rt + fq * 4) = make_uint2(pack2(Sacc[c2][0], Sacc[c2][1]), pack2(Sacc[c2][2], Sacc[c2][3]));
        if (dir == 1) {
            const int i = tid >> 3, c8 = (tid & 7) * 8, t = cg * 64 + 63 - i;
            f8v o = *(const f8v*)(Yf + i * 68 + c8) + unpack8v(*(const uint4*)(opart + (size_t)t * 512 + hc0 + c8));
            float mu = 0.f;
#pragma unroll
            for (int j = 0; j < 8; ++j) mu += o[j];
            mu = red8(mu) * (1.0f / 64.f);
            o -= mu;
            float var = 0.f;
#pragma unroll
            for (int j = 0; j < 8; ++j) var += o[j] * o[j];
            const float r = frsq(red8(var) * (1.0f / 64.f) + 64e-5f);
            const float* bn = (const float*)(p.ws + WS_BONUS) + ((size_t)t * 8 + h) * 2;
            const float bsum = bn[0] + bn[1];
            const f8v vsh = unpack8v(*(const uint4*)((const bf16*)(p.ws + WS_VSH) + (size_t)t * 512 + hc0 + c8));
            const f8v zb = unpack8v(*(const uint4*)((const bf16*)(p.ws + WS_PROJ) + (size_t)t * EW + E_ZB + hc0 + c8));
            const f8v lg = *(const f8v*)(p.in[I_LNG] + ei * 512 + hc0 + c8), lb = *(const f8v*)(p.in[I_LNB] + ei * 512 + hc0 + c8);
            f8v y;
#pragma unroll
            for (int j = 0; j < 8; ++j) y[j] = (o[j] * r * lg[j] + lb[j] + bsum * vsh[j]) * siluf_(zb[j]);
            *(uint4*)((bf16*)(p.ws + WS_YCE) + (size_t)t * D + 512 + hc0 + c8) = pack8v(y);
        }
    }
    if (!sq_.lat) {
#pragma unroll
        for (int c2 = 0; c2 < 2; ++c2)
            *(f4v*)(p.out + OUT_RWKV + ((((size_t)sq_.b * N_EVEN + ei) * 2 + dir) * 8 + h) * 4096 + (16 * (cb + c2) + fr) * 64 + 16 * rt + fq * 4) = Sacc[c2];
    }
}
constexpr int EV_AP_LAT = NB_LAT * 8, EV_AP_CTX = NB_CTX * 8, EV_GLA_LAT = NB_LAT * 4, EV_GLA_CTX = NB_CTX * 4;
constexpr int EVEN_SCAN_ITEMS = EV_AP_LAT + EV_GLA_LAT + EV_AP_CTX + EV_GLA_CTX;
__device__ __forceinline__ void ph_even_scan_item(const P& p, int w, int ei, int dir, unsigned char* dsm) {
    int kind, sbase, x;
    if (w < EV_AP_LAT) { kind = 0; sbase = NB_CTX; x = w; }
    else if (w < EV_AP_LAT + EV_GLA_LAT) { kind = 1; sbase = NB_CTX; x = w - EV_AP_LAT; }
    else if (w < EV_AP_LAT + EV_GLA_LAT + EV_AP_CTX) { kind = 0; sbase = 0; x = w - EV_AP_LAT - EV_GLA_LAT; }
    else { kind = 1; sbase = 0; x = w - EV_AP_LAT - EV_GLA_LAT - EV_AP_CTX; }
    if (kind == 0) rwkv_apply_task(p, ei, sbase + x / 8, x & 7, dir, dsm);
    else gla_scan_task(p, ei, sbase + x / 4, x & 3, dir, dsm);
}

__device__ __forceinline__ void ph_fin_even(const P& p, int bid, int ei) {
    const int lane = LT & 63, t = bid * 4 + (LT >> 6);
    if (t >= T) return;
    const bf16* pr = (const bf16*)(p.ws + WS_PROJ) + (size_t)t * EW;
    const bf16* oaf = (const bf16*)(p.ws + WS_PART) + (size_t)t * 512;
    const bf16* oab = (const bf16*)(p.ws + WS_PART + PART_SZ) + (size_t)t * 512;
    const bf16* obf = (const bf16*)(p.ws + WS_PART + 2 * PART_SZ) + (size_t)t * 512;
    const bf16* obb = (const bf16*)(p.ws + WS_PART + 3 * PART_SZ) + (size_t)t * 512;
    bf16* yc = (bf16*)(p.ws + WS_HM) + (size_t)t * D;
    const int idx = lane * 8;
    {
        float o[8], ss = 0.f;
#pragma unroll
        for (int j = 0; j < 8; ++j) { o[j] = bf2f(oaf[idx + j]) + bf2f(oab[idx + j]); ss += o[j] * o[j]; }
        ss += __shfl_xor(ss, 1); ss += __shfl_xor(ss, 2); ss += __shfl_xor(ss, 4); ss += __shfl_xor(ss, 8);
        const float r = frsq(ss * (1.0f / 128.f) + EPS);
        const float* gn = p.in[I_GLAN] + ei * 128 + (idx & 127);
#pragma unroll
        for (int j = 0; j < 8; ++j) yc[idx + j] = f2bf(o[j] * r * gn[j] * siluf_(bf2f(pr[E_ZA + idx + j])));
    }
    {
        float o[8], mu = 0.f;
#pragma unroll
        for (int j = 0; j < 8; ++j) { o[j] = bf2f(obf[idx + j]) + bf2f(obb[idx + j]); mu += o[j]; }
        mu += __shfl_xor(mu, 1); mu += __shfl_xor(mu, 2); mu += __shfl_xor(mu, 4);
        mu *= (1.0f / 64.f);
        float var = 0.f;
#pragma unroll
        for (int j = 0; j < 8; ++j) { o[j] -= mu; var += o[j] * o[j]; }
        var += __shfl_xor(var, 1); var += __shfl_xor(var, 2); var += __shfl_xor(var, 4);
        const float r = frsq(var * (1.0f / 64.f) + 64e-5f);
        const int h = idx >> 6;
        const float* bn = (const float*)(p.ws + WS_BONUS) + ((size_t)t * 8 + h) * 2;
        const float bsum = bn[0] + bn[1];
        bool hl, hr; tok_nbr(t, hl, hr);
        const float* mix = p.in[I_MIX] + (size_t)ei * 1792 + FB_V + idx;
        const float* lg = p.in[I_LNG] + ei * 512 + idx;
        const float* lb = p.in[I_LNB] + ei * 512 + idx;
#pragma unroll
        for (int j = 0; j < 8; ++j) {
            const bf16* pv = pr + E_FB + FB_V + idx + j;
            const float x = bf2f(pv[0]);
            const float nl = hl ? bf2f(pv[-EW]) : 0.f, nr = hr ? bf2f(pv[EW]) : 0.f;
            const float vsh = x + mix[j] * (0.5f * (nl + nr) - x);
            yc[512 + idx + j] = f2bf((o[j] * r * lg[j] + lb[j] + bsum * vsh) * siluf_(bf2f(pr[E_ZB + idx + j])));
        }
    }
}

constexpr int ODD_PREP_ITEMS = (T / 64) * 4;
constexpr int PQ_LD = 136;
__device__ __forceinline__ void ph_odd_prep(const P& p, int item, int oi, unsigned char* dsm) {
    bf16* sq = (bf16*)dsm;
    bf16* sk = sq + 64 * PQ_LD;
    float* sA = (float*)(dsm + 2 * 64 * PQ_LD * 2);
    float* sX = sA + 2 * 64 * TI_LD;
    float* sTm = sX + 2 * 64 * TI_LD;
    float* slg = sTm + 2 * 8 * 16 * TI_TLD;
    float* sbt = slg + 128;
    float* sgc = sbt + 128;
    float* sbp = sgc + 128;
    const int tid = opaque_tid(), lane = tid & 63, wid = tid >> 6;
    const int cg = item >> 2, h = item & 3;
    const bf16* proj = (const bf16*)(p.ws + WS_PROJ);
    const float* cw = p.in[I_CONV] + (size_t)oi * 9 * 1536;
    LBAR();
    if (wid < 6) {
        const int part = wid >> 1, oc = lane & 15, i0 = ((wid & 1) * 4 + (lane >> 4)) * 8, t0 = cg * 64;
        const bool lat = t0 >= T_CTX;
        int pos0, len;
        if (!lat) { pos0 = t0 % L_CTX; len = L_CTX; } else { pos0 = (t0 - T_CTX) % L_LAT; len = L_LAT; }
        const int gr = pos0 >> 6, nrows = len >> 6;
        const int ch = part * 512 + h * 128 + oc * 8;
        const bool okl = i0 > 0 || (!lat && pos0 > 0), okr = i0 < 56 || (!lat && pos0 + 64 < len);
        f8v acc[8];
#pragma unroll
        for (int j = 0; j < 8; ++j) acc[j] = (f8v)(0.f);
#pragma unroll
        for (int di = -1; di <= 1; ++di) {
            const bool rv = lat ? (gr + di >= 0 && gr + di < nrows) : (di == 0);
            if (rv) {
                const float* w = cw + ((di + 1) * 3) * 1536 + ch;
                const f8v w0 = *(const f8v*)w, w1 = *(const f8v*)(w + 1536), w2 = *(const f8v*)(w + 3072);
                const bf16* src = proj + (size_t)(t0 + di * 64 + i0) * OW + O_QKV + ch;
                uint4 x[10];
                x[0] = *(const uint4*)(okl ? src - OW : src);
#pragma unroll
                for (int c = 0; c < 8; ++c) x[c + 1] = *(const uint4*)(src + (size_t)c * OW);
                x[9] = *(const uint4*)(okr ? src + (size_t)8 * OW : src);
                if (!okl) x[0] = make_uint4(0u, 0u, 0u, 0u);
                if (!okr) x[9] = make_uint4(0u, 0u, 0u, 0u);
#pragma unroll
                for (int c = 0; c < 10; ++c) {
                    const f8v xc = unpack8v(x[c]);
                    if (c < 8) acc[c] += xc * w0;
                    if (c >= 1 && c <= 8) acc[c - 1] += xc * w1;
                    if (c >= 2) acc[c - 2] += xc * w2;
                }
            }
        }
        bf16* qo = (bf16*)(p.ws + WS_QKVN) + (size_t)(t0 + i0) * 1536 + ch;
        bf16* so = (part == 0 ? sq : sk) + i0 * PQ_LD + oc * 8;
#pragma unroll
        for (int j = 0; j < 8; ++j) {
            f8v a = acc[j];
            float ss = 0.f;
#pragma unroll
            for (int e = 0; e < 8; ++e) { a[e] = siluf_(a[e]); ss += a[e] * a[e]; }
            if (part < 2) {
                ss = red16(ss);
                float r = frsq(ss + EPS);
                if (part == 0) r *= 0.08838834764831845f;
                a *= r;
            }
            const uint4 pk = pack8v(a);
            *(uint4*)(qo + (size_t)j * 1536) = pk;
            if (part < 2) *(uint4*)(so + j * PQ_LD) = pk;
        }
    } else {
        const int dir = wid - 6, i = lane, t = cg * 64 + i;
        float* g = (float*)(p.ws + WS_GATES) + (size_t)t * 16;
        const float x = bf2f(proj[(size_t)t * OW + O_G + dir * 4 + h]);
        const float lgv = -fexp(p.in[I_ALOG][oi * 8 + dir * 4 + h]) * softplusf_(x + p.in[I_DTB][oi * 8 + dir * 4 + h]);
        const float bv = sigmoidf_(bf2f(proj[(size_t)t * OW + O_BETA + dir * 4 + h]));
        g[dir * 4 + h] = lgv; g[8 + dir * 4 + h] = bv;
        slg[dir * 64 + i] = lgv; sbt[dir * 64 + i] = bv;
    }
    LBAR();
    if (tid < 2) {
        const int dir = tid; float c = 0.f;
        for (int i = 0; i < 64; ++i) { const int n = dir ? 63 - i : i; c += slg[dir * 64 + n]; sgc[dir * 64 + i] = c; sbp[dir * 64 + i] = sbt[dir * 64 + n]; }
    }
    LBAR();
    {
        const int rt = wid & 3, fr = lane & 15, fq = lane >> 4;
        f4v acc[4];
#pragma unroll
        for (int ct = 0; ct < 4; ++ct) acc[ct] = (f4v){0.f, 0.f, 0.f, 0.f};
#pragma unroll
        for (int ks = 0; ks < 4; ++ks) {
            const s8v a = *(const s8v*)((wid < 4 ? sk : sq) + (16 * rt + fr) * PQ_LD + fq * 8 + ks * 32);
#pragma unroll
            for (int ct = 0; ct < 4; ++ct) {
                const s8v bb = *(const s8v*)(sk + (16 * ct + fr) * PQ_LD + fq * 8 + ks * 32);
                acc[ct] = (wid < 4) ? mfma16(a, bb, acc[ct]) : mfma16(bb, a, acc[ct]);
            }
        }
        const size_t task0 = ((size_t)cg * 4 + h) * 2;
        bf16* qk0 = (bf16*)(p.ws + WS_QKM) + task0 * 4096; bf16* qk1 = qk0 + 4096;
        if (wid < 4) {
#pragma unroll
            for (int ct = 0; ct < 4; ++ct)
#pragma unroll
                for (int r = 0; r < 4; ++r) {
                    const int a = 16 * rt + fq * 4 + r, b = 16 * ct + fr, i1 = 63 - a, j1 = 63 - b;
                    const float v = acc[ct][r];
                    if (b < a) sA[a * TI_LD + b] = sbp[a] * v * fexp(sgc[a] - sgc[b]);
                    if (b > a) sA[64 * TI_LD + i1 * TI_LD + j1] = sbp[64 + i1] * v * fexp(sgc[64 + i1] - sgc[64 + j1]);
                }
        } else {
            const int a = 16 * rt + fr, i1 = 63 - a;
            const float ga0 = sgc[a], ga1 = sgc[64 + i1];
#pragma unroll
            for (int ct = 0; ct < 4; ++ct) {
                const int b0 = 16 * ct + fq * 4;
                f4v v0, v1;
#pragma unroll
                for (int r = 0; r < 4; ++r) {
                    const int b = b0 + r, j1 = 63 - b;
                    const float v = acc[ct][r];
                    v0[r] = b <= a ? v * fexp(ga0 - sgc[b]) : 0.f;
                    v1[3 - r] = b >= a ? v * fexp(ga1 - sgc[64 + j1]) : 0.f;
                }
                *(uint2*)(qk0 + a * 64 + b0) = pack4(v0);
                *(uint2*)(qk1 + i1 * 64 + 60 - b0) = pack4(v1);
            }
        }
    }
    LBAR();
    if (wid == 2) {
        float* gco = (float*)(p.ws + WS_GC) + ((size_t)cg * 4 + h) * 128;
        gco[lane] = sgc[lane]; gco[64 + lane] = sgc[64 + lane];
    }
    tri_inv64(sA + (wid >> 2) * 64 * TI_LD, sX + (wid >> 2) * 64 * TI_LD, sTm + (wid >> 2) * 8 * 16 * TI_TLD, wid & 3, lane, true);
    {
        const int dir = tid >> 8, i = (tid >> 2) & 63, c16 = (tid & 3) * 16;
        const float* xs = sX + dir * 64 * TI_LD + i * TI_LD + c16;
        bf16* ti = (bf16*)(p.ws + WS_TINV) + (((size_t)cg * 4 + h) * 2 + dir) * 4096 + i * 64 + c16;
        *(uint4*)ti = pack8v(*(const f8v*)xs); *(uint4*)(ti + 8) = pack8v(*(const f8v*)(xs + 8));
    }
}

constexpr int G_LDS = 136, G_LDT = 72;
__device__ __forceinline__ void gdn_scan_task(const P& p, int oi, int s, int h, int dir, unsigned char* dsm) {
    bf16* St = (bf16*)dsm;
    bf16* Kc = St + 128 * G_LDS;
    bf16* Qc = Kc + 64 * G_LDS;
    bf16* KeT = Qc + 64 * G_LDS;
    bf16* rT = KeT + 128 * G_LDT;
    bf16* dT = rT + 128 * G_LDT;
    bf16* Vc = dT;
    bf16* Ti = dT + 128 * G_LDT;
    bf16* Qk = Ti + 64 * G_LDT;
    float* sgc = (float*)(Qk + 64 * G_LDT);
    float* sbt = sgc + 64;
    const Seq sq_ = get_seq(s);
    const int tid = opaque_tid(), lane = tid & 63, wid = tid >> 6, fr = lane & 15, fq = lane >> 4;
    const int rt = wid & 3, chf = wid >> 2;
    const bf16* qkvn = (const bf16*)(p.ws + WS_QKVN);
    const float* gates = (const float*)(p.ws + WS_GATES);
    bf16* opart = (bf16*)(p.ws + WS_PART + (size_t)dir * PART_SZ);
    f4v Sacc[8];
    LBAR();
    if (sq_.lat) {
        const float* s0 = p.in[I_SGDN] + ((((size_t)sq_.b * N_ODD + oi) * 2 + dir) * 4 + h) * 128 * 128;
#pragma unroll
        for (int ct = 0; ct < 8; ++ct)
#pragma unroll
            for (int r = 0; r < 4; ++r) Sacc[ct][r] = s0[(16 * wid + fq * 4 + r) * 128 + 16 * ct + fr];
    } else {
#pragma unroll
        for (int ct = 0; ct < 8; ++ct) Sacc[ct] = (f4v){0.f, 0.f, 0.f, 0.f};
    }
#pragma unroll
    for (int ct = 0; ct < 8; ++ct) *(uint2*)(St + (16 * ct + fr) * G_LDS + 16 * wid + fq * 4) = make_uint2(pack2(Sacc[ct][0], Sacc[ct][1]), pack2(Sacc[ct][2], Sacc[ct][3]));
    const int nch = sq_.len >> 6;
    uint4 pq0, pq1, pk0, pk1, pw0, pw1, pti, pqk; float pgi, pgl, pbt = 0.f;
#define GDN_FETCH(CG) do { const size_t task_ = ((size_t)(CG) * 4 + h) * 2 + dir; const int t_ = (CG) * 64 + (dir ? 63 - lane : lane); \
        const bf16* src_ = qkvn + (size_t)t_ * 1536 + h * 128 + wid * 8; \
        pq0 = *(const uint4*)src_; pq1 = *(const uint4*)(src_ + 64); pk0 = *(const uint4*)(src_ + 512); pk1 = *(const uint4*)(src_ + 576); pw0 = *(const uint4*)(src_ + 1024); pw1 = *(const uint4*)(src_ + 1088); \
        { const int i2_ = tid >> 3, c8_ = (tid & 7) * 8; pti = *(const uint4*)((const bf16*)(p.ws + WS_TINV) + task_ * 4096 + i2_ * 64 + c8_); pqk = *(const uint4*)((const bf16*)(p.ws + WS_QKM) + task_ * 4096 + i2_ * 64 + c8_); } \
        const float* gcp_ = (const float*)(p.ws + WS_GC) + task_ * 64; pgi = gcp_[lane]; pgl = gcp_[63]; \
        if (tid < 64) pbt = gates[(size_t)((CG) * 64 + (dir ? 63 - tid : tid)) * 16 + 8 + dir * 4 + h]; } while (0)
    GDN_FETCH((sq_.start >> 6) + (dir ? nch - 1 : 0));
    for (int cc = 0; cc < nch; ++cc) {
        const int cl = dir ? nch - 1 - cc : cc;
        const int cg = (sq_.start >> 6) + cl;
        {
            const int i = lane;
            const float sc = fexp(pgl - pgi);
#pragma unroll
            for (int rep = 0; rep < 2; ++rep) {
                const int c8 = (wid + 8 * rep) * 8;
                const uint4 qv = rep ? pq1 : pq0, kv = rep ? pk1 : pk0, vv = rep ? pw1 : pw0;
                *(uint4*)(Qc + i * G_LDS + c8) = qv; *(uint4*)(Kc + i * G_LDS + c8) = kv; *(uint4*)(Vc + i * G_LDS + c8) = vv;
                const f8v kf = unpack8v(kv);
#pragma unroll
                for (int j = 0; j < 8; ++j) KeT[(c8 + j) * G_LDT + i] = f2bf(kf[j] * sc);
            }
            { const int i2 = tid >> 3, c8 = (tid & 7) * 8; *(uint4*)(Ti + i2 * G_LDT + c8) = pti; *(uint4*)(Qk + i2 * G_LDT + c8) = pqk; }
            if (tid < 64) { sgc[tid] = pgi; sbt[tid] = pbt; }
            if (cc + 1 < nch) { const int cln = dir ? nch - 2 - cc : cc + 1; GDN_FETCH((sq_.start >> 6) + cln); }
        }
        LBAR();
        f4v oacc[4];
        {
            f4v kS[4], qS[4];
#pragma unroll
            for (int ct = 0; ct < 4; ++ct) { kS[ct] = (f4v){0.f, 0.f, 0.f, 0.f}; qS[ct] = (f4v){0.f, 0.f, 0.f, 0.f}; }
#pragma unroll
            for (int ks = 0; ks < 4; ++ks) {
                const s8v ak = *(const s8v*)(Kc + (16 * rt + fr) * G_LDS + ks * 32 + fq * 8);
                const s8v aq = *(const s8v*)(Qc + (16 * rt + fr) * G_LDS + ks * 32 + fq * 8);
#pragma unroll
                for (int ct = 0; ct < 4; ++ct) {
                    const s8v bb = *(const s8v*)(St + (64 * chf + 16 * ct + fr) * G_LDS + ks * 32 + fq * 8);
                    kS[ct] = mfma16(ak, bb, kS[ct]);
                    qS[ct] = mfma16(bb, aq, qS[ct]);
                }
            }
            float eg[4], bt[4];
#pragma unroll
            for (int r = 0; r < 4; ++r) { const int i = 16 * rt + fq * 4 + r; eg[r] = fexp(sgc[i]); bt[r] = sbt[i]; }
            const float egc = fexp(sgc[16 * rt + fr]);
#pragma unroll
            for (int ct = 0; ct < 4; ++ct) {
                const int dv = 64 * chf + 16 * ct + fr;
                float rv[4];
#pragma unroll
                for (int r = 0; r < 4; ++r) { const int i = 16 * rt + fq * 4 + r; rv[r] = bt[r] * (bf2f(Vc[i * G_LDS + dv]) - eg[r] * kS[ct][r]); oacc[ct][r] = egc * qS[ct][r]; }
                *(uint2*)(rT + dv * G_LDT + 16 * rt + fq * 4) = make_uint2(pack2(rv[0], rv[1]), pack2(rv[2], rv[3]));
            }
        }
        LBAR();
        {
            f4v dl[4];
#pragma unroll
            for (int ct = 0; ct < 4; ++ct) dl[ct] = (f4v){0.f, 0.f, 0.f, 0.f};
#pragma unroll
            for (int ks = 0; ks < 2; ++ks) {
                const s8v a = *(const s8v*)(Ti + (16 * rt + fr) * G_LDT + ks * 32 + fq * 8);
#pragma unroll
                for (int ct = 0; ct < 4; ++ct) { const s8v bb = *(const s8v*)(rT + (64 * chf + 16 * ct + fr) * G_LDT + ks * 32 + fq * 8); dl[ct] = mfma16(a, bb, dl[ct]); }
            }
#pragma unroll
            for (int ct = 0; ct < 4; ++ct) { const int dv = 64 * chf + 16 * ct + fr;
                *(uint2*)(dT + dv * G_LDT + 16 * rt + fq * 4) = make_uint2(pack2(dl[ct][0], dl[ct][1]), pack2(dl[ct][2], dl[ct][3])); }
        }
        LBAR();
        {
#pragma unroll
            for (int ks = 0; ks < 2; ++ks) {
                const s8v a = *(const s8v*)(Qk + (16 * rt + fr) * G_LDT + ks * 32 + fq * 8);
#pragma unroll
                for (int ct = 0; ct < 4; ++ct) { const s8v bb = *(const s8v*)(dT + (64 * chf + 16 * ct + fr) * G_LDT + ks * 32 + fq * 8); oacc[ct] = mfma16(bb, a, oacc[ct]); }
            }
            {
                const int i = 16 * rt + fr, t = cg * 64 + (dir ? 63 - i : i);
#pragma unroll
                for (int ct = 0; ct < 4; ++ct) *(uint2*)(opart + (size_t)t * 512 + h * 128 + 64 * chf + 16 * ct + fq * 4) = pack4(oacc[ct]);
            }
            const float ge = fexp(sgc[63]);
#pragma unroll
            for (int ct = 0; ct < 8; ++ct) Sacc[ct] *= ge;
#pragma unroll
            for (int ks = 0; ks < 2; ++ks) {
                const s8v a = *(const s8v*)(KeT + (16 * wid + fr) * G_LDT + ks * 32 + fq * 8);
#pragma unroll
                for (int ct = 0; ct < 8; ++ct) { const s8v bb = *(const s8v*)(dT + (16 * ct + fr) * G_LDT + ks * 32 + fq * 8); Sacc[ct] = mfma16(a, bb, Sacc[ct]); }
            }
#pragma unroll
            for (int ct = 0; ct < 8; ++ct) *(uint2*)(St + (16 * ct + fr) * G_LDS + 16 * wid + fq * 4) = make_uint2(pack2(Sacc[ct][0], Sacc[ct][1]), pack2(Sacc[ct][2], Sacc[ct][3]));
        }
        LBAR();
    }
    if (!sq_.lat) {
        float* fs = p.out + OUT_GDN + ((((size_t)sq_.b * N_ODD + oi) * 2 + dir) * 4 + h) * 128 * 128;
#pragma unroll
        for (int ct = 0; ct < 8; ++ct)
#pragma unroll
            for (int r = 0; r < 4; ++r) fs[(16 * wid + fq * 4 + r) * 128 + 16 * ct + fr] = Sacc[ct][r];
    }
}
constexpr int S5_HLD = 136;
constexpr int S5_ITEMS = 2 * 32 * 2;
__device__ __forceinline__ void s5_task(const P& p, int oi, int dir, int g, int set, unsigned char* dsm) {
    float* sPr = (float*)dsm;
    float* sPi = sPr + 17 * 64;
    float* sBr = sPi + 17 * 64;
    float* sBi = sBr + 1024;
    float* sCr = sBi + 1024;
    float* sCi = sCr + 16 * 65;
    bf16* sK = (bf16*)(sCi + 16 * 65 + 16);
    bf16* HT = sK + 4096;
    bf16* sG = HT + 2 * 16 * S5_HLD;
    bf16* UT = sG + 256 * S5_HLD;
    const int tid = opaque_tid(), lane = tid & 63, wid = tid >> 6, fr = lane & 15, fq = lane >> 4;
    const int nseq = set ? NB_CTX : NB_LAT, sbase = set ? 0 : NB_CTX, len = set ? L_CTX : L_LAT;
    const bf16* proj = (const bf16*)(p.ws + WS_PROJ);
    bf16* ypart = (bf16*)(p.ws + WS_PART + (size_t)(2 + dir) * PART_SZ);
    const size_t pg = ((size_t)(oi * 2 + dir) * 32 + g);
    LBAR();
    if (tid < 64) {
        const float are = fminf(p.in[I_S5AR][pg * 64 + tid], -1e-4f), aim = p.in[I_S5AI][pg * 64 + tid];
        const float dt = expf(p.in[I_S5DT][pg]);
        const float mag = expf(are * dt), ar = mag * cosf(aim * dt), ai = mag * sinf(aim * dt);
        float pr = 1.f, pi = 0.f;
        for (int j = 0; j <= 16; ++j) { sPr[j * 64 + tid] = pr; sPi[j * 64 + tid] = pi; const float nr = pr * ar - pi * ai, ni = pr * ai + pi * ar; pr = nr; pi = ni; }
    }
    {
        const int st = tid >> 3, c0 = (tid & 7) * 2;
        const float are = fminf(p.in[I_S5AR][pg * 64 + st], -1e-4f), aim = p.in[I_S5AI][pg * 64 + st];
        const float dt = expf(p.in[I_S5DT][pg]);
        const float mag = expf(are * dt), ar = mag * cosf(aim * dt), ai = mag * sinf(aim * dt);
        const float den = are * are + aim * aim;
        const float fre = ((ar - 1.0f) * are + ai * aim) / den, fim = (ai * are - (ar - 1.0f) * aim) / den;
#pragma unroll
        for (int c = 0; c < 2; ++c) {
            const float br = p.in[I_S5BR][(pg * 64 + st) * 16 + c0 + c], bi = p.in[I_S5BI][(pg * 64 + st) * 16 + c0 + c];
            sBr[st * 16 + c0 + c] = fre * br - fim * bi; sBi[st * 16 + c0 + c] = fre * bi + fim * br;
        }
        for (int e = tid; e < 1024; e += 512) { sCr[(e >> 6) * 65 + (e & 63)] = p.in[I_S5CR][pg * 1024 + e]; sCi[(e >> 6) * 65 + (e & 63)] = p.in[I_S5CI][pg * 1024 + e]; }
    }
    LBAR();
    {
        const int lag = tid >> 5, co = (tid >> 1) & 15, c8 = (tid & 1) * 8;
        f8v acc = (f8v)(0.f);
        for (int q = 0; q < 64; ++q) {
            const float cr = sCr[co * 65 + q], ci = sCi[co * 65 + q], pr = sPr[lag * 64 + q], pi = sPi[lag * 64 + q];
            const float mr = cr * pr - ci * pi, mi = cr * pi + ci * pr;
            const f8v br = *(const f8v*)(sBr + q * 16 + c8), bi = *(const f8v*)(sBi + q * 16 + c8);
            acc += mr * br - mi * bi;
        }
        *(uint4*)(sK + (lag * 16 + co) * 16 + c8) = pack8v(acc);
    }
    {
        const int row = tid >> 1, tt = row >> 4, co = row & 15, half = tid & 1;
        for (int q0 = 0; q0 < 64; q0 += 8) {
            f8v v;
#pragma unroll
            for (int j = 0; j < 8; ++j) { const int q = q0 + j; const float cr = sCr[co * 65 + q], ci = sCi[co * 65 + q], pr = sPr[(tt + 1) * 64 + q], pi = sPi[(tt + 1) * 64 + q]; v[j] = half ? -(cr * pi + ci * pr) : cr * pr - ci * pi; }
            *(uint4*)(sG + row * S5_HLD + half * 64 + q0) = pack8v(v);
        }
    }
    LBAR();
    const int sp = fq >> 1, cih = (fq & 1) * 8;
    const int nsteps = len >> 4;
    constexpr int S5_ULD = 264;
    const int un = (tid & 255) >> 4, us = tid & 15;
    const bf16* ubase = proj + (size_t)get_seq(sbase + (un < nseq ? un : 0)).start * OW + O_U + g * 16;
#define S5_UADDR(K) (ubase + (size_t)(dir ? len - 1 - (16 * (K) + us) : 16 * (K) + us) * OW)
#define S5_UPUT(K, QA, QB) do { bf16* d_ = UT + ((K) & 1) * 16 * S5_ULD + un * S5_ULD + us * 16; *(uint4*)d_ = QA; *(uint4*)(d_ + 8) = QB; } while (0)
#define S5_ULOAD(K) const bf16* up_ = UT + ((K) & 1) * 16 * S5_ULD + fr * S5_ULD + 8 * fq; \
        const s8v u0 = *(const s8v*)up_, u1 = *(const s8v*)(up_ + 32), u2 = *(const s8v*)(up_ + 64), u3 = *(const s8v*)(up_ + 96), \
                  u4 = *(const s8v*)(up_ + 128), u5 = *(const s8v*)(up_ + 160), u6 = *(const s8v*)(up_ + 192), u7 = *(const s8v*)(up_ + 224)
    if (wid < 4) {
        s8v wre[8], wim[8];
        {
            const int pp = 16 * wid + fr;
#pragma unroll
            for (int m = 0; m < 8; ++m) {
                const int sidx = 15 - (2 * m + sp);
                const float pr = sPr[sidx * 64 + pp], pi = sPi[sidx * 64 + pp];
#pragma unroll
                for (int j = 0; j < 8; ++j) {
                    const float br = sBr[pp * 16 + cih + j], bi = sBi[pp * 16 + cih + j];
                    wre[m][j] = (short)f2bf(pr * br - pi * bi); wim[m][j] = (short)f2bf(pr * bi + pi * br);
                }
            }
        }
        float a16r[4], a16i[4], hr[4], hi[4];
#pragma unroll
        for (int r = 0; r < 4; ++r) {
            const int pp = 16 * wid + fq * 4 + r;
            a16r[r] = sPr[16 * 64 + pp]; a16i[r] = sPi[16 * 64 + pp];
            hr[r] = 0.f; hi[r] = 0.f;
            if (set == 0 && fr < nseq) { const size_t o = (((size_t)fr * N_ODD + oi) * 2 + dir) * 32 * 64 + g * 64 + pp; hr[r] = p.in[I_SS5R][o]; hi[r] = p.in[I_SS5I][o]; }
        }
        *(uint2*)(HT + fr * S5_HLD + 16 * wid + fq * 4) = make_uint2(pack2(hr[0], hr[1]), pack2(hr[2], hr[3]));
        *(uint2*)(HT + fr * S5_HLD + 64 + 16 * wid + fq * 4) = make_uint2(pack2(hi[0], hi[1]), pack2(hi[2], hi[3]));
        uint4 qa0, qb0, qa1, qb1, qa2, qb2, qa3, qb3;
        { const bf16* a_ = S5_UADDR(0); qa0 = *(const uint4*)a_; qb0 = *(const uint4*)(a_ + 8); S5_UPUT(0, qa0, qb0); }
#define S5_QLOAD(K, QA, QB) do { if ((K) < nsteps) { const bf16* a_ = S5_UADDR(K); QA = *(const uint4*)a_; QB = *(const uint4*)(a_ + 8); } } while (0)
        S5_QLOAD(1, qa1, qb1); S5_QLOAD(2, qa2, qb2); S5_QLOAD(3, qa3, qb3); S5_QLOAD(4, qa0, qb0);
        LBAR();
#define S5_STATE_STEP(K, QA, QB) do { \
            const int k = (K); \
            S5_ULOAD(k); \
            if (k + 1 < nsteps) { S5_UPUT(k + 1, QA, QB); S5_QLOAD(k + 5, QA, QB); } \
            f4v zr = (f4v){0.f, 0.f, 0.f, 0.f}, zi = zr; \
            zr = mfma16(wre[0], u0, zr); zi = mfma16(wim[0], u0, zi); zr = mfma16(wre[1], u1, zr); zi = mfma16(wim[1], u1, zi); \
            zr = mfma16(wre[2], u2, zr); zi = mfma16(wim[2], u2, zi); zr = mfma16(wre[3], u3, zr); zi = mfma16(wim[3], u3, zi); \
            zr = mfma16(wre[4], u4, zr); zi = mfma16(wim[4], u4, zi); zr = mfma16(wre[5], u5, zr); zi = mfma16(wim[5], u5, zi); \
            zr = mfma16(wre[6], u6, zr); zi = mfma16(wim[6], u6, zi); zr = mfma16(wre[7], u7, zr); zi = mfma16(wim[7], u7, zi); \
            _Pragma("unroll") for (int r = 0; r < 4; ++r) { const float nr = a16r[r] * hr[r] - a16i[r] * hi[r] + zr[r], ni = a16r[r] * hi[r] + a16i[r] * hr[r] + zi[r]; hr[r] = nr; hi[r] = ni; } \
            bf16* hb = HT + ((k + 1) & 1) * 16 * S5_HLD; \
            *(uint2*)(hb + fr * S5_HLD + 16 * wid + fq * 4) = make_uint2(pack2(hr[0], hr[1]), pack2(hr[2], hr[3])); \
            *(uint2*)(hb + fr * S5_HLD + 64 + 16 * wid + fq * 4) = make_uint2(pack2(hi[0], hi[1]), pack2(hi[2], hi[3])); \
            LBAR(); } while (0)
        for (int k4 = 0; k4 < nsteps; k4 += 4) {
            S5_STATE_STEP(k4, qa1, qb1); S5_STATE_STEP(k4 + 1, qa2, qb2); S5_STATE_STEP(k4 + 2, qa3, qb3); S5_STATE_STEP(k4 + 3, qa0, qb0);
        }
        if (set == 1 && fr < nseq) {
#pragma unroll
            for (int r = 0; r < 4; ++r) { const size_t o = (((size_t)fr * N_ODD + oi) * 2 + dir) * 32 * 64 + g * 64 + 16 * wid + fq * 4 + r; p.out[OUT_S5R + o] = hr[r]; p.out[OUT_S5I + o] = hi[r]; }
        }
    } else {
        const int t0 = 4 * (RFL(wid) - 4);
        s8v klr[18];
#pragma unroll
        for (int e = 0; e < 18; ++e) { const int lg = t0 + 3 - e - sp; klr[e] = (lg >= 0) ? *(const s8v*)(sK + (lg * 16 + fr) * 16 + cih) : (s8v){0, 0, 0, 0, 0, 0, 0, 0}; }
        LBAR();
        for (int k = 0; k < nsteps; ++k) {
            S5_ULOAD(k);
            const bf16* hb = HT + (k & 1) * 16 * S5_HLD + fr * S5_HLD + 8 * fq;
            const s8v h0 = *(const s8v*)hb, h1 = *(const s8v*)(hb + 32), h2 = *(const s8v*)(hb + 64), h3 = *(const s8v*)(hb + 96);
            f4v y0 = (f4v){0.f, 0.f, 0.f, 0.f}, y1 = y0, y2 = y0, y3 = y0;
            {
                const bf16* gp = sG + (t0 * 16 + fr) * S5_HLD + 8 * fq;
#define S5_G4(KS, H) do { y0 = mfma16(*(const s8v*)(gp + 32 * (KS)), H, y0); y1 = mfma16(*(const s8v*)(gp + 16 * S5_HLD + 32 * (KS)), H, y1); \
                          y2 = mfma16(*(const s8v*)(gp + 32 * S5_HLD + 32 * (KS)), H, y2); y3 = mfma16(*(const s8v*)(gp + 48 * S5_HLD + 32 * (KS)), H, y3); } while (0)
                S5_G4(0, h0); S5_G4(1, h1); S5_G4(2, h2); S5_G4(3, h3);
#define S5_K4(M, U) do { if (2 * (M) <= t0 + 0) y0 = mfma16(klr[3 + 2 * (M)], U, y0); if (2 * (M) <= t0 + 1) y1 = mfma16(klr[2 + 2 * (M)], U, y1); \
                         if (2 * (M) <= t0 + 2) y2 = mfma16(klr[1 + 2 * (M)], U, y2); if (2 * (M) <= t0 + 3) y3 = mfma16(klr[0 + 2 * (M)], U, y3); } while (0)
                S5_K4(0, u0); S5_K4(1, u1); S5_K4(2, u2); S5_K4(3, u3); S5_K4(4, u4); S5_K4(5, u5); S5_K4(6, u6); S5_K4(7, u7);
            }
            if (fr < nseq) {
                const int tb_ = get_seq(sbase + fr).start;
#define S5_ST(TT, Y) do { const int pos = 16 * k + t0 + (TT), tok = tb_ + (dir ? len - 1 - pos : pos); *(uint2*)(ypart + (size_t)tok * 512 + g * 16 + fq * 4) = pack4(Y); } while (0)
                S5_ST(0, y0); S5_ST(1, y1); S5_ST(2, y2); S5_ST(3, y3);
            }
            LBAR();
        }
    }
}
constexpr int ODD_GDN_ITEMS = NSEQ * 8;
constexpr int ODD_SCAN_ITEMS = ODD_GDN_ITEMS + S5_ITEMS;
__device__ __forceinline__ void ph_odd_scan_item(const P& p, int w, int oi, float* smem_full) {
    unsigned char* dsm = (unsigned char*)smem_full;
    const int nlg = NB_LAT * 8, ncg = NB_CTX * 8;
    if (w < ncg) { gdn_scan_task(p, oi, w / 8, (w % 8) >> 1, w & 1, dsm); return; }
    w -= ncg;
    if (w < 64) { __syncthreads(); s5_task(p, oi, w >> 5, w & 31, 0, dsm); return; }
    w -= 64;
    if (w < nlg) { gdn_scan_task(p, oi, NB_CTX + w / 8, (w % 8) >> 1, w & 1, dsm); return; }
    w -= nlg;
    __syncthreads(); s5_task(p, oi, w >> 5, w & 31, 1, dsm);
}
__device__ __forceinline__ void ph_fin_odd_a(const P& p, int bid, int oi) {
    const int lane = LT & 63, t = bid * 4 + (LT >> 6);
    if (t >= T) return;
    const bf16* pr = (const bf16*)(p.ws + WS_PROJ) + (size_t)t * OW;
    const bf16* of = (const bf16*)(p.ws + WS_PART) + (size_t)t * 512;
    const bf16* ob = (const bf16*)(p.ws + WS_PART + PART_SZ) + (size_t)t * 512;
    const bf16* yf = (const bf16*)(p.ws + WS_PART + 2 * PART_SZ) + (size_t)t * 512;
    const bf16* yb = (const bf16*)(p.ws + WS_PART + 3 * PART_SZ) + (size_t)t * 512;
    bf16* ysw = (bf16*)(p.ws + WS_PART + 2 * PART_SZ) + (size_t)t * 512;
    bf16* yc = (bf16*)(p.ws + WS_HM) + (size_t)t * D;
    const int idx = lane * 8;
    float o[8], ss = 0.f;
#pragma unroll
    for (int j = 0; j < 8; ++j) { o[j] = bf2f(of[idx + j]) + bf2f(ob[idx + j]); ss += o[j] * o[j]; }
    ss += __shfl_xor(ss, 1); ss += __shfl_xor(ss, 2); ss += __shfl_xor(ss, 4); ss += __shfl_xor(ss, 8);
    const float r = frsq(ss * (1.0f / 128.f) + EPS);
    const float* gn = p.in[I_GDNN] + oi * 128 + (idx & 127);
    const float* dsk = p.in[I_S5D] + oi * 512 + idx;
#pragma unroll
    for (int j = 0; j < 8; ++j) {
        yc[idx + j] = f2bf(o[j] * r * gn[j] * siluf_(bf2f(pr[O_ZC + idx + j])));
        const float y = bf2f(yf[idx + j]) + bf2f(yb[idx + j]) + dsk[j] * bf2f(pr[O_U + idx + j]);
        ysw[idx + j] = f2bf(gelu_tanh(y));
    }
}
__device__ __forceinline__ void ph_fin_odd_b(const P& p, int bid, int oi) {
    const size_t e = ((size_t)bid * 256 + LT) * 4;
    if (e >= (size_t)T * 512) return;
    const int t = (int)(e >> 9), idx = (int)(e & 511);
    const bf16* pr = (const bf16*)(p.ws + WS_PROJ) + (size_t)t * OW;
    const bf16* gl = (const bf16*)(p.ws + WS_PART + 2 * PART_SZ) + (size_t)t * 512;
    bf16* yc = (bf16*)(p.ws + WS_HM) + (size_t)t * D + 512;
#pragma unroll
    for (int j = 0; j < 4; ++j) {
        const float ys = bf2f(yc[idx + j]);
        yc[idx + j] = f2bf(ys * sigmoidf_(bf2f(gl[idx + j]) + p.in[I_GLUB][oi * 512 + idx + j]) * siluf_(bf2f(pr[O_ZD + idx + j])));
    }
}

enum { PK_PREP0, PK_HMOD0, PK_GEMM_IN, PK_EVEN_SCAN, PK_FIN_EVEN, PK_ODD_PREP, PK_ODD_SCAN, PK_FIN_ODD_A, PK_GEMM_GLU, PK_FIN_ODD_B, PK_GEMM_OUT, PK_POST, PK_RWKV_PREP0, PK_RWKV_PREP1, PK_EVEN_SCAN1 };
constexpr int NPH = 2 + (DEPTH / 2) * 14;
constexpr int TOKB = (T + 3) / 4;
static_assert(DEPTH % 2 == 0, "even depth expected");
__host__ __device__ inline void phase_desc(int ph, int& kind, int& layer) {
    if (ph == 0) { kind = PK_PREP0; layer = 0; return; }
    if (ph == 1) { kind = PK_HMOD0; layer = 0; return; }
    ph -= 2;
    const int pair = ph / 14, r = ph % 14;
    if (r < 7) { layer = 2 * pair; kind = r == 0 ? PK_GEMM_IN : r == 1 ? PK_RWKV_PREP0 : r == 2 ? PK_EVEN_SCAN : r == 3 ? PK_RWKV_PREP1 : r == 4 ? PK_EVEN_SCAN1 : r == 5 ? PK_GEMM_OUT : PK_POST; }
    else { const int q = r - 7; layer = 2 * pair + 1; kind = q == 0 ? PK_GEMM_IN : q == 1 ? PK_ODD_PREP : q == 2 ? PK_ODD_SCAN : q == 3 ? PK_FIN_ODD_A : q == 4 ? PK_GEMM_GLU : q == 5 ? PK_GEMM_OUT : PK_POST; }
}
__host__ __device__ inline bool phase_is_gemm(int kind) { return kind == PK_GEMM_IN || kind == PK_GEMM_GLU || kind == PK_GEMM_OUT; }
__host__ __device__ inline int phase_nblk(int kind, int layer) {
    switch (kind) {
        case PK_PREP0: return MOD_VB + WT_TILES;
        case PK_FIN_ODD_B: return (T * 512 / 4 + 255) / 256;
        default: return TOKB;
    }
}
__device__ __forceinline__ void do_phase(const P& p, int kind, int layer, int vb, float* smem) {
    const int i = layer >> 1;
    switch (kind) {
        case PK_PREP0: if (vb < MOD_VB) ph_mod(p, vb, smem); else ph_wt(p, vb - MOD_VB, smem); break;
        case PK_HMOD0: ph_hmod0(p, vb); break;
        case PK_FIN_EVEN: ph_fin_even(p, vb, i); break;
        case PK_FIN_ODD_A: ph_fin_odd_a(p, vb, i); break;
        case PK_FIN_ODD_B: ph_fin_odd_b(p, vb, i); break;
        case PK_POST: ph_post(p, vb, layer); break;
    }
}
__device__ __forceinline__ void do_gemm(const P& p, int kind, int layer, int G, int c, unsigned char* dsm) {
    const int i = layer >> 1;
    const bf16* hm = (const bf16*)(p.ws + WS_HM);
    pg8::StaticOrder S;
    LDS_AS unsigned char* lds = (LDS_AS unsigned char*)dsm;
    if (kind == PK_GEMM_IN) {
        if ((layer & 1) == 0) { pg8::Gemm g{hm, (const bf16*)(p.ws + WS_WTE) + (size_t)i * EWP * D, T, EWP, D, D}; S.init(T, EWP, G, c); pg8::EpiBf16 E{(bf16*)(p.ws + WS_PROJ), EW, EW}; pg8::gemm_phase(lds, g, S, E); }
        else { pg8::Gemm g{hm, (const bf16*)(p.ws + WS_WTO) + (size_t)i * OWP * D, T, OWP, D, D}; S.init(T, OWP, G, c); pg8::EpiBf16 E{(bf16*)(p.ws + WS_PROJ), OW, OW}; pg8::gemm_phase(lds, g, S, E); }
    } else if (kind == PK_GEMM_GLU) {
        const bf16* ysb = (const bf16*)(p.ws + WS_PART + 2 * PART_SZ);
        pg8::Gemm g{ysb, (const bf16*)(p.ws + WS_WTGLU) + (size_t)i * 512 * 512, T, 512, 512, 512}; S.init(T, 512, G, c);
        pg8::EpiGlu E{(bf16*)(p.ws + WS_HM) + 512, ysb, (const bf16*)(p.ws + WS_PROJ) + O_ZD, p.in[I_GLUB] + i * 512}; pg8::gemm_phase(lds, g, S, E);
    } else {
        const bf16* ya = (layer & 1) ? hm : (const bf16*)(p.ws + WS_YCE);
        pg8::Gemm g{ya, (const bf16*)(p.ws + WS_WTOUT) + (size_t)layer * D * D, T, D, D, D}; S.init(T, D, G, c); pg8::EpiF32 E{(float*)(p.ws + WS_PROJ), D}; pg8::gemm_phase(lds, g, S, E);
    }
}
constexpr int LDS_BYTES = 163840;
constexpr bool EVEN_FUSED_SCHED = (NB_LAT == 8 && NB_CTX == 16 && L_CTX == 256 && L_LAT == 1024);
#ifndef REP_SCAN
#define REP_SCAN 1
#endif
#ifndef REP_GEMM
#define REP_GEMM 1
#endif

#ifdef CPU_EMU
__global__ void k_phase(P p, int kind, int layer, int nb) {
    __shared__ __attribute__((aligned(16))) unsigned char dsm[LDS_BYTES];
    if (phase_is_gemm(kind)) { do_gemm(p, kind, layer, gridDim.x, blockIdx.x, dsm); return; }
    if (kind == PK_ODD_SCAN) { ph_odd_scan_item(p, blockIdx.x, layer >> 1, (float*)dsm); return; }
    if (kind == PK_ODD_PREP) { ph_odd_prep(p, blockIdx.x, layer >> 1, dsm); return; }
    if (kind == PK_EVEN_SCAN || kind == PK_EVEN_SCAN1) { ph_even_scan_item(p, blockIdx.x, layer >> 1, kind == PK_EVEN_SCAN1, dsm); return; }
    if (kind == PK_RWKV_PREP0 || kind == PK_RWKV_PREP1) { rwkv_prep_phase(p, layer >> 1, kind == PK_RWKV_PREP1, blockIdx.x, gridDim.x, RWKV_PREP_ITEMS, dsm); return; }
    const int half = threadIdx.x >> 8, vb = 2 * blockIdx.x + half;
    if (vb < nb) do_phase(p, kind, layer, vb, (float*)dsm + half * 16384);
}
void emu_hook(const char* stage, int layer, const P& p);
extern "C" void kernel_launch(void* const* d_in, const int* in_sizes, int n_in, void* d_out, int out_size, void* d_ws, size_t ws_size, hipStream_t stream) {
    P p{};
    for (int i = 0; i < 44; ++i) p.in[i] = (const float*)d_in[i];
    p.out = (float*)d_out; p.ws = (char*)d_ws;
    static const char* names[] = {"prep0", "hmod", "proj", "even_scan0", "ycat", "odd_prep", "odd_scan", "fin_odd_a", "ycat", "ycat", "outproj", "post", "rwkv_prep0", "rwkv_prep1", "even_scan"};
    for (int ph = 0; ph < NPH; ++ph) {
        int kind, layer; phase_desc(ph, kind, layer);
        const int nb = phase_nblk(kind, layer);
        EMU_LAUNCH(k_phase, phase_is_gemm(kind) ? 3 : kind == PK_ODD_SCAN ? ODD_SCAN_ITEMS : (kind == PK_EVEN_SCAN || kind == PK_EVEN_SCAN1) ? EVEN_SCAN_ITEMS : (kind == PK_RWKV_PREP0 || kind == PK_RWKV_PREP1) ? RWKV_PREP_ITEMS : kind == PK_ODD_PREP ? ODD_PREP_ITEMS : (nb + 1) / 2, 512, p, kind, layer, nb);
        emu_hook(names[kind], layer, p);
    }
}
#else

#define XB_TMO      128
#define XB_XCNT(j)  (256  + 64 * (j))
#define XB_XSUB(j)  (1280 + 64 * (j))
#define XB_XGEN(j)  (2304 + 64 * (j))
#define XB_TOP      3328
#define XB_TOPGEN   3392
#define XCD_BAR_WORDS 3456
#define XB_SPIN_CAP (1u << 18)
__device__ __forceinline__ unsigned xb_ld(unsigned* p)              { return __hip_atomic_load(p, __ATOMIC_RELAXED, __HIP_MEMORY_SCOPE_AGENT); }
__device__ __forceinline__ unsigned xb_add(unsigned* p, unsigned v) { return __hip_atomic_fetch_add(p, v, __ATOMIC_RELAXED, __HIP_MEMORY_SCOPE_AGENT); }
__device__ __forceinline__ unsigned xb_xcc_id() { return (unsigned)__builtin_amdgcn_s_getreg((3 << 11) | 20) & 0xFu; }
#define XB_SPIN(cond, bar) do { unsigned _sp = 0; while (cond) { __builtin_amdgcn_s_sleep(1); \
    if ((++_sp & 255u) == 0u) { if (xb_ld(&(bar)[XB_TMO])) break; if (_sp > XB_SPIN_CAP) { atomicAdd(&(bar)[XB_TMO], 1u); break; } } } } while (0)
struct XcdBarrier { unsigned* bar; unsigned x; volatile LDS_AS unsigned* st; };
__device__ __forceinline__ XcdBarrier xcd_barrier_post(unsigned* bar, volatile LDS_AS unsigned* st) {
    XcdBarrier b; b.bar = bar; b.x = xb_xcc_id(); b.st = st;
    if (threadIdx.x == 0) (void)xb_add(&bar[XB_XCNT(b.x)], 1u);
    return b;
}
__device__ __forceinline__ void xcd_barrier_complete(unsigned* bar, unsigned x, unsigned& nloc, unsigned& nx) {
    const unsigned G = gridDim.x * gridDim.y * gridDim.z;
    unsigned sum, cnt, mine, sp = 0u;
    for (;;) {
        sum = 0u; cnt = 0u; mine = 0u;
#pragma unroll
        for (unsigned j = 0; j < 16; ++j) { const unsigned c = xb_ld(&bar[XB_XCNT(j)]); sum += c; cnt += (c > 0u) ? 1u : 0u; mine = (j == x) ? c : mine; }
        if (sum == G) break;
        __builtin_amdgcn_s_sleep(1);
        if ((++sp & 255u) == 0u) { if (xb_ld(&bar[XB_TMO])) break; if (sp > XB_SPIN_CAP) { atomicAdd(&bar[XB_TMO], 1u); break; } }
    }
    nloc = mine > 0u ? mine : 1u; nx = cnt > 0u ? cnt : 1u;
}
__device__ __forceinline__ void xcd_barrier(const XcdBarrier& b) {
    asm volatile("s_waitcnt vmcnt(0)" ::: "memory");
    __syncthreads();
    if (threadIdx.x == 0) {
        unsigned* bar = b.bar;
        __builtin_amdgcn_s_waitcnt(0);
        unsigned nloc = b.st[0], nx = b.st[1];
        if (nloc == 0u) { xcd_barrier_complete(bar, b.x, nloc, nx); b.st[0] = nloc; b.st[1] = nx; }
        const unsigned old = xb_add(&bar[XB_XSUB(b.x)], 1u);
        const unsigned gen = old / nloc;
        if (old + 1u == (gen + 1u) * nloc) {
            __builtin_amdgcn_fence(__ATOMIC_RELEASE, "agent");
            asm volatile("s_waitcnt vmcnt(0)" ::: "memory");
            const unsigned og = xb_add(&bar[XB_TOP], 1u);
            const unsigned tg = og / nx;
            if (og + 1u == (tg + 1u) * nx) xb_add(&bar[XB_TOPGEN], 1u);
            else XB_SPIN(xb_ld(&bar[XB_TOPGEN]) == tg, bar);
            __builtin_amdgcn_fence(__ATOMIC_ACQUIRE, "agent");
            xb_add(&bar[XB_XGEN(b.x)], 1u);
            asm volatile("s_waitcnt vmcnt(0)" ::: "memory");
        } else {
            XB_SPIN(xb_ld(&bar[XB_XGEN(b.x)]) == gen, bar);
            __builtin_amdgcn_fence(__ATOMIC_ACQUIRE, "agent");
            asm volatile("s_waitcnt vmcnt(0)" ::: "memory");
        }
    }
    __syncthreads();
}
extern __shared__ __attribute__((aligned(16))) unsigned char dsm[];
#define RUN_PHASE(KIND, LAYER) do { const int nb_ = phase_nblk(KIND, LAYER); const int half_ = opaque_tid() >> 8; \
    for (int b_ = blockIdx.x; 2 * b_ < nb_; b_ += gridDim.x) { const int vb_ = 2 * b_ + half_; if (vb_ < nb_) do_phase(p, KIND, LAYER, vb_, (float*)dsm + half_ * 16384); } } while (0)
#define RUN_GEMM(KIND, LAYER) do_gemm(p, KIND, LAYER, gridDim.x, blockIdx.x, dsm)
typedef const __attribute__((address_space(4))) P* KP;
__device__ __forceinline__ const P& phase_args(KP pk) { asm volatile("" : "+s"(pk)); return *(const P*)pk; }
__global__ void __launch_bounds__(512) mega(P p_unused) {
    const KP pk = (KP)__builtin_amdgcn_kernarg_segment_ptr();
    volatile LDS_AS unsigned* xst = (volatile LDS_AS unsigned*)(dsm + LDS_BYTES - 16);
    if (threadIdx.x == 0) { xst[0] = 0u; xst[1] = 0u; }
    __syncthreads();
    XcdBarrier xb;
    { const P& p = phase_args(pk); xb = xcd_barrier_post((unsigned*)(p.ws + WS_BAR), xst); }
#define GSYNC() do { const P& pb_ = phase_args(pk); XcdBarrier b_ = xb; b_.bar = (unsigned*)(pb_.ws + WS_BAR); xcd_barrier(b_); } while (0)
    { const P& p = phase_args(pk); RUN_PHASE(PK_PREP0, 0); } GSYNC();
    { const P& p = phase_args(pk); RUN_PHASE(PK_HMOD0, 0); } GSYNC();
#pragma nounroll
    for (int pair = 0; pair < DEPTH / 2; ++pair) {
        const int le = 2 * pair, lo = 2 * pair + 1;
        { const P& p = phase_args(pk); RUN_GEMM(PK_GEMM_IN, le); } GSYNC();
#pragma nounroll
        for (int dir_ = 0; dir_ < 2; ++dir_) {
            if (EVEN_FUSED_SCHED && gridDim.x == 256) {
                { const P& p = phase_args(pk); const int hg = blockIdx.x & 7, q = blockIdx.x >> 3;
                  int cg0, ncg;
                  if (q < 4) { const int x = hg * 4 + q; gla_scan_task(p, pair, NB_CTX + x / 4, x & 3, dir_, dsm); cg0 = q * 3; ncg = 3; }
                  else if (q < 12) { const int x = hg * 8 + (q - 4); gla_scan_task(p, pair, x / 4, x & 3, dir_, dsm); cg0 = 12 + (q - 4) * 5; ncg = 5; }
                  else { cg0 = 52 + (q - 12) * 7; ncg = 7; }
                  rwkv_prep_phase(p, pair, dir_, cg0 * 8 + hg, 8, (cg0 + ncg) * 8, dsm); } GSYNC();
                { const P& p = phase_args(pk); for (int w_ = blockIdx.x; w_ < EV_AP_LAT + EV_AP_CTX; w_ += gridDim.x) rwkv_apply_task(p, pair, w_ < EV_AP_LAT ? NB_CTX + w_ / 8 : (w_ - EV_AP_LAT) / 8, w_ & 7, dir_, dsm); } GSYNC();
            } else {
                { const P& p = phase_args(pk); rwkv_prep_phase(p, pair, dir_, blockIdx.x, gridDim.x, RWKV_PREP_ITEMS, dsm); } GSYNC();
                { const P& p = phase_args(pk); for (int w_ = blockIdx.x; w_ < EVEN_SCAN_ITEMS; w_ += gridDim.x) ph_even_scan_item(p, w_, pair, dir_, dsm); } GSYNC();
            }
        }
        { const P& p = phase_args(pk); RUN_GEMM(PK_GEMM_OUT, le); } GSYNC();
        { const P& p = phase_args(pk); RUN_PHASE(PK_POST, le); } GSYNC();
        { const P& p = phase_args(pk); RUN_GEMM(PK_GEMM_IN, lo); } GSYNC();
        { const P& p = phase_args(pk); for (int w_ = blockIdx.x; w_ < ODD_PREP_ITEMS; w_ += gridDim.x) ph_odd_prep(p, w_, pair, dsm); } GSYNC();
        { const P& p = phase_args(pk); for (int w_ = blockIdx.x; w_ < ODD_SCAN_ITEMS; w_ += gridDim.x) ph_odd_scan_item(p, w_, pair, (float*)dsm); } GSYNC();
        { const P& p = phase_args(pk); RUN_PHASE(PK_FIN_ODD_A, lo); } GSYNC();
        { const P& p = phase_args(pk); RUN_GEMM(PK_GEMM_GLU, lo); } GSYNC();
        { const P& p = phase_args(pk); RUN_GEMM(PK_GEMM_OUT, lo); } GSYNC();
        { const P& p = phase_args(pk); RUN_PHASE(PK_POST, lo); }
        if (pair + 1 < DEPTH / 2) GSYNC();
    }
}
extern "C" void kernel_launch(void* const* d_in, const int* in_sizes, int n_in, void* d_out, int out_size, void* d_ws, size_t ws_size, hipStream_t stream) {
    static int grid_blocks = 0;
    if (!grid_blocks) {
        int dev = 0, cus = 0, per_cu = 0;
        (void)hipGetDevice(&dev);
        (void)hipDeviceGetAttribute(&cus, hipDeviceAttributeMultiprocessorCount, dev);
        (void)hipFuncSetAttribute((const void*)mega, hipFuncAttributeMaxDynamicSharedMemorySize, LDS_BYTES);
        (void)hipOccupancyMaxActiveBlocksPerMultiprocessor(&per_cu, mega, 512, LDS_BYTES);
        if (per_cu < 1) fprintf(stderr, "occupancy query says %d blocks/CU\n", per_cu);
        grid_blocks = cus;
    }
    P p{};
    for (int i = 0; i < 44; ++i) p.in[i] = (const float*)d_in[i];
    p.out = (float*)d_out; p.ws = (char*)d_ws;
    (void)hipMemsetAsync((char*)d_ws + WS_BAR, 0, XCD_BAR_WORDS * 4, stream);
    hipLaunchKernelGGL(mega, dim3(grid_blocks), dim3(512), LDS_BYTES, stream, p);
    hipError_t e = hipPeekAtLastError();
    if (e != hipSuccess) fprintf(stderr, "launch failed: %s (grid %d)\n", hipGetErrorString(e), grid_blocks);
}
#endif
```

```cpp
#ifndef CPU_EMU
#include <hip/hip_runtime.h>
#include <hip/hip_cooperative_groups.h>
#include <cstdio>
namespace cg = cooperative_groups;
#endif
#include <stdint.h>

#ifndef CFG_BATCH
#define CFG_BATCH 16
#define CFG_SEQ 256
#define CFG_DEC_BATCH 8
#define CFG_DEC_SEQ 1024
#define CFG_DEPTH 4
#endif

typedef unsigned short bf16;
typedef short s8v __attribute__((ext_vector_type(8)));
typedef float f4v __attribute__((ext_vector_type(4)));

constexpr int D = 1024;
constexpr int NB_CTX = CFG_BATCH, L_CTX = CFG_SEQ, NB_LAT = CFG_DEC_BATCH, L_LAT = CFG_DEC_SEQ, DEPTH = CFG_DEPTH;
constexpr int N_EVEN = (DEPTH + 1) / 2, N_ODD = DEPTH / 2;
constexpr int T_CTX = NB_CTX * L_CTX, T_LAT = NB_LAT * L_LAT, T = T_CTX + T_LAT;
constexpr int NSEQ = NB_CTX + NB_LAT, NCOND = 1 + NB_LAT;
constexpr int EW = 3872, OW = 3088, EWP = 4096, OWP = 3328;
constexpr float EPS = 1e-6f;
constexpr int E_Q = 0, E_K = 256, E_V = 512, E_GD = 1024, E_ZA = 1056, E_FB = 1568, E_ZB = 3360;
constexpr int FB_R = 0, FB_K = 512, FB_V = 1024, FB_WD = 1536, FB_AD = 1664;
constexpr int O_QKV = 0, O_G = 1536, O_BETA = 1544, O_ZC = 1552, O_U = 2064, O_ZD = 2576;

constexpr size_t al(size_t x) { return (x + 255) & ~(size_t)255; }
constexpr size_t WS_MOD = 0;
constexpr size_t WS_WTE = WS_MOD + al((size_t)DEPTH * NCOND * 3072 * 4);
constexpr size_t WS_WTO = WS_WTE + al((size_t)N_EVEN * EWP * D * 2);
constexpr size_t WS_WTOUT = WS_WTO + al((size_t)(N_ODD ? N_ODD : 1) * OWP * D * 2);
constexpr size_t WS_WTGLU = WS_WTOUT + al((size_t)DEPTH * D * D * 2);
constexpr size_t WS_HM = WS_WTGLU + al((size_t)(N_ODD ? N_ODD : 1) * 512 * 512 * 2);
constexpr size_t WS_PROJ = WS_HM + al((size_t)T * D * 2);
constexpr size_t WS_PART = WS_PROJ + al((size_t)T * EW * 2);
constexpr size_t PART_SZ = al((size_t)T * 512 * 2);
constexpr size_t WS_YCE = WS_PART + 2 * PART_SZ;
constexpr size_t WS_BONUS = WS_PART + 4 * PART_SZ;
constexpr size_t WS_QKVN = WS_BONUS + al((size_t)T * 16 * 4);
constexpr size_t WS_GATES = WS_QKVN + al((size_t)T * 1536 * 2);
constexpr size_t WS_GC = WS_GATES + al((size_t)T * 16 * 4);
constexpr size_t WS_BAR = WS_GC + al((size_t)(T / 64) * 8 * 64 * 4);
constexpr size_t WS_END = WS_BAR + 16384;
constexpr size_t WS_TINV = WS_PROJ + al((size_t)T * OW * 2);
constexpr size_t WS_QKM = WS_HM;
static_assert(WS_TINV + (size_t)T * 1024 <= WS_PART, "TINV must fit in the PROJ tail");
constexpr size_t WS_RM12 = WS_HM;
constexpr size_t WS_RM34 = WS_QKVN;
constexpr size_t WS_VSH = WS_QKVN + (size_t)(T / 64) * 8 * 16384;
static_assert((size_t)(T / 64) * 8 * 16384 <= (size_t)T * D * 2, "M1/M2 must fit in HM");
static_assert((size_t)(T / 64) * 8 * 16384 + (size_t)T * 512 * 2 <= (size_t)T * 1536 * 2, "M3/M4 + shifted v must fit in QKVN");

constexpr size_t OUT_X = 0;
constexpr size_t OUT_GLA = (size_t)T * D;
constexpr size_t OUT_RWKV = OUT_GLA + (size_t)NB_CTX * N_EVEN * 2 * 4 * 64 * 128;
constexpr size_t OUT_GDN = OUT_RWKV + (size_t)NB_CTX * N_EVEN * 2 * 8 * 64 * 64;
constexpr size_t OUT_S5R = OUT_GDN + (size_t)NB_CTX * N_ODD * 2 * 4 * 128 * 128;
constexpr size_t OUT_S5I = OUT_S5R + (size_t)NB_CTX * N_ODD * 2 * 32 * 64;

struct P {
    const float* in[44];
    float* out;
    char* ws;
};
enum { I_XP = 0, I_XS, I_C, I_SGLA, I_SRWKV, I_SGDN, I_SS5R, I_SS5I, I_CCTX, I_WMOD, I_BMOD, I_GPRE, I_GPOST,
       I_WINE, I_WOUTE, I_GUP, I_GBIAS, I_GLAN, I_MIX, I_W0, I_W2, I_A0, I_A2, I_KK, I_KA, I_RK, I_LNG, I_LNB,
       I_WINO, I_WOUTO, I_CONV, I_ALOG, I_DTB, I_GDNN, I_S5AR, I_S5AI, I_S5DT, I_S5BR, I_S5BI, I_S5CR, I_S5CI,
       I_S5D, I_GLUW, I_GLUB };

#ifdef CPU_EMU
__device__ __forceinline__ int opaque_tid() { return (int)threadIdx.x; }
#else
__device__ __forceinline__ int opaque_tid() { int t = (int)threadIdx.x; asm volatile("" : "+v"(t)); return t; }
#endif
#define LT (opaque_tid() & 255)
__device__ __forceinline__ float u2f(unsigned u) { return __builtin_bit_cast(float, u); }
__device__ __forceinline__ unsigned f2u(float f) { return __builtin_bit_cast(unsigned, f); }
__device__ __forceinline__ float bf2f(bf16 h) { return u2f((unsigned)h << 16); }
#ifdef CPU_EMU
__device__ __forceinline__ bf16 f2bf(float f) { unsigned u = f2u(f); u += 0x7fffu + ((u >> 16) & 1u); return (bf16)(u >> 16); }
__device__ __forceinline__ unsigned pack2(float lo, float hi) { return (unsigned)f2bf(lo) | ((unsigned)f2bf(hi) << 16); }
__device__ __forceinline__ float fexp(float x) { return expf(x); }
__device__ __forceinline__ float flog(float x) { return logf(x); }
__device__ __forceinline__ float frcp(float x) { return 1.0f / x; }
__device__ __forceinline__ float frsq(float x) { return 1.0f / sqrtf(x); }
#else
typedef __bf16 hwbf2 __attribute__((ext_vector_type(2)));
typedef float hwf2 __attribute__((ext_vector_type(2)));
__device__ __forceinline__ unsigned pack2(float lo, float hi) { hwf2 v = {lo, hi}; return __builtin_bit_cast(unsigned, __builtin_convertvector(v, hwbf2)); }
__device__ __forceinline__ bf16 f2bf(float f) { return (bf16)(pack2(f, 0.f) & 0xffffu); }
__device__ __forceinline__ float fexp(float x) { return __builtin_amdgcn_exp2f(x * 1.4426950408889634f); }
__device__ __forceinline__ float flog(float x) { return __builtin_amdgcn_logf(x) * 0.6931471805599453f; }
__device__ __forceinline__ float frcp(float x) { return __builtin_amdgcn_rcpf(x); }
__device__ __forceinline__ float frsq(float x) { return __builtin_amdgcn_rsqf(x); }
#endif
__device__ __forceinline__ float sigmoidf_(float x) { return frcp(1.0f + fexp(-x)); }
__device__ __forceinline__ float siluf_(float x) { return x * frcp(1.0f + fexp(-x)); }
__device__ __forceinline__ float logsigf_(float x) { return fminf(x, 0.f) - flog(1.0f + fexp(-fabsf(x))); }
__device__ __forceinline__ float softplusf_(float x) { return fmaxf(x, 0.f) + flog(1.0f + fexp(-fabsf(x))); }
__device__ __forceinline__ float ftanh(float x) { const float e = fexp(-2.0f * fabsf(x)); const float t = (1.0f - e) * frcp(1.0f + e); return x < 0.f ? -t : t; }
__device__ __forceinline__ float gelu_tanh(float x) { return 0.5f * x * (1.0f + ftanh(0.7978845608028654f * (x + 0.044715f * x * x * x))); }

typedef float f8v __attribute__((ext_vector_type(8)));
__device__ __forceinline__ f8v unpack8v(const uint4& u) {
    f8v f; f[0] = u2f(u.x << 16); f[1] = u2f(u.x & 0xffff0000u); f[2] = u2f(u.y << 16); f[3] = u2f(u.y & 0xffff0000u);
    f[4] = u2f(u.z << 16); f[5] = u2f(u.z & 0xffff0000u); f[6] = u2f(u.w << 16); f[7] = u2f(u.w & 0xffff0000u); return f;
}
__device__ __forceinline__ uint4 pack8v(const f8v& f) { return make_uint4(pack2(f[0], f[1]), pack2(f[2], f[3]), pack2(f[4], f[5]), pack2(f[6], f[7])); }
struct Seq { int start, len, cond, lat, b; };
__device__ __forceinline__ Seq get_seq(int s) {
    Seq q;
    if (s < NB_CTX) { q.start = s * L_CTX; q.len = L_CTX; q.cond = 0; q.lat = 0; q.b = s; }
    else { int b = s - NB_CTX; q.start = T_CTX + b * L_LAT; q.len = L_LAT; q.cond = 1 + b; q.lat = 1; q.b = b; }
    return q;
}
__device__ __forceinline__ int tok_cond(int t) { return t < T_CTX ? 0 : 1 + (t - T_CTX) / L_LAT; }
__device__ __forceinline__ void tok_nbr(int t, bool& hl, bool& hr) {
    if (t < T_CTX) { int pos = t % L_CTX; hl = pos != 0; hr = pos != L_CTX - 1; }
    else { int pos = (t - T_CTX) & 63; hl = pos != 0; hr = pos != 63; }
}

constexpr int MOD_VB = DEPTH * 192;
__device__ __forceinline__ void ph_mod(const P& p, int bid, float* smem) {
    float (*sc)[1024] = (float(*)[1024])smem;
    float (*red)[16][NCOND] = (float(*)[16][NCOND])(smem + NCOND * 1024);
    const int layer = bid / 192, ct = bid % 192;
    __syncthreads();
    const int tid = LT, cl = tid & 15, kg = tid >> 4;
    for (int i = tid; i < NCOND * 1024; i += 256) {
        int ci = i >> 10, k = i & 1023;
        float v = ci == 0 ? p.in[I_CCTX][k] : p.in[I_C][(ci - 1) * 1024 + k];
        sc[ci][k] = siluf_(v);
    }
    __syncthreads();
    float acc[NCOND];
#pragma unroll
    for (int ci = 0; ci < NCOND; ++ci) acc[ci] = 0.f;
    const float* w = p.in[I_WMOD] + (size_t)layer * 1024 * 3072 + ct * 16 + cl;
#pragma unroll 4
    for (int kk = 0; kk < 64; ++kk) {
        const int k = kg * 64 + kk;
        const float wv = w[(size_t)k * 3072];
#pragma unroll
        for (int ci = 0; ci < NCOND; ++ci) acc[ci] += sc[ci][k] * wv;
    }
#pragma unroll
    for (int ci = 0; ci < NCOND; ++ci) red[kg][cl][ci] = acc[ci];
    __syncthreads();
    if (tid < 16 * NCOND) {
        const int c = tid / NCOND, ci = tid % NCOND;
        float sum = p.in[I_BMOD][layer * 3072 + ct * 16 + c];
#pragma unroll
        for (int g = 0; g < 16; ++g) sum += red[g][c][ci];
        ((float*)(p.ws + WS_MOD))[(size_t)(layer * NCOND + ci) * 3072 + ct * 16 + c] = sum;
    }
}

struct WtJob { const float* src; bf16* dst; int K, N, Npad; };
__device__ __forceinline__ WtJob wt_job(const P& p, int j) {
    WtJob q;
    if (j < N_EVEN) { q.src = p.in[I_WINE] + (size_t)j * D * EW; q.dst = (bf16*)(p.ws + WS_WTE) + (size_t)j * EWP * D; q.K = D; q.N = EW; q.Npad = EWP; return q; }
    j -= N_EVEN;
    if (j < N_ODD) { q.src = p.in[I_WINO] + (size_t)j * D * OW; q.dst = (bf16*)(p.ws + WS_WTO) + (size_t)j * OWP * D; q.K = D; q.N = OW; q.Npad = OWP; return q; }
    j -= N_ODD;
    if (j < DEPTH) { int i = j >> 1; q.src = (j & 1) ? p.in[I_WOUTO] + (size_t)i * D * D : p.in[I_WOUTE] + (size_t)i * D * D; q.dst = (bf16*)(p.ws + WS_WTOUT) + (size_t)j * D * D; q.K = D; q.N = D; q.Npad = D; return q; }
    j -= DEPTH;
    q.src = p.in[I_GLUW] + (size_t)j * 512 * 512; q.dst = (bf16*)(p.ws + WS_WTGLU) + (size_t)j * 512 * 512; q.K = 512; q.N = 512; q.Npad = 512; return q;
}
constexpr int WT_NJOBS = N_EVEN + N_ODD + DEPTH + N_ODD;
constexpr int WT_TILES = N_EVEN * (EWP / 64) * 16 + N_ODD * (OWP / 64) * 16 + DEPTH * 256 + N_ODD * 64;
__device__ __forceinline__ void ph_wt(const P& p, int bid, float* smem) {
    float (*tile)[65] = (float(*)[65])smem;
    int b = bid, j = 0;
    __syncthreads();
    WtJob q;
    for (;; ++j) { q = wt_job(p, j); int nt = (q.Npad / 64) * (q.K / 64); if (b < nt) break; b -= nt; }
    const int nk = q.K / 64, n0 = (b / nk) * 64, k0 = (b % nk) * 64;
    {
        const int kk = LT >> 4, n4 = (LT & 15) * 4, n = n0 + n4;
#pragma unroll
        for (int i = 0; i < 4; ++i) {
            float4 v = make_float4(0.f, 0.f, 0.f, 0.f);
            if (n < q.N) v = *(const float4*)(q.src + (size_t)(k0 + kk + 16 * i) * q.N + n);
            float* tr = &tile[kk + 16 * i][n4];
            tr[0] = v.x; tr[1] = v.y; tr[2] = v.z; tr[3] = v.w;
        }
    }
    __syncthreads();
    {
        const int nn = LT >> 2, k16 = (LT & 3) * 16;
        f8v a, c;
#pragma unroll
        for (int j = 0; j < 8; ++j) { a[j] = tile[k16 + j][nn]; c[j] = tile[k16 + 8 + j][nn]; }
        bf16* d = q.dst + (size_t)(n0 + nn) * q.K + k0 + k16;
        *(uint4*)d = pack8v(a); *(uint4*)(d + 8) = pack8v(c);
    }
}

constexpr int NTW = 3;
__device__ __forceinline__ float wave_sum(float v) {
#pragma unroll
    for (int m = 1; m < 64; m <<= 1) v += __shfl_xor(v, m);
    return v;
}
__device__ __forceinline__ void hmod_row(const float* xv  , int lane, const float* gpre, const float* mod, bf16* dst) {
    float ss = 0.f;
#pragma unroll
    for (int i = 0; i < 16; ++i) ss += xv[i] * xv[i];
    ss = wave_sum(ss);
    const float r = frsq(ss * (1.0f / 1024.f) + EPS);
#pragma unroll
    for (int i = 0; i < 4; ++i) {
        int idx = i * 256 + lane * 4;
        const float4 g = *(const float4*)(gpre + idx), sc = *(const float4*)(mod + 1024 + idx), sh = *(const float4*)(mod + idx);
        *(uint2*)(dst + idx) = make_uint2(pack2(xv[i * 4] * r * g.x * (1.0f + sc.x) + sh.x, xv[i * 4 + 1] * r * g.y * (1.0f + sc.y) + sh.y),
                                          pack2(xv[i * 4 + 2] * r * g.z * (1.0f + sc.z) + sh.z, xv[i * 4 + 3] * r * g.w * (1.0f + sc.w) + sh.w));
    }
}
__device__ __forceinline__ void ph_hmod0(const P& p, int bid) {
    const int lane = LT & 63, tb = bid * (4 * NTW) + (LT >> 6) * NTW;
    if (tb >= T) return;
    float xv[NTW][16];
#pragma unroll
    for (int u = 0; u < NTW; ++u) {
        const int t = (tb + u < T) ? tb + u : T - 1;
        const float* xr = t < T_CTX ? p.in[I_XP] + (size_t)t * D : p.in[I_XS] + (size_t)(t - T_CTX) * D;
#pragma unroll
        for (int i = 0; i < 4; ++i) { float4 v = *(const float4*)(xr + i * 256 + lane * 4); xv[u][i * 4] = v.x; xv[u][i * 4 + 1] = v.y; xv[u][i * 4 + 2] = v.z; xv[u][i * 4 + 3] = v.w; }
    }
#pragma unroll
    for (int u = 0; u < NTW; ++u) {
        const int t = tb + u; if (t >= T) break;
        const float* mod = (const float*)(p.ws + WS_MOD) + (size_t)(0 * NCOND + tok_cond(t)) * 3072;
        hmod_row(xv[u], lane, p.in[I_GPRE], mod, (bf16*)(p.ws + WS_HM) + (size_t)t * D);
    }
}
__device__ __forceinline__ void ph_post(const P& p, int bid, int layer) {
    const int lane = LT & 63, tb = bid * (4 * NTW) + (LT >> 6) * NTW;
    if (tb >= T) return;
    const float* gpost = p.in[I_GPOST] + layer * D;
    float xv[NTW][16], mv[NTW][16];
#pragma unroll
    for (int u = 0; u < NTW; ++u) {
        const int t = (tb + u < T) ? tb + u : T - 1;
        const bf16* mr = (const bf16*)(p.ws + WS_PROJ) + (size_t)t * D;
        if (layer == 0) {
            const float* xr = t < T_CTX ? p.in[I_XP] + (size_t)t * D : p.in[I_XS] + (size_t)(t - T_CTX) * D;
#pragma unroll
            for (int i = 0; i < 4; ++i) { float4 v = *(const float4*)(xr + i * 256 + lane * 4); xv[u][i * 4] = v.x; xv[u][i * 4 + 1] = v.y; xv[u][i * 4 + 2] = v.z; xv[u][i * 4 + 3] = v.w; }
        } else {
            const bf16* xb = (const bf16*)(p.out + OUT_X + (size_t)t * D + 512);
#pragma unroll
            for (int i = 0; i < 4; ++i) { const uint2 w = *(const uint2*)(xb + i * 256 + lane * 4); xv[u][i * 4] = u2f(w.x << 16); xv[u][i * 4 + 1] = u2f(w.x & 0xffff0000u); xv[u][i * 4 + 2] = u2f(w.y << 16); xv[u][i * 4 + 3] = u2f(w.y & 0xffff0000u); }
        }
#pragma unroll
        for (int i = 0; i < 4; ++i) { const uint2 w = *(const uint2*)(mr + i * 256 + lane * 4); mv[u][i * 4] = u2f(w.x << 16); mv[u][i * 4 + 1] = u2f(w.x & 0xffff0000u); mv[u][i * 4 + 2] = u2f(w.y << 16); mv[u][i * 4 + 3] = u2f(w.y & 0xffff0000u); }
    }
#pragma unroll
    for (int u = 0; u < NTW; ++u) {
        const int t = tb + u; if (t >= T) break;
        const float* mod = (const float*)(p.ws + WS_MOD) + (size_t)(layer * NCOND + tok_cond(t)) * 3072;
        float* xo = p.out + OUT_X + (size_t)t * D;
        bf16* xb = (bf16*)(xo + 512);
        float ss = 0.f;
#pragma unroll
        for (int i = 0; i < 16; ++i) ss += mv[u][i] * mv[u][i];
        ss = wave_sum(ss);
        const float r = frsq(ss * (1.0f / 1024.f) + EPS);
#pragma unroll
        for (int i = 0; i < 4; ++i) {
            const int idx = i * 256 + lane * 4;
            const float4 gt = *(const float4*)(mod + 2048 + idx), gp = *(const float4*)(gpost + idx);
            xv[u][i * 4] += gt.x * (mv[u][i * 4] * r * gp.x); xv[u][i * 4 + 1] += gt.y * (mv[u][i * 4 + 1] * r * gp.y);
            xv[u][i * 4 + 2] += gt.z * (mv[u][i * 4 + 2] * r * gp.z); xv[u][i * 4 + 3] += gt.w * (mv[u][i * 4 + 3] * r * gp.w);
        }
        if (layer + 1 < DEPTH) {
#pragma unroll
            for (int i = 0; i < 4; ++i) *(uint2*)(xb + i * 256 + lane * 4) = make_uint2(pack2(xv[u][i * 4], xv[u][i * 4 + 1]), pack2(xv[u][i * 4 + 2], xv[u][i * 4 + 3]));
            const float* mod2 = (const float*)(p.ws + WS_MOD) + (size_t)((layer + 1) * NCOND + tok_cond(t)) * 3072;
            hmod_row(xv[u], lane, p.in[I_GPRE] + (layer + 1) * D, mod2, (bf16*)(p.ws + WS_HM) + (size_t)t * D);
        } else {
#pragma unroll
            for (int i = 0; i < 4; ++i) *(float4*)(xo + i * 256 + lane * 4) = make_float4(xv[u][i * 4], xv[u][i * 4 + 1], xv[u][i * 4 + 2], xv[u][i * 4 + 3]);
        }
    }
}

#ifdef CPU_EMU
#define LDS_AS
#define GLDS16(gptr, lptr) memcpy((char*)(lptr) + (threadIdx.x & 63) * 16, (const void*)(gptr), 16)
#define PG_WAIT_V(n)
#define PG_WAIT_L(n)
#define PG_BAR __syncthreads()
#define PG_SCHED
#define PG_PRIO(x)
#define RFL(x) (x)
__device__ __forceinline__ unsigned cvt_pk_bf16(float lo, float hi) { return (unsigned)f2bf(lo) | ((unsigned)f2bf(hi) << 16); }
#else
#define LDS_AS __attribute__((address_space(3)))
#define GLDS16(gptr, lptr) __builtin_amdgcn_global_load_lds((const unsigned*)(gptr), (LDS_AS unsigned*)(lptr), 16, 0, 0)
#define PG_WAIT_V(n) asm volatile("s_waitcnt vmcnt(" #n ")" ::: "memory")
#define PG_WAIT_L(n) asm volatile("s_waitcnt lgkmcnt(" #n ")" ::: "memory")
#define PG_BAR __builtin_amdgcn_s_barrier()
#define PG_SCHED __builtin_amdgcn_sched_barrier(0)
#define PG_PRIO(x) __builtin_amdgcn_s_setprio(x)
#define RFL(x) __builtin_amdgcn_readfirstlane(x)
__device__ __forceinline__ unsigned cvt_pk_bf16(float lo, float hi) { return pack2(lo, hi); }
#endif
namespace pg8 {
constexpr int BM = 256, BK = 64, HALF = 128, HTB = HALF * BK * 2, STAGE_BYTES = 8 * HTB, NXCD = 8, WGM = 8;
__host__ __device__ __forceinline__ int lds_byte(int r, int c) { const int st = (r >> 4) * 2 + (c >> 5), rr = r & 15, cc = c & 31, ob = rr * 64 + cc * 2; return st * 1024 + (ob ^ (((ob >> 9) & 1) << 5)); }
__host__ __device__ __forceinline__ void stage_rc(int b, int& R, int& C) { const int st = b / 1024, sb = b % 1024, swz = sb ^ (((sb >> 9) & 1) << 5); R = (st >> 1) * 16 + swz / 64; C = (st & 1) * 32 + (swz % 64) / 2; }
__host__ __device__ __forceinline__ int perm32(int rho) { const int n = rho >> 4, i = rho & 15; return 8 * (i >> 2) + 4 * n + (i & 3); }
struct Unit { int pm, pn; };
struct Gemm { const bf16* A; const bf16* Bt; int M, N, K, lda; };
struct StaticOrder {
    int nM, nN, nwg, G, c;
    __host__ __device__ void init(int M, int N, int G_, int c_) { nM = M / BM; nN = N / BM; nwg = nM * nN; G = G_; c = c_; }
    __host__ __device__ bool next(int i, Unit& u) const {
        const long L = (long)i * G + c; if (L >= nwg) return false;
        int wgid = (int)L; { const int q = nwg / NXCD, r = nwg % NXCD, xcd = wgid % NXCD, off = wgid / NXCD; wgid = (xcd < r ? xcd * (q + 1) : r * (q + 1) + (xcd - r) * q) + off; }
        const int nig = WGM * nN, gid = wgid / nig, fm = gid * WGM, gsz = (nM - fm) < WGM ? (nM - fm) : WGM;
        u.pm = fm + ((wgid % nig) % gsz); u.pn = (wgid % nig) / gsz; return true;
    }
};
struct EpiF32 {
    static constexpr bool PERM = false;
    float* C; int ldc;
    __device__ __forceinline__ void operator()(const f4v (&acc)[2][2][4][2], const Unit& u, int wr, int wc, int fr, int fq) const {
        const int row0 = u.pm * BM + wr * 64 + fr, col0 = u.pn * BM + wc * 32 + 4 * fq;
#pragma unroll
        for (int ai = 0; ai < 2; ++ai)
#pragma unroll
            for (int m = 0; m < 4; ++m) { float* rowp = C + (size_t)(row0 + ai * HALF + m * 16) * ldc + col0;
#pragma unroll
                for (int bj = 0; bj < 2; ++bj)
#pragma unroll
                    for (int n = 0; n < 2; ++n) *(f4v*)(rowp + bj * HALF + n * 16) = acc[ai][bj][m][n]; }
    }
};
struct EpiBf16 {
    static constexpr bool PERM = true;
    bf16* O; int ldc; int N;
    __device__ __forceinline__ void operator()(const f4v (&acc)[2][2][4][2], const Unit& u, int wr, int wc, int fr, int fq) const {
        const int row0 = u.pm * BM + wr * 64 + fr, col0 = u.pn * BM + wc * 32 + 8 * fq;
#pragma unroll
        for (int ai = 0; ai < 2; ++ai)
#pragma unroll
            for (int m = 0; m < 4; ++m) { bf16* rowp = O + (size_t)(row0 + ai * HALF + m * 16) * ldc + col0;
#pragma unroll
                for (int bj = 0; bj < 2; ++bj) { const f4v v0 = acc[ai][bj][m][0], v1 = acc[ai][bj][m][1];
                    if (col0 + bj * HALF < N) *(uint4*)(rowp + bj * HALF) = make_uint4(cvt_pk_bf16(v0[0], v0[1]), cvt_pk_bf16(v0[2], v0[3]), cvt_pk_bf16(v1[0], v1[1]), cvt_pk_bf16(v1[2], v1[3])); } }
    }
};
struct EpiGlu {
    static constexpr bool PERM = true;
    bf16* O; const bf16* YS; const bf16* ZD; const float* GB;
    __device__ __forceinline__ void operator()(const f4v (&acc)[2][2][4][2], const Unit& u, int wr, int wc, int fr, int fq) const {
        const int row0 = u.pm * BM + wr * 64 + fr, col0 = u.pn * BM + wc * 32 + 8 * fq;
#pragma unroll
        for (int ai = 0; ai < 2; ++ai)
#pragma unroll
            for (int m = 0; m < 4; ++m) { const size_t row = (size_t)(row0 + ai * HALF + m * 16);
#pragma unroll
                for (int bj = 0; bj < 2; ++bj) { const int col = col0 + bj * HALF;
                    const f8v ys = unpack8v(*(const uint4*)(YS + row * 512 + col)), zd = unpack8v(*(const uint4*)(ZD + row * OW + col));
                    const f8v gb = *(const f8v*)(GB + col);
                    f8v o;
#pragma unroll
                    for (int j = 0; j < 8; ++j) { const float g = (j < 4 ? acc[ai][bj][m][0][j] : acc[ai][bj][m][1][j - 4]) + gb[j]; o[j] = ys[j] * sigmoidf_(g) * siluf_(zd[j]); }
                    *(uint4*)(O + row * D + col) = pack8v(o); } }
    }
};
template <class Epi>
__device__ __forceinline__ void gemm_phase(LDS_AS unsigned char* lds, const Gemm g, const StaticOrder& S, const Epi& E) {
    const int tid = opaque_tid(), wid = RFL(tid >> 6), lane = tid & 63, wr = wid >> 2, wc = wid & 3, fr = lane & 15, fq = lane >> 4;
    const int K = g.K, nt = K / BK;
    unsigned voffA[2], voffB[2];
#pragma unroll
    for (int i = 0; i < 2; ++i) { int R, C; stage_rc(tid * 16 + i * 8192, R, C); const int Rb = Epi::PERM ? ((R & ~31) + perm32(R & 31)) : R;
        voffA[i] = (unsigned)(R * g.lda + C) * 2u; voffB[i] = (unsigned)(Rb * K + C) * 2u; }
    const size_t kstep = (size_t)(BK * 2);
    const size_t hstepA = (size_t)HALF * g.lda * 2, hstepB = (size_t)HALF * K * 2;
    const size_t tstepA = 2 * hstepA, tstepB = 2 * hstepB;
    const unsigned ldsw = (unsigned)wid * 1024u;
    const int aoff = lds_byte(wr * 64 + fr, fq * 8), boff = lds_byte(wc * 32 + fr, fq * 8);
#define PG8_SA(b, h) (((b) * 2 + (h)) * HTB)
#define PG8_SB(b, h) ((4 + (b) * 2 + (h)) * HTB)
#define PG8_STAGE(bufoff, gbase, voff) do { _Pragma("unroll") for (int _i = 0; _i < 2; ++_i) GLDS16((const char*)(gbase) + (voff)[_i], lds + (bufoff) + ldsw + _i * 8192); } while (0)
#define PG8_LDA(dst, b, h) do { _Pragma("unroll") for (int m = 0; m < 4; ++m) _Pragma("unroll") for (int k = 0; k < 2; ++k) dst[m][k] = *(const LDS_AS s8v*)(lds + PG8_SA(b, h) + aoff + m * 2048 + k * 1024); } while (0)
#define PG8_LDB(dst, b, h) do { _Pragma("unroll") for (int n = 0; n < 2; ++n) _Pragma("unroll") for (int k = 0; k < 2; ++k) dst[n][k] = *(const LDS_AS s8v*)(lds + PG8_SB(b, h) + boff + n * 2048 + k * 1024); } while (0)
#define PG8_MMA(ai, bj, At, Bt) do { PG_PRIO(1); _Pragma("unroll") for (int m = 0; m < 4; ++m) _Pragma("unroll") for (int n = 0; n < 2; ++n) _Pragma("unroll") for (int k = 0; k < 2; ++k) \
        acc[ai][bj][m][n] = __builtin_amdgcn_mfma_f32_16x16x32_bf16(Bt[n][k], At[m][k], acc[ai][bj][m][n], 0, 0, 0); PG_PRIO(0); } while (0)
    Unit cur, nxt; int ui = 0;
    if (!S.next(0, cur)) return;
    f4v acc[2][2][4][2];
#pragma unroll
    for (int a = 0; a < 2; ++a)
#pragma unroll
        for (int b = 0; b < 2; ++b)
#pragma unroll
            for (int m = 0; m < 4; ++m)
#pragma unroll
                for (int n = 0; n < 2; ++n) acc[a][b][m][n] = (f4v){0.f, 0.f, 0.f, 0.f};
    s8v At[4][2], B0[2][2], B1[2][2];
    const char* cA = (const char*)g.A + (size_t)cur.pm * tstepA; const char* cB = (const char*)g.Bt + (size_t)cur.pn * tstepB;
    PG8_STAGE(PG8_SB(0, 0), cB, voffB); PG8_STAGE(PG8_SA(0, 0), cA, voffA); PG8_STAGE(PG8_SB(0, 1), cB + hstepB, voffB); PG8_STAGE(PG8_SA(0, 1), cA + hstepA, voffA);
    if (wr == 1) PG_BAR;
    PG_WAIT_V(4); PG_BAR;
    PG8_STAGE(PG8_SB(1, 0), cB + kstep, voffB); PG8_STAGE(PG8_SA(1, 0), cA + kstep, voffA); PG8_STAGE(PG8_SB(1, 1), cB + hstepB + kstep, voffB);
    PG_WAIT_V(6); PG_BAR;
    for (;;) {
        const bool has_next = S.next(ui + 1, nxt);
        const char* nA = has_next ? (const char*)g.A + (size_t)nxt.pm * tstepA : cA; const char* nB = has_next ? (const char*)g.Bt + (size_t)nxt.pn * tstepB : cB;
        for (int t = 0; t < nt; t += 2) {
            const bool last = (t == nt - 2);
            const char* a1 = cA + (size_t)(t + 1) * kstep;
            const char* a2 = last ? nA : cA + (size_t)(t + 2) * kstep; const char* b2 = last ? nB : cB + (size_t)(t + 2) * kstep;
            const char* a3 = a2 + kstep; const char* b3 = b2 + kstep;
            PG8_LDB(B0, 0, 0); PG_SCHED; PG8_LDA(At, 0, 0); PG8_STAGE(PG8_SA(1, 1), a1 + hstepA, voffA);
            PG_WAIT_L(8); PG_BAR; PG_WAIT_L(0); PG8_MMA(0, 0, At, B0); PG_BAR; PG_SCHED;
            PG8_LDB(B1, 0, 1); PG8_STAGE(PG8_SB(0, 0), b2, voffB);
            PG_BAR; PG_WAIT_L(0); PG8_MMA(0, 1, At, B1); PG_BAR;
            PG8_LDA(At, 0, 1); PG8_STAGE(PG8_SA(0, 0), a2, voffA);
            PG_BAR; PG_WAIT_L(0); PG8_MMA(1, 0, At, B0); PG_BAR; PG_SCHED;
            PG8_STAGE(PG8_SB(0, 1), b2 + hstepB, voffB);
            PG_WAIT_V(6); PG_BAR; PG8_MMA(1, 1, At, B1); PG_BAR;
            PG8_LDB(B0, 1, 0); PG_SCHED; PG8_LDA(At, 1, 0); PG8_STAGE(PG8_SA(0, 1), a2 + hstepA, voffA);
            PG_WAIT_L(8); PG_BAR; PG_WAIT_L(0); PG8_MMA(0, 0, At, B0); PG_BAR; PG_SCHED;
            PG8_LDB(B1, 1, 1); PG8_STAGE(PG8_SB(1, 0), b3, voffB);
            PG_BAR; PG_WAIT_L(0); PG8_MMA(0, 1, At, B1); PG_BAR;
            PG8_LDA(At, 1, 1); PG8_STAGE(PG8_SA(1, 0), a3, voffA);
            PG_BAR; PG_WAIT_L(0); PG8_MMA(1, 0, At, B0); PG_BAR; PG_SCHED;
            PG8_STAGE(PG8_SB(1, 1), b3 + hstepB, voffB);
            PG_WAIT_V(6); PG_BAR; PG8_MMA(1, 1, At, B1); PG_BAR;
        }
        E(acc, cur, wr, wc, fr, fq);
        if (!has_next) break;
#pragma unroll
        for (int a = 0; a < 2; ++a)
#pragma unroll
            for (int b = 0; b < 2; ++b)
#pragma unroll
                for (int m = 0; m < 4; ++m)
#pragma unroll
                    for (int n = 0; n < 2; ++n) acc[a][b][m][n] = (f4v){0.f, 0.f, 0.f, 0.f};
        cur = nxt; cA = nA; cB = nB; ++ui;
    }
    PG_WAIT_V(0);
    if (wr == 0) PG_BAR;
    PG_BAR;
}
}

#ifdef CPU_EMU
#define WAVE_SYNC() emu::wsync()
#define LBAR() __syncthreads()
#else
#define WAVE_SYNC() __builtin_amdgcn_wave_barrier()
#define LBAR() do { asm volatile("s_waitcnt lgkmcnt(0)" ::: "memory"); __builtin_amdgcn_s_barrier(); asm volatile("" ::: "memory"); } while (0)
#endif
__device__ __forceinline__ void unpack8(const uint4& u, float* f) {
    f[0] = u2f(u.x << 16); f[1] = u2f(u.x & 0xffff0000u); f[2] = u2f(u.y << 16); f[3] = u2f(u.y & 0xffff0000u);
    f[4] = u2f(u.z << 16); f[5] = u2f(u.z & 0xffff0000u); f[6] = u2f(u.w << 16); f[7] = u2f(u.w & 0xffff0000u);
}
__device__ __forceinline__ uint4 pack8(const float* f) { return make_uint4(pack2(f[0], f[1]), pack2(f[2], f[3]), pack2(f[4], f[5]), pack2(f[6], f[7])); }
__device__ __forceinline__ f4v unpack4(const uint2& u) { f4v f; f[0] = u2f(u.x << 16); f[1] = u2f(u.x & 0xffff0000u); f[2] = u2f(u.y << 16); f[3] = u2f(u.y & 0xffff0000u); return f; }
__device__ __forceinline__ uint2 pack4(const f4v& f) { return make_uint2(pack2(f[0], f[1]), pack2(f[2], f[3])); }
__device__ __forceinline__ f4v mfma16(const s8v& a, const s8v& b, const f4v& c) { return __builtin_amdgcn_mfma_f32_16x16x32_bf16(a, b, c, 0, 0, 0); }

__device__ __forceinline__ float red8(float x) {
#ifdef CPU_EMU
    x += __shfl_xor(x, 1); x += __shfl_xor(x, 2); x += __shfl_xor(x, 4);
#else
    x += __builtin_bit_cast(float, __builtin_amdgcn_mov_dpp(__builtin_bit_cast(int, x), 0xB1, 0xF, 0xF, true));
    x += __builtin_bit_cast(float, __builtin_amdgcn_mov_dpp(__builtin_bit_cast(int, x), 0x4E, 0xF, 0xF, true));
    x += __builtin_bit_cast(float, __builtin_amdgcn_mov_dpp(__builtin_bit_cast(int, x), 0x141, 0xF, 0xF, true));
#endif
    return x;
}
__device__ __forceinline__ float red16(float x) {
    x = red8(x);
#ifdef CPU_EMU
    x += __shfl_xor(x, 8);
#else
    x += __builtin_bit_cast(float, __builtin_amdgcn_mov_dpp(__builtin_bit_cast(int, x), 0x140, 0xF, 0xF, true));
#endif
    return x;
}
constexpr int TI_LD = 68, TI_TLD = 20;
__device__ __forceinline__ void ti_mm16(float* dst, int ldd, const float* L, int ldl, const float* R, int ldr, float sgn, const float* add, int lda, int lane) {
    const int r = lane >> 2, c4 = (lane & 3) * 4;
    f4v acc = (f4v){0.f, 0.f, 0.f, 0.f};
#pragma unroll
    for (int k = 0; k < 16; ++k) { const float l = L[r * ldl + k]; const f4v rv = *(const f4v*)(R + k * ldr + c4); acc += l * rv; }
    acc *= sgn;
    if (add) acc += *(const f4v*)(add + r * lda + c4);
    *(f4v*)(dst + r * ldd + c4) = acc;
}
__device__ __forceinline__ float red4(float x) {
#ifdef CPU_EMU
    x += __shfl_xor(x, 1); x += __shfl_xor(x, 2);
#else
    x += __builtin_bit_cast(float, __builtin_amdgcn_mov_dpp(__builtin_bit_cast(int, x), 0xB1, 0xF, 0xF, true));
    x += __builtin_bit_cast(float, __builtin_amdgcn_mov_dpp(__builtin_bit_cast(int, x), 0x4E, 0xF, 0xF, true));
#endif
    return x;
}
__device__ __forceinline__ void tri_inv64(const float* A, float* X, float* TMP, int wl, int lane, bool active) {
#define TI_A(a, b) (A + (16 * (a)) * TI_LD + 16 * (b))
#define TI_X(a, b) (X + (16 * (a)) * TI_LD + 16 * (b))
#define TI_T(n) (TMP + (n) * 16 * TI_TLD)
    if (active) {
        const int c = lane >> 2, js = lane & 3;
        float xr[4] = {0.f, 0.f, 0.f, 0.f};
        const float* Ab = TI_A(wl, wl);
#pragma unroll
        for (int i = 0; i < 16; ++i) {
            float part = 0.f;
#pragma unroll
            for (int m = 0; m <= (i - 1) / 4 && i > 0; ++m) { const int j = 4 * m + js; part += (j < i ? Ab[i * TI_LD + j] : 0.f) * xr[m]; }
            const float tot = red4(part);
            const float xi = (i == c ? 1.f : 0.f) - tot;
            xr[i >> 2] = ((i & 3) == js) ? xi : xr[i >> 2];
        }
        float* Xb = TI_X(wl, wl);
#pragma unroll
        for (int m = 0; m < 4; ++m) Xb[(4 * m + js) * TI_LD + c] = xr[m];
        for (int b = wl + 1; b < 4; ++b) { float* Z = TI_X(wl, b); const int r = lane >> 2, c4 = (lane & 3) * 4; *(f4v*)(Z + r * TI_LD + c4) = (f4v){0.f, 0.f, 0.f, 0.f}; }
    }
    LBAR();
    if (!active) {} else if (wl == 0) ti_mm16(TI_T(0), TI_TLD, TI_A(1, 0), TI_LD, TI_X(0, 0), TI_LD, 1.f, nullptr, 0, lane);
    else if (wl == 1) ti_mm16(TI_T(1), TI_TLD, TI_A(3, 2), TI_LD, TI_X(2, 2), TI_LD, 1.f, nullptr, 0, lane);
    else if (wl == 2) ti_mm16(TI_T(2), TI_TLD, TI_A(2, 1), TI_LD, TI_X(1, 1), TI_LD, 1.f, nullptr, 0, lane);
    else ti_mm16(TI_T(3), TI_TLD, TI_A(3, 1), TI_LD, TI_X(1, 1), TI_LD, 1.f, nullptr, 0, lane);
    LBAR();
    if (!active) {} else if (wl == 0) ti_mm16(TI_X(1, 0), TI_LD, TI_X(1, 1), TI_LD, TI_T(0), TI_TLD, -1.f, nullptr, 0, lane);
    else if (wl == 1) ti_mm16(TI_X(3, 2), TI_LD, TI_X(3, 3), TI_LD, TI_T(1), TI_TLD, -1.f, nullptr, 0, lane);
    else if (wl == 2) ti_mm16(TI_T(4), TI_TLD, TI_A(2, 0), TI_LD, TI_X(0, 0), TI_LD, 1.f, nullptr, 0, lane);
    else ti_mm16(TI_T(5), TI_TLD, TI_A(3, 0), TI_LD, TI_X(0, 0), TI_LD, 1.f, nullptr, 0, lane);
    LBAR();
    if (!active) {} else if (wl == 0) ti_mm16(TI_T(6), TI_TLD, TI_A(2, 1), TI_LD, TI_X(1, 0), TI_LD, 1.f, TI_T(4), TI_TLD, lane);
    else if (wl == 1) ti_mm16(TI_T(7), TI_TLD, TI_A(3, 1), TI_LD, TI_X(1, 0), TI_LD, 1.f, TI_T(5), TI_TLD, lane);
    LBAR();
    if (!active) {} else if (wl == 0) ti_mm16(TI_X(2, 0), TI_LD, TI_X(2, 2), TI_LD, TI_T(6), TI_TLD, -1.f, nullptr, 0, lane);
    else if (wl == 1) ti_mm16(TI_X(2, 1), TI_LD, TI_X(2, 2), TI_LD, TI_T(2), TI_TLD, -1.f, nullptr, 0, lane);
    else if (wl == 2) ti_mm16(TI_T(0), TI_TLD, TI_X(3, 3), TI_LD, TI_T(7), TI_TLD, 1.f, nullptr, 0, lane);
    else ti_mm16(TI_T(1), TI_TLD, TI_X(3, 3), TI_LD, TI_T(3), TI_TLD, 1.f, nullptr, 0, lane);
    LBAR();
    if (!active) {} else if (wl == 2) { ti_mm16(TI_X(3, 0), TI_LD, TI_X(3, 2), TI_LD, TI_T(6), TI_TLD, -1.f, nullptr, 0, lane); }
    else if (wl == 3) { ti_mm16(TI_X(3, 1), TI_LD, TI_X(3, 2), TI_LD, TI_T(2), TI_TLD, -1.f, nullptr, 0, lane); }
    if (active && wl >= 2) {
        const int r = lane >> 2, c4 = (lane & 3) * 4;
        float* d = TI_X(3, wl - 2) + r * TI_LD + c4; const float* t = TI_T(wl - 2) + r * TI_TLD + c4;
        *(f4v*)d = *(const f4v*)d - *(const f4v*)t;
    }
    LBAR();
#undef TI_A
#undef TI_X
#undef TI_T
}

constexpr int GL_LD = 72;
__device__ __forceinline__ void gla_scan_task(const P& p, int ei, int s, int h, int dir, unsigned char* dsm) {
    bf16* LAt = (bf16*)dsm;
    bf16* Qd = LAt + 64 * GL_LD;
    bf16* Ki = Qd + 64 * GL_LD;
    bf16* KiT = Ki + 64 * GL_LD;
    bf16* Sc = KiT + 64 * GL_LD;
    bf16* VT = Sc + 64 * GL_LD;
    bf16* St = VT + 128 * GL_LD;
    float* sAE = (float*)(St + 128 * GL_LD);
    float* Of = sAE + 64;
    const Seq sq_ = get_seq(s);
    const int tid = opaque_tid(), lane = tid & 63, wid = tid >> 6, fr = lane & 15, fq = lane >> 4;
    const int rt = wid & 3, chf = wid >> 2;
    const bf16* proj = (const bf16*)(p.ws + WS_PROJ);
    bf16* opart = (bf16*)(p.ws + WS_PART);
    s8v gfrag[2]; float gb[2];
    {
        const float* gup = p.in[I_GUP] + (size_t)(ei * 2 + dir) * 16 * 256 + h * 64;
        const float* gbias = p.in[I_GBIAS] + (size_t)(ei * 2 + dir) * 256 + h * 64;
#pragma unroll
        for (int c2 = 0; c2 < 2; ++c2) {
            const int d = 16 * (2 * chf + c2) + fr;
            gb[c2] = gbias[d];
#pragma unroll
            for (int j = 0; j < 8; ++j) gfrag[c2][j] = (short)f2bf(fq < 2 ? gup[(8 * fq + j) * 256 + d] : 0.f);
        }
    }
    f4v Sacc[4];
    LBAR();
    if (sq_.lat) {
        const float* s0 = p.in[I_SGLA] + ((((size_t)sq_.b * N_EVEN + ei) * 2 + dir) * 4 + h) * 64 * 128;
#pragma unroll
        for (int ct = 0; ct < 4; ++ct)
#pragma unroll
            for (int r = 0; r < 4; ++r) Sacc[ct][r] = s0[(16 * rt + fq * 4 + r) * 128 + 64 * chf + 16 * ct + fr];
    } else {
#pragma unroll
        for (int ct = 0; ct < 4; ++ct) Sacc[ct] = (f4v){0.f, 0.f, 0.f, 0.f};
    }
#pragma unroll
    for (int ct = 0; ct < 4; ++ct) *(uint2*)(St + (64 * chf + 16 * ct + fr) * GL_LD + 16 * rt + fq * 4) = make_uint2(pack2(Sacc[ct][0], Sacc[ct][1]), pack2(Sacc[ct][2], Sacc[ct][3]));
    const int nch = sq_.len >> 6;
    uint4 pv0, pv1, pq, pkk, pga;
#define GLA_FETCH(TB) do { \
        { const int i_ = lane, c8_ = wid * 8; const bf16* pr_ = proj + (size_t)((TB) + (dir ? 63 - i_ : i_)) * EW + E_V + h * 128 + c8_; \
          pv0 = *(const uint4*)pr_; pv1 = *(const uint4*)(pr_ + 64); } \
        { const int i_ = tid >> 3, c8_ = (tid & 7) * 8; const bf16* pr_ = proj + (size_t)((TB) + (dir ? 63 - i_ : i_)) * EW + h * 64 + c8_; \
          pq = *(const uint4*)(pr_ + E_Q); pkk = *(const uint4*)(pr_ + E_K); } \
        { const int i_ = 16 * rt + fr; pga = make_uint4(0u, 0u, 0u, 0u); if (fq < 2) pga = *(const uint4*)(proj + (size_t)((TB) + (dir ? 63 - i_ : i_)) * EW + E_GD + dir * 16 + fq * 8); } \
    } while (0)
    GLA_FETCH(sq_.start + (dir ? sq_.len - 64 : 0));
    for (int cc = 0; cc < nch; ++cc) {
        const int tb = sq_.start + (dir ? sq_.len - 64 - cc * 64 : cc * 64);
        {
            {
                const int i = lane, c8 = wid * 8;
                const f8v va = unpack8v(pv0), vb = unpack8v(pv1);
#pragma unroll
                for (int j = 0; j < 8; ++j) { VT[(c8 + j) * GL_LD + i] = f2bf(va[j]); VT[(64 + c8 + j) * GL_LD + i] = f2bf(vb[j]); }
            }
            { const int i = tid >> 3, c8 = (tid & 7) * 8; *(uint4*)(Qd + i * GL_LD + c8) = pq; *(uint4*)(Ki + i * GL_LD + c8) = pkk; }
            const s8v ga = __builtin_bit_cast(s8v, pga);
            if (cc + 1 < nch) GLA_FETCH(sq_.start + (dir ? sq_.len - 128 - cc * 64 : (cc + 1) * 64));
#pragma unroll
            for (int c2 = 0; c2 < 2; ++c2) {
                const f4v x = mfma16(ga, gfrag[c2], (f4v){0.f, 0.f, 0.f, 0.f});
                float la[4];
#pragma unroll
                for (int r = 0; r < 4; ++r) la[r] = logsigf_(x[r] + gb[c2]) * (1.0f / 16.0f);
                *(uint2*)(LAt + (16 * (2 * chf + c2) + fr) * GL_LD + 16 * rt + fq * 4) = make_uint2(pack2(la[0], la[1]), pack2(la[2], la[3]));
            }
        }
        LBAR();
        {
            f4v bc[2];
            bc[0] = (f4v){0.f, 0.f, 0.f, 0.f}; bc[1] = bc[0];
#pragma unroll
            for (int ks = 0; ks < 2; ++ks) {
                s8v lf;
#pragma unroll
                for (int j = 0; j < 8; ++j) lf[j] = (32 * ks + 8 * fq + j <= 16 * rt + fr) ? (short)0x3F80 : (short)0;
#pragma unroll
                for (int c2 = 0; c2 < 2; ++c2) bc[c2] = mfma16(lf, *(const s8v*)(LAt + (16 * (2 * chf + c2) + fr) * GL_LD + 32 * ks + 8 * fq), bc[c2]);
            }
#pragma unroll
            for (int c2 = 0; c2 < 2; ++c2) {
                const int d = 16 * (2 * chf + c2) + fr;
                float kiv[4];
#pragma unroll
                for (int r = 0; r < 4; ++r) {
                    const int i = 16 * rt + fq * 4 + r;
                    const float eb = fexp(bc[c2][r]);
                    const float qv = bf2f(Qd[i * GL_LD + d]) * 0.125f * eb;
                    kiv[r] = bf2f(Ki[i * GL_LD + d]) * frcp(eb);
                    Qd[i * GL_LD + d] = f2bf(qv); Ki[i * GL_LD + d] = f2bf(kiv[r]);
                    if (i == 63) sAE[d] = eb;
                }
                *(uint2*)(KiT + d * GL_LD + 16 * rt + fq * 4) = make_uint2(pack2(kiv[0], kiv[1]), pack2(kiv[2], kiv[3]));
            }
        }
        LBAR();
        f4v oacc[4];
        {
            f4v sc[2];
            sc[0] = (f4v){0.f, 0.f, 0.f, 0.f}; sc[1] = sc[0];
#pragma unroll
            for (int ct = 0; ct < 4; ++ct) oacc[ct] = (f4v){0.f, 0.f, 0.f, 0.f};
#pragma unroll
            for (int ks = 0; ks < 2; ++ks) {
                const s8v a = *(const s8v*)(Qd + (16 * rt + fr) * GL_LD + 32 * ks + 8 * fq);
#pragma unroll
                for (int c2 = 0; c2 < 2; ++c2) sc[c2] = mfma16(a, *(const s8v*)(Ki + (16 * (2 * chf + c2) + fr) * GL_LD + 32 * ks + 8 * fq), sc[c2]);
#pragma unroll
                for (int ct = 0; ct < 4; ++ct) oacc[ct] = mfma16(*(const s8v*)(St + (64 * chf + 16 * ct + fr) * GL_LD + 32 * ks + 8 * fq), a, oacc[ct]);
            }
#pragma unroll
            for (int c2 = 0; c2 < 2; ++c2)
#pragma unroll
                for (int r = 0; r < 4; ++r) { const int i = 16 * rt + fq * 4 + r, j = 16 * (2 * chf + c2) + fr; Sc[i * GL_LD + j] = f2bf(j <= i ? sc[c2][r] : 0.f); }
        }
        LBAR();
        {
#pragma unroll
            for (int ks = 0; ks < 2; ++ks) {
                const s8v a = *(const s8v*)(Sc + (16 * rt + fr) * GL_LD + 32 * ks + 8 * fq);
                const s8v kt = *(const s8v*)(KiT + (16 * rt + fr) * GL_LD + 32 * ks + 8 * fq);
#pragma unroll
                for (int ct = 0; ct < 4; ++ct) {
                    const s8v bv = *(const s8v*)(VT + (64 * chf + 16 * ct + fr) * GL_LD + 32 * ks + 8 * fq);
                    oacc[ct] = mfma16(bv, a, oacc[ct]); Sacc[ct] = mfma16(kt, bv, Sacc[ct]);
                }
            }
            {
                const int i = 16 * rt + fr, t = tb + (dir ? 63 - i : i);
                if (dir == 0) {
#pragma unroll
                    for (int ct = 0; ct < 4; ++ct) *(uint2*)(opart + (size_t)t * 512 + h * 128 + 64 * chf + 16 * ct + fq * 4) = pack4(oacc[ct]);
                } else {
#pragma unroll
                    for (int ct = 0; ct < 4; ++ct) *(f4v*)(Of + i * 132 + 64 * chf + 16 * ct + fq * 4) = oacc[ct];
                }
            }
            float ae[4];
#pragma unroll
            for (int r = 0; r < 4; ++r) ae[r] = sAE[16 * rt + fq * 4 + r];
#pragma unroll
            for (int ct = 0; ct < 4; ++ct) {
#pragma unroll
                for (int r = 0; r < 4; ++r) Sacc[ct][r] *= ae[r];
                *(uint2*)(St + (64 * chf + 16 * ct + fr) * GL_LD + 16 * rt + fq * 4) = make_uint2(pack2(Sacc[ct][0], Sacc[ct][1]), pack2(Sacc[ct][2], Sacc[ct][3]));
            }
        }
        LBAR();
        if (dir == 1) {
            const int i = tid >> 3, d0 = (tid & 7) * 16, t = tb + 63 - i;
            const bf16* ofp = opart + (size_t)t * 512 + h * 128 + d0;
            const bf16* zap = proj + (size_t)t * EW + E_ZA + h * 128 + d0;
            const f8v o0 = *(const f8v*)(Of + i * 132 + d0) + unpack8v(*(const uint4*)ofp), o1 = *(const f8v*)(Of + i * 132 + d0 + 8) + unpack8v(*(const uint4*)(ofp + 8));
            float ss = 0.f;
#pragma unroll
            for (int j = 0; j < 8; ++j) ss += o0[j] * o0[j] + o1[j] * o1[j];
            const float r = frsq(red8(ss) * (1.0f / 128.f) + EPS);
            const float* gn = p.in[I_GLAN] + ei * 128 + d0;
            const f8v z0 = unpack8v(*(const uint4*)zap), z1 = unpack8v(*(const uint4*)(zap + 8));
            f8v y0, y1;
#pragma unroll
            for (int j = 0; j < 8; ++j) { y0[j] = o0[j] * r * gn[j] * siluf_(z0[j]); y1[j] = o1[j] * r * gn[8 + j] * siluf_(z1[j]); }
            bf16* yc = (bf16*)(p.ws + WS_YCE) + (size_t)t * D + h * 128 + d0;
            *(uint4*)yc = pack8v(y0); *(uint4*)(yc + 8) = pack8v(y1);
        }
    }
    if (!sq_.lat) {
        float* fs = p.out + OUT_GLA + ((((size_t)sq_.b * N_EVEN + ei) * 2 + dir) * 4 + h) * 64 * 128;
#pragma unroll
        for (int ct = 0; ct < 4; ++ct)
#pragma unroll
            for (int r = 0; r < 4; ++r) fs[(16 * rt + fq * 4 + r) * 128 + 64 * chf + 16 * ct + fr] = Sacc[ct][r];
    }
}

#ifndef RW_PREFETCH
#define RW_PREFETCH 1
#endif
constexpr int RW_LD = 72;
constexpr int RWKV_PREP_ITEMS = (T / 64) * 8;
struct RwPre { uint4 x[5], l[5], r[5]; };
__device__ __forceinline__ void rwkv_prefetch(const P& p, int w, int dir, int tid, RwPre& q) {
    const int cg = w >> 3, h = w & 7, hc0 = h * 64;
    const int i = tid >> 3, c8 = (tid & 7) * 8, t = cg * 64 + (dir ? 63 - i : i);
    bool hl, hr; tok_nbr(t, hl, hr);
    const bf16* proj = (const bf16*)(p.ws + WS_PROJ);
#pragma unroll
    for (int grp = 0; grp < 5; ++grp) {
        const int col = (grp == 0 ? FB_R + hc0 : grp == 1 ? FB_K + hc0 : grp == 2 ? FB_V + hc0 : grp == 3 ? FB_WD + dir * 64 : FB_AD + dir * 64) + c8;
        const bf16* pr = proj + (size_t)t * EW + E_FB + col;
        q.x[grp] = *(const uint4*)pr;
        q.l[grp] = hl ? *(const uint4*)(pr - EW) : make_uint4(0u, 0u, 0u, 0u);
        q.r[grp] = hr ? *(const uint4*)(pr + EW) : make_uint4(0u, 0u, 0u, 0u);
    }
}
__device__ __forceinline__ void rwkv_prep_phase(const P& p, int ei, int dir, int w_first, int w_stride, int w_end, unsigned char* dsm) {
    float* sCS = (float*)dsm;
    float* sKK = sCS + 4096;
    float* sB = sKK + 4096;
    float* sKM = sB + 4096;
    float* sR = sKM + 4096;
    float* sAf = (float*)dsm;
    float* sXf = sAf + 64 * TI_LD;
    float* sTmp = sXf + 64 * TI_LD;
    bf16* AakT = (bf16*)(sTmp + 8 * 16 * TI_TLD);
    bf16* Brb = AakT + 64 * RW_LD;
    bf16* Tm = Brb + 64 * RW_LD;
    bf16* PT = (bf16*)dsm;
    bf16* W1T = PT + 64 * RW_LD;
    static_assert(2 * 64 * TI_LD * 4 + 8 * 16 * TI_TLD * 4 + 3 * 64 * RW_LD * 2 <= 81920, "RWKV prep overlays exceed region A");
    bf16* At = (bf16*)(dsm + 81920);
    bf16* Bt = At + 64 * RW_LD;
    bf16* Kt = Bt + 64 * RW_LD;
    bf16* Rt = Kt + 64 * RW_LD;
    bf16* BhT = Rt + 64 * RW_LD;
    bf16* KhT = BhT + 64 * RW_LD;
    bf16* AtT = KhT + 64 * RW_LD;
    bf16* sTW = At;
    bf16* sAD = Bt;
    float* sSeg = (float*)(AtT + 64 * RW_LD);
    const int tid0 = opaque_tid();
    float* bonus = (float*)(p.ws + WS_BONUS);
    const float* mix = p.in[I_MIX] + (size_t)ei * 1792;
    int hcur = -1;
    s8v lrf[4][2];
    float lrb[4];
    RwPre pre;
#if RW_PREFETCH
    if (w_first < w_end) rwkv_prefetch(p, w_first, dir, tid0, pre);
#endif
    for (int w = w_first; w < w_end; w += w_stride) {
        const int tid = opaque_tid(), lane = tid & 63, wid = tid >> 6, fr = lane & 15, fq = lane >> 4;
        const int rt = wid & 3, cb = 2 * (wid >> 2), which = wid >> 2;
        const int cg = w >> 3, h = w & 7, hc0 = h * 64;
        const size_t tk = (size_t)cg * 8 + h;
        if (h != hcur) {
            hcur = h;
            LBAR();
            const float* w2 = p.in[I_W2] + (size_t)(ei * 2 + dir) * 64 * 512 + hc0; const float* a2 = p.in[I_A2] + (size_t)(ei * 2 + dir) * 64 * 512 + hc0;
            for (int e = tid; e < 4096; e += 512) { const int r = e >> 6, c = e & 63; Kt[c * RW_LD + r] = f2bf(w2[(size_t)r * 512 + c]); Rt[c * RW_LD + r] = f2bf(a2[(size_t)r * 512 + c]); }
            LBAR();
            const bf16* src = which ? Rt : Kt;
            const float* lb = (which ? p.in[I_A0] : p.in[I_W0]) + (size_t)(ei * 2 + dir) * 512 + hc0;
#pragma unroll
            for (int ct = 0; ct < 4; ++ct) {
                lrb[ct] = lb[16 * ct + fr];
#pragma unroll
                for (int ks = 0; ks < 2; ++ks) lrf[ct][ks] = *(const s8v*)(src + (16 * ct + fr) * RW_LD + ks * 32 + fq * 8);
            }
        }
        LBAR();
#if !RW_PREFETCH
        rwkv_prefetch(p, w, dir, tid, pre);
#endif
        {
            const int i = tid >> 3, c8 = (tid & 7) * 8, t = cg * 64 + (dir ? 63 - i : i);
#pragma unroll
            for (int grp = 0; grp < 5; ++grp) {
                const int col = (grp == 0 ? FB_R + hc0 : grp == 1 ? FB_K + hc0 : grp == 2 ? FB_V + hc0 : grp == 3 ? FB_WD + dir * 64 : FB_AD + dir * 64) + c8;
                const f8v x = unpack8v(pre.x[grp]);
                const f8v nb = unpack8v(pre.l[grp]) + unpack8v(pre.r[grp]);
                const f8v mv = *(const f8v*)(mix + col);
                f8v y = x + mv * (nb * 0.5f - x);
                if (grp == 0) *(f8v*)(sR + i * 64 + c8) = y;
                else if (grp == 1) *(f8v*)(sKM + i * 64 + c8) = y;
                else if (grp == 2) { if (dir == 0) *(uint4*)((bf16*)(p.ws + WS_VSH) + (size_t)t * 512 + hc0 + c8) = pack8v(y); }
                else {
                    if (grp == 3) {
#pragma unroll
                        for (int j = 0; j < 8; ++j) y[j] = ftanh(y[j]);
                    }
                    *(uint4*)((grp == 3 ? sTW : sAD) + i * RW_LD + c8) = pack8v(y);
                }
            }
        }
#if RW_PREFETCH
        if (w + w_stride < w_end) rwkv_prefetch(p, w + w_stride, dir, tid, pre);
#endif
        LBAR();
        {
            const bf16* Am = which ? sAD : sTW;
            f4v acc[4];
#pragma unroll
            for (int ct = 0; ct < 4; ++ct) acc[ct] = (f4v){0.f, 0.f, 0.f, 0.f};
#pragma unroll
            for (int ks = 0; ks < 2; ++ks) {
                const s8v a = *(const s8v*)(Am + (16 * rt + fr) * RW_LD + ks * 32 + fq * 8);
#pragma unroll
                for (int ct = 0; ct < 4; ++ct) acc[ct] = mfma16(a, lrf[ct][ks], acc[ct]);
            }
#pragma unroll
            for (int ct = 0; ct < 4; ++ct) {
                const int c = 16 * ct + fr;
#pragma unroll
                for (int r = 0; r < 4; ++r) {
                    const int tok = 16 * rt + fq * 4 + r;
                    const float sg = sigmoidf_(lrb[ct] + acc[ct][r]);
                    if (which) sB[tok * 64 + c] = sg; else sCS[tok * 64 + c] = -0.6065306597126334f * sg;
                }
            }
        }
        LBAR();
        {
            const int i = tid >> 3, c8 = (tid & 7) * 8;
            const float* kkw = p.in[I_KK] + (size_t)ei * 512 + hc0; const float* kaw = p.in[I_KA] + (size_t)ei * 512 + hc0; const float* rkw = p.in[I_RK] + (size_t)ei * 512 + hc0;
            const f8v av = *(const f8v*)(sB + i * 64 + c8), kr = *(const f8v*)(sKM + i * 64 + c8), rv = *(const f8v*)(sR + i * 64 + c8);
            const f8v kav = *(const f8v*)(kaw + c8), kkv = *(const f8v*)(kkw + c8), rkv = *(const f8v*)(rkw + c8);
            const f8v km = kr * (1.0f + (av - 1.0f) * kav);
            f8v kk = kr * kkv;
            float ss = 0.f, bn = 0.f;
#pragma unroll
            for (int j = 0; j < 8; ++j) { ss += kk[j] * kk[j]; bn += rv[j] * km[j] * rkv[j]; }
            ss = red8(ss); bn = red8(bn);
            kk *= frsq(ss + EPS);
            *(f8v*)(sKK + i * 64 + c8) = kk; *(f8v*)(sB + i * 64 + c8) = kk * av; *(f8v*)(sKM + i * 64 + c8) = km;
            if ((tid & 7) == 0) { const int t = cg * 64 + (dir ? 63 - i : i); bonus[((size_t)t * 8 + h) * 2 + dir] = bn; }
        }
        {
            const int c = tid & 63, sg = tid >> 6;
            float run = 0.f;
#pragma unroll
            for (int j = 0; j < 8; ++j) { run += sCS[(8 * sg + j) * 64 + c]; sCS[(8 * sg + j) * 64 + c] = run; }
            sSeg[sg * 64 + c] = run;
        }
        LBAR();
        {
            const int c = tid & 63, sg = tid >> 6;
            float off = 0.f;
            for (int q = 0; q < sg; ++q) off += sSeg[q * 64 + c];
#pragma unroll
            for (int j = 0; j < 8; ++j) sCS[(8 * sg + j) * 64 + c] += off;
        }
        LBAR();
        {
            const int i = tid >> 3, c8 = (tid & 7) * 8;
            const f8v cs = *(const f8v*)(sCS + i * 64 + c8), cl = *(const f8v*)(sCS + 63 * 64 + c8);
            f8v cp = (f8v)(0.f);
            if (i > 0) cp = *(const f8v*)(sCS + (i - 1) * 64 + c8);
            const f8v kk = *(const f8v*)(sKK + i * 64 + c8), bb = *(const f8v*)(sB + i * 64 + c8), km = *(const f8v*)(sKM + i * 64 + c8), rv = *(const f8v*)(sR + i * 64 + c8);
            f8v at, bt, kt, rtv;
#pragma unroll
            for (int j = 0; j < 8; ++j) {
                const float g = fexp(cs[j]), gi = frcp(g), gp = fexp(cp[j]), gc = fexp(cl[j]) * gi;
                at[j] = -kk[j] * gp; bt[j] = bb[j] * gi; kt[j] = km[j] * gi; rtv[j] = rv[j] * g;
                BhT[(c8 + j) * RW_LD + i] = f2bf(bb[j] * gc); KhT[(c8 + j) * RW_LD + i] = f2bf(km[j] * gc); AtT[(c8 + j) * RW_LD + i] = f2bf(at[j]);
            }
            *(uint4*)(At + i * RW_LD + c8) = pack8v(at); *(uint4*)(Bt + i * RW_LD + c8) = pack8v(bt);
            *(uint4*)(Kt + i * RW_LD + c8) = pack8v(kt); *(uint4*)(Rt + i * RW_LD + c8) = pack8v(rtv);
            if (i == 63) {
                float* gco = (float*)(p.ws + WS_GC) + tk * 64 + c8;
#pragma unroll
                for (int j = 0; j < 8; ++j) gco[j] = fexp(cl[j]);
            }
        }
        LBAR();
        f4v brkT[2];
        {
            f4v aab[2], aak[2], brb[2];
#pragma unroll
            for (int c2 = 0; c2 < 2; ++c2) { aab[c2] = (f4v){0.f, 0.f, 0.f, 0.f}; aak[c2] = aab[c2]; brb[c2] = aab[c2]; brkT[c2] = aab[c2]; }
#pragma unroll
            for (int ks = 0; ks < 2; ++ks) {
                const int ko = ks * 32 + fq * 8, ra = (16 * rt + fr) * RW_LD + ko;
                const s8v fa = *(const s8v*)(At + ra), frr = *(const s8v*)(Rt + ra), fk = *(const s8v*)(Kt + ra);
#pragma unroll
                for (int c2 = 0; c2 < 2; ++c2) {
                    const int ro = (16 * (cb + c2) + fr) * RW_LD + ko;
                    const s8v gb = *(const s8v*)(Bt + ro), gk = *(const s8v*)(Kt + ro), gr = *(const s8v*)(Rt + ro);
                    aab[c2] = mfma16(fa, gb, aab[c2]); aak[c2] = mfma16(fa, gk, aak[c2]); brb[c2] = mfma16(frr, gb, brb[c2]);
                    brkT[c2] = mfma16(fk, gr, brkT[c2]);
                }
            }
#pragma unroll
            for (int c2 = 0; c2 < 2; ++c2) {
                const int col = 16 * (cb + c2) + fr, r0 = 16 * rt + fq * 4;
                f4v ak;
#pragma unroll
                for (int r = 0; r < 4; ++r) {
                    const int row = r0 + r;
                    sAf[row * TI_LD + col] = col < row ? -aab[c2][r] : 0.f;
                    ak[r] = col < row ? aak[c2][r] : 0.f;
                    Brb[row * RW_LD + col] = f2bf(col <= row ? brb[c2][r] : 0.f);
                    if (!(row <= col)) brkT[c2][r] = 0.f;
                }
                *(uint2*)(AakT + col * RW_LD + r0) = pack4(ak);
            }
        }
        LBAR();
        tri_inv64(sAf, sXf, sTmp, wid & 3, lane, wid < 4);
        { const int i = tid >> 3, c8 = (tid & 7) * 8; *(uint4*)(Tm + i * RW_LD + c8) = pack8v(*(const f8v*)(sXf + i * TI_LD + c8)); }
        LBAR();
        {
            f4v pp[2], ww[2];
#pragma unroll
            for (int c2 = 0; c2 < 2; ++c2) { pp[c2] = (f4v){0.f, 0.f, 0.f, 0.f}; ww[c2] = pp[c2]; }
#pragma unroll
            for (int ks = 0; ks < 2; ++ks) {
                const int ko = ks * 32 + fq * 8;
                const s8v ft = *(const s8v*)(Tm + (16 * rt + fr) * RW_LD + ko);
#pragma unroll
                for (int c2 = 0; c2 < 2; ++c2) {
                    const int ro = (16 * (cb + c2) + fr) * RW_LD + ko;
                    pp[c2] = mfma16(ft, *(const s8v*)(AtT + ro), pp[c2]); ww[c2] = mfma16(ft, *(const s8v*)(AakT + ro), ww[c2]);
                }
            }
#pragma unroll
            for (int c2 = 0; c2 < 2; ++c2) {
                const int col = 16 * (cb + c2) + fr;
                *(uint2*)(PT + col * RW_LD + 16 * rt + fq * 4) = pack4(pp[c2]);
                *(uint2*)(W1T + col * RW_LD + 16 * rt + fq * 4) = pack4(ww[c2]);
            }
        }
        LBAR();
        {
            bf16* m12 = (bf16*)(p.ws + WS_RM12) + tk * 8192; bf16* m34 = (bf16*)(p.ws + WS_RM34) + tk * 8192;
#pragma unroll
            for (int c2 = 0; c2 < 2; ++c2) {
                const int col = 16 * (cb + c2) + fr, r0 = 16 * rt + fq * 4;
                f4v m1 = unpack4(*(const uint2*)(Rt + col * RW_LD + r0));
                f4v m2 = brkT[c2], m3 = (f4v){0.f, 0.f, 0.f, 0.f};
                f4v m4 = unpack4(*(const uint2*)(KhT + col * RW_LD + r0));
#pragma unroll
                for (int ks = 0; ks < 2; ++ks) {
                    const int ko = ks * 32 + fq * 8;
                    const s8v fp = *(const s8v*)(PT + (16 * rt + fr) * RW_LD + ko), fw = *(const s8v*)(W1T + (16 * rt + fr) * RW_LD + ko);
                    const s8v gb = *(const s8v*)(Brb + col * RW_LD + ko), gh = *(const s8v*)(BhT + col * RW_LD + ko);
                    m1 = mfma16(fp, gb, m1);
                    m2 = mfma16(fw, gb, m2);
                    m3 = mfma16(fp, gh, m3);
                    m4 = mfma16(fw, gh, m4);
                }
                *(uint2*)(m12 + col * 64 + r0) = pack4(m1);
                *(uint2*)(m12 + 4096 + col * 64 + r0) = pack4(m2);
                *(uint2*)(m34 + col * 64 + r0) = pack4(m3);
                *(uint2*)(m34 + 4096 + col * 64 + r0) = pack4(m4);
            }
        }
    }
}
__device__ __forceinline__ void rwkv_apply_task(const P& p, int ei, int s, int h, int dir, unsigned char* dsm) {
    bf16* St = (bf16*)dsm;
    bf16* VT = St + 64 * RW_LD;
    bf16* M1 = VT + 64 * RW_LD;
    bf16* M2 = M1 + 64 * RW_LD;
    bf16* M3 = M2 + 64 * RW_LD;
    bf16* M4 = M3 + 64 * RW_LD;
    float* sGC = (float*)(M4 + 64 * RW_LD);
    float* Yf = sGC + 64;
    const Seq sq_ = get_seq(s);
    const int tid = opaque_tid(), lane = tid & 63, wid = tid >> 6, fr = lane & 15, fq = lane >> 4;
    const int rt = wid & 3, cb = 2 * (wid >> 2), hc0 = h * 64;
    bf16* opart = (bf16*)(p.ws + WS_PART + PART_SZ);
    f4v Sacc[2];
    LBAR();
#pragma unroll
    for (int c2 = 0; c2 < 2; ++c2) {
        const int v = 16 * (cb + c2) + fr, k0 = 16 * rt + fq * 4;
        if (sq_.lat) Sacc[c2] = *(const f4v*)(p.in[I_SRWKV] + ((((size_t)sq_.b * N_EVEN + ei) * 2 + dir) * 8 + h) * 4096 + v * 64 + k0);
        else Sacc[c2] = (f4v){0.f, 0.f, 0.f, 0.f};
        *(uint2*)(St + v * RW_LD + k0) = make_uint2(pack2(Sacc[c2][0], Sacc[c2][1]), pack2(Sacc[c2][2], Sacc[c2][3]));
    }
    const int nch = sq_.len >> 6;
    uint4 pm0, pm1, pm2, pm3, pvv; float pgc = 0.f;
    {
        const int cg0 = (sq_.start >> 6) + (dir ? nch - 1 : 0); const size_t tk0 = (size_t)cg0 * 8 + h;
        const int i = tid >> 3, c8 = (tid & 7) * 8;
        const bf16* m12 = (const bf16*)(p.ws + WS_RM12) + tk0 * 8192; const bf16* m34 = (const bf16*)(p.ws + WS_RM34) + tk0 * 8192;
        pm0 = *(const uint4*)(m12 + i * 64 + c8); pm1 = *(const uint4*)(m12 + 4096 + i * 64 + c8); pm2 = *(const uint4*)(m34 + i * 64 + c8); pm3 = *(const uint4*)(m34 + 4096 + i * 64 + c8);
        pvv = *(const uint4*)((const bf16*)(p.ws + WS_VSH) + (size_t)(cg0 * 64 + (dir ? 63 - lane : lane)) * 512 + hc0 + wid * 8);
        if (tid < 64) pgc = ((const float*)(p.ws + WS_GC))[tk0 * 64 + tid];
    }
    for (int cc = 0; cc < nch; ++cc) {
        const int cg = (sq_.start >> 6) + (dir ? nch - 1 - cc : cc);
        {
            const int i = tid >> 3, c8 = (tid & 7) * 8;
            *(uint4*)(M1 + i * RW_LD + c8) = pm0; *(uint4*)(M2 + i * RW_LD + c8) = pm1; *(uint4*)(M3 + i * RW_LD + c8) = pm2; *(uint4*)(M4 + i * RW_LD + c8) = pm3;
            const f8v vv = unpack8v(pvv);
#pragma unroll
            for (int j = 0; j < 8; ++j) VT[(wid * 8 + j) * RW_LD + lane] = f2bf(vv[j]);
            if (tid < 64) sGC[tid] = pgc;
            if (cc + 1 < nch) {
                const int cgn = (sq_.start >> 6) + (dir ? nch - 2 - cc : cc + 1); const size_t tkn = (size_t)cgn * 8 + h;
                const bf16* m12 = (const bf16*)(p.ws + WS_RM12) + tkn * 8192; const bf16* m34 = (const bf16*)(p.ws + WS_RM34) + tkn * 8192;
                pm0 = *(const uint4*)(m12 + i * 64 + c8); pm1 = *(const uint4*)(m12 + 4096 + i * 64 + c8); pm2 = *(const uint4*)(m34 + i * 64 + c8); pm3 = *(const uint4*)(m34 + 4096 + i * 64 + c8);
                pvv = *(const uint4*)((const bf16*)(p.ws + WS_VSH) + (size_t)(cgn * 64 + (dir ? 63 - lane : lane)) * 512 + hc0 + wid * 8);
                if (tid < 64) pgc = ((const float*)(p.ws + WS_GC))[tkn * 64 + tid];
            }
        }
        LBAR();
        {
            f4v yT[2], sn[2];
#pragma unroll
            for (int c2 = 0; c2 < 2; ++c2) { yT[c2] = (f4v){0.f, 0.f, 0.f, 0.f}; sn[c2] = yT[c2]; }
#pragma unroll
            for (int ks = 0; ks < 2; ++ks) {
                const int ko = ks * 32 + fq * 8;
                const s8v fs = *(const s8v*)(St + (16 * rt + fr) * RW_LD + ko), fv = *(const s8v*)(VT + (16 * rt + fr) * RW_LD + ko);
                const s8v f3 = *(const s8v*)(M3 + (16 * rt + fr) * RW_LD + ko), f4 = *(const s8v*)(M4 + (16 * rt + fr) * RW_LD + ko);
#pragma unroll
                for (int c2 = 0; c2 < 2; ++c2) {
                    const int ro = (16 * (cb + c2) + fr) * RW_LD + ko;
                    yT[c2] = mfma16(fs, *(const s8v*)(M1 + ro), yT[c2]); yT[c2] = mfma16(fv, *(const s8v*)(M2 + ro), yT[c2]);
                    sn[c2] = mfma16(f3, *(const s8v*)(St + ro), sn[c2]); sn[c2] = mfma16(f4, *(const s8v*)(VT + ro), sn[c2]);
                }
            }
            float gc[4];
#pragma unroll
            for (int r = 0; r < 4; ++r) gc[r] = sGC[16 * rt + fq * 4 + r];
#pragma unroll
            for (int c2 = 0; c2 < 2; ++c2) {
                const int tt = 16 * (cb + c2) + fr, t = cg * 64 + (dir ? 63 - tt : tt);
                if (dir == 0) *(uint2*)(opart + (size_t)t * 512 + hc0 + 16 * rt + fq * 4) = make_uint2(pack2(yT[c2][0], yT[c2][1]), pack2(yT[c2][2], yT[c2][3]));
                else *(f4v*)(Yf + tt * 68 + 16 * rt + fq * 4) = yT[c2];
#pragma unroll
                for (int r = 0; r < 4; ++r) Sacc[c2][r] = Sacc[c2][r] * gc[r] + sn[c2][r];
            }
        }
        LBAR();
#pragma unroll
        for (int c2 = 0; c2 < 2; ++c2) *(uint2*)(St + (16 * (cb + c2) + fr) * RW_LD + 16 * rt + fq * 4) = make_uint2(pack2(Sacc[c2][0], Sacc[c2][1]), pack2(Sacc[c2][2], Sacc[c2][3]));
        if (dir == 1) {
            const int i = tid >> 3, c8 = (tid & 7) * 8, t = cg * 64 + 63 - i;
            f8v o = *(const f8v*)(Yf + i * 68 + c8) + unpack8v(*(const uint4*)(opart + (size_t)t * 512 + hc0 + c8));
            float mu = 0.f;
#pragma unroll
            for (int j = 0; j < 8; ++j) mu += o[j];
            mu = red8(mu) * (1.0f / 64.f);
            o -= mu;
            float var = 0.f;
#pragma unroll
            for (int j = 0; j < 8; ++j) var += o[j] * o[j];
            const float r = frsq(red8(var) * (1.0f / 64.f) + 64e-5f);
            const float* bn = (const float*)(p.ws + WS_BONUS) + ((size_t)t * 8 + h) * 2;
            const float bsum = bn[0] + bn[1];
            const f8v vsh = unpack8v(*(const uint4*)((const bf16*)(p.ws + WS_VSH) + (size_t)t * 512 + hc0 + c8));
            const f8v zb = unpack8v(*(const uint4*)((const bf16*)(p.ws + WS_PROJ) + (size_t)t * EW + E_ZB + hc0 + c8));
            const f8v lg = *(const f8v*)(p.in[I_LNG] + ei * 512 + hc0 + c8), lb = *(const f8v*)(p.in[I_LNB] + ei * 512 + hc0 + c8);
            f8v y;
#pragma unroll
            for (int j = 0; j < 8; ++j) y[j] = (o[j] * r * lg[j] + lb[j] + bsum * vsh[j]) * siluf_(zb[j]);
            *(uint4*)((bf16*)(p.ws + WS_YCE) + (size_t)t * D + 512 + hc0 + c8) = pack8v(y);
        }
    }
    if (!sq_.lat) {
#pragma unroll
        for (int c2 = 0; c2 < 2; ++c2)
            *(f4v*)(p.out + OUT_RWKV + ((((size_t)sq_.b * N_EVEN + ei) * 2 + dir) * 8 + h) * 4096 + (16 * (cb + c2) + fr) * 64 + 16 * rt + fq * 4) = Sacc[c2];
    }
}
constexpr int EV_AP_LAT = NB_LAT * 8, EV_AP_CTX = NB_CTX * 8, EV_GLA_LAT = NB_LAT * 4, EV_GLA_CTX = NB_CTX * 4;
constexpr int EVEN_SCAN_ITEMS = EV_AP_LAT + EV_GLA_LAT + EV_AP_CTX + EV_GLA_CTX;
__device__ __forceinline__ void ph_even_scan_item(const P& p, int w, int ei, int dir, unsigned char* dsm) {
    int kind, sbase, x;
    if (w < EV_AP_LAT) { kind = 0; sbase = NB_CTX; x = w; }
    else if (w < EV_AP_LAT + EV_GLA_LAT) { kind = 1; sbase = NB_CTX; x = w - EV_AP_LAT; }
    else if (w < EV_AP_LAT + EV_GLA_LAT + EV_AP_CTX) { kind = 0; sbase = 0; x = w - EV_AP_LAT - EV_GLA_LAT; }
    else { kind = 1; sbase = 0; x = w - EV_AP_LAT - EV_GLA_LAT - EV_AP_CTX; }
    if (kind == 0) rwkv_apply_task(p, ei, sbase + x / 8, x & 7, dir, dsm);
    else gla_scan_task(p, ei, sbase + x / 4, x & 3, dir, dsm);
}

__device__ __forceinline__ void ph_fin_even(const P& p, int bid, int ei) {
    const int lane = LT & 63, t = bid * 4 + (LT >> 6);
    if (t >= T) return;
    const bf16* pr = (const bf16*)(p.ws + WS_PROJ) + (size_t)t * EW;
    const bf16* oaf = (const bf16*)(p.ws + WS_PART) + (size_t)t * 512;
    const bf16* oab = (const bf16*)(p.ws + WS_PART + PART_SZ) + (size_t)t * 512;
    const bf16* obf = (const bf16*)(p.ws + WS_PART + 2 * PART_SZ) + (size_t)t * 512;
    const bf16* obb = (const bf16*)(p.ws + WS_PART + 3 * PART_SZ) + (size_t)t * 512;
    bf16* yc = (bf16*)(p.ws + WS_HM) + (size_t)t * D;
    const int idx = lane * 8;
    {
        float o[8], ss = 0.f;
#pragma unroll
        for (int j = 0; j < 8; ++j) { o[j] = bf2f(oaf[idx + j]) + bf2f(oab[idx + j]); ss += o[j] * o[j]; }
        ss += __shfl_xor(ss, 1); ss += __shfl_xor(ss, 2); ss += __shfl_xor(ss, 4); ss += __shfl_xor(ss, 8);
        const float r = frsq(ss * (1.0f / 128.f) + EPS);
        const float* gn = p.in[I_GLAN] + ei * 128 + (idx & 127);
#pragma unroll
        for (int j = 0; j < 8; ++j) yc[idx + j] = f2bf(o[j] * r * gn[j] * siluf_(bf2f(pr[E_ZA + idx + j])));
    }
    {
        float o[8], mu = 0.f;
#pragma unroll
        for (int j = 0; j < 8; ++j) { o[j] = bf2f(obf[idx + j]) + bf2f(obb[idx + j]); mu += o[j]; }
        mu += __shfl_xor(mu, 1); mu += __shfl_xor(mu, 2); mu += __shfl_xor(mu, 4);
        mu *= (1.0f / 64.f);
        float var = 0.f;
#pragma unroll
        for (int j = 0; j < 8; ++j) { o[j] -= mu; var += o[j] * o[j]; }
        var += __shfl_xor(var, 1); var += __shfl_xor(var, 2); var += __shfl_xor(var, 4);
        const float r = frsq(var * (1.0f / 64.f) + 64e-5f);
        const int h = idx >> 6;
        const float* bn = (const float*)(p.ws + WS_BONUS) + ((size_t)t * 8 + h) * 2;
        const float bsum = bn[0] + bn[1];
        bool hl, hr; tok_nbr(t, hl, hr);
        const float* mix = p.in[I_MIX] + (size_t)ei * 1792 + FB_V + idx;
        const float* lg = p.in[I_LNG] + ei * 512 + idx;
        const float* lb = p.in[I_LNB] + ei * 512 + idx;
#pragma unroll
        for (int j = 0; j < 8; ++j) {
            const bf16* pv = pr + E_FB + FB_V + idx + j;
            const float x = bf2f(pv[0]);
            const float nl = hl ? bf2f(pv[-EW]) : 0.f, nr = hr ? bf2f(pv[EW]) : 0.f;
            const float vsh = x + mix[j] * (0.5f * (nl + nr) - x);
            yc[512 + idx + j] = f2bf((o[j] * r * lg[j] + lb[j] + bsum * vsh) * siluf_(bf2f(pr[E_ZB + idx + j])));
        }
    }
}

constexpr int ODD_PREP_ITEMS = (T / 64) * 4;
constexpr int PQ_LD = 136;
__device__ __forceinline__ void ph_odd_prep(const P& p, int item, int oi, unsigned char* dsm) {
    bf16* sq = (bf16*)dsm;
    bf16* sk = sq + 64 * PQ_LD;
    float* sA = (float*)(dsm + 2 * 64 * PQ_LD * 2);
    float* sX = sA + 2 * 64 * TI_LD;
    float* sTm = sX + 2 * 64 * TI_LD;
    float* slg = sTm + 2 * 8 * 16 * TI_TLD;
    float* sbt = slg + 128;
    float* sgc = sbt + 128;
    float* sbp = sgc + 128;
    const int tid = opaque_tid(), lane = tid & 63, wid = tid >> 6;
    const int cg = item >> 2, h = item & 3;
    const bf16* proj = (const bf16*)(p.ws + WS_PROJ);
    const float* cw = p.in[I_CONV] + (size_t)oi * 9 * 1536;
    LBAR();
    if (wid < 6) {
        const int part = wid >> 1, oc = lane & 15, i0 = ((wid & 1) * 4 + (lane >> 4)) * 8, t0 = cg * 64;
        const bool lat = t0 >= T_CTX;
        int pos0, len;
        if (!lat) { pos0 = t0 % L_CTX; len = L_CTX; } else { pos0 = (t0 - T_CTX) % L_LAT; len = L_LAT; }
        const int gr = pos0 >> 6, nrows = len >> 6;
        const int ch = part * 512 + h * 128 + oc * 8;
        const bool okl = i0 > 0 || (!lat && pos0 > 0), okr = i0 < 56 || (!lat && pos0 + 64 < len);
        f8v acc[8];
#pragma unroll
        for (int j = 0; j < 8; ++j) acc[j] = (f8v)(0.f);
#pragma unroll
        for (int di = -1; di <= 1; ++di) {
            const bool rv = lat ? (gr + di >= 0 && gr + di < nrows) : (di == 0);
            if (rv) {
                const float* w = cw + ((di + 1) * 3) * 1536 + ch;
                const f8v w0 = *(const f8v*)w, w1 = *(const f8v*)(w + 1536), w2 = *(const f8v*)(w + 3072);
                const bf16* src = proj + (size_t)(t0 + di * 64 + i0) * OW + O_QKV + ch;
                uint4 x[10];
                x[0] = *(const uint4*)(okl ? src - OW : src);
#pragma unroll
                for (int c = 0; c < 8; ++c) x[c + 1] = *(const uint4*)(src + (size_t)c * OW);
                x[9] = *(const uint4*)(okr ? src + (size_t)8 * OW : src);
                if (!okl) x[0] = make_uint4(0u, 0u, 0u, 0u);
                if (!okr) x[9] = make_uint4(0u, 0u, 0u, 0u);
#pragma unroll
                for (int c = 0; c < 10; ++c) {
                    const f8v xc = unpack8v(x[c]);
                    if (c < 8) acc[c] += xc * w0;
                    if (c >= 1 && c <= 8) acc[c - 1] += xc * w1;
                    if (c >= 2) acc[c - 2] += xc * w2;
                }
            }
        }
        bf16* qo = (bf16*)(p.ws + WS_QKVN) + (size_t)(t0 + i0) * 1536 + ch;
        bf16* so = (part == 0 ? sq : sk) + i0 * PQ_LD + oc * 8;
#pragma unroll
        for (int j = 0; j < 8; ++j) {
            f8v a = acc[j];
            float ss = 0.f;
#pragma unroll
            for (int e = 0; e < 8; ++e) { a[e] = siluf_(a[e]); ss += a[e] * a[e]; }
            if (part < 2) {
                ss = red16(ss);
                float r = frsq(ss + EPS);
                if (part == 0) r *= 0.08838834764831845f;
                a *= r;
            }
            const uint4 pk = pack8v(a);
            *(uint4*)(qo + (size_t)j * 1536) = pk;
            if (part < 2) *(uint4*)(so + j * PQ_LD) = pk;
        }
    } else {
        const int dir = wid - 6, i = lane, t = cg * 64 + i;
        float* g = (float*)(p.ws + WS_GATES) + (size_t)t * 16;
        const float x = bf2f(proj[(size_t)t * OW + O_G + dir * 4 + h]);
        const float lgv = -fexp(p.in[I_ALOG][oi * 8 + dir * 4 + h]) * softplusf_(x + p.in[I_DTB][oi * 8 + dir * 4 + h]);
        const float bv = sigmoidf_(bf2f(proj[(size_t)t * OW + O_BETA + dir * 4 + h]));
        g[dir * 4 + h] = lgv; g[8 + dir * 4 + h] = bv;
        slg[dir * 64 + i] = lgv; sbt[dir * 64 + i] = bv;
    }
    LBAR();
    if (tid < 2) {
        const int dir = tid; float c = 0.f;
        for (int i = 0; i < 64; ++i) { const int n = dir ? 63 - i : i; c += slg[dir * 64 + n]; sgc[dir * 64 + i] = c; sbp[dir * 64 + i] = sbt[dir * 64 + n]; }
    }
    LBAR();
    {
        const int rt = wid & 3, fr = lane & 15, fq = lane >> 4;
        f4v acc[4];
#pragma unroll
        for (int ct = 0; ct < 4; ++ct) acc[ct] = (f4v){0.f, 0.f, 0.f, 0.f};
#pragma unroll
        for (int ks = 0; ks < 4; ++ks) {
            const s8v a = *(const s8v*)((wid < 4 ? sk : sq) + (16 * rt + fr) * PQ_LD + fq * 8 + ks * 32);
#pragma unroll
            for (int ct = 0; ct < 4; ++ct) {
                const s8v bb = *(const s8v*)(sk + (16 * ct + fr) * PQ_LD + fq * 8 + ks * 32);
                acc[ct] = (wid < 4) ? mfma16(a, bb, acc[ct]) : mfma16(bb, a, acc[ct]);
            }
        }
        const size_t task0 = ((size_t)cg * 4 + h) * 2;
        bf16* qk0 = (bf16*)(p.ws + WS_QKM) + task0 * 4096; bf16* qk1 = qk0 + 4096;
        if (wid < 4) {
#pragma unroll
            for (int ct = 0; ct < 4; ++ct)
#pragma unroll
                for (int r = 0; r < 4; ++r) {
                    const int a = 16 * rt + fq * 4 + r, b = 16 * ct + fr, i1 = 63 - a, j1 = 63 - b;
                    const float v = acc[ct][r];
                    if (b < a) sA[a * TI_LD + b] = sbp[a] * v * fexp(sgc[a] - sgc[b]);
                    if (b > a) sA[64 * TI_LD + i1 * TI_LD + j1] = sbp[64 + i1] * v * fexp(sgc[64 + i1] - sgc[64 + j1]);
                }
        } else {
            const int a = 16 * rt + fr, i1 = 63 - a;
            const float ga0 = sgc[a], ga1 = sgc[64 + i1];
#pragma unroll
            for (int ct = 0; ct < 4; ++ct) {
                const int b0 = 16 * ct + fq * 4;
                f4v v0, v1;
#pragma unroll
                for (int r = 0; r < 4; ++r) {
                    const int b = b0 + r, j1 = 63 - b;
                    const float v = acc[ct][r];
                    v0[r] = b <= a ? v * fexp(ga0 - sgc[b]) : 0.f;
                    v1[3 - r] = b >= a ? v * fexp(ga1 - sgc[64 + j1]) : 0.f;
                }
                *(uint2*)(qk0 + a * 64 + b0) = pack4(v0);
                *(uint2*)(qk1 + i1 * 64 + 60 - b0) = pack4(v1);
            }
        }
    }
    LBAR();
    if (wid == 2) {
        float* gco = (float*)(p.ws + WS_GC) + ((size_t)cg * 4 + h) * 128;
        gco[lane] = sgc[lane]; gco[64 + lane] = sgc[64 + lane];
    }
    tri_inv64(sA + (wid >> 2) * 64 * TI_LD, sX + (wid >> 2) * 64 * TI_LD, sTm + (wid >> 2) * 8 * 16 * TI_TLD, wid & 3, lane, true);
    {
        const int dir = tid >> 8, i = (tid >> 2) & 63, c16 = (tid & 3) * 16;
        const float* xs = sX + dir * 64 * TI_LD + i * TI_LD + c16;
        bf16* ti = (bf16*)(p.ws + WS_TINV) + (((size_t)cg * 4 + h) * 2 + dir) * 4096 + i * 64 + c16;
        *(uint4*)ti = pack8v(*(const f8v*)xs); *(uint4*)(ti + 8) = pack8v(*(const f8v*)(xs + 8));
    }
}

constexpr int G_LDS = 136, G_LDT = 72;
__device__ __forceinline__ void gdn_scan_task(const P& p, int oi, int s, int h, int dir, unsigned char* dsm) {
    bf16* St = (bf16*)dsm;
    bf16* Kc = St + 128 * G_LDS;
    bf16* Qc = Kc + 64 * G_LDS;
    bf16* KeT = Qc + 64 * G_LDS;
    bf16* rT = KeT + 128 * G_LDT;
    bf16* dT = rT + 128 * G_LDT;
    bf16* Vc = dT;
    bf16* Ti = dT + 128 * G_LDT;
    bf16* Qk = Ti + 64 * G_LDT;
    float* sgc = (float*)(Qk + 64 * G_LDT);
    float* sbt = sgc + 64;
    const Seq sq_ = get_seq(s);
    const int tid = opaque_tid(), lane = tid & 63, wid = tid >> 6, fr = lane & 15, fq = lane >> 4;
    const int rt = wid & 3, chf = wid >> 2;
    const bf16* qkvn = (const bf16*)(p.ws + WS_QKVN);
    const float* gates = (const float*)(p.ws + WS_GATES);
    bf16* opart = (bf16*)(p.ws + WS_PART + (size_t)dir * PART_SZ);
    f4v Sacc[8];
    LBAR();
    if (sq_.lat) {
        const float* s0 = p.in[I_SGDN] + ((((size_t)sq_.b * N_ODD + oi) * 2 + dir) * 4 + h) * 128 * 128;
#pragma unroll
        for (int ct = 0; ct < 8; ++ct)
#pragma unroll
            for (int r = 0; r < 4; ++r) Sacc[ct][r] = s0[(16 * wid + fq * 4 + r) * 128 + 16 * ct + fr];
    } else {
#pragma unroll
        for (int ct = 0; ct < 8; ++ct) Sacc[ct] = (f4v){0.f, 0.f, 0.f, 0.f};
    }
#pragma unroll
    for (int ct = 0; ct < 8; ++ct) *(uint2*)(St + (16 * ct + fr) * G_LDS + 16 * wid + fq * 4) = make_uint2(pack2(Sacc[ct][0], Sacc[ct][1]), pack2(Sacc[ct][2], Sacc[ct][3]));
    const int nch = sq_.len >> 6;
    uint4 pq0, pq1, pk0, pk1, pw0, pw1, pti, pqk; float pgi, pgl, pbt = 0.f;
#define GDN_FETCH(CG) do { const size_t task_ = ((size_t)(CG) * 4 + h) * 2 + dir; const int t_ = (CG) * 64 + (dir ? 63 - lane : lane); \
        const bf16* src_ = qkvn + (size_t)t_ * 1536 + h * 128 + wid * 8; \
        pq0 = *(const uint4*)src_; pq1 = *(const uint4*)(src_ + 64); pk0 = *(const uint4*)(src_ + 512); pk1 = *(const uint4*)(src_ + 576); pw0 = *(const uint4*)(src_ + 1024); pw1 = *(const uint4*)(src_ + 1088); \
        { const int i2_ = tid >> 3, c8_ = (tid & 7) * 8; pti = *(const uint4*)((const bf16*)(p.ws + WS_TINV) + task_ * 4096 + i2_ * 64 + c8_); pqk = *(const uint4*)((const bf16*)(p.ws + WS_QKM) + task_ * 4096 + i2_ * 64 + c8_); } \
        const float* gcp_ = (const float*)(p.ws + WS_GC) + task_ * 64; pgi = gcp_[lane]; pgl = gcp_[63]; \
        if (tid < 64) pbt = gates[(size_t)((CG) * 64 + (dir ? 63 - tid : tid)) * 16 + 8 + dir * 4 + h]; } while (0)
    GDN_FETCH((sq_.start >> 6) + (dir ? nch - 1 : 0));
    for (int cc = 0; cc < nch; ++cc) {
        const int cl = dir ? nch - 1 - cc : cc;
        const int cg = (sq_.start >> 6) + cl;
        {
            const int i = lane;
            const float sc = fexp(pgl - pgi);
#pragma unroll
            for (int rep = 0; rep < 2; ++rep) {
                const int c8 = (wid + 8 * rep) * 8;
                const uint4 qv = rep ? pq1 : pq0, kv = rep ? pk1 : pk0, vv = rep ? pw1 : pw0;
                *(uint4*)(Qc + i * G_LDS + c8) = qv; *(uint4*)(Kc + i * G_LDS + c8) = kv; *(uint4*)(Vc + i * G_LDS + c8) = vv;
                const f8v kf = unpack8v(kv);
#pragma unroll
                for (int j = 0; j < 8; ++j) KeT[(c8 + j) * G_LDT + i] = f2bf(kf[j] * sc);
            }
            { const int i2 = tid >> 3, c8 = (tid & 7) * 8; *(uint4*)(Ti + i2 * G_LDT + c8) = pti; *(uint4*)(Qk + i2 * G_LDT + c8) = pqk; }
            if (tid < 64) { sgc[tid] = pgi; sbt[tid] = pbt; }
            if (cc + 1 < nch) { const int cln = dir ? nch - 2 - cc : cc + 1; GDN_FETCH((sq_.start >> 6) + cln); }
        }
        LBAR();
        f4v oacc[4];
        {
            f4v kS[4], qS[4];
#pragma unroll
            for (int ct = 0; ct < 4; ++ct) { kS[ct] = (f4v){0.f, 0.f, 0.f, 0.f}; qS[ct] = (f4v){0.f, 0.f, 0.f, 0.f}; }
#pragma unroll
            for (int ks = 0; ks < 4; ++ks) {
                const s8v ak = *(const s8v*)(Kc + (16 * rt + fr) * G_LDS + ks * 32 + fq * 8);
                const s8v aq = *(const s8v*)(Qc + (16 * rt + fr) * G_LDS + ks * 32 + fq * 8);
#pragma unroll
                for (int ct = 0; ct < 4; ++ct) {
                    const s8v bb = *(const s8v*)(St + (64 * chf + 16 * ct + fr) * G_LDS + ks * 32 + fq * 8);
                    kS[ct] = mfma16(ak, bb, kS[ct]);
                    qS[ct] = mfma16(bb, aq, qS[ct]);
                }
            }
            float eg[4], bt[4];
#pragma unroll
            for (int r = 0; r < 4; ++r) { const int i = 16 * rt + fq * 4 + r; eg[r] = fexp(sgc[i]); bt[r] = sbt[i]; }
            const float egc = fexp(sgc[16 * rt + fr]);
#pragma unroll
            for (int ct = 0; ct < 4; ++ct) {
                const int dv = 64 * chf + 16 * ct + fr;
                float rv[4];
#pragma unroll
                for (int r = 0; r < 4; ++r) { const int i = 16 * rt + fq * 4 + r; rv[r] = bt[r] * (bf2f(Vc[i * G_LDS + dv]) - eg[r] * kS[ct][r]); oacc[ct][r] = egc * qS[ct][r]; }
                *(uint2*)(rT + dv * G_LDT + 16 * rt + fq * 4) = make_uint2(pack2(rv[0], rv[1]), pack2(rv[2], rv[3]));
            }
        }
        LBAR();
        {
            f4v dl[4];
#pragma unroll
            for (int ct = 0; ct < 4; ++ct) dl[ct] = (f4v){0.f, 0.f, 0.f, 0.f};
#pragma unroll
            for (int ks = 0; ks < 2; ++ks) {
                const s8v a = *(const s8v*)(Ti + (16 * rt + fr) * G_LDT + ks * 32 + fq * 8);
#pragma unroll
                for (int ct = 0; ct < 4; ++ct) { const s8v bb = *(const s8v*)(rT + (64 * chf + 16 * ct + fr) * G_LDT + ks * 32 + fq * 8); dl[ct] = mfma16(a, bb, dl[ct]); }
            }
#pragma unroll
            for (int ct = 0; ct < 4; ++ct) { const int dv = 64 * chf + 16 * ct + fr;
                *(uint2*)(dT + dv * G_LDT + 16 * rt + fq * 4) = make_uint2(pack2(dl[ct][0], dl[ct][1]), pack2(dl[ct][2], dl[ct][3])); }
        }
        LBAR();
        {
#pragma unroll
            for (int ks = 0; ks < 2; ++ks) {
                const s8v a = *(const s8v*)(Qk + (16 * rt + fr) * G_LDT + ks * 32 + fq * 8);
#pragma unroll
                for (int ct = 0; ct < 4; ++ct) { const s8v bb = *(const s8v*)(dT + (64 * chf + 16 * ct + fr) * G_LDT + ks * 32 + fq * 8); oacc[ct] = mfma16(bb, a, oacc[ct]); }
            }
            {
                const int i = 16 * rt + fr, t = cg * 64 + (dir ? 63 - i : i);
#pragma unroll
                for (int ct = 0; ct < 4; ++ct) *(uint2*)(opart + (size_t)t * 512 + h * 128 + 64 * chf + 16 * ct + fq * 4) = pack4(oacc[ct]);
            }
            const float ge = fexp(sgc[63]);
#pragma unroll
            for (int ct = 0; ct < 8; ++ct) Sacc[ct] *= ge;
#pragma unroll
            for (int ks = 0; ks < 2; ++ks) {
                const s8v a = *(const s8v*)(KeT + (16 * wid + fr) * G_LDT + ks * 32 + fq * 8);
#pragma unroll
                for (int ct = 0; ct < 8; ++ct) { const s8v bb = *(const s8v*)(dT + (16 * ct + fr) * G_LDT + ks * 32 + fq * 8); Sacc[ct] = mfma16(a, bb, Sacc[ct]); }
            }
#pragma unroll
            for (int ct = 0; ct < 8; ++ct) *(uint2*)(St + (16 * ct + fr) * G_LDS + 16 * wid + fq * 4) = make_uint2(pack2(Sacc[ct][0], Sacc[ct][1]), pack2(Sacc[ct][2], Sacc[ct][3]));
        }
        LBAR();
    }
    if (!sq_.lat) {
        float* fs = p.out + OUT_GDN + ((((size_t)sq_.b * N_ODD + oi) * 2 + dir) * 4 + h) * 128 * 128;
#pragma unroll
        for (int ct = 0; ct < 8; ++ct)
#pragma unroll
            for (int r = 0; r < 4; ++r) fs[(16 * wid + fq * 4 + r) * 128 + 16 * ct + fr] = Sacc[ct][r];
    }
}
constexpr int S5_HLD = 136;
constexpr int S5_ITEMS = 2 * 32 * 2;
__device__ __forceinline__ void s5_task(const P& p, int oi, int dir, int g, int set, unsigned char* dsm) {
    float* sPr = (float*)dsm;
    float* sPi = sPr + 17 * 64;
    float* sBr = sPi + 17 * 64;
    float* sBi = sBr + 1024;
    float* sCr = sBi + 1024;
    float* sCi = sCr + 16 * 65;
    bf16* sK = (bf16*)(sCi + 16 * 65 + 16);
    bf16* HT = sK + 4096;
    bf16* sG = HT + 2 * 16 * S5_HLD;
    bf16* UT = sG + 256 * S5_HLD;
    const int tid = opaque_tid(), lane = tid & 63, wid = tid >> 6, fr = lane & 15, fq = lane >> 4;
    const int nseq = set ? NB_CTX : NB_LAT, sbase = set ? 0 : NB_CTX, len = set ? L_CTX : L_LAT;
    const bf16* proj = (const bf16*)(p.ws + WS_PROJ);
    bf16* ypart = (bf16*)(p.ws + WS_PART + (size_t)(2 + dir) * PART_SZ);
    const size_t pg = ((size_t)(oi * 2 + dir) * 32 + g);
    LBAR();
    if (tid < 64) {
        const float are = fminf(p.in[I_S5AR][pg * 64 + tid], -1e-4f), aim = p.in[I_S5AI][pg * 64 + tid];
        const float dt = expf(p.in[I_S5DT][pg]);
        const float mag = expf(are * dt), ar = mag * cosf(aim * dt), ai = mag * sinf(aim * dt);
        float pr = 1.f, pi = 0.f;
        for (int j = 0; j <= 16; ++j) { sPr[j * 64 + tid] = pr; sPi[j * 64 + tid] = pi; const float nr = pr * ar - pi * ai, ni = pr * ai + pi * ar; pr = nr; pi = ni; }
    }
    {
        const int st = tid >> 3, c0 = (tid & 7) * 2;
        const float are = fminf(p.in[I_S5AR][pg * 64 + st], -1e-4f), aim = p.in[I_S5AI][pg * 64 + st];
        const float dt = expf(p.in[I_S5DT][pg]);
        const float mag = expf(are * dt), ar = mag * cosf(aim * dt), ai = mag * sinf(aim * dt);
        const float den = are * are + aim * aim;
        const float fre = ((ar - 1.0f) * are + ai * aim) / den, fim = (ai * are - (ar - 1.0f) * aim) / den;
#pragma unroll
        for (int c = 0; c < 2; ++c) {
            const float br = p.in[I_S5BR][(pg * 64 + st) * 16 + c0 + c], bi = p.in[I_S5BI][(pg * 64 + st) * 16 + c0 + c];
            sBr[st * 16 + c0 + c] = fre * br - fim * bi; sBi[st * 16 + c0 + c] = fre * bi + fim * br;
        }
        for (int e = tid; e < 1024; e += 512) { sCr[(e >> 6) * 65 + (e & 63)] = p.in[I_S5CR][pg * 1024 + e]; sCi[(e >> 6) * 65 + (e & 63)] = p.in[I_S5CI][pg * 1024 + e]; }
    }
    LBAR();
    {
        const int lag = tid >> 5, co = (tid >> 1) & 15, c8 = (tid & 1) * 8;
        f8v acc = (f8v)(0.f);
        for (int q = 0; q < 64; ++q) {
            const float cr = sCr[co * 65 + q], ci = sCi[co * 65 + q], pr = sPr[lag * 64 + q], pi = sPi[lag * 64 + q];
            const float mr = cr * pr - ci * pi, mi = cr * pi + ci * pr;
            const f8v br = *(const f8v*)(sBr + q * 16 + c8), bi = *(const f8v*)(sBi + q * 16 + c8);
            acc += mr * br - mi * bi;
        }
        *(uint4*)(sK + (lag * 16 + co) * 16 + c8) = pack8v(acc);
    }
    {
        const int row = tid >> 1, tt = row >> 4, co = row & 15, half = tid & 1;
        for (int q0 = 0; q0 < 64; q0 += 8) {
            f8v v;
#pragma unroll
            for (int j = 0; j < 8; ++j) { const int q = q0 + j; const float cr = sCr[co * 65 + q], ci = sCi[co * 65 + q], pr = sPr[(tt + 1) * 64 + q], pi = sPi[(tt + 1) * 64 + q]; v[j] = half ? -(cr * pi + ci * pr) : cr * pr - ci * pi; }
            *(uint4*)(sG + row * S5_HLD + half * 64 + q0) = pack8v(v);
        }
    }
    LBAR();
    const int sp = fq >> 1, cih = (fq & 1) * 8;
    const int nsteps = len >> 4;
    constexpr int S5_ULD = 264;
    const int un = (tid & 255) >> 4, us = tid & 15;
    const bf16* ubase = proj + (size_t)get_seq(sbase + (un < nseq ? un : 0)).start * OW + O_U + g * 16;
#define S5_UADDR(K) (ubase + (size_t)(dir ? len - 1 - (16 * (K) + us) : 16 * (K) + us) * OW)
#define S5_UPUT(K, QA, QB) do { bf16* d_ = UT + ((K) & 1) * 16 * S5_ULD + un * S5_ULD + us * 16; *(uint4*)d_ = QA; *(uint4*)(d_ + 8) = QB; } while (0)
#define S5_ULOAD(K) const bf16* up_ = UT + ((K) & 1) * 16 * S5_ULD + fr * S5_ULD + 8 * fq; \
        const s8v u0 = *(const s8v*)up_, u1 = *(const s8v*)(up_ + 32), u2 = *(const s8v*)(up_ + 64), u3 = *(const s8v*)(up_ + 96), \
                  u4 = *(const s8v*)(up_ + 128), u5 = *(const s8v*)(up_ + 160), u6 = *(const s8v*)(up_ + 192), u7 = *(const s8v*)(up_ + 224)
    if (wid < 4) {
        s8v wre[8], wim[8];
        {
            const int pp = 16 * wid + fr;
#pragma unroll
            for (int m = 0; m < 8; ++m) {
                const int sidx = 15 - (2 * m + sp);
                const float pr = sPr[sidx * 64 + pp], pi = sPi[sidx * 64 + pp];
#pragma unroll
                for (int j = 0; j < 8; ++j) {
                    const float br = sBr[pp * 16 + cih + j], bi = sBi[pp * 16 + cih + j];
                    wre[m][j] = (short)f2bf(pr * br - pi * bi); wim[m][j] = (short)f2bf(pr * bi + pi * br);
                }
            }
        }
        float a16r[4], a16i[4], hr[4], hi[4];
#pragma unroll
        for (int r = 0; r < 4; ++r) {
            const int pp = 16 * wid + fq * 4 + r;
            a16r[r] = sPr[16 * 64 + pp]; a16i[r] = sPi[16 * 64 + pp];
            hr[r] = 0.f; hi[r] = 0.f;
            if (set == 0 && fr < nseq) { const size_t o = (((size_t)fr * N_ODD + oi) * 2 + dir) * 32 * 64 + g * 64 + pp; hr[r] = p.in[I_SS5R][o]; hi[r] = p.in[I_SS5I][o]; }
        }
        *(uint2*)(HT + fr * S5_HLD + 16 * wid + fq * 4) = make_uint2(pack2(hr[0], hr[1]), pack2(hr[2], hr[3]));
        *(uint2*)(HT + fr * S5_HLD + 64 + 16 * wid + fq * 4) = make_uint2(pack2(hi[0], hi[1]), pack2(hi[2], hi[3]));
        uint4 qa0, qb0, qa1, qb1, qa2, qb2, qa3, qb3;
        { const bf16* a_ = S5_UADDR(0); qa0 = *(const uint4*)a_; qb0 = *(const uint4*)(a_ + 8); S5_UPUT(0, qa0, qb0); }
#define S5_QLOAD(K, QA, QB) do { if ((K) < nsteps) { const bf16* a_ = S5_UADDR(K); QA = *(const uint4*)a_; QB = *(const uint4*)(a_ + 8); } } while (0)
        S5_QLOAD(1, qa1, qb1); S5_QLOAD(2, qa2, qb2); S5_QLOAD(3, qa3, qb3); S5_QLOAD(4, qa0, qb0);
        LBAR();
#define S5_STATE_STEP(K, QA, QB) do { \
            const int k = (K); \
            S5_ULOAD(k); \
            if (k + 1 < nsteps) { S5_UPUT(k + 1, QA, QB); S5_QLOAD(k + 5, QA, QB); } \
            f4v zr = (f4v){0.f, 0.f, 0.f, 0.f}, zi = zr; \
            zr = mfma16(wre[0], u0, zr); zi = mfma16(wim[0], u0, zi); zr = mfma16(wre[1], u1, zr); zi = mfma16(wim[1], u1, zi); \
            zr = mfma16(wre[2], u2, zr); zi = mfma16(wim[2], u2, zi); zr = mfma16(wre[3], u3, zr); zi = mfma16(wim[3], u3, zi); \
            zr = mfma16(wre[4], u4, zr); zi = mfma16(wim[4], u4, zi); zr = mfma16(wre[5], u5, zr); zi = mfma16(wim[5], u5, zi); \
            zr = mfma16(wre[6], u6, zr); zi = mfma16(wim[6], u6, zi); zr = mfma16(wre[7], u7, zr); zi = mfma16(wim[7], u7, zi); \
            _Pragma("unroll") for (int r = 0; r < 4; ++r) { const float nr = a16r[r] * hr[r] - a16i[r] * hi[r] + zr[r], ni = a16r[r] * hi[r] + a16i[r] * hr[r] + zi[r]; hr[r] = nr; hi[r] = ni; } \
            bf16* hb = HT + ((k + 1) & 1) * 16 * S5_HLD; \
            *(uint2*)(hb + fr * S5_HLD + 16 * wid + fq * 4) = make_uint2(pack2(hr[0], hr[1]), pack2(hr[2], hr[3])); \
            *(uint2*)(hb + fr * S5_HLD + 64 + 16 * wid + fq * 4) = make_uint2(pack2(hi[0], hi[1]), pack2(hi[2], hi[3])); \
            LBAR(); } while (0)
        for (int k4 = 0; k4 < nsteps; k4 += 4) {
            S5_STATE_STEP(k4, qa1, qb1); S5_STATE_STEP(k4 + 1, qa2, qb2); S5_STATE_STEP(k4 + 2, qa3, qb3); S5_STATE_STEP(k4 + 3, qa0, qb0);
        }
        if (set == 1 && fr < nseq) {
#pragma unroll
            for (int r = 0; r < 4; ++r) { const size_t o = (((size_t)fr * N_ODD + oi) * 2 + dir) * 32 * 64 + g * 64 + 16 * wid + fq * 4 + r; p.out[OUT_S5R + o] = hr[r]; p.out[OUT_S5I + o] = hi[r]; }
        }
    } else {
        const int t0 = 4 * (RFL(wid) - 4);
        s8v klr[18];
#pragma unroll
        for (int e = 0; e < 18; ++e) { const int lg = t0 + 3 - e - sp; klr[e] = (lg >= 0) ? *(const s8v*)(sK + (lg * 16 + fr) * 16 + cih) : (s8v){0, 0, 0, 0, 0, 0, 0, 0}; }
        LBAR();
        for (int k = 0; k < nsteps; ++k) {
            S5_ULOAD(k);
            const bf16* hb = HT + (k & 1) * 16 * S5_HLD + fr * S5_HLD + 8 * fq;
            const s8v h0 = *(const s8v*)hb, h1 = *(const s8v*)(hb + 32), h2 = *(const s8v*)(hb + 64), h3 = *(const s8v*)(hb + 96);
            f4v y0 = (f4v){0.f, 0.f, 0.f, 0.f}, y1 = y0, y2 = y0, y3 = y0;
            {
                const bf16* gp = sG + (t0 * 16 + fr) * S5_HLD + 8 * fq;
#define S5_G4(KS, H) do { y0 = mfma16(*(const s8v*)(gp + 32 * (KS)), H, y0); y1 = mfma16(*(const s8v*)(gp + 16 * S5_HLD + 32 * (KS)), H, y1); \
                          y2 = mfma16(*(const s8v*)(gp + 32 * S5_HLD + 32 * (KS)), H, y2); y3 = mfma16(*(const s8v*)(gp + 48 * S5_HLD + 32 * (KS)), H, y3); } while (0)
                S5_G4(0, h0); S5_G4(1, h1); S5_G4(2, h2); S5_G4(3, h3);
#define S5_K4(M, U) do { if (2 * (M) <= t0 + 0) y0 = mfma16(klr[3 + 2 * (M)], U, y0); if (2 * (M) <= t0 + 1) y1 = mfma16(klr[2 + 2 * (M)], U, y1); \
                         if (2 * (M) <= t0 + 2) y2 = mfma16(klr[1 + 2 * (M)], U, y2); if (2 * (M) <= t0 + 3) y3 = mfma16(klr[0 + 2 * (M)], U, y3); } while (0)
                S5_K4(0, u0); S5_K4(1, u1); S5_K4(2, u2); S5_K4(3, u3); S5_K4(4, u4); S5_K4(5, u5); S5_K4(6, u6); S5_K4(7, u7);
            }
            if (fr < nseq) {
                const int tb_ = get_seq(sbase + fr).start;
#define S5_ST(TT, Y) do { const int pos = 16 * k + t0 + (TT), tok = tb_ + (dir ? len - 1 - pos : pos); *(uint2*)(ypart + (size_t)tok * 512 + g * 16 + fq * 4) = pack4(Y); } while (0)
                S5_ST(0, y0); S5_ST(1, y1); S5_ST(2, y2); S5_ST(3, y3);
            }
            LBAR();
        }
    }
}
constexpr int ODD_GDN_ITEMS = NSEQ * 8;
constexpr int ODD_SCAN_ITEMS = ODD_GDN_ITEMS + S5_ITEMS;
__device__ __forceinline__ void ph_odd_scan_item(const P& p, int w, int oi, float* smem_full) {
    unsigned char* dsm = (unsigned char*)smem_full;
    const int nlg = NB_LAT * 8, ncg = NB_CTX * 8;
    if (w < ncg) { gdn_scan_task(p, oi, w / 8, (w % 8) >> 1, w & 1, dsm); return; }
    w -= ncg;
    if (w < 64) { __syncthreads(); s5_task(p, oi, w >> 5, w & 31, 0, dsm); return; }
    w -= 64;
    if (w < nlg) { gdn_scan_task(p, oi, NB_CTX + w / 8, (w % 8) >> 1, w & 1, dsm); return; }
    w -= nlg;
    __syncthreads(); s5_task(p, oi, w >> 5, w & 31, 1, dsm);
}
__device__ __forceinline__ void ph_fin_odd_a(const P& p, int bid, int oi) {
    const int lane = LT & 63, tb = bid * (4 * NTW) + (LT >> 6) * NTW;
    if (tb >= T) return;
    const int idx = lane * 8;
    uint4 vof[NTW], vob[NTW], vyf[NTW], vyb[NTW], vzc[NTW], vu[NTW];
#pragma unroll
    for (int u = 0; u < NTW; ++u) {
        const size_t t = (size_t)((tb + u < T) ? tb + u : T - 1);
        const bf16* pr = (const bf16*)(p.ws + WS_PROJ) + t * OW;
        vof[u] = *(const uint4*)((const bf16*)(p.ws + WS_PART) + t * 512 + idx);
        vob[u] = *(const uint4*)((const bf16*)(p.ws + WS_PART + PART_SZ) + t * 512 + idx);
        vyf[u] = *(const uint4*)((const bf16*)(p.ws + WS_PART + 2 * PART_SZ) + t * 512 + idx);
        vyb[u] = *(const uint4*)((const bf16*)(p.ws + WS_PART + 3 * PART_SZ) + t * 512 + idx);
        vzc[u] = *(const uint4*)(pr + O_ZC + idx);
        vu[u] = *(const uint4*)(pr + O_U + idx);
    }
    const f8v gn = *(const f8v*)(p.in[I_GDNN] + oi * 128 + (idx & 127));
    const f8v dsk = *(const f8v*)(p.in[I_S5D] + oi * 512 + idx);
#pragma unroll
    for (int u = 0; u < NTW; ++u) {
        const size_t t = (size_t)(tb + u); if (tb + u >= T) break;
        f8v o = unpack8v(vof[u]) + unpack8v(vob[u]);
        float ss = 0.f;
#pragma unroll
        for (int j = 0; j < 8; ++j) ss += o[j] * o[j];
        ss = red16(ss);
        const float r = frsq(ss * (1.0f / 128.f) + EPS);
        const f8v zc = unpack8v(vzc[u]);
        f8v y = unpack8v(vyf[u]) + unpack8v(vyb[u]) + dsk * unpack8v(vu[u]);
#pragma unroll
        for (int j = 0; j < 8; ++j) { o[j] = o[j] * r * gn[j] * siluf_(zc[j]); y[j] = gelu_tanh(y[j]); }
        *(uint4*)((bf16*)(p.ws + WS_HM) + t * D + idx) = pack8v(o);
        *(uint4*)((bf16*)(p.ws + WS_PART + 2 * PART_SZ) + t * 512 + idx) = pack8v(y);
    }
}
__device__ __forceinline__ void ph_fin_odd_b(const P& p, int bid, int oi) {
    const size_t e = ((size_t)bid * 256 + LT) * 4;
    if (e >= (size_t)T * 512) return;
    const int t = (int)(e >> 9), idx = (int)(e & 511);
    const bf16* pr = (const bf16*)(p.ws + WS_PROJ) + (size_t)t * OW;
    const bf16* gl = (const bf16*)(p.ws + WS_PART + 2 * PART_SZ) + (size_t)t * 512;
    bf16* yc = (bf16*)(p.ws + WS_HM) + (size_t)t * D + 512;
#pragma unroll
    for (int j = 0; j < 4; ++j) {
        const float ys = bf2f(yc[idx + j]);
        yc[idx + j] = f2bf(ys * sigmoidf_(bf2f(gl[idx + j]) + p.in[I_GLUB][oi * 512 + idx + j]) * siluf_(bf2f(pr[O_ZD + idx + j])));
    }
}

enum { PK_PREP0, PK_HMOD0, PK_GEMM_IN, PK_EVEN_SCAN, PK_FIN_EVEN, PK_ODD_PREP, PK_ODD_SCAN, PK_FIN_ODD_A, PK_GEMM_GLU, PK_FIN_ODD_B, PK_GEMM_OUT, PK_POST, PK_RWKV_PREP0, PK_RWKV_PREP1, PK_EVEN_SCAN1 };
constexpr int NPH = 2 + (DEPTH / 2) * 14;
constexpr int TOKB = (T + 3) / 4;
static_assert(DEPTH % 2 == 0, "even depth expected");
__host__ __device__ inline void phase_desc(int ph, int& kind, int& layer) {
    if (ph == 0) { kind = PK_PREP0; layer = 0; return; }
    if (ph == 1) { kind = PK_HMOD0; layer = 0; return; }
    ph -= 2;
    const int pair = ph / 14, r = ph % 14;
    if (r < 7) { layer = 2 * pair; kind = r == 0 ? PK_GEMM_IN : r == 1 ? PK_RWKV_PREP0 : r == 2 ? PK_EVEN_SCAN : r == 3 ? PK_RWKV_PREP1 : r == 4 ? PK_EVEN_SCAN1 : r == 5 ? PK_GEMM_OUT : PK_POST; }
    else { const int q = r - 7; layer = 2 * pair + 1; kind = q == 0 ? PK_GEMM_IN : q == 1 ? PK_ODD_PREP : q == 2 ? PK_ODD_SCAN : q == 3 ? PK_FIN_ODD_A : q == 4 ? PK_GEMM_GLU : q == 5 ? PK_GEMM_OUT : PK_POST; }
}
__host__ __device__ inline bool phase_is_gemm(int kind) { return kind == PK_GEMM_IN || kind == PK_GEMM_GLU || kind == PK_GEMM_OUT; }
__host__ __device__ inline int phase_nblk(int kind, int layer) {
    switch (kind) {
        case PK_PREP0: return MOD_VB + WT_TILES;
        case PK_FIN_ODD_B: return (T * 512 / 4 + 255) / 256;
        default: return (T + 4 * NTW - 1) / (4 * NTW);
    }
}
__device__ __forceinline__ void do_phase(const P& p, int kind, int layer, int vb, float* smem) {
    const int i = layer >> 1;
    switch (kind) {
        case PK_PREP0: if (vb < MOD_VB) ph_mod(p, vb, smem); else ph_wt(p, vb - MOD_VB, smem); break;
        case PK_HMOD0: ph_hmod0(p, vb); break;
        case PK_FIN_EVEN: ph_fin_even(p, vb, i); break;
        case PK_FIN_ODD_A: ph_fin_odd_a(p, vb, i); break;
        case PK_FIN_ODD_B: ph_fin_odd_b(p, vb, i); break;
        case PK_POST: ph_post(p, vb, layer); break;
    }
}
__device__ __forceinline__ void do_gemm(const P& p, int kind, int layer, int G, int c, unsigned char* dsm) {
    const int i = layer >> 1;
    const bf16* hm = (const bf16*)(p.ws + WS_HM);
    pg8::StaticOrder S;
    LDS_AS unsigned char* lds = (LDS_AS unsigned char*)dsm;
    if (kind == PK_GEMM_IN) {
        if ((layer & 1) == 0) { pg8::Gemm g{hm, (const bf16*)(p.ws + WS_WTE) + (size_t)i * EWP * D, T, EWP, D, D}; S.init(T, EWP, G, c); pg8::EpiBf16 E{(bf16*)(p.ws + WS_PROJ), EW, EW}; pg8::gemm_phase(lds, g, S, E); }
        else { pg8::Gemm g{hm, (const bf16*)(p.ws + WS_WTO) + (size_t)i * OWP * D, T, OWP, D, D}; S.init(T, OWP, G, c); pg8::EpiBf16 E{(bf16*)(p.ws + WS_PROJ), OW, OW}; pg8::gemm_phase(lds, g, S, E); }
    } else if (kind == PK_GEMM_GLU) {
        const bf16* ysb = (const bf16*)(p.ws + WS_PART + 2 * PART_SZ);
        pg8::Gemm g{ysb, (const bf16*)(p.ws + WS_WTGLU) + (size_t)i * 512 * 512, T, 512, 512, 512}; S.init(T, 512, G, c);
        pg8::EpiGlu E{(bf16*)(p.ws + WS_HM) + 512, ysb, (const bf16*)(p.ws + WS_PROJ) + O_ZD, p.in[I_GLUB] + i * 512}; pg8::gemm_phase(lds, g, S, E);
    } else {
        const bf16* ya = (layer & 1) ? hm : (const bf16*)(p.ws + WS_YCE);
        pg8::Gemm g{ya, (const bf16*)(p.ws + WS_WTOUT) + (size_t)layer * D * D, T, D, D, D}; S.init(T, D, G, c); pg8::EpiBf16 E{(bf16*)(p.ws + WS_PROJ), D, D}; pg8::gemm_phase(lds, g, S, E);
    }
}
constexpr int LDS_BYTES = 163840;
constexpr bool EVEN_FUSED_SCHED = (NB_LAT == 8 && NB_CTX == 16 && L_CTX == 256 && L_LAT == 1024);
#ifndef REP_SCAN
#define REP_SCAN 1
#endif
#ifndef REP_GEMM
#define REP_GEMM 1
#endif

#ifdef CPU_EMU
__global__ void k_phase(P p, int kind, int layer, int nb) {
    __shared__ __attribute__((aligned(16))) unsigned char dsm[LDS_BYTES];
    if (phase_is_gemm(kind)) { do_gemm(p, kind, layer, gridDim.x, blockIdx.x, dsm); return; }
    if (kind == PK_ODD_SCAN) { ph_odd_scan_item(p, blockIdx.x, layer >> 1, (float*)dsm); return; }
    if (kind == PK_ODD_PREP) { ph_odd_prep(p, blockIdx.x, layer >> 1, dsm); return; }
    if (kind == PK_EVEN_SCAN || kind == PK_EVEN_SCAN1) { ph_even_scan_item(p, blockIdx.x, layer >> 1, kind == PK_EVEN_SCAN1, dsm); return; }
    if (kind == PK_RWKV_PREP0 || kind == PK_RWKV_PREP1) { rwkv_prep_phase(p, layer >> 1, kind == PK_RWKV_PREP1, blockIdx.x, gridDim.x, RWKV_PREP_ITEMS, dsm); return; }
    const int half = threadIdx.x >> 8, vb = 2 * blockIdx.x + half;
    if (vb < nb) do_phase(p, kind, layer, vb, (float*)dsm + half * 16384);
}
void emu_hook(const char* stage, int layer, const P& p);
extern "C" void kernel_launch(void* const* d_in, const int* in_sizes, int n_in, void* d_out, int out_size, void* d_ws, size_t ws_size, hipStream_t stream) {
    P p{};
    for (int i = 0; i < 44; ++i) p.in[i] = (const float*)d_in[i];
    p.out = (float*)d_out; p.ws = (char*)d_ws;
    static const char* names[] = {"prep0", "hmod", "proj", "even_scan0", "ycat", "odd_prep", "odd_scan", "fin_odd_a", "ycat", "ycat", "outproj", "post", "rwkv_prep0", "rwkv_prep1", "even_scan"};
    for (int ph = 0; ph < NPH; ++ph) {
        int kind, layer; phase_desc(ph, kind, layer);
        const int nb = phase_nblk(kind, layer);
        EMU_LAUNCH(k_phase, phase_is_gemm(kind) ? 3 : kind == PK_ODD_SCAN ? ODD_SCAN_ITEMS : (kind == PK_EVEN_SCAN || kind == PK_EVEN_SCAN1) ? EVEN_SCAN_ITEMS : (kind == PK_RWKV_PREP0 || kind == PK_RWKV_PREP1) ? RWKV_PREP_ITEMS : kind == PK_ODD_PREP ? ODD_PREP_ITEMS : (nb + 1) / 2, 512, p, kind, layer, nb);
        emu_hook(names[kind], layer, p);
    }
}
#else

#define XB_TMO      128
#define XB_XCNT(j)  (256  + 64 * (j))
#define XB_XSUB(j)  (1280 + 64 * (j))
#define XB_XGEN(j)  (2304 + 64 * (j))
#define XB_TOP      3328
#define XB_TOPGEN   3392
#define XCD_BAR_WORDS 3456
#define XB_SPIN_CAP (1u << 18)
__device__ __forceinline__ unsigned xb_ld(unsigned* p)              { return __hip_atomic_load(p, __ATOMIC_RELAXED, __HIP_MEMORY_SCOPE_AGENT); }
__device__ __forceinline__ unsigned xb_add(unsigned* p, unsigned v) { return __hip_atomic_fetch_add(p, v, __ATOMIC_RELAXED, __HIP_MEMORY_SCOPE_AGENT); }
__device__ __forceinline__ unsigned xb_xcc_id() { return (unsigned)__builtin_amdgcn_s_getreg((3 << 11) | 20) & 0xFu; }
#define XB_SPIN(cond, bar) do { unsigned _sp = 0; while (cond) { __builtin_amdgcn_s_sleep(1); \
    if ((++_sp & 255u) == 0u) { if (xb_ld(&(bar)[XB_TMO])) break; if (_sp > XB_SPIN_CAP) { atomicAdd(&(bar)[XB_TMO], 1u); break; } } } } while (0)
struct XcdBarrier { unsigned* bar; unsigned x; volatile LDS_AS unsigned* st; };
__device__ __forceinline__ XcdBarrier xcd_barrier_post(unsigned* bar, volatile LDS_AS unsigned* st) {
    XcdBarrier b; b.bar = bar; b.x = xb_xcc_id(); b.st = st;
    if (threadIdx.x == 0) (void)xb_add(&bar[XB_XCNT(b.x)], 1u);
    return b;
}
__device__ __forceinline__ void xcd_barrier_complete(unsigned* bar, unsigned x, unsigned& nloc, unsigned& nx) {
    const unsigned G = gridDim.x * gridDim.y * gridDim.z;
    unsigned sum, cnt, mine, sp = 0u;
    for (;;) {
        sum = 0u; cnt = 0u; mine = 0u;
#pragma unroll
        for (unsigned j = 0; j < 16; ++j) { const unsigned c = xb_ld(&bar[XB_XCNT(j)]); sum += c; cnt += (c > 0u) ? 1u : 0u; mine = (j == x) ? c : mine; }
        if (sum == G) break;
        __builtin_amdgcn_s_sleep(1);
        if ((++sp & 255u) == 0u) { if (xb_ld(&bar[XB_TMO])) break; if (sp > XB_SPIN_CAP) { atomicAdd(&bar[XB_TMO], 1u); break; } }
    }
    nloc = mine > 0u ? mine : 1u; nx = cnt > 0u ? cnt : 1u;
}
__device__ __forceinline__ void xcd_barrier(const XcdBarrier& b) {
    asm volatile("s_waitcnt vmcnt(0)" ::: "memory");
    __syncthreads();
    if (threadIdx.x == 0) {
        unsigned* bar = b.bar;
        __builtin_amdgcn_s_waitcnt(0);
        unsigned nloc = b.st[0], nx = b.st[1];
        if (nloc == 0u) { xcd_barrier_complete(bar, b.x, nloc, nx); b.st[0] = nloc; b.st[1] = nx; }
        const unsigned old = xb_add(&bar[XB_XSUB(b.x)], 1u);
        const unsigned gen = old / nloc;
        if (old + 1u == (gen + 1u) * nloc) {
            __builtin_amdgcn_fence(__ATOMIC_RELEASE, "agent");
            asm volatile("s_waitcnt vmcnt(0)" ::: "memory");
            const unsigned og = xb_add(&bar[XB_TOP], 1u);
            const unsigned tg = og / nx;
            if (og + 1u == (tg + 1u) * nx) xb_add(&bar[XB_TOPGEN], 1u);
            else XB_SPIN(xb_ld(&bar[XB_TOPGEN]) == tg, bar);
            __builtin_amdgcn_fence(__ATOMIC_ACQUIRE, "agent");
            xb_add(&bar[XB_XGEN(b.x)], 1u);
            asm volatile("s_waitcnt vmcnt(0)" ::: "memory");
        } else {
            XB_SPIN(xb_ld(&bar[XB_XGEN(b.x)]) == gen, bar);
            __builtin_amdgcn_fence(__ATOMIC_ACQUIRE, "agent");
            asm volatile("s_waitcnt vmcnt(0)" ::: "memory");
        }
    }
    __syncthreads();
}
extern __shared__ __attribute__((aligned(16))) unsigned char dsm[];
#define RUN_PHASE(KIND, LAYER) do { const int nb_ = phase_nblk(KIND, LAYER); const int half_ = opaque_tid() >> 8; \
    for (int b_ = blockIdx.x; 2 * b_ < nb_; b_ += gridDim.x) { const int vb_ = 2 * b_ + half_; if (vb_ < nb_) do_phase(p, KIND, LAYER, vb_, (float*)dsm + half_ * 16384); } } while (0)
#define RUN_GEMM(KIND, LAYER) do_gemm(p, KIND, LAYER, gridDim.x, blockIdx.x, dsm)
typedef const __attribute__((address_space(4))) P* KP;
__device__ __forceinline__ const P& phase_args(KP pk) { asm volatile("" : "+s"(pk)); return *(const P*)pk; }
__global__ void __launch_bounds__(512) mega(P p_unused) {
    const KP pk = (KP)__builtin_amdgcn_kernarg_segment_ptr();
    volatile LDS_AS unsigned* xst = (volatile LDS_AS unsigned*)(dsm + LDS_BYTES - 16);
    if (threadIdx.x == 0) { xst[0] = 0u; xst[1] = 0u; }
    __syncthreads();
    XcdBarrier xb;
    { const P& p = phase_args(pk); xb = xcd_barrier_post((unsigned*)(p.ws + WS_BAR), xst); }
#define GSYNC() do { const P& pb_ = phase_args(pk); XcdBarrier b_ = xb; b_.bar = (unsigned*)(pb_.ws + WS_BAR); xcd_barrier(b_); } while (0)
    { const P& p = phase_args(pk); RUN_PHASE(PK_PREP0, 0); } GSYNC();
    { const P& p = phase_args(pk); RUN_PHASE(PK_HMOD0, 0); } GSYNC();
#pragma nounroll
    for (int pair = 0; pair < DEPTH / 2; ++pair) {
        const int le = 2 * pair, lo = 2 * pair + 1;
        { const P& p = phase_args(pk); RUN_GEMM(PK_GEMM_IN, le); } GSYNC();
#pragma nounroll
        for (int dir_ = 0; dir_ < 2; ++dir_) {
            if (EVEN_FUSED_SCHED && gridDim.x == 256) {
                { const P& p = phase_args(pk); const int hg = blockIdx.x & 7, q = blockIdx.x >> 3;
                  int cg0, ncg;
                  if (q < 4) { const int x = hg * 4 + q; gla_scan_task(p, pair, NB_CTX + x / 4, x & 3, dir_, dsm); cg0 = q * 3; ncg = 3; }
                  else if (q < 12) { const int x = hg * 8 + (q - 4); gla_scan_task(p, pair, x / 4, x & 3, dir_, dsm); cg0 = 12 + (q - 4) * 5; ncg = 5; }
                  else { cg0 = 52 + (q - 12) * 7; ncg = 7; }
                  rwkv_prep_phase(p, pair, dir_, cg0 * 8 + hg, 8, (cg0 + ncg) * 8, dsm); } GSYNC();
                { const P& p = phase_args(pk); for (int w_ = blockIdx.x; w_ < EV_AP_LAT + EV_AP_CTX; w_ += gridDim.x) rwkv_apply_task(p, pair, w_ < EV_AP_LAT ? NB_CTX + w_ / 8 : (w_ - EV_AP_LAT) / 8, w_ & 7, dir_, dsm); } GSYNC();
            } else {
                { const P& p = phase_args(pk); rwkv_prep_phase(p, pair, dir_, blockIdx.x, gridDim.x, RWKV_PREP_ITEMS, dsm); } GSYNC();
                { const P& p = phase_args(pk); for (int w_ = blockIdx.x; w_ < EVEN_SCAN_ITEMS; w_ += gridDim.x) ph_even_scan_item(p, w_, pair, dir_, dsm); } GSYNC();
            }
        }
        { const P& p = phase_args(pk); RUN_GEMM(PK_GEMM_OUT, le); } GSYNC();
        { const P& p = phase_args(pk); RUN_PHASE(PK_POST, le); } GSYNC();
        { const P& p = phase_args(pk); RUN_GEMM(PK_GEMM_IN, lo); } GSYNC();
        { const P& p = phase_args(pk); for (int w_ = blockIdx.x; w_ < ODD_PREP_ITEMS; w_ += gridDim.x) ph_odd_prep(p, w_, pair, dsm); } GSYNC();
        { const P& p = phase_args(pk); for (int w_ = blockIdx.x; w_ < ODD_SCAN_ITEMS; w_ += gridDim.x) ph_odd_scan_item(p, w_, pair, (float*)dsm); } GSYNC();
        { const P& p = phase_args(pk); RUN_PHASE(PK_FIN_ODD_A, lo); } GSYNC();
        { const P& p = phase_args(pk); RUN_GEMM(PK_GEMM_GLU, lo); } GSYNC();
        { const P& p = phase_args(pk); RUN_GEMM(PK_GEMM_OUT, lo); } GSYNC();
        { const P& p = phase_args(pk); RUN_PHASE(PK_POST, lo); }
        if (pair + 1 < DEPTH / 2) GSYNC();
    }
}
extern "C" void kernel_launch(void* const* d_in, const int* in_sizes, int n_in, void* d_out, int out_size, void* d_ws, size_t ws_size, hipStream_t stream) {
    static int grid_blocks = 0;
    if (!grid_blocks) {
        int dev = 0, cus = 0, per_cu = 0;
        (void)hipGetDevice(&dev);
        (void)hipDeviceGetAttribute(&cus, hipDeviceAttributeMultiprocessorCount, dev);
        (void)hipFuncSetAttribute((const void*)mega, hipFuncAttributeMaxDynamicSharedMemorySize, LDS_BYTES);
        (void)hipOccupancyMaxActiveBlocksPerMultiprocessor(&per_cu, mega, 512, LDS_BYTES);
        if (per_cu < 1) fprintf(stderr, "occupancy query says %d blocks/CU\n", per_cu);
        grid_blocks = cus;
    }
    P p{};
    for (int i = 0; i < 44; ++i) p.in[i] = (const float*)d_in[i];
    p.out = (float*)d_out; p.ws = (char*)d_ws;
    (void)hipMemsetAsync((char*)d_ws + WS_BAR, 0, XCD_BAR_WORDS * 4, stream);
    hipLaunchKernelGGL(mega, dim3(grid_blocks), dim3(512), LDS_BYTES, stream, p);
    hipError_t e = hipPeekAtLastError();
    if (e != hipSuccess) fprintf(stderr, "launch failed: %s (grid %d)\n", hipGetErrorString(e), grid_blocks);
}
#endif
```

```cpp
#ifndef CPU_EMU
#include <hip/hip_runtime.h>
#include <hip/hip_cooperative_groups.h>
#include <cstdio>
namespace cg = cooperative_groups;
#endif
#include <stdint.h>

#ifndef CFG_BATCH
#define CFG_BATCH 16
#define CFG_SEQ 256
#define CFG_DEC_BATCH 8
#define CFG_DEC_SEQ 1024
#define CFG_DEPTH 4
#endif

typedef unsigned short bf16;
typedef short s8v __attribute__((ext_vector_type(8)));
typedef float f4v __attribute__((ext_vector_type(4)));

constexpr int D = 1024;
constexpr int NB_CTX = CFG_BATCH, L_CTX = CFG_SEQ, NB_LAT = CFG_DEC_BATCH, L_LAT = CFG_DEC_SEQ, DEPTH = CFG_DEPTH;
constexpr int N_EVEN = (DEPTH + 1) / 2, N_ODD = DEPTH / 2;
constexpr int T_CTX = NB_CTX * L_CTX, T_LAT = NB_LAT * L_LAT, T = T_CTX + T_LAT;
constexpr int NSEQ = NB_CTX + NB_LAT, NCOND = 1 + NB_LAT;
constexpr int EW = 3872, OW = 3088, EWP = 4096, OWP = 3328;
constexpr float EPS = 1e-6f;
constexpr int E_Q = 0, E_K = 256, E_V = 512, E_GD = 1024, E_ZA = 1056, E_FB = 1568, E_ZB = 3360;
constexpr int FB_R = 0, FB_K = 512, FB_V = 1024, FB_WD = 1536, FB_AD = 1664;
constexpr int O_QKV = 0, O_G = 1536, O_BETA = 1544, O_ZC = 1552, O_U = 2064, O_ZD = 2576;

constexpr size_t al(size_t x) { return (x + 255) & ~(size_t)255; }
constexpr size_t WS_MOD = 0;
constexpr size_t WS_WTE = WS_MOD + al((size_t)DEPTH * NCOND * 3072 * 4);
constexpr size_t WS_WTO = WS_WTE + al((size_t)N_EVEN * EWP * D * 2);
constexpr size_t WS_WTOUT = WS_WTO + al((size_t)(N_ODD ? N_ODD : 1) * OWP * D * 2);
constexpr size_t WS_WTGLU = WS_WTOUT + al((size_t)DEPTH * D * D * 2);
constexpr size_t WS_HM = WS_WTGLU + al((size_t)(N_ODD ? N_ODD : 1) * 512 * 512 * 2);
constexpr size_t WS_PROJ = WS_HM + al((size_t)T * D * 2);
constexpr size_t WS_PART = WS_PROJ + al((size_t)T * EW * 2);
constexpr size_t PART_SZ = al((size_t)T * 512 * 2);
constexpr size_t WS_YCE = WS_PART + 2 * PART_SZ;
constexpr size_t WS_BONUS = WS_PART + 4 * PART_SZ;
constexpr size_t WS_QKVN = WS_BONUS + al((size_t)T * 16 * 4);
constexpr size_t WS_GATES = WS_QKVN + al((size_t)T * 1536 * 2);
constexpr size_t WS_GC = WS_GATES + al((size_t)T * 16 * 4);
constexpr size_t WS_BAR = WS_GC + al((size_t)(T / 64) * 8 * 64 * 4);
constexpr size_t WS_END = WS_BAR + 16384;
constexpr size_t WS_TINV = WS_PROJ + al((size_t)T * OW * 2);
constexpr size_t WS_QKM = WS_HM;
static_assert(WS_TINV + (size_t)T * 1024 <= WS_PART, "TINV must fit in the PROJ tail");
constexpr size_t WS_RM12 = WS_HM;
constexpr size_t WS_RM34 = WS_QKVN;
constexpr size_t WS_VSH = WS_QKVN + (size_t)(T / 64) * 8 * 16384;
static_assert((size_t)(T / 64) * 8 * 16384 <= (size_t)T * D * 2, "M1/M2 must fit in HM");
static_assert((size_t)(T / 64) * 8 * 16384 + (size_t)T * 512 * 2 <= (size_t)T * 1536 * 2, "M3/M4 + shifted v must fit in QKVN");

constexpr size_t OUT_X = 0;
constexpr size_t OUT_GLA = (size_t)T * D;
constexpr size_t OUT_RWKV = OUT_GLA + (size_t)NB_CTX * N_EVEN * 2 * 4 * 64 * 128;
constexpr size_t OUT_GDN = OUT_RWKV + (size_t)NB_CTX * N_EVEN * 2 * 8 * 64 * 64;
constexpr size_t OUT_S5R = OUT_GDN + (size_t)NB_CTX * N_ODD * 2 * 4 * 128 * 128;
constexpr size_t OUT_S5I = OUT_S5R + (size_t)NB_CTX * N_ODD * 2 * 32 * 64;

struct P {
    const float* in[44];
    float* out;
    char* ws;
};
enum { I_XP = 0, I_XS, I_C, I_SGLA, I_SRWKV, I_SGDN, I_SS5R, I_SS5I, I_CCTX, I_WMOD, I_BMOD, I_GPRE, I_GPOST,
       I_WINE, I_WOUTE, I_GUP, I_GBIAS, I_GLAN, I_MIX, I_W0, I_W2, I_A0, I_A2, I_KK, I_KA, I_RK, I_LNG, I_LNB,
       I_WINO, I_WOUTO, I_CONV, I_ALOG, I_DTB, I_GDNN, I_S5AR, I_S5AI, I_S5DT, I_S5BR, I_S5BI, I_S5CR, I_S5CI,
       I_S5D, I_GLUW, I_GLUB };

#ifdef CPU_EMU
__device__ __forceinline__ int opaque_tid() { return (int)threadIdx.x; }
#else
__device__ __forceinline__ int opaque_tid() { int t = (int)threadIdx.x; asm volatile("" : "+v"(t)); return t; }
#endif
#define LT (opaque_tid() & 255)
__device__ __forceinline__ float u2f(unsigned u) { return __builtin_bit_cast(float, u); }
__device__ __forceinline__ unsigned f2u(float f) { return __builtin_bit_cast(unsigned, f); }
__device__ __forceinline__ float bf2f(bf16 h) { return u2f((unsigned)h << 16); }
#ifdef CPU_EMU
__device__ __forceinline__ bf16 f2bf(float f) { unsigned u = f2u(f); u += 0x7fffu + ((u >> 16) & 1u); return (bf16)(u >> 16); }
__device__ __forceinline__ unsigned pack2(float lo, float hi) { return (unsigned)f2bf(lo) | ((unsigned)f2bf(hi) << 16); }
__device__ __forceinline__ float fexp(float x) { return expf(x); }
__device__ __forceinline__ float flog(float x) { return logf(x); }
__device__ __forceinline__ float frcp(float x) { return 1.0f / x; }
__device__ __forceinline__ float frsq(float x) { return 1.0f / sqrtf(x); }
#else
typedef __bf16 hwbf2 __attribute__((ext_vector_type(2)));
typedef float hwf2 __attribute__((ext_vector_type(2)));
__device__ __forceinline__ unsigned pack2(float lo, float hi) { hwf2 v = {lo, hi}; return __builtin_bit_cast(unsigned, __builtin_convertvector(v, hwbf2)); }
__device__ __forceinline__ bf16 f2bf(float f) { return (bf16)(pack2(f, 0.f) & 0xffffu); }
__device__ __forceinline__ float fexp(float x) { return __builtin_amdgcn_exp2f(x * 1.4426950408889634f); }
__device__ __forceinline__ float flog(float x) { return __builtin_amdgcn_logf(x) * 0.6931471805599453f; }
__device__ __forceinline__ float frcp(float x) { return __builtin_amdgcn_rcpf(x); }
__device__ __forceinline__ float frsq(float x) { return __builtin_amdgcn_rsqf(x); }
#endif
__device__ __forceinline__ float sigmoidf_(float x) { return frcp(1.0f + fexp(-x)); }
__device__ __forceinline__ float siluf_(float x) { return x * frcp(1.0f + fexp(-x)); }
__device__ __forceinline__ float logsigf_(float x) { return fminf(x, 0.f) - flog(1.0f + fexp(-fabsf(x))); }
__device__ __forceinline__ float softplusf_(float x) { return fmaxf(x, 0.f) + flog(1.0f + fexp(-fabsf(x))); }
__device__ __forceinline__ float ftanh(float x) { const float e = fexp(-2.0f * fabsf(x)); const float t = (1.0f - e) * frcp(1.0f + e); return x < 0.f ? -t : t; }
__device__ __forceinline__ float gelu_tanh(float x) { return 0.5f * x * (1.0f + ftanh(0.7978845608028654f * (x + 0.044715f * x * x * x))); }

typedef float f8v __attribute__((ext_vector_type(8)));
__device__ __forceinline__ f8v unpack8v(const uint4& u) {
    f8v f; f[0] = u2f(u.x << 16); f[1] = u2f(u.x & 0xffff0000u); f[2] = u2f(u.y << 16); f[3] = u2f(u.y & 0xffff0000u);
    f[4] = u2f(u.z << 16); f[5] = u2f(u.z & 0xffff0000u); f[6] = u2f(u.w << 16); f[7] = u2f(u.w & 0xffff0000u); return f;
}
__device__ __forceinline__ uint4 pack8v(const f8v& f) { return make_uint4(pack2(f[0], f[1]), pack2(f[2], f[3]), pack2(f[4], f[5]), pack2(f[6], f[7])); }
struct Seq { int start, len, cond, lat, b; };
__device__ __forceinline__ Seq get_seq(int s) {
    Seq q;
    if (s < NB_CTX) { q.start = s * L_CTX; q.len = L_CTX; q.cond = 0; q.lat = 0; q.b = s; }
    else { int b = s - NB_CTX; q.start = T_CTX + b * L_LAT; q.len = L_LAT; q.cond = 1 + b; q.lat = 1; q.b = b; }
    return q;
}
__device__ __forceinline__ int tok_cond(int t) { return t < T_CTX ? 0 : 1 + (t - T_CTX) / L_LAT; }
__device__ __forceinline__ void tok_nbr(int t, bool& hl, bool& hr) {
    if (t < T_CTX) { int pos = t % L_CTX; hl = pos != 0; hr = pos != L_CTX - 1; }
    else { int pos = (t - T_CTX) & 63; hl = pos != 0; hr = pos != 63; }
}

constexpr int MOD_VB = DEPTH * 192;
__device__ __forceinline__ void ph_mod(const P& p, int bid, float* smem) {
    float (*sc)[1024] = (float(*)[1024])smem;
    float (*red)[16][NCOND] = (float(*)[16][NCOND])(smem + NCOND * 1024);
    const int layer = bid / 192, ct = bid % 192;
    __syncthreads();
    const int tid = LT, cl = tid & 15, kg = tid >> 4;
    for (int i = tid; i < NCOND * 1024; i += 256) {
        int ci = i >> 10, k = i & 1023;
        float v = ci == 0 ? p.in[I_CCTX][k] : p.in[I_C][(ci - 1) * 1024 + k];
        sc[ci][k] = siluf_(v);
    }
    __syncthreads();
    float acc[NCOND];
#pragma unroll
    for (int ci = 0; ci < NCOND; ++ci) acc[ci] = 0.f;
    const float* w = p.in[I_WMOD] + (size_t)layer * 1024 * 3072 + ct * 16 + cl;
#pragma unroll 4
    for (int kk = 0; kk < 64; ++kk) {
        const int k = kg * 64 + kk;
        const float wv = w[(size_t)k * 3072];
#pragma unroll
        for (int ci = 0; ci < NCOND; ++ci) acc[ci] += sc[ci][k] * wv;
    }
#pragma unroll
    for (int ci = 0; ci < NCOND; ++ci) red[kg][cl][ci] = acc[ci];
    __syncthreads();
    if (tid < 16 * NCOND) {
        const int c = tid / NCOND, ci = tid % NCOND;
        float sum = p.in[I_BMOD][layer * 3072 + ct * 16 + c];
#pragma unroll
        for (int g = 0; g < 16; ++g) sum += red[g][c][ci];
        ((float*)(p.ws + WS_MOD))[(size_t)(layer * NCOND + ci) * 3072 + ct * 16 + c] = sum;
    }
}

struct WtJob { const float* src; bf16* dst; int K, N, Npad; };
__device__ __forceinline__ WtJob wt_job(const P& p, int j) {
    WtJob q;
    if (j < N_EVEN) { q.src = p.in[I_WINE] + (size_t)j * D * EW; q.dst = (bf16*)(p.ws + WS_WTE) + (size_t)j * EWP * D; q.K = D; q.N = EW; q.Npad = EWP; return q; }
    j -= N_EVEN;
    if (j < N_ODD) { q.src = p.in[I_WINO] + (size_t)j * D * OW; q.dst = (bf16*)(p.ws + WS_WTO) + (size_t)j * OWP * D; q.K = D; q.N = OW; q.Npad = OWP; return q; }
    j -= N_ODD;
    if (j < DEPTH) { int i = j >> 1; q.src = (j & 1) ? p.in[I_WOUTO] + (size_t)i * D * D : p.in[I_WOUTE] + (size_t)i * D * D; q.dst = (bf16*)(p.ws + WS_WTOUT) + (size_t)j * D * D; q.K = D; q.N = D; q.Npad = D; return q; }
    j -= DEPTH;
    q.src = p.in[I_GLUW] + (size_t)j * 512 * 512; q.dst = (bf16*)(p.ws + WS_WTGLU) + (size_t)j * 512 * 512; q.K = 512; q.N = 512; q.Npad = 512; return q;
}
constexpr int WT_NJOBS = N_EVEN + N_ODD + DEPTH + N_ODD;
constexpr int WT_TILES = N_EVEN * (EWP / 64) * 16 + N_ODD * (OWP / 64) * 16 + DEPTH * 256 + N_ODD * 64;
__device__ __forceinline__ void ph_wt(const P& p, int bid, float* smem) {
    float (*tile)[65] = (float(*)[65])smem;
    int b = bid, j = 0;
    __syncthreads();
    WtJob q;
    for (;; ++j) { q = wt_job(p, j); int nt = (q.Npad / 64) * (q.K / 64); if (b < nt) break; b -= nt; }
    const int nk = q.K / 64, n0 = (b / nk) * 64, k0 = (b % nk) * 64;
    {
        const int kk = LT >> 4, n4 = (LT & 15) * 4, n = n0 + n4;
#pragma unroll
        for (int i = 0; i < 4; ++i) {
            float4 v = make_float4(0.f, 0.f, 0.f, 0.f);
            if (n < q.N) v = *(const float4*)(q.src + (size_t)(k0 + kk + 16 * i) * q.N + n);
            float* tr = &tile[kk + 16 * i][n4];
            tr[0] = v.x; tr[1] = v.y; tr[2] = v.z; tr[3] = v.w;
        }
    }
    __syncthreads();
    {
        const int nn = LT >> 2, k16 = (LT & 3) * 16;
        f8v a, c;
#pragma unroll
        for (int j = 0; j < 8; ++j) { a[j] = tile[k16 + j][nn]; c[j] = tile[k16 + 8 + j][nn]; }
        bf16* d = q.dst + (size_t)(n0 + nn) * q.K + k0 + k16;
        *(uint4*)d = pack8v(a); *(uint4*)(d + 8) = pack8v(c);
    }
}


#ifndef PROBE_SEL
#define PROBE_SEL 0
#endif
#ifndef PROBE_BLK
#define PROBE_BLK 0
#endif
#ifndef PROBE_MUL
#define PROBE_MUL 4
#endif
#if PROBE_SEL && !defined(CPU_EMU)
extern __shared__ __attribute__((aligned(16))) unsigned char dsm_probe[];
#define PT_B(id) long long ptb_##id = 0; if (PROBE_SEL == (id)) ptb_##id = clock64()
#define PT_E(id) do { if (PROBE_SEL == (id) && blockIdx.x == PROBE_BLK && threadIdx.x == 0) { volatile unsigned long long* a_ = (volatile unsigned long long*)(dsm_probe + 163840 - 8); *a_ = *a_ + (unsigned long long)(clock64() - ptb_##id); } } while (0)
#else
#define PT_B(id) do {} while (0)
#define PT_E(id) do {} while (0)
#endif
constexpr int NTW = 3;
__device__ __forceinline__ float wave_sum(float v) {
#pragma unroll
    for (int m = 1; m < 64; m <<= 1) v += __shfl_xor(v, m);
    return v;
}
__device__ __forceinline__ void hmod_row(const float* xv  , int lane, const float* gpre, const float* mod, bf16* dst) {
    float ss = 0.f;
#pragma unroll
    for (int i = 0; i < 16; ++i) ss += xv[i] * xv[i];
    ss = wave_sum(ss);
    const float r = frsq(ss * (1.0f / 1024.f) + EPS);
#pragma unroll
    for (int i = 0; i < 4; ++i) {
        int idx = i * 256 + lane * 4;
        const float4 g = *(const float4*)(gpre + idx), sc = *(const float4*)(mod + 1024 + idx), sh = *(const float4*)(mod + idx);
        *(uint2*)(dst + idx) = make_uint2(pack2(xv[i * 4] * r * g.x * (1.0f + sc.x) + sh.x, xv[i * 4 + 1] * r * g.y * (1.0f + sc.y) + sh.y),
                                          pack2(xv[i * 4 + 2] * r * g.z * (1.0f + sc.z) + sh.z, xv[i * 4 + 3] * r * g.w * (1.0f + sc.w) + sh.w));
    }
}
__device__ __forceinline__ void ph_hmod0(const P& p, int bid) {
    const int lane = LT & 63, tb = bid * (4 * NTW) + (LT >> 6) * NTW;
    if (tb >= T) return;
    float xv[NTW][16];
#pragma unroll
    for (int u = 0; u < NTW; ++u) {
        const int t = (tb + u < T) ? tb + u : T - 1;
        const float* xr = t < T_CTX ? p.in[I_XP] + (size_t)t * D : p.in[I_XS] + (size_t)(t - T_CTX) * D;
#pragma unroll
        for (int i = 0; i < 4; ++i) { float4 v = *(const float4*)(xr + i * 256 + lane * 4); xv[u][i * 4] = v.x; xv[u][i * 4 + 1] = v.y; xv[u][i * 4 + 2] = v.z; xv[u][i * 4 + 3] = v.w; }
    }
#pragma unroll
    for (int u = 0; u < NTW; ++u) {
        const int t = tb + u; if (t >= T) break;
        const float* mod = (const float*)(p.ws + WS_MOD) + (size_t)(0 * NCOND + tok_cond(t)) * 3072;
        hmod_row(xv[u], lane, p.in[I_GPRE], mod, (bf16*)(p.ws + WS_HM) + (size_t)t * D);
    }
}
__device__ __forceinline__ void ph_post(const P& p, int bid, int layer) {
    const int lane = LT & 63, tb = bid * (4 * NTW) + (LT >> 6) * NTW;
    if (tb >= T) return;
    const float* gpost = p.in[I_GPOST] + layer * D;
    float xv[NTW][16], mv[NTW][16];
#pragma unroll
    for (int u = 0; u < NTW; ++u) {
        const int t = (tb + u < T) ? tb + u : T - 1;
        const bf16* mr = (const bf16*)(p.ws + WS_PROJ) + (size_t)t * D;
        if (layer == 0) {
            const float* xr = t < T_CTX ? p.in[I_XP] + (size_t)t * D : p.in[I_XS] + (size_t)(t - T_CTX) * D;
#pragma unroll
            for (int i = 0; i < 4; ++i) { float4 v = *(const float4*)(xr + i * 256 + lane * 4); xv[u][i * 4] = v.x; xv[u][i * 4 + 1] = v.y; xv[u][i * 4 + 2] = v.z; xv[u][i * 4 + 3] = v.w; }
        } else {
            const bf16* xb = (const bf16*)(p.out + OUT_X + (size_t)t * D + 512);
#pragma unroll
            for (int i = 0; i < 4; ++i) { const uint2 w = *(const uint2*)(xb + i * 256 + lane * 4); xv[u][i * 4] = u2f(w.x << 16); xv[u][i * 4 + 1] = u2f(w.x & 0xffff0000u); xv[u][i * 4 + 2] = u2f(w.y << 16); xv[u][i * 4 + 3] = u2f(w.y & 0xffff0000u); }
        }
#pragma unroll
        for (int i = 0; i < 4; ++i) { const uint2 w = *(const uint2*)(mr + i * 256 + lane * 4); mv[u][i * 4] = u2f(w.x << 16); mv[u][i * 4 + 1] = u2f(w.x & 0xffff0000u); mv[u][i * 4 + 2] = u2f(w.y << 16); mv[u][i * 4 + 3] = u2f(w.y & 0xffff0000u); }
    }
#pragma unroll
    for (int u = 0; u < NTW; ++u) {
        const int t = tb + u; if (t >= T) break;
        const float* mod = (const float*)(p.ws + WS_MOD) + (size_t)(layer * NCOND + tok_cond(t)) * 3072;
        float* xo = p.out + OUT_X + (size_t)t * D;
        bf16* xb = (bf16*)(xo + 512);
        float ss = 0.f;
#pragma unroll
        for (int i = 0; i < 16; ++i) ss += mv[u][i] * mv[u][i];
        ss = wave_sum(ss);
        const float r = frsq(ss * (1.0f / 1024.f) + EPS);
#pragma unroll
        for (int i = 0; i < 4; ++i) {
            const int idx = i * 256 + lane * 4;
            const float4 gt = *(const float4*)(mod + 2048 + idx), gp = *(const float4*)(gpost + idx);
            xv[u][i * 4] += gt.x * (mv[u][i * 4] * r * gp.x); xv[u][i * 4 + 1] += gt.y * (mv[u][i * 4 + 1] * r * gp.y);
            xv[u][i * 4 + 2] += gt.z * (mv[u][i * 4 + 2] * r * gp.z); xv[u][i * 4 + 3] += gt.w * (mv[u][i * 4 + 3] * r * gp.w);
        }
        if (layer + 1 < DEPTH) {
#pragma unroll
            for (int i = 0; i < 4; ++i) *(uint2*)(xb + i * 256 + lane * 4) = make_uint2(pack2(xv[u][i * 4], xv[u][i * 4 + 1]), pack2(xv[u][i * 4 + 2], xv[u][i * 4 + 3]));
            const float* mod2 = (const float*)(p.ws + WS_MOD) + (size_t)((layer + 1) * NCOND + tok_cond(t)) * 3072;
            hmod_row(xv[u], lane, p.in[I_GPRE] + (layer + 1) * D, mod2, (bf16*)(p.ws + WS_HM) + (size_t)t * D);
        } else {
#pragma unroll
            for (int i = 0; i < 4; ++i) *(float4*)(xo + i * 256 + lane * 4) = make_float4(xv[u][i * 4], xv[u][i * 4 + 1], xv[u][i * 4 + 2], xv[u][i * 4 + 3]);
        }
    }
}

#ifdef CPU_EMU
#define LDS_AS
#define GLDS16(gptr, lptr) memcpy((char*)(lptr) + (threadIdx.x & 63) * 16, (const void*)(gptr), 16)
#define PG_WAIT_V(n)
#define PG_WAIT_L(n)
#define PG_BAR __syncthreads()
#define PG_SCHED
#define PG_PRIO(x)
#define RFL(x) (x)
__device__ __forceinline__ unsigned cvt_pk_bf16(float lo, float hi) { return (unsigned)f2bf(lo) | ((unsigned)f2bf(hi) << 16); }
#else
#define LDS_AS __attribute__((address_space(3)))
#define GLDS16(gptr, lptr) __builtin_amdgcn_global_load_lds((const unsigned*)(gptr), (LDS_AS unsigned*)(lptr), 16, 0, 0)
#define PG_WAIT_V(n) asm volatile("s_waitcnt vmcnt(" #n ")" ::: "memory")
#define PG_WAIT_L(n) asm volatile("s_waitcnt lgkmcnt(" #n ")" ::: "memory")
#define PG_BAR __builtin_amdgcn_s_barrier()
#define PG_SCHED __builtin_amdgcn_sched_barrier(0)
#define PG_PRIO(x) __builtin_amdgcn_s_setprio(x)
#define RFL(x) __builtin_amdgcn_readfirstlane(x)
__device__ __forceinline__ unsigned cvt_pk_bf16(float lo, float hi) { return pack2(lo, hi); }
#endif
namespace pg8 {
constexpr int BM = 256, BK = 64, HALF = 128, HTB = HALF * BK * 2, STAGE_BYTES = 8 * HTB, NXCD = 8, WGM = 8;
__host__ __device__ __forceinline__ int lds_byte(int r, int c) { const int st = (r >> 4) * 2 + (c >> 5), rr = r & 15, cc = c & 31, ob = rr * 64 + cc * 2; return st * 1024 + (ob ^ (((ob >> 9) & 1) << 5)); }
__host__ __device__ __forceinline__ void stage_rc(int b, int& R, int& C) { const int st = b / 1024, sb = b % 1024, swz = sb ^ (((sb >> 9) & 1) << 5); R = (st >> 1) * 16 + swz / 64; C = (st & 1) * 32 + (swz % 64) / 2; }
__host__ __device__ __forceinline__ int perm32(int rho) { const int n = rho >> 4, i = rho & 15; return 8 * (i >> 2) + 4 * n + (i & 3); }
struct Unit { int pm, pn; };
struct Gemm { const bf16* A; const bf16* Bt; int M, N, K, lda; };
struct StaticOrder {
    int nM, nN, nwg, G, c;
    __host__ __device__ void init(int M, int N, int G_, int c_) { nM = M / BM; nN = N / BM; nwg = nM * nN; G = G_; c = c_; }
    __host__ __device__ bool next(int i, Unit& u) const {
        const long L = (long)i * G + c; if (L >= nwg) return false;
        int wgid = (int)L; { const int q = nwg / NXCD, r = nwg % NXCD, xcd = wgid % NXCD, off = wgid / NXCD; wgid = (xcd < r ? xcd * (q + 1) : r * (q + 1) + (xcd - r) * q) + off; }
        const int nig = WGM * nN, gid = wgid / nig, fm = gid * WGM, gsz = (nM - fm) < WGM ? (nM - fm) : WGM;
        u.pm = fm + ((wgid % nig) % gsz); u.pn = (wgid % nig) / gsz; return true;
    }
};
struct EpiF32 {
    static constexpr bool PERM = false;
    float* C; int ldc;
    __device__ __forceinline__ void operator()(const f4v (&acc)[2][2][4][2], const Unit& u, int wr, int wc, int fr, int fq) const {
        const int row0 = u.pm * BM + wr * 64 + fr, col0 = u.pn * BM + wc * 32 + 4 * fq;
#pragma unroll
        for (int ai = 0; ai < 2; ++ai)
#pragma unroll
            for (int m = 0; m < 4; ++m) { float* rowp = C + (size_t)(row0 + ai * HALF + m * 16) * ldc + col0;
#pragma unroll
                for (int bj = 0; bj < 2; ++bj)
#pragma unroll
                    for (int n = 0; n < 2; ++n) *(f4v*)(rowp + bj * HALF + n * 16) = acc[ai][bj][m][n]; }
    }
};
struct EpiBf16 {
    static constexpr bool PERM = true;
    bf16* O; int ldc; int N;
    __device__ __forceinline__ void operator()(const f4v (&acc)[2][2][4][2], const Unit& u, int wr, int wc, int fr, int fq) const {
        const int row0 = u.pm * BM + wr * 64 + fr, col0 = u.pn * BM + wc * 32 + 8 * fq;
#pragma unroll
        for (int ai = 0; ai < 2; ++ai)
#pragma unroll
            for (int m = 0; m < 4; ++m) { bf16* rowp = O + (size_t)(row0 + ai * HALF + m * 16) * ldc + col0;
#pragma unroll
                for (int bj = 0; bj < 2; ++bj) { const f4v v0 = acc[ai][bj][m][0], v1 = acc[ai][bj][m][1];
                    if (col0 + bj * HALF < N) *(uint4*)(rowp + bj * HALF) = make_uint4(cvt_pk_bf16(v0[0], v0[1]), cvt_pk_bf16(v0[2], v0[3]), cvt_pk_bf16(v1[0], v1[1]), cvt_pk_bf16(v1[2], v1[3])); } }
    }
};
struct EpiGlu {
    static constexpr bool PERM = true;
    bf16* O; const bf16* YS; const bf16* ZD; const float* GB;
    __device__ __forceinline__ void operator()(const f4v (&acc)[2][2][4][2], const Unit& u, int wr, int wc, int fr, int fq) const {
        const int row0 = u.pm * BM + wr * 64 + fr, col0 = u.pn * BM + wc * 32 + 8 * fq;
#pragma unroll
        for (int ai = 0; ai < 2; ++ai)
#pragma unroll
            for (int m = 0; m < 4; ++m) { const size_t row = (size_t)(row0 + ai * HALF + m * 16);
#pragma unroll
                for (int bj = 0; bj < 2; ++bj) { const int col = col0 + bj * HALF;
                    const f8v ys = unpack8v(*(const uint4*)(YS + row * 512 + col)), zd = unpack8v(*(const uint4*)(ZD + row * OW + col));
                    const f8v gb = *(const f8v*)(GB + col);
                    f8v o;
#pragma unroll
                    for (int j = 0; j < 8; ++j) { const float g = (j < 4 ? acc[ai][bj][m][0][j] : acc[ai][bj][m][1][j - 4]) + gb[j]; o[j] = ys[j] * sigmoidf_(g) * siluf_(zd[j]); }
                    *(uint4*)(O + row * D + col) = pack8v(o); } }
    }
};
template <class Epi>
__device__ __forceinline__ void gemm_phase(LDS_AS unsigned char* lds, const Gemm g, const StaticOrder& S, const Epi& E) {
    const int tid = opaque_tid(), wid = RFL(tid >> 6), lane = tid & 63, wr = wid >> 2, wc = wid & 3, fr = lane & 15, fq = lane >> 4;
    const int K = g.K, nt = K / BK;
    unsigned voffA[2], voffB[2];
#pragma unroll
    for (int i = 0; i < 2; ++i) { int R, C; stage_rc(tid * 16 + i * 8192, R, C); const int Rb = Epi::PERM ? ((R & ~31) + perm32(R & 31)) : R;
        voffA[i] = (unsigned)(R * g.lda + C) * 2u; voffB[i] = (unsigned)(Rb * K + C) * 2u; }
    const size_t kstep = (size_t)(BK * 2);
    const size_t hstepA = (size_t)HALF * g.lda * 2, hstepB = (size_t)HALF * K * 2;
    const size_t tstepA = 2 * hstepA, tstepB = 2 * hstepB;
    const unsigned ldsw = (unsigned)wid * 1024u;
    const int aoff = lds_byte(wr * 64 + fr, fq * 8), boff = lds_byte(wc * 32 + fr, fq * 8);
#define PG8_SA(b, h) (((b) * 2 + (h)) * HTB)
#define PG8_SB(b, h) ((4 + (b) * 2 + (h)) * HTB)
#define PG8_STAGE(bufoff, gbase, voff) do { _Pragma("unroll") for (int _i = 0; _i < 2; ++_i) GLDS16((const char*)(gbase) + (voff)[_i], lds + (bufoff) + ldsw + _i * 8192); } while (0)
#define PG8_LDA(dst, b, h) do { _Pragma("unroll") for (int m = 0; m < 4; ++m) _Pragma("unroll") for (int k = 0; k < 2; ++k) dst[m][k] = *(const LDS_AS s8v*)(lds + PG8_SA(b, h) + aoff + m * 2048 + k * 1024); } while (0)
#define PG8_LDB(dst, b, h) do { _Pragma("unroll") for (int n = 0; n < 2; ++n) _Pragma("unroll") for (int k = 0; k < 2; ++k) dst[n][k] = *(const LDS_AS s8v*)(lds + PG8_SB(b, h) + boff + n * 2048 + k * 1024); } while (0)
#define PG8_MMA(ai, bj, At, Bt) do { PG_PRIO(1); _Pragma("unroll") for (int m = 0; m < 4; ++m) _Pragma("unroll") for (int n = 0; n < 2; ++n) _Pragma("unroll") for (int k = 0; k < 2; ++k) \
        acc[ai][bj][m][n] = __builtin_amdgcn_mfma_f32_16x16x32_bf16(Bt[n][k], At[m][k], acc[ai][bj][m][n], 0, 0, 0); PG_PRIO(0); } while (0)
    Unit cur, nxt; int ui = 0;
    if (!S.next(0, cur)) return;
    f4v acc[2][2][4][2];
#pragma unroll
    for (int a = 0; a < 2; ++a)
#pragma unroll
        for (int b = 0; b < 2; ++b)
#pragma unroll
            for (int m = 0; m < 4; ++m)
#pragma unroll
                for (int n = 0; n < 2; ++n) acc[a][b][m][n] = (f4v){0.f, 0.f, 0.f, 0.f};
    s8v At[4][2], B0[2][2], B1[2][2];
    const char* cA = (const char*)g.A + (size_t)cur.pm * tstepA; const char* cB = (const char*)g.Bt + (size_t)cur.pn * tstepB;
    PG8_STAGE(PG8_SB(0, 0), cB, voffB); PG8_STAGE(PG8_SA(0, 0), cA, voffA); PG8_STAGE(PG8_SB(0, 1), cB + hstepB, voffB); PG8_STAGE(PG8_SA(0, 1), cA + hstepA, voffA);
    if (wr == 1) PG_BAR;
    PG_WAIT_V(4); PG_BAR;
    PG8_STAGE(PG8_SB(1, 0), cB + kstep, voffB); PG8_STAGE(PG8_SA(1, 0), cA + kstep, voffA); PG8_STAGE(PG8_SB(1, 1), cB + hstepB + kstep, voffB);
    PG_WAIT_V(6); PG_BAR;
    for (;;) {
        const bool has_next = S.next(ui + 1, nxt);
        const char* nA = has_next ? (const char*)g.A + (size_t)nxt.pm * tstepA : cA; const char* nB = has_next ? (const char*)g.Bt + (size_t)nxt.pn * tstepB : cB;
        for (int t = 0; t < nt; t += 2) {
            const bool last = (t == nt - 2);
            const char* a1 = cA + (size_t)(t + 1) * kstep;
            const char* a2 = last ? nA : cA + (size_t)(t + 2) * kstep; const char* b2 = last ? nB : cB + (size_t)(t + 2) * kstep;
            const char* a3 = a2 + kstep; const char* b3 = b2 + kstep;
            PG8_LDB(B0, 0, 0); PG_SCHED; PG8_LDA(At, 0, 0); PG8_STAGE(PG8_SA(1, 1), a1 + hstepA, voffA);
            PG_WAIT_L(8); PG_BAR; PG_WAIT_L(0); PG8_MMA(0, 0, At, B0); PG_BAR; PG_SCHED;
            PG8_LDB(B1, 0, 1); PG8_STAGE(PG8_SB(0, 0), b2, voffB);
            PG_BAR; PG_WAIT_L(0); PG8_MMA(0, 1, At, B1); PG_BAR;
            PG8_LDA(At, 0, 1); PG8_STAGE(PG8_SA(0, 0), a2, voffA);
            PG_BAR; PG_WAIT_L(0); PG8_MMA(1, 0, At, B0); PG_BAR; PG_SCHED;
            PG8_STAGE(PG8_SB(0, 1), b2 + hstepB, voffB);
            PG_WAIT_V(6); PG_BAR; PG8_MMA(1, 1, At, B1); PG_BAR;
            PG8_LDB(B0, 1, 0); PG_SCHED; PG8_LDA(At, 1, 0); PG8_STAGE(PG8_SA(0, 1), a2 + hstepA, voffA);
            PG_WAIT_L(8); PG_BAR; PG_WAIT_L(0); PG8_MMA(0, 0, At, B0); PG_BAR; PG_SCHED;
            PG8_LDB(B1, 1, 1); PG8_STAGE(PG8_SB(1, 0), b3, voffB);
            PG_BAR; PG_WAIT_L(0); PG8_MMA(0, 1, At, B1); PG_BAR;
            PG8_LDA(At, 1, 1); PG8_STAGE(PG8_SA(1, 0), a3, voffA);
            PG_BAR; PG_WAIT_L(0); PG8_MMA(1, 0, At, B0); PG_BAR; PG_SCHED;
            PG8_STAGE(PG8_SB(1, 1), b3 + hstepB, voffB);
            PG_WAIT_V(6); PG_BAR; PG8_MMA(1, 1, At, B1); PG_BAR;
        }
        E(acc, cur, wr, wc, fr, fq);
        if (!has_next) break;
#pragma unroll
        for (int a = 0; a < 2; ++a)
#pragma unroll
            for (int b = 0; b < 2; ++b)
#pragma unroll
                for (int m = 0; m < 4; ++m)
#pragma unroll
                    for (int n = 0; n < 2; ++n) acc[a][b][m][n] = (f4v){0.f, 0.f, 0.f, 0.f};
        cur = nxt; cA = nA; cB = nB; ++ui;
    }
    PG_WAIT_V(0);
    if (wr == 0) PG_BAR;
    PG_BAR;
}
}

#ifdef CPU_EMU
#define WAVE_SYNC() emu::wsync()
#define LBAR() __syncthreads()
#else
#define WAVE_SYNC() __builtin_amdgcn_wave_barrier()
#define LBAR() do { asm volatile("s_waitcnt lgkmcnt(0)" ::: "memory"); __builtin_amdgcn_s_barrier(); asm volatile("" ::: "memory"); } while (0)
#endif
__device__ __forceinline__ void unpack8(const uint4& u, float* f) {
    f[0] = u2f(u.x << 16); f[1] = u2f(u.x & 0xffff0000u); f[2] = u2f(u.y << 16); f[3] = u2f(u.y & 0xffff0000u);
    f[4] = u2f(u.z << 16); f[5] = u2f(u.z & 0xffff0000u); f[6] = u2f(u.w << 16); f[7] = u2f(u.w & 0xffff0000u);
}
__device__ __forceinline__ uint4 pack8(const float* f) { return make_uint4(pack2(f[0], f[1]), pack2(f[2], f[3]), pack2(f[4], f[5]), pack2(f[6], f[7])); }
__device__ __forceinline__ f4v unpack4(const uint2& u) { f4v f; f[0] = u2f(u.x << 16); f[1] = u2f(u.x & 0xffff0000u); f[2] = u2f(u.y << 16); f[3] = u2f(u.y & 0xffff0000u); return f; }
__device__ __forceinline__ uint2 pack4(const f4v& f) { return make_uint2(pack2(f[0], f[1]), pack2(f[2], f[3])); }
__device__ __forceinline__ f4v mfma16(const s8v& a, const s8v& b, const f4v& c) { return __builtin_amdgcn_mfma_f32_16x16x32_bf16(a, b, c, 0, 0, 0); }

__device__ __forceinline__ float red8(float x) {
#ifdef CPU_EMU
    x += __shfl_xor(x, 1); x += __shfl_xor(x, 2); x += __shfl_xor(x, 4);
#else
    x += __builtin_bit_cast(float, __builtin_amdgcn_mov_dpp(__builtin_bit_cast(int, x), 0xB1, 0xF, 0xF, true));
    x += __builtin_bit_cast(float, __builtin_amdgcn_mov_dpp(__builtin_bit_cast(int, x), 0x4E, 0xF, 0xF, true));
    x += __builtin_bit_cast(float, __builtin_amdgcn_mov_dpp(__builtin_bit_cast(int, x), 0x141, 0xF, 0xF, true));
#endif
    return x;
}
__device__ __forceinline__ float red16(float x) {
    x = red8(x);
#ifdef CPU_EMU
    x += __shfl_xor(x, 8);
#else
    x += __builtin_bit_cast(float, __builtin_amdgcn_mov_dpp(__builtin_bit_cast(int, x), 0x140, 0xF, 0xF, true));
#endif
    return x;
}
constexpr int TI_LD = 68, TI_TLD = 20;
__device__ __forceinline__ void ti_mm16(float* dst, int ldd, const float* L, int ldl, const float* R, int ldr, float sgn, const float* add, int lda, int lane) {
    const int r = lane >> 2, c4 = (lane & 3) * 4;
    f4v acc = (f4v){0.f, 0.f, 0.f, 0.f};
#pragma unroll
    for (int k = 0; k < 16; ++k) { const float l = L[r * ldl + k]; const f4v rv = *(const f4v*)(R + k * ldr + c4); acc += l * rv; }
    acc *= sgn;
    if (add) acc += *(const f4v*)(add + r * lda + c4);
    *(f4v*)(dst + r * ldd + c4) = acc;
}
__device__ __forceinline__ float red4(float x) {
#ifdef CPU_EMU
    x += __shfl_xor(x, 1); x += __shfl_xor(x, 2);
#else
    x += __builtin_bit_cast(float, __builtin_amdgcn_mov_dpp(__builtin_bit_cast(int, x), 0xB1, 0xF, 0xF, true));
    x += __builtin_bit_cast(float, __builtin_amdgcn_mov_dpp(__builtin_bit_cast(int, x), 0x4E, 0xF, 0xF, true));
#endif
    return x;
}
__device__ __forceinline__ void tri_inv64(const float* A, float* X, float* TMP, int wl, int lane, bool active) {
    wl = RFL(wl);
#define TI_A(a, b) (A + (16 * (a)) * TI_LD + 16 * (b))
#define TI_X(a, b) (X + (16 * (a)) * TI_LD + 16 * (b))
#define TI_T(n) (TMP + (n) * 16 * TI_TLD)
    if (active) {
        const int c = lane >> 2, js = lane & 3;
        float xr[4] = {0.f, 0.f, 0.f, 0.f};
        const float* Ab = TI_A(wl, wl);
#pragma unroll
        for (int i = 0; i < 16; ++i) {
            float part = 0.f;
#pragma unroll
            for (int m = 0; m <= (i - 1) / 4 && i > 0; ++m) { const int j = 4 * m + js; part += (j < i ? Ab[i * TI_LD + j] : 0.f) * xr[m]; }
            const float tot = red4(part);
            const float xi = (i == c ? 1.f : 0.f) - tot;
            xr[i >> 2] = ((i & 3) == js) ? xi : xr[i >> 2];
        }
        float* Xb = TI_X(wl, wl);
#pragma unroll
        for (int m = 0; m < 4; ++m) Xb[(4 * m + js) * TI_LD + c] = xr[m];
        for (int b = wl + 1; b < 4; ++b) { float* Z = TI_X(wl, b); const int r = lane >> 2, c4 = (lane & 3) * 4; *(f4v*)(Z + r * TI_LD + c4) = (f4v){0.f, 0.f, 0.f, 0.f}; }
    }
    LBAR();
    if (active && wl < 3) {
        const int col = lane & 15, g4 = (lane >> 4) * 4;
        const f4v zero = (f4v){0.f, 0.f, 0.f, 0.f};
#define TI_MMA(Lp, Bv, ACC) do { const f4v a_ = *(const f4v*)((Lp) + col * TI_LD + g4); _Pragma("unroll") for (int ks_ = 0; ks_ < 4; ++ks_) ACC = __builtin_amdgcn_mfma_f32_16x16x4f32(a_[ks_], (Bv)[ks_], ACC, 0, 0, 0); } while (0)
#define TI_ST(Dp, Cv) do { _Pragma("unroll") for (int r_ = 0; r_ < 4; ++r_) (Dp)[(g4 + r_) * TI_LD + col] = (Cv)[r_]; } while (0)
        f4v xb[4];
#pragma unroll
        for (int r = 0; r < 4; ++r) xb[0][r] = TI_X(wl, wl)[(g4 + r) * TI_LD + col];
#pragma unroll
        for (int a2 = 1; a2 < 4; ++a2) {
            const int ar = wl + a2;
            if (ar < 4) {
                f4v t = zero;
#pragma unroll
                for (int j = 0; j < a2; ++j) TI_MMA(TI_A(ar, wl + j), xb[j], t);
                f4v x = zero;
                TI_MMA(TI_X(ar, ar), t, x);
                x = -x;
                xb[a2] = x;
                TI_ST(TI_X(ar, wl), x);
            }
        }
#undef TI_MMA
#undef TI_ST
    }
    LBAR();
#undef TI_A
#undef TI_X
#undef TI_T
}

constexpr int GL_LD = 72;
__device__ __forceinline__ void gla_scan_task(const P& p, int ei, int s, int h, int dir, unsigned char* dsm) {
    bf16* LAt = (bf16*)dsm;
    bf16* Qd = LAt + 64 * GL_LD;
    bf16* Ki = Qd + 64 * GL_LD;
    bf16* KiT = Ki + 64 * GL_LD;
    bf16* Sc = KiT + 64 * GL_LD;
    bf16* VT = Sc + 64 * GL_LD;
    bf16* St = VT + 128 * GL_LD;
    float* sAE = (float*)(St + 128 * GL_LD);
    float* Of = sAE + 64;
    const Seq sq_ = get_seq(s);
    const int tid = opaque_tid(), lane = tid & 63, wid = tid >> 6, fr = lane & 15, fq = lane >> 4;
    const int rt = wid & 3, chf = wid >> 2;
    const bf16* proj = (const bf16*)(p.ws + WS_PROJ);
    bf16* opart = (bf16*)(p.ws + WS_PART);
    s8v gfrag[2]; float gb[2];
    {
        const float* gup = p.in[I_GUP] + (size_t)(ei * 2 + dir) * 16 * 256 + h * 64;
        const float* gbias = p.in[I_GBIAS] + (size_t)(ei * 2 + dir) * 256 + h * 64;
#pragma unroll
        for (int c2 = 0; c2 < 2; ++c2) {
            const int d = 16 * (2 * chf + c2) + fr;
            gb[c2] = gbias[d];
#pragma unroll
            for (int j = 0; j < 8; ++j) gfrag[c2][j] = (short)f2bf(fq < 2 ? gup[(8 * fq + j) * 256 + d] : 0.f);
        }
    }
    f4v Sacc[4];
    LBAR();
    if (sq_.lat) {
        const float* s0 = p.in[I_SGLA] + ((((size_t)sq_.b * N_EVEN + ei) * 2 + dir) * 4 + h) * 64 * 128;
#pragma unroll
        for (int ct = 0; ct < 4; ++ct)
#pragma unroll
            for (int r = 0; r < 4; ++r) Sacc[ct][r] = s0[(16 * rt + fq * 4 + r) * 128 + 64 * chf + 16 * ct + fr];
    } else {
#pragma unroll
        for (int ct = 0; ct < 4; ++ct) Sacc[ct] = (f4v){0.f, 0.f, 0.f, 0.f};
    }
#pragma unroll
    for (int ct = 0; ct < 4; ++ct) *(uint2*)(St + (64 * chf + 16 * ct + fr) * GL_LD + 16 * rt + fq * 4) = make_uint2(pack2(Sacc[ct][0], Sacc[ct][1]), pack2(Sacc[ct][2], Sacc[ct][3]));
    const int nch = sq_.len >> 6;
    uint4 pv0, pv1, pq, pkk, pga;
#define GLA_FETCH(TB) do { \
        { const int i_ = lane, c8_ = wid * 8; const bf16* pr_ = proj + (size_t)((TB) + (dir ? 63 - i_ : i_)) * EW + E_V + h * 128 + c8_; \
          pv0 = *(const uint4*)pr_; pv1 = *(const uint4*)(pr_ + 64); } \
        { const int i_ = tid >> 3, c8_ = (tid & 7) * 8; const bf16* pr_ = proj + (size_t)((TB) + (dir ? 63 - i_ : i_)) * EW + h * 64 + c8_; \
          pq = *(const uint4*)(pr_ + E_Q); pkk = *(const uint4*)(pr_ + E_K); } \
        { const int i_ = 16 * rt + fr; pga = make_uint4(0u, 0u, 0u, 0u); if (fq < 2) pga = *(const uint4*)(proj + (size_t)((TB) + (dir ? 63 - i_ : i_)) * EW + E_GD + dir * 16 + fq * 8); } \
    } while (0)
    GLA_FETCH(sq_.start + (dir ? sq_.len - 64 : 0));
    for (int cc = 0; cc < nch; ++cc) {
        const int tb = sq_.start + (dir ? sq_.len - 64 - cc * 64 : cc * 64);
        {
            {
                const int i = lane, c8 = wid * 8;
                const f8v va = unpack8v(pv0), vb = unpack8v(pv1);
#pragma unroll
                for (int j = 0; j < 8; ++j) { VT[(c8 + j) * GL_LD + i] = f2bf(va[j]); VT[(64 + c8 + j) * GL_LD + i] = f2bf(vb[j]); }
            }
            { const int i = tid >> 3, c8 = (tid & 7) * 8; *(uint4*)(Qd + i * GL_LD + c8) = pq; *(uint4*)(Ki + i * GL_LD + c8) = pkk; }
            const s8v ga = __builtin_bit_cast(s8v, pga);
            if (cc + 1 < nch) GLA_FETCH(sq_.start + (dir ? sq_.len - 128 - cc * 64 : (cc + 1) * 64));
#pragma unroll
            for (int c2 = 0; c2 < 2; ++c2) {
                const f4v x = mfma16(ga, gfrag[c2], (f4v){0.f, 0.f, 0.f, 0.f});
                float la[4];
#pragma unroll
                for (int r = 0; r < 4; ++r) la[r] = logsigf_(x[r] + gb[c2]) * (1.0f / 16.0f);
                *(uint2*)(LAt + (16 * (2 * chf + c2) + fr) * GL_LD + 16 * rt + fq * 4) = make_uint2(pack2(la[0], la[1]), pack2(la[2], la[3]));
            }
        }
        LBAR();
        {
            f4v bc[2];
            bc[0] = (f4v){0.f, 0.f, 0.f, 0.f}; bc[1] = bc[0];
#pragma unroll
            for (int ks = 0; ks < 2; ++ks) {
                s8v lf;
#pragma unroll
                for (int j = 0; j < 8; ++j) lf[j] = (32 * ks + 8 * fq + j <= 16 * rt + fr) ? (short)0x3F80 : (short)0;
#pragma unroll
                for (int c2 = 0; c2 < 2; ++c2) bc[c2] = mfma16(lf, *(const s8v*)(LAt + (16 * (2 * chf + c2) + fr) * GL_LD + 32 * ks + 8 * fq), bc[c2]);
            }
#pragma unroll
            for (int c2 = 0; c2 < 2; ++c2) {
                const int d = 16 * (2 * chf + c2) + fr;
                float kiv[4];
#pragma unroll
                for (int r = 0; r < 4; ++r) {
                    const int i = 16 * rt + fq * 4 + r;
                    const float eb = fexp(bc[c2][r]);
                    const float qv = bf2f(Qd[i * GL_LD + d]) * 0.125f * eb;
                    kiv[r] = bf2f(Ki[i * GL_LD + d]) * frcp(eb);
                    Qd[i * GL_LD + d] = f2bf(qv); Ki[i * GL_LD + d] = f2bf(kiv[r]);
                    if (i == 63) sAE[d] = eb;
                }
                *(uint2*)(KiT + d * GL_LD + 16 * rt + fq * 4) = make_uint2(pack2(kiv[0], kiv[1]), pack2(kiv[2], kiv[3]));
            }
        }
        LBAR();
        f4v oacc[4];
        {
            f4v sc[2];
            sc[0] = (f4v){0.f, 0.f, 0.f, 0.f}; sc[1] = sc[0];
#pragma unroll
            for (int ct = 0; ct < 4; ++ct) oacc[ct] = (f4v){0.f, 0.f, 0.f, 0.f};
#pragma unroll
            for (int ks = 0; ks < 2; ++ks) {
                const s8v a = *(const s8v*)(Qd + (16 * rt + fr) * GL_LD + 32 * ks + 8 * fq);
#pragma unroll
                for (int c2 = 0; c2 < 2; ++c2) sc[c2] = mfma16(a, *(const s8v*)(Ki + (16 * (2 * chf + c2) + fr) * GL_LD + 32 * ks + 8 * fq), sc[c2]);
#pragma unroll
                for (int ct = 0; ct < 4; ++ct) oacc[ct] = mfma16(*(const s8v*)(St + (64 * chf + 16 * ct + fr) * GL_LD + 32 * ks + 8 * fq), a, oacc[ct]);
            }
#pragma unroll
            for (int c2 = 0; c2 < 2; ++c2)
#pragma unroll
                for (int r = 0; r < 4; ++r) { const int i = 16 * rt + fq * 4 + r, j = 16 * (2 * chf + c2) + fr; Sc[i * GL_LD + j] = f2bf(j <= i ? sc[c2][r] : 0.f); }
        }
        LBAR();
        {
#pragma unroll
            for (int ks = 0; ks < 2; ++ks) {
                const s8v a = *(const s8v*)(Sc + (16 * rt + fr) * GL_LD + 32 * ks + 8 * fq);
                const s8v kt = *(const s8v*)(KiT + (16 * rt + fr) * GL_LD + 32 * ks + 8 * fq);
#pragma unroll
                for (int ct = 0; ct < 4; ++ct) {
                    const s8v bv = *(const s8v*)(VT + (64 * chf + 16 * ct + fr) * GL_LD + 32 * ks + 8 * fq);
                    oacc[ct] = mfma16(bv, a, oacc[ct]); Sacc[ct] = mfma16(kt, bv, Sacc[ct]);
                }
            }
            {
                const int i = 16 * rt + fr, t = tb + (dir ? 63 - i : i);
                if (dir == 0) {
#pragma unroll
                    for (int ct = 0; ct < 4; ++ct) *(uint2*)(opart + (size_t)t * 512 + h * 128 + 64 * chf + 16 * ct + fq * 4) = pack4(oacc[ct]);
                } else {
#pragma unroll
                    for (int ct = 0; ct < 4; ++ct) *(f4v*)(Of + i * 132 + 64 * chf + 16 * ct + fq * 4) = oacc[ct];
                }
            }
            float ae[4];
#pragma unroll
            for (int r = 0; r < 4; ++r) ae[r] = sAE[16 * rt + fq * 4 + r];
#pragma unroll
            for (int ct = 0; ct < 4; ++ct) {
#pragma unroll
                for (int r = 0; r < 4; ++r) Sacc[ct][r] *= ae[r];
                *(uint2*)(St + (64 * chf + 16 * ct + fr) * GL_LD + 16 * rt + fq * 4) = make_uint2(pack2(Sacc[ct][0], Sacc[ct][1]), pack2(Sacc[ct][2], Sacc[ct][3]));
            }
        }
        LBAR();
        if (dir == 1) {
            const int i = tid >> 3, d0 = (tid & 7) * 16, t = tb + 63 - i;
            const bf16* ofp = opart + (size_t)t * 512 + h * 128 + d0;
            const bf16* zap = proj + (size_t)t * EW + E_ZA + h * 128 + d0;
            const f8v o0 = *(const f8v*)(Of + i * 132 + d0) + unpack8v(*(const uint4*)ofp), o1 = *(const f8v*)(Of + i * 132 + d0 + 8) + unpack8v(*(const uint4*)(ofp + 8));
            float ss = 0.f;
#pragma unroll
            for (int j = 0; j < 8; ++j) ss += o0[j] * o0[j] + o1[j] * o1[j];
            const float r = frsq(red8(ss) * (1.0f / 128.f) + EPS);
            const float* gn = p.in[I_GLAN] + ei * 128 + d0;
            const f8v z0 = unpack8v(*(const uint4*)zap), z1 = unpack8v(*(const uint4*)(zap + 8));
            f8v y0, y1;
#pragma unroll
            for (int j = 0; j < 8; ++j) { y0[j] = o0[j] * r * gn[j] * siluf_(z0[j]); y1[j] = o1[j] * r * gn[8 + j] * siluf_(z1[j]); }
            bf16* yc = (bf16*)(p.ws + WS_YCE) + (size_t)t * D + h * 128 + d0;
            *(uint4*)yc = pack8v(y0); *(uint4*)(yc + 8) = pack8v(y1);
        }
    }
    if (!sq_.lat) {
        float* fs = p.out + OUT_GLA + ((((size_t)sq_.b * N_EVEN + ei) * 2 + dir) * 4 + h) * 64 * 128;
#pragma unroll
        for (int ct = 0; ct < 4; ++ct)
#pragma unroll
            for (int r = 0; r < 4; ++r) fs[(16 * rt + fq * 4 + r) * 128 + 64 * chf + 16 * ct + fr] = Sacc[ct][r];
    }
}

#ifndef RW_PREFETCH
#define RW_PREFETCH 1
#endif
constexpr int RW_LD = 72;
constexpr int RWKV_PREP_ITEMS = (T / 64) * 8;
struct RwPre { uint4 x[5], l[5], r[5]; };
__device__ __forceinline__ void rwkv_prefetch(const P& p, int w, int dir, int tid, RwPre& q) {
    const int cg = w >> 3, h = w & 7, hc0 = h * 64;
    const int i = tid >> 3, c8 = (tid & 7) * 8, t = cg * 64 + (dir ? 63 - i : i);
    bool hl, hr; tok_nbr(t, hl, hr);
    const bf16* proj = (const bf16*)(p.ws + WS_PROJ);
#pragma unroll
    for (int grp = 0; grp < 5; ++grp) {
        const int col = (grp == 0 ? FB_R + hc0 : grp == 1 ? FB_K + hc0 : grp == 2 ? FB_V + hc0 : grp == 3 ? FB_WD + dir * 64 : FB_AD + dir * 64) + c8;
        const bf16* pr = proj + (size_t)t * EW + E_FB + col;
        q.x[grp] = *(const uint4*)pr;
        q.l[grp] = hl ? *(const uint4*)(pr - EW) : make_uint4(0u, 0u, 0u, 0u);
        q.r[grp] = hr ? *(const uint4*)(pr + EW) : make_uint4(0u, 0u, 0u, 0u);
    }
}
__device__ __forceinline__ void rwkv_prep_phase(const P& p, int ei, int dir, int w_first, int w_stride, int w_end, unsigned char* dsm) {
    float* sCS = (float*)dsm;
    float* sKK = sCS + 4096;
    float* sB = sKK + 4096;
    float* sKM = sB + 4096;
    float* sR = sKM + 4096;
    float* sAf = (float*)dsm;
    float* sXf = sAf + 64 * TI_LD;
    float* sTmp = sXf + 64 * TI_LD;
    bf16* AakT = (bf16*)(sTmp + 8 * 16 * TI_TLD);
    bf16* Brb = AakT + 64 * RW_LD;
    bf16* Tm = Brb + 64 * RW_LD;
    bf16* PT = (bf16*)dsm;
    bf16* W1T = PT + 64 * RW_LD;
    static_assert(2 * 64 * TI_LD * 4 + 8 * 16 * TI_TLD * 4 + 3 * 64 * RW_LD * 2 <= 81920, "RWKV prep overlays exceed region A");
    bf16* At = (bf16*)(dsm + 81920);
    bf16* Bt = At + 64 * RW_LD;
    bf16* Kt = Bt + 64 * RW_LD;
    bf16* Rt = Kt + 64 * RW_LD;
    bf16* BhT = Rt + 64 * RW_LD;
    bf16* KhT = BhT + 64 * RW_LD;
    bf16* AtT = KhT + 64 * RW_LD;
    bf16* sTW = At;
    bf16* sAD = Bt;
    float* sSeg = (float*)(AtT + 64 * RW_LD);
    float* sMix = sSeg + 512;
    float* sKw = sMix + 320;
    const int tid0 = opaque_tid();
    float* bonus = (float*)(p.ws + WS_BONUS);
    const float* mix = p.in[I_MIX] + (size_t)ei * 1792;
    int hcur = -1;
    s8v lrf[4][2];
    float lrb[4];
    RwPre pre;
#if RW_PREFETCH
    if (w_first < w_end) rwkv_prefetch(p, w_first, dir, tid0, pre);
#endif
    for (int w = w_first; w < w_end; w += w_stride) {
        const int tid = opaque_tid(), lane = tid & 63, wid = tid >> 6, fr = lane & 15, fq = lane >> 4;
        const int rt = wid & 3, cb = 2 * (wid >> 2), which = wid >> 2;
        const int cg = w >> 3, h = w & 7, hc0 = h * 64;
        const size_t tk = (size_t)cg * 8 + h;
        PT_B(1);
        if (h != hcur) {
            hcur = h;
            LBAR();
            const float* w2 = p.in[I_W2] + (size_t)(ei * 2 + dir) * 64 * 512 + hc0; const float* a2 = p.in[I_A2] + (size_t)(ei * 2 + dir) * 64 * 512 + hc0;
            {
                float wv[8], av[8];
#pragma unroll
                for (int u = 0; u < 8; ++u) { const int e = tid + u * 512, r = e >> 6, c = e & 63; wv[u] = w2[(size_t)r * 512 + c]; av[u] = a2[(size_t)r * 512 + c]; }
#pragma unroll
                for (int u = 0; u < 8; ++u) { const int e = tid + u * 512, r = e >> 6, c = e & 63; Kt[c * RW_LD + r] = f2bf(wv[u]); Rt[c * RW_LD + r] = f2bf(av[u]); }
                if (tid < 320) { const int grp = tid >> 6, c = tid & 63; sMix[tid] = mix[(grp == 0 ? FB_R + hc0 : grp == 1 ? FB_K + hc0 : grp == 2 ? FB_V + hc0 : grp == 3 ? FB_WD + dir * 64 : FB_AD + dir * 64) + c]; }
                else if (tid < 512) { const int e = tid - 320, which3 = e >> 6, c = e & 63; sKw[e] = ((which3 == 0 ? p.in[I_KK] : which3 == 1 ? p.in[I_KA] : p.in[I_RK]) + (size_t)ei * 512 + hc0)[c]; }
            }
            LBAR();
            const bf16* src = which ? Rt : Kt;
            const float* lb = (which ? p.in[I_A0] : p.in[I_W0]) + (size_t)(ei * 2 + dir) * 512 + hc0;
#pragma unroll
            for (int ct = 0; ct < 4; ++ct) {
                lrb[ct] = lb[16 * ct + fr];
#pragma unroll
                for (int ks = 0; ks < 2; ++ks) lrf[ct][ks] = *(const s8v*)(src + (16 * ct + fr) * RW_LD + ks * 32 + fq * 8);
            }
        }
        LBAR();
        PT_E(1); PT_B(2);
#if !RW_PREFETCH
        rwkv_prefetch(p, w, dir, tid, pre);
#endif
        {
            const int i = tid >> 3, c8 = (tid & 7) * 8, t = cg * 64 + (dir ? 63 - i : i);
#pragma unroll
            for (int grp = 0; grp < 5; ++grp) {
                const int col = (grp == 0 ? FB_R + hc0 : grp == 1 ? FB_K + hc0 : grp == 2 ? FB_V + hc0 : grp == 3 ? FB_WD + dir * 64 : FB_AD + dir * 64) + c8;
                const f8v x = unpack8v(pre.x[grp]);
                const f8v nb = unpack8v(pre.l[grp]) + unpack8v(pre.r[grp]);
                const f8v mv = *(const f8v*)(sMix + grp * 64 + c8);
                f8v y = x + mv * (nb * 0.5f - x);
                if (grp == 0) *(f8v*)(sR + i * 64 + c8) = y;
                else if (grp == 1) *(f8v*)(sKM + i * 64 + c8) = y;
                else if (grp == 2) { if (dir == 0) *(uint4*)((bf16*)(p.ws + WS_VSH) + (size_t)t * 512 + hc0 + c8) = pack8v(y); }
                else {
                    if (grp == 3) {
#pragma unroll
                        for (int j = 0; j < 8; ++j) y[j] = ftanh(y[j]);
                    }
                    *(uint4*)((grp == 3 ? sTW : sAD) + i * RW_LD + c8) = pack8v(y);
                }
            }
        }
#if RW_PREFETCH
        if (w + w_stride < w_end) rwkv_prefetch(p, w + w_stride, dir, tid, pre);
#endif
        LBAR();
        PT_E(2); PT_B(3);
        {
            const bf16* Am = which ? sAD : sTW;
            f4v acc[4];
#pragma unroll
            for (int ct = 0; ct < 4; ++ct) acc[ct] = (f4v){0.f, 0.f, 0.f, 0.f};
#pragma unroll
            for (int ks = 0; ks < 2; ++ks) {
                const s8v a = *(const s8v*)(Am + (16 * rt + fr) * RW_LD + ks * 32 + fq * 8);
#pragma unroll
                for (int ct = 0; ct < 4; ++ct) acc[ct] = mfma16(a, lrf[ct][ks], acc[ct]);
            }
#pragma unroll
            for (int ct = 0; ct < 4; ++ct) {
                const int c = 16 * ct + fr;
#pragma unroll
                for (int r = 0; r < 4; ++r) {
                    const int tok = 16 * rt + fq * 4 + r;
                    const float sg = sigmoidf_(lrb[ct] + acc[ct][r]);
                    if (which) sB[tok * 64 + c] = sg; else sCS[tok * 64 + c] = -0.6065306597126334f * sg;
                }
            }
        }
        LBAR();
        PT_E(3); PT_B(4);
        {
            const int i = tid >> 3, c8 = (tid & 7) * 8;
            const f8v av = *(const f8v*)(sB + i * 64 + c8), kr = *(const f8v*)(sKM + i * 64 + c8), rv = *(const f8v*)(sR + i * 64 + c8);
            const f8v kkv = *(const f8v*)(sKw + c8), kav = *(const f8v*)(sKw + 64 + c8), rkv = *(const f8v*)(sKw + 128 + c8);
            const f8v km = kr * (1.0f + (av - 1.0f) * kav);
            f8v kk = kr * kkv;
            float ss = 0.f, bn = 0.f;
#pragma unroll
            for (int j = 0; j < 8; ++j) { ss += kk[j] * kk[j]; bn += rv[j] * km[j] * rkv[j]; }
            ss = red8(ss); bn = red8(bn);
            kk *= frsq(ss + EPS);
            *(f8v*)(sKK + i * 64 + c8) = kk; *(f8v*)(sB + i * 64 + c8) = kk * av; *(f8v*)(sKM + i * 64 + c8) = km;
            if ((tid & 7) == 0) { const int t = cg * 64 + (dir ? 63 - i : i); bonus[((size_t)t * 8 + h) * 2 + dir] = bn; }
        }
        {
            const int c = tid & 63, sg = tid >> 6;
            float run = 0.f;
#pragma unroll
            for (int j = 0; j < 8; ++j) { run += sCS[(8 * sg + j) * 64 + c]; sCS[(8 * sg + j) * 64 + c] = run; }
            sSeg[sg * 64 + c] = run;
        }
        LBAR();
        PT_E(4); PT_B(5);
        {
            const int c = tid & 63, sg = tid >> 6;
            float off = 0.f;
            for (int q = 0; q < sg; ++q) off += sSeg[q * 64 + c];
#pragma unroll
            for (int j = 0; j < 8; ++j) sCS[(8 * sg + j) * 64 + c] += off;
        }
        LBAR();
        PT_E(5); PT_B(6);
        {
            const int i = tid >> 3, c8 = (tid & 7) * 8;
            const f8v cs = *(const f8v*)(sCS + i * 64 + c8), cl = *(const f8v*)(sCS + 63 * 64 + c8);
            f8v cp = (f8v)(0.f);
            if (i > 0) cp = *(const f8v*)(sCS + (i - 1) * 64 + c8);
            const f8v kk = *(const f8v*)(sKK + i * 64 + c8), bb = *(const f8v*)(sB + i * 64 + c8), km = *(const f8v*)(sKM + i * 64 + c8), rv = *(const f8v*)(sR + i * 64 + c8);
            f8v at, bt, kt, rtv;
#pragma unroll
            for (int j = 0; j < 8; ++j) {
                const float g = fexp(cs[j]), gi = frcp(g), gp = fexp(cp[j]), gc = fexp(cl[j]) * gi;
                at[j] = -kk[j] * gp; bt[j] = bb[j] * gi; kt[j] = km[j] * gi; rtv[j] = rv[j] * g;
                BhT[(c8 + j) * RW_LD + i] = f2bf(bb[j] * gc); KhT[(c8 + j) * RW_LD + i] = f2bf(km[j] * gc); AtT[(c8 + j) * RW_LD + i] = f2bf(at[j]);
            }
            *(uint4*)(At + i * RW_LD + c8) = pack8v(at); *(uint4*)(Bt + i * RW_LD + c8) = pack8v(bt);
            *(uint4*)(Kt + i * RW_LD + c8) = pack8v(kt); *(uint4*)(Rt + i * RW_LD + c8) = pack8v(rtv);
            if (i == 63) {
                float* gco = (float*)(p.ws + WS_GC) + tk * 64 + c8;
#pragma unroll
                for (int j = 0; j < 8; ++j) gco[j] = fexp(cl[j]);
            }
        }
        LBAR();
        PT_E(6); PT_B(7);
        f4v brkT[2];
        {
            f4v aab[2], aak[2], brb[2];
#pragma unroll
            for (int c2 = 0; c2 < 2; ++c2) { aab[c2] = (f4v){0.f, 0.f, 0.f, 0.f}; aak[c2] = aab[c2]; brb[c2] = aab[c2]; brkT[c2] = aab[c2]; }
#pragma unroll
            for (int ks = 0; ks < 2; ++ks) {
                const int ko = ks * 32 + fq * 8, ra = (16 * rt + fr) * RW_LD + ko;
                const s8v fa = *(const s8v*)(At + ra), frr = *(const s8v*)(Rt + ra), fk = *(const s8v*)(Kt + ra);
#pragma unroll
                for (int c2 = 0; c2 < 2; ++c2) {
                    const int ro = (16 * (cb + c2) + fr) * RW_LD + ko;
                    const s8v gb = *(const s8v*)(Bt + ro), gk = *(const s8v*)(Kt + ro), gr = *(const s8v*)(Rt + ro);
                    aab[c2] = mfma16(fa, gb, aab[c2]); aak[c2] = mfma16(fa, gk, aak[c2]); brb[c2] = mfma16(frr, gb, brb[c2]);
                    brkT[c2] = mfma16(fk, gr, brkT[c2]);
                }
            }
#pragma unroll
            for (int c2 = 0; c2 < 2; ++c2) {
                const int col = 16 * (cb + c2) + fr, r0 = 16 * rt + fq * 4;
                f4v ak;
#pragma unroll
                for (int r = 0; r < 4; ++r) {
                    const int row = r0 + r;
                    sAf[row * TI_LD + col] = col < row ? -aab[c2][r] : 0.f;
                    ak[r] = col < row ? aak[c2][r] : 0.f;
                    Brb[row * RW_LD + col] = f2bf(col <= row ? brb[c2][r] : 0.f);
                    if (!(row <= col)) brkT[c2][r] = 0.f;
                }
                *(uint2*)(AakT + col * RW_LD + r0) = pack4(ak);
            }
        }
        LBAR();
        PT_E(7); PT_B(8);
        tri_inv64(sAf, sXf, sTmp, wid & 3, lane, wid < 4);
        { const int i = tid >> 3, c8 = (tid & 7) * 8; *(uint4*)(Tm + i * RW_LD + c8) = pack8v(*(const f8v*)(sXf + i * TI_LD + c8)); }
        LBAR();
        PT_E(8); PT_B(9);
        {
            f4v pp[2], ww[2];
#pragma unroll
            for (int c2 = 0; c2 < 2; ++c2) { pp[c2] = (f4v){0.f, 0.f, 0.f, 0.f}; ww[c2] = pp[c2]; }
#pragma unroll
            for (int ks = 0; ks < 2; ++ks) {
                const int ko = ks * 32 + fq * 8;
                const s8v ft = *(const s8v*)(Tm + (16 * rt + fr) * RW_LD + ko);
#pragma unroll
                for (int c2 = 0; c2 < 2; ++c2) {
                    const int ro = (16 * (cb + c2) + fr) * RW_LD + ko;
                    pp[c2] = mfma16(ft, *(const s8v*)(AtT + ro), pp[c2]); ww[c2] = mfma16(ft, *(const s8v*)(AakT + ro), ww[c2]);
                }
            }
#pragma unroll
            for (int c2 = 0; c2 < 2; ++c2) {
                const int col = 16 * (cb + c2) + fr;
                *(uint2*)(PT + col * RW_LD + 16 * rt + fq * 4) = pack4(pp[c2]);
                *(uint2*)(W1T + col * RW_LD + 16 * rt + fq * 4) = pack4(ww[c2]);
            }
        }
        LBAR();
        PT_E(9); PT_B(10);
        {
            bf16* m12 = (bf16*)(p.ws + WS_RM12) + tk * 8192; bf16* m34 = (bf16*)(p.ws + WS_RM34) + tk * 8192;
#pragma unroll
            for (int c2 = 0; c2 < 2; ++c2) {
                const int col = 16 * (cb + c2) + fr, r0 = 16 * rt + fq * 4;
                f4v m1 = unpack4(*(const uint2*)(Rt + col * RW_LD + r0));
                f4v m2 = brkT[c2], m3 = (f4v){0.f, 0.f, 0.f, 0.f};
                f4v m4 = unpack4(*(const uint2*)(KhT + col * RW_LD + r0));
#pragma unroll
                for (int ks = 0; ks < 2; ++ks) {
                    const int ko = ks * 32 + fq * 8;
                    const s8v fp = *(const s8v*)(PT + (16 * rt + fr) * RW_LD + ko), fw = *(const s8v*)(W1T + (16 * rt + fr) * RW_LD + ko);
                    const s8v gb = *(const s8v*)(Brb + col * RW_LD + ko), gh = *(const s8v*)(BhT + col * RW_LD + ko);
                    m1 = mfma16(fp, gb, m1);
                    m2 = mfma16(fw, gb, m2);
                    m3 = mfma16(fp, gh, m3);
                    m4 = mfma16(fw, gh, m4);
                }
                *(uint2*)(m12 + col * 64 + r0) = pack4(m1);
                *(uint2*)(m12 + 4096 + col * 64 + r0) = pack4(m2);
                *(uint2*)(m34 + col * 64 + r0) = pack4(m3);
                *(uint2*)(m34 + 4096 + col * 64 + r0) = pack4(m4);
            }
        }
        PT_E(10);
    }
}
__device__ __forceinline__ void rwkv_apply_task(const P& p, int ei, int s, int h, int dir, unsigned char* dsm) {
    bf16* St = (bf16*)dsm;
    bf16* VT = St + 64 * RW_LD;
    bf16* M1 = VT + 64 * RW_LD;
    bf16* M2 = M1 + 64 * RW_LD;
    bf16* M3 = M2 + 64 * RW_LD;
    bf16* M4 = M3 + 64 * RW_LD;
    float* sGC = (float*)(M4 + 64 * RW_LD);
    float* Yf = sGC + 64;
    const Seq sq_ = get_seq(s);
    const int tid = opaque_tid(), lane = tid & 63, wid = tid >> 6, fr = lane & 15, fq = lane >> 4;
    const int rt = wid & 3, cb = 2 * (wid >> 2), hc0 = h * 64;
    bf16* opart = (bf16*)(p.ws + WS_PART + PART_SZ);
    f4v Sacc[2];
    LBAR();
#pragma unroll
    for (int c2 = 0; c2 < 2; ++c2) {
        const int v = 16 * (cb + c2) + fr, k0 = 16 * rt + fq * 4;
        if (sq_.lat) Sacc[c2] = *(const f4v*)(p.in[I_SRWKV] + ((((size_t)sq_.b * N_EVEN + ei) * 2 + dir) * 8 + h) * 4096 + v * 64 + k0);
        else Sacc[c2] = (f4v){0.f, 0.f, 0.f, 0.f};
        *(uint2*)(St + v * RW_LD + k0) = make_uint2(pack2(Sacc[c2][0], Sacc[c2][1]), pack2(Sacc[c2][2], Sacc[c2][3]));
    }
    const int nch = sq_.len >> 6;
    uint4 pm0, pm1, pm2, pm3, pvv; float pgc = 0.f;
    {
        const int cg0 = (sq_.start >> 6) + (dir ? nch - 1 : 0); const size_t tk0 = (size_t)cg0 * 8 + h;
        const int i = tid >> 3, c8 = (tid & 7) * 8;
        const bf16* m12 = (const bf16*)(p.ws + WS_RM12) + tk0 * 8192; const bf16* m34 = (const bf16*)(p.ws + WS_RM34) + tk0 * 8192;
        pm0 = *(const uint4*)(m12 + i * 64 + c8); pm1 = *(const uint4*)(m12 + 4096 + i * 64 + c8); pm2 = *(const uint4*)(m34 + i * 64 + c8); pm3 = *(const uint4*)(m34 + 4096 + i * 64 + c8);
        pvv = *(const uint4*)((const bf16*)(p.ws + WS_VSH) + (size_t)(cg0 * 64 + (dir ? 63 - lane : lane)) * 512 + hc0 + wid * 8);
        if (tid < 64) pgc = ((const float*)(p.ws + WS_GC))[tk0 * 64 + tid];
    }
    for (int cc = 0; cc < nch; ++cc) {
        const int cg = (sq_.start >> 6) + (dir ? nch - 1 - cc : cc);
        {
            const int i = tid >> 3, c8 = (tid & 7) * 8;
            *(uint4*)(M1 + i * RW_LD + c8) = pm0; *(uint4*)(M2 + i * RW_LD + c8) = pm1; *(uint4*)(M3 + i * RW_LD + c8) = pm2; *(uint4*)(M4 + i * RW_LD + c8) = pm3;
            const f8v vv = unpack8v(pvv);
#pragma unroll
            for (int j = 0; j < 8; ++j) VT[(wid * 8 + j) * RW_LD + lane] = f2bf(vv[j]);
            if (tid < 64) sGC[tid] = pgc;
            if (cc + 1 < nch) {
                const int cgn = (sq_.start >> 6) + (dir ? nch - 2 - cc : cc + 1); const size_t tkn = (size_t)cgn * 8 + h;
                const bf16* m12 = (const bf16*)(p.ws + WS_RM12) + tkn * 8192; const bf16* m34 = (const bf16*)(p.ws + WS_RM34) + tkn * 8192;
                pm0 = *(const uint4*)(m12 + i * 64 + c8); pm1 = *(const uint4*)(m12 + 4096 + i * 64 + c8); pm2 = *(const uint4*)(m34 + i * 64 + c8); pm3 = *(const uint4*)(m34 + 4096 + i * 64 + c8);
                pvv = *(const uint4*)((const bf16*)(p.ws + WS_VSH) + (size_t)(cgn * 64 + (dir ? 63 - lane : lane)) * 512 + hc0 + wid * 8);
                if (tid < 64) pgc = ((const float*)(p.ws + WS_GC))[tkn * 64 + tid];
            }
        }
        LBAR();
        {
            f4v yT[2], sn[2];
#pragma unroll
            for (int c2 = 0; c2 < 2; ++c2) { yT[c2] = (f4v){0.f, 0.f, 0.f, 0.f}; sn[c2] = yT[c2]; }
#pragma unroll
            for (int ks = 0; ks < 2; ++ks) {
                const int ko = ks * 32 + fq * 8;
                const s8v fs = *(const s8v*)(St + (16 * rt + fr) * RW_LD + ko), fv = *(const s8v*)(VT + (16 * rt + fr) * RW_LD + ko);
                const s8v f3 = *(const s8v*)(M3 + (16 * rt + fr) * RW_LD + ko), f4 = *(const s8v*)(M4 + (16 * rt + fr) * RW_LD + ko);
#pragma unroll
                for (int c2 = 0; c2 < 2; ++c2) {
                    const int ro = (16 * (cb + c2) + fr) * RW_LD + ko;
                    yT[c2] = mfma16(fs, *(const s8v*)(M1 + ro), yT[c2]); yT[c2] = mfma16(fv, *(const s8v*)(M2 + ro), yT[c2]);
                    sn[c2] = mfma16(f3, *(const s8v*)(St + ro), sn[c2]); sn[c2] = mfma16(f4, *(const s8v*)(VT + ro), sn[c2]);
                }
            }
            float gc[4];
#pragma unroll
            for (int r = 0; r < 4; ++r) gc[r] = sGC[16 * rt + fq * 4 + r];
#pragma unroll
            for (int c2 = 0; c2 < 2; ++c2) {
                const int tt = 16 * (cb + c2) + fr, t = cg * 64 + (dir ? 63 - tt : tt);
                if (dir == 0) *(uint2*)(opart + (size_t)t * 512 + hc0 + 16 * rt + fq * 4) = make_uint2(pack2(yT[c2][0], yT[c2][1]), pack2(yT[c2][2], yT[c2][3]));
                else *(f4v*)(Yf + tt * 68 + 16 * rt + fq * 4) = yT[c2];
#pragma unroll
                for (int r = 0; r < 4; ++r) Sacc[c2][r] = Sacc[c2][r] * gc[r] + sn[c2][r];
            }
        }
        LBAR();
#pragma unroll
        for (int c2 = 0; c2 < 2; ++c2) *(uint2*)(St + (16 * (cb + c2) + fr) * RW_LD + 16 * rt + fq * 4) = make_uint2(pack2(Sacc[c2][0], Sacc[c2][1]), pack2(Sacc[c2][2], Sacc[c2][3]));
        if (dir == 1) {
            const int i = tid >> 3, c8 = (tid & 7) * 8, t = cg * 64 + 63 - i;
            f8v o = *(const f8v*)(Yf + i * 68 + c8) + unpack8v(*(const uint4*)(opart + (size_t)t * 512 + hc0 + c8));
            float mu = 0.f;
#pragma unroll
            for (int j = 0; j < 8; ++j) mu += o[j];
            mu = red8(mu) * (1.0f / 64.f);
            o -= mu;
            float var = 0.f;
#pragma unroll
            for (int j = 0; j < 8; ++j) var += o[j] * o[j];
            const float r = frsq(red8(var) * (1.0f / 64.f) + 64e-5f);
            const float* bn = (const float*)(p.ws + WS_BONUS) + ((size_t)t * 8 + h) * 2;
            const float bsum = bn[0] + bn[1];
            const f8v vsh = unpack8v(*(const uint4*)((const bf16*)(p.ws + WS_VSH) + (size_t)t * 512 + hc0 + c8));
            const f8v zb = unpack8v(*(const uint4*)((const bf16*)(p.ws + WS_PROJ) + (size_t)t * EW + E_ZB + hc0 + c8));
            const f8v lg = *(const f8v*)(p.in[I_LNG] + ei * 512 + hc0 + c8), lb = *(const f8v*)(p.in[I_LNB] + ei * 512 + hc0 + c8);
            f8v y;
#pragma unroll
            for (int j = 0; j < 8; ++j) y[j] = (o[j] * r * lg[j] + lb[j] + bsum * vsh[j]) * siluf_(zb[j]);
            *(uint4*)((bf16*)(p.ws + WS_YCE) + (size_t)t * D + 512 + hc0 + c8) = pack8v(y);
        }
    }
    if (!sq_.lat) {
#pragma unroll
        for (int c2 = 0; c2 < 2; ++c2)
            *(f4v*)(p.out + OUT_RWKV + ((((size_t)sq_.b * N_EVEN + ei) * 2 + dir) * 8 + h) * 4096 + (16 * (cb + c2) + fr) * 64 + 16 * rt + fq * 4) = Sacc[c2];
    }
}
constexpr int EV_AP_LAT = NB_LAT * 8, EV_AP_CTX = NB_CTX * 8, EV_GLA_LAT = NB_LAT * 4, EV_GLA_CTX = NB_CTX * 4;
constexpr int EVEN_SCAN_ITEMS = EV_AP_LAT + EV_GLA_LAT + EV_AP_CTX + EV_GLA_CTX;
__device__ __forceinline__ void ph_even_scan_item(const P& p, int w, int ei, int dir, unsigned char* dsm) {
    int kind, sbase, x;
    if (w < EV_AP_LAT) { kind = 0; sbase = NB_CTX; x = w; }
    else if (w < EV_AP_LAT + EV_GLA_LAT) { kind = 1; sbase = NB_CTX; x = w - EV_AP_LAT; }
    else if (w < EV_AP_LAT + EV_GLA_LAT + EV_AP_CTX) { kind = 0; sbase = 0; x = w - EV_AP_LAT - EV_GLA_LAT; }
    else { kind = 1; sbase = 0; x = w - EV_AP_LAT - EV_GLA_LAT - EV_AP_CTX; }
    if (kind == 0) rwkv_apply_task(p, ei, sbase + x / 8, x & 7, dir, dsm);
    else gla_scan_task(p, ei, sbase + x / 4, x & 3, dir, dsm);
}

__device__ __forceinline__ void ph_fin_even(const P& p, int bid, int ei) {
    const int lane = LT & 63, t = bid * 4 + (LT >> 6);
    if (t >= T) return;
    const bf16* pr = (const bf16*)(p.ws + WS_PROJ) + (size_t)t * EW;
    const bf16* oaf = (const bf16*)(p.ws + WS_PART) + (size_t)t * 512;
    const bf16* oab = (const bf16*)(p.ws + WS_PART + PART_SZ) + (size_t)t * 512;
    const bf16* obf = (const bf16*)(p.ws + WS_PART + 2 * PART_SZ) + (size_t)t * 512;
    const bf16* obb = (const bf16*)(p.ws + WS_PART + 3 * PART_SZ) + (size_t)t * 512;
    bf16* yc = (bf16*)(p.ws + WS_HM) + (size_t)t * D;
    const int idx = lane * 8;
    {
        float o[8], ss = 0.f;
#pragma unroll
        for (int j = 0; j < 8; ++j) { o[j] = bf2f(oaf[idx + j]) + bf2f(oab[idx + j]); ss += o[j] * o[j]; }
        ss += __shfl_xor(ss, 1); ss += __shfl_xor(ss, 2); ss += __shfl_xor(ss, 4); ss += __shfl_xor(ss, 8);
        const float r = frsq(ss * (1.0f / 128.f) + EPS);
        const float* gn = p.in[I_GLAN] + ei * 128 + (idx & 127);
#pragma unroll
        for (int j = 0; j < 8; ++j) yc[idx + j] = f2bf(o[j] * r * gn[j] * siluf_(bf2f(pr[E_ZA + idx + j])));
    }
    {
        float o[8], mu = 0.f;
#pragma unroll
        for (int j = 0; j < 8; ++j) { o[j] = bf2f(obf[idx + j]) + bf2f(obb[idx + j]); mu += o[j]; }
        mu += __shfl_xor(mu, 1); mu += __shfl_xor(mu, 2); mu += __shfl_xor(mu, 4);
        mu *= (1.0f / 64.f);
        float var = 0.f;
#pragma unroll
        for (int j = 0; j < 8; ++j) { o[j] -= mu; var += o[j] * o[j]; }
        var += __shfl_xor(var, 1); var += __shfl_xor(var, 2); var += __shfl_xor(var, 4);
        const float r = frsq(var * (1.0f / 64.f) + 64e-5f);
        const int h = idx >> 6;
        const float* bn = (const float*)(p.ws + WS_BONUS) + ((size_t)t * 8 + h) * 2;
        const float bsum = bn[0] + bn[1];
        bool hl, hr; tok_nbr(t, hl, hr);
        const float* mix = p.in[I_MIX] + (size_t)ei * 1792 + FB_V + idx;
        const float* lg = p.in[I_LNG] + ei * 512 + idx;
        const float* lb = p.in[I_LNB] + ei * 512 + idx;
#pragma unroll
        for (int j = 0; j < 8; ++j) {
            const bf16* pv = pr + E_FB + FB_V + idx + j;
            const float x = bf2f(pv[0]);
            const float nl = hl ? bf2f(pv[-EW]) : 0.f, nr = hr ? bf2f(pv[EW]) : 0.f;
            const float vsh = x + mix[j] * (0.5f * (nl + nr) - x);
            yc[512 + idx + j] = f2bf((o[j] * r * lg[j] + lb[j] + bsum * vsh) * siluf_(bf2f(pr[E_ZB + idx + j])));
        }
    }
}

constexpr int ODD_PREP_ITEMS = (T / 64) * 4;
constexpr int PQ_LD = 136;
__device__ __forceinline__ void ph_odd_prep(const P& p, int item, int oi, unsigned char* dsm) {
    bf16* sq = (bf16*)dsm;
    bf16* sk = sq + 64 * PQ_LD;
    float* sA = (float*)(dsm + 2 * 64 * PQ_LD * 2);
    float* sX = sA + 2 * 64 * TI_LD;
    float* sTm = sX + 2 * 64 * TI_LD;
    float* slg = sTm + 2 * 8 * 16 * TI_TLD;
    float* sbt = slg + 128;
    float* sgc = sbt + 128;
    float* sbp = sgc + 128;
    const int tid = opaque_tid(), lane = tid & 63, wid = tid >> 6;
    const int cg = item >> 2, h = item & 3;
    const bf16* proj = (const bf16*)(p.ws + WS_PROJ);
    const float* cw = p.in[I_CONV] + (size_t)oi * 9 * 1536;
    LBAR();
    if (wid < 6) {
        const int part = wid >> 1, oc = lane & 15, i0 = ((wid & 1) * 4 + (lane >> 4)) * 8, t0 = cg * 64;
        const bool lat = t0 >= T_CTX;
        int pos0, len;
        if (!lat) { pos0 = t0 % L_CTX; len = L_CTX; } else { pos0 = (t0 - T_CTX) % L_LAT; len = L_LAT; }
        const int gr = pos0 >> 6, nrows = len >> 6;
        const int ch = part * 512 + h * 128 + oc * 8;
        const bool okl = i0 > 0 || (!lat && pos0 > 0), okr = i0 < 56 || (!lat && pos0 + 64 < len);
        f8v acc[8];
#pragma unroll
        for (int j = 0; j < 8; ++j) acc[j] = (f8v)(0.f);
#pragma unroll
        for (int di = -1; di <= 1; ++di) {
            const bool rv = lat ? (gr + di >= 0 && gr + di < nrows) : (di == 0);
            if (rv) {
                const float* w = cw + ((di + 1) * 3) * 1536 + ch;
                const f8v w0 = *(const f8v*)w, w1 = *(const f8v*)(w + 1536), w2 = *(const f8v*)(w + 3072);
                const bf16* src = proj + (size_t)(t0 + di * 64 + i0) * OW + O_QKV + ch;
                uint4 x[10];
                x[0] = *(const uint4*)(okl ? src - OW : src);
#pragma unroll
                for (int c = 0; c < 8; ++c) x[c + 1] = *(const uint4*)(src + (size_t)c * OW);
                x[9] = *(const uint4*)(okr ? src + (size_t)8 * OW : src);
                if (!okl) x[0] = make_uint4(0u, 0u, 0u, 0u);
                if (!okr) x[9] = make_uint4(0u, 0u, 0u, 0u);
#pragma unroll
                for (int c = 0; c < 10; ++c) {
                    const f8v xc = unpack8v(x[c]);
                    if (c < 8) acc[c] += xc * w0;
                    if (c >= 1 && c <= 8) acc[c - 1] += xc * w1;
                    if (c >= 2) acc[c - 2] += xc * w2;
                }
            }
        }
        bf16* qo = (bf16*)(p.ws + WS_QKVN) + (size_t)(t0 + i0) * 1536 + ch;
        bf16* so = (part == 0 ? sq : sk) + i0 * PQ_LD + oc * 8;
#pragma unroll
        for (int j = 0; j < 8; ++j) {
            f8v a = acc[j];
            float ss = 0.f;
#pragma unroll
            for (int e = 0; e < 8; ++e) { a[e] = siluf_(a[e]); ss += a[e] * a[e]; }
            if (part < 2) {
                ss = red16(ss);
                float r = frsq(ss + EPS);
                if (part == 0) r *= 0.08838834764831845f;
                a *= r;
            }
            const uint4 pk = pack8v(a);
            *(uint4*)(qo + (size_t)j * 1536) = pk;
            if (part < 2) *(uint4*)(so + j * PQ_LD) = pk;
        }
    } else {
        const int dir = wid - 6, i = lane, t = cg * 64 + i;
        float* g = (float*)(p.ws + WS_GATES) + (size_t)t * 16;
        const float x = bf2f(proj[(size_t)t * OW + O_G + dir * 4 + h]);
        const float lgv = -fexp(p.in[I_ALOG][oi * 8 + dir * 4 + h]) * softplusf_(x + p.in[I_DTB][oi * 8 + dir * 4 + h]);
        const float bv = sigmoidf_(bf2f(proj[(size_t)t * OW + O_BETA + dir * 4 + h]));
        g[dir * 4 + h] = lgv; g[8 + dir * 4 + h] = bv;
        slg[dir * 64 + i] = lgv; sbt[dir * 64 + i] = bv;
    }
    LBAR();
    if (tid < 2) {
        const int dir = tid; float c = 0.f;
        for (int i = 0; i < 64; ++i) { const int n = dir ? 63 - i : i; c += slg[dir * 64 + n]; sgc[dir * 64 + i] = c; sbp[dir * 64 + i] = sbt[dir * 64 + n]; }
    }
    LBAR();
    {
        const int rt = wid & 3, fr = lane & 15, fq = lane >> 4;
        f4v acc[4];
#pragma unroll
        for (int ct = 0; ct < 4; ++ct) acc[ct] = (f4v){0.f, 0.f, 0.f, 0.f};
#pragma unroll
        for (int ks = 0; ks < 4; ++ks) {
            const s8v a = *(const s8v*)((wid < 4 ? sk : sq) + (16 * rt + fr) * PQ_LD + fq * 8 + ks * 32);
#pragma unroll
            for (int ct = 0; ct < 4; ++ct) {
                const s8v bb = *(const s8v*)(sk + (16 * ct + fr) * PQ_LD + fq * 8 + ks * 32);
                acc[ct] = (wid < 4) ? mfma16(a, bb, acc[ct]) : mfma16(bb, a, acc[ct]);
            }
        }
        const size_t task0 = ((size_t)cg * 4 + h) * 2;
        bf16* qk0 = (bf16*)(p.ws + WS_QKM) + task0 * 4096; bf16* qk1 = qk0 + 4096;
        if (wid < 4) {
#pragma unroll
            for (int ct = 0; ct < 4; ++ct)
#pragma unroll
                for (int r = 0; r < 4; ++r) {
                    const int a = 16 * rt + fq * 4 + r, b = 16 * ct + fr, i1 = 63 - a, j1 = 63 - b;
                    const float v = acc[ct][r];
                    if (b < a) sA[a * TI_LD + b] = sbp[a] * v * fexp(sgc[a] - sgc[b]);
                    if (b > a) sA[64 * TI_LD + i1 * TI_LD + j1] = sbp[64 + i1] * v * fexp(sgc[64 + i1] - sgc[64 + j1]);
                }
        } else {
            const int a = 16 * rt + fr, i1 = 63 - a;
            const float ga0 = sgc[a], ga1 = sgc[64 + i1];
#pragma unroll
            for (int ct = 0; ct < 4; ++ct) {
                const int b0 = 16 * ct + fq * 4;
                f4v v0, v1;
#pragma unroll
                for (int r = 0; r < 4; ++r) {
                    const int b = b0 + r, j1 = 63 - b;
                    const float v = acc[ct][r];
                    v0[r] = b <= a ? v * fexp(ga0 - sgc[b]) : 0.f;
                    v1[3 - r] = b >= a ? v * fexp(ga1 - sgc[64 + j1]) : 0.f;
                }
                *(uint2*)(qk0 + a * 64 + b0) = pack4(v0);
                *(uint2*)(qk1 + i1 * 64 + 60 - b0) = pack4(v1);
            }
        }
    }
    LBAR();
    if (wid == 2) {
        float* gco = (float*)(p.ws + WS_GC) + ((size_t)cg * 4 + h) * 128;
        gco[lane] = sgc[lane]; gco[64 + lane] = sgc[64 + lane];
    }
    tri_inv64(sA + (wid >> 2) * 64 * TI_LD, sX + (wid >> 2) * 64 * TI_LD, sTm + (wid >> 2) * 8 * 16 * TI_TLD, wid & 3, lane, true);
    {
        const int dir = tid >> 8, i = (tid >> 2) & 63, c16 = (tid & 3) * 16;
        const float* xs = sX + dir * 64 * TI_LD + i * TI_LD + c16;
        bf16* ti = (bf16*)(p.ws + WS_TINV) + (((size_t)cg * 4 + h) * 2 + dir) * 4096 + i * 64 + c16;
        *(uint4*)ti = pack8v(*(const f8v*)xs); *(uint4*)(ti + 8) = pack8v(*(const f8v*)(xs + 8));
    }
}

constexpr int G_LDS = 136, G_LDT = 72;
__device__ __forceinline__ void gdn_scan_task(const P& p, int oi, int s, int h, int dir, unsigned char* dsm) {
    bf16* St = (bf16*)dsm;
    bf16* Kc = St + 128 * G_LDS;
    bf16* Qc = Kc + 64 * G_LDS;
    bf16* KeT = Qc + 64 * G_LDS;
    bf16* rT = KeT + 128 * G_LDT;
    bf16* dT = rT + 128 * G_LDT;
    bf16* Vc = dT;
    bf16* Ti = dT + 128 * G_LDT;
    bf16* Qk = Ti + 64 * G_LDT;
    float* sgc = (float*)(Qk + 64 * G_LDT);
    float* sbt = sgc + 64;
    const Seq sq_ = get_seq(s);
    const int tid = opaque_tid(), lane = tid & 63, wid = tid >> 6, fr = lane & 15, fq = lane >> 4;
    const int rt = wid & 3, chf = wid >> 2;
    const bf16* qkvn = (const bf16*)(p.ws + WS_QKVN);
    const float* gates = (const float*)(p.ws + WS_GATES);
    bf16* opart = (bf16*)(p.ws + WS_PART + (size_t)dir * PART_SZ);
    f4v Sacc[8];
    LBAR();
    if (sq_.lat) {
        const float* s0 = p.in[I_SGDN] + ((((size_t)sq_.b * N_ODD + oi) * 2 + dir) * 4 + h) * 128 * 128;
#pragma unroll
        for (int ct = 0; ct < 8; ++ct)
#pragma unroll
            for (int r = 0; r < 4; ++r) Sacc[ct][r] = s0[(16 * wid + fq * 4 + r) * 128 + 16 * ct + fr];
    } else {
#pragma unroll
        for (int ct = 0; ct < 8; ++ct) Sacc[ct] = (f4v){0.f, 0.f, 0.f, 0.f};
    }
#pragma unroll
    for (int ct = 0; ct < 8; ++ct) *(uint2*)(St + (16 * ct + fr) * G_LDS + 16 * wid + fq * 4) = make_uint2(pack2(Sacc[ct][0], Sacc[ct][1]), pack2(Sacc[ct][2], Sacc[ct][3]));
    const int nch = sq_.len >> 6;
    uint4 pq0, pq1, pk0, pk1, pw0, pw1, pti, pqk; float pgi, pgl, pbt = 0.f;
#define GDN_FETCH(CG) do { const size_t task_ = ((size_t)(CG) * 4 + h) * 2 + dir; const int t_ = (CG) * 64 + (dir ? 63 - lane : lane); \
        const bf16* src_ = qkvn + (size_t)t_ * 1536 + h * 128 + wid * 8; \
        pq0 = *(const uint4*)src_; pq1 = *(const uint4*)(src_ + 64); pk0 = *(const uint4*)(src_ + 512); pk1 = *(const uint4*)(src_ + 576); pw0 = *(const uint4*)(src_ + 1024); pw1 = *(const uint4*)(src_ + 1088); \
        { const int i2_ = tid >> 3, c8_ = (tid & 7) * 8; pti = *(const uint4*)((const bf16*)(p.ws + WS_TINV) + task_ * 4096 + i2_ * 64 + c8_); pqk = *(const uint4*)((const bf16*)(p.ws + WS_QKM) + task_ * 4096 + i2_ * 64 + c8_); } \
        const float* gcp_ = (const float*)(p.ws + WS_GC) + task_ * 64; pgi = gcp_[lane]; pgl = gcp_[63]; \
        if (tid < 64) pbt = gates[(size_t)((CG) * 64 + (dir ? 63 - tid : tid)) * 16 + 8 + dir * 4 + h]; } while (0)
    GDN_FETCH((sq_.start >> 6) + (dir ? nch - 1 : 0));
    for (int cc = 0; cc < nch; ++cc) {
        const int cl = dir ? nch - 1 - cc : cc;
        const int cg = (sq_.start >> 6) + cl;
        {
            const int i = lane;
            const float sc = fexp(pgl - pgi);
#pragma unroll
            for (int rep = 0; rep < 2; ++rep) {
                const int c8 = (wid + 8 * rep) * 8;
                const uint4 qv = rep ? pq1 : pq0, kv = rep ? pk1 : pk0, vv = rep ? pw1 : pw0;
                *(uint4*)(Qc + i * G_LDS + c8) = qv; *(uint4*)(Kc + i * G_LDS + c8) = kv; *(uint4*)(Vc + i * G_LDS + c8) = vv;
                const f8v kf = unpack8v(kv);
#pragma unroll
                for (int j = 0; j < 8; ++j) KeT[(c8 + j) * G_LDT + i] = f2bf(kf[j] * sc);
            }
            { const int i2 = tid >> 3, c8 = (tid & 7) * 8; *(uint4*)(Ti + i2 * G_LDT + c8) = pti; *(uint4*)(Qk + i2 * G_LDT + c8) = pqk; }
            if (tid < 64) { sgc[tid] = pgi; sbt[tid] = pbt; }
            if (cc + 1 < nch) { const int cln = dir ? nch - 2 - cc : cc + 1; GDN_FETCH((sq_.start >> 6) + cln); }
        }
        LBAR();
        f4v oacc[4];
        {
            f4v kS[4], qS[4];
#pragma unroll
            for (int ct = 0; ct < 4; ++ct) { kS[ct] = (f4v){0.f, 0.f, 0.f, 0.f}; qS[ct] = (f4v){0.f, 0.f, 0.f, 0.f}; }
#pragma unroll
            for (int ks = 0; ks < 4; ++ks) {
                const s8v ak = *(const s8v*)(Kc + (16 * rt + fr) * G_LDS + ks * 32 + fq * 8);
                const s8v aq = *(const s8v*)(Qc + (16 * rt + fr) * G_LDS + ks * 32 + fq * 8);
#pragma unroll
                for (int ct = 0; ct < 4; ++ct) {
                    const s8v bb = *(const s8v*)(St + (64 * chf + 16 * ct + fr) * G_LDS + ks * 32 + fq * 8);
                    kS[ct] = mfma16(ak, bb, kS[ct]);
                    qS[ct] = mfma16(bb, aq, qS[ct]);
                }
            }
            float eg[4], bt[4];
#pragma unroll
            for (int r = 0; r < 4; ++r) { const int i = 16 * rt + fq * 4 + r; eg[r] = fexp(sgc[i]); bt[r] = sbt[i]; }
            const float egc = fexp(sgc[16 * rt + fr]);
#pragma unroll
            for (int ct = 0; ct < 4; ++ct) {
                const int dv = 64 * chf + 16 * ct + fr;
                float rv[4];
#pragma unroll
                for (int r = 0; r < 4; ++r) { const int i = 16 * rt + fq * 4 + r; rv[r] = bt[r] * (bf2f(Vc[i * G_LDS + dv]) - eg[r] * kS[ct][r]); oacc[ct][r] = egc * qS[ct][r]; }
                *(uint2*)(rT + dv * G_LDT + 16 * rt + fq * 4) = make_uint2(pack2(rv[0], rv[1]), pack2(rv[2], rv[3]));
            }
        }
        LBAR();
        {
            f4v dl[4];
#pragma unroll
            for (int ct = 0; ct < 4; ++ct) dl[ct] = (f4v){0.f, 0.f, 0.f, 0.f};
#pragma unroll
            for (int ks = 0; ks < 2; ++ks) {
                const s8v a = *(const s8v*)(Ti + (16 * rt + fr) * G_LDT + ks * 32 + fq * 8);
#pragma unroll
                for (int ct = 0; ct < 4; ++ct) { const s8v bb = *(const s8v*)(rT + (64 * chf + 16 * ct + fr) * G_LDT + ks * 32 + fq * 8); dl[ct] = mfma16(a, bb, dl[ct]); }
            }
#pragma unroll
            for (int ct = 0; ct < 4; ++ct) { const int dv = 64 * chf + 16 * ct + fr;
                *(uint2*)(dT + dv * G_LDT + 16 * rt + fq * 4) = make_uint2(pack2(dl[ct][0], dl[ct][1]), pack2(dl[ct][2], dl[ct][3])); }
        }
        LBAR();
        {
#pragma unroll
            for (int ks = 0; ks < 2; ++ks) {
                const s8v a = *(const s8v*)(Qk + (16 * rt + fr) * G_LDT + ks * 32 + fq * 8);
#pragma unroll
                for (int ct = 0; ct < 4; ++ct) { const s8v bb = *(const s8v*)(dT + (64 * chf + 16 * ct + fr) * G_LDT + ks * 32 + fq * 8); oacc[ct] = mfma16(bb, a, oacc[ct]); }
            }
            {
                const int i = 16 * rt + fr, t = cg * 64 + (dir ? 63 - i : i);
#pragma unroll
                for (int ct = 0; ct < 4; ++ct) *(uint2*)(opart + (size_t)t * 512 + h * 128 + 64 * chf + 16 * ct + fq * 4) = pack4(oacc[ct]);
            }
            const float ge = fexp(sgc[63]);
#pragma unroll
            for (int ct = 0; ct < 8; ++ct) Sacc[ct] *= ge;
#pragma unroll
            for (int ks = 0; ks < 2; ++ks) {
                const s8v a = *(const s8v*)(KeT + (16 * wid + fr) * G_LDT + ks * 32 + fq * 8);
#pragma unroll
                for (int ct = 0; ct < 8; ++ct) { const s8v bb = *(const s8v*)(dT + (16 * ct + fr) * G_LDT + ks * 32 + fq * 8); Sacc[ct] = mfma16(a, bb, Sacc[ct]); }
            }
#pragma unroll
            for (int ct = 0; ct < 8; ++ct) *(uint2*)(St + (16 * ct + fr) * G_LDS + 16 * wid + fq * 4) = make_uint2(pack2(Sacc[ct][0], Sacc[ct][1]), pack2(Sacc[ct][2], Sacc[ct][3]));
        }
        LBAR();
    }
    if (!sq_.lat) {
        float* fs = p.out + OUT_GDN + ((((size_t)sq_.b * N_ODD + oi) * 2 + dir) * 4 + h) * 128 * 128;
#pragma unroll
        for (int ct = 0; ct < 8; ++ct)
#pragma unroll
            for (int r = 0; r < 4; ++r) fs[(16 * wid + fq * 4 + r) * 128 + 16 * ct + fr] = Sacc[ct][r];
    }
}
constexpr int S5_HLD = 136;
constexpr int S5_ITEMS = 2 * 32 * 2;
__device__ __forceinline__ void s5_task(const P& p, int oi, int dir, int g, int set, unsigned char* dsm) {
    float* sPr = (float*)dsm;
    float* sPi = sPr + 17 * 64;
    float* sBr = sPi + 17 * 64;
    float* sBi = sBr + 1024;
    float* sCr = sBi + 1024;
    float* sCi = sCr + 16 * 65;
    bf16* sK = (bf16*)(sCi + 16 * 65 + 16);
    bf16* HT = sK + 4096;
    bf16* sG = HT + 2 * 16 * S5_HLD;
    bf16* UT = sG + 256 * S5_HLD;
    const int tid = opaque_tid(), lane = tid & 63, wid = tid >> 6, fr = lane & 15, fq = lane >> 4;
    const int nseq = set ? NB_CTX : NB_LAT, sbase = set ? 0 : NB_CTX, len = set ? L_CTX : L_LAT;
    const bf16* proj = (const bf16*)(p.ws + WS_PROJ);
    bf16* ypart = (bf16*)(p.ws + WS_PART + (size_t)(2 + dir) * PART_SZ);
    const size_t pg = ((size_t)(oi * 2 + dir) * 32 + g);
    LBAR();
    if (tid < 64) {
        const float are = fminf(p.in[I_S5AR][pg * 64 + tid], -1e-4f), aim = p.in[I_S5AI][pg * 64 + tid];
        const float dt = expf(p.in[I_S5DT][pg]);
        const float mag = expf(are * dt), ar = mag * cosf(aim * dt), ai = mag * sinf(aim * dt);
        float pr = 1.f, pi = 0.f;
        for (int j = 0; j <= 16; ++j) { sPr[j * 64 + tid] = pr; sPi[j * 64 + tid] = pi; const float nr = pr * ar - pi * ai, ni = pr * ai + pi * ar; pr = nr; pi = ni; }
    }
    {
        const int st = tid >> 3, c0 = (tid & 7) * 2;
        const float are = fminf(p.in[I_S5AR][pg * 64 + st], -1e-4f), aim = p.in[I_S5AI][pg * 64 + st];
        const float dt = expf(p.in[I_S5DT][pg]);
        const float mag = expf(are * dt), ar = mag * cosf(aim * dt), ai = mag * sinf(aim * dt);
        const float den = are * are + aim * aim;
        const float fre = ((ar - 1.0f) * are + ai * aim) / den, fim = (ai * are - (ar - 1.0f) * aim) / den;
#pragma unroll
        for (int c = 0; c < 2; ++c) {
            const float br = p.in[I_S5BR][(pg * 64 + st) * 16 + c0 + c], bi = p.in[I_S5BI][(pg * 64 + st) * 16 + c0 + c];
            sBr[st * 16 + c0 + c] = fre * br - fim * bi; sBi[st * 16 + c0 + c] = fre * bi + fim * br;
        }
        for (int e = tid; e < 1024; e += 512) { sCr[(e >> 6) * 65 + (e & 63)] = p.in[I_S5CR][pg * 1024 + e]; sCi[(e >> 6) * 65 + (e & 63)] = p.in[I_S5CI][pg * 1024 + e]; }
    }
    LBAR();
    {
        const int lag = tid >> 5, co = (tid >> 1) & 15, c8 = (tid & 1) * 8;
        f8v acc = (f8v)(0.f);
        for (int q = 0; q < 64; ++q) {
            const float cr = sCr[co * 65 + q], ci = sCi[co * 65 + q], pr = sPr[lag * 64 + q], pi = sPi[lag * 64 + q];
            const float mr = cr * pr - ci * pi, mi = cr * pi + ci * pr;
            const f8v br = *(const f8v*)(sBr + q * 16 + c8), bi = *(const f8v*)(sBi + q * 16 + c8);
            acc += mr * br - mi * bi;
        }
        *(uint4*)(sK + (lag * 16 + co) * 16 + c8) = pack8v(acc);
    }
    {
        const int row = tid >> 1, tt = row >> 4, co = row & 15, half = tid & 1;
        for (int q0 = 0; q0 < 64; q0 += 8) {
            f8v v;
#pragma unroll
            for (int j = 0; j < 8; ++j) { const int q = q0 + j; const float cr = sCr[co * 65 + q], ci = sCi[co * 65 + q], pr = sPr[(tt + 1) * 64 + q], pi = sPi[(tt + 1) * 64 + q]; v[j] = half ? -(cr * pi + ci * pr) : cr * pr - ci * pi; }
            *(uint4*)(sG + row * S5_HLD + half * 64 + q0) = pack8v(v);
        }
    }
    LBAR();
    const int sp = fq >> 1, cih = (fq & 1) * 8;
    const int nsteps = len >> 4;
    constexpr int S5_ULD = 264;
    const int un = (tid & 255) >> 4, us = tid & 15;
    const bf16* ubase = proj + (size_t)get_seq(sbase + (un < nseq ? un : 0)).start * OW + O_U + g * 16;
#define S5_UADDR(K) (ubase + (size_t)(dir ? len - 1 - (16 * (K) + us) : 16 * (K) + us) * OW)
#define S5_UPUT(K, QA, QB) do { bf16* d_ = UT + ((K) & 1) * 16 * S5_ULD + un * S5_ULD + us * 16; *(uint4*)d_ = QA; *(uint4*)(d_ + 8) = QB; } while (0)
#define S5_ULOAD(K) const bf16* up_ = UT + ((K) & 1) * 16 * S5_ULD + fr * S5_ULD + 8 * fq; \
        const s8v u0 = *(const s8v*)up_, u1 = *(const s8v*)(up_ + 32), u2 = *(const s8v*)(up_ + 64), u3 = *(const s8v*)(up_ + 96), \
                  u4 = *(const s8v*)(up_ + 128), u5 = *(const s8v*)(up_ + 160), u6 = *(const s8v*)(up_ + 192), u7 = *(const s8v*)(up_ + 224)
    if (wid < 4) {
        s8v wre[8], wim[8];
        {
            const int pp = 16 * wid + fr;
#pragma unroll
            for (int m = 0; m < 8; ++m) {
                const int sidx = 15 - (2 * m + sp);
                const float pr = sPr[sidx * 64 + pp], pi = sPi[sidx * 64 + pp];
#pragma unroll
                for (int j = 0; j < 8; ++j) {
                    const float br = sBr[pp * 16 + cih + j], bi = sBi[pp * 16 + cih + j];
                    wre[m][j] = (short)f2bf(pr * br - pi * bi); wim[m][j] = (short)f2bf(pr * bi + pi * br);
                }
            }
        }
        float a16r[4], a16i[4], hr[4], hi[4];
#pragma unroll
        for (int r = 0; r < 4; ++r) {
            const int pp = 16 * wid + fq * 4 + r;
            a16r[r] = sPr[16 * 64 + pp]; a16i[r] = sPi[16 * 64 + pp];
            hr[r] = 0.f; hi[r] = 0.f;
            if (set == 0 && fr < nseq) { const size_t o = (((size_t)fr * N_ODD + oi) * 2 + dir) * 32 * 64 + g * 64 + pp; hr[r] = p.in[I_SS5R][o]; hi[r] = p.in[I_SS5I][o]; }
        }
        *(uint2*)(HT + fr * S5_HLD + 16 * wid + fq * 4) = make_uint2(pack2(hr[0], hr[1]), pack2(hr[2], hr[3]));
        *(uint2*)(HT + fr * S5_HLD + 64 + 16 * wid + fq * 4) = make_uint2(pack2(hi[0], hi[1]), pack2(hi[2], hi[3]));
        uint4 qa0, qb0, qa1, qb1, qa2, qb2, qa3, qb3;
        { const bf16* a_ = S5_UADDR(0); qa0 = *(const uint4*)a_; qb0 = *(const uint4*)(a_ + 8); S5_UPUT(0, qa0, qb0); }
#define S5_QLOAD(K, QA, QB) do { if ((K) < nsteps) { const bf16* a_ = S5_UADDR(K); QA = *(const uint4*)a_; QB = *(const uint4*)(a_ + 8); } } while (0)
        S5_QLOAD(1, qa1, qb1); S5_QLOAD(2, qa2, qb2); S5_QLOAD(3, qa3, qb3); S5_QLOAD(4, qa0, qb0);
        LBAR();
#define S5_STATE_STEP(K, QA, QB) do { \
            const int k = (K); \
            S5_ULOAD(k); \
            if (k + 1 < nsteps) { S5_UPUT(k + 1, QA, QB); S5_QLOAD(k + 5, QA, QB); } \
            f4v zr = (f4v){0.f, 0.f, 0.f, 0.f}, zi = zr; \
            zr = mfma16(wre[0], u0, zr); zi = mfma16(wim[0], u0, zi); zr = mfma16(wre[1], u1, zr); zi = mfma16(wim[1], u1, zi); \
            zr = mfma16(wre[2], u2, zr); zi = mfma16(wim[2], u2, zi); zr = mfma16(wre[3], u3, zr); zi = mfma16(wim[3], u3, zi); \
            zr = mfma16(wre[4], u4, zr); zi = mfma16(wim[4], u4, zi); zr = mfma16(wre[5], u5, zr); zi = mfma16(wim[5], u5, zi); \
            zr = mfma16(wre[6], u6, zr); zi = mfma16(wim[6], u6, zi); zr = mfma16(wre[7], u7, zr); zi = mfma16(wim[7], u7, zi); \
            _Pragma("unroll") for (int r = 0; r < 4; ++r) { const float nr = a16r[r] * hr[r] - a16i[r] * hi[r] + zr[r], ni = a16r[r] * hi[r] + a16i[r] * hr[r] + zi[r]; hr[r] = nr; hi[r] = ni; } \
            bf16* hb = HT + ((k + 1) & 1) * 16 * S5_HLD; \
            *(uint2*)(hb + fr * S5_HLD + 16 * wid + fq * 4) = make_uint2(pack2(hr[0], hr[1]), pack2(hr[2], hr[3])); \
            *(uint2*)(hb + fr * S5_HLD + 64 + 16 * wid + fq * 4) = make_uint2(pack2(hi[0], hi[1]), pack2(hi[2], hi[3])); \
            LBAR(); } while (0)
        for (int k4 = 0; k4 < nsteps; k4 += 4) {
            S5_STATE_STEP(k4, qa1, qb1); S5_STATE_STEP(k4 + 1, qa2, qb2); S5_STATE_STEP(k4 + 2, qa3, qb3); S5_STATE_STEP(k4 + 3, qa0, qb0);
        }
        if (set == 1 && fr < nseq) {
#pragma unroll
            for (int r = 0; r < 4; ++r) { const size_t o = (((size_t)fr * N_ODD + oi) * 2 + dir) * 32 * 64 + g * 64 + 16 * wid + fq * 4 + r; p.out[OUT_S5R + o] = hr[r]; p.out[OUT_S5I + o] = hi[r]; }
        }
    } else {
        const int t0 = 4 * (RFL(wid) - 4);
        s8v klr[18];
#pragma unroll
        for (int e = 0; e < 18; ++e) { const int lg = t0 + 3 - e - sp; klr[e] = (lg >= 0) ? *(const s8v*)(sK + (lg * 16 + fr) * 16 + cih) : (s8v){0, 0, 0, 0, 0, 0, 0, 0}; }
        LBAR();
        for (int k = 0; k < nsteps; ++k) {
            S5_ULOAD(k);
            const bf16* hb = HT + (k & 1) * 16 * S5_HLD + fr * S5_HLD + 8 * fq;
            const s8v h0 = *(const s8v*)hb, h1 = *(const s8v*)(hb + 32), h2 = *(const s8v*)(hb + 64), h3 = *(const s8v*)(hb + 96);
            f4v y0 = (f4v){0.f, 0.f, 0.f, 0.f}, y1 = y0, y2 = y0, y3 = y0;
            {
                const bf16* gp = sG + (t0 * 16 + fr) * S5_HLD + 8 * fq;
#define S5_G4(KS, H) do { y0 = mfma16(*(const s8v*)(gp + 32 * (KS)), H, y0); y1 = mfma16(*(const s8v*)(gp + 16 * S5_HLD + 32 * (KS)), H, y1); \
                          y2 = mfma16(*(const s8v*)(gp + 32 * S5_HLD + 32 * (KS)), H, y2); y3 = mfma16(*(const s8v*)(gp + 48 * S5_HLD + 32 * (KS)), H, y3); } while (0)
                S5_G4(0, h0); S5_G4(1, h1); S5_G4(2, h2); S5_G4(3, h3);
#define S5_K4(M, U) do { if (2 * (M) <= t0 + 0) y0 = mfma16(klr[3 + 2 * (M)], U, y0); if (2 * (M) <= t0 + 1) y1 = mfma16(klr[2 + 2 * (M)], U, y1); \
                         if (2 * (M) <= t0 + 2) y2 = mfma16(klr[1 + 2 * (M)], U, y2); if (2 * (M) <= t0 + 3) y3 = mfma16(klr[0 + 2 * (M)], U, y3); } while (0)
                S5_K4(0, u0); S5_K4(1, u1); S5_K4(2, u2); S5_K4(3, u3); S5_K4(4, u4); S5_K4(5, u5); S5_K4(6, u6); S5_K4(7, u7);
            }
            if (fr < nseq) {
                const int tb_ = get_seq(sbase + fr).start;
#define S5_ST(TT, Y) do { const int pos = 16 * k + t0 + (TT), tok = tb_ + (dir ? len - 1 - pos : pos); *(uint2*)(ypart + (size_t)tok * 512 + g * 16 + fq * 4) = pack4(Y); } while (0)
                S5_ST(0, y0); S5_ST(1, y1); S5_ST(2, y2); S5_ST(3, y3);
            }
            LBAR();
        }
    }
}
constexpr int ODD_GDN_ITEMS = NSEQ * 8;
constexpr int ODD_SCAN_ITEMS = ODD_GDN_ITEMS + S5_ITEMS;
__device__ __forceinline__ void ph_odd_scan_item(const P& p, int w, int oi, float* smem_full) {
    unsigned char* dsm = (unsigned char*)smem_full;
    const int nlg = NB_LAT * 8, ncg = NB_CTX * 8;
    if (w < ncg) { gdn_scan_task(p, oi, w / 8, (w % 8) >> 1, w & 1, dsm); return; }
    w -= ncg;
    if (w < 64) { __syncthreads(); s5_task(p, oi, w >> 5, w & 31, 0, dsm); return; }
    w -= 64;
    if (w < nlg) { gdn_scan_task(p, oi, NB_CTX + w / 8, (w % 8) >> 1, w & 1, dsm); return; }
    w -= nlg;
    __syncthreads(); s5_task(p, oi, w >> 5, w & 31, 1, dsm);
}
__device__ __forceinline__ void ph_fin_odd_a(const P& p, int bid, int oi) {
    const int lane = LT & 63, tb = bid * (4 * NTW) + (LT >> 6) * NTW;
    if (tb >= T) return;
    const int idx = lane * 8;
    uint4 vof[NTW], vob[NTW], vyf[NTW], vyb[NTW], vzc[NTW], vu[NTW];
#pragma unroll
    for (int u = 0; u < NTW; ++u) {
        const size_t t = (size_t)((tb + u < T) ? tb + u : T - 1);
        const bf16* pr = (const bf16*)(p.ws + WS_PROJ) + t * OW;
        vof[u] = *(const uint4*)((const bf16*)(p.ws + WS_PART) + t * 512 + idx);
        vob[u] = *(const uint4*)((const bf16*)(p.ws + WS_PART + PART_SZ) + t * 512 + idx);
        vyf[u] = *(const uint4*)((const bf16*)(p.ws + WS_PART + 2 * PART_SZ) + t * 512 + idx);
        vyb[u] = *(const uint4*)((const bf16*)(p.ws + WS_PART + 3 * PART_SZ) + t * 512 + idx);
        vzc[u] = *(const uint4*)(pr + O_ZC + idx);
        vu[u] = *(const uint4*)(pr + O_U + idx);
    }
    const f8v gn = *(const f8v*)(p.in[I_GDNN] + oi * 128 + (idx & 127));
    const f8v dsk = *(const f8v*)(p.in[I_S5D] + oi * 512 + idx);
#pragma unroll
    for (int u = 0; u < NTW; ++u) {
        const size_t t = (size_t)(tb + u); if (tb + u >= T) break;
        f8v o = unpack8v(vof[u]) + unpack8v(vob[u]);
        float ss = 0.f;
#pragma unroll
        for (int j = 0; j < 8; ++j) ss += o[j] * o[j];
        ss = red16(ss);
        const float r = frsq(ss * (1.0f / 128.f) + EPS);
        const f8v zc = unpack8v(vzc[u]);
        f8v y = unpack8v(vyf[u]) + unpack8v(vyb[u]) + dsk * unpack8v(vu[u]);
#pragma unroll
        for (int j = 0; j < 8; ++j) { o[j] = o[j] * r * gn[j] * siluf_(zc[j]); y[j] = gelu_tanh(y[j]); }
        *(uint4*)((bf16*)(p.ws + WS_HM) + t * D + idx) = pack8v(o);
        *(uint4*)((bf16*)(p.ws + WS_PART + 2 * PART_SZ) + t * 512 + idx) = pack8v(y);
    }
}
__device__ __forceinline__ void ph_fin_odd_b(const P& p, int bid, int oi) {
    const size_t e = ((size_t)bid * 256 + LT) * 4;
    if (e >= (size_t)T * 512) return;
    const int t = (int)(e >> 9), idx = (int)(e & 511);
    const bf16* pr = (const bf16*)(p.ws + WS_PROJ) + (size_t)t * OW;
    const bf16* gl = (const bf16*)(p.ws + WS_PART + 2 * PART_SZ) + (size_t)t * 512;
    bf16* yc = (bf16*)(p.ws + WS_HM) + (size_t)t * D + 512;
#pragma unroll
    for (int j = 0; j < 4; ++j) {
        const float ys = bf2f(yc[idx + j]);
        yc[idx + j] = f2bf(ys * sigmoidf_(bf2f(gl[idx + j]) + p.in[I_GLUB][oi * 512 + idx + j]) * siluf_(bf2f(pr[O_ZD + idx + j])));
    }
}

enum { PK_PREP0, PK_HMOD0, PK_GEMM_IN, PK_EVEN_SCAN, PK_FIN_EVEN, PK_ODD_PREP, PK_ODD_SCAN, PK_FIN_ODD_A, PK_GEMM_GLU, PK_FIN_ODD_B, PK_GEMM_OUT, PK_POST, PK_RWKV_PREP0, PK_RWKV_PREP1, PK_EVEN_SCAN1 };
constexpr int NPH = 2 + (DEPTH / 2) * 14;
constexpr int TOKB = (T + 3) / 4;
static_assert(DEPTH % 2 == 0, "even depth expected");
__host__ __device__ inline void phase_desc(int ph, int& kind, int& layer) {
    if (ph == 0) { kind = PK_PREP0; layer = 0; return; }
    if (ph == 1) { kind = PK_HMOD0; layer = 0; return; }
    ph -= 2;
    const int pair = ph / 14, r = ph % 14;
    if (r < 7) { layer = 2 * pair; kind = r == 0 ? PK_GEMM_IN : r == 1 ? PK_RWKV_PREP0 : r == 2 ? PK_EVEN_SCAN : r == 3 ? PK_RWKV_PREP1 : r == 4 ? PK_EVEN_SCAN1 : r == 5 ? PK_GEMM_OUT : PK_POST; }
    else { const int q = r - 7; layer = 2 * pair + 1; kind = q == 0 ? PK_GEMM_IN : q == 1 ? PK_ODD_PREP : q == 2 ? PK_ODD_SCAN : q == 3 ? PK_FIN_ODD_A : q == 4 ? PK_GEMM_GLU : q == 5 ? PK_GEMM_OUT : PK_POST; }
}
__host__ __device__ inline bool phase_is_gemm(int kind) { return kind == PK_GEMM_IN || kind == PK_GEMM_GLU || kind == PK_GEMM_OUT; }
__host__ __device__ inline int phase_nblk(int kind, int layer) {
    switch (kind) {
        case PK_PREP0: return MOD_VB + WT_TILES;
        case PK_FIN_ODD_B: return (T * 512 / 4 + 255) / 256;
        default: return (T + 4 * NTW - 1) / (4 * NTW);
    }
}
__device__ __forceinline__ void do_phase(const P& p, int kind, int layer, int vb, float* smem) {
    const int i = layer >> 1;
    switch (kind) {
        case PK_PREP0: if (vb < MOD_VB) ph_mod(p, vb, smem); else ph_wt(p, vb - MOD_VB, smem); break;
        case PK_HMOD0: ph_hmod0(p, vb); break;
        case PK_FIN_EVEN: ph_fin_even(p, vb, i); break;
        case PK_FIN_ODD_A: ph_fin_odd_a(p, vb, i); break;
        case PK_FIN_ODD_B: ph_fin_odd_b(p, vb, i); break;
        case PK_POST: ph_post(p, vb, layer); break;
    }
}
__device__ __forceinline__ void do_gemm(const P& p, int kind, int layer, int G, int c, unsigned char* dsm) {
    const int i = layer >> 1;
    const bf16* hm = (const bf16*)(p.ws + WS_HM);
    pg8::StaticOrder S;
    LDS_AS unsigned char* lds = (LDS_AS unsigned char*)dsm;
    if (kind == PK_GEMM_IN) {
        if ((layer & 1) == 0) { pg8::Gemm g{hm, (const bf16*)(p.ws + WS_WTE) + (size_t)i * EWP * D, T, EWP, D, D}; S.init(T, EWP, G, c); pg8::EpiBf16 E{(bf16*)(p.ws + WS_PROJ), EW, EW}; pg8::gemm_phase(lds, g, S, E); }
        else { pg8::Gemm g{hm, (const bf16*)(p.ws + WS_WTO) + (size_t)i * OWP * D, T, OWP, D, D}; S.init(T, OWP, G, c); pg8::EpiBf16 E{(bf16*)(p.ws + WS_PROJ), OW, OW}; pg8::gemm_phase(lds, g, S, E); }
    } else if (kind == PK_GEMM_GLU) {
        const bf16* ysb = (const bf16*)(p.ws + WS_PART + 2 * PART_SZ);
        pg8::Gemm g{ysb, (const bf16*)(p.ws + WS_WTGLU) + (size_t)i * 512 * 512, T, 512, 512, 512}; S.init(T, 512, G, c);
        pg8::EpiGlu E{(bf16*)(p.ws + WS_HM) + 512, ysb, (const bf16*)(p.ws + WS_PROJ) + O_ZD, p.in[I_GLUB] + i * 512}; pg8::gemm_phase(lds, g, S, E);
    } else {
        const bf16* ya = (layer & 1) ? hm : (const bf16*)(p.ws + WS_YCE);
        pg8::Gemm g{ya, (const bf16*)(p.ws + WS_WTOUT) + (size_t)layer * D * D, T, D, D, D}; S.init(T, D, G, c); pg8::EpiBf16 E{(bf16*)(p.ws + WS_PROJ), D, D}; pg8::gemm_phase(lds, g, S, E);
    }
}
constexpr int LDS_BYTES = 163840;
constexpr bool EVEN_FUSED_SCHED = (NB_LAT == 8 && NB_CTX == 16 && L_CTX == 256 && L_LAT == 1024);
#ifndef REP_SCAN
#define REP_SCAN 1
#endif
#ifndef REP_GEMM
#define REP_GEMM 1
#endif

#ifdef CPU_EMU
__global__ void k_phase(P p, int kind, int layer, int nb) {
    __shared__ __attribute__((aligned(16))) unsigned char dsm[LDS_BYTES];
    if (phase_is_gemm(kind)) { do_gemm(p, kind, layer, gridDim.x, blockIdx.x, dsm); return; }
    if (kind == PK_ODD_SCAN) { ph_odd_scan_item(p, blockIdx.x, layer >> 1, (float*)dsm); return; }
    if (kind == PK_ODD_PREP) { ph_odd_prep(p, blockIdx.x, layer >> 1, dsm); return; }
    if (kind == PK_EVEN_SCAN || kind == PK_EVEN_SCAN1) { ph_even_scan_item(p, blockIdx.x, layer >> 1, kind == PK_EVEN_SCAN1, dsm); return; }
    if (kind == PK_RWKV_PREP0 || kind == PK_RWKV_PREP1) { rwkv_prep_phase(p, layer >> 1, kind == PK_RWKV_PREP1, blockIdx.x, gridDim.x, RWKV_PREP_ITEMS, dsm); return; }
    const int half = threadIdx.x >> 8, vb = 2 * blockIdx.x + half;
    if (vb < nb) do_phase(p, kind, layer, vb, (float*)dsm + half * 16384);
}
void emu_hook(const char* stage, int layer, const P& p);
extern "C" void kernel_launch(void* const* d_in, const int* in_sizes, int n_in, void* d_out, int out_size, void* d_ws, size_t ws_size, hipStream_t stream) {
    P p{};
    for (int i = 0; i < 44; ++i) p.in[i] = (const float*)d_in[i];
    p.out = (float*)d_out; p.ws = (char*)d_ws;
    static const char* names[] = {"prep0", "hmod", "proj", "even_scan0", "ycat", "odd_prep", "odd_scan", "fin_odd_a", "ycat", "ycat", "outproj", "post", "rwkv_prep0", "rwkv_prep1", "even_scan"};
    for (int ph = 0; ph < NPH; ++ph) {
        int kind, layer; phase_desc(ph, kind, layer);
        const int nb = phase_nblk(kind, layer);
        EMU_LAUNCH(k_phase, phase_is_gemm(kind) ? 3 : kind == PK_ODD_SCAN ? ODD_SCAN_ITEMS : (kind == PK_EVEN_SCAN || kind == PK_EVEN_SCAN1) ? EVEN_SCAN_ITEMS : (kind == PK_RWKV_PREP0 || kind == PK_RWKV_PREP1) ? RWKV_PREP_ITEMS : kind == PK_ODD_PREP ? ODD_PREP_ITEMS : (nb + 1) / 2, 512, p, kind, layer, nb);
        emu_hook(names[kind], layer, p);
    }
}
#else

#define XB_TMO      128
#define XB_XCNT(j)  (256  + 64 * (j))
#define XB_XSUB(j)  (1280 + 64 * (j))
#define XB_XGEN(j)  (2304 + 64 * (j))
#define XB_TOP      3328
#define XB_TOPGEN   3392
#define XCD_BAR_WORDS 3456
#define XB_SPIN_CAP (1u << 18)
__device__ __forceinline__ unsigned xb_ld(unsigned* p)              { return __hip_atomic_load(p, __ATOMIC_RELAXED, __HIP_MEMORY_SCOPE_AGENT); }
__device__ __forceinline__ unsigned xb_add(unsigned* p, unsigned v) { return __hip_atomic_fetch_add(p, v, __ATOMIC_RELAXED, __HIP_MEMORY_SCOPE_AGENT); }
__device__ __forceinline__ unsigned xb_xcc_id() { return (unsigned)__builtin_amdgcn_s_getreg((3 << 11) | 20) & 0xFu; }
#define XB_SPIN(cond, bar) do { unsigned _sp = 0; while (cond) { __builtin_amdgcn_s_sleep(1); \
    if ((++_sp & 255u) == 0u) { if (xb_ld(&(bar)[XB_TMO])) break; if (_sp > XB_SPIN_CAP) { atomicAdd(&(bar)[XB_TMO], 1u); break; } } } } while (0)
struct XcdBarrier { unsigned* bar; unsigned x; volatile LDS_AS unsigned* st; };
__device__ __forceinline__ XcdBarrier xcd_barrier_post(unsigned* bar, volatile LDS_AS unsigned* st) {
    XcdBarrier b; b.bar = bar; b.x = xb_xcc_id(); b.st = st;
    if (threadIdx.x == 0) (void)xb_add(&bar[XB_XCNT(b.x)], 1u);
    return b;
}
__device__ __forceinline__ void xcd_barrier_complete(unsigned* bar, unsigned x, unsigned& nloc, unsigned& nx) {
    const unsigned G = gridDim.x * gridDim.y * gridDim.z;
    unsigned sum, cnt, mine, sp = 0u;
    for (;;) {
        sum = 0u; cnt = 0u; mine = 0u;
#pragma unroll
        for (unsigned j = 0; j < 16; ++j) { const unsigned c = xb_ld(&bar[XB_XCNT(j)]); sum += c; cnt += (c > 0u) ? 1u : 0u; mine = (j == x) ? c : mine; }
        if (sum == G) break;
        __builtin_amdgcn_s_sleep(1);
        if ((++sp & 255u) == 0u) { if (xb_ld(&bar[XB_TMO])) break; if (sp > XB_SPIN_CAP) { atomicAdd(&bar[XB_TMO], 1u); break; } }
    }
    nloc = mine > 0u ? mine : 1u; nx = cnt > 0u ? cnt : 1u;
}
__device__ __forceinline__ void xcd_barrier(const XcdBarrier& b) {
    asm volatile("s_waitcnt vmcnt(0)" ::: "memory");
    __syncthreads();
    if (threadIdx.x == 0) {
        unsigned* bar = b.bar;
        __builtin_amdgcn_s_waitcnt(0);
        unsigned nloc = b.st[0], nx = b.st[1];
        if (nloc == 0u) { xcd_barrier_complete(bar, b.x, nloc, nx); b.st[0] = nloc; b.st[1] = nx; }
        const unsigned old = xb_add(&bar[XB_XSUB(b.x)], 1u);
        const unsigned gen = old / nloc;
        if (old + 1u == (gen + 1u) * nloc) {
            __builtin_amdgcn_fence(__ATOMIC_RELEASE, "agent");
            asm volatile("s_waitcnt vmcnt(0)" ::: "memory");
            const unsigned og = xb_add(&bar[XB_TOP], 1u);
            const unsigned tg = og / nx;
            if (og + 1u == (tg + 1u) * nx) xb_add(&bar[XB_TOPGEN], 1u);
            else XB_SPIN(xb_ld(&bar[XB_TOPGEN]) == tg, bar);
            __builtin_amdgcn_fence(__ATOMIC_ACQUIRE, "agent");
            xb_add(&bar[XB_XGEN(b.x)], 1u);
            asm volatile("s_waitcnt vmcnt(0)" ::: "memory");
        } else {
            XB_SPIN(xb_ld(&bar[XB_XGEN(b.x)]) == gen, bar);
            __builtin_amdgcn_fence(__ATOMIC_ACQUIRE, "agent");
            asm volatile("s_waitcnt vmcnt(0)" ::: "memory");
        }
    }
    __syncthreads();
}
extern __shared__ __attribute__((aligned(16))) unsigned char dsm[];
#define RUN_PHASE(KIND, LAYER) do { const int nb_ = phase_nblk(KIND, LAYER); const int half_ = opaque_tid() >> 8; \
    for (int b_ = blockIdx.x; 2 * b_ < nb_; b_ += gridDim.x) { const int vb_ = 2 * b_ + half_; if (vb_ < nb_) do_phase(p, KIND, LAYER, vb_, (float*)dsm + half_ * 16384); } } while (0)
#define RUN_GEMM(KIND, LAYER) do_gemm(p, KIND, LAYER, gridDim.x, blockIdx.x, dsm)
typedef const __attribute__((address_space(4))) P* KP;
__device__ __forceinline__ const P& phase_args(KP pk) { asm volatile("" : "+s"(pk)); return *(const P*)pk; }
__global__ void __launch_bounds__(512) mega(P p_unused) {
    const KP pk = (KP)__builtin_amdgcn_kernarg_segment_ptr();
    volatile LDS_AS unsigned* xst = (volatile LDS_AS unsigned*)(dsm + LDS_BYTES - 16);
    if (threadIdx.x == 0) { xst[0] = 0u; xst[1] = 0u; xst[2] = 0u; xst[3] = 0u; }
    __syncthreads();
    XcdBarrier xb;
    { const P& p = phase_args(pk); xb = xcd_barrier_post((unsigned*)(p.ws + WS_BAR), xst); }
#define GSYNC() do { PT_B(31); const P& pb_ = phase_args(pk); XcdBarrier b_ = xb; b_.bar = (unsigned*)(pb_.ws + WS_BAR); xcd_barrier(b_); PT_E(31); } while (0)
    { PT_B(20); const P& p = phase_args(pk); RUN_PHASE(PK_PREP0, 0); PT_E(20); } GSYNC();
    { PT_B(21); const P& p = phase_args(pk); RUN_PHASE(PK_HMOD0, 0); PT_E(21); } GSYNC();
#pragma nounroll
    for (int pair = 0; pair < DEPTH / 2; ++pair) {
        const int le = 2 * pair, lo = 2 * pair + 1;
        { PT_B(22); const P& p = phase_args(pk); RUN_GEMM(PK_GEMM_IN, le); PT_E(22); } GSYNC();
#pragma nounroll
        for (int dir_ = 0; dir_ < 2; ++dir_) {
            if (EVEN_FUSED_SCHED && gridDim.x == 256) {
                { const P& p = phase_args(pk); const int hg = blockIdx.x & 7, q = blockIdx.x >> 3;
                  int cg0, ncg;
                  PT_B(12);
                  if (q < 4) { const int x = hg * 4 + q; gla_scan_task(p, pair, NB_CTX + x / 4, x & 3, dir_, dsm); cg0 = q * 2; ncg = 2; }
                  else if (q < 12) { const int x = hg * 8 + (q - 4); gla_scan_task(p, pair, x / 4, x & 3, dir_, dsm); const int j = q - 4; ncg = 5 + (j & 1); cg0 = 8 + (j >> 1) * 11 + (j & 1) * 5; }
                  else { cg0 = 52 + (q - 12) * 7; ncg = 7; }
                  PT_E(12); PT_B(11);
                  rwkv_prep_phase(p, pair, dir_, cg0 * 8 + hg, 8, (cg0 + ncg) * 8, dsm); PT_E(11); } GSYNC();
                { PT_B(23); const P& p = phase_args(pk); for (int w_ = blockIdx.x; w_ < EV_AP_LAT + EV_AP_CTX; w_ += gridDim.x) rwkv_apply_task(p, pair, w_ < EV_AP_LAT ? NB_CTX + w_ / 8 : (w_ - EV_AP_LAT) / 8, w_ & 7, dir_, dsm); PT_E(23); } GSYNC();
            } else {
                { const P& p = phase_args(pk); rwkv_prep_phase(p, pair, dir_, blockIdx.x, gridDim.x, RWKV_PREP_ITEMS, dsm); } GSYNC();
                { const P& p = phase_args(pk); for (int w_ = blockIdx.x; w_ < EVEN_SCAN_ITEMS; w_ += gridDim.x) ph_even_scan_item(p, w_, pair, dir_, dsm); } GSYNC();
            }
        }
        { PT_B(24); const P& p = phase_args(pk); RUN_GEMM(PK_GEMM_OUT, le); PT_E(24); } GSYNC();
        { PT_B(25); const P& p = phase_args(pk); RUN_PHASE(PK_POST, le); PT_E(25); } GSYNC();
        { PT_B(26); const P& p = phase_args(pk); RUN_GEMM(PK_GEMM_IN, lo); PT_E(26); } GSYNC();
        { PT_B(27); const P& p = phase_args(pk); for (int w_ = blockIdx.x; w_ < ODD_PREP_ITEMS; w_ += gridDim.x) ph_odd_prep(p, w_, pair, dsm); PT_E(27); } GSYNC();
        { PT_B(28); const P& p = phase_args(pk); for (int w_ = blockIdx.x; w_ < ODD_SCAN_ITEMS; w_ += gridDim.x) ph_odd_scan_item(p, w_, pair, (float*)dsm); PT_E(28); } GSYNC();
        { PT_B(29); const P& p = phase_args(pk); RUN_PHASE(PK_FIN_ODD_A, lo); PT_E(29); } GSYNC();
        { PT_B(30); const P& p = phase_args(pk); RUN_GEMM(PK_GEMM_GLU, lo); PT_E(30); } GSYNC();
        { PT_B(24); const P& p = phase_args(pk); RUN_GEMM(PK_GEMM_OUT, lo); PT_E(24); } GSYNC();
        { PT_B(25); const P& p = phase_args(pk); RUN_PHASE(PK_POST, lo); PT_E(25); }
        if (pair + 1 < DEPTH / 2) GSYNC();
    }
#if PROBE_SEL
    if (blockIdx.x == PROBE_BLK && threadIdx.x == 0) {
        const unsigned long long tot_ = *(volatile unsigned long long*)(dsm + LDS_BYTES - 8) * PROBE_MUL;
        const long long s_ = clock64();
        while ((unsigned long long)(clock64() - s_) < tot_) {}
    }
#endif
}
extern "C" void kernel_launch(void* const* d_in, const int* in_sizes, int n_in, void* d_out, int out_size, void* d_ws, size_t ws_size, hipStream_t stream) {
    static int grid_blocks = 0;
    if (!grid_blocks) {
        int dev = 0, cus = 0, per_cu = 0;
        (void)hipGetDevice(&dev);
        (void)hipDeviceGetAttribute(&cus, hipDeviceAttributeMultiprocessorCount, dev);
        (void)hipFuncSetAttribute((const void*)mega, hipFuncAttributeMaxDynamicSharedMemorySize, LDS_BYTES);
        (void)hipOccupancyMaxActiveBlocksPerMultiprocessor(&per_cu, mega, 512, LDS_BYTES);
        if (per_cu < 1) fprintf(stderr, "occupancy query says %d blocks/CU\n", per_cu);
        grid_blocks = cus;
    }
    P p{};
    for (int i = 0; i < 44; ++i) p.in[i] = (const float*)d_in[i];
    p.out = (float*)d_out; p.ws = (char*)d_ws;
    (void)hipMemsetAsync((char*)d_ws + WS_BAR, 0, XCD_BAR_WORDS * 4, stream);
    hipLaunchKernelGGL(mega, dim3(grid_blocks), dim3(512), LDS_BYTES, stream, p);
    hipError_t e = hipPeekAtLastError();
    if (e != hipSuccess) fprintf(stderr, "launch failed: %s (grid %d)\n", hipGetErrorString(e), grid_blocks);
}
#endif
```

```cpp
#ifndef CPU_EMU
#include <hip/hip_runtime.h>
#include <hip/hip_cooperative_groups.h>
#include <cstdio>
namespace cg = cooperative_groups;
#endif
#include <stdint.h>

#ifndef CFG_BATCH
#define CFG_BATCH 16
#define CFG_SEQ 256
#define CFG_DEC_BATCH 8
#define CFG_DEC_SEQ 1024
#define CFG_DEPTH 4
#endif

typedef unsigned short bf16;
typedef short s8v __attribute__((ext_vector_type(8)));
typedef float f4v __attribute__((ext_vector_type(4)));

constexpr int D = 1024;
constexpr int NB_CTX = CFG_BATCH, L_CTX = CFG_SEQ, NB_LAT = CFG_DEC_BATCH, L_LAT = CFG_DEC_SEQ, DEPTH = CFG_DEPTH;
constexpr int N_EVEN = (DEPTH + 1) / 2, N_ODD = DEPTH / 2;
constexpr int T_CTX = NB_CTX * L_CTX, T_LAT = NB_LAT * L_LAT, T = T_CTX + T_LAT;
constexpr int NSEQ = NB_CTX + NB_LAT, NCOND = 1 + NB_LAT;
constexpr int EW = 3872, OW = 3088, EWP = 4096, OWP = 3328;
constexpr float EPS = 1e-6f;
constexpr int E_Q = 0, E_K = 256, E_V = 512, E_GD = 1024, E_ZA = 1056, E_FB = 1568, E_ZB = 3360;
constexpr int FB_R = 0, FB_K = 512, FB_V = 1024, FB_WD = 1536, FB_AD = 1664;
constexpr int O_QKV = 0, O_G = 1536, O_BETA = 1544, O_ZC = 1552, O_U = 2064, O_ZD = 2576;

constexpr size_t al(size_t x) { return (x + 255) & ~(size_t)255; }
constexpr size_t WS_MOD = 0;
constexpr size_t WS_WTE = WS_MOD + al((size_t)DEPTH * NCOND * 3072 * 4);
constexpr size_t WS_WTO = WS_WTE + al((size_t)N_EVEN * EWP * D * 2);
constexpr size_t WS_WTOUT = WS_WTO + al((size_t)(N_ODD ? N_ODD : 1) * OWP * D * 2);
constexpr size_t WS_WTGLU = WS_WTOUT + al((size_t)DEPTH * D * D * 2);
constexpr size_t WS_HM = WS_WTGLU + al((size_t)(N_ODD ? N_ODD : 1) * 512 * 512 * 2);
constexpr size_t WS_PROJ = WS_HM + al((size_t)T * D * 2);
constexpr size_t WS_PART = WS_PROJ + al((size_t)T * EW * 2);
constexpr size_t PART_SZ = al((size_t)T * 512 * 2);
constexpr size_t WS_YCE = WS_PART + 2 * PART_SZ;
constexpr size_t WS_BONUS = WS_PART + 4 * PART_SZ;
constexpr size_t WS_QKVN = WS_BONUS + al((size_t)T * 16 * 4);
constexpr size_t WS_GATES = WS_QKVN + al((size_t)T * 1536 * 2);
constexpr size_t WS_GC = WS_GATES + al((size_t)T * 16 * 4);
constexpr size_t WS_BAR = WS_GC + al((size_t)(T / 64) * 8 * 64 * 4);
constexpr size_t WS_END = WS_BAR + 16384;
constexpr size_t WS_TINV = WS_PROJ + al((size_t)T * OW * 2);
constexpr size_t WS_QKM = WS_HM;
static_assert(WS_TINV + (size_t)T * 1024 <= WS_PART, "TINV must fit in the PROJ tail");
constexpr size_t WS_RM12 = WS_HM;
constexpr size_t WS_RM34 = WS_QKVN;
constexpr size_t WS_VSH = WS_QKVN + (size_t)(T / 64) * 8 * 16384;
static_assert((size_t)(T / 64) * 8 * 16384 <= (size_t)T * D * 2, "M1/M2 must fit in HM");
static_assert((size_t)(T / 64) * 8 * 16384 + (size_t)T * 512 * 2 <= (size_t)T * 1536 * 2, "M3/M4 + shifted v must fit in QKVN");

constexpr size_t OUT_X = 0;
constexpr size_t OUT_GLA = (size_t)T * D;
constexpr size_t OUT_RWKV = OUT_GLA + (size_t)NB_CTX * N_EVEN * 2 * 4 * 64 * 128;
constexpr size_t OUT_GDN = OUT_RWKV + (size_t)NB_CTX * N_EVEN * 2 * 8 * 64 * 64;
constexpr size_t OUT_S5R = OUT_GDN + (size_t)NB_CTX * N_ODD * 2 * 4 * 128 * 128;
constexpr size_t OUT_S5I = OUT_S5R + (size_t)NB_CTX * N_ODD * 2 * 32 * 64;

struct P {
    const float* in[44];
    float* out;
    char* ws;
};
enum { I_XP = 0, I_XS, I_C, I_SGLA, I_SRWKV, I_SGDN, I_SS5R, I_SS5I, I_CCTX, I_WMOD, I_BMOD, I_GPRE, I_GPOST,
       I_WINE, I_WOUTE, I_GUP, I_GBIAS, I_GLAN, I_MIX, I_W0, I_W2, I_A0, I_A2, I_KK, I_KA, I_RK, I_LNG, I_LNB,
       I_WINO, I_WOUTO, I_CONV, I_ALOG, I_DTB, I_GDNN, I_S5AR, I_S5AI, I_S5DT, I_S5BR, I_S5BI, I_S5CR, I_S5CI,
       I_S5D, I_GLUW, I_GLUB };

#ifdef CPU_EMU
__device__ __forceinline__ int opaque_tid() { return (int)threadIdx.x; }
#else
__device__ __forceinline__ int opaque_tid() { int t = (int)threadIdx.x; asm volatile("" : "+v"(t)); return t; }
#endif
#define LT (opaque_tid() & 255)
__device__ __forceinline__ float u2f(unsigned u) { return __builtin_bit_cast(float, u); }
__device__ __forceinline__ unsigned f2u(float f) { return __builtin_bit_cast(unsigned, f); }
__device__ __forceinline__ float bf2f(bf16 h) { return u2f((unsigned)h << 16); }
#ifdef CPU_EMU
__device__ __forceinline__ bf16 f2bf(float f) { unsigned u = f2u(f); u += 0x7fffu + ((u >> 16) & 1u); return (bf16)(u >> 16); }
__device__ __forceinline__ unsigned pack2(float lo, float hi) { return (unsigned)f2bf(lo) | ((unsigned)f2bf(hi) << 16); }
__device__ __forceinline__ float fexp(float x) { return expf(x); }
__device__ __forceinline__ float flog(float x) { return logf(x); }
__device__ __forceinline__ float frcp(float x) { return 1.0f / x; }
__device__ __forceinline__ float frsq(float x) { return 1.0f / sqrtf(x); }
#else
typedef __bf16 hwbf2 __attribute__((ext_vector_type(2)));
typedef float hwf2 __attribute__((ext_vector_type(2)));
__device__ __forceinline__ unsigned pack2(float lo, float hi) { hwf2 v = {lo, hi}; return __builtin_bit_cast(unsigned, __builtin_convertvector(v, hwbf2)); }
__device__ __forceinline__ bf16 f2bf(float f) { return (bf16)(pack2(f, 0.f) & 0xffffu); }
__device__ __forceinline__ float fexp(float x) { return __builtin_amdgcn_exp2f(x * 1.4426950408889634f); }
__device__ __forceinline__ float flog(float x) { return __builtin_amdgcn_logf(x) * 0.6931471805599453f; }
__device__ __forceinline__ float frcp(float x) { return __builtin_amdgcn_rcpf(x); }
__device__ __forceinline__ float frsq(float x) { return __builtin_amdgcn_rsqf(x); }
#endif
__device__ __forceinline__ float sigmoidf_(float x) { return frcp(1.0f + fexp(-x)); }
__device__ __forceinline__ float siluf_(float x) { return x * frcp(1.0f + fexp(-x)); }
__device__ __forceinline__ float logsigf_(float x) { return fminf(x, 0.f) - flog(1.0f + fexp(-fabsf(x))); }
__device__ __forceinline__ float softplusf_(float x) { return fmaxf(x, 0.f) + flog(1.0f + fexp(-fabsf(x))); }
__device__ __forceinline__ float ftanh(float x) { const float e = fexp(-2.0f * fabsf(x)); const float t = (1.0f - e) * frcp(1.0f + e); return x < 0.f ? -t : t; }
__device__ __forceinline__ float gelu_tanh(float x) { return 0.5f * x * (1.0f + ftanh(0.7978845608028654f * (x + 0.044715f * x * x * x))); }

typedef float f8v __attribute__((ext_vector_type(8)));
__device__ __forceinline__ f8v unpack8v(const uint4& u) {
    f8v f; f[0] = u2f(u.x << 16); f[1] = u2f(u.x & 0xffff0000u); f[2] = u2f(u.y << 16); f[3] = u2f(u.y & 0xffff0000u);
    f[4] = u2f(u.z << 16); f[5] = u2f(u.z & 0xffff0000u); f[6] = u2f(u.w << 16); f[7] = u2f(u.w & 0xffff0000u); return f;
}
__device__ __forceinline__ uint4 pack8v(const f8v& f) { return make_uint4(pack2(f[0], f[1]), pack2(f[2], f[3]), pack2(f[4], f[5]), pack2(f[6], f[7])); }
struct Seq { int start, len, cond, lat, b; };
__device__ __forceinline__ Seq get_seq(int s) {
    Seq q;
    if (s < NB_CTX) { q.start = s * L_CTX; q.len = L_CTX; q.cond = 0; q.lat = 0; q.b = s; }
    else { int b = s - NB_CTX; q.start = T_CTX + b * L_LAT; q.len = L_LAT; q.cond = 1 + b; q.lat = 1; q.b = b; }
    return q;
}
__device__ __forceinline__ int tok_cond(int t) { return t < T_CTX ? 0 : 1 + (t - T_CTX) / L_LAT; }
__device__ __forceinline__ void tok_nbr(int t, bool& hl, bool& hr) {
    if (t < T_CTX) { int pos = t % L_CTX; hl = pos != 0; hr = pos != L_CTX - 1; }
    else { int pos = (t - T_CTX) & 63; hl = pos != 0; hr = pos != 63; }
}

constexpr int MOD_VB = DEPTH * 48;
__device__ __forceinline__ void ph_mod(const P& p, int bid, float* smem) {
    float (*sc)[1024] = (float(*)[1024])smem;
    float (*red)[64][NCOND] = (float(*)[64][NCOND])smem;
    const int layer = bid / 48, ct = bid % 48;
    __syncthreads();
    const int tid = LT, c4 = (tid & 15) * 4, kg = tid >> 4;
    {
        float cv[NCOND * 4];
#pragma unroll
        for (int u = 0; u < NCOND * 4; ++u) { const int i = tid + u * 256, ci = i >> 10, k = i & 1023; cv[u] = ci == 0 ? p.in[I_CCTX][k] : p.in[I_C][(ci - 1) * 1024 + k]; }
#pragma unroll
        for (int u = 0; u < NCOND * 4; ++u) { const int i = tid + u * 256; sc[i >> 10][i & 1023] = siluf_(cv[u]); }
    }
    __syncthreads();
    f4v acc[NCOND];
#pragma unroll
    for (int ci = 0; ci < NCOND; ++ci) acc[ci] = (f4v){0.f, 0.f, 0.f, 0.f};
    const float* w = p.in[I_WMOD] + (size_t)layer * 1024 * 3072 + ct * 64 + c4;
#pragma unroll 2
    for (int k8 = 0; k8 < 8; ++k8) {
        const int k0 = kg * 64 + k8 * 8;
        f4v wv[8];
#pragma unroll
        for (int j = 0; j < 8; ++j) wv[j] = *(const f4v*)(w + (size_t)(k0 + j) * 3072);
#pragma unroll
        for (int ci = 0; ci < NCOND; ++ci) {
            const f4v s0 = *(const f4v*)&sc[ci][k0], s1 = *(const f4v*)&sc[ci][k0 + 4];
#pragma unroll
            for (int j = 0; j < 4; ++j) { acc[ci] += s0[j] * wv[j]; acc[ci] += s1[j] * wv[4 + j]; }
        }
    }
    __syncthreads();
#pragma unroll
    for (int ci = 0; ci < NCOND; ++ci)
#pragma unroll
        for (int j = 0; j < 4; ++j) red[kg][c4 + j][ci] = acc[ci][j];
    __syncthreads();
    for (int o = tid; o < 64 * NCOND; o += 256) {
        const int c = o / NCOND, ci = o % NCOND;
        float sum = p.in[I_BMOD][layer * 3072 + ct * 64 + c];
#pragma unroll
        for (int g = 0; g < 16; ++g) sum += red[g][c][ci];
        ((float*)(p.ws + WS_MOD))[(size_t)(layer * NCOND + ci) * 3072 + ct * 64 + c] = sum;
    }
}

struct WtJob { const float* src; bf16* dst; int K, N, Npad; };
__device__ __forceinline__ WtJob wt_job(const P& p, int j) {
    WtJob q;
    if (j < N_EVEN) { q.src = p.in[I_WINE] + (size_t)j * D * EW; q.dst = (bf16*)(p.ws + WS_WTE) + (size_t)j * EWP * D; q.K = D; q.N = EW; q.Npad = EWP; return q; }
    j -= N_EVEN;
    if (j < N_ODD) { q.src = p.in[I_WINO] + (size_t)j * D * OW; q.dst = (bf16*)(p.ws + WS_WTO) + (size_t)j * OWP * D; q.K = D; q.N = OW; q.Npad = OWP; return q; }
    j -= N_ODD;
    if (j < DEPTH) { int i = j >> 1; q.src = (j & 1) ? p.in[I_WOUTO] + (size_t)i * D * D : p.in[I_WOUTE] + (size_t)i * D * D; q.dst = (bf16*)(p.ws + WS_WTOUT) + (size_t)j * D * D; q.K = D; q.N = D; q.Npad = D; return q; }
    j -= DEPTH;
    q.src = p.in[I_GLUW] + (size_t)j * 512 * 512; q.dst = (bf16*)(p.ws + WS_WTGLU) + (size_t)j * 512 * 512; q.K = 512; q.N = 512; q.Npad = 512; return q;
}
constexpr int WT_NJOBS = N_EVEN + N_ODD + DEPTH + N_ODD;
constexpr int WT_TILES = N_EVEN * (EWP / 64) * 16 + N_ODD * (OWP / 64) * 16 + DEPTH * 256 + N_ODD * 64;
constexpr int WT_NT = 4;
static_assert(WT_TILES % WT_NT == 0, "WT_TILES must be a multiple of WT_NT");
__device__ __forceinline__ void ph_wt(const P& p, int bid, float* smem) {
    float (*tile)[65] = (float(*)[65])smem;
    float4 v[WT_NT][4];
    bf16* dsts[WT_NT];
    const int kk = LT >> 4, n4 = (LT & 15) * 4;
    const int nn = LT >> 2, k16 = (LT & 3) * 16;
#pragma unroll
    for (int u = 0; u < WT_NT; ++u) {
        int b = bid * WT_NT + u, j = 0;
        WtJob q;
        for (;; ++j) { q = wt_job(p, j); int nt = (q.Npad / 64) * (q.K / 64); if (b < nt) break; b -= nt; }
        const int nk = q.K / 64, n0 = (b / nk) * 64, k0 = (b % nk) * 64, n = n0 + n4;
#pragma unroll
        for (int i = 0; i < 4; ++i) {
            v[u][i] = make_float4(0.f, 0.f, 0.f, 0.f);
            if (n < q.N) v[u][i] = *(const float4*)(q.src + (size_t)(k0 + kk + 16 * i) * q.N + n);
        }
        dsts[u] = q.dst + (size_t)(n0 + nn) * q.K + k0 + k16;
    }
#pragma unroll
    for (int u = 0; u < WT_NT; ++u) {
        __syncthreads();
#pragma unroll
        for (int i = 0; i < 4; ++i) { float* tr = &tile[kk + 16 * i][n4]; tr[0] = v[u][i].x; tr[1] = v[u][i].y; tr[2] = v[u][i].z; tr[3] = v[u][i].w; }
        __syncthreads();
        f8v a, c;
#pragma unroll
        for (int j = 0; j < 8; ++j) { a[j] = tile[k16 + j][nn]; c[j] = tile[k16 + 8 + j][nn]; }
        *(uint4*)dsts[u] = pack8v(a); *(uint4*)(dsts[u] + 8) = pack8v(c);
    }
}

#ifndef PROBE_SEL
#define PROBE_SEL 0
#endif
#ifndef PROBE_BLK
#define PROBE_BLK 0
#endif
#ifndef PROBE_MUL
#define PROBE_MUL 4
#endif
#if PROBE_SEL && !defined(CPU_EMU)
extern __shared__ __attribute__((aligned(16))) unsigned char dsm_probe[];
#define PT_B(id) long long ptb_##id = 0; if (PROBE_SEL == (id)) ptb_##id = clock64()
#define PT_E(id) do { if (PROBE_SEL == (id) && blockIdx.x == PROBE_BLK && threadIdx.x == 0) { volatile unsigned long long* a_ = (volatile unsigned long long*)(dsm_probe + 163840 - 8); *a_ = *a_ + (unsigned long long)(clock64() - ptb_##id); } } while (0)
#else
#define PT_B(id) do {} while (0)
#define PT_E(id) do {} while (0)
#endif
constexpr int NTW = 3;
__device__ __forceinline__ float wave_sum(float v) {
#pragma unroll
    for (int m = 1; m < 64; m <<= 1) v += __shfl_xor(v, m);
    return v;
}
__device__ __forceinline__ void hmod_row(const float* xv  , int lane, const float* gpre, const float* mod, bf16* dst) {
    float ss = 0.f;
#pragma unroll
    for (int i = 0; i < 16; ++i) ss += xv[i] * xv[i];
    ss = wave_sum(ss);
    const float r = frsq(ss * (1.0f / 1024.f) + EPS);
#pragma unroll
    for (int i = 0; i < 4; ++i) {
        int idx = i * 256 + lane * 4;
        const float4 g = *(const float4*)(gpre + idx), sc = *(const float4*)(mod + 1024 + idx), sh = *(const float4*)(mod + idx);
        *(uint2*)(dst + idx) = make_uint2(pack2(xv[i * 4] * r * g.x * (1.0f + sc.x) + sh.x, xv[i * 4 + 1] * r * g.y * (1.0f + sc.y) + sh.y),
                                          pack2(xv[i * 4 + 2] * r * g.z * (1.0f + sc.z) + sh.z, xv[i * 4 + 3] * r * g.w * (1.0f + sc.w) + sh.w));
    }
}
__device__ __forceinline__ void ph_hmod0(const P& p, int bid) {
    const int lane = LT & 63, tb = bid * (4 * NTW) + (LT >> 6) * NTW;
    if (tb >= T) return;
    float xv[NTW][16];
#pragma unroll
    for (int u = 0; u < NTW; ++u) {
        const int t = (tb + u < T) ? tb + u : T - 1;
        const float* xr = t < T_CTX ? p.in[I_XP] + (size_t)t * D : p.in[I_XS] + (size_t)(t - T_CTX) * D;
#pragma unroll
        for (int i = 0; i < 4; ++i) { float4 v = *(const float4*)(xr + i * 256 + lane * 4); xv[u][i * 4] = v.x; xv[u][i * 4 + 1] = v.y; xv[u][i * 4 + 2] = v.z; xv[u][i * 4 + 3] = v.w; }
    }
#pragma unroll
    for (int u = 0; u < NTW; ++u) {
        const int t = tb + u; if (t >= T) break;
        const float* mod = (const float*)(p.ws + WS_MOD) + (size_t)(0 * NCOND + tok_cond(t)) * 3072;
        hmod_row(xv[u], lane, p.in[I_GPRE], mod, (bf16*)(p.ws + WS_HM) + (size_t)t * D);
    }
}
__device__ __forceinline__ void ph_post(const P& p, int bid, int layer) {
    const int lane = LT & 63, tb = bid * (4 * NTW) + (LT >> 6) * NTW;
    if (tb >= T) return;
    const float* gpost = p.in[I_GPOST] + layer * D;
    float xv[NTW][16], mv[NTW][16];
#pragma unroll
    for (int u = 0; u < NTW; ++u) {
        const int t = (tb + u < T) ? tb + u : T - 1;
        const bf16* mr = (const bf16*)(p.ws + WS_PROJ) + (size_t)t * D;
        if (layer == 0) {
            const float* xr = t < T_CTX ? p.in[I_XP] + (size_t)t * D : p.in[I_XS] + (size_t)(t - T_CTX) * D;
#pragma unroll
            for (int i = 0; i < 4; ++i) { float4 v = *(const float4*)(xr + i * 256 + lane * 4); xv[u][i * 4] = v.x; xv[u][i * 4 + 1] = v.y; xv[u][i * 4 + 2] = v.z; xv[u][i * 4 + 3] = v.w; }
        } else {
            const bf16* xb = (const bf16*)(p.out + OUT_X + (size_t)t * D + 512);
#pragma unroll
            for (int i = 0; i < 4; ++i) { const uint2 w = *(const uint2*)(xb + i * 256 + lane * 4); xv[u][i * 4] = u2f(w.x << 16); xv[u][i * 4 + 1] = u2f(w.x & 0xffff0000u); xv[u][i * 4 + 2] = u2f(w.y << 16); xv[u][i * 4 + 3] = u2f(w.y & 0xffff0000u); }
        }
#pragma unroll
        for (int i = 0; i < 4; ++i) { const uint2 w = *(const uint2*)(mr + i * 256 + lane * 4); mv[u][i * 4] = u2f(w.x << 16); mv[u][i * 4 + 1] = u2f(w.x & 0xffff0000u); mv[u][i * 4 + 2] = u2f(w.y << 16); mv[u][i * 4 + 3] = u2f(w.y & 0xffff0000u); }
    }
#pragma unroll
    for (int u = 0; u < NTW; ++u) {
        const int t = tb + u; if (t >= T) break;
        const float* mod = (const float*)(p.ws + WS_MOD) + (size_t)(layer * NCOND + tok_cond(t)) * 3072;
        float* xo = p.out + OUT_X + (size_t)t * D;
        bf16* xb = (bf16*)(xo + 512);
        float ss = 0.f;
#pragma unroll
        for (int i = 0; i < 16; ++i) ss += mv[u][i] * mv[u][i];
        ss = wave_sum(ss);
        const float r = frsq(ss * (1.0f / 1024.f) + EPS);
#pragma unroll
        for (int i = 0; i < 4; ++i) {
            const int idx = i * 256 + lane * 4;
            const float4 gt = *(const float4*)(mod + 2048 + idx), gp = *(const float4*)(gpost + idx);
            xv[u][i * 4] += gt.x * (mv[u][i * 4] * r * gp.x); xv[u][i * 4 + 1] += gt.y * (mv[u][i * 4 + 1] * r * gp.y);
            xv[u][i * 4 + 2] += gt.z * (mv[u][i * 4 + 2] * r * gp.z); xv[u][i * 4 + 3] += gt.w * (mv[u][i * 4 + 3] * r * gp.w);
        }
        if (layer + 1 < DEPTH) {
#pragma unroll
            for (int i = 0; i < 4; ++i) *(uint2*)(xb + i * 256 + lane * 4) = make_uint2(pack2(xv[u][i * 4], xv[u][i * 4 + 1]), pack2(xv[u][i * 4 + 2], xv[u][i * 4 + 3]));
            const float* mod2 = (const float*)(p.ws + WS_MOD) + (size_t)((layer + 1) * NCOND + tok_cond(t)) * 3072;
            hmod_row(xv[u], lane, p.in[I_GPRE] + (layer + 1) * D, mod2, (bf16*)(p.ws + WS_HM) + (size_t)t * D);
        } else {
#pragma unroll
            for (int i = 0; i < 4; ++i) *(float4*)(xo + i * 256 + lane * 4) = make_float4(xv[u][i * 4], xv[u][i * 4 + 1], xv[u][i * 4 + 2], xv[u][i * 4 + 3]);
        }
    }
}

#ifdef CPU_EMU
#define LDS_AS
#define GLDS16(gptr, lptr) memcpy((char*)(lptr) + (threadIdx.x & 63) * 16, (const void*)(gptr), 16)
#define PG_WAIT_V(n)
#define PG_WAIT_L(n)
#define PG_BAR __syncthreads()
#define PG_SCHED
#define PG_PRIO(x)
#define RFL(x) (x)
__device__ __forceinline__ unsigned cvt_pk_bf16(float lo, float hi) { return (unsigned)f2bf(lo) | ((unsigned)f2bf(hi) << 16); }
#else
#define LDS_AS __attribute__((address_space(3)))
#define GLDS16(gptr, lptr) __builtin_amdgcn_global_load_lds((const unsigned*)(gptr), (LDS_AS unsigned*)(lptr), 16, 0, 0)
#define PG_WAIT_V(n) asm volatile("s_waitcnt vmcnt(" #n ")" ::: "memory")
#define PG_WAIT_L(n) asm volatile("s_waitcnt lgkmcnt(" #n ")" ::: "memory")
#define PG_BAR __builtin_amdgcn_s_barrier()
#define PG_SCHED __builtin_amdgcn_sched_barrier(0)
#define PG_PRIO(x) __builtin_amdgcn_s_setprio(x)
#define RFL(x) __builtin_amdgcn_readfirstlane(x)
__device__ __forceinline__ unsigned cvt_pk_bf16(float lo, float hi) { return pack2(lo, hi); }
#endif
namespace pg8 {
constexpr int BM = 256, BK = 64, HALF = 128, HTB = HALF * BK * 2, STAGE_BYTES = 8 * HTB, NXCD = 8, WGM = 8;
__host__ __device__ __forceinline__ int lds_byte(int r, int c) { const int st = (r >> 4) * 2 + (c >> 5), rr = r & 15, cc = c & 31, ob = rr * 64 + cc * 2; return st * 1024 + (ob ^ (((ob >> 9) & 1) << 5)); }
__host__ __device__ __forceinline__ void stage_rc(int b, int& R, int& C) { const int st = b / 1024, sb = b % 1024, swz = sb ^ (((sb >> 9) & 1) << 5); R = (st >> 1) * 16 + swz / 64; C = (st & 1) * 32 + (swz % 64) / 2; }
__host__ __device__ __forceinline__ int perm32(int rho) { const int n = rho >> 4, i = rho & 15; return 8 * (i >> 2) + 4 * n + (i & 3); }
struct Unit { int pm, pn; };
struct Gemm { const bf16* A; const bf16* Bt; int M, N, K, lda; };
struct StaticOrder {
    int nM, nN, nwg, G, c;
    __host__ __device__ void init(int M, int N, int G_, int c_) { nM = M / BM; nN = N / BM; nwg = nM * nN; G = G_; c = c_; }
    __host__ __device__ bool next(int i, Unit& u) const {
        const long L = (long)i * G + c; if (L >= nwg) return false;
        int wgid = (int)L; { const int q = nwg / NXCD, r = nwg % NXCD, xcd = wgid % NXCD, off = wgid / NXCD; wgid = (xcd < r ? xcd * (q + 1) : r * (q + 1) + (xcd - r) * q) + off; }
        const int nig = WGM * nN, gid = wgid / nig, fm = gid * WGM, gsz = (nM - fm) < WGM ? (nM - fm) : WGM;
        u.pm = fm + ((wgid % nig) % gsz); u.pn = (wgid % nig) / gsz; return true;
    }
};
struct EpiF32 {
    static constexpr bool PERM = false;
    float* C; int ldc;
    __device__ __forceinline__ void operator()(const f4v (&acc)[2][2][4][2], const Unit& u, int wr, int wc, int fr, int fq) const {
        const int row0 = u.pm * BM + wr * 64 + fr, col0 = u.pn * BM + wc * 32 + 4 * fq;
#pragma unroll
        for (int ai = 0; ai < 2; ++ai)
#pragma unroll
            for (int m = 0; m < 4; ++m) { float* rowp = C + (size_t)(row0 + ai * HALF + m * 16) * ldc + col0;
#pragma unroll
                for (int bj = 0; bj < 2; ++bj)
#pragma unroll
                    for (int n = 0; n < 2; ++n) *(f4v*)(rowp + bj * HALF + n * 16) = acc[ai][bj][m][n]; }
    }
};
struct EpiBf16 {
    static constexpr bool PERM = true;
    bf16* O; int ldc; int N;
    __device__ __forceinline__ void operator()(const f4v (&acc)[2][2][4][2], const Unit& u, int wr, int wc, int fr, int fq) const {
        const int row0 = u.pm * BM + wr * 64 + fr, col0 = u.pn * BM + wc * 32 + 8 * fq;
#pragma unroll
        for (int ai = 0; ai < 2; ++ai)
#pragma unroll
            for (int m = 0; m < 4; ++m) { bf16* rowp = O + (size_t)(row0 + ai * HALF + m * 16) * ldc + col0;
#pragma unroll
                for (int bj = 0; bj < 2; ++bj) { const f4v v0 = acc[ai][bj][m][0], v1 = acc[ai][bj][m][1];
                    if (col0 + bj * HALF < N) *(uint4*)(rowp + bj * HALF) = make_uint4(cvt_pk_bf16(v0[0], v0[1]), cvt_pk_bf16(v0[2], v0[3]), cvt_pk_bf16(v1[0], v1[1]), cvt_pk_bf16(v1[2], v1[3])); } }
    }
};
struct EpiGlu {
    static constexpr bool PERM = true;
    bf16* O; const bf16* YS; const bf16* ZD; const float* GB;
    __device__ __forceinline__ void operator()(const f4v (&acc)[2][2][4][2], const Unit& u, int wr, int wc, int fr, int fq) const {
        const int row0 = u.pm * BM + wr * 64 + fr, col0 = u.pn * BM + wc * 32 + 8 * fq;
        f8v gb[2];
#pragma unroll
        for (int bj = 0; bj < 2; ++bj) gb[bj] = *(const f8v*)(GB + col0 + bj * HALF);
#pragma unroll
        for (int am = 0; am < 4; ++am) {
            const int ai = am >> 1, m0 = (am & 1) * 2;
            uint4 ysr[2][2], zdr[2][2];
#pragma unroll
            for (int mm = 0; mm < 2; ++mm)
#pragma unroll
                for (int bj = 0; bj < 2; ++bj) { const size_t row = (size_t)(row0 + ai * HALF + (m0 + mm) * 16); const int col = col0 + bj * HALF;
                    ysr[mm][bj] = *(const uint4*)(YS + row * 512 + col); zdr[mm][bj] = *(const uint4*)(ZD + row * OW + col); }
#pragma unroll
            for (int mm = 0; mm < 2; ++mm)
#pragma unroll
                for (int bj = 0; bj < 2; ++bj) { const size_t row = (size_t)(row0 + ai * HALF + (m0 + mm) * 16); const int col = col0 + bj * HALF;
                    const f8v ys = unpack8v(ysr[mm][bj]), zd = unpack8v(zdr[mm][bj]);
                    f8v o;
#pragma unroll
                    for (int j = 0; j < 8; ++j) { const float g = (j < 4 ? acc[ai][bj][m0 + mm][0][j] : acc[ai][bj][m0 + mm][1][j - 4]) + gb[bj][j]; o[j] = ys[j] * sigmoidf_(g) * siluf_(zd[j]); }
                    *(uint4*)(O + row * D + col) = pack8v(o); }
        }
    }
};
template <class Epi>
__device__ __forceinline__ void gemm_phase(LDS_AS unsigned char* lds, const Gemm g, const StaticOrder& S, const Epi& E) {
    const int tid = opaque_tid(), wid = RFL(tid >> 6), lane = tid & 63, wr = wid >> 2, wc = wid & 3, fr = lane & 15, fq = lane >> 4;
    const int K = g.K, nt = K / BK;
    unsigned voffA[2], voffB[2];
#pragma unroll
    for (int i = 0; i < 2; ++i) { int R, C; stage_rc(tid * 16 + i * 8192, R, C); const int Rb = Epi::PERM ? ((R & ~31) + perm32(R & 31)) : R;
        voffA[i] = (unsigned)(R * g.lda + C) * 2u; voffB[i] = (unsigned)(Rb * K + C) * 2u; }
    const size_t kstep = (size_t)(BK * 2);
    const size_t hstepA = (size_t)HALF * g.lda * 2, hstepB = (size_t)HALF * K * 2;
    const size_t tstepA = 2 * hstepA, tstepB = 2 * hstepB;
    const unsigned ldsw = (unsigned)wid * 1024u;
    const int aoff = lds_byte(wr * 64 + fr, fq * 8), boff = lds_byte(wc * 32 + fr, fq * 8);
#define PG8_SA(b, h) (((b) * 2 + (h)) * HTB)
#define PG8_SB(b, h) ((4 + (b) * 2 + (h)) * HTB)
#define PG8_STAGE(bufoff, gbase, voff) do { _Pragma("unroll") for (int _i = 0; _i < 2; ++_i) GLDS16((const char*)(gbase) + (voff)[_i], lds + (bufoff) + ldsw + _i * 8192); } while (0)
#define PG8_LDA(dst, b, h) do { _Pragma("unroll") for (int m = 0; m < 4; ++m) _Pragma("unroll") for (int k = 0; k < 2; ++k) dst[m][k] = *(const LDS_AS s8v*)(lds + PG8_SA(b, h) + aoff + m * 2048 + k * 1024); } while (0)
#define PG8_LDB(dst, b, h) do { _Pragma("unroll") for (int n = 0; n < 2; ++n) _Pragma("unroll") for (int k = 0; k < 2; ++k) dst[n][k] = *(const LDS_AS s8v*)(lds + PG8_SB(b, h) + boff + n * 2048 + k * 1024); } while (0)
#define PG8_MMA(ai, bj, At, Bt) do { PG_PRIO(1); _Pragma("unroll") for (int m = 0; m < 4; ++m) _Pragma("unroll") for (int n = 0; n < 2; ++n) _Pragma("unroll") for (int k = 0; k < 2; ++k) \
        acc[ai][bj][m][n] = __builtin_amdgcn_mfma_f32_16x16x32_bf16(Bt[n][k], At[m][k], acc[ai][bj][m][n], 0, 0, 0); PG_PRIO(0); } while (0)
    Unit cur, nxt; int ui = 0;
    if (!S.next(0, cur)) return;
    f4v acc[2][2][4][2];
#pragma unroll
    for (int a = 0; a < 2; ++a)
#pragma unroll
        for (int b = 0; b < 2; ++b)
#pragma unroll
            for (int m = 0; m < 4; ++m)
#pragma unroll
                for (int n = 0; n < 2; ++n) acc[a][b][m][n] = (f4v){0.f, 0.f, 0.f, 0.f};
    s8v At[4][2], B0[2][2], B1[2][2];
    const char* cA = (const char*)g.A + (size_t)cur.pm * tstepA; const char* cB = (const char*)g.Bt + (size_t)cur.pn * tstepB;
    PG8_STAGE(PG8_SB(0, 0), cB, voffB); PG8_STAGE(PG8_SA(0, 0), cA, voffA); PG8_STAGE(PG8_SB(0, 1), cB + hstepB, voffB); PG8_STAGE(PG8_SA(0, 1), cA + hstepA, voffA);
    if (wr == 1) PG_BAR;
    PG_WAIT_V(4); PG_BAR;
    PG8_STAGE(PG8_SB(1, 0), cB + kstep, voffB); PG8_STAGE(PG8_SA(1, 0), cA + kstep, voffA); PG8_STAGE(PG8_SB(1, 1), cB + hstepB + kstep, voffB);
    PG_WAIT_V(6); PG_BAR;
    for (;;) {
        const bool has_next = S.next(ui + 1, nxt);
        const char* nA = has_next ? (const char*)g.A + (size_t)nxt.pm * tstepA : cA; const char* nB = has_next ? (const char*)g.Bt + (size_t)nxt.pn * tstepB : cB;
        for (int t = 0; t < nt; t += 2) {
            const bool last = (t == nt - 2);
            const char* a1 = cA + (size_t)(t + 1) * kstep;
            const char* a2 = last ? nA : cA + (size_t)(t + 2) * kstep; const char* b2 = last ? nB : cB + (size_t)(t + 2) * kstep;
            const char* a3 = a2 + kstep; const char* b3 = b2 + kstep;
            PG8_LDB(B0, 0, 0); PG_SCHED; PG8_LDA(At, 0, 0); PG8_STAGE(PG8_SA(1, 1), a1 + hstepA, voffA);
            PG_WAIT_L(8); PG_BAR; PG_WAIT_L(0); PG8_MMA(0, 0, At, B0); PG_BAR; PG_SCHED;
            PG8_LDB(B1, 0, 1); PG8_STAGE(PG8_SB(0, 0), b2, voffB);
            PG_BAR; PG_WAIT_L(0); PG8_MMA(0, 1, At, B1); PG_BAR;
            PG8_LDA(At, 0, 1); PG8_STAGE(PG8_SA(0, 0), a2, voffA);
            PG_BAR; PG_WAIT_L(0); PG8_MMA(1, 0, At, B0); PG_BAR; PG_SCHED;
            PG8_STAGE(PG8_SB(0, 1), b2 + hstepB, voffB);
            PG_WAIT_V(6); PG_BAR; PG8_MMA(1, 1, At, B1); PG_BAR;
            PG8_LDB(B0, 1, 0); PG_SCHED; PG8_LDA(At, 1, 0); PG8_STAGE(PG8_SA(0, 1), a2 + hstepA, voffA);
            PG_WAIT_L(8); PG_BAR; PG_WAIT_L(0); PG8_MMA(0, 0, At, B0); PG_BAR; PG_SCHED;
            PG8_LDB(B1, 1, 1); PG8_STAGE(PG8_SB(1, 0), b3, voffB);
            PG_BAR; PG_WAIT_L(0); PG8_MMA(0, 1, At, B1); PG_BAR;
            PG8_LDA(At, 1, 1); PG8_STAGE(PG8_SA(1, 0), a3, voffA);
            PG_BAR; PG_WAIT_L(0); PG8_MMA(1, 0, At, B0); PG_BAR; PG_SCHED;
            PG8_STAGE(PG8_SB(1, 1), b3 + hstepB, voffB);
            PG_WAIT_V(6); PG_BAR; PG8_MMA(1, 1, At, B1); PG_BAR;
        }
        E(acc, cur, wr, wc, fr, fq);
        if (!has_next) break;
#pragma unroll
        for (int a = 0; a < 2; ++a)
#pragma unroll
            for (int b = 0; b < 2; ++b)
#pragma unroll
                for (int m = 0; m < 4; ++m)
#pragma unroll
                    for (int n = 0; n < 2; ++n) acc[a][b][m][n] = (f4v){0.f, 0.f, 0.f, 0.f};
        cur = nxt; cA = nA; cB = nB; ++ui;
    }
    PG_WAIT_V(0);
    if (wr == 0) PG_BAR;
    PG_BAR;
}
}

#ifdef CPU_EMU
#define WAVE_SYNC() emu::wsync()
#define LBAR() __syncthreads()
#else
#define WAVE_SYNC() __builtin_amdgcn_wave_barrier()
#define LBAR() do { asm volatile("s_waitcnt lgkmcnt(0)" ::: "memory"); __builtin_amdgcn_s_barrier(); asm volatile("" ::: "memory"); } while (0)
#endif
__device__ __forceinline__ void unpack8(const uint4& u, float* f) {
    f[0] = u2f(u.x << 16); f[1] = u2f(u.x & 0xffff0000u); f[2] = u2f(u.y << 16); f[3] = u2f(u.y & 0xffff0000u);
    f[4] = u2f(u.z << 16); f[5] = u2f(u.z & 0xffff0000u); f[6] = u2f(u.w << 16); f[7] = u2f(u.w & 0xffff0000u);
}
__device__ __forceinline__ uint4 pack8(const float* f) { return make_uint4(pack2(f[0], f[1]), pack2(f[2], f[3]), pack2(f[4], f[5]), pack2(f[6], f[7])); }
__device__ __forceinline__ f4v unpack4(const uint2& u) { f4v f; f[0] = u2f(u.x << 16); f[1] = u2f(u.x & 0xffff0000u); f[2] = u2f(u.y << 16); f[3] = u2f(u.y & 0xffff0000u); return f; }
__device__ __forceinline__ uint2 pack4(const f4v& f) { return make_uint2(pack2(f[0], f[1]), pack2(f[2], f[3])); }
__device__ __forceinline__ f4v mfma16(const s8v& a, const s8v& b, const f4v& c) { return __builtin_amdgcn_mfma_f32_16x16x32_bf16(a, b, c, 0, 0, 0); }

__device__ __forceinline__ float red8(float x) {
#ifdef CPU_EMU
    x += __shfl_xor(x, 1); x += __shfl_xor(x, 2); x += __shfl_xor(x, 4);
#else
    x += __builtin_bit_cast(float, __builtin_amdgcn_mov_dpp(__builtin_bit_cast(int, x), 0xB1, 0xF, 0xF, true));
    x += __builtin_bit_cast(float, __builtin_amdgcn_mov_dpp(__builtin_bit_cast(int, x), 0x4E, 0xF, 0xF, true));
    x += __builtin_bit_cast(float, __builtin_amdgcn_mov_dpp(__builtin_bit_cast(int, x), 0x141, 0xF, 0xF, true));
#endif
    return x;
}
__device__ __forceinline__ float red16(float x) {
    x = red8(x);
#ifdef CPU_EMU
    x += __shfl_xor(x, 8);
#else
    x += __builtin_bit_cast(float, __builtin_amdgcn_mov_dpp(__builtin_bit_cast(int, x), 0x140, 0xF, 0xF, true));
#endif
    return x;
}
constexpr int TI_LD = 68, TI_TLD = 20;
__device__ __forceinline__ void ti_mm16(float* dst, int ldd, const float* L, int ldl, const float* R, int ldr, float sgn, const float* add, int lda, int lane) {
    const int r = lane >> 2, c4 = (lane & 3) * 4;
    f4v acc = (f4v){0.f, 0.f, 0.f, 0.f};
#pragma unroll
    for (int k = 0; k < 16; ++k) { const float l = L[r * ldl + k]; const f4v rv = *(const f4v*)(R + k * ldr + c4); acc += l * rv; }
    acc *= sgn;
    if (add) acc += *(const f4v*)(add + r * lda + c4);
    *(f4v*)(dst + r * ldd + c4) = acc;
}
__device__ __forceinline__ float red4(float x) {
#ifdef CPU_EMU
    x += __shfl_xor(x, 1); x += __shfl_xor(x, 2);
#else
    x += __builtin_bit_cast(float, __builtin_amdgcn_mov_dpp(__builtin_bit_cast(int, x), 0xB1, 0xF, 0xF, true));
    x += __builtin_bit_cast(float, __builtin_amdgcn_mov_dpp(__builtin_bit_cast(int, x), 0x4E, 0xF, 0xF, true));
#endif
    return x;
}
__device__ __forceinline__ void tri_inv64(const float* A, float* X, float* TMP, int wl, int lane, bool active) {
    wl = RFL(wl);
#define TI_A(a, b) (A + (16 * (a)) * TI_LD + 16 * (b))
#define TI_X(a, b) (X + (16 * (a)) * TI_LD + 16 * (b))
#define TI_T(n) (TMP + (n) * 16 * TI_TLD)
    if (active) {
        const int c = lane >> 2, js = lane & 3;
        float xr[4] = {0.f, 0.f, 0.f, 0.f};
        const float* Ab = TI_A(wl, wl);
#pragma unroll
        for (int i = 0; i < 16; ++i) {
            float part = 0.f;
#pragma unroll
            for (int m = 0; m <= (i - 1) / 4 && i > 0; ++m) { const int j = 4 * m + js; part += (j < i ? Ab[i * TI_LD + j] : 0.f) * xr[m]; }
            const float tot = red4(part);
            const float xi = (i == c ? 1.f : 0.f) - tot;
            xr[i >> 2] = ((i & 3) == js) ? xi : xr[i >> 2];
        }
        float* Xb = TI_X(wl, wl);
#pragma unroll
        for (int m = 0; m < 4; ++m) Xb[(4 * m + js) * TI_LD + c] = xr[m];
        for (int b = wl + 1; b < 4; ++b) { float* Z = TI_X(wl, b); const int r = lane >> 2, c4 = (lane & 3) * 4; *(f4v*)(Z + r * TI_LD + c4) = (f4v){0.f, 0.f, 0.f, 0.f}; }
    }
    LBAR();
    if (active && wl < 3) {
        const int col = lane & 15, g4 = (lane >> 4) * 4;
        const f4v zero = (f4v){0.f, 0.f, 0.f, 0.f};
#define TI_MMA(Lp, Bv, ACC) do { const f4v a_ = *(const f4v*)((Lp) + col * TI_LD + g4); _Pragma("unroll") for (int ks_ = 0; ks_ < 4; ++ks_) ACC = __builtin_amdgcn_mfma_f32_16x16x4f32(a_[ks_], (Bv)[ks_], ACC, 0, 0, 0); } while (0)
#define TI_ST(Dp, Cv) do { _Pragma("unroll") for (int r_ = 0; r_ < 4; ++r_) (Dp)[(g4 + r_) * TI_LD + col] = (Cv)[r_]; } while (0)
        f4v xb[4];
#pragma unroll
        for (int r = 0; r < 4; ++r) xb[0][r] = TI_X(wl, wl)[(g4 + r) * TI_LD + col];
#pragma unroll
        for (int a2 = 1; a2 < 4; ++a2) {
            const int ar = wl + a2;
            if (ar < 4) {
                f4v t = zero;
#pragma unroll
                for (int j = 0; j < a2; ++j) TI_MMA(TI_A(ar, wl + j), xb[j], t);
                f4v x = zero;
                TI_MMA(TI_X(ar, ar), t, x);
                x = -x;
                xb[a2] = x;
                TI_ST(TI_X(ar, wl), x);
            }
        }
#undef TI_MMA
#undef TI_ST
    }
    LBAR();
#undef TI_A
#undef TI_X
#undef TI_T
}

constexpr int GL_LD = 72;
__device__ __forceinline__ void gla_scan_task(const P& p, int ei, int s, int h, int dir, unsigned char* dsm) {
    bf16* LAt = (bf16*)dsm;
    bf16* Qd = LAt + 64 * GL_LD;
    bf16* Ki = Qd + 64 * GL_LD;
    bf16* KiT = Ki + 64 * GL_LD;
    bf16* Sc = KiT + 64 * GL_LD;
    bf16* VT = Sc + 64 * GL_LD;
    bf16* St = VT + 128 * GL_LD;
    float* sAE = (float*)(St + 128 * GL_LD);
    float* Of = sAE + 64;
    const Seq sq_ = get_seq(s);
    const int tid = opaque_tid(), lane = tid & 63, wid = tid >> 6, fr = lane & 15, fq = lane >> 4;
    const int rt = wid & 3, chf = wid >> 2;
    const bf16* proj = (const bf16*)(p.ws + WS_PROJ);
    bf16* opart = (bf16*)(p.ws + WS_PART);
    s8v gfrag[2]; float gb[2];
    {
        const float* gup = p.in[I_GUP] + (size_t)(ei * 2 + dir) * 16 * 256 + h * 64;
        const float* gbias = p.in[I_GBIAS] + (size_t)(ei * 2 + dir) * 256 + h * 64;
#pragma unroll
        for (int c2 = 0; c2 < 2; ++c2) {
            const int d = 16 * (2 * chf + c2) + fr;
            gb[c2] = gbias[d];
#pragma unroll
            for (int j = 0; j < 8; ++j) gfrag[c2][j] = (short)f2bf(fq < 2 ? gup[(8 * fq + j) * 256 + d] : 0.f);
        }
    }
    f4v Sacc[4];
    LBAR();
    if (sq_.lat) {
        const float* s0 = p.in[I_SGLA] + ((((size_t)sq_.b * N_EVEN + ei) * 2 + dir) * 4 + h) * 64 * 128;
#pragma unroll
        for (int ct = 0; ct < 4; ++ct)
#pragma unroll
            for (int r = 0; r < 4; ++r) Sacc[ct][r] = s0[(16 * rt + fq * 4 + r) * 128 + 64 * chf + 16 * ct + fr];
    } else {
#pragma unroll
        for (int ct = 0; ct < 4; ++ct) Sacc[ct] = (f4v){0.f, 0.f, 0.f, 0.f};
    }
#pragma unroll
    for (int ct = 0; ct < 4; ++ct) *(uint2*)(St + (64 * chf + 16 * ct + fr) * GL_LD + 16 * rt + fq * 4) = make_uint2(pack2(Sacc[ct][0], Sacc[ct][1]), pack2(Sacc[ct][2], Sacc[ct][3]));
    const int nch = sq_.len >> 6;
    uint4 pv0, pv1, pq, pkk, pga;
#define GLA_FETCH(TB) do { \
        { const int i_ = lane, c8_ = wid * 8; const bf16* pr_ = proj + (size_t)((TB) + (dir ? 63 - i_ : i_)) * EW + E_V + h * 128 + c8_; \
          pv0 = *(const uint4*)pr_; pv1 = *(const uint4*)(pr_ + 64); } \
        { const int i_ = tid >> 3, c8_ = (tid & 7) * 8; const bf16* pr_ = proj + (size_t)((TB) + (dir ? 63 - i_ : i_)) * EW + h * 64 + c8_; \
          pq = *(const uint4*)(pr_ + E_Q); pkk = *(const uint4*)(pr_ + E_K); } \
        { const int i_ = 16 * rt + fr; pga = make_uint4(0u, 0u, 0u, 0u); if (fq < 2) pga = *(const uint4*)(proj + (size_t)((TB) + (dir ? 63 - i_ : i_)) * EW + E_GD + dir * 16 + fq * 8); } \
    } while (0)
    GLA_FETCH(sq_.start + (dir ? sq_.len - 64 : 0));
    uint4 gf0 = make_uint4(0u, 0u, 0u, 0u), gf1 = gf0, gz0 = gf0, gz1 = gf0;
    f8v gn0 = (f8v)(0.f), gn1 = (f8v)(0.f);
#define GLA_FIN_FETCH(TB) do { const int i_ = tid >> 3, d0_ = (tid & 7) * 16, t_ = (TB) + 63 - i_; \
        const bf16* ofp_ = opart + (size_t)t_ * 512 + h * 128 + d0_; const bf16* zap_ = proj + (size_t)t_ * EW + E_ZA + h * 128 + d0_; \
        gf0 = *(const uint4*)ofp_; gf1 = *(const uint4*)(ofp_ + 8); gz0 = *(const uint4*)zap_; gz1 = *(const uint4*)(zap_ + 8); } while (0)
    if (dir == 1) {
        const float* gn = p.in[I_GLAN] + ei * 128 + (tid & 7) * 16;
        gn0 = *(const f8v*)gn; gn1 = *(const f8v*)(gn + 8);
        GLA_FIN_FETCH(sq_.start + sq_.len - 64);
    }
    for (int cc = 0; cc < nch; ++cc) {
        const int tb = sq_.start + (dir ? sq_.len - 64 - cc * 64 : cc * 64);
        {
            {
                const int i = lane, c8 = wid * 8;
                const f8v va = unpack8v(pv0), vb = unpack8v(pv1);
#pragma unroll
                for (int j = 0; j < 8; ++j) { VT[(c8 + j) * GL_LD + i] = f2bf(va[j]); VT[(64 + c8 + j) * GL_LD + i] = f2bf(vb[j]); }
            }
            { const int i = tid >> 3, c8 = (tid & 7) * 8; *(uint4*)(Qd + i * GL_LD + c8) = pq; *(uint4*)(Ki + i * GL_LD + c8) = pkk; }
            const s8v ga = __builtin_bit_cast(s8v, pga);
            if (cc + 1 < nch) GLA_FETCH(sq_.start + (dir ? sq_.len - 128 - cc * 64 : (cc + 1) * 64));
#pragma unroll
            for (int c2 = 0; c2 < 2; ++c2) {
                const f4v x = mfma16(ga, gfrag[c2], (f4v){0.f, 0.f, 0.f, 0.f});
                float la[4];
#pragma unroll
                for (int r = 0; r < 4; ++r) la[r] = logsigf_(x[r] + gb[c2]) * (1.0f / 16.0f);
                *(uint2*)(LAt + (16 * (2 * chf + c2) + fr) * GL_LD + 16 * rt + fq * 4) = make_uint2(pack2(la[0], la[1]), pack2(la[2], la[3]));
            }
        }
        LBAR();
        {
            f4v bc[2];
            bc[0] = (f4v){0.f, 0.f, 0.f, 0.f}; bc[1] = bc[0];
#pragma unroll
            for (int ks = 0; ks < 2; ++ks) {
                s8v lf;
#pragma unroll
                for (int j = 0; j < 8; ++j) lf[j] = (32 * ks + 8 * fq + j <= 16 * rt + fr) ? (short)0x3F80 : (short)0;
#pragma unroll
                for (int c2 = 0; c2 < 2; ++c2) bc[c2] = mfma16(lf, *(const s8v*)(LAt + (16 * (2 * chf + c2) + fr) * GL_LD + 32 * ks + 8 * fq), bc[c2]);
            }
#pragma unroll
            for (int c2 = 0; c2 < 2; ++c2) {
                const int d = 16 * (2 * chf + c2) + fr;
                float kiv[4];
#pragma unroll
                for (int r = 0; r < 4; ++r) {
                    const int i = 16 * rt + fq * 4 + r;
                    const float eb = fexp(bc[c2][r]);
                    const float qv = bf2f(Qd[i * GL_LD + d]) * 0.125f * eb;
                    kiv[r] = bf2f(Ki[i * GL_LD + d]) * frcp(eb);
                    Qd[i * GL_LD + d] = f2bf(qv); Ki[i * GL_LD + d] = f2bf(kiv[r]);
                    if (i == 63) sAE[d] = eb;
                }
                *(uint2*)(KiT + d * GL_LD + 16 * rt + fq * 4) = make_uint2(pack2(kiv[0], kiv[1]), pack2(kiv[2], kiv[3]));
            }
        }
        LBAR();
        f4v oacc[4];
        {
            f4v sc[2];
            sc[0] = (f4v){0.f, 0.f, 0.f, 0.f}; sc[1] = sc[0];
#pragma unroll
            for (int ct = 0; ct < 4; ++ct) oacc[ct] = (f4v){0.f, 0.f, 0.f, 0.f};
#pragma unroll
            for (int ks = 0; ks < 2; ++ks) {
                const s8v a = *(const s8v*)(Qd + (16 * rt + fr) * GL_LD + 32 * ks + 8 * fq);
#pragma unroll
                for (int c2 = 0; c2 < 2; ++c2) sc[c2] = mfma16(a, *(const s8v*)(Ki + (16 * (2 * chf + c2) + fr) * GL_LD + 32 * ks + 8 * fq), sc[c2]);
#pragma unroll
                for (int ct = 0; ct < 4; ++ct) oacc[ct] = mfma16(*(const s8v*)(St + (64 * chf + 16 * ct + fr) * GL_LD + 32 * ks + 8 * fq), a, oacc[ct]);
            }
#pragma unroll
            for (int c2 = 0; c2 < 2; ++c2)
#pragma unroll
                for (int r = 0; r < 4; ++r) { const int i = 16 * rt + fq * 4 + r, j = 16 * (2 * chf + c2) + fr; Sc[i * GL_LD + j] = f2bf(j <= i ? sc[c2][r] : 0.f); }
        }
        LBAR();
        {
#pragma unroll
            for (int ks = 0; ks < 2; ++ks) {
                const s8v a = *(const s8v*)(Sc + (16 * rt + fr) * GL_LD + 32 * ks + 8 * fq);
                const s8v kt = *(const s8v*)(KiT + (16 * rt + fr) * GL_LD + 32 * ks + 8 * fq);
#pragma unroll
                for (int ct = 0; ct < 4; ++ct) {
                    const s8v bv = *(const s8v*)(VT + (64 * chf + 16 * ct + fr) * GL_LD + 32 * ks + 8 * fq);
                    oacc[ct] = mfma16(bv, a, oacc[ct]); Sacc[ct] = mfma16(kt, bv, Sacc[ct]);
                }
            }
            {
                const int i = 16 * rt + fr, t = tb + (dir ? 63 - i : i);
                if (dir == 0) {
#pragma unroll
                    for (int ct = 0; ct < 4; ++ct) *(uint2*)(opart + (size_t)t * 512 + h * 128 + 64 * chf + 16 * ct + fq * 4) = pack4(oacc[ct]);
                } else {
#pragma unroll
                    for (int ct = 0; ct < 4; ++ct) *(f4v*)(Of + i * 132 + 64 * chf + 16 * ct + fq * 4) = oacc[ct];
                }
            }
            float ae[4];
#pragma unroll
            for (int r = 0; r < 4; ++r) ae[r] = sAE[16 * rt + fq * 4 + r];
#pragma unroll
            for (int ct = 0; ct < 4; ++ct) {
#pragma unroll
                for (int r = 0; r < 4; ++r) Sacc[ct][r] *= ae[r];
                *(uint2*)(St + (64 * chf + 16 * ct + fr) * GL_LD + 16 * rt + fq * 4) = make_uint2(pack2(Sacc[ct][0], Sacc[ct][1]), pack2(Sacc[ct][2], Sacc[ct][3]));
            }
        }
        LBAR();
        if (dir == 1) {
            const int i = tid >> 3, d0 = (tid & 7) * 16, t = tb + 63 - i;
            const f8v o0 = *(const f8v*)(Of + i * 132 + d0) + unpack8v(gf0), o1 = *(const f8v*)(Of + i * 132 + d0 + 8) + unpack8v(gf1);
            float ss = 0.f;
#pragma unroll
            for (int j = 0; j < 8; ++j) ss += o0[j] * o0[j] + o1[j] * o1[j];
            const float r = frsq(red8(ss) * (1.0f / 128.f) + EPS);
            const f8v z0 = unpack8v(gz0), z1 = unpack8v(gz1);
            f8v y0, y1;
#pragma unroll
            for (int j = 0; j < 8; ++j) { y0[j] = o0[j] * r * gn0[j] * siluf_(z0[j]); y1[j] = o1[j] * r * gn1[j] * siluf_(z1[j]); }
            bf16* yc = (bf16*)(p.ws + WS_YCE) + (size_t)t * D + h * 128 + d0;
            *(uint4*)yc = pack8v(y0); *(uint4*)(yc + 8) = pack8v(y1);
            if (cc + 1 < nch) GLA_FIN_FETCH(tb - 64);
        }
    }
    if (!sq_.lat) {
        float* fs = p.out + OUT_GLA + ((((size_t)sq_.b * N_EVEN + ei) * 2 + dir) * 4 + h) * 64 * 128;
#pragma unroll
        for (int ct = 0; ct < 4; ++ct)
#pragma unroll
            for (int r = 0; r < 4; ++r) fs[(16 * rt + fq * 4 + r) * 128 + 64 * chf + 16 * ct + fr] = Sacc[ct][r];
    }
}

#ifndef RW_PREFETCH
#define RW_PREFETCH 1
#endif
constexpr int RW_LD = 72;
constexpr int RWKV_PREP_ITEMS = (T / 64) * 8;
struct RwPre { uint4 x[5], l[5], r[5]; };
__device__ __forceinline__ void rwkv_prefetch(const P& p, int w, int dir, int tid, RwPre& q) {
    const int cg = w >> 3, h = w & 7, hc0 = h * 64;
    const int i = tid >> 3, c8 = (tid & 7) * 8, t = cg * 64 + (dir ? 63 - i : i);
    bool hl, hr; tok_nbr(t, hl, hr);
    const bf16* proj = (const bf16*)(p.ws + WS_PROJ);
#pragma unroll
    for (int grp = 0; grp < 5; ++grp) {
        const int col = (grp == 0 ? FB_R + hc0 : grp == 1 ? FB_K + hc0 : grp == 2 ? FB_V + hc0 : grp == 3 ? FB_WD + dir * 64 : FB_AD + dir * 64) + c8;
        const bf16* pr = proj + (size_t)t * EW + E_FB + col;
        q.x[grp] = *(const uint4*)pr;
        q.l[grp] = hl ? *(const uint4*)(pr - EW) : make_uint4(0u, 0u, 0u, 0u);
        q.r[grp] = hr ? *(const uint4*)(pr + EW) : make_uint4(0u, 0u, 0u, 0u);
    }
}
__device__ __forceinline__ void rwkv_prep_phase(const P& p, int ei, int dir, int w_first, int w_stride, int w_end, unsigned char* dsm) {
    float* sCS = (float*)dsm;
    float* sKK = sCS + 4096;
    float* sB = sKK + 4096;
    float* sKM = sB + 4096;
    float* sR = sKM + 4096;
    float* sAf = (float*)dsm;
    float* sXf = sAf + 64 * TI_LD;
    float* sTmp = sXf + 64 * TI_LD;
    bf16* AakT = (bf16*)(sTmp + 8 * 16 * TI_TLD);
    bf16* Brb = AakT + 64 * RW_LD;
    bf16* Tm = Brb + 64 * RW_LD;
    bf16* PT = (bf16*)dsm;
    bf16* W1T = PT + 64 * RW_LD;
    static_assert(2 * 64 * TI_LD * 4 + 8 * 16 * TI_TLD * 4 + 3 * 64 * RW_LD * 2 <= 81920, "RWKV prep overlays exceed region A");
    bf16* At = (bf16*)(dsm + 81920);
    bf16* Bt = At + 64 * RW_LD;
    bf16* Kt = Bt + 64 * RW_LD;
    bf16* Rt = Kt + 64 * RW_LD;
    bf16* BhT = Rt + 64 * RW_LD;
    bf16* KhT = BhT + 64 * RW_LD;
    bf16* AtT = KhT + 64 * RW_LD;
    bf16* sTW = At;
    bf16* sAD = Bt;
    float* sSeg = (float*)(AtT + 64 * RW_LD);
    float* sMix = sSeg + 512;
    float* sKw = sMix + 320;
    const int tid0 = opaque_tid();
    float* bonus = (float*)(p.ws + WS_BONUS);
    const float* mix = p.in[I_MIX] + (size_t)ei * 1792;
    int hcur = -1;
    s8v lrf[4][2];
    float lrb[4];
    RwPre pre;
#if RW_PREFETCH
    if (w_first < w_end) rwkv_prefetch(p, w_first, dir, tid0, pre);
#endif
    for (int w = w_first; w < w_end; w += w_stride) {
        const int tid = opaque_tid(), lane = tid & 63, wid = tid >> 6, fr = lane & 15, fq = lane >> 4;
        const int rt = wid & 3, cb = 2 * (wid >> 2), which = wid >> 2;
        const int cg = w >> 3, h = w & 7, hc0 = h * 64;
        const size_t tk = (size_t)cg * 8 + h;
        PT_B(1);
        if (h != hcur) {
            hcur = h;
            LBAR();
            const float* w2 = p.in[I_W2] + (size_t)(ei * 2 + dir) * 64 * 512 + hc0; const float* a2 = p.in[I_A2] + (size_t)(ei * 2 + dir) * 64 * 512 + hc0;
            {
                float wv[8], av[8];
#pragma unroll
                for (int u = 0; u < 8; ++u) { const int e = tid + u * 512, r = e >> 6, c = e & 63; wv[u] = w2[(size_t)r * 512 + c]; av[u] = a2[(size_t)r * 512 + c]; }
#pragma unroll
                for (int u = 0; u < 8; ++u) { const int e = tid + u * 512, r = e >> 6, c = e & 63; Kt[c * RW_LD + r] = f2bf(wv[u]); Rt[c * RW_LD + r] = f2bf(av[u]); }
                if (tid < 320) { const int grp = tid >> 6, c = tid & 63; sMix[tid] = mix[(grp == 0 ? FB_R + hc0 : grp == 1 ? FB_K + hc0 : grp == 2 ? FB_V + hc0 : grp == 3 ? FB_WD + dir * 64 : FB_AD + dir * 64) + c]; }
                else if (tid < 512) { const int e = tid - 320, which3 = e >> 6, c = e & 63; sKw[e] = ((which3 == 0 ? p.in[I_KK] : which3 == 1 ? p.in[I_KA] : p.in[I_RK]) + (size_t)ei * 512 + hc0)[c]; }
            }
            LBAR();
            const bf16* src = which ? Rt : Kt;
            const float* lb = (which ? p.in[I_A0] : p.in[I_W0]) + (size_t)(ei * 2 + dir) * 512 + hc0;
#pragma unroll
            for (int ct = 0; ct < 4; ++ct) {
                lrb[ct] = lb[16 * ct + fr];
#pragma unroll
                for (int ks = 0; ks < 2; ++ks) lrf[ct][ks] = *(const s8v*)(src + (16 * ct + fr) * RW_LD + ks * 32 + fq * 8);
            }
        }
        LBAR();
        PT_E(1); PT_B(2);
#if !RW_PREFETCH
        rwkv_prefetch(p, w, dir, tid, pre);
#endif
        {
            const int i = tid >> 3, c8 = (tid & 7) * 8, t = cg * 64 + (dir ? 63 - i : i);
#pragma unroll
            for (int grp = 0; grp < 5; ++grp) {
                const int col = (grp == 0 ? FB_R + hc0 : grp == 1 ? FB_K + hc0 : grp == 2 ? FB_V + hc0 : grp == 3 ? FB_WD + dir * 64 : FB_AD + dir * 64) + c8;
                const f8v x = unpack8v(pre.x[grp]);
                const f8v nb = unpack8v(pre.l[grp]) + unpack8v(pre.r[grp]);
                const f8v mv = *(const f8v*)(sMix + grp * 64 + c8);
                f8v y = x + mv * (nb * 0.5f - x);
                if (grp == 0) *(f8v*)(sR + i * 64 + c8) = y;
                else if (grp == 1) *(f8v*)(sKM + i * 64 + c8) = y;
                else if (grp == 2) { if (dir == 0) *(uint4*)((bf16*)(p.ws + WS_VSH) + (size_t)t * 512 + hc0 + c8) = pack8v(y); }
                else {
                    if (grp == 3) {
#pragma unroll
                        for (int j = 0; j < 8; ++j) y[j] = ftanh(y[j]);
                    }
                    *(uint4*)((grp == 3 ? sTW : sAD) + i * RW_LD + c8) = pack8v(y);
                }
            }
        }
#if RW_PREFETCH
        if (w + w_stride < w_end) rwkv_prefetch(p, w + w_stride, dir, tid, pre);
#endif
        LBAR();
        PT_E(2); PT_B(3);
        {
            const bf16* Am = which ? sAD : sTW;
            f4v acc[4];
#pragma unroll
            for (int ct = 0; ct < 4; ++ct) acc[ct] = (f4v){0.f, 0.f, 0.f, 0.f};
#pragma unroll
            for (int ks = 0; ks < 2; ++ks) {
                const s8v a = *(const s8v*)(Am + (16 * rt + fr) * RW_LD + ks * 32 + fq * 8);
#pragma unroll
                for (int ct = 0; ct < 4; ++ct) acc[ct] = mfma16(a, lrf[ct][ks], acc[ct]);
            }
#pragma unroll
            for (int ct = 0; ct < 4; ++ct) {
                const int c = 16 * ct + fr;
#pragma unroll
                for (int r = 0; r < 4; ++r) {
                    const int tok = 16 * rt + fq * 4 + r;
                    const float sg = sigmoidf_(lrb[ct] + acc[ct][r]);
                    if (which) sB[tok * 64 + c] = sg; else sCS[tok * 64 + c] = -0.6065306597126334f * sg;
                }
            }
        }
        LBAR();
        PT_E(3); PT_B(4);
        {
            const int i = tid >> 3, c8 = (tid & 7) * 8;
            const f8v av = *(const f8v*)(sB + i * 64 + c8), kr = *(const f8v*)(sKM + i * 64 + c8), rv = *(const f8v*)(sR + i * 64 + c8);
            const f8v kkv = *(const f8v*)(sKw + c8), kav = *(const f8v*)(sKw + 64 + c8), rkv = *(const f8v*)(sKw + 128 + c8);
            const f8v km = kr * (1.0f + (av - 1.0f) * kav);
            f8v kk = kr * kkv;
            float ss = 0.f, bn = 0.f;
#pragma unroll
            for (int j = 0; j < 8; ++j) { ss += kk[j] * kk[j]; bn += rv[j] * km[j] * rkv[j]; }
            ss = red8(ss); bn = red8(bn);
            kk *= frsq(ss + EPS);
            *(f8v*)(sKK + i * 64 + c8) = kk; *(f8v*)(sB + i * 64 + c8) = kk * av; *(f8v*)(sKM + i * 64 + c8) = km;
            if ((tid & 7) == 0) { const int t = cg * 64 + (dir ? 63 - i : i); bonus[((size_t)t * 8 + h) * 2 + dir] = bn; }
        }
        {
            const int c = tid & 63, sg = tid >> 6;
            float run = 0.f;
#pragma unroll
            for (int j = 0; j < 8; ++j) { run += sCS[(8 * sg + j) * 64 + c]; sCS[(8 * sg + j) * 64 + c] = run; }
            sSeg[sg * 64 + c] = run;
        }
        LBAR();
        PT_E(4); PT_B(5);
        {
            const int c = tid & 63, sg = tid >> 6;
            float off = 0.f;
            for (int q = 0; q < sg; ++q) off += sSeg[q * 64 + c];
#pragma unroll
            for (int j = 0; j < 8; ++j) sCS[(8 * sg + j) * 64 + c] += off;
        }
        LBAR();
        PT_E(5); PT_B(6);
        {
            const int i = tid >> 3, c8 = (tid & 7) * 8;
            const f8v cs = *(const f8v*)(sCS + i * 64 + c8), cl = *(const f8v*)(sCS + 63 * 64 + c8);
            f8v cp = (f8v)(0.f);
            if (i > 0) cp = *(const f8v*)(sCS + (i - 1) * 64 + c8);
            const f8v kk = *(const f8v*)(sKK + i * 64 + c8), bb = *(const f8v*)(sB + i * 64 + c8), km = *(const f8v*)(sKM + i * 64 + c8), rv = *(const f8v*)(sR + i * 64 + c8);
            f8v at, bt, kt, rtv;
#pragma unroll
            for (int j = 0; j < 8; ++j) {
                const float g = fexp(cs[j]), gi = frcp(g), gp = fexp(cp[j]), gc = fexp(cl[j]) * gi;
                at[j] = -kk[j] * gp; bt[j] = bb[j] * gi; kt[j] = km[j] * gi; rtv[j] = rv[j] * g;
                BhT[(c8 + j) * RW_LD + i] = f2bf(bb[j] * gc); KhT[(c8 + j) * RW_LD + i] = f2bf(km[j] * gc); AtT[(c8 + j) * RW_LD + i] = f2bf(at[j]);
            }
            *(uint4*)(At + i * RW_LD + c8) = pack8v(at); *(uint4*)(Bt + i * RW_LD + c8) = pack8v(bt);
            *(uint4*)(Kt + i * RW_LD + c8) = pack8v(kt); *(uint4*)(Rt + i * RW_LD + c8) = pack8v(rtv);
            if (i == 63) {
                float* gco = (float*)(p.ws + WS_GC) + tk * 64 + c8;
#pragma unroll
                for (int j = 0; j < 8; ++j) gco[j] = fexp(cl[j]);
            }
        }
        LBAR();
        PT_E(6); PT_B(7);
        f4v brkT[2];
        {
            f4v aab[2], aak[2], brb[2];
#pragma unroll
            for (int c2 = 0; c2 < 2; ++c2) { aab[c2] = (f4v){0.f, 0.f, 0.f, 0.f}; aak[c2] = aab[c2]; brb[c2] = aab[c2]; brkT[c2] = aab[c2]; }
#pragma unroll
            for (int ks = 0; ks < 2; ++ks) {
                const int ko = ks * 32 + fq * 8, ra = (16 * rt + fr) * RW_LD + ko;
                const s8v fa = *(const s8v*)(At + ra), frr = *(const s8v*)(Rt + ra), fk = *(const s8v*)(Kt + ra);
#pragma unroll
                for (int c2 = 0; c2 < 2; ++c2) {
                    const int ro = (16 * (cb + c2) + fr) * RW_LD + ko;
                    const s8v gb = *(const s8v*)(Bt + ro), gk = *(const s8v*)(Kt + ro), gr = *(const s8v*)(Rt + ro);
                    aab[c2] = mfma16(fa, gb, aab[c2]); aak[c2] = mfma16(fa, gk, aak[c2]); brb[c2] = mfma16(frr, gb, brb[c2]);
                    brkT[c2] = mfma16(fk, gr, brkT[c2]);
                }
            }
#pragma unroll
            for (int c2 = 0; c2 < 2; ++c2) {
                const int col = 16 * (cb + c2) + fr, r0 = 16 * rt + fq * 4;
                f4v ak;
#pragma unroll
                for (int r = 0; r < 4; ++r) {
                    const int row = r0 + r;
                    sAf[row * TI_LD + col] = col < row ? -aab[c2][r] : 0.f;
                    ak[r] = col < row ? aak[c2][r] : 0.f;
                    Brb[row * RW_LD + col] = f2bf(col <= row ? brb[c2][r] : 0.f);
                    if (!(row <= col)) brkT[c2][r] = 0.f;
                }
                *(uint2*)(AakT + col * RW_LD + r0) = pack4(ak);
            }
        }
        LBAR();
        PT_E(7); PT_B(8);
        tri_inv64(sAf, sXf, sTmp, wid & 3, lane, wid < 4);
        { const int i = tid >> 3, c8 = (tid & 7) * 8; *(uint4*)(Tm + i * RW_LD + c8) = pack8v(*(const f8v*)(sXf + i * TI_LD + c8)); }
        LBAR();
        PT_E(8); PT_B(9);
        {
            f4v pp[2], ww[2];
#pragma unroll
            for (int c2 = 0; c2 < 2; ++c2) { pp[c2] = (f4v){0.f, 0.f, 0.f, 0.f}; ww[c2] = pp[c2]; }
#pragma unroll
            for (int ks = 0; ks < 2; ++ks) {
                const int ko = ks * 32 + fq * 8;
                const s8v ft = *(const s8v*)(Tm + (16 * rt + fr) * RW_LD + ko);
#pragma unroll
                for (int c2 = 0; c2 < 2; ++c2) {
                    const int ro = (16 * (cb + c2) + fr) * RW_LD + ko;
                    pp[c2] = mfma16(ft, *(const s8v*)(AtT + ro), pp[c2]); ww[c2] = mfma16(ft, *(const s8v*)(AakT + ro), ww[c2]);
                }
            }
#pragma unroll
            for (int c2 = 0; c2 < 2; ++c2) {
                const int col = 16 * (cb + c2) + fr;
                *(uint2*)(PT + col * RW_LD + 16 * rt + fq * 4) = pack4(pp[c2]);
                *(uint2*)(W1T + col * RW_LD + 16 * rt + fq * 4) = pack4(ww[c2]);
            }
        }
        LBAR();
        PT_E(9); PT_B(10);
        {
            bf16* m12 = (bf16*)(p.ws + WS_RM12) + tk * 8192; bf16* m34 = (bf16*)(p.ws + WS_RM34) + tk * 8192;
#pragma unroll
            for (int c2 = 0; c2 < 2; ++c2) {
                const int col = 16 * (cb + c2) + fr, r0 = 16 * rt + fq * 4;
                f4v m1 = unpack4(*(const uint2*)(Rt + col * RW_LD + r0));
                f4v m2 = brkT[c2], m3 = (f4v){0.f, 0.f, 0.f, 0.f};
                f4v m4 = unpack4(*(const uint2*)(KhT + col * RW_LD + r0));
#pragma unroll
                for (int ks = 0; ks < 2; ++ks) {
                    const int ko = ks * 32 + fq * 8;
                    const s8v fp = *(const s8v*)(PT + (16 * rt + fr) * RW_LD + ko), fw = *(const s8v*)(W1T + (16 * rt + fr) * RW_LD + ko);
                    const s8v gb = *(const s8v*)(Brb + col * RW_LD + ko), gh = *(const s8v*)(BhT + col * RW_LD + ko);
                    m1 = mfma16(fp, gb, m1);
                    m2 = mfma16(fw, gb, m2);
                    m3 = mfma16(fp, gh, m3);
                    m4 = mfma16(fw, gh, m4);
                }
                *(uint2*)(m12 + col * 64 + r0) = pack4(m1);
                *(uint2*)(m12 + 4096 + col * 64 + r0) = pack4(m2);
                *(uint2*)(m34 + col * 64 + r0) = pack4(m3);
                *(uint2*)(m34 + 4096 + col * 64 + r0) = pack4(m4);
            }
        }
        PT_E(10);
    }
}
__device__ __forceinline__ void rwkv_apply_task(const P& p, int ei, int s, int h, int dir, unsigned char* dsm) {
    bf16* St = (bf16*)dsm;
    bf16* VT = St + 64 * RW_LD;
    bf16* M1 = VT + 64 * RW_LD;
    bf16* M2 = M1 + 64 * RW_LD;
    bf16* M3 = M2 + 64 * RW_LD;
    bf16* M4 = M3 + 64 * RW_LD;
    float* sGC = (float*)(M4 + 64 * RW_LD);
    float* Yf = sGC + 64;
    const Seq sq_ = get_seq(s);
    const int tid = opaque_tid(), lane = tid & 63, wid = tid >> 6, fr = lane & 15, fq = lane >> 4;
    const int rt = wid & 3, cb = 2 * (wid >> 2), hc0 = h * 64;
    bf16* opart = (bf16*)(p.ws + WS_PART + PART_SZ);
    f4v Sacc[2];
    LBAR();
#pragma unroll
    for (int c2 = 0; c2 < 2; ++c2) {
        const int v = 16 * (cb + c2) + fr, k0 = 16 * rt + fq * 4;
        if (sq_.lat) Sacc[c2] = *(const f4v*)(p.in[I_SRWKV] + ((((size_t)sq_.b * N_EVEN + ei) * 2 + dir) * 8 + h) * 4096 + v * 64 + k0);
        else Sacc[c2] = (f4v){0.f, 0.f, 0.f, 0.f};
        *(uint2*)(St + v * RW_LD + k0) = make_uint2(pack2(Sacc[c2][0], Sacc[c2][1]), pack2(Sacc[c2][2], Sacc[c2][3]));
    }
    const int nch = sq_.len >> 6;
    uint4 pm0, pm1, pm2, pm3, pvv; float pgc = 0.f;
    {
        const int cg0 = (sq_.start >> 6) + (dir ? nch - 1 : 0); const size_t tk0 = (size_t)cg0 * 8 + h;
        const int i = tid >> 3, c8 = (tid & 7) * 8;
        const bf16* m12 = (const bf16*)(p.ws + WS_RM12) + tk0 * 8192; const bf16* m34 = (const bf16*)(p.ws + WS_RM34) + tk0 * 8192;
        pm0 = *(const uint4*)(m12 + i * 64 + c8); pm1 = *(const uint4*)(m12 + 4096 + i * 64 + c8); pm2 = *(const uint4*)(m34 + i * 64 + c8); pm3 = *(const uint4*)(m34 + 4096 + i * 64 + c8);
        pvv = *(const uint4*)((const bf16*)(p.ws + WS_VSH) + (size_t)(cg0 * 64 + (dir ? 63 - lane : lane)) * 512 + hc0 + wid * 8);
        if (tid < 64) pgc = ((const float*)(p.ws + WS_GC))[tk0 * 64 + tid];
    }
    uint4 pfo = make_uint4(0u, 0u, 0u, 0u), pfv = pfo, pfz = pfo; float pfb = 0.f;
    f8v lng = (f8v)(0.f), lnb = (f8v)(0.f);
#define RWA_FIN_FETCH(CG) do { const int i_ = tid >> 3, c8_ = (tid & 7) * 8, t_ = (CG) * 64 + 63 - i_; \
        pfo = *(const uint4*)(opart + (size_t)t_ * 512 + hc0 + c8_); pfv = *(const uint4*)((const bf16*)(p.ws + WS_VSH) + (size_t)t_ * 512 + hc0 + c8_); \
        pfz = *(const uint4*)((const bf16*)(p.ws + WS_PROJ) + (size_t)t_ * EW + E_ZB + hc0 + c8_); \
        const float* bn_ = (const float*)(p.ws + WS_BONUS) + ((size_t)t_ * 8 + h) * 2; pfb = bn_[0] + bn_[1]; } while (0)
    if (dir == 1) {
        const int c8 = (tid & 7) * 8;
        lng = *(const f8v*)(p.in[I_LNG] + ei * 512 + hc0 + c8); lnb = *(const f8v*)(p.in[I_LNB] + ei * 512 + hc0 + c8);
        RWA_FIN_FETCH((sq_.start >> 6) + nch - 1);
    }
    for (int cc = 0; cc < nch; ++cc) {
        const int cg = (sq_.start >> 6) + (dir ? nch - 1 - cc : cc);
        {
            const int i = tid >> 3, c8 = (tid & 7) * 8;
            *(uint4*)(M1 + i * RW_LD + c8) = pm0; *(uint4*)(M2 + i * RW_LD + c8) = pm1; *(uint4*)(M3 + i * RW_LD + c8) = pm2; *(uint4*)(M4 + i * RW_LD + c8) = pm3;
            const f8v vv = unpack8v(pvv);
#pragma unroll
            for (int j = 0; j < 8; ++j) VT[(wid * 8 + j) * RW_LD + lane] = f2bf(vv[j]);
            if (tid < 64) sGC[tid] = pgc;
            if (cc + 1 < nch) {
                const int cgn = (sq_.start >> 6) + (dir ? nch - 2 - cc : cc + 1); const size_t tkn = (size_t)cgn * 8 + h;
                const bf16* m12 = (const bf16*)(p.ws + WS_RM12) + tkn * 8192; const bf16* m34 = (const bf16*)(p.ws + WS_RM34) + tkn * 8192;
                pm0 = *(const uint4*)(m12 + i * 64 + c8); pm1 = *(const uint4*)(m12 + 4096 + i * 64 + c8); pm2 = *(const uint4*)(m34 + i * 64 + c8); pm3 = *(const uint4*)(m34 + 4096 + i * 64 + c8);
                pvv = *(const uint4*)((const bf16*)(p.ws + WS_VSH) + (size_t)(cgn * 64 + (dir ? 63 - lane : lane)) * 512 + hc0 + wid * 8);
                if (tid < 64) pgc = ((const float*)(p.ws + WS_GC))[tkn * 64 + tid];
            }
        }
        LBAR();
        {
            f4v yT[2], sn[2];
#pragma unroll
            for (int c2 = 0; c2 < 2; ++c2) { yT[c2] = (f4v){0.f, 0.f, 0.f, 0.f}; sn[c2] = yT[c2]; }
#pragma unroll
            for (int ks = 0; ks < 2; ++ks) {
                const int ko = ks * 32 + fq * 8;
                const s8v fs = *(const s8v*)(St + (16 * rt + fr) * RW_LD + ko), fv = *(const s8v*)(VT + (16 * rt + fr) * RW_LD + ko);
                const s8v f3 = *(const s8v*)(M3 + (16 * rt + fr) * RW_LD + ko), f4 = *(const s8v*)(M4 + (16 * rt + fr) * RW_LD + ko);
#pragma unroll
                for (int c2 = 0; c2 < 2; ++c2) {
                    const int ro = (16 * (cb + c2) + fr) * RW_LD + ko;
                    yT[c2] = mfma16(fs, *(const s8v*)(M1 + ro), yT[c2]); yT[c2] = mfma16(fv, *(const s8v*)(M2 + ro), yT[c2]);
                    sn[c2] = mfma16(f3, *(const s8v*)(St + ro), sn[c2]); sn[c2] = mfma16(f4, *(const s8v*)(VT + ro), sn[c2]);
                }
            }
            float gc[4];
#pragma unroll
            for (int r = 0; r < 4; ++r) gc[r] = sGC[16 * rt + fq * 4 + r];
#pragma unroll
            for (int c2 = 0; c2 < 2; ++c2) {
                const int tt = 16 * (cb + c2) + fr, t = cg * 64 + (dir ? 63 - tt : tt);
                if (dir == 0) *(uint2*)(opart + (size_t)t * 512 + hc0 + 16 * rt + fq * 4) = make_uint2(pack2(yT[c2][0], yT[c2][1]), pack2(yT[c2][2], yT[c2][3]));
                else *(f4v*)(Yf + tt * 68 + 16 * rt + fq * 4) = yT[c2];
#pragma unroll
                for (int r = 0; r < 4; ++r) Sacc[c2][r] = Sacc[c2][r] * gc[r] + sn[c2][r];
            }
        }
        LBAR();
#pragma unroll
        for (int c2 = 0; c2 < 2; ++c2) *(uint2*)(St + (16 * (cb + c2) + fr) * RW_LD + 16 * rt + fq * 4) = make_uint2(pack2(Sacc[c2][0], Sacc[c2][1]), pack2(Sacc[c2][2], Sacc[c2][3]));
        if (dir == 1) {
            const int i = tid >> 3, c8 = (tid & 7) * 8, t = cg * 64 + 63 - i;
            f8v o = *(const f8v*)(Yf + i * 68 + c8) + unpack8v(pfo);
            float mu = 0.f;
#pragma unroll
            for (int j = 0; j < 8; ++j) mu += o[j];
            mu = red8(mu) * (1.0f / 64.f);
            o -= mu;
            float var = 0.f;
#pragma unroll
            for (int j = 0; j < 8; ++j) var += o[j] * o[j];
            const float r = frsq(red8(var) * (1.0f / 64.f) + 64e-5f);
            const float bsum = pfb;
            const f8v vsh = unpack8v(pfv), zb = unpack8v(pfz);
            f8v y;
#pragma unroll
            for (int j = 0; j < 8; ++j) y[j] = (o[j] * r * lng[j] + lnb[j] + bsum * vsh[j]) * siluf_(zb[j]);
            *(uint4*)((bf16*)(p.ws + WS_YCE) + (size_t)t * D + 512 + hc0 + c8) = pack8v(y);
            if (cc + 1 < nch) RWA_FIN_FETCH(cg - 1);
        }
    }
    if (!sq_.lat) {
#pragma unroll
        for (int c2 = 0; c2 < 2; ++c2)
            *(f4v*)(p.out + OUT_RWKV + ((((size_t)sq_.b * N_EVEN + ei) * 2 + dir) * 8 + h) * 4096 + (16 * (cb + c2) + fr) * 64 + 16 * rt + fq * 4) = Sacc[c2];
    }
}
constexpr int EV_AP_LAT = NB_LAT * 8, EV_AP_CTX = NB_CTX * 8, EV_GLA_LAT = NB_LAT * 4, EV_GLA_CTX = NB_CTX * 4;
constexpr int EVEN_SCAN_ITEMS = EV_AP_LAT + EV_GLA_LAT + EV_AP_CTX + EV_GLA_CTX;
__device__ __forceinline__ void ph_even_scan_item(const P& p, int w, int ei, int dir, unsigned char* dsm) {
    int kind, sbase, x;
    if (w < EV_AP_LAT) { kind = 0; sbase = NB_CTX; x = w; }
    else if (w < EV_AP_LAT + EV_GLA_LAT) { kind = 1; sbase = NB_CTX; x = w - EV_AP_LAT; }
    else if (w < EV_AP_LAT + EV_GLA_LAT + EV_AP_CTX) { kind = 0; sbase = 0; x = w - EV_AP_LAT - EV_GLA_LAT; }
    else { kind = 1; sbase = 0; x = w - EV_AP_LAT - EV_GLA_LAT - EV_AP_CTX; }
    if (kind == 0) rwkv_apply_task(p, ei, sbase + x / 8, x & 7, dir, dsm);
    else gla_scan_task(p, ei, sbase + x / 4, x & 3, dir, dsm);
}

__device__ __forceinline__ void ph_fin_even(const P& p, int bid, int ei) {
    const int lane = LT & 63, t = bid * 4 + (LT >> 6);
    if (t >= T) return;
    const bf16* pr = (const bf16*)(p.ws + WS_PROJ) + (size_t)t * EW;
    const bf16* oaf = (const bf16*)(p.ws + WS_PART) + (size_t)t * 512;
    const bf16* oab = (const bf16*)(p.ws + WS_PART + PART_SZ) + (size_t)t * 512;
    const bf16* obf = (const bf16*)(p.ws + WS_PART + 2 * PART_SZ) + (size_t)t * 512;
    const bf16* obb = (const bf16*)(p.ws + WS_PART + 3 * PART_SZ) + (size_t)t * 512;
    bf16* yc = (bf16*)(p.ws + WS_HM) + (size_t)t * D;
    const int idx = lane * 8;
    {
        float o[8], ss = 0.f;
#pragma unroll
        for (int j = 0; j < 8; ++j) { o[j] = bf2f(oaf[idx + j]) + bf2f(oab[idx + j]); ss += o[j] * o[j]; }
        ss += __shfl_xor(ss, 1); ss += __shfl_xor(ss, 2); ss += __shfl_xor(ss, 4); ss += __shfl_xor(ss, 8);
        const float r = frsq(ss * (1.0f / 128.f) + EPS);
        const float* gn = p.in[I_GLAN] + ei * 128 + (idx & 127);
#pragma unroll
        for (int j = 0; j < 8; ++j) yc[idx + j] = f2bf(o[j] * r * gn[j] * siluf_(bf2f(pr[E_ZA + idx + j])));
    }
    {
        float o[8], mu = 0.f;
#pragma unroll
        for (int j = 0; j < 8; ++j) { o[j] = bf2f(obf[idx + j]) + bf2f(obb[idx + j]); mu += o[j]; }
        mu += __shfl_xor(mu, 1); mu += __shfl_xor(mu, 2); mu += __shfl_xor(mu, 4);
        mu *= (1.0f / 64.f);
        float var = 0.f;
#pragma unroll
        for (int j = 0; j < 8; ++j) { o[j] -= mu; var += o[j] * o[j]; }
        var += __shfl_xor(var, 1); var += __shfl_xor(var, 2); var += __shfl_xor(var, 4);
        const float r = frsq(var * (1.0f / 64.f) + 64e-5f);
        const int h = idx >> 6;
        const float* bn = (const float*)(p.ws + WS_BONUS) + ((size_t)t * 8 + h) * 2;
        const float bsum = bn[0] + bn[1];
        bool hl, hr; tok_nbr(t, hl, hr);
        const float* mix = p.in[I_MIX] + (size_t)ei * 1792 + FB_V + idx;
        const float* lg = p.in[I_LNG] + ei * 512 + idx;
        const float* lb = p.in[I_LNB] + ei * 512 + idx;
#pragma unroll
        for (int j = 0; j < 8; ++j) {
            const bf16* pv = pr + E_FB + FB_V + idx + j;
            const float x = bf2f(pv[0]);
            const float nl = hl ? bf2f(pv[-EW]) : 0.f, nr = hr ? bf2f(pv[EW]) : 0.f;
            const float vsh = x + mix[j] * (0.5f * (nl + nr) - x);
            yc[512 + idx + j] = f2bf((o[j] * r * lg[j] + lb[j] + bsum * vsh) * siluf_(bf2f(pr[E_ZB + idx + j])));
        }
    }
}

constexpr int ODD_PREP_ITEMS = (T / 64) * 4;
constexpr int PQ_LD = 136;
__device__ __forceinline__ void ph_odd_prep(const P& p, int item, int oi, unsigned char* dsm) {
    bf16* sq = (bf16*)dsm;
    bf16* sk = sq + 64 * PQ_LD;
    float* sA = (float*)(dsm + 2 * 64 * PQ_LD * 2);
    float* sX = sA + 2 * 64 * TI_LD;
    float* sTm = sX + 2 * 64 * TI_LD;
    float* slg = sTm + 2 * 8 * 16 * TI_TLD;
    float* sbt = slg + 128;
    float* sgc = sbt + 128;
    float* sbp = sgc + 128;
    const int tid = opaque_tid(), lane = tid & 63, wid = tid >> 6;
    const int cg = item >> 2, h = item & 3;
    const bf16* proj = (const bf16*)(p.ws + WS_PROJ);
    const float* cw = p.in[I_CONV] + (size_t)oi * 9 * 1536;
    LBAR();
    if (wid < 6) {
        const int part = wid >> 1, oc = lane & 15, i0 = ((wid & 1) * 4 + (lane >> 4)) * 8, t0 = cg * 64;
        const bool lat = t0 >= T_CTX;
        int pos0, len;
        if (!lat) { pos0 = t0 % L_CTX; len = L_CTX; } else { pos0 = (t0 - T_CTX) % L_LAT; len = L_LAT; }
        const int gr = pos0 >> 6, nrows = len >> 6;
        const int ch = part * 512 + h * 128 + oc * 8;
        const bool okl = i0 > 0 || (!lat && pos0 > 0), okr = i0 < 56 || (!lat && pos0 + 64 < len);
        f8v acc[8];
#pragma unroll
        for (int j = 0; j < 8; ++j) acc[j] = (f8v)(0.f);
#pragma unroll
        for (int di = -1; di <= 1; ++di) {
            const bool rv = lat ? (gr + di >= 0 && gr + di < nrows) : (di == 0);
            if (rv) {
                const float* w = cw + ((di + 1) * 3) * 1536 + ch;
                const f8v w0 = *(const f8v*)w, w1 = *(const f8v*)(w + 1536), w2 = *(const f8v*)(w + 3072);
                const bf16* src = proj + (size_t)(t0 + di * 64 + i0) * OW + O_QKV + ch;
                uint4 x[10];
                x[0] = *(const uint4*)(okl ? src - OW : src);
#pragma unroll
                for (int c = 0; c < 8; ++c) x[c + 1] = *(const uint4*)(src + (size_t)c * OW);
                x[9] = *(const uint4*)(okr ? src + (size_t)8 * OW : src);
                if (!okl) x[0] = make_uint4(0u, 0u, 0u, 0u);
                if (!okr) x[9] = make_uint4(0u, 0u, 0u, 0u);
#pragma unroll
                for (int c = 0; c < 10; ++c) {
                    const f8v xc = unpack8v(x[c]);
                    if (c < 8) acc[c] += xc * w0;
                    if (c >= 1 && c <= 8) acc[c - 1] += xc * w1;
                    if (c >= 2) acc[c - 2] += xc * w2;
                }
            }
        }
        bf16* qo = (bf16*)(p.ws + WS_QKVN) + (size_t)(t0 + i0) * 1536 + ch;
        bf16* so = (part == 0 ? sq : sk) + i0 * PQ_LD + oc * 8;
#pragma unroll
        for (int j = 0; j < 8; ++j) {
            f8v a = acc[j];
            float ss = 0.f;
#pragma unroll
            for (int e = 0; e < 8; ++e) { a[e] = siluf_(a[e]); ss += a[e] * a[e]; }
            if (part < 2) {
                ss = red16(ss);
                float r = frsq(ss + EPS);
                if (part == 0) r *= 0.08838834764831845f;
                a *= r;
            }
            const uint4 pk = pack8v(a);
            *(uint4*)(qo + (size_t)j * 1536) = pk;
            if (part < 2) *(uint4*)(so + j * PQ_LD) = pk;
        }
    } else {
        const int dir = wid - 6, i = lane, t = cg * 64 + i;
        float* g = (float*)(p.ws + WS_GATES) + (size_t)t * 16;
        const float x = bf2f(proj[(size_t)t * OW + O_G + dir * 4 + h]);
        const float lgv = -fexp(p.in[I_ALOG][oi * 8 + dir * 4 + h]) * softplusf_(x + p.in[I_DTB][oi * 8 + dir * 4 + h]);
        const float bv = sigmoidf_(bf2f(proj[(size_t)t * OW + O_BETA + dir * 4 + h]));
        g[dir * 4 + h] = lgv; g[8 + dir * 4 + h] = bv;
        slg[dir * 64 + i] = lgv; sbt[dir * 64 + i] = bv;
    }
    LBAR();
    if (tid < 2) {
        const int dir = tid; float c = 0.f;
        for (int i = 0; i < 64; ++i) { const int n = dir ? 63 - i : i; c += slg[dir * 64 + n]; sgc[dir * 64 + i] = c; sbp[dir * 64 + i] = sbt[dir * 64 + n]; }
    }
    LBAR();
    {
        const int rt = wid & 3, fr = lane & 15, fq = lane >> 4;
        f4v acc[4];
#pragma unroll
        for (int ct = 0; ct < 4; ++ct) acc[ct] = (f4v){0.f, 0.f, 0.f, 0.f};
#pragma unroll
        for (int ks = 0; ks < 4; ++ks) {
            const s8v a = *(const s8v*)((wid < 4 ? sk : sq) + (16 * rt + fr) * PQ_LD + fq * 8 + ks * 32);
#pragma unroll
            for (int ct = 0; ct < 4; ++ct) {
                const s8v bb = *(const s8v*)(sk + (16 * ct + fr) * PQ_LD + fq * 8 + ks * 32);
                acc[ct] = (wid < 4) ? mfma16(a, bb, acc[ct]) : mfma16(bb, a, acc[ct]);
            }
        }
        const size_t task0 = ((size_t)cg * 4 + h) * 2;
        bf16* qk0 = (bf16*)(p.ws + WS_QKM) + task0 * 4096; bf16* qk1 = qk0 + 4096;
        if (wid < 4) {
#pragma unroll
            for (int ct = 0; ct < 4; ++ct)
#pragma unroll
                for (int r = 0; r < 4; ++r) {
                    const int a = 16 * rt + fq * 4 + r, b = 16 * ct + fr, i1 = 63 - a, j1 = 63 - b;
                    const float v = acc[ct][r];
                    if (b < a) sA[a * TI_LD + b] = sbp[a] * v * fexp(sgc[a] - sgc[b]);
                    if (b > a) sA[64 * TI_LD + i1 * TI_LD + j1] = sbp[64 + i1] * v * fexp(sgc[64 + i1] - sgc[64 + j1]);
                }
        } else {
            const int a = 16 * rt + fr, i1 = 63 - a;
            const float ga0 = sgc[a], ga1 = sgc[64 + i1];
#pragma unroll
            for (int ct = 0; ct < 4; ++ct) {
                const int b0 = 16 * ct + fq * 4;
                f4v v0, v1;
#pragma unroll
                for (int r = 0; r < 4; ++r) {
                    const int b = b0 + r, j1 = 63 - b;
                    const float v = acc[ct][r];
                    v0[r] = b <= a ? v * fexp(ga0 - sgc[b]) : 0.f;
                    v1[3 - r] = b >= a ? v * fexp(ga1 - sgc[64 + j1]) : 0.f;
                }
                *(uint2*)(qk0 + a * 64 + b0) = pack4(v0);
                *(uint2*)(qk1 + i1 * 64 + 60 - b0) = pack4(v1);
            }
        }
    }
    LBAR();
    if (wid == 2) {
        float* gco = (float*)(p.ws + WS_GC) + ((size_t)cg * 4 + h) * 128;
        gco[lane] = sgc[lane]; gco[64 + lane] = sgc[64 + lane];
    }
    tri_inv64(sA + (wid >> 2) * 64 * TI_LD, sX + (wid >> 2) * 64 * TI_LD, sTm + (wid >> 2) * 8 * 16 * TI_TLD, wid & 3, lane, true);
    {
        const int dir = tid >> 8, i = (tid >> 2) & 63, c16 = (tid & 3) * 16;
        const float* xs = sX + dir * 64 * TI_LD + i * TI_LD + c16;
        bf16* ti = (bf16*)(p.ws + WS_TINV) + (((size_t)cg * 4 + h) * 2 + dir) * 4096 + i * 64 + c16;
        *(uint4*)ti = pack8v(*(const f8v*)xs); *(uint4*)(ti + 8) = pack8v(*(const f8v*)(xs + 8));
    }
}

constexpr int G_LDS = 136, G_LDT = 72;
__device__ __forceinline__ void gdn_scan_task(const P& p, int oi, int s, int h, int dir, unsigned char* dsm) {
    bf16* St = (bf16*)dsm;
    bf16* Kc = St + 128 * G_LDS;
    bf16* Qc = Kc + 64 * G_LDS;
    bf16* KeT = Qc + 64 * G_LDS;
    bf16* rT = KeT + 128 * G_LDT;
    bf16* dT = rT + 128 * G_LDT;
    bf16* Vc = dT;
    bf16* Ti = dT + 128 * G_LDT;
    bf16* Qk = Ti + 64 * G_LDT;
    float* sgc = (float*)(Qk + 64 * G_LDT);
    float* sbt = sgc + 64;
    const Seq sq_ = get_seq(s);
    const int tid = opaque_tid(), lane = tid & 63, wid = tid >> 6, fr = lane & 15, fq = lane >> 4;
    const int rt = wid & 3, chf = wid >> 2;
    const bf16* qkvn = (const bf16*)(p.ws + WS_QKVN);
    const float* gates = (const float*)(p.ws + WS_GATES);
    bf16* opart = (bf16*)(p.ws + WS_PART + (size_t)dir * PART_SZ);
    f4v Sacc[8];
    LBAR();
    if (sq_.lat) {
        const float* s0 = p.in[I_SGDN] + ((((size_t)sq_.b * N_ODD + oi) * 2 + dir) * 4 + h) * 128 * 128;
#pragma unroll
        for (int ct = 0; ct < 8; ++ct)
#pragma unroll
            for (int r = 0; r < 4; ++r) Sacc[ct][r] = s0[(16 * wid + fq * 4 + r) * 128 + 16 * ct + fr];
    } else {
#pragma unroll
        for (int ct = 0; ct < 8; ++ct) Sacc[ct] = (f4v){0.f, 0.f, 0.f, 0.f};
    }
#pragma unroll
    for (int ct = 0; ct < 8; ++ct) *(uint2*)(St + (16 * ct + fr) * G_LDS + 16 * wid + fq * 4) = make_uint2(pack2(Sacc[ct][0], Sacc[ct][1]), pack2(Sacc[ct][2], Sacc[ct][3]));
    const int nch = sq_.len >> 6;
    uint4 pq0, pq1, pk0, pk1, pw0, pw1, pti, pqk; float pgi, pgl, pbt = 0.f;
#define GDN_FETCH(CG) do { const size_t task_ = ((size_t)(CG) * 4 + h) * 2 + dir; const int t_ = (CG) * 64 + (dir ? 63 - lane : lane); \
        const bf16* src_ = qkvn + (size_t)t_ * 1536 + h * 128 + wid * 8; \
        pq0 = *(const uint4*)src_; pq1 = *(const uint4*)(src_ + 64); pk0 = *(const uint4*)(src_ + 512); pk1 = *(const uint4*)(src_ + 576); pw0 = *(const uint4*)(src_ + 1024); pw1 = *(const uint4*)(src_ + 1088); \
        { const int i2_ = tid >> 3, c8_ = (tid & 7) * 8; pti = *(const uint4*)((const bf16*)(p.ws + WS_TINV) + task_ * 4096 + i2_ * 64 + c8_); pqk = *(const uint4*)((const bf16*)(p.ws + WS_QKM) + task_ * 4096 + i2_ * 64 + c8_); } \
        const float* gcp_ = (const float*)(p.ws + WS_GC) + task_ * 64; pgi = gcp_[lane]; pgl = gcp_[63]; \
        if (tid < 64) pbt = gates[(size_t)((CG) * 64 + (dir ? 63 - tid : tid)) * 16 + 8 + dir * 4 + h]; } while (0)
    GDN_FETCH((sq_.start >> 6) + (dir ? nch - 1 : 0));
    for (int cc = 0; cc < nch; ++cc) {
        const int cl = dir ? nch - 1 - cc : cc;
        const int cg = (sq_.start >> 6) + cl;
        {
            const int i = lane;
            const float sc = fexp(pgl - pgi);
#pragma unroll
            for (int rep = 0; rep < 2; ++rep) {
                const int c8 = (wid + 8 * rep) * 8;
                const uint4 qv = rep ? pq1 : pq0, kv = rep ? pk1 : pk0, vv = rep ? pw1 : pw0;
                *(uint4*)(Qc + i * G_LDS + c8) = qv; *(uint4*)(Kc + i * G_LDS + c8) = kv; *(uint4*)(Vc + i * G_LDS + c8) = vv;
                const f8v kf = unpack8v(kv);
#pragma unroll
                for (int j = 0; j < 8; ++j) KeT[(c8 + j) * G_LDT + i] = f2bf(kf[j] * sc);
            }
            { const int i2 = tid >> 3, c8 = (tid & 7) * 8; *(uint4*)(Ti + i2 * G_LDT + c8) = pti; *(uint4*)(Qk + i2 * G_LDT + c8) = pqk; }
            if (tid < 64) { sgc[tid] = pgi; sbt[tid] = pbt; }
            if (cc + 1 < nch) { const int cln = dir ? nch - 2 - cc : cc + 1; GDN_FETCH((sq_.start >> 6) + cln); }
        }
        LBAR();
        f4v oacc[4];
        {
            f4v kS[4], qS[4];
#pragma unroll
            for (int ct = 0; ct < 4; ++ct) { kS[ct] = (f4v){0.f, 0.f, 0.f, 0.f}; qS[ct] = (f4v){0.f, 0.f, 0.f, 0.f}; }
#pragma unroll
            for (int ks = 0; ks < 4; ++ks) {
                const s8v ak = *(const s8v*)(Kc + (16 * rt + fr) * G_LDS + ks * 32 + fq * 8);
                const s8v aq = *(const s8v*)(Qc + (16 * rt + fr) * G_LDS + ks * 32 + fq * 8);
#pragma unroll
                for (int ct = 0; ct < 4; ++ct) {
                    const s8v bb = *(const s8v*)(St + (64 * chf + 16 * ct + fr) * G_LDS + ks * 32 + fq * 8);
                    kS[ct] = mfma16(ak, bb, kS[ct]);
                    qS[ct] = mfma16(bb, aq, qS[ct]);
                }
            }
            float eg[4], bt[4];
#pragma unroll
            for (int r = 0; r < 4; ++r) { const int i = 16 * rt + fq * 4 + r; eg[r] = fexp(sgc[i]); bt[r] = sbt[i]; }
            const float egc = fexp(sgc[16 * rt + fr]);
#pragma unroll
            for (int ct = 0; ct < 4; ++ct) {
                const int dv = 64 * chf + 16 * ct + fr;
                float rv[4];
#pragma unroll
                for (int r = 0; r < 4; ++r) { const int i = 16 * rt + fq * 4 + r; rv[r] = bt[r] * (bf2f(Vc[i * G_LDS + dv]) - eg[r] * kS[ct][r]); oacc[ct][r] = egc * qS[ct][r]; }
                *(uint2*)(rT + dv * G_LDT + 16 * rt + fq * 4) = make_uint2(pack2(rv[0], rv[1]), pack2(rv[2], rv[3]));
            }
        }
        LBAR();
        {
            f4v dl[4];
#pragma unroll
            for (int ct = 0; ct < 4; ++ct) dl[ct] = (f4v){0.f, 0.f, 0.f, 0.f};
#pragma unroll
            for (int ks = 0; ks < 2; ++ks) {
                const s8v a = *(const s8v*)(Ti + (16 * rt + fr) * G_LDT + ks * 32 + fq * 8);
#pragma unroll
                for (int ct = 0; ct < 4; ++ct) { const s8v bb = *(const s8v*)(rT + (64 * chf + 16 * ct + fr) * G_LDT + ks * 32 + fq * 8); dl[ct] = mfma16(a, bb, dl[ct]); }
            }
#pragma unroll
            for (int ct = 0; ct < 4; ++ct) { const int dv = 64 * chf + 16 * ct + fr;
                *(uint2*)(dT + dv * G_LDT + 16 * rt + fq * 4) = make_uint2(pack2(dl[ct][0], dl[ct][1]), pack2(dl[ct][2], dl[ct][3])); }
        }
        LBAR();
        {
#pragma unroll
            for (int ks = 0; ks < 2; ++ks) {
                const s8v a = *(const s8v*)(Qk + (16 * rt + fr) * G_LDT + ks * 32 + fq * 8);
#pragma unroll
                for (int ct = 0; ct < 4; ++ct) { const s8v bb = *(const s8v*)(dT + (64 * chf + 16 * ct + fr) * G_LDT + ks * 32 + fq * 8); oacc[ct] = mfma16(bb, a, oacc[ct]); }
            }
            {
                const int i = 16 * rt + fr, t = cg * 64 + (dir ? 63 - i : i);
#pragma unroll
                for (int ct = 0; ct < 4; ++ct) *(uint2*)(opart + (size_t)t * 512 + h * 128 + 64 * chf + 16 * ct + fq * 4) = pack4(oacc[ct]);
            }
            const float ge = fexp(sgc[63]);
#pragma unroll
            for (int ct = 0; ct < 8; ++ct) Sacc[ct] *= ge;
#pragma unroll
            for (int ks = 0; ks < 2; ++ks) {
                const s8v a = *(const s8v*)(KeT + (16 * wid + fr) * G_LDT + ks * 32 + fq * 8);
#pragma unroll
                for (int ct = 0; ct < 8; ++ct) { const s8v bb = *(const s8v*)(dT + (16 * ct + fr) * G_LDT + ks * 32 + fq * 8); Sacc[ct] = mfma16(a, bb, Sacc[ct]); }
            }
#pragma unroll
            for (int ct = 0; ct < 8; ++ct) *(uint2*)(St + (16 * ct + fr) * G_LDS + 16 * wid + fq * 4) = make_uint2(pack2(Sacc[ct][0], Sacc[ct][1]), pack2(Sacc[ct][2], Sacc[ct][3]));
        }
        LBAR();
    }
    if (!sq_.lat) {
        float* fs = p.out + OUT_GDN + ((((size_t)sq_.b * N_ODD + oi) * 2 + dir) * 4 + h) * 128 * 128;
#pragma unroll
        for (int ct = 0; ct < 8; ++ct)
#pragma unroll
            for (int r = 0; r < 4; ++r) fs[(16 * wid + fq * 4 + r) * 128 + 16 * ct + fr] = Sacc[ct][r];
    }
}
constexpr int S5_HLD = 136;
constexpr int S5_ITEMS = 2 * 32 * 2;
__device__ __forceinline__ void s5_task(const P& p, int oi, int dir, int g, int set, unsigned char* dsm) {
    float* sPr = (float*)dsm;
    float* sPi = sPr + 17 * 64;
    float* sBr = sPi + 17 * 64;
    float* sBi = sBr + 1024;
    float* sCr = sBi + 1024;
    float* sCi = sCr + 16 * 65;
    bf16* sK = (bf16*)(sCi + 16 * 65 + 16);
    bf16* HT = sK + 4096;
    bf16* sG = HT + 2 * 16 * S5_HLD;
    bf16* UT = sG + 256 * S5_HLD;
    const int tid = opaque_tid(), lane = tid & 63, wid = tid >> 6, fr = lane & 15, fq = lane >> 4;
    const int nseq = set ? NB_CTX : NB_LAT, sbase = set ? 0 : NB_CTX, len = set ? L_CTX : L_LAT;
    const bf16* proj = (const bf16*)(p.ws + WS_PROJ);
    bf16* ypart = (bf16*)(p.ws + WS_PART + (size_t)(2 + dir) * PART_SZ);
    const size_t pg = ((size_t)(oi * 2 + dir) * 32 + g);
    LBAR();
    if (tid < 64) {
        const float are = fminf(p.in[I_S5AR][pg * 64 + tid], -1e-4f), aim = p.in[I_S5AI][pg * 64 + tid];
        const float dt = expf(p.in[I_S5DT][pg]);
        const float mag = expf(are * dt), ar = mag * cosf(aim * dt), ai = mag * sinf(aim * dt);
        float pr = 1.f, pi = 0.f;
        for (int j = 0; j <= 16; ++j) { sPr[j * 64 + tid] = pr; sPi[j * 64 + tid] = pi; const float nr = pr * ar - pi * ai, ni = pr * ai + pi * ar; pr = nr; pi = ni; }
    }
    {
        const int st = tid >> 3, c0 = (tid & 7) * 2;
        const float are = fminf(p.in[I_S5AR][pg * 64 + st], -1e-4f), aim = p.in[I_S5AI][pg * 64 + st];
        const float dt = expf(p.in[I_S5DT][pg]);
        const float mag = expf(are * dt), ar = mag * cosf(aim * dt), ai = mag * sinf(aim * dt);
        const float den = are * are + aim * aim;
        const float fre = ((ar - 1.0f) * are + ai * aim) / den, fim = (ai * are - (ar - 1.0f) * aim) / den;
#pragma unroll
        for (int c = 0; c < 2; ++c) {
            const float br = p.in[I_S5BR][(pg * 64 + st) * 16 + c0 + c], bi = p.in[I_S5BI][(pg * 64 + st) * 16 + c0 + c];
            sBr[st * 16 + c0 + c] = fre * br - fim * bi; sBi[st * 16 + c0 + c] = fre * bi + fim * br;
        }
        for (int e = tid; e < 1024; e += 512) { sCr[(e >> 6) * 65 + (e & 63)] = p.in[I_S5CR][pg * 1024 + e]; sCi[(e >> 6) * 65 + (e & 63)] = p.in[I_S5CI][pg * 1024 + e]; }
    }
    LBAR();
    {
        const int lag = tid >> 5, co = (tid >> 1) & 15, c8 = (tid & 1) * 8;
        f8v acc = (f8v)(0.f);
        for (int q = 0; q < 64; ++q) {
            const float cr = sCr[co * 65 + q], ci = sCi[co * 65 + q], pr = sPr[lag * 64 + q], pi = sPi[lag * 64 + q];
            const float mr = cr * pr - ci * pi, mi = cr * pi + ci * pr;
            const f8v br = *(const f8v*)(sBr + q * 16 + c8), bi = *(const f8v*)(sBi + q * 16 + c8);
            acc += mr * br - mi * bi;
        }
        *(uint4*)(sK + (lag * 16 + co) * 16 + c8) = pack8v(acc);
    }
    {
        const int row = tid >> 1, tt = row >> 4, co = row & 15, half = tid & 1;
        for (int q0 = 0; q0 < 64; q0 += 8) {
            f8v v;
#pragma unroll
            for (int j = 0; j < 8; ++j) { const int q = q0 + j; const float cr = sCr[co * 65 + q], ci = sCi[co * 65 + q], pr = sPr[(tt + 1) * 64 + q], pi = sPi[(tt + 1) * 64 + q]; v[j] = half ? -(cr * pi + ci * pr) : cr * pr - ci * pi; }
            *(uint4*)(sG + row * S5_HLD + half * 64 + q0) = pack8v(v);
        }
    }
    LBAR();
    const int sp = fq >> 1, cih = (fq & 1) * 8;
    const int nsteps = len >> 4;
    constexpr int S5_ULD = 264;
    const int un = (tid & 255) >> 4, us = tid & 15;
    const bf16* ubase = proj + (size_t)get_seq(sbase + (un < nseq ? un : 0)).start * OW + O_U + g * 16;
#define S5_UADDR(K) (ubase + (size_t)(dir ? len - 1 - (16 * (K) + us) : 16 * (K) + us) * OW)
#define S5_UPUT(K, QA, QB) do { bf16* d_ = UT + ((K) & 1) * 16 * S5_ULD + un * S5_ULD + us * 16; *(uint4*)d_ = QA; *(uint4*)(d_ + 8) = QB; } while (0)
#define S5_ULOAD(K) const bf16* up_ = UT + ((K) & 1) * 16 * S5_ULD + fr * S5_ULD + 8 * fq; \
        const s8v u0 = *(const s8v*)up_, u1 = *(const s8v*)(up_ + 32), u2 = *(const s8v*)(up_ + 64), u3 = *(const s8v*)(up_ + 96), \
                  u4 = *(const s8v*)(up_ + 128), u5 = *(const s8v*)(up_ + 160), u6 = *(const s8v*)(up_ + 192), u7 = *(const s8v*)(up_ + 224)
    if (wid < 4) {
        s8v wre[8], wim[8];
        {
            const int pp = 16 * wid + fr;
#pragma unroll
            for (int m = 0; m < 8; ++m) {
                const int sidx = 15 - (2 * m + sp);
                const float pr = sPr[sidx * 64 + pp], pi = sPi[sidx * 64 + pp];
#pragma unroll
                for (int j = 0; j < 8; ++j) {
                    const float br = sBr[pp * 16 + cih + j], bi = sBi[pp * 16 + cih + j];
                    wre[m][j] = (short)f2bf(pr * br - pi * bi); wim[m][j] = (short)f2bf(pr * bi + pi * br);
                }
            }
        }
        float a16r[4], a16i[4], hr[4], hi[4];
#pragma unroll
        for (int r = 0; r < 4; ++r) {
            const int pp = 16 * wid + fq * 4 + r;
            a16r[r] = sPr[16 * 64 + pp]; a16i[r] = sPi[16 * 64 + pp];
            hr[r] = 0.f; hi[r] = 0.f;
            if (set == 0 && fr < nseq) { const size_t o = (((size_t)fr * N_ODD + oi) * 2 + dir) * 32 * 64 + g * 64 + pp; hr[r] = p.in[I_SS5R][o]; hi[r] = p.in[I_SS5I][o]; }
        }
        *(uint2*)(HT + fr * S5_HLD + 16 * wid + fq * 4) = make_uint2(pack2(hr[0], hr[1]), pack2(hr[2], hr[3]));
        *(uint2*)(HT + fr * S5_HLD + 64 + 16 * wid + fq * 4) = make_uint2(pack2(hi[0], hi[1]), pack2(hi[2], hi[3]));
        uint4 qa0, qb0, qa1, qb1, qa2, qb2, qa3, qb3;
        { const bf16* a_ = S5_UADDR(0); qa0 = *(const uint4*)a_; qb0 = *(const uint4*)(a_ + 8); S5_UPUT(0, qa0, qb0); }
#define S5_QLOAD(K, QA, QB) do { if ((K) < nsteps) { const bf16* a_ = S5_UADDR(K); QA = *(const uint4*)a_; QB = *(const uint4*)(a_ + 8); } } while (0)
        S5_QLOAD(1, qa1, qb1); S5_QLOAD(2, qa2, qb2); S5_QLOAD(3, qa3, qb3); S5_QLOAD(4, qa0, qb0);
        LBAR();
#define S5_STATE_STEP(K, QA, QB) do { \
            const int k = (K); \
            S5_ULOAD(k); \
            if (k + 1 < nsteps) { S5_UPUT(k + 1, QA, QB); S5_QLOAD(k + 5, QA, QB); } \
            f4v zr = (f4v){0.f, 0.f, 0.f, 0.f}, zi = zr; \
            zr = mfma16(wre[0], u0, zr); zi = mfma16(wim[0], u0, zi); zr = mfma16(wre[1], u1, zr); zi = mfma16(wim[1], u1, zi); \
            zr = mfma16(wre[2], u2, zr); zi = mfma16(wim[2], u2, zi); zr = mfma16(wre[3], u3, zr); zi = mfma16(wim[3], u3, zi); \
            zr = mfma16(wre[4], u4, zr); zi = mfma16(wim[4], u4, zi); zr = mfma16(wre[5], u5, zr); zi = mfma16(wim[5], u5, zi); \
            zr = mfma16(wre[6], u6, zr); zi = mfma16(wim[6], u6, zi); zr = mfma16(wre[7], u7, zr); zi = mfma16(wim[7], u7, zi); \
            _Pragma("unroll") for (int r = 0; r < 4; ++r) { const float nr = a16r[r] * hr[r] - a16i[r] * hi[r] + zr[r], ni = a16r[r] * hi[r] + a16i[r] * hr[r] + zi[r]; hr[r] = nr; hi[r] = ni; } \
            bf16* hb = HT + ((k + 1) & 1) * 16 * S5_HLD; \
            *(uint2*)(hb + fr * S5_HLD + 16 * wid + fq * 4) = make_uint2(pack2(hr[0], hr[1]), pack2(hr[2], hr[3])); \
            *(uint2*)(hb + fr * S5_HLD + 64 + 16 * wid + fq * 4) = make_uint2(pack2(hi[0], hi[1]), pack2(hi[2], hi[3])); \
            LBAR(); } while (0)
        for (int k4 = 0; k4 < nsteps; k4 += 4) {
            S5_STATE_STEP(k4, qa1, qb1); S5_STATE_STEP(k4 + 1, qa2, qb2); S5_STATE_STEP(k4 + 2, qa3, qb3); S5_STATE_STEP(k4 + 3, qa0, qb0);
        }
        if (set == 1 && fr < nseq) {
#pragma unroll
            for (int r = 0; r < 4; ++r) { const size_t o = (((size_t)fr * N_ODD + oi) * 2 + dir) * 32 * 64 + g * 64 + 16 * wid + fq * 4 + r; p.out[OUT_S5R + o] = hr[r]; p.out[OUT_S5I + o] = hi[r]; }
        }
    } else {
        const int t0 = 4 * (RFL(wid) - 4);
        s8v klr[18];
#pragma unroll
        for (int e = 0; e < 18; ++e) { const int lg = t0 + 3 - e - sp; klr[e] = (lg >= 0) ? *(const s8v*)(sK + (lg * 16 + fr) * 16 + cih) : (s8v){0, 0, 0, 0, 0, 0, 0, 0}; }
        LBAR();
        for (int k = 0; k < nsteps; ++k) {
            S5_ULOAD(k);
            const bf16* hb = HT + (k & 1) * 16 * S5_HLD + fr * S5_HLD + 8 * fq;
            const s8v h0 = *(const s8v*)hb, h1 = *(const s8v*)(hb + 32), h2 = *(const s8v*)(hb + 64), h3 = *(const s8v*)(hb + 96);
            f4v y0 = (f4v){0.f, 0.f, 0.f, 0.f}, y1 = y0, y2 = y0, y3 = y0;
            {
                const bf16* gp = sG + (t0 * 16 + fr) * S5_HLD + 8 * fq;
#define S5_G4(KS, H) do { y0 = mfma16(*(const s8v*)(gp + 32 * (KS)), H, y0); y1 = mfma16(*(const s8v*)(gp + 16 * S5_HLD + 32 * (KS)), H, y1); \
                          y2 = mfma16(*(const s8v*)(gp + 32 * S5_HLD + 32 * (KS)), H, y2); y3 = mfma16(*(const s8v*)(gp + 48 * S5_HLD + 32 * (KS)), H, y3); } while (0)
                S5_G4(0, h0); S5_G4(1, h1); S5_G4(2, h2); S5_G4(3, h3);
#define S5_K4(M, U) do { if (2 * (M) <= t0 + 0) y0 = mfma16(klr[3 + 2 * (M)], U, y0); if (2 * (M) <= t0 + 1) y1 = mfma16(klr[2 + 2 * (M)], U, y1); \
                         if (2 * (M) <= t0 + 2) y2 = mfma16(klr[1 + 2 * (M)], U, y2); if (2 * (M) <= t0 + 3) y3 = mfma16(klr[0 + 2 * (M)], U, y3); } while (0)
                S5_K4(0, u0); S5_K4(1, u1); S5_K4(2, u2); S5_K4(3, u3); S5_K4(4, u4); S5_K4(5, u5); S5_K4(6, u6); S5_K4(7, u7);
            }
            if (fr < nseq) {
                const int tb_ = get_seq(sbase + fr).start;
#define S5_ST(TT, Y) do { const int pos = 16 * k + t0 + (TT), tok = tb_ + (dir ? len - 1 - pos : pos); *(uint2*)(ypart + (size_t)tok * 512 + g * 16 + fq * 4) = pack4(Y); } while (0)
                S5_ST(0, y0); S5_ST(1, y1); S5_ST(2, y2); S5_ST(3, y3);
            }
            LBAR();
        }
    }
}
constexpr int ODD_GDN_ITEMS = NSEQ * 8;
constexpr int ODD_SCAN_ITEMS = ODD_GDN_ITEMS + S5_ITEMS;
__device__ __forceinline__ void ph_odd_scan_item(const P& p, int w, int oi, float* smem_full) {
    unsigned char* dsm = (unsigned char*)smem_full;
    const int nlg = NB_LAT * 8, ncg = NB_CTX * 8;
    if (w < ncg) { gdn_scan_task(p, oi, w / 8, (w % 8) >> 1, w & 1, dsm); return; }
    w -= ncg;
    if (w < 64) { __syncthreads(); s5_task(p, oi, w >> 5, w & 31, 0, dsm); return; }
    w -= 64;
    if (w < nlg) { gdn_scan_task(p, oi, NB_CTX + w / 8, (w % 8) >> 1, w & 1, dsm); return; }
    w -= nlg;
    __syncthreads(); s5_task(p, oi, w >> 5, w & 31, 1, dsm);
}
__device__ __forceinline__ void ph_fin_odd_a(const P& p, int bid, int oi) {
    const int lane = LT & 63, tb = bid * (4 * NTW) + (LT >> 6) * NTW;
    if (tb >= T) return;
    const int idx = lane * 8;
    uint4 vof[NTW], vob[NTW], vyf[NTW], vyb[NTW], vzc[NTW], vu[NTW];
#pragma unroll
    for (int u = 0; u < NTW; ++u) {
        const size_t t = (size_t)((tb + u < T) ? tb + u : T - 1);
        const bf16* pr = (const bf16*)(p.ws + WS_PROJ) + t * OW;
        vof[u] = *(const uint4*)((const bf16*)(p.ws + WS_PART) + t * 512 + idx);
        vob[u] = *(const uint4*)((const bf16*)(p.ws + WS_PART + PART_SZ) + t * 512 + idx);
        vyf[u] = *(const uint4*)((const bf16*)(p.ws + WS_PART + 2 * PART_SZ) + t * 512 + idx);
        vyb[u] = *(const uint4*)((const bf16*)(p.ws + WS_PART + 3 * PART_SZ) + t * 512 + idx);
        vzc[u] = *(const uint4*)(pr + O_ZC + idx);
        vu[u] = *(const uint4*)(pr + O_U + idx);
    }
    const f8v gn = *(const f8v*)(p.in[I_GDNN] + oi * 128 + (idx & 127));
    const f8v dsk = *(const f8v*)(p.in[I_S5D] + oi * 512 + idx);
#pragma unroll
    for (int u = 0; u < NTW; ++u) {
        const size_t t = (size_t)(tb + u); if (tb + u >= T) break;
        f8v o = unpack8v(vof[u]) + unpack8v(vob[u]);
        float ss = 0.f;
#pragma unroll
        for (int j = 0; j < 8; ++j) ss += o[j] * o[j];
        ss = red16(ss);
        const float r = frsq(ss * (1.0f / 128.f) + EPS);
        const f8v zc = unpack8v(vzc[u]);
        f8v y = unpack8v(vyf[u]) + unpack8v(vyb[u]) + dsk * unpack8v(vu[u]);
#pragma unroll
        for (int j = 0; j < 8; ++j) { o[j] = o[j] * r * gn[j] * siluf_(zc[j]); y[j] = gelu_tanh(y[j]); }
        *(uint4*)((bf16*)(p.ws + WS_HM) + t * D + idx) = pack8v(o);
        *(uint4*)((bf16*)(p.ws + WS_PART + 2 * PART_SZ) + t * 512 + idx) = pack8v(y);
    }
}
__device__ __forceinline__ void ph_fin_odd_b(const P& p, int bid, int oi) {
    const size_t e = ((size_t)bid * 256 + LT) * 4;
    if (e >= (size_t)T * 512) return;
    const int t = (int)(e >> 9), idx = (int)(e & 511);
    const bf16* pr = (const bf16*)(p.ws + WS_PROJ) + (size_t)t * OW;
    const bf16* gl = (const bf16*)(p.ws + WS_PART + 2 * PART_SZ) + (size_t)t * 512;
    bf16* yc = (bf16*)(p.ws + WS_HM) + (size_t)t * D + 512;
#pragma unroll
    for (int j = 0; j < 4; ++j) {
        const float ys = bf2f(yc[idx + j]);
        yc[idx + j] = f2bf(ys * sigmoidf_(bf2f(gl[idx + j]) + p.in[I_GLUB][oi * 512 + idx + j]) * siluf_(bf2f(pr[O_ZD + idx + j])));
    }
}

enum { PK_PREP0, PK_HMOD0, PK_GEMM_IN, PK_EVEN_SCAN, PK_FIN_EVEN, PK_ODD_PREP, PK_ODD_SCAN, PK_FIN_ODD_A, PK_GEMM_GLU, PK_FIN_ODD_B, PK_GEMM_OUT, PK_POST, PK_RWKV_PREP0, PK_RWKV_PREP1, PK_EVEN_SCAN1 };
constexpr int NPH = 2 + (DEPTH / 2) * 14;
constexpr int TOKB = (T + 3) / 4;
static_assert(DEPTH % 2 == 0, "even depth expected");
__host__ __device__ inline void phase_desc(int ph, int& kind, int& layer) {
    if (ph == 0) { kind = PK_PREP0; layer = 0; return; }
    if (ph == 1) { kind = PK_HMOD0; layer = 0; return; }
    ph -= 2;
    const int pair = ph / 14, r = ph % 14;
    if (r < 7) { layer = 2 * pair; kind = r == 0 ? PK_GEMM_IN : r == 1 ? PK_RWKV_PREP0 : r == 2 ? PK_EVEN_SCAN : r == 3 ? PK_RWKV_PREP1 : r == 4 ? PK_EVEN_SCAN1 : r == 5 ? PK_GEMM_OUT : PK_POST; }
    else { const int q = r - 7; layer = 2 * pair + 1; kind = q == 0 ? PK_GEMM_IN : q == 1 ? PK_ODD_PREP : q == 2 ? PK_ODD_SCAN : q == 3 ? PK_FIN_ODD_A : q == 4 ? PK_GEMM_GLU : q == 5 ? PK_GEMM_OUT : PK_POST; }
}
__host__ __device__ inline bool phase_is_gemm(int kind) { return kind == PK_GEMM_IN || kind == PK_GEMM_GLU || kind == PK_GEMM_OUT; }
__host__ __device__ inline int phase_nblk(int kind, int layer) {
    switch (kind) {
        case PK_PREP0: return MOD_VB + WT_TILES / WT_NT;
        case PK_FIN_ODD_B: return (T * 512 / 4 + 255) / 256;
        default: return (T + 4 * NTW - 1) / (4 * NTW);
    }
}
__device__ __forceinline__ void do_phase(const P& p, int kind, int layer, int vb, float* smem) {
    const int i = layer >> 1;
    switch (kind) {
        case PK_PREP0: if (vb < MOD_VB) { PT_B(50); ph_mod(p, vb, smem); PT_E(50); } else { PT_B(51); ph_wt(p, vb - MOD_VB, smem); PT_E(51); } break;
        case PK_HMOD0: ph_hmod0(p, vb); break;
        case PK_FIN_EVEN: ph_fin_even(p, vb, i); break;
        case PK_FIN_ODD_A: ph_fin_odd_a(p, vb, i); break;
        case PK_FIN_ODD_B: ph_fin_odd_b(p, vb, i); break;
        case PK_POST: ph_post(p, vb, layer); break;
    }
}
__device__ __forceinline__ void do_gemm(const P& p, int kind, int layer, int G, int c, unsigned char* dsm) {
    const int i = layer >> 1;
    const bf16* hm = (const bf16*)(p.ws + WS_HM);
    pg8::StaticOrder S;
    LDS_AS unsigned char* lds = (LDS_AS unsigned char*)dsm;
    if (kind == PK_GEMM_IN) {
        if ((layer & 1) == 0) { pg8::Gemm g{hm, (const bf16*)(p.ws + WS_WTE) + (size_t)i * EWP * D, T, EWP, D, D}; S.init(T, EWP, G, c); pg8::EpiBf16 E{(bf16*)(p.ws + WS_PROJ), EW, EW}; pg8::gemm_phase(lds, g, S, E); }
        else { pg8::Gemm g{hm, (const bf16*)(p.ws + WS_WTO) + (size_t)i * OWP * D, T, OWP, D, D}; S.init(T, OWP, G, c); pg8::EpiBf16 E{(bf16*)(p.ws + WS_PROJ), OW, OW}; pg8::gemm_phase(lds, g, S, E); }
    } else if (kind == PK_GEMM_GLU) {
        const bf16* ysb = (const bf16*)(p.ws + WS_PART + 2 * PART_SZ);
        pg8::Gemm g{ysb, (const bf16*)(p.ws + WS_WTGLU) + (size_t)i * 512 * 512, T, 512, 512, 512}; S.init(T, 512, G, c);
        pg8::EpiGlu E{(bf16*)(p.ws + WS_HM) + 512, ysb, (const bf16*)(p.ws + WS_PROJ) + O_ZD, p.in[I_GLUB] + i * 512}; pg8::gemm_phase(lds, g, S, E);
    } else {
        const bf16* ya = (layer & 1) ? hm : (const bf16*)(p.ws + WS_YCE);
        pg8::Gemm g{ya, (const bf16*)(p.ws + WS_WTOUT) + (size_t)layer * D * D, T, D, D, D}; S.init(T, D, G, c); pg8::EpiBf16 E{(bf16*)(p.ws + WS_PROJ), D, D}; pg8::gemm_phase(lds, g, S, E);
    }
}
constexpr int LDS_BYTES = 163840;
constexpr bool EVEN_FUSED_SCHED = (NB_LAT == 8 && NB_CTX == 16 && L_CTX == 256 && L_LAT == 1024);
#ifndef REP_SCAN
#define REP_SCAN 1
#endif
#ifndef REP_GEMM
#define REP_GEMM 1
#endif

#ifdef CPU_EMU
__global__ void k_phase(P p, int kind, int layer, int nb) {
    __shared__ __attribute__((aligned(16))) unsigned char dsm[LDS_BYTES];
    if (phase_is_gemm(kind)) { do_gemm(p, kind, layer, gridDim.x, blockIdx.x, dsm); return; }
    if (kind == PK_ODD_SCAN) { ph_odd_scan_item(p, blockIdx.x, layer >> 1, (float*)dsm); return; }
    if (kind == PK_ODD_PREP) { ph_odd_prep(p, blockIdx.x, layer >> 1, dsm); return; }
    if (kind == PK_EVEN_SCAN || kind == PK_EVEN_SCAN1) { ph_even_scan_item(p, blockIdx.x, layer >> 1, kind == PK_EVEN_SCAN1, dsm); return; }
    if (kind == PK_RWKV_PREP0 || kind == PK_RWKV_PREP1) { rwkv_prep_phase(p, layer >> 1, kind == PK_RWKV_PREP1, blockIdx.x, gridDim.x, RWKV_PREP_ITEMS, dsm); return; }
    const int half = threadIdx.x >> 8, vb = 2 * blockIdx.x + half;
    if (vb < nb) do_phase(p, kind, layer, vb, (float*)dsm + half * 16384);
}
void emu_hook(const char* stage, int layer, const P& p);
extern "C" void kernel_launch(void* const* d_in, const int* in_sizes, int n_in, void* d_out, int out_size, void* d_ws, size_t ws_size, hipStream_t stream) {
    P p{};
    for (int i = 0; i < 44; ++i) p.in[i] = (const float*)d_in[i];
    p.out = (float*)d_out; p.ws = (char*)d_ws;
    static const char* names[] = {"prep0", "hmod", "proj", "even_scan0", "ycat", "odd_prep", "odd_scan", "fin_odd_a", "ycat", "ycat", "outproj", "post", "rwkv_prep0", "rwkv_prep1", "even_scan"};
    for (int ph = 0; ph < NPH; ++ph) {
        int kind, layer; phase_desc(ph, kind, layer);
        const int nb = phase_nblk(kind, layer);
        EMU_LAUNCH(k_phase, phase_is_gemm(kind) ? 3 : kind == PK_ODD_SCAN ? ODD_SCAN_ITEMS : (kind == PK_EVEN_SCAN || kind == PK_EVEN_SCAN1) ? EVEN_SCAN_ITEMS : (kind == PK_RWKV_PREP0 || kind == PK_RWKV_PREP1) ? RWKV_PREP_ITEMS : kind == PK_ODD_PREP ? ODD_PREP_ITEMS : (nb + 1) / 2, 512, p, kind, layer, nb);
        emu_hook(names[kind], layer, p);
    }
}
#else

#define XB_TMO      128
#define XB_XCNT(j)  (256  + 64 * (j))
#define XB_XSUB(j)  (1280 + 64 * (j))
#define XB_XGEN(j)  (2304 + 64 * (j))
#define XB_TOP      3328
#define XB_TOPGEN   3392
#define XCD_BAR_WORDS 3456
#define XB_SPIN_CAP (1u << 18)
__device__ __forceinline__ unsigned xb_ld(unsigned* p)              { return __hip_atomic_load(p, __ATOMIC_RELAXED, __HIP_MEMORY_SCOPE_AGENT); }
__device__ __forceinline__ unsigned xb_add(unsigned* p, unsigned v) { return __hip_atomic_fetch_add(p, v, __ATOMIC_RELAXED, __HIP_MEMORY_SCOPE_AGENT); }
__device__ __forceinline__ unsigned xb_xcc_id() { return (unsigned)__builtin_amdgcn_s_getreg((3 << 11) | 20) & 0xFu; }
#define XB_SPIN(cond, bar) do { unsigned _sp = 0; while (cond) { __builtin_amdgcn_s_sleep(1); \
    if ((++_sp & 255u) == 0u) { if (xb_ld(&(bar)[XB_TMO])) break; if (_sp > XB_SPIN_CAP) { atomicAdd(&(bar)[XB_TMO], 1u); break; } } } } while (0)
struct XcdBarrier { unsigned* bar; unsigned x; volatile LDS_AS unsigned* st; };
__device__ __forceinline__ XcdBarrier xcd_barrier_post(unsigned* bar, volatile LDS_AS unsigned* st) {
    XcdBarrier b; b.bar = bar; b.x = xb_xcc_id(); b.st = st;
    if (threadIdx.x == 0) (void)xb_add(&bar[XB_XCNT(b.x)], 1u);
    return b;
}
__device__ __forceinline__ void xcd_barrier_complete(unsigned* bar, unsigned x, unsigned& nloc, unsigned& nx) {
    const unsigned G = gridDim.x * gridDim.y * gridDim.z;
    unsigned sum, cnt, mine, sp = 0u;
    for (;;) {
        sum = 0u; cnt = 0u; mine = 0u;
#pragma unroll
        for (unsigned j = 0; j < 16; ++j) { const unsigned c = xb_ld(&bar[XB_XCNT(j)]); sum += c; cnt += (c > 0u) ? 1u : 0u; mine = (j == x) ? c : mine; }
        if (sum == G) break;
        __builtin_amdgcn_s_sleep(1);
        if ((++sp & 255u) == 0u) { if (xb_ld(&bar[XB_TMO])) break; if (sp > XB_SPIN_CAP) { atomicAdd(&bar[XB_TMO], 1u); break; } }
    }
    nloc = mine > 0u ? mine : 1u; nx = cnt > 0u ? cnt : 1u;
}
__device__ __forceinline__ void xcd_barrier(const XcdBarrier& b) {
    asm volatile("s_waitcnt vmcnt(0)" ::: "memory");
    __syncthreads();
    if (threadIdx.x == 0) {
        unsigned* bar = b.bar;
        __builtin_amdgcn_s_waitcnt(0);
        unsigned nloc = b.st[0], nx = b.st[1];
        if (nloc == 0u) { xcd_barrier_complete(bar, b.x, nloc, nx); b.st[0] = nloc; b.st[1] = nx; }
        const unsigned old = xb_add(&bar[XB_XSUB(b.x)], 1u);
        const unsigned gen = old / nloc;
        if (old + 1u == (gen + 1u) * nloc) {
            __builtin_amdgcn_fence(__ATOMIC_RELEASE, "agent");
            asm volatile("s_waitcnt vmcnt(0)" ::: "memory");
            const unsigned og = xb_add(&bar[XB_TOP], 1u);
            const unsigned tg = og / nx;
            if (og + 1u == (tg + 1u) * nx) xb_add(&bar[XB_TOPGEN], 1u);
            else XB_SPIN(xb_ld(&bar[XB_TOPGEN]) == tg, bar);
            __builtin_amdgcn_fence(__ATOMIC_ACQUIRE, "agent");
            xb_add(&bar[XB_XGEN(b.x)], 1u);
            asm volatile("s_waitcnt vmcnt(0)" ::: "memory");
        } else {
            XB_SPIN(xb_ld(&bar[XB_XGEN(b.x)]) == gen, bar);
            __builtin_amdgcn_fence(__ATOMIC_ACQUIRE, "agent");
            asm volatile("s_waitcnt vmcnt(0)" ::: "memory");
        }
    }
    __syncthreads();
}
extern __shared__ __attribute__((aligned(16))) unsigned char dsm[];
#define RUN_PHASE(KIND, LAYER) do { const int nb_ = phase_nblk(KIND, LAYER); const int half_ = opaque_tid() >> 8; \
    for (int b_ = blockIdx.x; 2 * b_ < nb_; b_ += gridDim.x) { const int vb_ = 2 * b_ + half_; if (vb_ < nb_) do_phase(p, KIND, LAYER, vb_, (float*)dsm + half_ * 16384); } } while (0)
#define RUN_GEMM(KIND, LAYER) do_gemm(p, KIND, LAYER, gridDim.x, blockIdx.x, dsm)
typedef const __attribute__((address_space(4))) P* KP;
__device__ __forceinline__ const P& phase_args(KP pk) { asm volatile("" : "+s"(pk)); return *(const P*)pk; }
__global__ void __launch_bounds__(512) mega(P p_unused) {
    const KP pk = (KP)__builtin_amdgcn_kernarg_segment_ptr();
    volatile LDS_AS unsigned* xst = (volatile LDS_AS unsigned*)(dsm + LDS_BYTES - 16);
    if (threadIdx.x == 0) { xst[0] = 0u; xst[1] = 0u; xst[2] = 0u; xst[3] = 0u; }
    __syncthreads();
    XcdBarrier xb;
    { const P& p = phase_args(pk); xb = xcd_barrier_post((unsigned*)(p.ws + WS_BAR), xst); }
#define GSYNC() do { PT_B(31); const P& pb_ = phase_args(pk); XcdBarrier b_ = xb; b_.bar = (unsigned*)(pb_.ws + WS_BAR); xcd_barrier(b_); PT_E(31); } while (0)
    { PT_B(20); { const P& p = phase_args(pk); RUN_PHASE(PK_PREP0, 0); } GSYNC(); PT_E(20); }
    { PT_B(21); { const P& p = phase_args(pk); RUN_PHASE(PK_HMOD0, 0); } GSYNC(); PT_E(21); }
#pragma nounroll
    for (int pair = 0; pair < DEPTH / 2; ++pair) {
        const int le = 2 * pair, lo = 2 * pair + 1;
        { PT_B(22); { const P& p = phase_args(pk); RUN_GEMM(PK_GEMM_IN, le); } GSYNC(); PT_E(22); }
#pragma nounroll
        for (int dir_ = 0; dir_ < 2; ++dir_) {
            if (EVEN_FUSED_SCHED && gridDim.x == 256) {
                { PT_B(13); { const P& p = phase_args(pk); const int hg = blockIdx.x & 7, q = blockIdx.x >> 3;
                  int cg0, ncg;
                  PT_B(12);
                  if (q < 4) { const int x = hg * 4 + q; gla_scan_task(p, pair, NB_CTX + x / 4, x & 3, dir_, dsm); cg0 = q * 2; ncg = 2; }
                  else if (q < 12) { const int x = hg * 8 + (q - 4); gla_scan_task(p, pair, x / 4, x & 3, dir_, dsm); const int j = q - 4; ncg = 5 + (j & 1); cg0 = 8 + (j >> 1) * 11 + (j & 1) * 5; }
                  else { cg0 = 52 + (q - 12) * 7; ncg = 7; }
                  PT_E(12); PT_B(11);
                  rwkv_prep_phase(p, pair, dir_, cg0 * 8 + hg, 8, (cg0 + ncg) * 8, dsm); PT_E(11); } GSYNC(); PT_E(13); }
                { PT_B(23); { const P& p = phase_args(pk); for (int w_ = blockIdx.x; w_ < EV_AP_LAT + EV_AP_CTX; w_ += gridDim.x) rwkv_apply_task(p, pair, w_ < EV_AP_LAT ? NB_CTX + w_ / 8 : (w_ - EV_AP_LAT) / 8, w_ & 7, dir_, dsm); } GSYNC(); PT_E(23); }
            } else {
                { const P& p = phase_args(pk); rwkv_prep_phase(p, pair, dir_, blockIdx.x, gridDim.x, RWKV_PREP_ITEMS, dsm); } GSYNC();
                { const P& p = phase_args(pk); for (int w_ = blockIdx.x; w_ < EVEN_SCAN_ITEMS; w_ += gridDim.x) ph_even_scan_item(p, w_, pair, dir_, dsm); } GSYNC();
            }
        }
        { PT_B(24); { const P& p = phase_args(pk); RUN_GEMM(PK_GEMM_OUT, le); } GSYNC(); PT_E(24); }
        { PT_B(25); { const P& p = phase_args(pk); RUN_PHASE(PK_POST, le); } GSYNC(); PT_E(25); }
        { PT_B(26); { const P& p = phase_args(pk); RUN_GEMM(PK_GEMM_IN, lo); } GSYNC(); PT_E(26); }
        { PT_B(27); { const P& p = phase_args(pk); for (int w_ = blockIdx.x; w_ < ODD_PREP_ITEMS; w_ += gridDim.x) ph_odd_prep(p, w_, pair, dsm); } GSYNC(); PT_E(27); }
        { PT_B(28); { const P& p = phase_args(pk); for (int w_ = blockIdx.x; w_ < ODD_SCAN_ITEMS; w_ += gridDim.x) ph_odd_scan_item(p, w_, pair, (float*)dsm); } GSYNC(); PT_E(28); }
        { PT_B(29); { const P& p = phase_args(pk); RUN_PHASE(PK_FIN_ODD_A, lo); } GSYNC(); PT_E(29); }
        { PT_B(30); { const P& p = phase_args(pk); RUN_GEMM(PK_GEMM_GLU, lo); } GSYNC(); PT_E(30); }
        { PT_B(24); { const P& p = phase_args(pk); RUN_GEMM(PK_GEMM_OUT, lo); } GSYNC(); PT_E(24); }
        { PT_B(25); const P& p = phase_args(pk); RUN_PHASE(PK_POST, lo); PT_E(25); }
        if (pair + 1 < DEPTH / 2) GSYNC();
    }
#if PROBE_SEL
    if (blockIdx.x == PROBE_BLK && threadIdx.x == 0) {
        const unsigned long long tot_ = *(volatile unsigned long long*)(dsm + LDS_BYTES - 8) * PROBE_MUL;
        const long long s_ = clock64();
        while ((unsigned long long)(clock64() - s_) < tot_) {}
    }
#endif
}
extern "C" void kernel_launch(void* const* d_in, const int* in_sizes, int n_in, void* d_out, int out_size, void* d_ws, size_t ws_size, hipStream_t stream) {
    static int grid_blocks = 0;
    if (!grid_blocks) {
        int dev = 0, cus = 0, per_cu = 0;
        (void)hipGetDevice(&dev);
        (void)hipDeviceGetAttribute(&cus, hipDeviceAttributeMultiprocessorCount, dev);
        (void)hipFuncSetAttribute((const void*)mega, hipFuncAttributeMaxDynamicSharedMemorySize, LDS_BYTES);
        (void)hipOccupancyMaxActiveBlocksPerMultiprocessor(&per_cu, mega, 512, LDS_BYTES);
        if (per_cu < 1) fprintf(stderr, "occupancy query says %d blocks/CU\n", per_cu);
        grid_blocks = cus;
    }
    P p{};
    for (int i = 0; i < 44; ++i) p.in[i] = (const float*)d_in[i];
    p.out = (float*)d_out; p.ws = (char*)d_ws;
    (void)hipMemsetAsync((char*)d_ws + WS_BAR, 0, XCD_BAR_WORDS * 4, stream);
    hipLaunchKernelGGL(mega, dim3(grid_blocks), dim3(512), LDS_BYTES, stream, p);
    hipError_t e = hipPeekAtLastError();
    if (e != hipSuccess) fprintf(stderr, "launch failed: %s (grid %d)\n", hipGetErrorString(e), grid_blocks);
}
#endif
```

```cpp
#ifndef CPU_EMU
#include <hip/hip_runtime.h>
#include <hip/hip_cooperative_groups.h>
#include <cstdio>
namespace cg = cooperative_groups;
#endif
#include <stdint.h>

#ifndef CFG_BATCH
#define CFG_BATCH 16
#define CFG_SEQ 256
#define CFG_DEC_BATCH 8
#define CFG_DEC_SEQ 1024
#define CFG_DEPTH 4
#endif

typedef unsigned short bf16;
typedef short s8v __attribute__((ext_vector_type(8)));
typedef float f4v __attribute__((ext_vector_type(4)));

constexpr int D = 1024;
constexpr int NB_CTX = CFG_BATCH, L_CTX = CFG_SEQ, NB_LAT = CFG_DEC_BATCH, L_LAT = CFG_DEC_SEQ, DEPTH = CFG_DEPTH;
constexpr int N_EVEN = (DEPTH + 1) / 2, N_ODD = DEPTH / 2;
constexpr int T_CTX = NB_CTX * L_CTX, T_LAT = NB_LAT * L_LAT, T = T_CTX + T_LAT;
constexpr int NSEQ = NB_CTX + NB_LAT, NCOND = 1 + NB_LAT;
constexpr int EW = 3872, OW = 3088, EWP = 4096, OWP = 3328;
constexpr float EPS = 1e-6f;
constexpr int E_Q = 0, E_K = 256, E_V = 512, E_GD = 1024, E_ZA = 1056, E_FB = 1568, E_ZB = 3360;
constexpr int FB_R = 0, FB_K = 512, FB_V = 1024, FB_WD = 1536, FB_AD = 1664;
constexpr int O_QKV = 0, O_G = 1536, O_BETA = 1544, O_ZC = 1552, O_U = 2064, O_ZD = 2576;

constexpr size_t al(size_t x) { return (x + 255) & ~(size_t)255; }
constexpr size_t WS_MOD = 0;
constexpr size_t WS_WTE = WS_MOD + al((size_t)DEPTH * NCOND * 3072 * 4);
constexpr size_t WS_WTO = WS_WTE + al((size_t)N_EVEN * EWP * D * 2);
constexpr size_t WS_WTOUT = WS_WTO + al((size_t)(N_ODD ? N_ODD : 1) * OWP * D * 2);
constexpr size_t WS_WTGLU = WS_WTOUT + al((size_t)DEPTH * D * D * 2);
constexpr size_t WS_HM = WS_WTGLU + al((size_t)(N_ODD ? N_ODD : 1) * 512 * 512 * 2);
constexpr size_t WS_PROJ = WS_HM + al((size_t)T * D * 2);
constexpr size_t WS_PART = WS_PROJ + al((size_t)T * EW * 2);
constexpr size_t PART_SZ = al((size_t)T * 512 * 2);
constexpr size_t WS_YCE = WS_PART + 2 * PART_SZ;
constexpr size_t WS_BONUS = WS_PART + 4 * PART_SZ;
constexpr size_t WS_QKVN = WS_BONUS + al((size_t)T * 16 * 4);
constexpr size_t WS_GATES = WS_QKVN + al((size_t)T * 1536 * 2);
constexpr size_t WS_GC = WS_GATES + al((size_t)T * 16 * 4);
constexpr size_t WS_BAR = WS_GC + al((size_t)(T / 64) * 8 * 64 * 4);
constexpr size_t WS_END = WS_BAR + 16384;
constexpr size_t WS_TINV = WS_PROJ + al((size_t)T * OW * 2);
constexpr size_t WS_QKM = WS_HM;
static_assert(WS_TINV + (size_t)T * 1024 <= WS_PART, "TINV must fit in the PROJ tail");
constexpr size_t WS_RM12 = WS_HM;
constexpr size_t WS_RM34 = WS_QKVN;
constexpr size_t WS_VSH = WS_QKVN + (size_t)(T / 64) * 8 * 16384;
static_assert((size_t)(T / 64) * 8 * 16384 <= (size_t)T * D * 2, "M1/M2 must fit in HM");
static_assert((size_t)(T / 64) * 8 * 16384 + (size_t)T * 512 * 2 <= (size_t)T * 1536 * 2, "M3/M4 + shifted v must fit in QKVN");

constexpr size_t OUT_X = 0;
constexpr size_t OUT_GLA = (size_t)T * D;
constexpr size_t OUT_RWKV = OUT_GLA + (size_t)NB_CTX * N_EVEN * 2 * 4 * 64 * 128;
constexpr size_t OUT_GDN = OUT_RWKV + (size_t)NB_CTX * N_EVEN * 2 * 8 * 64 * 64;
constexpr size_t OUT_S5R = OUT_GDN + (size_t)NB_CTX * N_ODD * 2 * 4 * 128 * 128;
constexpr size_t OUT_S5I = OUT_S5R + (size_t)NB_CTX * N_ODD * 2 * 32 * 64;

struct P {
    const float* in[44];
    float* out;
    char* ws;
};
enum { I_XP = 0, I_XS, I_C, I_SGLA, I_SRWKV, I_SGDN, I_SS5R, I_SS5I, I_CCTX, I_WMOD, I_BMOD, I_GPRE, I_GPOST,
       I_WINE, I_WOUTE, I_GUP, I_GBIAS, I_GLAN, I_MIX, I_W0, I_W2, I_A0, I_A2, I_KK, I_KA, I_RK, I_LNG, I_LNB,
       I_WINO, I_WOUTO, I_CONV, I_ALOG, I_DTB, I_GDNN, I_S5AR, I_S5AI, I_S5DT, I_S5BR, I_S5BI, I_S5CR, I_S5CI,
       I_S5D, I_GLUW, I_GLUB };

#ifdef CPU_EMU
__device__ __forceinline__ int opaque_tid() { return (int)threadIdx.x; }
#else
__device__ __forceinline__ int opaque_tid() { int t = (int)threadIdx.x; asm volatile("" : "+v"(t)); return t; }
#endif
#define LT (opaque_tid() & 255)
__device__ __forceinline__ float u2f(unsigned u) { return __builtin_bit_cast(float, u); }
__device__ __forceinline__ unsigned f2u(float f) { return __builtin_bit_cast(unsigned, f); }
__device__ __forceinline__ float bf2f(bf16 h) { return u2f((unsigned)h << 16); }
#ifdef CPU_EMU
__device__ __forceinline__ bf16 f2bf(float f) { unsigned u = f2u(f); u += 0x7fffu + ((u >> 16) & 1u); return (bf16)(u >> 16); }
__device__ __forceinline__ unsigned pack2(float lo, float hi) { return (unsigned)f2bf(lo) | ((unsigned)f2bf(hi) << 16); }
__device__ __forceinline__ float fexp(float x) { return expf(x); }
__device__ __forceinline__ float flog(float x) { return logf(x); }
__device__ __forceinline__ float frcp(float x) { return 1.0f / x; }
__device__ __forceinline__ float frsq(float x) { return 1.0f / sqrtf(x); }
#else
typedef __bf16 hwbf2 __attribute__((ext_vector_type(2)));
typedef float hwf2 __attribute__((ext_vector_type(2)));
__device__ __forceinline__ unsigned pack2(float lo, float hi) { hwf2 v = {lo, hi}; return __builtin_bit_cast(unsigned, __builtin_convertvector(v, hwbf2)); }
__device__ __forceinline__ bf16 f2bf(float f) { return (bf16)(pack2(f, 0.f) & 0xffffu); }
__device__ __forceinline__ float fexp(float x) { return __builtin_amdgcn_exp2f(x * 1.4426950408889634f); }
__device__ __forceinline__ float flog(float x) { return __builtin_amdgcn_logf(x) * 0.6931471805599453f; }
__device__ __forceinline__ float frcp(float x) { return __builtin_amdgcn_rcpf(x); }
__device__ __forceinline__ float frsq(float x) { return __builtin_amdgcn_rsqf(x); }
#endif
__device__ __forceinline__ float sigmoidf_(float x) { return frcp(1.0f + fexp(-x)); }
__device__ __forceinline__ float siluf_(float x) { return x * frcp(1.0f + fexp(-x)); }
__device__ __forceinline__ float logsigf_(float x) { return fminf(x, 0.f) - flog(1.0f + fexp(-fabsf(x))); }
__device__ __forceinline__ float softplusf_(float x) { return fmaxf(x, 0.f) + flog(1.0f + fexp(-fabsf(x))); }
__device__ __forceinline__ float ftanh(float x) { const float e = fexp(-2.0f * fabsf(x)); const float t = (1.0f - e) * frcp(1.0f + e); return x < 0.f ? -t : t; }
__device__ __forceinline__ float gelu_tanh(float x) { return 0.5f * x * (1.0f + ftanh(0.7978845608028654f * (x + 0.044715f * x * x * x))); }

typedef float f8v __attribute__((ext_vector_type(8)));
__device__ __forceinline__ f8v unpack8v(const uint4& u) {
    f8v f; f[0] = u2f(u.x << 16); f[1] = u2f(u.x & 0xffff0000u); f[2] = u2f(u.y << 16); f[3] = u2f(u.y & 0xffff0000u);
    f[4] = u2f(u.z << 16); f[5] = u2f(u.z & 0xffff0000u); f[6] = u2f(u.w << 16); f[7] = u2f(u.w & 0xffff0000u); return f;
}
__device__ __forceinline__ uint4 pack8v(const f8v& f) { return make_uint4(pack2(f[0], f[1]), pack2(f[2], f[3]), pack2(f[4], f[5]), pack2(f[6], f[7])); }
struct Seq { int start, len, cond, lat, b; };
__device__ __forceinline__ Seq get_seq(int s) {
    Seq q;
    if (s < NB_CTX) { q.start = s * L_CTX; q.len = L_CTX; q.cond = 0; q.lat = 0; q.b = s; }
    else { int b = s - NB_CTX; q.start = T_CTX + b * L_LAT; q.len = L_LAT; q.cond = 1 + b; q.lat = 1; q.b = b; }
    return q;
}
__device__ __forceinline__ int tok_cond(int t) { return t < T_CTX ? 0 : 1 + (t - T_CTX) / L_LAT; }
__device__ __forceinline__ void tok_nbr(int t, bool& hl, bool& hr) {
    if (t < T_CTX) { int pos = t % L_CTX; hl = pos != 0; hr = pos != L_CTX - 1; }
    else { int pos = (t - T_CTX) & 63; hl = pos != 0; hr = pos != 63; }
}

#ifndef PROBE_SEL
#define PROBE_SEL 0
#endif
#ifndef PROBE_BLK
#define PROBE_BLK 0
#endif
#ifndef PROBE_MUL
#define PROBE_MUL 4
#endif
#if PROBE_SEL && !defined(CPU_EMU)
extern __shared__ __attribute__((aligned(16))) unsigned char dsm_probe[];
#define PT_B(id) long long ptb_##id = 0; if (PROBE_SEL == (id)) ptb_##id = clock64()
#define PT_E4(id) do { if (PROBE_SEL == (id) && blockIdx.x == PROBE_BLK && threadIdx.x == 256) { volatile unsigned long long* a_ = (volatile unsigned long long*)(dsm_probe + 163840 - 8); *a_ = *a_ + (unsigned long long)(clock64() - ptb_##id); } } while (0)
#define PT_E(id) do { if (PROBE_SEL == (id) && blockIdx.x == PROBE_BLK && threadIdx.x == 0) { volatile unsigned long long* a_ = (volatile unsigned long long*)(dsm_probe + 163840 - 8); *a_ = *a_ + (unsigned long long)(clock64() - ptb_##id); } } while (0)
#else
#define PT_B(id) do {} while (0)
#define PT_E(id) do {} while (0)
#define PT_E4(id) do {} while (0)
#endif
constexpr int MOD_VB = DEPTH * 48;
__device__ __forceinline__ void ph_mod(const P& p, int bid, float* smem) {
    float (*sc)[1024] = (float(*)[1024])smem;
    float (*red)[64][NCOND] = (float(*)[64][NCOND])smem;
    const int wg_ = bid >> 1, xcd_ = wg_ & 7;
    const int layer = DEPTH == 4 ? (xcd_ & 3) : bid / 48, ct = DEPTH == 4 ? (xcd_ >> 2) * 24 + (wg_ >> 3) * 2 + (bid & 1) : bid % 48;
    __syncthreads();
    const int tid = LT, c4 = (tid & 15) * 4, kg = tid >> 4;
    PT_B(52);
    {
        float cv[NCOND * 4];
#pragma unroll
        for (int u = 0; u < NCOND * 4; ++u) { const int i = tid + u * 256, ci = i >> 10, k = i & 1023; cv[u] = ci == 0 ? p.in[I_CCTX][k] : p.in[I_C][(ci - 1) * 1024 + k]; }
#pragma unroll
        for (int u = 0; u < NCOND * 4; ++u) { const int i = tid + u * 256; sc[i >> 10][i & 1023] = siluf_(cv[u]); }
    }
    __syncthreads();
    PT_E(52); PT_B(53);
    f4v acc[NCOND];
#pragma unroll
    for (int ci = 0; ci < NCOND; ++ci) acc[ci] = (f4v){0.f, 0.f, 0.f, 0.f};
    const float* w = p.in[I_WMOD] + (size_t)layer * 1024 * 3072 + ct * 64 + c4;
    f4v wa[8], wb[8];
    const int rot = DEPTH == 4 ? (xcd_ * 2) & 15 : (bid * 5) & 15;
#define MOD_LOAD(W, K8) do { const int m0_ = (2 * (K8) + rot) & 15, m1_ = (2 * (K8) + 1 + rot) & 15; _Pragma("unroll") for (int j = 0; j < 8; ++j) W[j] = __builtin_nontemporal_load((const f4v*)(w + (size_t)(64 * (j < 4 ? m0_ : m1_) + 4 * kg + (j & 3)) * 3072)); } while (0)
#define MOD_FMA(W, K8) do { const int k0 = 64 * ((2 * (K8) + rot) & 15) + 4 * kg, k1 = 64 * ((2 * (K8) + 1 + rot) & 15) + 4 * kg; _Pragma("unroll") for (int ci = 0; ci < NCOND; ++ci) { \
        const f4v s0 = *(const f4v*)&sc[ci][k0], s1 = *(const f4v*)&sc[ci][k1]; \
        _Pragma("unroll") for (int j = 0; j < 4; ++j) { acc[ci] += s0[j] * W[j]; acc[ci] += s1[j] * W[4 + j]; } } } while (0)
    MOD_LOAD(wa, 0);
#pragma unroll
    for (int k8 = 0; k8 < 8; k8 += 2) {
        MOD_LOAD(wb, k8 + 1);
        MOD_FMA(wa, k8);
        if (k8 + 2 < 8) MOD_LOAD(wa, k8 + 2);
        MOD_FMA(wb, k8 + 1);
    }
#undef MOD_LOAD
#undef MOD_FMA
    __syncthreads();
    PT_E(53);
#pragma unroll
    for (int ci = 0; ci < NCOND; ++ci)
#pragma unroll
        for (int j = 0; j < 4; ++j) red[kg][c4 + j][ci] = acc[ci][j];
    __syncthreads();
    for (int o = tid; o < 64 * NCOND; o += 256) {
        const int c = o / NCOND, ci = o % NCOND;
        float sum = p.in[I_BMOD][layer * 3072 + ct * 64 + c];
#pragma unroll
        for (int g = 0; g < 16; ++g) sum += red[g][c][ci];
        ((float*)(p.ws + WS_MOD))[(size_t)(layer * NCOND + ci) * 3072 + ct * 64 + c] = sum;
    }
}

struct WtJob { const float* src; bf16* dst; int K, N, Npad; };
__device__ __forceinline__ WtJob wt_job(const P& p, int j) {
    WtJob q;
    if (j < N_EVEN) { q.src = p.in[I_WINE] + (size_t)j * D * EW; q.dst = (bf16*)(p.ws + WS_WTE) + (size_t)j * EWP * D; q.K = D; q.N = EW; q.Npad = EWP; return q; }
    j -= N_EVEN;
    if (j < N_ODD) { q.src = p.in[I_WINO] + (size_t)j * D * OW; q.dst = (bf16*)(p.ws + WS_WTO) + (size_t)j * OWP * D; q.K = D; q.N = OW; q.Npad = OWP; return q; }
    j -= N_ODD;
    if (j < DEPTH) { int i = j >> 1; q.src = (j & 1) ? p.in[I_WOUTO] + (size_t)i * D * D : p.in[I_WOUTE] + (size_t)i * D * D; q.dst = (bf16*)(p.ws + WS_WTOUT) + (size_t)j * D * D; q.K = D; q.N = D; q.Npad = D; return q; }
    j -= DEPTH;
    q.src = p.in[I_GLUW] + (size_t)j * 512 * 512; q.dst = (bf16*)(p.ws + WS_WTGLU) + (size_t)j * 512 * 512; q.K = 512; q.N = 512; q.Npad = 512; return q;
}
constexpr int WT_NJOBS = N_EVEN + N_ODD + DEPTH + N_ODD;
constexpr int WT_NT = 4;
__host__ __device__ constexpr int wt_stage_job(int l, int k) { return k == 0 ? ((l & 1) ? N_EVEN + (l >> 1) : (l >> 1)) : k == 1 ? N_EVEN + N_ODD + l : N_EVEN + N_ODD + DEPTH + (l >> 1); }
__host__ __device__ constexpr int wt_stage_njobs(int l) { return (l & 1) ? 3 : 2; }
__host__ __device__ constexpr int wt_stage_tiles(int l) { return ((l & 1) ? (OWP / 64) * 16 + 64 : (EWP / 64) * 16) + 256; }
static_assert(wt_stage_tiles(0) % (2 * WT_NT) == 0 && wt_stage_tiles(1) % (2 * WT_NT) == 0, "stage tile counts must give an even number of virtual blocks");
__device__ __forceinline__ void ph_wt(const P& p, int stage, int bid, float* smem) {
    float (*tile)[65] = (float(*)[65])smem;
    float4 v[WT_NT][4];
    bf16* dsts[WT_NT];
    const int kk = LT >> 4, n4 = (LT & 15) * 4;
    const int nn = LT >> 2, k16 = (LT & 3) * 16;
#pragma unroll
    for (int u = 0; u < WT_NT; ++u) {
        int b = bid * WT_NT + u, j = 0;
        WtJob q;
        for (;; ++j) { q = wt_job(p, wt_stage_job(stage, j)); int nt = (q.Npad / 64) * (q.K / 64); if (b < nt) break; b -= nt; }
        const int nk = q.K / 64, n0 = (b / nk) * 64, k0 = (b % nk) * 64, n = n0 + n4;
#pragma unroll
        for (int i = 0; i < 4; ++i) {
            v[u][i] = make_float4(0.f, 0.f, 0.f, 0.f);
            if (n < q.N) { const f4v t_ = __builtin_nontemporal_load((const f4v*)(q.src + (size_t)(k0 + kk + 16 * i) * q.N + n)); v[u][i] = make_float4(t_[0], t_[1], t_[2], t_[3]); }
        }
        dsts[u] = q.dst + (size_t)(n0 + nn) * q.K + k0 + k16;
    }
#pragma unroll
    for (int u = 0; u < WT_NT; ++u) {
        __syncthreads();
#pragma unroll
        for (int i = 0; i < 4; ++i) { float* tr = &tile[kk + 16 * i][n4]; tr[0] = v[u][i].x; tr[1] = v[u][i].y; tr[2] = v[u][i].z; tr[3] = v[u][i].w; }
        __syncthreads();
        f8v a, c;
#pragma unroll
        for (int j = 0; j < 8; ++j) { a[j] = tile[k16 + j][nn]; c[j] = tile[k16 + 8 + j][nn]; }
        *(uint4*)dsts[u] = pack8v(a); *(uint4*)(dsts[u] + 8) = pack8v(c);
    }
}

constexpr int NTW = 3;
__device__ __forceinline__ float wave_sum(float v) {
#pragma unroll
    for (int m = 1; m < 64; m <<= 1) v += __shfl_xor(v, m);
    return v;
}
__device__ __forceinline__ void hmod_row(const float* xv  , int lane, const float* gpre, const float* mod, bf16* dst) {
    float ss = 0.f;
#pragma unroll
    for (int i = 0; i < 16; ++i) ss += xv[i] * xv[i];
    ss = wave_sum(ss);
    const float r = frsq(ss * (1.0f / 1024.f) + EPS);
#pragma unroll
    for (int i = 0; i < 4; ++i) {
        int idx = i * 256 + lane * 4;
        const float4 g = *(const float4*)(gpre + idx), sc = *(const float4*)(mod + 1024 + idx), sh = *(const float4*)(mod + idx);
        *(uint2*)(dst + idx) = make_uint2(pack2(xv[i * 4] * r * g.x * (1.0f + sc.x) + sh.x, xv[i * 4 + 1] * r * g.y * (1.0f + sc.y) + sh.y),
                                          pack2(xv[i * 4 + 2] * r * g.z * (1.0f + sc.z) + sh.z, xv[i * 4 + 3] * r * g.w * (1.0f + sc.w) + sh.w));
    }
}
__device__ __forceinline__ void ph_hmod0(const P& p, int bid) {
    const int lane = LT & 63, tb = bid * (4 * NTW) + (LT >> 6) * NTW;
    if (tb >= T) return;
    float xv[NTW][16];
#pragma unroll
    for (int u = 0; u < NTW; ++u) {
        const int t = (tb + u < T) ? tb + u : T - 1;
        const float* xr = t < T_CTX ? p.in[I_XP] + (size_t)t * D : p.in[I_XS] + (size_t)(t - T_CTX) * D;
#pragma unroll
        for (int i = 0; i < 4; ++i) { const f4v v = __builtin_nontemporal_load((const f4v*)(xr + i * 256 + lane * 4)); xv[u][i * 4] = v[0]; xv[u][i * 4 + 1] = v[1]; xv[u][i * 4 + 2] = v[2]; xv[u][i * 4 + 3] = v[3]; }
    }
#pragma unroll
    for (int u = 0; u < NTW; ++u) {
        const int t = tb + u; if (t >= T) break;
        const float* mod = (const float*)(p.ws + WS_MOD) + (size_t)(0 * NCOND + tok_cond(t)) * 3072;
        hmod_row(xv[u], lane, p.in[I_GPRE], mod, (bf16*)(p.ws + WS_HM) + (size_t)t * D);
    }
}
__device__ __forceinline__ void ph_post(const P& p, int bid, int layer) {
    const int lane = LT & 63, tb = bid * (4 * NTW) + (LT >> 6) * NTW;
    if (tb >= T) return;
    const float* gpost = p.in[I_GPOST] + layer * D;
    float xv[NTW][16], mv[NTW][16];
#pragma unroll
    for (int u = 0; u < NTW; ++u) {
        const int t = (tb + u < T) ? tb + u : T - 1;
        const bf16* mr = (const bf16*)(p.ws + WS_PROJ) + (size_t)t * D;
        if (layer == 0) {
            const float* xr = t < T_CTX ? p.in[I_XP] + (size_t)t * D : p.in[I_XS] + (size_t)(t - T_CTX) * D;
#pragma unroll
            for (int i = 0; i < 4; ++i) { const f4v v = __builtin_nontemporal_load((const f4v*)(xr + i * 256 + lane * 4)); xv[u][i * 4] = v[0]; xv[u][i * 4 + 1] = v[1]; xv[u][i * 4 + 2] = v[2]; xv[u][i * 4 + 3] = v[3]; }
        } else {
            const bf16* xb = (const bf16*)(p.out + OUT_X + (size_t)t * D + 512);
#pragma unroll
            for (int i = 0; i < 4; ++i) { const unsigned long long w_ = __builtin_nontemporal_load((const unsigned long long*)(xb + i * 256 + lane * 4)); const uint2 w = make_uint2((unsigned)w_, (unsigned)(w_ >> 32)); xv[u][i * 4] = u2f(w.x << 16); xv[u][i * 4 + 1] = u2f(w.x & 0xffff0000u); xv[u][i * 4 + 2] = u2f(w.y << 16); xv[u][i * 4 + 3] = u2f(w.y & 0xffff0000u); }
        }
#pragma unroll
        for (int i = 0; i < 4; ++i) { const unsigned long long w_ = __builtin_nontemporal_load((const unsigned long long*)(mr + i * 256 + lane * 4)); const uint2 w = make_uint2((unsigned)w_, (unsigned)(w_ >> 32)); mv[u][i * 4] = u2f(w.x << 16); mv[u][i * 4 + 1] = u2f(w.x & 0xffff0000u); mv[u][i * 4 + 2] = u2f(w.y << 16); mv[u][i * 4 + 3] = u2f(w.y & 0xffff0000u); }
    }
#pragma unroll
    for (int u = 0; u < NTW; ++u) {
        const int t = tb + u; if (t >= T) break;
        const float* mod = (const float*)(p.ws + WS_MOD) + (size_t)(layer * NCOND + tok_cond(t)) * 3072;
        float* xo = p.out + OUT_X + (size_t)t * D;
        bf16* xb = (bf16*)(xo + 512);
        float ss = 0.f;
#pragma unroll
        for (int i = 0; i < 16; ++i) ss += mv[u][i] * mv[u][i];
        ss = wave_sum(ss);
        const float r = frsq(ss * (1.0f / 1024.f) + EPS);
#pragma unroll
        for (int i = 0; i < 4; ++i) {
            const int idx = i * 256 + lane * 4;
            const float4 gt = *(const float4*)(mod + 2048 + idx), gp = *(const float4*)(gpost + idx);
            xv[u][i * 4] += gt.x * (mv[u][i * 4] * r * gp.x); xv[u][i * 4 + 1] += gt.y * (mv[u][i * 4 + 1] * r * gp.y);
            xv[u][i * 4 + 2] += gt.z * (mv[u][i * 4 + 2] * r * gp.z); xv[u][i * 4 + 3] += gt.w * (mv[u][i * 4 + 3] * r * gp.w);
        }
        if (layer + 1 < DEPTH) {
#pragma unroll
            for (int i = 0; i < 4; ++i) *(uint2*)(xb + i * 256 + lane * 4) = make_uint2(pack2(xv[u][i * 4], xv[u][i * 4 + 1]), pack2(xv[u][i * 4 + 2], xv[u][i * 4 + 3]));
            const float* mod2 = (const float*)(p.ws + WS_MOD) + (size_t)((layer + 1) * NCOND + tok_cond(t)) * 3072;
            hmod_row(xv[u], lane, p.in[I_GPRE] + (layer + 1) * D, mod2, (bf16*)(p.ws + WS_HM) + (size_t)t * D);
        } else {
#pragma unroll
            for (int i = 0; i < 4; ++i) { const f4v o_ = {xv[u][i * 4], xv[u][i * 4 + 1], xv[u][i * 4 + 2], xv[u][i * 4 + 3]}; __builtin_nontemporal_store(o_, (f4v*)(xo + i * 256 + lane * 4)); }
        }
    }
}

#ifdef CPU_EMU
#define LDS_AS
#define GLDS16(gptr, lptr) memcpy((char*)(lptr) + (threadIdx.x & 63) * 16, (const void*)(gptr), 16)
#define PG_WAIT_V(n)
#define PG_WAIT_L(n)
#define PG_BAR __syncthreads()
#define PG_SCHED
#define PG_PRIO(x)
#define RFL(x) (x)
__device__ __forceinline__ unsigned cvt_pk_bf16(float lo, float hi) { return (unsigned)f2bf(lo) | ((unsigned)f2bf(hi) << 16); }
#else
#define LDS_AS __attribute__((address_space(3)))
#define GLDS16(gptr, lptr) __builtin_amdgcn_global_load_lds((const unsigned*)(gptr), (LDS_AS unsigned*)(lptr), 16, 0, 0)
#define PG_WAIT_V(n) asm volatile("s_waitcnt vmcnt(" #n ")" ::: "memory")
#define PG_WAIT_L(n) asm volatile("s_waitcnt lgkmcnt(" #n ")" ::: "memory")
#define PG_BAR __builtin_amdgcn_s_barrier()
#define PG_SCHED __builtin_amdgcn_sched_barrier(0)
#define PG_PRIO(x) __builtin_amdgcn_s_setprio(x)
#define RFL(x) __builtin_amdgcn_readfirstlane(x)
__device__ __forceinline__ unsigned cvt_pk_bf16(float lo, float hi) { return pack2(lo, hi); }
#endif
namespace pg8 {
constexpr int BM = 256, BK = 64, HALF = 128, HTB = HALF * BK * 2, STAGE_BYTES = 8 * HTB, NXCD = 8, WGM = 8;
__host__ __device__ __forceinline__ int lds_byte(int r, int c) { const int st = (r >> 4) * 2 + (c >> 5), rr = r & 15, cc = c & 31, ob = rr * 64 + cc * 2; return st * 1024 + (ob ^ (((ob >> 9) & 1) << 5)); }
__host__ __device__ __forceinline__ void stage_rc(int b, int& R, int& C) { const int st = b / 1024, sb = b % 1024, swz = sb ^ (((sb >> 9) & 1) << 5); R = (st >> 1) * 16 + swz / 64; C = (st & 1) * 32 + (swz % 64) / 2; }
__host__ __device__ __forceinline__ int perm32(int rho) { const int n = rho >> 4, i = rho & 15; return 8 * (i >> 2) + 4 * n + (i & 3); }
struct Unit { int pm, pn; };
struct Gemm { const bf16* A; const bf16* Bt; int M, N, K, lda; };
struct StaticOrder {
    int nM, nN, nwg, G, c;
    __host__ __device__ void init(int M, int N, int G_, int c_) { nM = M / BM; nN = N / BM; nwg = nM * nN; G = G_; c = c_; }
    __host__ __device__ bool next(int i, Unit& u) const {
        const long L = (long)i * G + c; if (L >= nwg) return false;
        int wgid = (int)L; { const int q = nwg / NXCD, r = nwg % NXCD, xcd = wgid % NXCD, off = wgid / NXCD; wgid = (xcd < r ? xcd * (q + 1) : r * (q + 1) + (xcd - r) * q) + off; }
        const int nig = WGM * nN, gid = wgid / nig, fm = gid * WGM, gsz = (nM - fm) < WGM ? (nM - fm) : WGM;
        u.pm = fm + ((wgid % nig) % gsz); u.pn = (wgid % nig) / gsz; return true;
    }
};
struct EpiF32 {
    static constexpr bool PERM = false;
    float* C; int ldc;
    __device__ __forceinline__ void operator()(const f4v (&acc)[2][2][4][2], const Unit& u, int wr, int wc, int fr, int fq) const {
        const int row0 = u.pm * BM + wr * 64 + fr, col0 = u.pn * BM + wc * 32 + 4 * fq;
#pragma unroll
        for (int ai = 0; ai < 2; ++ai)
#pragma unroll
            for (int m = 0; m < 4; ++m) { float* rowp = C + (size_t)(row0 + ai * HALF + m * 16) * ldc + col0;
#pragma unroll
                for (int bj = 0; bj < 2; ++bj)
#pragma unroll
                    for (int n = 0; n < 2; ++n) *(f4v*)(rowp + bj * HALF + n * 16) = acc[ai][bj][m][n]; }
    }
};
struct EpiBf16 {
    static constexpr bool PERM = true;
    bf16* O; int ldc; int N;
    __device__ __forceinline__ void operator()(const f4v (&acc)[2][2][4][2], const Unit& u, int wr, int wc, int fr, int fq) const {
        const int row0 = u.pm * BM + wr * 64 + fr, col0 = u.pn * BM + wc * 32 + 8 * fq;
#pragma unroll
        for (int ai = 0; ai < 2; ++ai)
#pragma unroll
            for (int m = 0; m < 4; ++m) { bf16* rowp = O + (size_t)(row0 + ai * HALF + m * 16) * ldc + col0;
#pragma unroll
                for (int bj = 0; bj < 2; ++bj) { const f4v v0 = acc[ai][bj][m][0], v1 = acc[ai][bj][m][1];
                    if (col0 + bj * HALF < N) *(uint4*)(rowp + bj * HALF) = make_uint4(cvt_pk_bf16(v0[0], v0[1]), cvt_pk_bf16(v0[2], v0[3]), cvt_pk_bf16(v1[0], v1[1]), cvt_pk_bf16(v1[2], v1[3])); } }
    }
};
struct EpiGlu {
    static constexpr bool PERM = true;
    bf16* O; const bf16* YS; const bf16* ZD; const float* GB;
    __device__ __forceinline__ void operator()(const f4v (&acc)[2][2][4][2], const Unit& u, int wr, int wc, int fr, int fq) const {
        const int row0 = u.pm * BM + wr * 64 + fr, col0 = u.pn * BM + wc * 32 + 8 * fq;
        f8v gb[2];
#pragma unroll
        for (int bj = 0; bj < 2; ++bj) gb[bj] = *(const f8v*)(GB + col0 + bj * HALF);
#pragma unroll
        for (int am = 0; am < 4; ++am) {
            const int ai = am >> 1, m0 = (am & 1) * 2;
            uint4 ysr[2][2], zdr[2][2];
#pragma unroll
            for (int mm = 0; mm < 2; ++mm)
#pragma unroll
                for (int bj = 0; bj < 2; ++bj) { const size_t row = (size_t)(row0 + ai * HALF + (m0 + mm) * 16); const int col = col0 + bj * HALF;
                    ysr[mm][bj] = *(const uint4*)(YS + row * 512 + col); zdr[mm][bj] = *(const uint4*)(ZD + row * OW + col); }
#pragma unroll
            for (int mm = 0; mm < 2; ++mm)
#pragma unroll
                for (int bj = 0; bj < 2; ++bj) { const size_t row = (size_t)(row0 + ai * HALF + (m0 + mm) * 16); const int col = col0 + bj * HALF;
                    const f8v ys = unpack8v(ysr[mm][bj]), zd = unpack8v(zdr[mm][bj]);
                    f8v o;
#pragma unroll
                    for (int j = 0; j < 8; ++j) { const float g = (j < 4 ? acc[ai][bj][m0 + mm][0][j] : acc[ai][bj][m0 + mm][1][j - 4]) + gb[bj][j]; o[j] = ys[j] * sigmoidf_(g) * siluf_(zd[j]); }
                    *(uint4*)(O + row * D + col) = pack8v(o); }
        }
    }
};
template <class Epi>
__device__ __forceinline__ void gemm_phase(LDS_AS unsigned char* lds, const Gemm g, const StaticOrder& S, const Epi& E) {
    const int tid = opaque_tid(), wid = RFL(tid >> 6), lane = tid & 63, wr = wid >> 2, wc = wid & 3, fr = lane & 15, fq = lane >> 4;
    const int K = g.K, nt = K / BK;
    unsigned voffA[2], voffB[2];
#pragma unroll
    for (int i = 0; i < 2; ++i) { int R, C; stage_rc(tid * 16 + i * 8192, R, C); const int Rb = Epi::PERM ? ((R & ~31) + perm32(R & 31)) : R;
        voffA[i] = (unsigned)(R * g.lda + C) * 2u; voffB[i] = (unsigned)(Rb * K + C) * 2u; }
    const size_t kstep = (size_t)(BK * 2);
    const size_t hstepA = (size_t)HALF * g.lda * 2, hstepB = (size_t)HALF * K * 2;
    const size_t tstepA = 2 * hstepA, tstepB = 2 * hstepB;
    const unsigned ldsw = (unsigned)wid * 1024u;
    const int aoff = lds_byte(wr * 64 + fr, fq * 8), boff = lds_byte(wc * 32 + fr, fq * 8);
#define PG8_SA(b, h) (((b) * 2 + (h)) * HTB)
#define PG8_SB(b, h) ((4 + (b) * 2 + (h)) * HTB)
#define PG8_STAGE(bufoff, gbase, voff) do { _Pragma("unroll") for (int _i = 0; _i < 2; ++_i) GLDS16((const char*)(gbase) + (voff)[_i], lds + (bufoff) + ldsw + _i * 8192); } while (0)
#define PG8_LDA(dst, b, h) do { _Pragma("unroll") for (int m = 0; m < 4; ++m) _Pragma("unroll") for (int k = 0; k < 2; ++k) dst[m][k] = *(const LDS_AS s8v*)(lds + PG8_SA(b, h) + aoff + m * 2048 + k * 1024); } while (0)
#define PG8_LDB(dst, b, h) do { _Pragma("unroll") for (int n = 0; n < 2; ++n) _Pragma("unroll") for (int k = 0; k < 2; ++k) dst[n][k] = *(const LDS_AS s8v*)(lds + PG8_SB(b, h) + boff + n * 2048 + k * 1024); } while (0)
#define PG8_MMA(ai, bj, At, Bt) do { PG_PRIO(1); _Pragma("unroll") for (int m = 0; m < 4; ++m) _Pragma("unroll") for (int n = 0; n < 2; ++n) _Pragma("unroll") for (int k = 0; k < 2; ++k) \
        acc[ai][bj][m][n] = __builtin_amdgcn_mfma_f32_16x16x32_bf16(Bt[n][k], At[m][k], acc[ai][bj][m][n], 0, 0, 0); PG_PRIO(0); } while (0)
    Unit cur, nxt; int ui = 0;
    if (!S.next(0, cur)) return;
    f4v acc[2][2][4][2];
#pragma unroll
    for (int a = 0; a < 2; ++a)
#pragma unroll
        for (int b = 0; b < 2; ++b)
#pragma unroll
            for (int m = 0; m < 4; ++m)
#pragma unroll
                for (int n = 0; n < 2; ++n) acc[a][b][m][n] = (f4v){0.f, 0.f, 0.f, 0.f};
    s8v At[4][2], B0[2][2], B1[2][2];
    const char* cA = (const char*)g.A + (size_t)cur.pm * tstepA; const char* cB = (const char*)g.Bt + (size_t)cur.pn * tstepB;
    PG8_STAGE(PG8_SB(0, 0), cB, voffB); PG8_STAGE(PG8_SA(0, 0), cA, voffA); PG8_STAGE(PG8_SB(0, 1), cB + hstepB, voffB); PG8_STAGE(PG8_SA(0, 1), cA + hstepA, voffA);
    if (wr == 1) PG_BAR;
    PG_WAIT_V(4); PG_BAR;
    PG8_STAGE(PG8_SB(1, 0), cB + kstep, voffB); PG8_STAGE(PG8_SA(1, 0), cA + kstep, voffA); PG8_STAGE(PG8_SB(1, 1), cB + hstepB + kstep, voffB);
    PG_WAIT_V(6); PG_BAR;
    for (;;) {
        const bool has_next = S.next(ui + 1, nxt);
        const char* nA = has_next ? (const char*)g.A + (size_t)nxt.pm * tstepA : cA; const char* nB = has_next ? (const char*)g.Bt + (size_t)nxt.pn * tstepB : cB;
        for (int t = 0; t < nt; t += 2) {
            const bool last = (t == nt - 2);
            const char* a1 = cA + (size_t)(t + 1) * kstep;
            const char* a2 = last ? nA : cA + (size_t)(t + 2) * kstep; const char* b2 = last ? nB : cB + (size_t)(t + 2) * kstep;
            const char* a3 = a2 + kstep; const char* b3 = b2 + kstep;
            PG8_LDB(B0, 0, 0); PG_SCHED; PG8_LDA(At, 0, 0); PG8_STAGE(PG8_SA(1, 1), a1 + hstepA, voffA);
            PG_WAIT_L(8); PG_BAR; PG_WAIT_L(0); PG8_MMA(0, 0, At, B0); PG_BAR; PG_SCHED;
            PG8_LDB(B1, 0, 1); PG8_STAGE(PG8_SB(0, 0), b2, voffB);
            PG_BAR; PG_WAIT_L(0); PG8_MMA(0, 1, At, B1); PG_BAR;
            PG8_LDA(At, 0, 1); PG8_STAGE(PG8_SA(0, 0), a2, voffA);
            PG_BAR; PG_WAIT_L(0); PG8_MMA(1, 0, At, B0); PG_BAR; PG_SCHED;
            PG8_STAGE(PG8_SB(0, 1), b2 + hstepB, voffB);
            PG_WAIT_V(6); PG_BAR; PG8_MMA(1, 1, At, B1); PG_BAR;
            PG8_LDB(B0, 1, 0); PG_SCHED; PG8_LDA(At, 1, 0); PG8_STAGE(PG8_SA(0, 1), a2 + hstepA, voffA);
            PG_WAIT_L(8); PG_BAR; PG_WAIT_L(0); PG8_MMA(0, 0, At, B0); PG_BAR; PG_SCHED;
            PG8_LDB(B1, 1, 1); PG8_STAGE(PG8_SB(1, 0), b3, voffB);
            PG_BAR; PG_WAIT_L(0); PG8_MMA(0, 1, At, B1); PG_BAR;
            PG8_LDA(At, 1, 1); PG8_STAGE(PG8_SA(1, 0), a3, voffA);
            PG_BAR; PG_WAIT_L(0); PG8_MMA(1, 0, At, B0); PG_BAR; PG_SCHED;
            PG8_STAGE(PG8_SB(1, 1), b3 + hstepB, voffB);
            PG_WAIT_V(6); PG_BAR; PG8_MMA(1, 1, At, B1); PG_BAR;
        }
        E(acc, cur, wr, wc, fr, fq);
        if (!has_next) break;
#pragma unroll
        for (int a = 0; a < 2; ++a)
#pragma unroll
            for (int b = 0; b < 2; ++b)
#pragma unroll
                for (int m = 0; m < 4; ++m)
#pragma unroll
                    for (int n = 0; n < 2; ++n) acc[a][b][m][n] = (f4v){0.f, 0.f, 0.f, 0.f};
        cur = nxt; cA = nA; cB = nB; ++ui;
    }
    PG_WAIT_V(0);
    if (wr == 0) PG_BAR;
    PG_BAR;
}
}

#ifdef CPU_EMU
#define WAVE_SYNC() emu::wsync()
#define LBAR() __syncthreads()
#else
#define WAVE_SYNC() __builtin_amdgcn_wave_barrier()
#define LBAR() do { asm volatile("s_waitcnt lgkmcnt(0)" ::: "memory"); __builtin_amdgcn_s_barrier(); asm volatile("" ::: "memory"); } while (0)
#endif
__device__ __forceinline__ void unpack8(const uint4& u, float* f) {
    f[0] = u2f(u.x << 16); f[1] = u2f(u.x & 0xffff0000u); f[2] = u2f(u.y << 16); f[3] = u2f(u.y & 0xffff0000u);
    f[4] = u2f(u.z << 16); f[5] = u2f(u.z & 0xffff0000u); f[6] = u2f(u.w << 16); f[7] = u2f(u.w & 0xffff0000u);
}
__device__ __forceinline__ uint4 pack8(const float* f) { return make_uint4(pack2(f[0], f[1]), pack2(f[2], f[3]), pack2(f[4], f[5]), pack2(f[6], f[7])); }
__device__ __forceinline__ f4v unpack4(const uint2& u) { f4v f; f[0] = u2f(u.x << 16); f[1] = u2f(u.x & 0xffff0000u); f[2] = u2f(u.y << 16); f[3] = u2f(u.y & 0xffff0000u); return f; }
__device__ __forceinline__ uint2 pack4(const f4v& f) { return make_uint2(pack2(f[0], f[1]), pack2(f[2], f[3])); }
__device__ __forceinline__ f4v mfma16(const s8v& a, const s8v& b, const f4v& c) { return __builtin_amdgcn_mfma_f32_16x16x32_bf16(a, b, c, 0, 0, 0); }

__device__ __forceinline__ float red8(float x) {
#ifdef CPU_EMU
    x += __shfl_xor(x, 1); x += __shfl_xor(x, 2); x += __shfl_xor(x, 4);
#else
    x += __builtin_bit_cast(float, __builtin_amdgcn_mov_dpp(__builtin_bit_cast(int, x), 0xB1, 0xF, 0xF, true));
    x += __builtin_bit_cast(float, __builtin_amdgcn_mov_dpp(__builtin_bit_cast(int, x), 0x4E, 0xF, 0xF, true));
    x += __builtin_bit_cast(float, __builtin_amdgcn_mov_dpp(__builtin_bit_cast(int, x), 0x141, 0xF, 0xF, true));
#endif
    return x;
}
__device__ __forceinline__ float red16(float x) {
    x = red8(x);
#ifdef CPU_EMU
    x += __shfl_xor(x, 8);
#else
    x += __builtin_bit_cast(float, __builtin_amdgcn_mov_dpp(__builtin_bit_cast(int, x), 0x140, 0xF, 0xF, true));
#endif
    return x;
}
typedef unsigned long long u64t;
__device__ __forceinline__ const bf16* tr_lane_ptr(const bf16* X, int ld, int row0, int col0, int lane) {
    const int fr = lane & 15, fq = lane >> 4;
    return X + (size_t)(row0 + 8 * fq + (fr >> 2)) * ld + col0 + 4 * (fr & 3);
}
template <int OFF> __device__ __forceinline__ u64t tr_rd(const bf16* lp) {
#ifdef CPU_EMU
    const int tid_ = threadIdx.x, w_ = tid_ >> 6, l_ = tid_ & 63, g_ = l_ >> 4, i_ = l_ & 15;
    const bf16* a0 = (const bf16*)((const char*)lp + OFF);
    memcpy(&emu::xbuf[w_][l_][0], &a0, sizeof(a0));
    emu::wsync();
    unsigned short e[4];
    for (int q = 0; q < 4; ++q) { const bf16* p0; memcpy(&p0, &emu::xbuf[w_][16 * g_ + 4 * q + (i_ >> 2)][0], sizeof(p0)); e[q] = p0[i_ & 3]; }
    emu::wsync();
    u64t r; memcpy(&r, e, 8); return r;
#else
    u64t x; const unsigned o = (unsigned)(size_t)lp;
    asm volatile("ds_read_b64_tr_b16 %0, %1 offset:%2" : "=v"(x) : "v"(o), "n"(OFF) : "memory");
    return x;
#endif
}
#ifdef CPU_EMU
#define TR_WAIT8(a, b, c, d, e, f, g, h) do {} while (0)
#define TR_WAIT6(a, b, c, d, e, f) do {} while (0)
#define TR_WAIT2(a, b) do {} while (0)
#define TR_WAIT4(a, b, c, d) do {} while (0)
#else
#define TR_WAIT8(a, b, c, d, e, f, g, h) asm volatile("s_waitcnt lgkmcnt(0)" : "+v"(a), "+v"(b), "+v"(c), "+v"(d), "+v"(e), "+v"(f), "+v"(g), "+v"(h) :: "memory")
#define TR_WAIT6(a, b, c, d, e, f) asm volatile("s_waitcnt lgkmcnt(0)" : "+v"(a), "+v"(b), "+v"(c), "+v"(d), "+v"(e), "+v"(f) :: "memory")
#define TR_WAIT2(a, b) asm volatile("s_waitcnt lgkmcnt(0)" : "+v"(a), "+v"(b) :: "memory")
#define TR_WAIT4(a, b, c, d) asm volatile("s_waitcnt lgkmcnt(0)" : "+v"(a), "+v"(b), "+v"(c), "+v"(d) :: "memory")
#endif
__device__ __forceinline__ s8v tr_pair(u64t lo, u64t hi) { typedef u64t u64x2 __attribute__((ext_vector_type(2))); u64x2 v = {lo, hi}; return __builtin_bit_cast(s8v, v); }
__device__ __forceinline__ s8v tr_frag(const bf16* X, int ld, int row0, int col0, int lane) {
    const int fr = lane & 15, fq = lane >> 4;
    const bf16* a0 = X + (size_t)(row0 + 8 * fq + (fr >> 2)) * ld + col0 + 4 * (fr & 3);
    const bf16* a1 = a0 + 4 * ld;
#ifdef CPU_EMU
    const int tid_ = threadIdx.x, w_ = tid_ >> 6, l_ = tid_ & 63, g_ = l_ >> 4, i_ = l_ & 15;
    memcpy(&emu::xbuf[w_][l_][0], &a0, sizeof(a0)); memcpy(&emu::xbuf[w_][l_][4], &a1, sizeof(a1));
    emu::wsync();
    s8v out;
    for (int q = 0; q < 4; ++q) {
        const bf16 *p0, *p1;
        memcpy(&p0, &emu::xbuf[w_][16 * g_ + 4 * q + (i_ >> 2)][0], sizeof(p0)); memcpy(&p1, &emu::xbuf[w_][16 * g_ + 4 * q + (i_ >> 2)][4], sizeof(p1));
        out[q] = (short)p0[i_ & 3]; out[4 + q] = (short)p1[i_ & 3];
    }
    emu::wsync();
    return out;
#else
    unsigned long long lo, hi;
    const unsigned o0 = (unsigned)(size_t)a0, o1 = (unsigned)(size_t)a1;
    asm volatile("ds_read_b64_tr_b16 %0, %2\n\tds_read_b64_tr_b16 %1, %3\n\ts_waitcnt lgkmcnt(0)" : "=&v"(lo), "=&v"(hi) : "v"(o0), "v"(o1) : "memory");
    typedef unsigned long long u64x2 __attribute__((ext_vector_type(2)));
    u64x2 v = {lo, hi};
    return __builtin_bit_cast(s8v, v);
#endif
}
constexpr int TI_LD = 68, TI_TLD = 20;
__device__ __forceinline__ void ti_mm16(float* dst, int ldd, const float* L, int ldl, const float* R, int ldr, float sgn, const float* add, int lda, int lane) {
    const int r = lane >> 2, c4 = (lane & 3) * 4;
    f4v acc = (f4v){0.f, 0.f, 0.f, 0.f};
#pragma unroll
    for (int k = 0; k < 16; ++k) { const float l = L[r * ldl + k]; const f4v rv = *(const f4v*)(R + k * ldr + c4); acc += l * rv; }
    acc *= sgn;
    if (add) acc += *(const f4v*)(add + r * lda + c4);
    *(f4v*)(dst + r * ldd + c4) = acc;
}
__device__ __forceinline__ float red4(float x) {
#ifdef CPU_EMU
    x += __shfl_xor(x, 1); x += __shfl_xor(x, 2);
#else
    x += __builtin_bit_cast(float, __builtin_amdgcn_mov_dpp(__builtin_bit_cast(int, x), 0xB1, 0xF, 0xF, true));
    x += __builtin_bit_cast(float, __builtin_amdgcn_mov_dpp(__builtin_bit_cast(int, x), 0x4E, 0xF, 0xF, true));
#endif
    return x;
}
__device__ __forceinline__ void tri_inv64(const float* A, float* X, float* TMP, int wl, int lane, bool active) {
    wl = RFL(wl);
#define TI_A(a, b) (A + (16 * (a)) * TI_LD + 16 * (b))
#define TI_X(a, b) (X + (16 * (a)) * TI_LD + 16 * (b))
#define TI_T(n) (TMP + (n) * 16 * TI_TLD)
    if (active) {
        const int c = lane >> 2, js = lane & 3;
        float xr[4] = {0.f, 0.f, 0.f, 0.f};
        const float* Ab = TI_A(wl, wl);
#pragma unroll
        for (int i = 0; i < 16; ++i) {
            float part = 0.f;
#pragma unroll
            for (int m = 0; m <= (i - 1) / 4 && i > 0; ++m) { const int j = 4 * m + js; const float av = Ab[i * TI_LD + j]; part += (j < i ? av : 0.f) * xr[m]; }
            const float tot = red4(part);
            const float xi = (i == c ? 1.f : 0.f) - tot;
            xr[i >> 2] = ((i & 3) == js) ? xi : xr[i >> 2];
        }
        float* Xb = TI_X(wl, wl);
#pragma unroll
        for (int m = 0; m < 4; ++m) Xb[(4 * m + js) * TI_LD + c] = xr[m];
        for (int b = wl + 1; b < 4; ++b) { float* Z = TI_X(wl, b); const int r = lane >> 2, c4 = (lane & 3) * 4; *(f4v*)(Z + r * TI_LD + c4) = (f4v){0.f, 0.f, 0.f, 0.f}; }
    }
    LBAR();
    if (active && wl < 3) {
        const int col = lane & 15, g4 = (lane >> 4) * 4;
        const f4v zero = (f4v){0.f, 0.f, 0.f, 0.f};
#define TI_MMA(Lp, Bv, ACC) do { const f4v a_ = *(const f4v*)((Lp) + col * TI_LD + g4); _Pragma("unroll") for (int ks_ = 0; ks_ < 4; ++ks_) ACC = __builtin_amdgcn_mfma_f32_16x16x4f32(a_[ks_], (Bv)[ks_], ACC, 0, 0, 0); } while (0)
#define TI_ST(Dp, Cv) do { _Pragma("unroll") for (int r_ = 0; r_ < 4; ++r_) (Dp)[(g4 + r_) * TI_LD + col] = (Cv)[r_]; } while (0)
        f4v xb[4];
#pragma unroll
        for (int r = 0; r < 4; ++r) xb[0][r] = TI_X(wl, wl)[(g4 + r) * TI_LD + col];
#pragma unroll
        for (int a2 = 1; a2 < 4; ++a2) {
            const int ar = wl + a2;
            if (ar < 4) {
                f4v t = zero;
#pragma unroll
                for (int j = 0; j < a2; ++j) TI_MMA(TI_A(ar, wl + j), xb[j], t);
                f4v x = zero;
                TI_MMA(TI_X(ar, ar), t, x);
                x = -x;
                xb[a2] = x;
                TI_ST(TI_X(ar, wl), x);
            }
        }
#undef TI_MMA
#undef TI_ST
    }
    LBAR();
#undef TI_A
#undef TI_X
#undef TI_T
}

constexpr int GL_LD = 72;
__device__ __forceinline__ void gla_scan_task(const P& p, int ei, int s, int h, int dir, unsigned char* dsm) {
    bf16* LAt = (bf16*)dsm;
    bf16* Qd = LAt + 64 * GL_LD;
    bf16* Ki = Qd + 64 * GL_LD;
    bf16* KiT = Ki + 64 * GL_LD;
    bf16* Sc = KiT + 64 * GL_LD;
    bf16* Vr = Sc + 64 * GL_LD;
    bf16* St = Vr + 128 * GL_LD;
    float* sAE = (float*)(St + 128 * GL_LD);
    float* Of = sAE + 64;
    const Seq sq_ = get_seq(s);
    const int tid = opaque_tid(), lane = tid & 63, wid = tid >> 6, fr = lane & 15, fq = lane >> 4;
    const int rt = wid & 3, chf = wid >> 2;
    const bf16* proj = (const bf16*)(p.ws + WS_PROJ);
    bf16* opart = (bf16*)(p.ws + WS_PART);
    s8v gfrag[2]; float gb[2];
    {
        const float* gup = p.in[I_GUP] + (size_t)(ei * 2 + dir) * 16 * 256 + h * 64;
        const float* gbias = p.in[I_GBIAS] + (size_t)(ei * 2 + dir) * 256 + h * 64;
#pragma unroll
        for (int c2 = 0; c2 < 2; ++c2) {
            const int d = 16 * (2 * chf + c2) + fr;
            gb[c2] = gbias[d];
#pragma unroll
            for (int j = 0; j < 8; ++j) gfrag[c2][j] = (short)f2bf(fq < 2 ? gup[(8 * fq + j) * 256 + d] : 0.f);
        }
    }
    f4v Sacc[4];
    LBAR();
    if (sq_.lat) {
        const float* s0 = p.in[I_SGLA] + ((((size_t)sq_.b * N_EVEN + ei) * 2 + dir) * 4 + h) * 64 * 128;
#pragma unroll
        for (int ct = 0; ct < 4; ++ct)
#pragma unroll
            for (int r = 0; r < 4; ++r) Sacc[ct][r] = s0[(16 * rt + fq * 4 + r) * 128 + 64 * chf + 16 * ct + fr];
    } else {
#pragma unroll
        for (int ct = 0; ct < 4; ++ct) Sacc[ct] = (f4v){0.f, 0.f, 0.f, 0.f};
    }
#pragma unroll
    for (int ct = 0; ct < 4; ++ct) *(uint2*)(St + (64 * chf + 16 * ct + fr) * GL_LD + 16 * rt + fq * 4) = make_uint2(pack2(Sacc[ct][0], Sacc[ct][1]), pack2(Sacc[ct][2], Sacc[ct][3]));
    const int nch = sq_.len >> 6;
    uint4 pv0, pv1, pq, pkk, pga;
#define GLA_FETCH(TB) do { \
        { const int i0_ = tid >> 4, i1_ = i0_ + 32, c8_ = (tid & 15) * 8;     \
          pv0 = *(const uint4*)(proj + (size_t)((TB) + (dir ? 63 - i0_ : i0_)) * EW + E_V + h * 128 + c8_); pv1 = *(const uint4*)(proj + (size_t)((TB) + (dir ? 63 - i1_ : i1_)) * EW + E_V + h * 128 + c8_); } \
        { const int i_ = tid >> 3, c8_ = (tid & 7) * 8; const bf16* pr_ = proj + (size_t)((TB) + (dir ? 63 - i_ : i_)) * EW + h * 64 + c8_; \
          pq = *(const uint4*)(pr_ + E_Q); pkk = *(const uint4*)(pr_ + E_K); } \
        { const int i_ = 16 * rt + fr; pga = make_uint4(0u, 0u, 0u, 0u); if (fq < 2) pga = *(const uint4*)(proj + (size_t)((TB) + (dir ? 63 - i_ : i_)) * EW + E_GD + dir * 16 + fq * 8); } \
    } while (0)
    GLA_FETCH(sq_.start + (dir ? sq_.len - 64 : 0));
    uint4 gf0 = make_uint4(0u, 0u, 0u, 0u), gf1 = gf0, gz0 = gf0, gz1 = gf0;
    f8v gn0 = (f8v)(0.f), gn1 = (f8v)(0.f);
#define GLA_FIN_FETCH(TB) do { const int i_ = tid >> 3, d0_ = (tid & 7) * 16, t_ = (TB) + 63 - i_; \
        const bf16* ofp_ = opart + (size_t)t_ * 512 + h * 128 + d0_; const bf16* zap_ = proj + (size_t)t_ * EW + E_ZA + h * 128 + d0_; \
        gf0 = *(const uint4*)ofp_; gf1 = *(const uint4*)(ofp_ + 8); gz0 = *(const uint4*)zap_; gz1 = *(const uint4*)(zap_ + 8); } while (0)
    if (dir == 1) {
        const float* gn = p.in[I_GLAN] + ei * 128 + (tid & 7) * 16;
        gn0 = *(const f8v*)gn; gn1 = *(const f8v*)(gn + 8);
        GLA_FIN_FETCH(sq_.start + sq_.len - 64);
    }
    for (int cc = 0; cc < nch; ++cc) {
        const int tb = sq_.start + (dir ? sq_.len - 64 - cc * 64 : cc * 64);
        PT_B(65);
        {
            { const int i0 = tid >> 4, c8 = (tid & 15) * 8; *(uint4*)(Vr + i0 * 136 + c8) = pv0; *(uint4*)(Vr + (i0 + 32) * 136 + c8) = pv1; }
            { const int i = tid >> 3, c8 = (tid & 7) * 8; *(uint4*)(Qd + i * GL_LD + c8) = pq; *(uint4*)(Ki + i * GL_LD + c8) = pkk; }
            const s8v ga = __builtin_bit_cast(s8v, pga);
            if (cc + 1 < nch) GLA_FETCH(sq_.start + (dir ? sq_.len - 128 - cc * 64 : (cc + 1) * 64));
#pragma unroll
            for (int c2 = 0; c2 < 2; ++c2) {
                const f4v x = mfma16(ga, gfrag[c2], (f4v){0.f, 0.f, 0.f, 0.f});
                float la[4];
#pragma unroll
                for (int r = 0; r < 4; ++r) la[r] = logsigf_(x[r] + gb[c2]) * (1.0f / 16.0f);
                *(uint2*)(LAt + (16 * (2 * chf + c2) + fr) * GL_LD + 16 * rt + fq * 4) = make_uint2(pack2(la[0], la[1]), pack2(la[2], la[3]));
            }
        }
        LBAR();
        PT_E(65); PT_B(66);
        {
            f4v bc[2];
            bc[0] = (f4v){0.f, 0.f, 0.f, 0.f}; bc[1] = bc[0];
#pragma unroll
            for (int ks = 0; ks < 2; ++ks) {
                s8v lf;
#pragma unroll
                for (int j = 0; j < 8; ++j) lf[j] = (32 * ks + 8 * fq + j <= 16 * rt + fr) ? (short)0x3F80 : (short)0;
#pragma unroll
                for (int c2 = 0; c2 < 2; ++c2) bc[c2] = mfma16(lf, *(const s8v*)(LAt + (16 * (2 * chf + c2) + fr) * GL_LD + 32 * ks + 8 * fq), bc[c2]);
            }
#pragma unroll
            for (int c2 = 0; c2 < 2; ++c2) {
                const int d = 16 * (2 * chf + c2) + fr;
                float kiv[4];
#pragma unroll
                for (int r = 0; r < 4; ++r) {
                    const int i = 16 * rt + fq * 4 + r;
                    const float eb = fexp(bc[c2][r]);
                    const float qv = bf2f(Qd[i * GL_LD + d]) * 0.125f * eb;
                    kiv[r] = bf2f(Ki[i * GL_LD + d]) * frcp(eb);
                    Qd[i * GL_LD + d] = f2bf(qv); Ki[i * GL_LD + d] = f2bf(kiv[r]);
                    if (i == 63) sAE[d] = eb;
                }
                *(uint2*)(KiT + d * GL_LD + 16 * rt + fq * 4) = make_uint2(pack2(kiv[0], kiv[1]), pack2(kiv[2], kiv[3]));
            }
        }
        LBAR();
        PT_E(66); PT_B(67);
        f4v oacc[4];
        {
            f4v sc[2];
            sc[0] = (f4v){0.f, 0.f, 0.f, 0.f}; sc[1] = sc[0];
#pragma unroll
            for (int ct = 0; ct < 4; ++ct) oacc[ct] = (f4v){0.f, 0.f, 0.f, 0.f};
#pragma unroll
            for (int ks = 0; ks < 2; ++ks) {
                const s8v a = *(const s8v*)(Qd + (16 * rt + fr) * GL_LD + 32 * ks + 8 * fq);
#pragma unroll
                for (int c2 = 0; c2 < 2; ++c2) sc[c2] = mfma16(a, *(const s8v*)(Ki + (16 * (2 * chf + c2) + fr) * GL_LD + 32 * ks + 8 * fq), sc[c2]);
#pragma unroll
                for (int ct = 0; ct < 4; ++ct) oacc[ct] = mfma16(*(const s8v*)(St + (64 * chf + 16 * ct + fr) * GL_LD + 32 * ks + 8 * fq), a, oacc[ct]);
            }
#pragma unroll
            for (int c2 = 0; c2 < 2; ++c2)
#pragma unroll
                for (int r = 0; r < 4; ++r) { const int i = 16 * rt + fq * 4 + r, j = 16 * (2 * chf + c2) + fr; Sc[i * GL_LD + j] = f2bf(j <= i ? sc[c2][r] : 0.f); }
        }
        LBAR();
        PT_E(67); PT_B(68);
        {
            s8v bvf[2][4];
            {
                const bf16* lp = tr_lane_ptr(Vr, 136, 0, 64 * chf, lane);
#define GLA_TR(KS) do { u64t r0 = tr_rd<(KS) * 8704 + 0>(lp), r1 = tr_rd<(KS) * 8704 + 1088>(lp), r2 = tr_rd<(KS) * 8704 + 32>(lp), r3 = tr_rd<(KS) * 8704 + 1088 + 32>(lp), \
                                     r4 = tr_rd<(KS) * 8704 + 64>(lp), r5 = tr_rd<(KS) * 8704 + 1088 + 64>(lp), r6 = tr_rd<(KS) * 8704 + 96>(lp), r7 = tr_rd<(KS) * 8704 + 1088 + 96>(lp); \
                            TR_WAIT8(r0, r1, r2, r3, r4, r5, r6, r7); \
                            bvf[KS][0] = tr_pair(r0, r1); bvf[KS][1] = tr_pair(r2, r3); bvf[KS][2] = tr_pair(r4, r5); bvf[KS][3] = tr_pair(r6, r7); } while (0)
                GLA_TR(0); GLA_TR(1);
#undef GLA_TR
            }
#pragma unroll
            for (int ks = 0; ks < 2; ++ks) {
                const s8v a = *(const s8v*)(Sc + (16 * rt + fr) * GL_LD + 32 * ks + 8 * fq);
                const s8v kt = *(const s8v*)(KiT + (16 * rt + fr) * GL_LD + 32 * ks + 8 * fq);
#pragma unroll
                for (int ct = 0; ct < 4; ++ct) { oacc[ct] = mfma16(bvf[ks][ct], a, oacc[ct]); Sacc[ct] = mfma16(kt, bvf[ks][ct], Sacc[ct]); }
            }
            {
                const int i = 16 * rt + fr, t = tb + (dir ? 63 - i : i);
                if (dir == 0) {
#pragma unroll
                    for (int ct = 0; ct < 4; ++ct) *(uint2*)(opart + (size_t)t * 512 + h * 128 + 64 * chf + 16 * ct + fq * 4) = pack4(oacc[ct]);
                } else {
#pragma unroll
                    for (int ct = 0; ct < 4; ++ct) *(f4v*)(Of + i * 132 + 64 * chf + 16 * ct + fq * 4) = oacc[ct];
                }
            }
            float ae[4];
#pragma unroll
            for (int r = 0; r < 4; ++r) ae[r] = sAE[16 * rt + fq * 4 + r];
#pragma unroll
            for (int ct = 0; ct < 4; ++ct) {
#pragma unroll
                for (int r = 0; r < 4; ++r) Sacc[ct][r] *= ae[r];
                *(uint2*)(St + (64 * chf + 16 * ct + fr) * GL_LD + 16 * rt + fq * 4) = make_uint2(pack2(Sacc[ct][0], Sacc[ct][1]), pack2(Sacc[ct][2], Sacc[ct][3]));
            }
        }
        LBAR();
        PT_E(68); PT_B(69);
        if (dir == 1) {
            const int i = tid >> 3, d0 = (tid & 7) * 16, t = tb + 63 - i;
            const f8v o0 = *(const f8v*)(Of + i * 132 + d0) + unpack8v(gf0), o1 = *(const f8v*)(Of + i * 132 + d0 + 8) + unpack8v(gf1);
            float ss = 0.f;
#pragma unroll
            for (int j = 0; j < 8; ++j) ss += o0[j] * o0[j] + o1[j] * o1[j];
            const float r = frsq(red8(ss) * (1.0f / 128.f) + EPS);
            const f8v z0 = unpack8v(gz0), z1 = unpack8v(gz1);
            f8v y0, y1;
#pragma unroll
            for (int j = 0; j < 8; ++j) { y0[j] = o0[j] * r * gn0[j] * siluf_(z0[j]); y1[j] = o1[j] * r * gn1[j] * siluf_(z1[j]); }
            bf16* yc = (bf16*)(p.ws + WS_YCE) + (size_t)t * D + h * 128 + d0;
            *(uint4*)yc = pack8v(y0); *(uint4*)(yc + 8) = pack8v(y1);
            if (cc + 1 < nch) GLA_FIN_FETCH(tb - 64);
        }
        PT_E(69);
    }
    if (!sq_.lat) {
        float* fs = p.out + OUT_GLA + ((((size_t)sq_.b * N_EVEN + ei) * 2 + dir) * 4 + h) * 64 * 128;
#pragma unroll
        for (int ct = 0; ct < 4; ++ct)
#pragma unroll
            for (int r = 0; r < 4; ++r) fs[(16 * rt + fq * 4 + r) * 128 + 64 * chf + 16 * ct + fr] = Sacc[ct][r];
    }
}

#ifndef RW_PREFETCH
#define RW_PREFETCH 1
#endif
constexpr int RW_LD = 72;
constexpr int RWKV_PREP_ITEMS = (T / 64) * 8;
struct RwPre { uint4 x[5], l[5], r[5]; };
__device__ __forceinline__ void rwkv_prefetch(const P& p, int w, int dir, int tid, RwPre& q) {
    const int cg = w >> 3, h = w & 7, hc0 = h * 64;
    const int i = tid >> 3, c8 = (tid & 7) * 8, t = cg * 64 + (dir ? 63 - i : i);
    bool hl, hr; tok_nbr(t, hl, hr);
    const bf16* proj = (const bf16*)(p.ws + WS_PROJ);
#pragma unroll
    for (int grp = 0; grp < 5; ++grp) {
        const int col = (grp == 0 ? FB_R + hc0 : grp == 1 ? FB_K + hc0 : grp == 2 ? FB_V + hc0 : grp == 3 ? FB_WD + dir * 64 : FB_AD + dir * 64) + c8;
        const bf16* pr = proj + (size_t)t * EW + E_FB + col;
        q.x[grp] = *(const uint4*)pr;
        q.l[grp] = hl ? *(const uint4*)(pr - EW) : make_uint4(0u, 0u, 0u, 0u);
        q.r[grp] = hr ? *(const uint4*)(pr + EW) : make_uint4(0u, 0u, 0u, 0u);
    }
}
__device__ __forceinline__ void rwkv_prep_phase(const P& p, int ei, int dir, int w_first, int w_stride, int w_end, unsigned char* dsm) {
    float* sCS = (float*)dsm;
    float* sKK = sCS + 4096;
    float* sB = sKK + 4096;
    float* sKM = sB + 4096;
    float* sR = sKM + 4096;
    float* sAf = (float*)dsm;
    float* sXf = sAf + 64 * TI_LD;
    float* sTmp = sXf + 64 * TI_LD;
    bf16* AakT = (bf16*)(sTmp + 8 * 16 * TI_TLD);
    bf16* Brb = AakT + 64 * RW_LD;
    bf16* Tm = Brb + 64 * RW_LD;
    bf16* PT = (bf16*)dsm;
    bf16* W1T = PT + 64 * RW_LD;
    static_assert(2 * 64 * TI_LD * 4 + 8 * 16 * TI_TLD * 4 + 3 * 64 * RW_LD * 2 <= 81920, "RWKV prep overlays exceed region A");
    bf16* At = (bf16*)(dsm + 81920);
    bf16* Bt = At + 64 * RW_LD;
    bf16* Kt = Bt + 64 * RW_LD;
    bf16* Rt = Kt + 64 * RW_LD;
    bf16* Bh = Rt + 64 * RW_LD;
    bf16* Kh = Bh + 64 * RW_LD;
    bf16* AtT = Kh + 64 * RW_LD;
    bf16* sTW = At;
    bf16* sAD = Bt;
    float* sSeg = (float*)(AtT + 64 * RW_LD);
    float* sMix = sSeg + 512;
    float* sKw = sMix + 320;
    const int tid0 = opaque_tid();
    float* bonus = (float*)(p.ws + WS_BONUS);
    const float* mix = p.in[I_MIX] + (size_t)ei * 1792;
    int hcur = -1;
    s8v lrf[4][2];
    float lrb[4];
    RwPre pre;
#if RW_PREFETCH
    if (w_first < w_end) rwkv_prefetch(p, w_first, dir, tid0, pre);
#endif
    for (int w = w_first; w < w_end; w += w_stride) {
        const int tid = opaque_tid(), lane = tid & 63, wid = tid >> 6, fr = lane & 15, fq = lane >> 4;
        const int rt = wid & 3, cb = 2 * (wid >> 2), which = wid >> 2;
        const int cg = w >> 3, h = w & 7, hc0 = h * 64;
        const size_t tk = (size_t)cg * 8 + h;
        PT_B(1);
        if (h != hcur) {
            hcur = h;
            LBAR();
            const float* w2 = p.in[I_W2] + (size_t)(ei * 2 + dir) * 64 * 512 + hc0; const float* a2 = p.in[I_A2] + (size_t)(ei * 2 + dir) * 64 * 512 + hc0;
            {
                float wv[8], av[8];
#pragma unroll
                for (int u = 0; u < 8; ++u) { const int e = tid + u * 512, r = e >> 6, c = e & 63; wv[u] = w2[(size_t)r * 512 + c]; av[u] = a2[(size_t)r * 512 + c]; }
#pragma unroll
                for (int u = 0; u < 8; ++u) { const int e = tid + u * 512, r = e >> 6, c = e & 63; Kt[c * RW_LD + r] = f2bf(wv[u]); Rt[c * RW_LD + r] = f2bf(av[u]); }
                if (tid < 320) { const int grp = tid >> 6, c = tid & 63; sMix[tid] = mix[(grp == 0 ? FB_R + hc0 : grp == 1 ? FB_K + hc0 : grp == 2 ? FB_V + hc0 : grp == 3 ? FB_WD + dir * 64 : FB_AD + dir * 64) + c]; }
                else if (tid < 512) { const int e = tid - 320, which3 = e >> 6, c = e & 63; sKw[e] = ((which3 == 0 ? p.in[I_KK] : which3 == 1 ? p.in[I_KA] : p.in[I_RK]) + (size_t)ei * 512 + hc0)[c]; }
            }
            LBAR();
            const bf16* src = which ? Rt : Kt;
            const float* lb = (which ? p.in[I_A0] : p.in[I_W0]) + (size_t)(ei * 2 + dir) * 512 + hc0;
#pragma unroll
            for (int ct = 0; ct < 4; ++ct) {
                lrb[ct] = lb[16 * ct + fr];
#pragma unroll
                for (int ks = 0; ks < 2; ++ks) lrf[ct][ks] = *(const s8v*)(src + (16 * ct + fr) * RW_LD + ks * 32 + fq * 8);
            }
        }
        LBAR();
        PT_E(1); PT_B(2);
#if !RW_PREFETCH
        rwkv_prefetch(p, w, dir, tid, pre);
#endif
        {
            const int i = tid >> 3, c8 = (tid & 7) * 8, t = cg * 64 + (dir ? 63 - i : i);
#pragma unroll
            for (int grp = 0; grp < 5; ++grp) {
                const int col = (grp == 0 ? FB_R + hc0 : grp == 1 ? FB_K + hc0 : grp == 2 ? FB_V + hc0 : grp == 3 ? FB_WD + dir * 64 : FB_AD + dir * 64) + c8;
                const f8v x = unpack8v(pre.x[grp]);
                const f8v nb = unpack8v(pre.l[grp]) + unpack8v(pre.r[grp]);
                const f8v mv = *(const f8v*)(sMix + grp * 64 + c8);
                f8v y = x + mv * (nb * 0.5f - x);
                if (grp == 0) *(f8v*)(sR + i * 64 + c8) = y;
                else if (grp == 1) *(f8v*)(sKM + i * 64 + c8) = y;
                else if (grp == 2) { if (dir == 0) *(uint4*)((bf16*)(p.ws + WS_VSH) + (size_t)t * 512 + hc0 + c8) = pack8v(y); }
                else {
                    if (grp == 3) {
#pragma unroll
                        for (int j = 0; j < 8; ++j) y[j] = ftanh(y[j]);
                    }
                    *(uint4*)((grp == 3 ? sTW : sAD) + i * RW_LD + c8) = pack8v(y);
                }
            }
        }
#if RW_PREFETCH
        if (w + w_stride < w_end) rwkv_prefetch(p, w + w_stride, dir, tid, pre);
#endif
        LBAR();
        PT_E(2); PT_B(3);
        {
            const bf16* Am = which ? sAD : sTW;
            f4v acc[4];
#pragma unroll
            for (int ct = 0; ct < 4; ++ct) acc[ct] = (f4v){0.f, 0.f, 0.f, 0.f};
#pragma unroll
            for (int ks = 0; ks < 2; ++ks) {
                const s8v a = *(const s8v*)(Am + (16 * rt + fr) * RW_LD + ks * 32 + fq * 8);
#pragma unroll
                for (int ct = 0; ct < 4; ++ct) acc[ct] = mfma16(a, lrf[ct][ks], acc[ct]);
            }
#pragma unroll
            for (int ct = 0; ct < 4; ++ct) {
                const int c = 16 * ct + fr;
#pragma unroll
                for (int r = 0; r < 4; ++r) {
                    const int tok = 16 * rt + fq * 4 + r;
                    const float sg = sigmoidf_(lrb[ct] + acc[ct][r]);
                    if (which) sB[tok * 64 + c] = sg; else sCS[tok * 64 + c] = -0.6065306597126334f * sg;
                }
            }
        }
        LBAR();
        PT_E(3); PT_B(4);
        {
            const int i = tid >> 3, c8 = (tid & 7) * 8;
            const f8v av = *(const f8v*)(sB + i * 64 + c8), kr = *(const f8v*)(sKM + i * 64 + c8), rv = *(const f8v*)(sR + i * 64 + c8);
            const f8v kkv = *(const f8v*)(sKw + c8), kav = *(const f8v*)(sKw + 64 + c8), rkv = *(const f8v*)(sKw + 128 + c8);
            const f8v km = kr * (1.0f + (av - 1.0f) * kav);
            f8v kk = kr * kkv;
            float ss = 0.f, bn = 0.f;
#pragma unroll
            for (int j = 0; j < 8; ++j) { ss += kk[j] * kk[j]; bn += rv[j] * km[j] * rkv[j]; }
            ss = red8(ss); bn = red8(bn);
            kk *= frsq(ss + EPS);
            *(f8v*)(sKK + i * 64 + c8) = kk; *(f8v*)(sB + i * 64 + c8) = kk * av; *(f8v*)(sKM + i * 64 + c8) = km;
            if ((tid & 7) == 0) { const int t = cg * 64 + (dir ? 63 - i : i); bonus[((size_t)t * 8 + h) * 2 + dir] = bn; }
        }
        {
            const int c = tid & 63, sg = tid >> 6;
            float run = 0.f;
#pragma unroll
            for (int j = 0; j < 8; ++j) { run += sCS[(8 * sg + j) * 64 + c]; sCS[(8 * sg + j) * 64 + c] = run; }
            sSeg[sg * 64 + c] = run;
        }
        LBAR();
        PT_E(4); PT_B(5);
        {
            const int c = tid & 63, sg = tid >> 6;
            float off = 0.f;
            for (int q = 0; q < sg; ++q) off += sSeg[q * 64 + c];
#pragma unroll
            for (int j = 0; j < 8; ++j) sCS[(8 * sg + j) * 64 + c] += off;
        }
        LBAR();
        PT_E(5); PT_B(6);
        {
            const int i = tid >> 3, c8 = (tid & 7) * 8;
            const f8v cs = *(const f8v*)(sCS + i * 64 + c8), cl = *(const f8v*)(sCS + 63 * 64 + c8);
            f8v cp = (f8v)(0.f);
            if (i > 0) cp = *(const f8v*)(sCS + (i - 1) * 64 + c8);
            const f8v kk = *(const f8v*)(sKK + i * 64 + c8), bb = *(const f8v*)(sB + i * 64 + c8), km = *(const f8v*)(sKM + i * 64 + c8), rv = *(const f8v*)(sR + i * 64 + c8);
            f8v at, bt, kt, rtv, bh, kh;
#pragma unroll
            for (int j = 0; j < 8; ++j) {
                const float g = fexp(cs[j]), gi = frcp(g), gp = fexp(cp[j]), gc = fexp(cl[j]) * gi;
                at[j] = -kk[j] * gp; bt[j] = bb[j] * gi; kt[j] = km[j] * gi; rtv[j] = rv[j] * g;
                bh[j] = bb[j] * gc; kh[j] = km[j] * gc;
            }
            *(uint4*)(At + i * RW_LD + c8) = pack8v(at); *(uint4*)(Bt + i * RW_LD + c8) = pack8v(bt);
            *(uint4*)(Kt + i * RW_LD + c8) = pack8v(kt); *(uint4*)(Rt + i * RW_LD + c8) = pack8v(rtv);
            *(uint4*)(Bh + i * RW_LD + c8) = pack8v(bh); *(uint4*)(Kh + i * RW_LD + c8) = pack8v(kh);
            if (i == 63) {
                float* gco = (float*)(p.ws + WS_GC) + tk * 64 + c8;
#pragma unroll
                for (int j = 0; j < 8; ++j) gco[j] = fexp(cl[j]);
            }
        }
        LBAR();
        PT_E(6); PT_B(7);
        f4v brkT[2];
        {
            f4v aab[2], aak[2], brb[2];
#pragma unroll
            for (int c2 = 0; c2 < 2; ++c2) { aab[c2] = (f4v){0.f, 0.f, 0.f, 0.f}; aak[c2] = aab[c2]; brb[c2] = aab[c2]; brkT[c2] = aab[c2]; }
#pragma unroll
            for (int ks = 0; ks < 2; ++ks) {
                const int ko = ks * 32 + fq * 8, ra = (16 * rt + fr) * RW_LD + ko;
                const s8v fa = *(const s8v*)(At + ra), frr = *(const s8v*)(Rt + ra), fk = *(const s8v*)(Kt + ra);
#pragma unroll
                for (int c2 = 0; c2 < 2; ++c2) {
                    const int ro = (16 * (cb + c2) + fr) * RW_LD + ko;
                    const s8v gb = *(const s8v*)(Bt + ro), gk = *(const s8v*)(Kt + ro), gr = *(const s8v*)(Rt + ro);
                    aab[c2] = mfma16(fa, gb, aab[c2]); aak[c2] = mfma16(fa, gk, aak[c2]); brb[c2] = mfma16(frr, gb, brb[c2]);
                    brkT[c2] = mfma16(fk, gr, brkT[c2]);
                }
            }
#pragma unroll
            for (int c2 = 0; c2 < 2; ++c2) {
                const int col = 16 * (cb + c2) + fr, r0 = 16 * rt + fq * 4;
                f4v ak;
#pragma unroll
                for (int r = 0; r < 4; ++r) {
                    const int row = r0 + r;
                    sAf[row * TI_LD + col] = col < row ? -aab[c2][r] : 0.f;
                    ak[r] = col < row ? aak[c2][r] : 0.f;
                    Brb[row * RW_LD + col] = f2bf(col <= row ? brb[c2][r] : 0.f);
                    if (!(row <= col)) brkT[c2][r] = 0.f;
                }
                *(uint2*)(AakT + col * RW_LD + r0) = pack4(ak);
            }
        }
        LBAR();
        PT_E(7); PT_B(8);
        tri_inv64(sAf, sXf, sTmp, wid & 3, lane, wid < 4);
        { const int i = tid >> 3, c8 = (tid & 7) * 8; *(uint4*)(Tm + i * RW_LD + c8) = pack8v(*(const f8v*)(sXf + i * TI_LD + c8)); }
        LBAR();
        PT_E(8); PT_B(9);
        {
            f4v pp[2], ww[2];
#pragma unroll
            for (int c2 = 0; c2 < 2; ++c2) { pp[c2] = (f4v){0.f, 0.f, 0.f, 0.f}; ww[c2] = pp[c2]; }
            s8v atf[2][2];
            {
                const bf16* lp = tr_lane_ptr(At, RW_LD, 0, 16 * cb, lane);
                u64t r0 = tr_rd<0>(lp), r1 = tr_rd<576>(lp), r2 = tr_rd<32>(lp), r3 = tr_rd<576 + 32>(lp), r4 = tr_rd<4608>(lp), r5 = tr_rd<4608 + 576>(lp), r6 = tr_rd<4608 + 32>(lp), r7 = tr_rd<4608 + 576 + 32>(lp);
                TR_WAIT8(r0, r1, r2, r3, r4, r5, r6, r7);
                atf[0][0] = tr_pair(r0, r1); atf[0][1] = tr_pair(r2, r3); atf[1][0] = tr_pair(r4, r5); atf[1][1] = tr_pair(r6, r7);
            }
#pragma unroll
            for (int ks = 0; ks < 2; ++ks) {
                const int ko = ks * 32 + fq * 8;
                const s8v ft = *(const s8v*)(Tm + (16 * rt + fr) * RW_LD + ko);
#pragma unroll
                for (int c2 = 0; c2 < 2; ++c2) {
                    const int ro = (16 * (cb + c2) + fr) * RW_LD + ko;
                    pp[c2] = mfma16(ft, atf[ks][c2], pp[c2]); ww[c2] = mfma16(ft, *(const s8v*)(AakT + ro), ww[c2]);
                }
            }
#pragma unroll
            for (int c2 = 0; c2 < 2; ++c2) {
                const int col = 16 * (cb + c2) + fr;
                *(uint2*)(PT + col * RW_LD + 16 * rt + fq * 4) = pack4(pp[c2]);
                *(uint2*)(W1T + col * RW_LD + 16 * rt + fq * 4) = pack4(ww[c2]);
            }
        }
        LBAR();
        PT_E(9); PT_B(10);
        {
            bf16* m12 = (bf16*)(p.ws + WS_RM12) + tk * 8192; bf16* m34 = (bf16*)(p.ws + WS_RM34) + tk * 8192;
            s8v bhf[2][2]; u64t khi[2];
            {
                const bf16* lp = tr_lane_ptr(Bh, RW_LD, 0, 16 * cb, lane);
                const bf16* lk = Kh + (size_t)(16 * rt + 4 * fq + (fr >> 2)) * RW_LD + 16 * cb + 4 * (fr & 3);
                u64t r0 = tr_rd<0>(lp), r1 = tr_rd<576>(lp), r2 = tr_rd<32>(lp), r3 = tr_rd<576 + 32>(lp), r4 = tr_rd<4608>(lp), r5 = tr_rd<4608 + 576>(lp), r6 = tr_rd<4608 + 32>(lp), r7 = tr_rd<4608 + 576 + 32>(lp);
                u64t k0_ = tr_rd<0>(lk), k1_ = tr_rd<32>(lk);
                TR_WAIT8(r0, r1, r2, r3, r4, r5, r6, r7); TR_WAIT6(k0_, k1_, r0, r1, r2, r3);
                bhf[0][0] = tr_pair(r0, r1); bhf[0][1] = tr_pair(r2, r3); bhf[1][0] = tr_pair(r4, r5); bhf[1][1] = tr_pair(r6, r7);
                khi[0] = k0_; khi[1] = k1_;
            }
#pragma unroll
            for (int c2 = 0; c2 < 2; ++c2) {
                const int col = 16 * (cb + c2) + fr, r0 = 16 * rt + fq * 4;
                f4v m1 = unpack4(*(const uint2*)(Rt + col * RW_LD + r0));
                f4v m2 = brkT[c2], m3 = (f4v){0.f, 0.f, 0.f, 0.f};
                f4v m4 = unpack4(__builtin_bit_cast(uint2, khi[c2]));
#pragma unroll
                for (int ks = 0; ks < 2; ++ks) {
                    const int ko = ks * 32 + fq * 8;
                    const s8v fp = *(const s8v*)(PT + (16 * rt + fr) * RW_LD + ko), fw = *(const s8v*)(W1T + (16 * rt + fr) * RW_LD + ko);
                    const s8v gb = *(const s8v*)(Brb + col * RW_LD + ko), gh = bhf[ks][c2];
                    m1 = mfma16(fp, gb, m1);
                    m2 = mfma16(fw, gb, m2);
                    m3 = mfma16(fp, gh, m3);
                    m4 = mfma16(fw, gh, m4);
                }
                *(uint2*)(m12 + col * 64 + r0) = pack4(m1);
                *(uint2*)(m12 + 4096 + col * 64 + r0) = pack4(m2);
                *(uint2*)(m34 + col * 64 + r0) = pack4(m3);
                *(uint2*)(m34 + 4096 + col * 64 + r0) = pack4(m4);
            }
        }
        PT_E(10);
    }
}
__device__ __forceinline__ void rwkv_apply_task(const P& p, int ei, int s, int h, int dir, unsigned char* dsm) {
    bf16* St = (bf16*)dsm;
    bf16* VT = St + 64 * RW_LD;
    unsigned char* Mb = (unsigned char*)(VT + 64 * RW_LD);
    unsigned char* Vb = Mb + 2 * 4 * 8192;
    float* sGC = (float*)(Vb + 2 * 8192);
    float* Yf = sGC + 64;
    const Seq sq_ = get_seq(s);
    const int tid = opaque_tid(), lane = tid & 63, wid = tid >> 6, fr = lane & 15, fq = lane >> 4;
    const int rt = wid & 3, cb = 2 * (wid >> 2), hc0 = h * 64;
    bf16* opart = (bf16*)(p.ws + WS_PART + PART_SZ);
    f4v Sacc[2];
    LBAR();
#pragma unroll
    for (int c2 = 0; c2 < 2; ++c2) {
        const int v = 16 * (cb + c2) + fr, k0 = 16 * rt + fq * 4;
        if (sq_.lat) Sacc[c2] = *(const f4v*)(p.in[I_SRWKV] + ((((size_t)sq_.b * N_EVEN + ei) * 2 + dir) * 8 + h) * 4096 + v * 64 + k0);
        else Sacc[c2] = (f4v){0.f, 0.f, 0.f, 0.f};
        *(uint2*)(St + v * RW_LD + k0) = make_uint2(pack2(Sacc[c2][0], Sacc[c2][1]), pack2(Sacc[c2][2], Sacc[c2][3]));
    }
    const int nch = sq_.len >> 6;
    float pgc = 0.f;
    const int wu = RFL(wid);
#define RWA_FETCH(CC) do { const int cgn_ = (sq_.start >> 6) + (dir ? nch - 1 - (CC) : (CC)); const size_t tkn_ = (size_t)cgn_ * 8 + h; \
        const bf16* m12_ = (const bf16*)(p.ws + WS_RM12) + tkn_ * 8192; const bf16* m34_ = (const bf16*)(p.ws + WS_RM34) + tkn_ * 8192; \
        _Pragma("unroll") for (int u_ = 0; u_ < 4; ++u_) { const int q_ = wu * 4 + u_, mat_ = q_ >> 3, sub_ = q_ & 7; int R_, C_; pg8::stage_rc(sub_ * 1024 + lane * 16, R_, C_); \
            const bf16* src_ = (mat_ < 2 ? m12_ + mat_ * 4096 : m34_ + (mat_ - 2) * 4096) + R_ * 64 + C_; \
            GLDS16(src_, Mb + (((CC) & 1) * 4 + mat_) * 8192 + sub_ * 1024); } \
        { int R_, C_; pg8::stage_rc(wu * 1024 + lane * 16, R_, C_);     \
          GLDS16((const bf16*)(p.ws + WS_VSH) + (size_t)(cgn_ * 64 + (dir ? 63 - R_ : R_)) * 512 + hc0 + C_, Vb + ((CC) & 1) * 8192 + wu * 1024); } \
        if (tid < 64) pgc = ((const float*)(p.ws + WS_GC))[tkn_ * 64 + tid]; } while (0)
    RWA_FETCH(0);
    uint4 pfo = make_uint4(0u, 0u, 0u, 0u), pfv = pfo, pfz = pfo; float pfb = 0.f;
    f8v lng = (f8v)(0.f), lnb = (f8v)(0.f);
#define RWA_FIN_FETCH(CG) do { const int i_ = tid >> 3, c8_ = (tid & 7) * 8, t_ = (CG) * 64 + 63 - i_; \
        pfo = *(const uint4*)(opart + (size_t)t_ * 512 + hc0 + c8_); pfv = *(const uint4*)((const bf16*)(p.ws + WS_VSH) + (size_t)t_ * 512 + hc0 + c8_); \
        pfz = *(const uint4*)((const bf16*)(p.ws + WS_PROJ) + (size_t)t_ * EW + E_ZB + hc0 + c8_); \
        const float* bn_ = (const float*)(p.ws + WS_BONUS) + ((size_t)t_ * 8 + h) * 2; pfb = bn_[0] + bn_[1]; } while (0)
    if (dir == 1) {
        const int c8 = (tid & 7) * 8;
        lng = *(const f8v*)(p.in[I_LNG] + ei * 512 + hc0 + c8); lnb = *(const f8v*)(p.in[I_LNB] + ei * 512 + hc0 + c8);
        RWA_FIN_FETCH((sq_.start >> 6) + nch - 1);
    }
    for (int cc = 0; cc < nch; ++cc) {
        const int cg = (sq_.start >> 6) + (dir ? nch - 1 - cc : cc);
        PT_B(80);
        PG_WAIT_V(0);
        {
            if (tid < 64) sGC[tid] = pgc;
            if (cc + 1 < nch) RWA_FETCH(cc + 1);
        }
        LBAR();
        PT_E(80); PT_B(81);
        {
            f4v yT[2], sn[2];
#pragma unroll
            for (int c2 = 0; c2 < 2; ++c2) { yT[c2] = (f4v){0.f, 0.f, 0.f, 0.f}; sn[c2] = yT[c2]; }
            s8v vfr[2], vfc[2][2];
            {
                const unsigned char* Vs = Vb + (cc & 1) * 8192;
                const int tq = 8 * fq + (fr >> 2), c4 = 4 * (fr & 3);
#define RWA_TP(KS, B, COL) ((const bf16*)(Vs + pg8::lds_byte(32 * (KS) + tq + 4 * (B), (COL) + c4)))
                u64t a0 = tr_rd<0>(RWA_TP(0, 0, 16 * rt)), a1 = tr_rd<0>(RWA_TP(0, 1, 16 * rt)), a2 = tr_rd<0>(RWA_TP(1, 0, 16 * rt)), a3 = tr_rd<0>(RWA_TP(1, 1, 16 * rt));
                u64t b0 = tr_rd<0>(RWA_TP(0, 0, 16 * cb)), b1 = tr_rd<0>(RWA_TP(0, 1, 16 * cb)), b2 = tr_rd<0>(RWA_TP(0, 0, 16 * cb + 16)), b3 = tr_rd<0>(RWA_TP(0, 1, 16 * cb + 16));
                u64t c0 = tr_rd<0>(RWA_TP(1, 0, 16 * cb)), c1 = tr_rd<0>(RWA_TP(1, 1, 16 * cb)), c2_ = tr_rd<0>(RWA_TP(1, 0, 16 * cb + 16)), c3 = tr_rd<0>(RWA_TP(1, 1, 16 * cb + 16));
#undef RWA_TP
                TR_WAIT8(a0, a1, a2, a3, b0, b1, b2, b3); TR_WAIT6(c0, c1, c2_, c3, a0, a1);
                vfr[0] = tr_pair(a0, a1); vfr[1] = tr_pair(a2, a3);
                vfc[0][0] = tr_pair(b0, b1); vfc[0][1] = tr_pair(b2, b3); vfc[1][0] = tr_pair(c0, c1); vfc[1][1] = tr_pair(c2_, c3);
            }
#pragma unroll
            for (int ks = 0; ks < 2; ++ks) {
                const int ko = ks * 32 + fq * 8;
                const s8v fs = *(const s8v*)(St + (16 * rt + fr) * RW_LD + ko), fv = vfr[ks];
                const unsigned char* Ms = Mb + (cc & 1) * 4 * 8192;
                const int oa = pg8::lds_byte(16 * rt + fr, ko);
                const s8v f3 = *(const s8v*)(Ms + 2 * 8192 + oa), f4 = *(const s8v*)(Ms + 3 * 8192 + oa);
#pragma unroll
                for (int c2 = 0; c2 < 2; ++c2) {
                    const int ro = (16 * (cb + c2) + fr) * RW_LD + ko, ob = pg8::lds_byte(16 * (cb + c2) + fr, ko);
                    yT[c2] = mfma16(fs, *(const s8v*)(Ms + ob), yT[c2]); yT[c2] = mfma16(fv, *(const s8v*)(Ms + 8192 + ob), yT[c2]);
                    sn[c2] = mfma16(f3, *(const s8v*)(St + ro), sn[c2]); sn[c2] = mfma16(f4, vfc[ks][c2], sn[c2]);
                }
            }
            float gc[4];
#pragma unroll
            for (int r = 0; r < 4; ++r) gc[r] = sGC[16 * rt + fq * 4 + r];
#pragma unroll
            for (int c2 = 0; c2 < 2; ++c2) {
                const int tt = 16 * (cb + c2) + fr, t = cg * 64 + (dir ? 63 - tt : tt);
                if (dir == 0) *(uint2*)(opart + (size_t)t * 512 + hc0 + 16 * rt + fq * 4) = make_uint2(pack2(yT[c2][0], yT[c2][1]), pack2(yT[c2][2], yT[c2][3]));
                else *(f4v*)(Yf + tt * 68 + 16 * rt + fq * 4) = yT[c2];
#pragma unroll
                for (int r = 0; r < 4; ++r) Sacc[c2][r] = Sacc[c2][r] * gc[r] + sn[c2][r];
            }
        }
        LBAR();
        PT_E(81); PT_B(82);
#pragma unroll
        for (int c2 = 0; c2 < 2; ++c2) *(uint2*)(St + (16 * (cb + c2) + fr) * RW_LD + 16 * rt + fq * 4) = make_uint2(pack2(Sacc[c2][0], Sacc[c2][1]), pack2(Sacc[c2][2], Sacc[c2][3]));
        if (dir == 1) {
            const int i = tid >> 3, c8 = (tid & 7) * 8, t = cg * 64 + 63 - i;
            f8v o = *(const f8v*)(Yf + i * 68 + c8) + unpack8v(pfo);
            float mu = 0.f;
#pragma unroll
            for (int j = 0; j < 8; ++j) mu += o[j];
            mu = red8(mu) * (1.0f / 64.f);
            o -= mu;
            float var = 0.f;
#pragma unroll
            for (int j = 0; j < 8; ++j) var += o[j] * o[j];
            const float r = frsq(red8(var) * (1.0f / 64.f) + 64e-5f);
            const float bsum = pfb;
            const f8v vsh = unpack8v(pfv), zb = unpack8v(pfz);
            f8v y;
#pragma unroll
            for (int j = 0; j < 8; ++j) y[j] = (o[j] * r * lng[j] + lnb[j] + bsum * vsh[j]) * siluf_(zb[j]);
            *(uint4*)((bf16*)(p.ws + WS_YCE) + (size_t)t * D + 512 + hc0 + c8) = pack8v(y);
            if (cc + 1 < nch) RWA_FIN_FETCH(cg - 1);
        }
        PT_E(82);
    }
    if (!sq_.lat) {
#pragma unroll
        for (int c2 = 0; c2 < 2; ++c2)
            *(f4v*)(p.out + OUT_RWKV + ((((size_t)sq_.b * N_EVEN + ei) * 2 + dir) * 8 + h) * 4096 + (16 * (cb + c2) + fr) * 64 + 16 * rt + fq * 4) = Sacc[c2];
    }
}
constexpr int EV_AP_LAT = NB_LAT * 8, EV_AP_CTX = NB_CTX * 8, EV_GLA_LAT = NB_LAT * 4, EV_GLA_CTX = NB_CTX * 4;
constexpr int EVEN_SCAN_ITEMS = EV_AP_LAT + EV_GLA_LAT + EV_AP_CTX + EV_GLA_CTX;
__device__ __forceinline__ void ph_even_scan_item(const P& p, int w, int ei, int dir, unsigned char* dsm) {
    int kind, sbase, x;
    if (w < EV_AP_LAT) { kind = 0; sbase = NB_CTX; x = w; }
    else if (w < EV_AP_LAT + EV_GLA_LAT) { kind = 1; sbase = NB_CTX; x = w - EV_AP_LAT; }
    else if (w < EV_AP_LAT + EV_GLA_LAT + EV_AP_CTX) { kind = 0; sbase = 0; x = w - EV_AP_LAT - EV_GLA_LAT; }
    else { kind = 1; sbase = 0; x = w - EV_AP_LAT - EV_GLA_LAT - EV_AP_CTX; }
    if (kind == 0) rwkv_apply_task(p, ei, sbase + x / 8, x & 7, dir, dsm);
    else gla_scan_task(p, ei, sbase + x / 4, x & 3, dir, dsm);
}

__device__ __forceinline__ void ph_fin_even(const P& p, int bid, int ei) {
    const int lane = LT & 63, t = bid * 4 + (LT >> 6);
    if (t >= T) return;
    const bf16* pr = (const bf16*)(p.ws + WS_PROJ) + (size_t)t * EW;
    const bf16* oaf = (const bf16*)(p.ws + WS_PART) + (size_t)t * 512;
    const bf16* oab = (const bf16*)(p.ws + WS_PART + PART_SZ) + (size_t)t * 512;
    const bf16* obf = (const bf16*)(p.ws + WS_PART + 2 * PART_SZ) + (size_t)t * 512;
    const bf16* obb = (const bf16*)(p.ws + WS_PART + 3 * PART_SZ) + (size_t)t * 512;
    bf16* yc = (bf16*)(p.ws + WS_HM) + (size_t)t * D;
    const int idx = lane * 8;
    {
        float o[8], ss = 0.f;
#pragma unroll
        for (int j = 0; j < 8; ++j) { o[j] = bf2f(oaf[idx + j]) + bf2f(oab[idx + j]); ss += o[j] * o[j]; }
        ss += __shfl_xor(ss, 1); ss += __shfl_xor(ss, 2); ss += __shfl_xor(ss, 4); ss += __shfl_xor(ss, 8);
        const float r = frsq(ss * (1.0f / 128.f) + EPS);
        const float* gn = p.in[I_GLAN] + ei * 128 + (idx & 127);
#pragma unroll
        for (int j = 0; j < 8; ++j) yc[idx + j] = f2bf(o[j] * r * gn[j] * siluf_(bf2f(pr[E_ZA + idx + j])));
    }
    {
        float o[8], mu = 0.f;
#pragma unroll
        for (int j = 0; j < 8; ++j) { o[j] = bf2f(obf[idx + j]) + bf2f(obb[idx + j]); mu += o[j]; }
        mu += __shfl_xor(mu, 1); mu += __shfl_xor(mu, 2); mu += __shfl_xor(mu, 4);
        mu *= (1.0f / 64.f);
        float var = 0.f;
#pragma unroll
        for (int j = 0; j < 8; ++j) { o[j] -= mu; var += o[j] * o[j]; }
        var += __shfl_xor(var, 1); var += __shfl_xor(var, 2); var += __shfl_xor(var, 4);
        const float r = frsq(var * (1.0f / 64.f) + 64e-5f);
        const int h = idx >> 6;
        const float* bn = (const float*)(p.ws + WS_BONUS) + ((size_t)t * 8 + h) * 2;
        const float bsum = bn[0] + bn[1];
        bool hl, hr; tok_nbr(t, hl, hr);
        const float* mix = p.in[I_MIX] + (size_t)ei * 1792 + FB_V + idx;
        const float* lg = p.in[I_LNG] + ei * 512 + idx;
        const float* lb = p.in[I_LNB] + ei * 512 + idx;
#pragma unroll
        for (int j = 0; j < 8; ++j) {
            const bf16* pv = pr + E_FB + FB_V + idx + j;
            const float x = bf2f(pv[0]);
            const float nl = hl ? bf2f(pv[-EW]) : 0.f, nr = hr ? bf2f(pv[EW]) : 0.f;
            const float vsh = x + mix[j] * (0.5f * (nl + nr) - x);
            yc[512 + idx + j] = f2bf((o[j] * r * lg[j] + lb[j] + bsum * vsh) * siluf_(bf2f(pr[E_ZB + idx + j])));
        }
    }
}

constexpr int ODD_PREP_ITEMS = (T / 64) * 4;
constexpr int PQ_LD = 136;
__device__ __forceinline__ void ph_odd_prep(const P& p, int item, int oi, bool stage_w, unsigned char* dsm) {
    bf16* sq = (bf16*)dsm;
    bf16* sk = sq + 64 * PQ_LD;
    float* sA = (float*)(dsm + 2 * 64 * PQ_LD * 2);
    float* sX = sA + 2 * 64 * TI_LD;
    float* sTm = sX + 2 * 64 * TI_LD;
    float* slg = sTm + 2 * 8 * 16 * TI_TLD;
    float* sbt = slg + 128;
    float* sgc = sbt + 128;
    float* sbp = sgc + 128;
    float* sCW = sbp + 128;
    const int tid = opaque_tid(), lane = tid & 63, wid = tid >> 6;
    const int cg = item >> 2, h = item & 3;
    const bf16* proj = (const bf16*)(p.ws + WS_PROJ);
    const float* cw = p.in[I_CONV] + (size_t)oi * 9 * 1536;
    LBAR();
    if (stage_w) {
        float wv[7];
#pragma unroll
        for (int u = 0; u < 7; ++u) { const int e = tid + u * 512; wv[u] = 0.f; if (e < 3456) { const int tap = e / 384, r = e % 384; wv[u] = cw[tap * 1536 + (r >> 7) * 512 + h * 128 + (r & 127)]; } }
#pragma unroll
        for (int u = 0; u < 7; ++u) { const int e = tid + u * 512; if (e < 3456) sCW[e] = wv[u]; }
        LBAR();
    }
    PT_B(40);
#pragma unroll 1
    for (int rep = 0; rep < 2; ++rep) {
        const int ur = wid + 8 * rep;
        if (ur < 12) {
            const int part = ur >> 2, oc = lane & 15, i0 = ((ur & 3) * 4 + (lane >> 4)) * 4, t0 = cg * 64;
            const bool lat = t0 >= T_CTX;
            int pos0, len;
            if (!lat) { pos0 = t0 % L_CTX; len = L_CTX; } else { pos0 = (t0 - T_CTX) % L_LAT; len = L_LAT; }
            const int gr = pos0 >> 6, nrows = len >> 6;
            const int ch = part * 512 + h * 128 + oc * 8;
            const bool okl = i0 > 0 || (!lat && pos0 > 0), okr = i0 < 60 || (!lat && pos0 + 64 < len);
            f8v acc[4];
#pragma unroll
            for (int j = 0; j < 4; ++j) acc[j] = (f8v)(0.f);
            uint4 x[3][6];
            bool rv[3];
#pragma unroll
            for (int di = -1; di <= 1; ++di) {
                rv[di + 1] = lat ? (gr + di >= 0 && gr + di < nrows) : (di == 0);
                if (rv[di + 1]) {
                    const bf16* src = proj + (size_t)(t0 + di * 64 + i0) * OW + O_QKV + ch;
                    x[di + 1][0] = *(const uint4*)(okl ? src - OW : src);
#pragma unroll
                    for (int c = 0; c < 4; ++c) x[di + 1][c + 1] = *(const uint4*)(src + (size_t)c * OW);
                    x[di + 1][5] = *(const uint4*)(okr ? src + (size_t)4 * OW : src);
                }
            }
#pragma unroll
            for (int di = -1; di <= 1; ++di) {
                if (rv[di + 1]) {
                    const float* w = sCW + ((di + 1) * 3) * 384 + part * 128 + oc * 8;
                    const f8v w0 = *(const f8v*)w, w1 = *(const f8v*)(w + 384), w2 = *(const f8v*)(w + 768);
                    if (!okl) x[di + 1][0] = make_uint4(0u, 0u, 0u, 0u);
                    if (!okr) x[di + 1][5] = make_uint4(0u, 0u, 0u, 0u);
#pragma unroll
                    for (int c = 0; c < 6; ++c) {
                        const f8v xc = unpack8v(x[di + 1][c]);
                        if (c < 4) acc[c] += xc * w0;
                        if (c >= 1 && c <= 4) acc[c - 1] += xc * w1;
                        if (c >= 2) acc[c - 2] += xc * w2;
                    }
                }
            }
            bf16* qo = (bf16*)(p.ws + WS_QKVN) + (size_t)(t0 + i0) * 1536 + ch;
            bf16* so = (part == 0 ? sq : sk) + i0 * PQ_LD + oc * 8;
#pragma unroll
            for (int j = 0; j < 4; ++j) {
                f8v a = acc[j];
                float ss = 0.f;
#pragma unroll
                for (int e = 0; e < 8; ++e) { a[e] = siluf_(a[e]); ss += a[e] * a[e]; }
                if (part < 2) {
                    ss = red16(ss);
                    float r = frsq(ss + EPS);
                    if (part == 0) r *= 0.08838834764831845f;
                    a *= r;
                }
                const uint4 pk = pack8v(a);
                *(uint4*)(qo + (size_t)j * 1536) = pk;
                if (part < 2) *(uint4*)(so + j * PQ_LD) = pk;
            }
        } else if (ur < 14) {
            const int dir = ur - 12, i = lane, t = cg * 64 + i;
            float* g = (float*)(p.ws + WS_GATES) + (size_t)t * 16;
            const float x = bf2f(proj[(size_t)t * OW + O_G + dir * 4 + h]);
            const float lgv = -fexp(p.in[I_ALOG][oi * 8 + dir * 4 + h]) * softplusf_(x + p.in[I_DTB][oi * 8 + dir * 4 + h]);
            const float bv = sigmoidf_(bf2f(proj[(size_t)t * OW + O_BETA + dir * 4 + h]));
            g[dir * 4 + h] = lgv; g[8 + dir * 4 + h] = bv;
            slg[dir * 64 + i] = lgv; sbt[dir * 64 + i] = bv;
        }
    }
    LBAR();
    PT_E(40); PT_B(41);
    if (wid < 2) {
        const int dir = wid, n = dir ? 63 - lane : lane;
        float c = slg[dir * 64 + n];
#pragma unroll
        for (int d = 1; d < 64; d <<= 1) { const float o = __shfl(c, lane >= d ? lane - d : lane); if (lane >= d) c += o; }
        sgc[dir * 64 + lane] = c; sbp[dir * 64 + lane] = sbt[dir * 64 + n];
    }
    LBAR();
    PT_E(41); PT_B(42);
    {
        const int rt = wid & 3, fr = lane & 15, fq = lane >> 4;
        f4v acc[4];
#pragma unroll
        for (int ct = 0; ct < 4; ++ct) acc[ct] = (f4v){0.f, 0.f, 0.f, 0.f};
#pragma unroll
        for (int ks = 0; ks < 4; ++ks) {
            const s8v a = *(const s8v*)((wid < 4 ? sk : sq) + (16 * rt + fr) * PQ_LD + fq * 8 + ks * 32);
#pragma unroll
            for (int ct = 0; ct < 4; ++ct) {
                const s8v bb = *(const s8v*)(sk + (16 * ct + fr) * PQ_LD + fq * 8 + ks * 32);
                acc[ct] = (wid < 4) ? mfma16(a, bb, acc[ct]) : mfma16(bb, a, acc[ct]);
            }
        }
        const size_t task0 = ((size_t)cg * 4 + h) * 2;
        bf16* qk0 = (bf16*)(p.ws + WS_QKM) + task0 * 4096; bf16* qk1 = qk0 + 4096;
        if (wid < 4) {
            float ba0[4], ga0[4], ba1[4], ga1[4];
#pragma unroll
            for (int r = 0; r < 4; ++r) { const int a = 16 * rt + fq * 4 + r, i1 = 63 - a; ba0[r] = sbp[a]; ga0[r] = sgc[a]; ba1[r] = sbp[64 + i1]; ga1[r] = sgc[64 + i1]; }
#pragma unroll
            for (int ct = 0; ct < 4; ++ct) {
                const int b = 16 * ct + fr, j1 = 63 - b;
                const float gb0 = sgc[b], gb1 = sgc[64 + j1];
#pragma unroll
                for (int r = 0; r < 4; ++r) {
                    const int a = 16 * rt + fq * 4 + r, i1 = 63 - a;
                    const float v = acc[ct][r];
                    sA[a * TI_LD + b] = b < a ? ba0[r] * v * fexp(ga0[r] - gb0) : 0.f;
                    sA[64 * TI_LD + i1 * TI_LD + j1] = b > a ? ba1[r] * v * fexp(ga1[r] - gb1) : 0.f;
                }
            }
        } else {
            const int a = 16 * rt + fr, i1 = 63 - a;
            const float ga0 = sgc[a], ga1 = sgc[64 + i1];
#pragma unroll
            for (int ct = 0; ct < 4; ++ct) {
                const int b0 = 16 * ct + fq * 4;
                f4v v0, v1;
#pragma unroll
                for (int r = 0; r < 4; ++r) {
                    const int b = b0 + r, j1 = 63 - b;
                    const float v = acc[ct][r];
                    v0[r] = b <= a ? v * fexp(ga0 - sgc[b]) : 0.f;
                    v1[3 - r] = b >= a ? v * fexp(ga1 - sgc[64 + j1]) : 0.f;
                }
                *(uint2*)(qk0 + a * 64 + b0) = pack4(v0);
                *(uint2*)(qk1 + i1 * 64 + 60 - b0) = pack4(v1);
            }
        }
    }
    LBAR();
    PT_E(42); PT_B(43);
    if (wid == 2) {
        float* gco = (float*)(p.ws + WS_GC) + ((size_t)cg * 4 + h) * 128;
        gco[lane] = sgc[lane]; gco[64 + lane] = sgc[64 + lane];
    }
    tri_inv64(sA + (wid >> 2) * 64 * TI_LD, sX + (wid >> 2) * 64 * TI_LD, sTm + (wid >> 2) * 8 * 16 * TI_TLD, wid & 3, lane, true);
    PT_E(43); PT_B(44);
    {
        const int dir = tid >> 8, i = (tid >> 2) & 63, c16 = (tid & 3) * 16;
        const float* xs = sX + dir * 64 * TI_LD + i * TI_LD + c16;
        bf16* ti = (bf16*)(p.ws + WS_TINV) + (((size_t)cg * 4 + h) * 2 + dir) * 4096 + i * 64 + c16;
        *(uint4*)ti = pack8v(*(const f8v*)xs); *(uint4*)(ti + 8) = pack8v(*(const f8v*)(xs + 8));
    }
    PT_E(44);
}

constexpr int G_LDS = 136, G_LDT = 72;
__device__ __forceinline__ void gdn_scan_task(const P& p, int oi, int s, int h, int dir, unsigned char* dsm) {
    bf16* St = (bf16*)dsm;
    unsigned char* Kb = (unsigned char*)(St + 128 * G_LDS);
    unsigned char* Qb = Kb + 2 * 16384;
    bf16* dTe = (bf16*)(Qb + 16384);
    bf16* rT = dTe + 128 * G_LDT;
    bf16* dT = rT + 128 * G_LDT;
    bf16* Vc = dT;
    bf16* Ti = dT + 128 * G_LDT;
    bf16* Qk = Ti + 64 * G_LDT;
    float* sgc = (float*)(Qk + 64 * G_LDT);
    float* sbt = sgc + 64;
    const Seq sq_ = get_seq(s);
    const int tid = opaque_tid(), lane = tid & 63, wid = tid >> 6, fr = lane & 15, fq = lane >> 4;
    const int rt = wid & 3, chf = wid >> 2;
    const bf16* qkvn = (const bf16*)(p.ws + WS_QKVN);
    const float* gates = (const float*)(p.ws + WS_GATES);
    bf16* opart = (bf16*)(p.ws + WS_PART + (size_t)dir * PART_SZ);
    f4v Sacc[8];
    LBAR();
    if (sq_.lat) {
        const float* s0 = p.in[I_SGDN] + ((((size_t)sq_.b * N_ODD + oi) * 2 + dir) * 4 + h) * 128 * 128;
#pragma unroll
        for (int ct = 0; ct < 8; ++ct)
#pragma unroll
            for (int r = 0; r < 4; ++r) Sacc[ct][r] = s0[(16 * wid + fq * 4 + r) * 128 + 16 * ct + fr];
    } else {
#pragma unroll
        for (int ct = 0; ct < 8; ++ct) Sacc[ct] = (f4v){0.f, 0.f, 0.f, 0.f};
    }
#pragma unroll
    for (int ct = 0; ct < 8; ++ct) *(uint2*)(St + (16 * ct + fr) * G_LDS + 16 * wid + fq * 4) = make_uint2(pack2(Sacc[ct][0], Sacc[ct][1]), pack2(Sacc[ct][2], Sacc[ct][3]));
    const int nch = sq_.len >> 6;
    uint4 pw0, pw1, pti, pqk; float pgi, pgl, pbt = 0.f;
    const int wu = RFL(wid);
#define GDN_OFF(R, C) ((((C) >> 6) * 8192) + pg8::lds_byte((R), (C) & 63))
#define GDN_DMA(CG, COLOFF, DST) do { _Pragma("unroll") for (int u_ = 0; u_ < 2; ++u_) { const int s16_ = wu * 2 + u_, half_ = s16_ >> 3, sub_ = s16_ & 7; int R_, C_; pg8::stage_rc(sub_ * 1024 + lane * 16, R_, C_); \
        GLDS16(qkvn + (size_t)((CG) * 64 + (dir ? 63 - R_ : R_)) * 1536 + (COLOFF) + h * 128 + half_ * 64 + C_, (DST) + half_ * 8192 + sub_ * 1024); } } while (0)
#define GDN_FETCH(CG) do { const size_t task_ = ((size_t)(CG) * 4 + h) * 2 + dir; const int t_ = (CG) * 64 + (dir ? 63 - lane : lane); \
        { const int c8_ = (tid & 15) * 8, i0_ = tid >> 4, i1_ = i0_ + 32;     \
          const bf16* s0_ = qkvn + (size_t)((CG) * 64 + (dir ? 63 - i0_ : i0_)) * 1536 + h * 128 + c8_; const bf16* s1_ = qkvn + (size_t)((CG) * 64 + (dir ? 63 - i1_ : i1_)) * 1536 + h * 128 + c8_; \
          pw0 = *(const uint4*)(s0_ + 1024); pw1 = *(const uint4*)(s1_ + 1024); } \
        { const int i2_ = tid >> 3, c8_ = (tid & 7) * 8; typedef unsigned u4n_ __attribute__((ext_vector_type(4))); const u4n_ a_ = __builtin_nontemporal_load((const u4n_*)((const bf16*)(p.ws + WS_TINV) + task_ * 4096 + i2_ * 64 + c8_)), b_ = __builtin_nontemporal_load((const u4n_*)((const bf16*)(p.ws + WS_QKM) + task_ * 4096 + i2_ * 64 + c8_)); pti = make_uint4(a_[0], a_[1], a_[2], a_[3]); pqk = make_uint4(b_[0], b_[1], b_[2], b_[3]); } \
        const float* gcp_ = (const float*)(p.ws + WS_GC) + task_ * 64; pgi = gcp_[lane]; pgl = gcp_[63]; \
        if (tid < 64) pbt = gates[(size_t)((CG) * 64 + (dir ? 63 - tid : tid)) * 16 + 8 + dir * 4 + h]; } while (0)
    GDN_DMA((sq_.start >> 6) + (dir ? nch - 1 : 0), 512, Kb);
    GDN_DMA((sq_.start >> 6) + (dir ? nch - 1 : 0), 0, Qb);
    GDN_FETCH((sq_.start >> 6) + (dir ? nch - 1 : 0));
    for (int cc = 0; cc < nch; ++cc) {
        const int cl = dir ? nch - 1 - cc : cc;
        const int cg = (sq_.start >> 6) + cl;
        const unsigned char* Kc = Kb + (cc & 1) * 16384;
        PT_B(61);
        PG_WAIT_V(0);
        {
            {
                const int c8 = (tid & 15) * 8, i0 = tid >> 4, i1 = i0 + 32;
                *(uint4*)(Vc + i0 * G_LDS + c8) = pw0; *(uint4*)(Vc + i1 * G_LDS + c8) = pw1;
            }
            { const int i2 = tid >> 3, c8 = (tid & 7) * 8; *(uint4*)(Ti + i2 * G_LDT + c8) = pti; *(uint4*)(Qk + i2 * G_LDT + c8) = pqk; }
            if (tid < 64) { sgc[tid] = pgi; sbt[tid] = pbt; }
            if (cc + 1 < nch) { const int cln = dir ? nch - 2 - cc : cc + 1; GDN_DMA((sq_.start >> 6) + cln, 512, Kb + ((cc + 1) & 1) * 16384); GDN_FETCH((sq_.start >> 6) + cln); }
        }
        LBAR();
        PT_E(61); PT_B(62);
        f4v oacc[4];
        {
            f4v kS[4], qS[4];
#pragma unroll
            for (int ct = 0; ct < 4; ++ct) { kS[ct] = (f4v){0.f, 0.f, 0.f, 0.f}; qS[ct] = (f4v){0.f, 0.f, 0.f, 0.f}; }
            const bf16* vlp = Vc + (16 * rt + 4 * fq + (fr >> 2)) * G_LDS + 64 * chf + 4 * (fr & 3);
            u64t vt0 = tr_rd<0>(vlp), vt1 = tr_rd<32>(vlp), vt2 = tr_rd<64>(vlp), vt3 = tr_rd<96>(vlp);
#pragma unroll
            for (int ks = 0; ks < 4; ++ks) {
                const s8v ak = *(const s8v*)(Kc + GDN_OFF(16 * rt + fr, ks * 32 + fq * 8));
                const s8v aq = *(const s8v*)(Qb + GDN_OFF(16 * rt + fr, ks * 32 + fq * 8));
#pragma unroll
                for (int ct = 0; ct < 4; ++ct) {
                    const s8v bb = *(const s8v*)(St + (64 * chf + 16 * ct + fr) * G_LDS + ks * 32 + fq * 8);
                    kS[ct] = mfma16(ak, bb, kS[ct]);
                    qS[ct] = mfma16(bb, aq, qS[ct]);
                }
            }
            float eg[4], bt[4];
#pragma unroll
            for (int r = 0; r < 4; ++r) { const int i = 16 * rt + fq * 4 + r; eg[r] = fexp(sgc[i]); bt[r] = sbt[i]; }
            const float egc = fexp(sgc[16 * rt + fr]);
            TR_WAIT4(vt0, vt1, vt2, vt3);
#pragma unroll
            for (int ct = 0; ct < 4; ++ct) {
                const int dv = 64 * chf + 16 * ct + fr;
                const f4v vv4 = unpack4(__builtin_bit_cast(uint2, ct == 0 ? vt0 : ct == 1 ? vt1 : ct == 2 ? vt2 : vt3));
                float rv[4];
#pragma unroll
                for (int r = 0; r < 4; ++r) { rv[r] = bt[r] * (vv4[r] - eg[r] * kS[ct][r]); oacc[ct][r] = egc * qS[ct][r]; }
                *(uint2*)(rT + dv * G_LDT + 16 * rt + fq * 4) = make_uint2(pack2(rv[0], rv[1]), pack2(rv[2], rv[3]));
            }
        }
        LBAR();
        PT_E(62); PT_B(63);
        if (cc + 1 < nch) { const int cln = dir ? nch - 2 - cc : cc + 1; GDN_DMA((sq_.start >> 6) + cln, 0, Qb); }
        {
            f4v dl[4];
#pragma unroll
            for (int ct = 0; ct < 4; ++ct) dl[ct] = (f4v){0.f, 0.f, 0.f, 0.f};
#pragma unroll
            for (int ks = 0; ks < 2; ++ks) {
                const s8v a = *(const s8v*)(Ti + (16 * rt + fr) * G_LDT + ks * 32 + fq * 8);
#pragma unroll
                for (int ct = 0; ct < 4; ++ct) { const s8v bb = *(const s8v*)(rT + (64 * chf + 16 * ct + fr) * G_LDT + ks * 32 + fq * 8); dl[ct] = mfma16(a, bb, dl[ct]); }
            }
            float se[4];
            { const float gl = sgc[63];
#pragma unroll
              for (int r = 0; r < 4; ++r) se[r] = fexp(gl - sgc[16 * rt + fq * 4 + r]); }
#pragma unroll
            for (int ct = 0; ct < 4; ++ct) { const int dv = 64 * chf + 16 * ct + fr;
                *(uint2*)(dT + dv * G_LDT + 16 * rt + fq * 4) = make_uint2(pack2(dl[ct][0], dl[ct][1]), pack2(dl[ct][2], dl[ct][3]));
                *(uint2*)(dTe + dv * G_LDT + 16 * rt + fq * 4) = make_uint2(pack2(dl[ct][0] * se[0], dl[ct][1] * se[1]), pack2(dl[ct][2] * se[2], dl[ct][3] * se[3])); }
        }
        LBAR();
        PT_E(63); PT_B(64);
        {
            s8v ktf[2];
            {
                const int tq = 8 * fq + (fr >> 2), c4 = 16 * wid + 4 * (fr & 3);
                u64t ka0 = tr_rd<0>((const bf16*)(Kc + GDN_OFF(tq, c4))), ka1 = tr_rd<0>((const bf16*)(Kc + GDN_OFF(tq + 4, c4)));
                u64t kb0 = tr_rd<0>((const bf16*)(Kc + GDN_OFF(32 + tq, c4))), kb1 = tr_rd<0>((const bf16*)(Kc + GDN_OFF(32 + tq + 4, c4)));
                TR_WAIT4(ka0, ka1, kb0, kb1);
                ktf[0] = tr_pair(ka0, ka1); ktf[1] = tr_pair(kb0, kb1);
            }
#pragma unroll
            for (int ks = 0; ks < 2; ++ks) {
                const s8v a = *(const s8v*)(Qk + (16 * rt + fr) * G_LDT + ks * 32 + fq * 8);
#pragma unroll
                for (int ct = 0; ct < 4; ++ct) { const s8v bb = *(const s8v*)(dT + (64 * chf + 16 * ct + fr) * G_LDT + ks * 32 + fq * 8); oacc[ct] = mfma16(bb, a, oacc[ct]); }
            }
            {
                const int i = 16 * rt + fr, t = cg * 64 + (dir ? 63 - i : i);
#pragma unroll
                for (int ct = 0; ct < 4; ++ct) *(uint2*)(opart + (size_t)t * 512 + h * 128 + 64 * chf + 16 * ct + fq * 4) = pack4(oacc[ct]);
            }
            const float ge = fexp(sgc[63]);
#pragma unroll
            for (int ct = 0; ct < 8; ++ct) Sacc[ct] *= ge;
#pragma unroll
            for (int ks = 0; ks < 2; ++ks) {
                const s8v a = ktf[ks];
#pragma unroll
                for (int ct = 0; ct < 8; ++ct) { const s8v bb = *(const s8v*)(dTe + (16 * ct + fr) * G_LDT + ks * 32 + fq * 8); Sacc[ct] = mfma16(a, bb, Sacc[ct]); }
            }
#pragma unroll
            for (int ct = 0; ct < 8; ++ct) *(uint2*)(St + (16 * ct + fr) * G_LDS + 16 * wid + fq * 4) = make_uint2(pack2(Sacc[ct][0], Sacc[ct][1]), pack2(Sacc[ct][2], Sacc[ct][3]));
        }
        LBAR();
        PT_E(64);
    }
    if (!sq_.lat) {
        float* fs = p.out + OUT_GDN + ((((size_t)sq_.b * N_ODD + oi) * 2 + dir) * 4 + h) * 128 * 128;
#pragma unroll
        for (int ct = 0; ct < 8; ++ct)
#pragma unroll
            for (int r = 0; r < 4; ++r) fs[(16 * wid + fq * 4 + r) * 128 + 16 * ct + fr] = Sacc[ct][r];
    }
}
constexpr int S5_HLD = 136;
constexpr int S5_ITEMS = 2 * 32 * 2;
__device__ __forceinline__ void s5_task(const P& p, int oi, int dir, int g, int set, unsigned char* dsm) {
    float* sPr = (float*)dsm;
    float* sPi = sPr + 17 * 64;
    float* sBr = sPi + 17 * 64;
    float* sBi = sBr + 1024;
    constexpr int S5_CLD = 68;
    float* sCr = sBi + 1024;
    float* sCi = sCr + 16 * S5_CLD;
    bf16* sK = (bf16*)(sCi + 16 * S5_CLD);
    bf16* HT = sK + 4096;
    bf16* sG = HT + 2 * 16 * S5_HLD;
    bf16* UT = sG + 256 * S5_HLD;
    bf16* sG0 = UT + 2 * 16 * 264;
    bf16* BT = sG0 + 16 * S5_HLD;
    bf16* YS = BT + 16 * S5_HLD;
    const int tid = opaque_tid(), lane = tid & 63, wid = tid >> 6, fr = lane & 15, fq = lane >> 4;
    const int nseq = set ? NB_CTX : NB_LAT, sbase = set ? 0 : NB_CTX, len = set ? L_CTX : L_LAT;
    const bf16* proj = (const bf16*)(p.ws + WS_PROJ);
    bf16* ypart = (bf16*)(p.ws + WS_PART + (size_t)(2 + dir) * PART_SZ);
    const size_t pg = ((size_t)(oi * 2 + dir) * 32 + g);
    LBAR();
    const int st = tid >> 3, c0 = (tid & 7) * 2;
    {
        const float are_b = fminf(p.in[I_S5AR][pg * 64 + st], -1e-4f), aim_b = p.in[I_S5AI][pg * 64 + st];
        const float br0 = p.in[I_S5BR][(pg * 64 + st) * 16 + c0], br1 = p.in[I_S5BR][(pg * 64 + st) * 16 + c0 + 1];
        const float bi0 = p.in[I_S5BI][(pg * 64 + st) * 16 + c0], bi1 = p.in[I_S5BI][(pg * 64 + st) * 16 + c0 + 1];
        const float cr0 = p.in[I_S5CR][pg * 1024 + tid], cr1 = p.in[I_S5CR][pg * 1024 + 512 + tid], ci0 = p.in[I_S5CI][pg * 1024 + tid], ci1 = p.in[I_S5CI][pg * 1024 + 512 + tid];
        if (tid < 64) {
            const float are = fminf(p.in[I_S5AR][pg * 64 + tid], -1e-4f), aim = p.in[I_S5AI][pg * 64 + tid];
            const float dt = expf(p.in[I_S5DT][pg]);
            const float mag = expf(are * dt), ar = mag * cosf(aim * dt), ai = mag * sinf(aim * dt);
            float pr = 1.f, pi = 0.f;
            for (int j = 0; j <= 16; ++j) { sPr[j * 64 + tid] = pr; sPi[j * 64 + tid] = pi; const float nr = pr * ar - pi * ai, ni = pr * ai + pi * ar; pr = nr; pi = ni; }
        }
        sCr[(tid >> 6) * S5_CLD + (tid & 63)] = cr0; sCr[(8 + (tid >> 6)) * S5_CLD + (tid & 63)] = cr1;
        sCi[(tid >> 6) * S5_CLD + (tid & 63)] = ci0; sCi[(8 + (tid >> 6)) * S5_CLD + (tid & 63)] = ci1;
        LBAR();
        const float ar = sPr[64 + st], ai = sPi[64 + st];
        const float den = are_b * are_b + aim_b * aim_b;
        const float fre = ((ar - 1.0f) * are_b + ai * aim_b) / den, fim = (ai * are_b - (ar - 1.0f) * aim_b) / den;
        const float v0r = fre * br0 - fim * bi0, v0i = fre * bi0 + fim * br0, v1r = fre * br1 - fim * bi1, v1i = fre * bi1 + fim * br1;
        sBr[st * 16 + c0] = v0r; sBi[st * 16 + c0] = v0i; sBr[st * 16 + c0 + 1] = v1r; sBi[st * 16 + c0 + 1] = v1i;
        BT[c0 * S5_HLD + st] = f2bf(v0r); BT[c0 * S5_HLD + 64 + st] = f2bf(v0i); BT[(c0 + 1) * S5_HLD + st] = f2bf(v1r); BT[(c0 + 1) * S5_HLD + 64 + st] = f2bf(v1i);
    }
    {
        for (int rr = tid >> 1; rr < 272; rr += 256) {
            const int tt = rr >> 4, co = rr & 15, half = tid & 1, pw = tt == 16 ? 0 : tt + 1;
            bf16* dst = (tt == 16 ? sG0 + co * S5_HLD : sG + rr * S5_HLD) + half * 64;
#pragma unroll 2
            for (int q0 = 0; q0 < 64; q0 += 8) {
                const f8v cr = *(const f8v*)(sCr + co * S5_CLD + q0), ci = *(const f8v*)(sCi + co * S5_CLD + q0);
                const f8v pr = *(const f8v*)(sPr + pw * 64 + q0), pi = *(const f8v*)(sPi + pw * 64 + q0);
                const f8v v = half ? -(cr * pi + ci * pr) : cr * pr - ci * pi;
                *(uint4*)(dst + q0) = pack8v(v);
            }
        }
    }
    LBAR();
    {
#pragma unroll
        for (int u = 0; u < 2; ++u) {
            const int L = 2 * wid + u;
            const bf16* At_ = (L == 0) ? sG0 : sG + (L - 1) * 16 * S5_HLD;
            f4v acc = (f4v){0.f, 0.f, 0.f, 0.f};
#pragma unroll
            for (int ks = 0; ks < 4; ++ks) acc = mfma16(*(const s8v*)(At_ + fr * S5_HLD + 32 * ks + 8 * fq), *(const s8v*)(BT + fr * S5_HLD + 32 * ks + 8 * fq), acc);
#pragma unroll
            for (int r = 0; r < 4; ++r) sK[(L * 16 + 4 * fq + r) * 16 + fr] = f2bf(acc[r]);
        }
    }
    LBAR();
    const int sp = fq >> 1, cih = (fq & 1) * 8;
    const int nsteps = len >> 4;
    constexpr int S5_ULD = 264;
    const int un = (tid & 255) >> 4, us = tid & 15;
    const bf16* ubase = proj + (size_t)get_seq(sbase + (un < nseq ? un : 0)).start * OW + O_U + g * 16;
    bf16* ybase = ypart + (size_t)get_seq(sbase + (un < nseq ? un : 0)).start * 512 + g * 16;
#define S5_UADDR(K) (ubase + (size_t)(dir ? len - 1 - (16 * (K) + us) : 16 * (K) + us) * OW)
#define S5_UPUT(K, QA, QB) do { bf16* d_ = UT + ((K) & 1) * 16 * S5_ULD + un * S5_ULD + us * 16; *(uint4*)d_ = QA; *(uint4*)(d_ + 8) = QB; } while (0)
#define S5_ULOAD(K) const bf16* up_ = UT + ((K) & 1) * 16 * S5_ULD + fr * S5_ULD + 8 * fq; \
        const s8v u0 = *(const s8v*)up_, u1 = *(const s8v*)(up_ + 32), u2 = *(const s8v*)(up_ + 64), u3 = *(const s8v*)(up_ + 96), \
                  u4 = *(const s8v*)(up_ + 128), u5 = *(const s8v*)(up_ + 160), u6 = *(const s8v*)(up_ + 192), u7 = *(const s8v*)(up_ + 224)
    if (wid < 4) {
        s8v wre[8], wim[8];
        {
            const int pp = 16 * wid + fr;
#pragma unroll
            for (int m = 0; m < 8; ++m) {
                const int sidx = 15 - (2 * m + sp);
                const float pr = sPr[sidx * 64 + pp], pi = sPi[sidx * 64 + pp];
#pragma unroll
                for (int j = 0; j < 8; ++j) {
                    const float br = sBr[pp * 16 + cih + j], bi = sBi[pp * 16 + cih + j];
                    wre[m][j] = (short)f2bf(pr * br - pi * bi); wim[m][j] = (short)f2bf(pr * bi + pi * br);
                }
            }
        }
        float a16r[4], a16i[4], hr[4], hi[4];
#pragma unroll
        for (int r = 0; r < 4; ++r) {
            const int pp = 16 * wid + fq * 4 + r;
            a16r[r] = sPr[16 * 64 + pp]; a16i[r] = sPi[16 * 64 + pp];
            hr[r] = 0.f; hi[r] = 0.f;
            if (set == 0 && fr < nseq) { const size_t o = (((size_t)fr * N_ODD + oi) * 2 + dir) * 32 * 64 + g * 64 + pp; hr[r] = p.in[I_SS5R][o]; hi[r] = p.in[I_SS5I][o]; }
        }
        *(uint2*)(HT + fr * S5_HLD + 16 * wid + fq * 4) = make_uint2(pack2(hr[0], hr[1]), pack2(hr[2], hr[3]));
        *(uint2*)(HT + fr * S5_HLD + 64 + 16 * wid + fq * 4) = make_uint2(pack2(hi[0], hi[1]), pack2(hi[2], hi[3]));
        uint4 qa0, qb0, qa1, qb1, qa2, qb2, qa3, qb3;
        { const bf16* a_ = S5_UADDR(0); qa0 = *(const uint4*)a_; qb0 = *(const uint4*)(a_ + 8); S5_UPUT(0, qa0, qb0); }
#define S5_QLOAD(K, QA, QB) do { if ((K) < nsteps) { const bf16* a_ = S5_UADDR(K); QA = *(const uint4*)a_; QB = *(const uint4*)(a_ + 8); } } while (0)
        S5_QLOAD(1, qa1, qb1); S5_QLOAD(2, qa2, qb2); S5_QLOAD(3, qa3, qb3); S5_QLOAD(4, qa0, qb0);
        LBAR();
#define S5_YFLUSH(KK) do { if (un < nseq) { const bf16* ys_ = YS + ((KK) & 1) * 4096 + (us * 16 + un) * 16; const uint4 ya_ = *(const uint4*)ys_, yb_ = *(const uint4*)(ys_ + 8); \
            const int pos_ = 16 * (KK) + us; bf16* yd_ = ybase + (size_t)(dir ? len - 1 - pos_ : pos_) * 512; *(uint4*)yd_ = ya_; *(uint4*)(yd_ + 8) = yb_; } } while (0)
#define S5_STATE_STEP(K, QA, QB) do { \
            const int k = (K); \
            S5_ULOAD(k); \
            if (k + 1 < nsteps) { S5_UPUT(k + 1, QA, QB); S5_QLOAD(k + 5, QA, QB); } \
            f4v zr = (f4v){0.f, 0.f, 0.f, 0.f}, zi = zr; \
            zr = mfma16(wre[0], u0, zr); zi = mfma16(wim[0], u0, zi); zr = mfma16(wre[1], u1, zr); zi = mfma16(wim[1], u1, zi); \
            zr = mfma16(wre[2], u2, zr); zi = mfma16(wim[2], u2, zi); zr = mfma16(wre[3], u3, zr); zi = mfma16(wim[3], u3, zi); \
            zr = mfma16(wre[4], u4, zr); zi = mfma16(wim[4], u4, zi); zr = mfma16(wre[5], u5, zr); zi = mfma16(wim[5], u5, zi); \
            zr = mfma16(wre[6], u6, zr); zi = mfma16(wim[6], u6, zi); zr = mfma16(wre[7], u7, zr); zi = mfma16(wim[7], u7, zi); \
            if (k > 0) S5_YFLUSH(k - 1);     \
            _Pragma("unroll") for (int r = 0; r < 4; ++r) { const float nr = a16r[r] * hr[r] - a16i[r] * hi[r] + zr[r], ni = a16r[r] * hi[r] + a16i[r] * hr[r] + zi[r]; hr[r] = nr; hi[r] = ni; } \
            bf16* hb = HT + ((k + 1) & 1) * 16 * S5_HLD; \
            *(uint2*)(hb + fr * S5_HLD + 16 * wid + fq * 4) = make_uint2(pack2(hr[0], hr[1]), pack2(hr[2], hr[3])); \
            *(uint2*)(hb + fr * S5_HLD + 64 + 16 * wid + fq * 4) = make_uint2(pack2(hi[0], hi[1]), pack2(hi[2], hi[3])); \
            { PT_B(70); LBAR(); PT_E(70); } } while (0)
        PT_B(71);
        for (int k4 = 0; k4 < nsteps; k4 += 4) {
            S5_STATE_STEP(k4, qa1, qb1); S5_STATE_STEP(k4 + 1, qa2, qb2); S5_STATE_STEP(k4 + 2, qa3, qb3); S5_STATE_STEP(k4 + 3, qa0, qb0);
        }
        PT_E(71);
        S5_YFLUSH(nsteps - 1);
        if (set == 1 && fr < nseq) {
#pragma unroll
            for (int r = 0; r < 4; ++r) { const size_t o = (((size_t)fr * N_ODD + oi) * 2 + dir) * 32 * 64 + g * 64 + 16 * wid + fq * 4 + r; p.out[OUT_S5R + o] = hr[r]; p.out[OUT_S5I + o] = hi[r]; }
        }
    } else {
        const int w4 = RFL(wid) - 4;
        s8v klr[14];
#pragma unroll
        for (int e = 0; e < 14; ++e) { const int lg = w4 - sp + 2 * (e - 7); klr[e] = (lg >= 0 && lg < 16) ? *(const s8v*)(sK + (lg * 16 + fr) * 16 + cih) : (s8v){0, 0, 0, 0, 0, 0, 0, 0}; }
        s8v gfr[4][4];
#pragma unroll
        for (int j = 0; j < 4; ++j)
#pragma unroll
            for (int ks = 0; ks < 4; ++ks) gfr[j][ks] = *(const s8v*)(sG + ((w4 + 4 * j) * 16 + fr) * S5_HLD + 8 * fq + 32 * ks);
        LBAR();
        for (int k = 0; k < nsteps; ++k) {
            S5_ULOAD(k);
            const bf16* hb = HT + (k & 1) * 16 * S5_HLD + fr * S5_HLD + 8 * fq;
            const s8v h0 = *(const s8v*)hb, h1 = *(const s8v*)(hb + 32), h2 = *(const s8v*)(hb + 64), h3 = *(const s8v*)(hb + 96);
            f4v y0 = (f4v){0.f, 0.f, 0.f, 0.f}, y1 = y0, y2 = y0, y3 = y0;
            {
#define S5_KJ(J, M, U, Y) Y = mfma16(klr[2 * (J) - (M) + 7], U, Y)
                S5_KJ(0, 0, u0, y0); S5_KJ(1, 0, u0, y1); S5_KJ(2, 0, u0, y2); S5_KJ(3, 0, u0, y3);
                S5_KJ(0, 1, u1, y0); S5_KJ(1, 1, u1, y1); S5_KJ(2, 1, u1, y2); S5_KJ(3, 1, u1, y3);
                S5_KJ(1, 2, u2, y1); S5_KJ(2, 2, u2, y2); S5_KJ(3, 2, u2, y3);
                S5_KJ(1, 3, u3, y1); S5_KJ(2, 3, u3, y2); S5_KJ(3, 3, u3, y3);
                S5_KJ(2, 4, u4, y2); S5_KJ(3, 4, u4, y3);
                S5_KJ(2, 5, u5, y2); S5_KJ(3, 5, u5, y3);
                S5_KJ(3, 6, u6, y3);
                S5_KJ(3, 7, u7, y3);
#define S5_G4(KS, H) do { y0 = mfma16(gfr[0][KS], H, y0); y1 = mfma16(gfr[1][KS], H, y1); y2 = mfma16(gfr[2][KS], H, y2); y3 = mfma16(gfr[3][KS], H, y3); } while (0)
                S5_G4(0, h0); S5_G4(1, h1); S5_G4(2, h2); S5_G4(3, h3);
            }
            {
#define S5_ST(J, Y) *(uint2*)(YS + (k & 1) * 4096 + ((w4 + 4 * (J)) * 16 + fr) * 16 + fq * 4) = pack4(Y)
                S5_ST(0, y0); S5_ST(1, y1); S5_ST(2, y2); S5_ST(3, y3);
            }
            LBAR();
        }
    }
}
constexpr int ODD_GDN_ITEMS = NSEQ * 8;
constexpr int ODD_SCAN_ITEMS = ODD_GDN_ITEMS + S5_ITEMS;
__device__ __forceinline__ void ph_odd_scan_item(const P& p, int w, int oi, float* smem_full) {
    unsigned char* dsm = (unsigned char*)smem_full;
    const int nlg = NB_LAT * 8, ncg = NB_CTX * 8;
    if (w < ncg) { gdn_scan_task(p, oi, w / 8, (w % 8) >> 1, w & 1, dsm); return; }
    w -= ncg;
    if (w < 64) { __syncthreads(); s5_task(p, oi, w >> 5, w & 31, 0, dsm); return; }
    w -= 64;
    if (w < nlg) { gdn_scan_task(p, oi, NB_CTX + w / 8, (w % 8) >> 1, w & 1, dsm); return; }
    w -= nlg;
    __syncthreads(); s5_task(p, oi, w >> 5, w & 31, 1, dsm);
}
__device__ __forceinline__ void ph_fin_odd_a(const P& p, int bid, int oi) {
    const int lane = LT & 63, tb = bid * (4 * NTW) + (LT >> 6) * NTW;
    if (tb >= T) return;
    const int idx = lane * 8;
    uint4 vyf[NTW], vyb[NTW], vu[NTW];
#pragma unroll
    for (int u = 0; u < NTW; ++u) {
        const size_t t = (size_t)((tb + u < T) ? tb + u : T - 1);
        vyf[u] = *(const uint4*)((const bf16*)(p.ws + WS_PART + 2 * PART_SZ) + t * 512 + idx);
        vyb[u] = *(const uint4*)((const bf16*)(p.ws + WS_PART + 3 * PART_SZ) + t * 512 + idx);
        vu[u] = *(const uint4*)((const bf16*)(p.ws + WS_PROJ) + t * OW + O_U + idx);
    }
    const f8v dsk = *(const f8v*)(p.in[I_S5D] + oi * 512 + idx);
#pragma unroll
    for (int u = 0; u < NTW; ++u) {
        const size_t t = (size_t)(tb + u); if (tb + u >= T) break;
        f8v y = unpack8v(vyf[u]) + unpack8v(vyb[u]) + dsk * unpack8v(vu[u]);
#pragma unroll
        for (int j = 0; j < 8; ++j) y[j] = gelu_tanh(y[j]);
        *(uint4*)((bf16*)(p.ws + WS_PART + 2 * PART_SZ) + t * 512 + idx) = pack8v(y);
    }
}
__device__ __forceinline__ void ph_fin_odd_gdn(const P& p, int bid, int oi) {
    const int lane = LT & 63, tb = bid * (4 * NTW) + (LT >> 6) * NTW;
    if (tb >= T) return;
    const int idx = lane * 8;
    uint4 vof[NTW], vob[NTW], vzc[NTW];
#pragma unroll
    for (int u = 0; u < NTW; ++u) {
        const size_t t = (size_t)((tb + u < T) ? tb + u : T - 1);
        vof[u] = *(const uint4*)((const bf16*)(p.ws + WS_PART) + t * 512 + idx);
        vob[u] = *(const uint4*)((const bf16*)(p.ws + WS_PART + PART_SZ) + t * 512 + idx);
        vzc[u] = *(const uint4*)((const bf16*)(p.ws + WS_PROJ) + t * OW + O_ZC + idx);
    }
    const f8v gn = *(const f8v*)(p.in[I_GDNN] + oi * 128 + (idx & 127));
#pragma unroll
    for (int u = 0; u < NTW; ++u) {
        const size_t t = (size_t)(tb + u); if (tb + u >= T) break;
        f8v o = unpack8v(vof[u]) + unpack8v(vob[u]);
        float ss = 0.f;
#pragma unroll
        for (int j = 0; j < 8; ++j) ss += o[j] * o[j];
        ss = red16(ss);
        const float r = frsq(ss * (1.0f / 128.f) + EPS);
        const f8v zc = unpack8v(vzc[u]);
#pragma unroll
        for (int j = 0; j < 8; ++j) o[j] = o[j] * r * gn[j] * siluf_(zc[j]);
        *(uint4*)((bf16*)(p.ws + WS_HM) + t * D + idx) = pack8v(o);
    }
}
__device__ __forceinline__ void ph_fin_odd_b(const P& p, int bid, int oi) {
    const size_t e = ((size_t)bid * 256 + LT) * 4;
    if (e >= (size_t)T * 512) return;
    const int t = (int)(e >> 9), idx = (int)(e & 511);
    const bf16* pr = (const bf16*)(p.ws + WS_PROJ) + (size_t)t * OW;
    const bf16* gl = (const bf16*)(p.ws + WS_PART + 2 * PART_SZ) + (size_t)t * 512;
    bf16* yc = (bf16*)(p.ws + WS_HM) + (size_t)t * D + 512;
#pragma unroll
    for (int j = 0; j < 4; ++j) {
        const float ys = bf2f(yc[idx + j]);
        yc[idx + j] = f2bf(ys * sigmoidf_(bf2f(gl[idx + j]) + p.in[I_GLUB][oi * 512 + idx + j]) * siluf_(bf2f(pr[O_ZD + idx + j])));
    }
}

enum { PK_PREP0, PK_HMOD0, PK_GEMM_IN, PK_EVEN_SCAN, PK_FIN_EVEN, PK_ODD_PREP, PK_ODD_SCAN, PK_FIN_ODD_A, PK_GEMM_GLU, PK_FIN_ODD_B, PK_GEMM_OUT, PK_POST, PK_RWKV_PREP0, PK_RWKV_PREP1, PK_EVEN_SCAN1 };
constexpr int NPH = 2 + (DEPTH / 2) * 14;
constexpr int TOKB = (T + 3) / 4;
static_assert(DEPTH % 2 == 0, "even depth expected");
__host__ __device__ inline void phase_desc(int ph, int& kind, int& layer) {
    if (ph == 0) { kind = PK_PREP0; layer = 0; return; }
    if (ph == 1) { kind = PK_HMOD0; layer = 0; return; }
    ph -= 2;
    const int pair = ph / 14, r = ph % 14;
    if (r < 7) { layer = 2 * pair; kind = r == 0 ? PK_GEMM_IN : r == 1 ? PK_RWKV_PREP0 : r == 2 ? PK_EVEN_SCAN : r == 3 ? PK_RWKV_PREP1 : r == 4 ? PK_EVEN_SCAN1 : r == 5 ? PK_GEMM_OUT : PK_POST; }
    else { const int q = r - 7; layer = 2 * pair + 1; kind = q == 0 ? PK_GEMM_IN : q == 1 ? PK_ODD_PREP : q == 2 ? PK_ODD_SCAN : q == 3 ? PK_FIN_ODD_A : q == 4 ? PK_GEMM_GLU : q == 5 ? PK_GEMM_OUT : PK_POST; }
}
__host__ __device__ inline bool phase_is_gemm(int kind) { return kind == PK_GEMM_IN || kind == PK_GEMM_GLU || kind == PK_GEMM_OUT; }
__host__ __device__ inline int phase_nblk(int kind, int layer) {
    switch (kind) {
        case PK_PREP0: return MOD_VB + wt_stage_tiles(0) / WT_NT;
        case PK_FIN_ODD_B: return (T * 512 / 4 + 255) / 256;
        default: return (T + 4 * NTW - 1) / (4 * NTW);
    }
}
__device__ __forceinline__ void do_phase(const P& p, int kind, int layer, int vb, float* smem) {
    const int i = layer >> 1;
    switch (kind) {
        case PK_PREP0: if (vb < MOD_VB) { PT_B(50); ph_mod(p, vb, smem); PT_E(50); } else { PT_B(51); ph_wt(p, 0, vb - MOD_VB, smem); PT_E(51); } break;
        case PK_HMOD0: ph_hmod0(p, vb); break;
        case PK_FIN_EVEN: ph_fin_even(p, vb, i); break;
        case PK_FIN_ODD_A: ph_fin_odd_a(p, vb, i); break;
        case PK_FIN_ODD_B: ph_fin_odd_b(p, vb, i); break;
        case PK_POST: ph_post(p, vb, layer); break;
    }
}
__device__ __forceinline__ void do_gemm(const P& p, int kind, int layer, int G, int c, unsigned char* dsm) {
    const int i = layer >> 1;
    const bf16* hm = (const bf16*)(p.ws + WS_HM);
    pg8::StaticOrder S;
    LDS_AS unsigned char* lds = (LDS_AS unsigned char*)dsm;
    if (kind == PK_GEMM_IN) {
        if ((layer & 1) == 0) { pg8::Gemm g{hm, (const bf16*)(p.ws + WS_WTE) + (size_t)i * EWP * D, T, EWP, D, D}; S.init(T, EWP, G, c); pg8::EpiBf16 E{(bf16*)(p.ws + WS_PROJ), EW, EW}; pg8::gemm_phase(lds, g, S, E); }
        else { pg8::Gemm g{hm, (const bf16*)(p.ws + WS_WTO) + (size_t)i * OWP * D, T, OWP, D, D}; S.init(T, OWP, G, c); pg8::EpiBf16 E{(bf16*)(p.ws + WS_PROJ), OW, OW}; pg8::gemm_phase(lds, g, S, E); }
    } else if (kind == PK_GEMM_GLU) {
        const bf16* ysb = (const bf16*)(p.ws + WS_PART + 2 * PART_SZ);
        pg8::Gemm g{ysb, (const bf16*)(p.ws + WS_WTGLU) + (size_t)i * 512 * 512, T, 512, 512, 512}; S.init(T, 512, G, c);
        pg8::EpiGlu E{(bf16*)(p.ws + WS_HM) + 512, ysb, (const bf16*)(p.ws + WS_PROJ) + O_ZD, p.in[I_GLUB] + i * 512}; pg8::gemm_phase(lds, g, S, E);
    } else {
        const bf16* ya = (layer & 1) ? hm : (const bf16*)(p.ws + WS_YCE);
        pg8::Gemm g{ya, (const bf16*)(p.ws + WS_WTOUT) + (size_t)layer * D * D, T, D, D, D}; S.init(T, D, G, c); pg8::EpiBf16 E{(bf16*)(p.ws + WS_PROJ), D, D}; pg8::gemm_phase(lds, g, S, E);
    }
}
constexpr int LDS_BYTES = 163840;
constexpr bool EVEN_FUSED_SCHED = (NB_LAT == 8 && NB_CTX == 16 && L_CTX == 256 && L_LAT == 1024);
#ifndef REP_SCAN
#define REP_SCAN 1
#endif
#ifndef REP_GEMM
#define REP_GEMM 1
#endif

#ifdef CPU_EMU
__global__ void k_phase(P p, int kind, int layer, int nb) {
    __shared__ __attribute__((aligned(16))) unsigned char dsm[LDS_BYTES];
    if (phase_is_gemm(kind)) { do_gemm(p, kind, layer, gridDim.x, blockIdx.x, dsm); return; }
    if (kind == PK_ODD_SCAN) { ph_odd_scan_item(p, blockIdx.x, layer >> 1, (float*)dsm); return; }
    if (kind == PK_ODD_PREP) { ph_odd_prep(p, blockIdx.x, layer >> 1, true, dsm); return; }
    if (kind == PK_EVEN_SCAN || kind == PK_EVEN_SCAN1) { ph_even_scan_item(p, blockIdx.x, layer >> 1, kind == PK_EVEN_SCAN1, dsm); return; }
    if (kind == PK_RWKV_PREP0 || kind == PK_RWKV_PREP1) { rwkv_prep_phase(p, layer >> 1, kind == PK_RWKV_PREP1, blockIdx.x, gridDim.x, RWKV_PREP_ITEMS, dsm); return; }
    const int half = threadIdx.x >> 8, vb = 2 * blockIdx.x + half;
    if (vb < nb) do_phase(p, kind, layer, vb, (float*)dsm + half * 16384);
}
__global__ void k_side(P p, int what, int layer, int nb) {
    __shared__ __attribute__((aligned(16))) unsigned char dsm[LDS_BYTES];
    const int half = threadIdx.x >> 8, vb = 2 * blockIdx.x + half;
    if (vb < nb) { if (what == 0) ph_wt(p, layer, vb, (float*)dsm + half * 16384); else ph_fin_odd_gdn(p, vb, layer >> 1); }
}
void emu_hook(const char* stage, int layer, const P& p);
extern "C" void kernel_launch(void* const* d_in, const int* in_sizes, int n_in, void* d_out, int out_size, void* d_ws, size_t ws_size, hipStream_t stream) {
    P p{};
    for (int i = 0; i < 44; ++i) p.in[i] = (const float*)d_in[i];
    p.out = (float*)d_out; p.ws = (char*)d_ws;
    static const char* names[] = {"prep0", "hmod", "proj", "even_scan0", "ycat", "odd_prep", "odd_scan", "fin_odd_a", "ycat", "ycat", "outproj", "post", "rwkv_prep0", "rwkv_prep1", "even_scan"};
    for (int ph = 0; ph < NPH; ++ph) {
        int kind, layer; phase_desc(ph, kind, layer);
        const int nb = phase_nblk(kind, layer);
        EMU_LAUNCH(k_phase, phase_is_gemm(kind) ? 3 : kind == PK_ODD_SCAN ? ODD_SCAN_ITEMS : (kind == PK_EVEN_SCAN || kind == PK_EVEN_SCAN1) ? EVEN_SCAN_ITEMS : (kind == PK_RWKV_PREP0 || kind == PK_RWKV_PREP1) ? RWKV_PREP_ITEMS : kind == PK_ODD_PREP ? ODD_PREP_ITEMS : (nb + 1) / 2, 512, p, kind, layer, nb);
        if (kind == PK_GEMM_OUT && layer + 1 < DEPTH) EMU_LAUNCH(k_side, (wt_stage_tiles(layer + 1) / WT_NT + 1) / 2, 512, p, 0, layer + 1, wt_stage_tiles(layer + 1) / WT_NT);
        if (kind == PK_GEMM_GLU) EMU_LAUNCH(k_side, (phase_nblk(PK_FIN_ODD_A, layer) + 1) / 2, 512, p, 1, layer, phase_nblk(PK_FIN_ODD_A, layer));
        emu_hook(names[kind], layer, p);
    }
}
#else

#define XB_TMO      128
#define XB_XCNT(j)  (256  + 64 * (j))
#define XB_XSUB(j)  (1280 + 64 * (j))
#define XB_XGEN(j)  (2304 + 64 * (j))
#define XB_TOP      3328
#define XB_TOPGEN   3392
#define XCD_BAR_WORDS 3456
#define XB_SPIN_CAP (1u << 18)
__device__ __forceinline__ unsigned xb_ld(unsigned* p)              { return __hip_atomic_load(p, __ATOMIC_RELAXED, __HIP_MEMORY_SCOPE_AGENT); }
__device__ __forceinline__ unsigned xb_add(unsigned* p, unsigned v) { return __hip_atomic_fetch_add(p, v, __ATOMIC_RELAXED, __HIP_MEMORY_SCOPE_AGENT); }
__device__ __forceinline__ unsigned xb_xcc_id() { return (unsigned)__builtin_amdgcn_s_getreg((3 << 11) | 20) & 0xFu; }
#define XB_SPIN(cond, bar) do { unsigned _sp = 0; while (cond) { __builtin_amdgcn_s_sleep(1); \
    if ((++_sp & 255u) == 0u) { if (xb_ld(&(bar)[XB_TMO])) break; if (_sp > XB_SPIN_CAP) { atomicAdd(&(bar)[XB_TMO], 1u); break; } } } } while (0)
struct XcdBarrier { unsigned* bar; unsigned x; volatile LDS_AS unsigned* st; };
__device__ __forceinline__ XcdBarrier xcd_barrier_post(unsigned* bar, volatile LDS_AS unsigned* st) {
    XcdBarrier b; b.bar = bar; b.x = xb_xcc_id(); b.st = st;
    if (threadIdx.x == 0) (void)xb_add(&bar[XB_XCNT(b.x)], 1u);
    return b;
}
__device__ __forceinline__ void xcd_barrier_complete(unsigned* bar, unsigned x, unsigned& nloc, unsigned& nx) {
    const unsigned G = gridDim.x * gridDim.y * gridDim.z;
    unsigned sum, cnt, mine, sp = 0u;
    for (;;) {
        sum = 0u; cnt = 0u; mine = 0u;
#pragma unroll
        for (unsigned j = 0; j < 16; ++j) { const unsigned c = xb_ld(&bar[XB_XCNT(j)]); sum += c; cnt += (c > 0u) ? 1u : 0u; mine = (j == x) ? c : mine; }
        if (sum == G) break;
        __builtin_amdgcn_s_sleep(1);
        if ((++sp & 255u) == 0u) { if (xb_ld(&bar[XB_TMO])) break; if (sp > XB_SPIN_CAP) { atomicAdd(&bar[XB_TMO], 1u); break; } }
    }
    nloc = mine > 0u ? mine : 1u; nx = cnt > 0u ? cnt : 1u;
}
__device__ __forceinline__ void xcd_barrier(const XcdBarrier& b) {
    asm volatile("s_waitcnt vmcnt(0)" ::: "memory");
    __syncthreads();
    if (threadIdx.x == 0) {
        unsigned* bar = b.bar;
        __builtin_amdgcn_s_waitcnt(0);
        unsigned nloc = b.st[0], nx = b.st[1];
        if (nloc == 0u) { xcd_barrier_complete(bar, b.x, nloc, nx); b.st[0] = nloc; b.st[1] = nx; }
        const unsigned old = xb_add(&bar[XB_XSUB(b.x)], 1u);
        const unsigned gen = old / nloc;
        if (old + 1u == (gen + 1u) * nloc) {
            __builtin_amdgcn_fence(__ATOMIC_RELEASE, "agent");
            asm volatile("s_waitcnt vmcnt(0)" ::: "memory");
            const unsigned og = xb_add(&bar[XB_TOP], 1u);
            const unsigned tg = og / nx;
            if (og + 1u == (tg + 1u) * nx) xb_add(&bar[XB_TOPGEN], 1u);
            else XB_SPIN(xb_ld(&bar[XB_TOPGEN]) == tg, bar);
            __builtin_amdgcn_fence(__ATOMIC_ACQUIRE, "agent");
            xb_add(&bar[XB_XGEN(b.x)], 1u);
            asm volatile("s_waitcnt vmcnt(0)" ::: "memory");
        } else {
            XB_SPIN(xb_ld(&bar[XB_XGEN(b.x)]) == gen, bar);
            __builtin_amdgcn_fence(__ATOMIC_ACQUIRE, "agent");
            asm volatile("s_waitcnt vmcnt(0)" ::: "memory");
        }
    }
    __syncthreads();
}
extern __shared__ __attribute__((aligned(16))) unsigned char dsm[];
#define RUN_PHASE(KIND, LAYER) do { const int nb_ = phase_nblk(KIND, LAYER); const int half_ = opaque_tid() >> 8; \
    for (int b_ = blockIdx.x; 2 * b_ < nb_; b_ += gridDim.x) { const int vb_ = 2 * b_ + half_; if (vb_ < nb_) do_phase(p, KIND, LAYER, vb_, (float*)dsm + half_ * 16384); } } while (0)
#define RUN_GEMM(KIND, LAYER) do_gemm(p, KIND, LAYER, gridDim.x, blockIdx.x, dsm)
#define RUN_SIDE(NWG, NVB, CALL) do { const int nwg_ = (NWG), nvb_ = (NVB), half_ = opaque_tid() >> 8; \
    const int first_ = (int)gridDim.x > nwg_ ? (int)blockIdx.x - nwg_ : (int)blockIdx.x, stride_ = (int)gridDim.x > nwg_ ? (int)gridDim.x - nwg_ : (int)gridDim.x; \
    if (first_ >= 0) { if ((int)gridDim.x <= nwg_) __syncthreads(); for (int b_ = first_; 2 * b_ < nvb_; b_ += stride_) { const int v = 2 * b_ + half_; if (v < nvb_) { CALL; } } } } while (0)
typedef const __attribute__((address_space(4))) P* KP;
__device__ __forceinline__ const P& phase_args(KP pk) { asm volatile("" : "+s"(pk)); return *(const P*)pk; }
__global__ void __launch_bounds__(512) mega(P p_unused) {
    const KP pk = (KP)__builtin_amdgcn_kernarg_segment_ptr();
    volatile LDS_AS unsigned* xst = (volatile LDS_AS unsigned*)(dsm + LDS_BYTES - 16);
    if (threadIdx.x == 0) { xst[0] = 0u; xst[1] = 0u; xst[2] = 0u; xst[3] = 0u; }
    __syncthreads();
    XcdBarrier xb;
    { const P& p = phase_args(pk); xb = xcd_barrier_post((unsigned*)(p.ws + WS_BAR), xst); }
#define GSYNC() do { PT_B(31); const P& pb_ = phase_args(pk); XcdBarrier b_ = xb; b_.bar = (unsigned*)(pb_.ws + WS_BAR); xcd_barrier(b_); PT_E(31); } while (0)
    { PT_B(20); { const P& p = phase_args(pk); RUN_PHASE(PK_PREP0, 0); } GSYNC(); PT_E(20); }
    { PT_B(21); { const P& p = phase_args(pk); RUN_PHASE(PK_HMOD0, 0); } GSYNC(); PT_E(21); }
#pragma nounroll
    for (int pair = 0; pair < DEPTH / 2; ++pair) {
        const int le = 2 * pair, lo = 2 * pair + 1;
        { PT_B(22); { const P& p = phase_args(pk); RUN_GEMM(PK_GEMM_IN, le); } GSYNC(); PT_E(22); }
#pragma nounroll
        for (int dir_ = 0; dir_ < 2; ++dir_) {
            if (EVEN_FUSED_SCHED && gridDim.x == 256) {
                { PT_B(13); { const P& p = phase_args(pk); const int hg = blockIdx.x & 7, q = blockIdx.x >> 3;
                  int cg0, ncg;
                  PT_B(12);
                  if (q < 4) { const int x = hg * 4 + q; gla_scan_task(p, pair, NB_CTX + x / 4, x & 3, dir_, dsm); cg0 = q; ncg = 1; }
                  else if (q < 12) { const int x = hg * 8 + (q - 4); gla_scan_task(p, pair, x / 4, x & 3, dir_, dsm); ncg = 6; cg0 = 4 + (q - 4) * 6; }
                  else { cg0 = 52 + (q - 12) * 7; ncg = 7; }
                  PT_E(12); PT_B(11);
                  rwkv_prep_phase(p, pair, dir_, cg0 * 8 + hg, 8, (cg0 + ncg) * 8, dsm); PT_E(11); } GSYNC(); PT_E(13); }
                { PT_B(23); { const P& p = phase_args(pk); for (int w_ = blockIdx.x; w_ < EV_AP_LAT + EV_AP_CTX; w_ += gridDim.x) rwkv_apply_task(p, pair, w_ < EV_AP_LAT ? NB_CTX + w_ / 8 : (w_ - EV_AP_LAT) / 8, w_ & 7, dir_, dsm); } GSYNC(); PT_E(23); }
            } else {
                { const P& p = phase_args(pk); rwkv_prep_phase(p, pair, dir_, blockIdx.x, gridDim.x, RWKV_PREP_ITEMS, dsm); } GSYNC();
                { const P& p = phase_args(pk); for (int w_ = blockIdx.x; w_ < EVEN_SCAN_ITEMS; w_ += gridDim.x) ph_even_scan_item(p, w_, pair, dir_, dsm); } GSYNC();
            }
        }
        { PT_B(24); { const P& p = phase_args(pk); RUN_GEMM(PK_GEMM_OUT, le); RUN_SIDE((T / 256) * (D / 256), wt_stage_tiles(lo) / WT_NT, ph_wt(p, lo, v, (float*)dsm + half_ * 16384)); } GSYNC(); PT_E(24); }
        { PT_B(25); { const P& p = phase_args(pk); RUN_PHASE(PK_POST, le); } GSYNC(); PT_E(25); }
        { PT_B(26); { const P& p = phase_args(pk); RUN_GEMM(PK_GEMM_IN, lo); } GSYNC(); PT_E(26); }
        { PT_B(27); { const P& p = phase_args(pk); for (int w_ = blockIdx.x; w_ < ODD_PREP_ITEMS; w_ += gridDim.x) ph_odd_prep(p, w_, pair, w_ == (int)blockIdx.x || (gridDim.x & 3) != 0, dsm); } GSYNC(); PT_E(27); }
        { PT_B(28); { const P& p = phase_args(pk); for (int w_ = blockIdx.x; w_ < ODD_SCAN_ITEMS; w_ += gridDim.x) { PT_B(60); ph_odd_scan_item(p, w_, pair, (float*)dsm); PT_E(60); } } GSYNC(); PT_E(28); }
        { PT_B(29); { const P& p = phase_args(pk); RUN_PHASE(PK_FIN_ODD_A, lo); } GSYNC(); PT_E(29); }
        { PT_B(30); { const P& p = phase_args(pk); RUN_GEMM(PK_GEMM_GLU, lo); RUN_SIDE((T / 256) * 2, phase_nblk(PK_FIN_ODD_A, lo), ph_fin_odd_gdn(p, v, pair)); } GSYNC(); PT_E(30); }
        { PT_B(24); { const P& p = phase_args(pk); RUN_GEMM(PK_GEMM_OUT, lo); if (lo + 1 < DEPTH) RUN_SIDE((T / 256) * (D / 256), wt_stage_tiles(lo + 1) / WT_NT, ph_wt(p, lo + 1, v, (float*)dsm + half_ * 16384)); } GSYNC(); PT_E(24); }
        { PT_B(25); const P& p = phase_args(pk); RUN_PHASE(PK_POST, lo); PT_E(25); }
        if (pair + 1 < DEPTH / 2) GSYNC();
    }
#if PROBE_SEL
    if (blockIdx.x == PROBE_BLK && threadIdx.x == 0) {
        const unsigned long long tot_ = *(volatile unsigned long long*)(dsm + LDS_BYTES - 8) * PROBE_MUL;
        const long long s_ = clock64();
        while ((unsigned long long)(clock64() - s_) < tot_) {}
    }
#endif
}
extern "C" void kernel_launch(void* const* d_in, const int* in_sizes, int n_in, void* d_out, int out_size, void* d_ws, size_t ws_size, hipStream_t stream) {
    static int grid_blocks = 0;
    if (!grid_blocks) {
        int dev = 0, cus = 0, per_cu = 0;
        (void)hipGetDevice(&dev);
        (void)hipDeviceGetAttribute(&cus, hipDeviceAttributeMultiprocessorCount, dev);
        (void)hipFuncSetAttribute((const void*)mega, hipFuncAttributeMaxDynamicSharedMemorySize, LDS_BYTES);
        (void)hipOccupancyMaxActiveBlocksPerMultiprocessor(&per_cu, mega, 512, LDS_BYTES);
        if (per_cu < 1) fprintf(stderr, "occupancy query says %d blocks/CU\n", per_cu);
        grid_blocks = cus;
    }
    P p{};
    for (int i = 0; i < 44; ++i) p.in[i] = (const float*)d_in[i];
    p.out = (float*)d_out; p.ws = (char*)d_ws;
    (void)hipMemsetAsync((char*)d_ws + WS_BAR, 0, XCD_BAR_WORDS * 4, stream);
    hipLaunchKernelGGL(mega, dim3(grid_blocks), dim3(512), LDS_BYTES, stream, p);
    hipError_t e = hipPeekAtLastError();
    if (e != hipSuccess) fprintf(stderr, "launch failed: %s (grid %d)\n", hipGetErrorString(e), grid_blocks);
}
#endif
```
